# Optimizing an MI355X kernel written in HIP

```python
import jax, jax.numpy as jnp
from jax import lax
import numpy as np

D_MODEL = 2048
BATCH = 4
SEQ = 2048
DEPTH = 1
DEC_BATCH = 128
DEC_SEQ = 8
PAST_LEN = 16384
PAGE_SIZE = 128

MIX_WIDTH = D_MODEL
C_CONV = MIX_WIDTH // 2
CONV_WIDTH = 31
RWKV_HEAD_DIM = 64
RWKV_WIDTH = MIX_WIDTH - C_CONV
RWKV_HEADS = RWKV_WIDTH // RWKV_HEAD_DIM
DECAY_LORA = 96
A_LORA = 96
GATE_LORA = 256
N_RWKV_COLS = 3 * RWKV_WIDTH + DECAY_LORA + A_LORA + GATE_LORA
N_IN_COLS = 2 * C_CONV + N_RWKV_COLS
N_MEM = 256
XA_HEADS = 4
XA_HEAD_DIM = D_MODEL // XA_HEADS
D_FF = 11 * D_MODEL // 4
FFN_CONV_WIDTH = 3
RMS_EPS = 1e-6
LN_EPS = 1e-5
GN_EPS = 64e-5

kernel_name = 'hymba_conformer_rwkv7_convffn_xattn_step'


def rms_norm(x, g):
    xf = x.astype(jnp.float32)
    y = xf * lax.rsqrt(jnp.mean(xf * xf, axis=-1, keepdims=True) + RMS_EPS)
    return (y * g.astype(jnp.float32)).astype(x.dtype)


def layer_norm(x, g, b):
    xf = x.astype(jnp.float32)
    mu = jnp.mean(xf, axis=-1, keepdims=True)
    var = jnp.mean(jnp.square(xf - mu), axis=-1, keepdims=True)
    y = (xf - mu) * lax.rsqrt(var + LN_EPS) * g.astype(jnp.float32) + b.astype(jnp.float32)
    return y.astype(x.dtype)


def causal_dwconv(u, past, w, bias):
    k = w.shape[0]
    t = u.shape[1]
    full = jnp.concatenate([past.astype(u.dtype), u], axis=1)
    wf = w.astype(jnp.float32)
    acc = bias.astype(jnp.float32)
    for j in range(k):
        acc = acc + full[:, j:j + t].astype(jnp.float32) * wf[j]
    return acc.astype(u.dtype), full[:, t:]


def wkv_step(S, inp):
    r, w, k, v, a, b = inp
    sa = jnp.einsum('bhij,bhj->bhi', S, a)
    S = S * w[:, :, None, :] + sa[..., None] * b[:, :, None, :] + v[..., None] * k[:, :, None, :]
    y = jnp.einsum('bhij,bhj->bhi', S, r)
    return S, y


def rwkv7_mix(xs, wkv, p):
    f32 = jnp.float32
    b_, t_ = xs.shape[:2]
    W = RWKV_WIDTH
    heads = lambda z: z.reshape(b_, t_, RWKV_HEADS, RWKV_HEAD_DIM)
    r = xs[..., :W].astype(f32)
    k = xs[..., W:2 * W].astype(f32)
    v = xs[..., 2 * W:3 * W].astype(f32)
    o = 3 * W
    wd = xs[..., o:o + DECAY_LORA]
    ad = xs[..., o + DECAY_LORA:o + DECAY_LORA + A_LORA]
    gd = xs[..., o + DECAY_LORA + A_LORA:]
    w_log = -jax.nn.softplus(-(p['w0'] + jnp.tanh(wd) @ p['w_lora']).astype(f32)) - 0.5
    decay = jnp.exp(-jnp.exp(w_log))
    a = jax.nn.sigmoid((p['a0'] + ad @ p['a_lora']).astype(f32))
    g = (jax.nn.sigmoid(gd) @ p['g_lora']).astype(f32)
    kk = heads(k * p['k_k'].astype(f32))
    kk = kk / jnp.maximum(jnp.sqrt(jnp.sum(kk * kk, axis=-1, keepdims=True)), 1e-12)
    k = k * (1.0 + (a - 1.0) * p['k_a'].astype(f32))
    rh, kh, vh, ah = heads(r), heads(k), heads(v), heads(a)
    seq = tuple(jnp.moveaxis(z, 1, 0) for z in (rh, heads(decay), kh, vh, -kk, kk * ah))
    S_new, ys = lax.scan(wkv_step, wkv.astype(f32), seq)
    y = jnp.moveaxis(ys, 0, 1)
    mu = jnp.mean(y, axis=-1, keepdims=True)
    var = jnp.mean(jnp.square(y - mu), axis=-1, keepdims=True)
    yn = ((y - mu) * lax.rsqrt(var + GN_EPS)).reshape(b_, t_, W)
    yn = yn * p['ln_x_g'].astype(f32) + p['ln_x_b'].astype(f32)
    bonus = jnp.sum(rh * kh * heads(jnp.broadcast_to(p['r_k'].astype(f32), r.shape)), axis=-1, keepdims=True) * vh
    out = (yn + bonus.reshape(b_, t_, W)) * g
    return out.astype(xs.dtype), S_new


def memory_kv(mem, p):
    b_ = mem.shape[0]
    m = rms_norm(mem, p['norm_mem'])
    k = (m @ p['w_k']).reshape(b_, N_MEM, XA_HEADS, XA_HEAD_DIM)
    v = (m @ p['w_v']).reshape(b_, N_MEM, XA_HEADS, XA_HEAD_DIM)
    return k, v


def trunk_layer(x, mem_k, mem_v, conv_buf, shift, wkv, ffn_buf, p):
    b_, t_ = x.shape[:2]
    h = rms_norm(x, p['norm_mix_pre'])
    proj = h @ p['w_in']
    glu = proj[..., :C_CONV] * jax.nn.sigmoid(proj[..., C_CONV:2 * C_CONV])
    cv, new_conv = causal_dwconv(glu, conv_buf, p['conv_dw'], p['conv_dw_b'])
    cv = jax.nn.silu(layer_norm(cv, p['conv_ln_g'], p['conv_ln_b']))
    pr = proj[..., 2 * C_CONV:]
    prev = jnp.concatenate([shift[:, None].astype(pr.dtype), pr[:, :-1]], axis=1)
    xs = pr + (prev - pr) * p['rwkv_mu']
    new_shift = pr[:, -1]
    rw, new_wkv = rwkv7_mix(xs, wkv, p)
    mix = jnp.concatenate([cv, rw.astype(cv.dtype)], axis=-1) @ p['w_out']
    x = x + rms_norm(mix, p['norm_mix_post'])
    h = rms_norm(x, p['norm_xa_pre'])
    q = (h @ p['w_q']).reshape(b_, t_, XA_HEADS, XA_HEAD_DIM)
    s = jnp.einsum('bthd,bmhd->bhtm', q, mem_k.astype(q.dtype)).astype(jnp.float32) * (XA_HEAD_DIM ** -0.5)
    attn = jax.nn.softmax(s, axis=-1).astype(x.dtype)
    o = jnp.einsum('bhtm,bmhd->bthd', attn, mem_v.astype(x.dtype)).reshape(b_, t_, XA_HEADS * XA_HEAD_DIM)
    x = x + rms_norm(o @ p['w_o'], p['norm_xa_post'])
    h = rms_norm(x, p['norm_ffn_pre'])
    up = h @ p['w_up']
    uc, new_ffn = causal_dwconv(up, ffn_buf, p['ffn_dw'], p['ffn_dw_b'])
    act = jax.nn.silu(uc[..., :D_FF]) * uc[..., D_FF:]
    x = x + rms_norm(act @ p['w_down'], p['norm_ffn_post'])
    return x, new_conv, new_shift, new_wkv, new_ffn


def setup_inputs(seed: int = 0) -> dict:
    key = jax.random.key(seed)
    ks = iter(jax.random.split(key, 64))
    nrm = lambda shape, s=1.0: jax.random.normal(next(ks), shape, jnp.float32) * s
    gain = lambda n: 1.0 + nrm((DEPTH, n), 0.05)
    L = DEPTH
    return {
        'x_prompt': nrm((BATCH, SEQ, D_MODEL)),
        'x_sample': nrm((DEC_BATCH, DEC_SEQ, D_MODEL)),
        'cache_mem_k': nrm((L, DEC_BATCH, N_MEM, XA_HEADS, XA_HEAD_DIM)),
        'cache_mem_v': nrm((L, DEC_BATCH, N_MEM, XA_HEADS, XA_HEAD_DIM)),
        'state_conv': nrm((L, DEC_BATCH, CONV_WIDTH - 1, C_CONV), 0.5),
        'state_shift': nrm((L, DEC_BATCH, N_RWKV_COLS)),
        'state_wkv': nrm((L, DEC_BATCH, RWKV_HEADS, RWKV_HEAD_DIM, RWKV_HEAD_DIM), 0.1),
        'state_ffn': nrm((L, DEC_BATCH, FFN_CONV_WIDTH - 1, 2 * D_FF)),
        'mem_prompt': nrm((BATCH, N_MEM, D_MODEL)),
        'norm_mix_pre': gain(D_MODEL),
        'w_in': nrm((L, D_MODEL, N_IN_COLS), D_MODEL ** -0.5),
        'conv_dw': nrm((L, CONV_WIDTH, C_CONV), CONV_WIDTH ** -0.5),
        'conv_dw_b': nrm((L, C_CONV), 0.02),
        'conv_ln_g': gain(C_CONV),
        'conv_ln_b': nrm((L, C_CONV), 0.02),
        'rwkv_mu': jax.random.uniform(next(ks), (L, N_RWKV_COLS), jnp.float32),
        'w0': jax.random.uniform(next(ks), (L, RWKV_WIDTH), jnp.float32, -6.0, 1.0),
        'w_lora': nrm((L, DECAY_LORA, RWKV_WIDTH), 0.1 * DECAY_LORA ** -0.5),
        'a0': nrm((L, RWKV_WIDTH), 0.1),
        'a_lora': nrm((L, A_LORA, RWKV_WIDTH), 0.1 * A_LORA ** -0.5),
        'g_lora': nrm((L, GATE_LORA, RWKV_WIDTH), GATE_LORA ** -0.5),
        'k_k': 0.85 + nrm((L, RWKV_WIDTH), 0.05),
        'k_a': 1.0 + nrm((L, RWKV_WIDTH), 0.05),
        'r_k': nrm((L, RWKV_WIDTH), 0.1),
        'ln_x_g': gain(RWKV_WIDTH),
        'ln_x_b': nrm((L, RWKV_WIDTH), 0.02),
        'w_out': nrm((L, MIX_WIDTH, D_MODEL), MIX_WIDTH ** -0.5),
        'norm_mix_post': gain(D_MODEL),
        'norm_xa_pre': gain(D_MODEL),
        'norm_mem': gain(D_MODEL),
        'w_q': nrm((L, D_MODEL, XA_HEADS * XA_HEAD_DIM), D_MODEL ** -0.5),
        'w_k': nrm((L, D_MODEL, XA_HEADS * XA_HEAD_DIM), D_MODEL ** -0.5),
        'w_v': nrm((L, D_MODEL, XA_HEADS * XA_HEAD_DIM), D_MODEL ** -0.5),
        'w_o': nrm((L, XA_HEADS * XA_HEAD_DIM, D_MODEL), (XA_HEADS * XA_HEAD_DIM) ** -0.5),
        'norm_xa_post': gain(D_MODEL),
        'norm_ffn_pre': gain(D_MODEL),
        'w_up': nrm((L, D_MODEL, 2 * D_FF), D_MODEL ** -0.5),
        'ffn_dw': nrm((L, FFN_CONV_WIDTH, 2 * D_FF), FFN_CONV_WIDTH ** -0.5),
        'ffn_dw_b': nrm((L, 2 * D_FF), 0.02),
        'w_down': nrm((L, D_FF, D_MODEL), D_FF ** -0.5),
        'norm_ffn_post': gain(D_MODEL),
    }


def reference(x_prompt, x_sample, cache_mem_k, cache_mem_v, state_conv, state_shift, state_wkv, state_ffn,
              mem_prompt, norm_mix_pre, w_in, conv_dw, conv_dw_b, conv_ln_g, conv_ln_b, rwkv_mu, w0, w_lora,
              a0, a_lora, g_lora, k_k, k_a, r_k, ln_x_g, ln_x_b, w_out, norm_mix_post, norm_xa_pre, norm_mem,
              w_q, w_k, w_v, w_o, norm_xa_post, norm_ffn_pre, w_up, ffn_dw, ffn_dw_b, w_down, norm_ffn_post):
    bp = x_prompt.shape[0]
    dt = x_prompt.dtype
    yp, ys = x_prompt, x_sample
    conv_p, conv_s, shift_p, shift_s, wkv_p, wkv_s, ffn_p, ffn_s, memk_p, memv_p = ([] for _ in range(10))
    for l in range(DEPTH):
        p = {'norm_mix_pre': norm_mix_pre[l], 'w_in': w_in[l], 'conv_dw': conv_dw[l], 'conv_dw_b': conv_dw_b[l],
             'conv_ln_g': conv_ln_g[l], 'conv_ln_b': conv_ln_b[l], 'rwkv_mu': rwkv_mu[l], 'w0': w0[l],
             'w_lora': w_lora[l], 'a0': a0[l], 'a_lora': a_lora[l], 'g_lora': g_lora[l], 'k_k': k_k[l],
             'k_a': k_a[l], 'r_k': r_k[l], 'ln_x_g': ln_x_g[l], 'ln_x_b': ln_x_b[l], 'w_out': w_out[l],
             'norm_mix_post': norm_mix_post[l], 'norm_xa_pre': norm_xa_pre[l], 'norm_mem': norm_mem[l],
             'w_q': w_q[l], 'w_k': w_k[l], 'w_v': w_v[l], 'w_o': w_o[l], 'norm_xa_post': norm_xa_post[l],
             'norm_ffn_pre': norm_ffn_pre[l], 'w_up': w_up[l], 'ffn_dw': ffn_dw[l], 'ffn_dw_b': ffn_dw_b[l],
             'w_down': w_down[l], 'norm_ffn_post': norm_ffn_post[l]}
        mk, mv = memory_kv(mem_prompt, p)
        yp, c1, s1, w1, f1 = trunk_layer(
            yp, mk, mv,
            jnp.zeros((bp, CONV_WIDTH - 1, C_CONV), dt),
            jnp.zeros((bp, N_RWKV_COLS), dt),
            jnp.zeros((bp, RWKV_HEADS, RWKV_HEAD_DIM, RWKV_HEAD_DIM), jnp.float32),
            jnp.zeros((bp, FFN_CONV_WIDTH - 1, 2 * D_FF), dt), p)
        ys, c2, s2, w2, f2 = trunk_layer(ys, cache_mem_k[l], cache_mem_v[l], state_conv[l], state_shift[l],
                                         state_wkv[l], state_ffn[l], p)
        conv_p.append(c1); conv_s.append(c2); shift_p.append(s1); shift_s.append(s2)
        wkv_p.append(w1); wkv_s.append(w2); ffn_p.append(f1); ffn_s.append(f2)
        memk_p.append(mk); memv_p.append(mv)
    return (yp, ys, jnp.stack(conv_p), jnp.stack(conv_s), jnp.stack(shift_p), jnp.stack(shift_s),
            jnp.stack(wkv_p), jnp.stack(wkv_s), jnp.stack(ffn_p), jnp.stack(ffn_s),
            jnp.stack(memk_p), jnp.stack(memv_p))
```

```cpp
#include <hip/hip_runtime.h>
#include <hip/hip_cooperative_groups.h>
#include <cstdio>
#include <cstdint>
namespace cg = cooperative_groups;
constexpr int D = 2048, MP = 8192, MS = 1024, M = MP + MS, SEQ = 2048, TS = 8, NBP = 4, NBS = 128;
constexpr int CC = 1024, CW = 31, RW = 1024, RH = 16, HD = 64;
constexpr int NRC = 3520, NRCP = 3584, NINP = 5632;
constexpr int NMEM = 256, XH = 4, XD = 512, DFF = 5632, DFF2 = 11264;
namespace pg8 {
#define PG8_LAS __attribute__((address_space(3)))
typedef unsigned short bf16_t;
typedef short bf16x8 __attribute__((ext_vector_type(8)));
typedef float f32x4 __attribute__((ext_vector_type(4)));
typedef unsigned u32x4 __attribute__((ext_vector_type(4)));
constexpr int BM = 256, BK = 64, HALF = 128, HTB = HALF * BK * 2  , STAGE_BYTES = 8 * HTB, NXCD = 8, WGM = 8;

__host__ __device__ __forceinline__ int lds_byte(int r, int c) { const int st = (r >> 4) * 2 + (c >> 5), rr = r & 15, cc = c & 31, ob = rr * 64 + cc * 2; return st * 1024 + (ob ^ (((ob >> 9) & 1) << 5)); }
__host__ __device__ __forceinline__ void stage_rc(int b, int& R, int& C) { const int st = b / 1024, sb = b % 1024, swz = sb ^ (((sb >> 9) & 1) << 5); R = (st >> 1) * 16 + swz / 64; C = (st & 1) * 32 + (swz % 64) / 2; }
__host__ __device__ __forceinline__ int perm32(int rho) { const int n = rho >> 4, i = rho & 15; return 8 * (i >> 2) + 4 * n + (i & 3); }

struct Unit { int pm, pn; };
struct Gemm { const bf16_t* A; const bf16_t* Bt; int M, N, K; };

struct StaticOrder {
    int nM, nN, nwg, G, c;
    __host__ __device__ void init(int M, int N, int G_, int c_) { nM = M / BM; nN = N / BM; nwg = nM * nN; G = G_; c = c_; }
    __host__ __device__ bool next(int i, Unit& u) const {
        const long L = (long)i * G + c; if (L >= nwg) return false;
        int wgid = (int)L; { const int q = nwg / NXCD, r = nwg % NXCD, xcd = wgid % NXCD, off = wgid / NXCD; wgid = (xcd < r ? xcd * (q + 1) : r * (q + 1) + (xcd - r) * q) + off; }
        const int nig = WGM * nN, gid = wgid / nig, fm = gid * WGM, gsz = (nM - fm) < WGM ? (nM - fm) : WGM;
        u.pm = fm + ((wgid % nig) % gsz); u.pn = (wgid % nig) / gsz; return true;
    }
    __device__ __forceinline__ void a_ready(const Unit&) const {}
    __device__ __forceinline__ void done(const Unit&) const {}
};

__device__ __forceinline__ unsigned cvt_pk_bf16(float lo, float hi) { unsigned r; asm volatile("v_cvt_pk_bf16_f32 %0, %1, %2" : "=v"(r) : "v"(lo), "v"(hi)); return r; }
typedef float f32x2 __attribute__((ext_vector_type(2)));
typedef unsigned u32x2 __attribute__((ext_vector_type(2)));
struct EpiIn {
    static constexpr bool PERM = true, AFTER_DRAIN = false;
    bf16_t* glu; bf16_t* pr; float* oconv_p; float* oconv_s; float* oshift_p; float* oshift_s;
    __device__ __forceinline__ void operator()(const f32x4 (&acc)[2][2][4][2], const Unit& u, int wr, int wc, int fr, int fq) const {
        const int row0 = u.pm * BM + wr * 64 + fr;
        if (u.pn < 8) {
#pragma unroll
            for (int ai = 0; ai < 2; ++ai)
#pragma unroll
                for (int m = 0; m < 4; ++m) {
                    const int row = row0 + ai * HALF + m * 16;
                    float* cdst = nullptr;
                    if (row < MP) { const int t = row & (SEQ - 1); if (t >= SEQ - 30) cdst = oconv_p + (size_t)((row >> 11) * 30 + (t - (SEQ - 30))) * CC; }
                    else { const int rs = row - MP; cdst = oconv_s + (size_t)((rs >> 3) * 30 + 22 + (rs & 7)) * CC; }
#pragma unroll
                    for (int bj = 0; bj < 2; ++bj) {
                        const int cgl = 16 * (8 * u.pn + 4 * bj + wc) + 4 * fq;
                        const f32x4 a = acc[ai][bj][m][0], g = acc[ai][bj][m][1];
                        f32x4 v;
#pragma unroll
                        for (int e = 0; e < 4; ++e) v[e] = a[e] / (1.0f + __expf(-g[e]));
                        u32x2 w; w.x = cvt_pk_bf16(v[0], v[1]); w.y = cvt_pk_bf16(v[2], v[3]);
                        *(u32x2*)(glu + (size_t)row * CC + cgl) = w;
                        if (cdst) *(f32x4*)(cdst + cgl) = v;
                    }
                }
        } else {
#pragma unroll
            for (int ai = 0; ai < 2; ++ai)
#pragma unroll
                for (int m = 0; m < 4; ++m) {
                    const int row = row0 + ai * HALF + m * 16;
                    float* sdst = nullptr;
                    if (row < MP) { if ((row & (SEQ - 1)) == SEQ - 1) sdst = oshift_p + (size_t)(row >> 11) * NRC; }
                    else { const int rs = row - MP; if ((rs & 7) == 7) sdst = oshift_s + (size_t)(rs >> 3) * NRC; }
#pragma unroll
                    for (int bj = 0; bj < 2; ++bj) {
                        const int jj0 = 256 * (u.pn - 8) + 128 * bj + 32 * wc + 8 * fq;
                        const f32x4 v0 = acc[ai][bj][m][0], v1 = acc[ai][bj][m][1];
                        u32x4 w; w.x = cvt_pk_bf16(v0[0], v0[1]); w.y = cvt_pk_bf16(v0[2], v0[3]); w.z = cvt_pk_bf16(v1[0], v1[1]); w.w = cvt_pk_bf16(v1[2], v1[3]);
                        *(u32x4*)(pr + (size_t)row * NRCP + jj0) = w;
                        if (sdst && jj0 < NRC) { *(f32x4*)(sdst + jj0) = v0; *(f32x4*)(sdst + jj0 + 4) = v1; }
                    }
                }
        }
    }
};
struct EpiKV {
    static constexpr bool PERM = false, AFTER_DRAIN = false;
    float* ok; float* ov; bf16_t* kb; bf16_t* vt;
    __device__ __forceinline__ void operator()(const f32x4 (&acc)[2][2][4][2], const Unit& u, int wr, int wc, int fr, int fq) const {
        const int row0 = u.pm * BM + wr * 64 + fr;
#pragma unroll
        for (int ai = 0; ai < 2; ++ai)
#pragma unroll
            for (int m = 0; m < 4; ++m) {
                const int r = row0 + ai * HALF + m * 16;
#pragma unroll
                for (int bj = 0; bj < 2; ++bj)
#pragma unroll
                    for (int n = 0; n < 2; ++n) {
                        const int c = 256 * u.pn + 128 * bj + 32 * wc + 16 * n + 4 * fq;
                        const f32x4 v = acc[ai][bj][m][n];
                        if (u.pn < 8) {
                            *(f32x4*)(ok + (size_t)r * 2048 + c) = v;
                            u32x2 w; w.x = cvt_pk_bf16(v[0], v[1]); w.y = cvt_pk_bf16(v[2], v[3]);
                            *(u32x2*)(kb + (size_t)r * 2048 + c) = w;
                        } else {
                            const int cv = c - 2048;
                            *(f32x4*)(ov + (size_t)r * 2048 + cv) = v;
                            const int b = r >> 8, key = r & 255, h = cv >> 9, d = cv & 511;
                            bf16_t* dst = vt + ((size_t)((b * 4 + h) * 512 + d)) * 256 + key;
                            const unsigned w0 = cvt_pk_bf16(v[0], v[1]), w1 = cvt_pk_bf16(v[2], v[3]);
                            dst[0] = (bf16_t)(w0 & 0xffffu); dst[256] = (bf16_t)(w0 >> 16); dst[512] = (bf16_t)(w1 & 0xffffu); dst[768] = (bf16_t)(w1 >> 16);
                        }
                    }
            }
    }
};
struct EpiF32 {
    static constexpr bool PERM = false, AFTER_DRAIN = false;
    float* C; int ldc;
    __device__ __forceinline__ void operator()(const f32x4 (&acc)[2][2][4][2], const Unit& u, int wr, int wc, int fr, int fq) const {
        const int row0 = u.pm * BM + wr * 64 + fr, col0 = u.pn * BM + wc * 32 + 4 * fq;
#pragma unroll
        for (int ai = 0; ai < 2; ++ai)
#pragma unroll
            for (int m = 0; m < 4; ++m) { float* rowp = C + (size_t)(row0 + ai * HALF + m * 16) * ldc + col0;
#pragma unroll
                for (int bj = 0; bj < 2; ++bj)
#pragma unroll
                    for (int n = 0; n < 2; ++n) *(f32x4*)(rowp + bj * HALF + n * 16) = acc[ai][bj][m][n]; }
    }
};
struct EpiBf16S {
    static constexpr bool PERM = true, AFTER_DRAIN = false;
    bf16_t* O; int ldc; float scale; float* f;
    __device__ __forceinline__ void operator()(const f32x4 (&acc)[2][2][4][2], const Unit& u, int wr, int wc, int fr, int fq) const {
        const int row0 = u.pm * BM + wr * 64 + fr, col0 = u.pn * BM + wc * 32 + 8 * fq;
#pragma unroll
        for (int ai = 0; ai < 2; ++ai)
#pragma unroll
            for (int m = 0; m < 4; ++m) {
                const int row = row0 + ai * HALF + m * 16;
                long foff = -1;
                if (f) {
                    if (row < MP) { const int t = row & (SEQ - 1); if (t >= SEQ - 2) foff = (long)((row >> 11) * 2 + (t - (SEQ - 2))) * DFF2; }
                    else { const int rs = row - MP, t = rs & 7; if (t >= 6) foff = (long)(NBP * 2 + (rs >> 3) * 2 + (t - 6)) * DFF2; }
                }
                float* fdst = f + (foff < 0 ? 0 : foff);
                bf16_t* rowp = O + (size_t)row * ldc + col0;
#pragma unroll
                for (int bj = 0; bj < 2; ++bj) {
                    const f32x4 v0 = acc[ai][bj][m][0] * scale, v1 = acc[ai][bj][m][1] * scale;
                    u32x4 w; w.x = cvt_pk_bf16(v0[0], v0[1]); w.y = cvt_pk_bf16(v0[2], v0[3]); w.z = cvt_pk_bf16(v1[0], v1[1]); w.w = cvt_pk_bf16(v1[2], v1[3]);
                    *(u32x4*)(rowp + bj * HALF) = w;
                    if (foff >= 0) { *(f32x4*)(fdst + col0 + bj * HALF) = v0; *(f32x4*)(fdst + col0 + bj * HALF + 4) = v1; }
                }
            }
    }
};

template <class Epi, class Sched, bool ALIGN_EPI = false, bool SP2 = false>
__device__ __forceinline__ void gemm_phase(PG8_LAS unsigned char* lds, const Gemm g, const Sched& S, const Epi& E) {
    const int tid = threadIdx.x, wid = __builtin_amdgcn_readfirstlane(tid >> 6), lane = tid & 63, wr = wid >> 2, wc = wid & 3, fr = lane & 15, fq = lane >> 4;
    const int K = g.K, nt = K / BK;
    unsigned voffA[2], voffB[2];
#pragma unroll
    for (int i = 0; i < 2; ++i) { int R, C; stage_rc(tid * 16 + i * 8192, R, C); const int Rb = Epi::PERM ? ((R & ~31) + perm32(R & 31)) : R;
        voffA[i] = (unsigned)(R * K + C) * 2u; voffB[i] = (unsigned)(Rb * K + C) * 2u; }
    const size_t kstep = (size_t)(BK * 2);
    const size_t hstep = (size_t)HALF * K * 2;
    const size_t tstep = 2 * hstep;
    const unsigned ldsw = (unsigned)wid * 1024u;
    const int aoff = lds_byte(wr * 64 + fr, fq * 8), boff = lds_byte(wc * 32 + fr, fq * 8);
#define PG8_SA(b, h) (((b) * 2 + (h)) * HTB)
#define PG8_SB(b, h) ((4 + (b) * 2 + (h)) * HTB)
#define PG8_STAGE(bufoff, gbase, voff) do { _Pragma("unroll") for (int _i = 0; _i < 2; ++_i) \
        __builtin_amdgcn_global_load_lds((const unsigned*)((const char*)(gbase) + (voff)[_i]), (PG8_LAS unsigned*)(lds + (bufoff) + ldsw + _i * 8192), 16, 0, 0); } while (0)
#define PG8_LDA(dst, b, h) do { _Pragma("unroll") for (int m = 0; m < 4; ++m) _Pragma("unroll") for (int k = 0; k < 2; ++k) dst[m][k] = *(const PG8_LAS bf16x8*)(lds + PG8_SA(b, h) + aoff + m * 2048 + k * 1024); } while (0)
#define PG8_LDB(dst, b, h) do { _Pragma("unroll") for (int n = 0; n < 2; ++n) _Pragma("unroll") for (int k = 0; k < 2; ++k) dst[n][k] = *(const PG8_LAS bf16x8*)(lds + PG8_SB(b, h) + boff + n * 2048 + k * 1024); } while (0)
#define PG8_MMA(ai, bj, At, Bt) do { __builtin_amdgcn_s_setprio(1); _Pragma("unroll") for (int m = 0; m < 4; ++m) _Pragma("unroll") for (int n = 0; n < 2; ++n) _Pragma("unroll") for (int k = 0; k < 2; ++k) \
        acc[ai][bj][m][n] = __builtin_amdgcn_mfma_f32_16x16x32_bf16(Bt[n][k], At[m][k], acc[ai][bj][m][n], 0, 0, 0); __builtin_amdgcn_s_setprio(0); } while (0)
#define PG8_WAIT_V(n) asm volatile("s_waitcnt vmcnt(" #n ")" ::: "memory")
#define PG8_WAIT_L(n) asm volatile("s_waitcnt lgkmcnt(" #n ")" ::: "memory")
#define PG8_BAR __builtin_amdgcn_s_barrier()
#define PG8_SCHED __builtin_amdgcn_sched_barrier(0)
    Unit cur, nxt; int ui = 0;
    if (!S.next(0, cur)) return;
    f32x4 acc[2][2][4][2];
#pragma unroll
    for (int a = 0; a < 2; ++a)
#pragma unroll
        for (int b = 0; b < 2; ++b)
#pragma unroll
            for (int m = 0; m < 4; ++m)
#pragma unroll
                for (int n = 0; n < 2; ++n) acc[a][b][m][n] = (f32x4){0.f, 0.f, 0.f, 0.f};
    bf16x8 At[4][2], B0[2][2], B1[2][2];
    const char* cA = (const char*)g.A + (size_t)cur.pm * tstep; const char* cB = (const char*)g.Bt + (size_t)cur.pn * tstep;
    S.a_ready(cur);
    if constexpr (SP2) {
        PG8_STAGE(PG8_SB(0, 0), cB, voffB); PG8_STAGE(PG8_SB(0, 1), cB + hstep, voffB); PG8_STAGE(PG8_SA(0, 0), cA, voffA); PG8_STAGE(PG8_SA(0, 1), cA + hstep, voffA);
        if (wr == 1) PG8_BAR;
        PG8_WAIT_V(2); PG8_BAR;
        PG8_STAGE(PG8_SB(1, 0), cB + kstep, voffB); PG8_STAGE(PG8_SA(1, 0), cA + kstep, voffA); PG8_STAGE(PG8_SB(1, 1), cB + hstep + kstep, voffB);
        PG8_WAIT_V(6); PG8_BAR;
    } else {
        PG8_STAGE(PG8_SB(0, 0), cB, voffB); PG8_STAGE(PG8_SA(0, 0), cA, voffA); PG8_STAGE(PG8_SB(0, 1), cB + hstep, voffB); PG8_STAGE(PG8_SA(0, 1), cA + hstep, voffA);
        if (wr == 1) PG8_BAR;
        PG8_WAIT_V(4); PG8_BAR;
        PG8_STAGE(PG8_SB(1, 0), cB + kstep, voffB); PG8_STAGE(PG8_SA(1, 0), cA + kstep, voffA); PG8_STAGE(PG8_SB(1, 1), cB + hstep + kstep, voffB);
        PG8_WAIT_V(6); PG8_BAR;
    }
    for (;;) {
        const bool has_next = S.next(ui + 1, nxt);
        const char* nA = has_next ? (const char*)g.A + (size_t)nxt.pm * tstep : cA; const char* nB = has_next ? (const char*)g.Bt + (size_t)nxt.pn * tstep : cB;
        for (int t = 0; t < nt; t += 2) {
            const bool last = (t == nt - 2);
            const char* a1 = cA + (size_t)(t + 1) * kstep;
            const char* a2 = last ? nA : cA + (size_t)(t + 2) * kstep; const char* b2 = last ? nB : cB + (size_t)(t + 2) * kstep;
            const char* a3 = a2 + kstep; const char* b3 = b2 + kstep;
            if (last && has_next) S.a_ready(nxt);
            if constexpr (SP2) {
            PG8_LDB(B0, 0, 0); PG8_LDB(B1, 0, 1); PG8_SCHED; PG8_LDA(At, 0, 0); PG8_STAGE(PG8_SA(1, 1), a1 + hstep, voffA);
            PG8_WAIT_V(8); PG8_WAIT_L(0); PG8_BAR; PG8_MMA(0, 0, At, B0); PG8_MMA(0, 1, At, B1); PG8_BAR; PG8_SCHED;
            PG8_LDA(At, 0, 1); PG8_STAGE(PG8_SB(0, 0), b2, voffB); PG8_STAGE(PG8_SB(0, 1), b2 + hstep, voffB); PG8_STAGE(PG8_SA(0, 0), a2, voffA);
            PG8_WAIT_V(8); PG8_WAIT_L(0); PG8_BAR; PG8_MMA(1, 0, At, B0); PG8_MMA(1, 1, At, B1); PG8_BAR; PG8_SCHED;
            PG8_LDB(B0, 1, 0); PG8_LDB(B1, 1, 1); PG8_SCHED; PG8_LDA(At, 1, 0); PG8_STAGE(PG8_SA(0, 1), a2 + hstep, voffA);
            PG8_WAIT_V(8); PG8_WAIT_L(0); PG8_BAR; PG8_MMA(0, 0, At, B0); PG8_MMA(0, 1, At, B1); PG8_BAR; PG8_SCHED;
            PG8_LDA(At, 1, 1); PG8_STAGE(PG8_SB(1, 0), b3, voffB); PG8_STAGE(PG8_SB(1, 1), b3 + hstep, voffB); PG8_STAGE(PG8_SA(1, 0), a3, voffA);
            PG8_WAIT_V(8); PG8_WAIT_L(0); PG8_BAR; PG8_MMA(1, 0, At, B0); PG8_MMA(1, 1, At, B1); PG8_BAR; PG8_SCHED;
            } else {
            PG8_LDB(B0, 0, 0); PG8_SCHED; PG8_LDA(At, 0, 0); PG8_STAGE(PG8_SA(1, 1), a1 + hstep, voffA);
            PG8_WAIT_L(8); PG8_BAR; PG8_WAIT_L(0); PG8_MMA(0, 0, At, B0); PG8_BAR; PG8_SCHED;
            PG8_LDB(B1, 0, 1); PG8_STAGE(PG8_SB(0, 0), b2, voffB);
            PG8_BAR; PG8_WAIT_L(0); PG8_MMA(0, 1, At, B1); PG8_BAR;
            PG8_LDA(At, 0, 1); PG8_STAGE(PG8_SA(0, 0), a2, voffA);
            PG8_BAR; PG8_WAIT_L(0); PG8_MMA(1, 0, At, B0); PG8_BAR; PG8_SCHED;
            PG8_STAGE(PG8_SB(0, 1), b2 + hstep, voffB);
            PG8_WAIT_V(6); PG8_BAR; PG8_MMA(1, 1, At, B1); PG8_BAR;
            PG8_LDB(B0, 1, 0); PG8_SCHED; PG8_LDA(At, 1, 0); PG8_STAGE(PG8_SA(0, 1), a2 + hstep, voffA);
            PG8_WAIT_L(8); PG8_BAR; PG8_WAIT_L(0); PG8_MMA(0, 0, At, B0); PG8_BAR; PG8_SCHED;
            PG8_LDB(B1, 1, 1); PG8_STAGE(PG8_SB(1, 0), b3, voffB);
            PG8_BAR; PG8_WAIT_L(0); PG8_MMA(0, 1, At, B1); PG8_BAR;
            PG8_LDA(At, 1, 1); PG8_STAGE(PG8_SA(1, 0), a3, voffA);
            PG8_BAR; PG8_WAIT_L(0); PG8_MMA(1, 0, At, B0); PG8_BAR; PG8_SCHED;
            PG8_STAGE(PG8_SB(1, 1), b3 + hstep, voffB);
            PG8_WAIT_V(6); PG8_BAR; PG8_MMA(1, 1, At, B1); PG8_BAR;
            }
        }
        if constexpr (ALIGN_EPI) { if (wr == 0) PG8_BAR; }
        if constexpr (!Epi::AFTER_DRAIN) { E(acc, cur, wr, wc, fr, fq); S.done(cur); }
        if (!has_next) break;
#pragma unroll
        for (int a = 0; a < 2; ++a)
#pragma unroll
            for (int b = 0; b < 2; ++b)
#pragma unroll
                for (int m = 0; m < 4; ++m)
#pragma unroll
                    for (int n = 0; n < 2; ++n) acc[a][b][m][n] = (f32x4){0.f, 0.f, 0.f, 0.f};
        cur = nxt; cA = nA; cB = nB; ++ui;
        if constexpr (ALIGN_EPI) { if (wr == 1) PG8_BAR; }
    }
    PG8_WAIT_V(0);
    if constexpr (!ALIGN_EPI) { if (wr == 0) PG8_BAR; }
    PG8_BAR;
    if constexpr (Epi::AFTER_DRAIN) { E.fused(acc, cur, wr, wc, fr, fq, lds, wid, lane); S.done(cur); }
#undef PG8_SA
#undef PG8_SB
#undef PG8_STAGE
#undef PG8_LDA
#undef PG8_LDB
#undef PG8_MMA
#undef PG8_WAIT_V
#undef PG8_WAIT_L
#undef PG8_BAR
#undef PG8_SCHED
}
}
#ifndef PG8_SP2
#define PG8_SP2 true
#endif
#ifndef PG8_ALIGN
#define PG8_ALIGN true
#endif
#define LAS __attribute__((address_space(3)))
typedef unsigned short bf16;
typedef unsigned v4u __attribute__((ext_vector_type(4)));
typedef unsigned v2u __attribute__((ext_vector_type(2)));
typedef float f32x4 __attribute__((ext_vector_type(4)));
typedef float f32x2 __attribute__((ext_vector_type(2)));
typedef short bf16x8 __attribute__((ext_vector_type(8)));
constexpr int NT = 512;
constexpr int LDS_BYTES = 147456;
constexpr int NPHASE = 15;

constexpr size_t MiB = 1u << 20;
constexpr size_t WS_WIN = 1 * MiB, WS_WKV = 23 * MiB, WS_WOUT = 39 * MiB, WS_WQ = 47 * MiB, WS_WO = 55 * MiB, WS_WUP = 63 * MiB, WS_WDN = 107 * MiB;
constexpr size_t WS_LW = 129 * MiB, WS_LA = 129 * MiB + 256 * 1024, WS_LG = 129 * MiB + 512 * 1024;
constexpr size_t WS_HB = 130 * MiB, WS_MB = 166 * MiB, WS_A2 = 170 * MiB, WS_MIX = 206 * MiB, WS_X1 = 278 * MiB, WS_Q = 350 * MiB, WS_O = 386 * MiB;
constexpr size_t WS_KB = 422 * MiB, WS_VT = 426 * MiB, WS_Y = 430 * MiB, WS_G = 466 * MiB, WS_BON = 502 * MiB;
constexpr size_t WS_SHB = 818 * MiB;
constexpr size_t WS_SI = 503 * MiB, SI_STRIDE = 36 * MiB;
constexpr size_t WS_UP = 503 * MiB;
constexpr size_t WS_GLU = 719 * MiB, WS_PR = 737 * MiB;
constexpr size_t WS_ACT = 719 * MiB;
constexpr size_t WS_END = 820 * MiB;
constexpr size_t O_YP = 0, O_YS = 16777216, O_CP = 18874368, O_CS = 18997248, O_SP = 22929408, O_SS = 22943488, O_WP = 23394048, O_WS = 23656192,
                 O_FP = 32044800, O_FS = 32134912, O_MK = 35018496, O_MV = 37115648, O_END = 39212800;

enum { I_XP = 0, I_XS, I_CK, I_CV, I_SCONV, I_SSHIFT, I_SWKV, I_SFFN, I_MEM, I_NMIXPRE, I_WIN, I_CDW, I_CDWB, I_CLNG, I_CLNB, I_MU, I_W0, I_WLORA, I_A0, I_ALORA,
       I_GLORA, I_KK, I_KA, I_RK, I_LNXG, I_LNXB, I_WOUT, I_NMIXPOST, I_NXAPRE, I_NMEM, I_WQ, I_WK, I_WV, I_WO, I_NXAPOST, I_NFFNPRE, I_WUP, I_FDW, I_FDWB, I_WDOWN,
       I_NFFNPOST, N_IN };

struct Params { const float* in[N_IN]; float* out; unsigned char* ws; int ph_lo, ph_hi; };

__device__ __forceinline__ unsigned f2bf(float f) { unsigned u = __builtin_bit_cast(unsigned, f); return (u + 0x7fffu + ((u >> 16) & 1u)) >> 16; }
__device__ __forceinline__ unsigned pk2(float lo, float hi) { return f2bf(lo) | (f2bf(hi) << 16); }
__device__ __forceinline__ float bflo(unsigned u) { return __builtin_bit_cast(float, u << 16); }
__device__ __forceinline__ float bfhi(unsigned u) { return __builtin_bit_cast(float, u & 0xffff0000u); }
__device__ __forceinline__ float wave_sum(float v) {
#pragma unroll
    for (int o = 1; o < 64; o <<= 1) v += __shfl_xor(v, o);
    return v;
}
__device__ __forceinline__ float wave_max(float v) {
#pragma unroll
    for (int o = 1; o < 64; o <<= 1) v = fmaxf(v, __shfl_xor(v, o));
    return v;
}
__device__ __forceinline__ float sigm(float x) { return 1.0f / (1.0f + __expf(-x)); }
#define LDS_WAIT() asm volatile("s_waitcnt lgkmcnt(0)" ::: "memory")

struct Ctx { int tid, lane, wave, bid, G, gw, NGW; };

template <class ColMap>
__device__ __forceinline__ void transpose_item(const float* __restrict__ W, int K, int N, bf16* __restrict__ WT, LAS float* scr, int kb, int jb, int lane, ColMap cm) {
    const int k0 = 64 * kb, j0 = 32 * jb;
    const int sc = cm(j0 + (lane & 31));
#pragma unroll 8
    for (int i = 0; i < 32; ++i) { const int kk = 2 * i + (lane >> 5); scr[kk * 33 + (lane & 31)] = sc >= 0 ? W[(size_t)(k0 + kk) * N + sc] : 0.f; }
    LDS_WAIT(); asm volatile("" ::: "memory");
    const int c = lane & 7;
#pragma unroll
    for (int j = 0; j < 4; ++j) { const int n = (lane >> 3) + 8 * j; const LAS float* s = scr + (8 * c) * 33 + n;
        v4u o; o.x = pk2(s[0 * 33], s[1 * 33]); o.y = pk2(s[2 * 33], s[3 * 33]); o.z = pk2(s[4 * 33], s[5 * 33]); o.w = pk2(s[6 * 33], s[7 * 33]);
        *(v4u*)(WT + (size_t)(j0 + n) * K + k0 + 8 * c) = o; }
    LDS_WAIT(); asm volatile("" ::: "memory");
}
struct MapId { __device__ __forceinline__ int operator()(int j) const { return j; } };
struct MapIn {
    __device__ __forceinline__ int operator()(int j) const {
        if (j < 2048) { const int g = j >> 5, q = (j >> 3) & 3, n = (j >> 2) & 1, e = j & 3; return n * 1024 + 16 * g + 4 * q + e; }
        const int jj = j - 2048; return jj < NRC ? 2048 + jj : -1;
    }
};
__device__ __forceinline__ void rms_row_bf16(const float* __restrict__ xrow, const float* __restrict__ g, bf16* __restrict__ orow, int lane) {
    f32x4 v[8]; float s = 0.f;
#pragma unroll
    for (int j = 0; j < 8; ++j) { v[j] = *(const f32x4*)(xrow + 4 * (lane + 64 * j)); s += (v[j][0] * v[j][0] + v[j][1] * v[j][1]) + (v[j][2] * v[j][2] + v[j][3] * v[j][3]); }
    const float r = rsqrtf(wave_sum(s) * (1.0f / 2048.0f) + 1e-6f);
#pragma unroll
    for (int j = 0; j < 8; ++j) { const f32x4 gg = *(const f32x4*)(g + 4 * (lane + 64 * j));
        v2u o; o.x = pk2(v[j][0] * r * gg[0], v[j][1] * r * gg[1]); o.y = pk2(v[j][2] * r * gg[2], v[j][3] * r * gg[3]);
        *(v2u*)(orow + 4 * (lane + 64 * j)) = o; }
}
__device__ __forceinline__ void p0_prologue(const Params& P, const Ctx& C, LAS unsigned char* lds) {
    unsigned char* ws = P.ws;
    LAS float* scr = (LAS float*)(lds + C.wave * 16384);
    constexpr int I_IN = 32 * 176, I_SQ = 32 * 64, I_UP = 32 * 352, I_DN = 88 * 64;
    constexpr int NITEMS = I_IN + 5 * I_SQ + I_UP + I_DN;
    for (int it = C.gw; it < NITEMS; it += C.NGW) {
        int r = it;
        if (r < I_IN) { transpose_item(P.in[I_WIN], 2048, 5568, (bf16*)(ws + WS_WIN), scr, r / 176, r % 176, C.lane, MapIn()); continue; } r -= I_IN;
        if (r < I_SQ) { transpose_item(P.in[I_WK], 2048, 2048, (bf16*)(ws + WS_WKV), scr, r / 64, r % 64, C.lane, MapId()); continue; } r -= I_SQ;
        if (r < I_SQ) { transpose_item(P.in[I_WV], 2048, 2048, (bf16*)(ws + WS_WKV) + (size_t)2048 * 2048, scr, r / 64, r % 64, C.lane, MapId()); continue; } r -= I_SQ;
        if (r < I_SQ) { transpose_item(P.in[I_WOUT], 2048, 2048, (bf16*)(ws + WS_WOUT), scr, r / 64, r % 64, C.lane, MapId()); continue; } r -= I_SQ;
        if (r < I_SQ) { transpose_item(P.in[I_WQ], 2048, 2048, (bf16*)(ws + WS_WQ), scr, r / 64, r % 64, C.lane, MapId()); continue; } r -= I_SQ;
        if (r < I_SQ) { transpose_item(P.in[I_WO], 2048, 2048, (bf16*)(ws + WS_WO), scr, r / 64, r % 64, C.lane, MapId()); continue; } r -= I_SQ;
        if (r < I_UP) { transpose_item(P.in[I_WUP], 2048, 11264, (bf16*)(ws + WS_WUP), scr, r / 352, r % 352, C.lane, MapId()); continue; } r -= I_UP;
        transpose_item(P.in[I_WDOWN], 5632, 2048, (bf16*)(ws + WS_WDN), scr, r / 64, r % 64, C.lane, MapId());
    }
    const int gt = C.bid * NT + C.tid, ngt = C.G * NT;
    { bf16* d = (bf16*)(ws + WS_LW); const float* s = P.in[I_WLORA]; for (int i = gt; i < 1024 * 96; i += ngt) { const int n = i / 96, k = i - n * 96; d[i] = (bf16)f2bf(s[k * 1024 + n]); } }
    { bf16* d = (bf16*)(ws + WS_LA); const float* s = P.in[I_ALORA]; for (int i = gt; i < 1024 * 96; i += ngt) { const int n = i / 96, k = i - n * 96; d[i] = (bf16)f2bf(s[k * 1024 + n]); } }
    { bf16* d = (bf16*)(ws + WS_LG); const float* s = P.in[I_GLORA]; for (int i = gt; i < 1024 * 256; i += ngt) { const int n = i >> 8, k = i & 255; d[i] = (bf16)f2bf(s[k * 1024 + n]); } }
    for (int m = C.gw; m < M + 1024; m += C.NGW) {
        if (m < M) { const float* xr = m < MP ? P.in[I_XP] + (size_t)m * D : P.in[I_XS] + (size_t)(m - MP) * D; rms_row_bf16(xr, P.in[I_NMIXPRE], (bf16*)(ws + WS_HB) + (size_t)m * D, C.lane); }
        else { const int r = m - M; rms_row_bf16(P.in[I_MEM] + (size_t)r * D, P.in[I_NMEM], (bf16*)(ws + WS_MB) + (size_t)r * D, C.lane); }
    }
    { bf16* d = (bf16*)(ws + WS_SHB); const float* sp = P.in[I_SSHIFT];
      for (int i = gt; i < (NBS + 1) * NRCP; i += ngt) { const int b = i / NRCP, c = i - b * NRCP; d[i] = (b < NBS && c < NRC) ? (bf16)f2bf(sp[(size_t)b * NRC + c]) : (bf16)0; } }
    { const f32x4* s = (const f32x4*)P.in[I_SCONV]; f32x4* d = (f32x4*)(P.out + O_CS);
      for (int i = gt; i < NBS * 22 * 256; i += ngt) { const int b = i / (22 * 256), r = i - b * (22 * 256); d[(size_t)b * 30 * 256 + r] = s[(size_t)b * 30 * 256 + 8 * 256 + r]; } }
}

template <int R>
__device__ __forceinline__ void conv_task(const Params& P, const Ctx& C, LAS unsigned char* lds, int grow0  , int t0  , int sb  ) {
    const bf16* glu = (const bf16*)(P.ws + WS_GLU);
    LAS unsigned* st = (LAS unsigned*)lds;
    LAS float* red = (LAS float*)(lds + 98304);
    constexpr int NR = R + 30;
    for (int p = C.tid; p < NR * 128; p += NT) {
        const int rr = p >> 7, ch = p & 127; const int t = t0 - 30 + rr;
        v4u v = (v4u){0u, 0u, 0u, 0u};
        if (t >= 0) v = *(const v4u*)(glu + (size_t)(grow0 - 30 + rr) * CC + ch * 8);
        else if (sb >= 0) { const float* s = P.in[I_SCONV] + ((size_t)sb * 30 + rr) * CC + ch * 8;
            const f32x4 a = *(const f32x4*)s, b = *(const f32x4*)(s + 4); v.x = pk2(a[0], a[1]); v.y = pk2(a[2], a[3]); v.z = pk2(b[0], b[1]); v.w = pk2(b[2], b[3]); }
        *(LAS v4u*)(st + rr * 512 + ch * 4) = v;
    }
    const int c = 2 * C.tid;
    f32x2 w[31];
#pragma unroll
    for (int j = 0; j < 31; ++j) w[j] = *(const f32x2*)(P.in[I_CDW] + j * CC + c);
    const f32x2 bias = *(const f32x2*)(P.in[I_CDWB] + c);
    f32x2 acc[R];
#pragma unroll
    for (int r = 0; r < R; ++r) acc[r] = bias;
    __syncthreads();
#pragma unroll
    for (int rr = 0; rr < NR; ++rr) {
        const unsigned u = st[rr * 512 + C.tid]; const float x0 = bflo(u), x1 = bfhi(u);
#pragma unroll
        for (int r = 0; r < R; ++r) { const int j = rr - r; if (j >= 0 && j < 31) { acc[r][0] += x0 * w[j][0]; acc[r][1] += x1 * w[j][1]; } }
    }
    float s[R];
#pragma unroll
    for (int r = 0; r < R; ++r) s[r] = wave_sum(acc[r][0] + acc[r][1]);
    if (C.lane == 0) {
#pragma unroll
        for (int r = 0; r < R; ++r) red[C.wave * 16 + r] = s[r]; }
    __syncthreads();
    float mean[R];
#pragma unroll
    for (int r = 0; r < R; ++r) { float t = 0.f;
#pragma unroll
        for (int wv = 0; wv < 8; ++wv) t += red[wv * 16 + r];
        mean[r] = t * (1.0f / 1024.0f); }
    __syncthreads();
#pragma unroll
    for (int r = 0; r < R; ++r) { const float d0 = acc[r][0] - mean[r], d1 = acc[r][1] - mean[r]; acc[r][0] = d0; acc[r][1] = d1; s[r] = wave_sum(d0 * d0 + d1 * d1); }
    if (C.lane == 0) {
#pragma unroll
        for (int r = 0; r < R; ++r) red[C.wave * 16 + r] = s[r]; }
    __syncthreads();
    const f32x2 lg = *(const f32x2*)(P.in[I_CLNG] + c), lb = *(const f32x2*)(P.in[I_CLNB] + c);
    bf16* a2 = (bf16*)(P.ws + WS_A2);
#pragma unroll
    for (int r = 0; r < R; ++r) { float t = 0.f;
#pragma unroll
        for (int wv = 0; wv < 8; ++wv) t += red[wv * 16 + r];
        const float rstd = rsqrtf(t * (1.0f / 1024.0f) + 1e-5f);
        float y0 = acc[r][0] * rstd * lg[0] + lb[0], y1 = acc[r][1] * rstd * lg[1] + lb[1];
        y0 = y0 * sigm(y0); y1 = y1 * sigm(y1);
        *(unsigned*)(a2 + (size_t)(grow0 + r) * D + c) = pk2(y0, y1); }
    __syncthreads();
}

#define XS8(col_, xs_) do { const v4u cu_ = *(const v4u*)(curp + (col_)); const v4u pu_ = *(const v4u*)(prvp + (col_)); \
        const f32x4 m0_ = *(const f32x4*)(mup + (col_)), m1_ = *(const f32x4*)(mup + (col_) + 4); float c_, p_; \
        c_ = bflo(cu_.x); p_ = bflo(pu_.x); xs_[0] = c_ + (p_ - c_) * m0_[0]; c_ = bfhi(cu_.x); p_ = bfhi(pu_.x); xs_[1] = c_ + (p_ - c_) * m0_[1]; \
        c_ = bflo(cu_.y); p_ = bflo(pu_.y); xs_[2] = c_ + (p_ - c_) * m0_[2]; c_ = bfhi(cu_.y); p_ = bfhi(pu_.y); xs_[3] = c_ + (p_ - c_) * m0_[3]; \
        c_ = bflo(cu_.z); p_ = bflo(pu_.z); xs_[4] = c_ + (p_ - c_) * m1_[0]; c_ = bfhi(cu_.z); p_ = bfhi(pu_.z); xs_[5] = c_ + (p_ - c_) * m1_[1]; \
        c_ = bflo(cu_.w); p_ = bflo(pu_.w); xs_[6] = c_ + (p_ - c_) * m1_[2]; c_ = bfhi(cu_.w); p_ = bfhi(pu_.w); xs_[7] = c_ + (p_ - c_) * m1_[3]; } while (0)
#define XS4(col_, xs_) do { const v2u cu_ = *(const v2u*)(curp + (col_)); const v2u pu_ = *(const v2u*)(prvp + (col_)); const f32x4 m0_ = *(const f32x4*)(mup + (col_)); float c_, p_; \
        c_ = bflo(cu_.x); p_ = bflo(pu_.x); xs_[0] = c_ + (p_ - c_) * m0_[0]; c_ = bfhi(cu_.x); p_ = bfhi(pu_.x); xs_[1] = c_ + (p_ - c_) * m0_[1]; \
        c_ = bflo(cu_.y); p_ = bflo(pu_.y); xs_[2] = c_ + (p_ - c_) * m0_[2]; c_ = bfhi(cu_.y); p_ = bfhi(pu_.y); xs_[3] = c_ + (p_ - c_) * m0_[3]; } while (0)
__device__ __forceinline__ bf16x8 pack8(const float (&x)[8]) {
    v4u o; o.x = pk2(x[0], x[1]); o.y = pk2(x[2], x[3]); o.z = pk2(x[4], x[5]); o.w = pk2(x[6], x[7]);
    return __builtin_bit_cast(bf16x8, o);
}
__device__ __forceinline__ float tanh_fast(float x) { return 1.0f - 2.0f / (1.0f + __expf(2.0f * x)); }
__device__ __forceinline__ void prep_wave(const Params& P, int rowbase, int h, int lane) {
    const int fr = lane & 15, fq = lane >> 4, row = rowbase + fr;
    unsigned char* ws = P.ws;
    const bf16* curp = (const bf16*)(ws + WS_PR) + (size_t)row * NRCP;
    const bf16* prvp = curp - NRCP;
    if (row < MP) { if ((row & (SEQ - 1)) == 0) prvp = (const bf16*)(ws + WS_SHB) + (size_t)NBS * NRCP; }
    else { const int rs = row - MP; if ((rs & 7) == 0) prvp = (const bf16*)(ws + WS_SHB) + (size_t)(rs >> 3) * NRCP; }
    const float* mup = P.in[I_MU];
    const bf16* lw = (const bf16*)(ws + WS_LW); const bf16* la = (const bf16*)(ws + WS_LA); const bf16* lg = (const bf16*)(ws + WS_LG);
    const f32x4 z4 = (f32x4){0.f, 0.f, 0.f, 0.f};
    f32x4 accW[4] = {z4, z4, z4, z4}, accA[4] = {z4, z4, z4, z4}, accG[4] = {z4, z4, z4, z4};
    {   bf16x8 A[3];
#pragma unroll
        for (int s = 0; s < 3; ++s) { float xs[8]; XS8(3072 + 32 * s + 8 * fq, xs);
#pragma unroll
            for (int e = 0; e < 8; ++e) xs[e] = tanh_fast(xs[e]);
            A[s] = pack8(xs); }
#pragma unroll
        for (int nt = 0; nt < 4; ++nt)
#pragma unroll
            for (int s = 0; s < 3; ++s) { const bf16x8 b = *(const bf16x8*)(lw + (size_t)(h * 64 + 16 * nt + fr) * 96 + 32 * s + 8 * fq); accW[nt] = __builtin_amdgcn_mfma_f32_16x16x32_bf16(b, A[s], accW[nt], 0, 0, 0); }
    }
    {   bf16x8 A[3];
#pragma unroll
        for (int s = 0; s < 3; ++s) { float xs[8]; XS8(3168 + 32 * s + 8 * fq, xs); A[s] = pack8(xs); }
#pragma unroll
        for (int nt = 0; nt < 4; ++nt)
#pragma unroll
            for (int s = 0; s < 3; ++s) { const bf16x8 b = *(const bf16x8*)(la + (size_t)(h * 64 + 16 * nt + fr) * 96 + 32 * s + 8 * fq); accA[nt] = __builtin_amdgcn_mfma_f32_16x16x32_bf16(b, A[s], accA[nt], 0, 0, 0); }
    }
    {   bf16x8 A[8];
#pragma unroll
        for (int s = 0; s < 8; ++s) { float xs[8]; XS8(3264 + 32 * s + 8 * fq, xs);
#pragma unroll
            for (int e = 0; e < 8; ++e) xs[e] = sigm(xs[e]);
            A[s] = pack8(xs); }
#pragma unroll
        for (int nt = 0; nt < 4; ++nt)
#pragma unroll
            for (int s = 0; s < 8; ++s) { const bf16x8 b = *(const bf16x8*)(lg + (size_t)(h * 64 + 16 * nt + fr) * 256 + 32 * s + 8 * fq); accG[nt] = __builtin_amdgcn_mfma_f32_16x16x32_bf16(b, A[s], accG[nt], 0, 0, 0); }
    }
    float xk[4][4];
    float ss = 0.f;
#pragma unroll
    for (int nt = 0; nt < 4; ++nt) {
        const int c = h * 64 + 16 * nt + 4 * fq;
        XS4(1024 + c, xk[nt]);
        const f32x4 kkw = *(const f32x4*)(P.in[I_KK] + c);
#pragma unroll
        for (int e = 0; e < 4; ++e) { const float t = xk[nt][e] * kkw[e]; ss += t * t; }
    }
    ss += __shfl_xor(ss, 16); ss += __shfl_xor(ss, 32);
    const float inv = 1.0f / fmaxf(sqrtf(ss), 1e-12f);
    float bon = 0.f;
    float* SI = (float*)(ws + WS_SI); constexpr size_t SS = SI_STRIDE / 4;
#pragma unroll
    for (int nt = 0; nt < 4; ++nt) {
        const int c = h * 64 + 16 * nt + 4 * fq; const size_t o = (size_t)row * RW + c;
        float xr[4], xv[4];
        XS4(c, xr); XS4(2048 + c, xv);
        const f32x4 w0 = *(const f32x4*)(P.in[I_W0] + c), ka = *(const f32x4*)(P.in[I_KA] + c), rk = *(const f32x4*)(P.in[I_RK] + c);
        const f32x4 kkw = *(const f32x4*)(P.in[I_KK] + c), a0 = *(const f32x4*)(P.in[I_A0] + c);
        f32x4 vr, vw, vk, vv, va, vb;
#pragma unroll
        for (int e = 0; e < 4; ++e) {
            const float ee = 0.6065306597126334f * sigm(w0[e] + accW[nt][e]);
            vw[e] = __expf(-ee);
            const float a = sigm(a0[e] + accA[nt][e]);
            const float kn = xk[nt][e] * kkw[e] * inv;
            const float k2 = xk[nt][e] * (1.0f + (a - 1.0f) * ka[e]);
            vr[e] = xr[e]; vk[e] = k2; vv[e] = xv[e]; va[e] = -kn; vb[e] = kn * a;
            bon += xr[e] * k2 * rk[e];
        }
        *(f32x4*)(SI + 0 * SS + o) = vr; *(f32x4*)(SI + 1 * SS + o) = vw; *(f32x4*)(SI + 2 * SS + o) = vk;
        *(f32x4*)(SI + 3 * SS + o) = vv; *(f32x4*)(SI + 4 * SS + o) = va; *(f32x4*)(SI + 5 * SS + o) = vb;
        *(f32x4*)((float*)(ws + WS_G) + o) = accG[nt];
    }
    bon += __shfl_xor(bon, 16); bon += __shfl_xor(bon, 32);
    if (fq == 0) ((float*)(ws + WS_BON))[(size_t)row * RH + h] = bon;
}

constexpr int TC = 32, STEPF = 5 * 64 + 16;
__device__ __forceinline__ float red32(float v) {
    v += __shfl_xor(v, 1); v += __shfl_xor(v, 2); v += __shfl_xor(v, 4); v += __shfl_xor(v, 8); v += __shfl_xor(v, 16); return v;
}
__device__ __forceinline__ void scan_task(const Params& P, const Ctx& C, LAS unsigned char* lds, int m0, int T, int h, int rb, const float* s_in, float* s_out) {
    LAS float* buf = (LAS float*)lds;
    const float* SI = (const float*)(P.ws + WS_SI); constexpr size_t SS = SI_STRIDE / 4;
    float* Y = (float*)(P.ws + WS_Y);
    const int rl = C.lane >> 5, cl = C.lane & 31, irow = rb * 16 + C.wave * 2 + rl;
    float S0 = 0.f, S1 = 0.f;
    if (s_in) { const f32x2 t = *(const f32x2*)(s_in + (size_t)irow * 64 + 2 * cl); S0 = t[0]; S1 = t[1]; }
    constexpr int NPF = TC * STEPF / NT;
    static_assert(TC * STEPF % NT == 0, "chunk image divides over the threads");
    float pf[NPF];
#define SCAN_GLOAD(tc0_) do { _Pragma("unroll") for (int q = 0; q < NPF; ++q) { const int idx = C.tid + q * NT; const int t = idx / STEPF, o = idx - t * STEPF; \
        float v = 0.f; \
        if ((tc0_) + t < T) { const size_t rowo = (size_t)(m0 + (tc0_) + t) * RW + h * 64; \
            if (o < 320) { const int vec = o >> 6, j = o & 63; const int arr = vec == 0 ? 0 : vec == 1 ? 1 : vec == 2 ? 2 : vec == 3 ? 4 : 5; v = SI[arr * SS + rowo + j]; } \
            else v = SI[3 * SS + rowo + rb * 16 + (o - 320)]; } \
        pf[q] = v; } } while (0)
    const int nchunk = (T + TC - 1) / TC;
    SCAN_GLOAD(0);
    for (int ck = 0; ck < nchunk; ++ck) {
        LAS float* cb = buf + (ck & 1) * (TC * STEPF);
#pragma unroll
        for (int q = 0; q < NPF; ++q) cb[C.tid + q * NT] = pf[q];
        if (ck + 1 < nchunk) SCAN_GLOAD((ck + 1) * TC);
        __syncthreads();
        const int nst = (T - ck * TC) < TC ? (T - ck * TC) : TC;
        for (int t = 0; t < nst; ++t) {
            const LAS float* sb = cb + t * STEPF;
            const f32x2 r2 = *(const LAS f32x2*)(sb + 0 * 64 + 2 * cl), w2 = *(const LAS f32x2*)(sb + 1 * 64 + 2 * cl), k2 = *(const LAS f32x2*)(sb + 2 * 64 + 2 * cl);
            const f32x2 a2 = *(const LAS f32x2*)(sb + 3 * 64 + 2 * cl), b2 = *(const LAS f32x2*)(sb + 4 * 64 + 2 * cl);
            const float v = sb[320 + C.wave * 2 + rl];
            const float sa = red32(S0 * a2[0] + S1 * a2[1]);
            S0 = S0 * w2[0] + sa * b2[0] + v * k2[0];
            S1 = S1 * w2[1] + sa * b2[1] + v * k2[1];
            const float y = red32(S0 * r2[0] + S1 * r2[1]);
            if (cl == 0) Y[(size_t)(m0 + ck * TC + t) * RW + h * 64 + irow] = y;
        }
    }
    *(f32x2*)(s_out + (size_t)irow * 64 + 2 * cl) = (f32x2){S0, S1};
    __syncthreads();
}

__device__ __forceinline__ void post_row(const Params& P, int row, int lane) {
    const float* Y = (const float*)(P.ws + WS_Y) + (size_t)row * RW + 16 * lane;
    const float* V = (const float*)(P.ws + WS_SI) + 3 * (SI_STRIDE / 4) + (size_t)row * RW + 16 * lane;
    const float* G = (const float*)(P.ws + WS_G) + (size_t)row * RW + 16 * lane;
    const float bon = ((const float*)(P.ws + WS_BON))[(size_t)row * RH + (lane >> 2)];
    float y[16], s = 0.f;
#pragma unroll
    for (int q = 0; q < 4; ++q) { const f32x4 t = *(const f32x4*)(Y + 4 * q); y[4 * q] = t[0]; y[4 * q + 1] = t[1]; y[4 * q + 2] = t[2]; y[4 * q + 3] = t[3]; s += (t[0] + t[1]) + (t[2] + t[3]); }
    s += __shfl_xor(s, 1); s += __shfl_xor(s, 2);
    const float mu = s * (1.0f / 64.0f); float q2 = 0.f;
#pragma unroll
    for (int e = 0; e < 16; ++e) { y[e] -= mu; q2 += y[e] * y[e]; }
    q2 += __shfl_xor(q2, 1); q2 += __shfl_xor(q2, 2);
    const float rstd = rsqrtf(q2 * (1.0f / 64.0f) + 64e-5f);
    const float* lg = P.in[I_LNXG] + 16 * lane; const float* lb = P.in[I_LNXB] + 16 * lane;
    unsigned o[8];
#pragma unroll
    for (int q = 0; q < 4; ++q) { const f32x4 g4 = *(const f32x4*)(lg + 4 * q), b4 = *(const f32x4*)(lb + 4 * q), v4 = *(const f32x4*)(V + 4 * q), gg = *(const f32x4*)(G + 4 * q);
        float r[4];
#pragma unroll
        for (int e = 0; e < 4; ++e) r[e] = (y[4 * q + e] * rstd * g4[e] + b4[e] + bon * v4[e]) * gg[e];
        o[2 * q] = pk2(r[0], r[1]); o[2 * q + 1] = pk2(r[2], r[3]); }
    bf16* dst = (bf16*)(P.ws + WS_A2) + (size_t)row * D + 1024 + 16 * lane;
    *(v4u*)dst = (v4u){o[0], o[1], o[2], o[3]}; *(v4u*)(dst + 8) = (v4u){o[4], o[5], o[6], o[7]};
}

__device__ __forceinline__ void rowpass(const float* xa, const float* __restrict__ mix, const float* __restrict__ g1, float* xo,
                                        const float* __restrict__ g2, bf16* __restrict__ hb, int lane) {
    f32x4 mv[8]; float s = 0.f;
#pragma unroll
    for (int j = 0; j < 8; ++j) { mv[j] = *(const f32x4*)(mix + 4 * (lane + 64 * j)); s += (mv[j][0] * mv[j][0] + mv[j][1] * mv[j][1]) + (mv[j][2] * mv[j][2] + mv[j][3] * mv[j][3]); }
    const float r = rsqrtf(wave_sum(s) * (1.0f / 2048.0f) + 1e-6f);
    float s2 = 0.f;
#pragma unroll
    for (int j = 0; j < 8; ++j) { const f32x4 a = *(const f32x4*)(xa + 4 * (lane + 64 * j)), gg = *(const f32x4*)(g1 + 4 * (lane + 64 * j));
        mv[j] = a + mv[j] * r * gg; *(f32x4*)(xo + 4 * (lane + 64 * j)) = mv[j];
        s2 += (mv[j][0] * mv[j][0] + mv[j][1] * mv[j][1]) + (mv[j][2] * mv[j][2] + mv[j][3] * mv[j][3]); }
    if (hb) {
        const float r2 = rsqrtf(wave_sum(s2) * (1.0f / 2048.0f) + 1e-6f);
#pragma unroll
        for (int j = 0; j < 8; ++j) { const f32x4 gg = *(const f32x4*)(g2 + 4 * (lane + 64 * j));
            v2u o; o.x = pk2(mv[j][0] * r2 * gg[0], mv[j][1] * r2 * gg[1]); o.y = pk2(mv[j][2] * r2 * gg[2], mv[j][3] * r2 * gg[3]);
            *(v2u*)(hb + 4 * (lane + 64 * j)) = o; }
    }
}
__device__ __forceinline__ void attn_prompt_task(const Params& P, const Ctx& C, LAS unsigned char* lds, int b, int h, int qt) {
    const bf16* Qg = (const bf16*)(P.ws + WS_Q); const bf16* Kg = (const bf16*)(P.ws + WS_KB); const bf16* VTg = (const bf16*)(P.ws + WS_VT);
    bf16* Og = (bf16*)(P.ws + WS_O);
    const int fr = C.lane & 15, fq = C.lane >> 4;
    const int qrow = b * SEQ + qt * 128 + C.wave * 16 + fr;
    constexpr int BUFB = 33792;
    bf16x8 Qf[16];
#pragma unroll
    for (int s = 0; s < 16; ++s) Qf[s] = *(const bf16x8*)(Qg + (size_t)qrow * D + h * XD + 32 * s + 8 * fq);
    f32x4 accS[16];
#pragma unroll
    for (int nt = 0; nt < 16; ++nt) accS[nt] = (f32x4){0.f, 0.f, 0.f, 0.f};
    v4u stg[4];
#define ATT_GLOAD(c_) do { if ((c_) < 8) { _Pragma("unroll") for (int i = 0; i < 4; ++i) { const int idx = C.tid + i * NT, key = idx >> 3, ch = idx & 7; \
            stg[i] = *(const v4u*)(Kg + (size_t)(b * NMEM + key) * D + h * XD + (c_) * 64 + ch * 8); } } \
        else { _Pragma("unroll") for (int i = 0; i < 4; ++i) { const int idx = C.tid + i * NT, dd = idx >> 5, ch = idx & 31; \
            stg[i] = *(const v4u*)(VTg + ((size_t)((b * XH + h) * XD + ((c_) - 8) * 64 + dd)) * NMEM + ch * 8); } } } while (0)
#define ATT_SWRITE(c_) do { LAS unsigned char* sbuf = lds + ((c_) & 1) * BUFB; if ((c_) < 8) { _Pragma("unroll") for (int i = 0; i < 4; ++i) { const int idx = C.tid + i * NT, key = idx >> 3, ch = idx & 7; \
            *(LAS v4u*)(sbuf + key * 128 + ((ch ^ (key & 7)) * 16)) = stg[i]; } } \
        else { _Pragma("unroll") for (int i = 0; i < 4; ++i) { const int idx = C.tid + i * NT, dd = idx >> 5, ch = idx & 31; \
            *(LAS v4u*)(sbuf + dd * 528 + ch * 16) = stg[i]; } } } while (0)
    ATT_GLOAD(0); ATT_SWRITE(0); __syncthreads();
    bf16x8 Pf[8];
#pragma unroll
    for (int c = 0; c < 8; ++c) {
        ATT_GLOAD(c + 1);
        const LAS unsigned char* sbuf = lds + (c & 1) * BUFB;
#pragma unroll
        for (int ss = 0; ss < 2; ++ss)
#pragma unroll
            for (int nt = 0; nt < 16; ++nt) {
                const int key = 16 * nt + fr, ch = ss * 4 + fq;
                const bf16x8 kf = *(const LAS bf16x8*)(sbuf + key * 128 + ((ch ^ (key & 7)) * 16));
                accS[nt] = __builtin_amdgcn_mfma_f32_16x16x32_bf16(kf, Qf[2 * c + ss], accS[nt], 0, 0, 0);
            }
        if (c == 7) {
            float mx = -3.0e38f;
#pragma unroll
            for (int nt = 0; nt < 16; ++nt) mx = fmaxf(mx, fmaxf(fmaxf(accS[nt][0], accS[nt][1]), fmaxf(accS[nt][2], accS[nt][3])));
            mx = fmaxf(mx, __shfl_xor(mx, 16)); mx = fmaxf(mx, __shfl_xor(mx, 32));
            float sum = 0.f;
#pragma unroll
            for (int nt = 0; nt < 16; ++nt) {
#pragma unroll
                for (int e = 0; e < 4; ++e) { const float p = exp2f(accS[nt][e] - mx); accS[nt][e] = p; sum += p; } }
            sum += __shfl_xor(sum, 16); sum += __shfl_xor(sum, 32);
            const float inv = 1.0f / sum;
#pragma unroll
            for (int s = 0; s < 8; ++s) { v4u o; o.x = pk2(accS[2 * s][0] * inv, accS[2 * s][1] * inv); o.y = pk2(accS[2 * s][2] * inv, accS[2 * s][3] * inv);
                o.z = pk2(accS[2 * s + 1][0] * inv, accS[2 * s + 1][1] * inv); o.w = pk2(accS[2 * s + 1][2] * inv, accS[2 * s + 1][3] * inv); Pf[s] = __builtin_bit_cast(bf16x8, o); }
        }
        ATT_SWRITE(c + 1);
        __syncthreads();
    }
    for (int c = 8; c < 16; ++c) {
        if (c + 1 < 16) ATT_GLOAD(c + 1);
        const LAS unsigned char* sbuf = lds + (c & 1) * BUFB;
        const int dv = c - 8;
        f32x4 accO[4];
#pragma unroll
        for (int nd = 0; nd < 4; ++nd) accO[nd] = (f32x4){0.f, 0.f, 0.f, 0.f};
#pragma unroll
        for (int s = 0; s < 8; ++s)
#pragma unroll
            for (int nd = 0; nd < 4; ++nd) {
                const LAS unsigned char* rp = sbuf + (nd * 16 + fr) * 528 + (32 * s + 4 * fq) * 2;
                const v2u lo = *(const LAS v2u*)rp, hi = *(const LAS v2u*)(rp + 32);
                const bf16x8 vf = __builtin_bit_cast(bf16x8, ((v4u){lo.x, lo.y, hi.x, hi.y}));
                accO[nd] = __builtin_amdgcn_mfma_f32_16x16x32_bf16(vf, Pf[s], accO[nd], 0, 0, 0);
            }
#pragma unroll
        for (int nd = 0; nd < 4; ++nd) { v2u o; o.x = pk2(accO[nd][0], accO[nd][1]); o.y = pk2(accO[nd][2], accO[nd][3]);
            *(v2u*)(Og + (size_t)qrow * D + h * XD + dv * 64 + nd * 16 + 4 * fq) = o; }
        if (c + 1 < 16) ATT_SWRITE(c + 1);
        __syncthreads();
    }
#undef ATT_GLOAD
#undef ATT_SWRITE
}
__device__ __forceinline__ void attn_sample_task(const Params& P, const Ctx& C, LAS unsigned char* lds, int b, int h) {
    const bf16* Qg = (const bf16*)(P.ws + WS_Q); bf16* Og = (bf16*)(P.ws + WS_O);
    const float* CK = P.in[I_CK]; const float* CV = P.in[I_CV];
    LAS float* sS = (LAS float*)lds;
    LAS float* sP = (LAS float*)(lds + 8192);
    const int row0 = MP + 8 * b;
    float qv[8][8];
#pragma unroll
    for (int q = 0; q < 8; ++q) { const bf16* qp = Qg + (size_t)(row0 + q) * D + h * XD;
        const v2u a = *(const v2u*)(qp + 4 * C.lane), c2 = *(const v2u*)(qp + 256 + 4 * C.lane);
        qv[q][0] = bflo(a.x); qv[q][1] = bfhi(a.x); qv[q][2] = bflo(a.y); qv[q][3] = bfhi(a.y); qv[q][4] = bflo(c2.x); qv[q][5] = bfhi(c2.x); qv[q][6] = bflo(c2.y); qv[q][7] = bfhi(c2.y); }
    for (int k0 = 0; k0 < 32; k0 += 4) {
        f32x4 ka[4], kb2[4];
#pragma unroll
        for (int u = 0; u < 4; ++u) { const float* kp = CK + ((size_t)(b * NMEM + C.wave * 32 + k0 + u) * XH + h) * XD; ka[u] = *(const f32x4*)(kp + 4 * C.lane); kb2[u] = *(const f32x4*)(kp + 256 + 4 * C.lane); }
#pragma unroll
        for (int u = 0; u < 4; ++u) {
            float part[8];
#pragma unroll
            for (int q = 0; q < 8; ++q) part[q] = (qv[q][0] * ka[u][0] + qv[q][1] * ka[u][1]) + (qv[q][2] * ka[u][2] + qv[q][3] * ka[u][3]) + (qv[q][4] * kb2[u][0] + qv[q][5] * kb2[u][1]) + (qv[q][6] * kb2[u][2] + qv[q][7] * kb2[u][3]);
#pragma unroll
            for (int q = 0; q < 8; ++q) part[q] = wave_sum(part[q]);
            if (C.lane == 0) {
#pragma unroll
                for (int q = 0; q < 8; ++q) sS[q * 256 + C.wave * 32 + k0 + u] = part[q]; }
        }
    }
    __syncthreads();
    {
        const int q = C.wave; const f32x4 s4 = *(const LAS f32x4*)(sS + q * 256 + 4 * C.lane);
        const float mx = wave_max(fmaxf(fmaxf(s4[0], s4[1]), fmaxf(s4[2], s4[3])));
        const float p0 = exp2f(s4[0] - mx), p1 = exp2f(s4[1] - mx), p2 = exp2f(s4[2] - mx), p3 = exp2f(s4[3] - mx);
        const float inv = 1.0f / wave_sum((p0 + p1) + (p2 + p3));
        sP[(4 * C.lane + 0) * 8 + q] = p0 * inv; sP[(4 * C.lane + 1) * 8 + q] = p1 * inv; sP[(4 * C.lane + 2) * 8 + q] = p2 * inv; sP[(4 * C.lane + 3) * 8 + q] = p3 * inv;
    }
    __syncthreads();
    float acc[8];
#pragma unroll
    for (int q = 0; q < 8; ++q) acc[q] = 0.f;
    const int d = C.wave * 64 + C.lane;
    for (int k0 = 0; k0 < 256; k0 += 8) {
        float vv[8];
#pragma unroll
        for (int u = 0; u < 8; ++u) vv[u] = CV[((size_t)(b * NMEM + k0 + u) * XH + h) * XD + d];
#pragma unroll
        for (int u = 0; u < 8; ++u) { const f32x4 pa = *(const LAS f32x4*)(sP + (k0 + u) * 8), pb = *(const LAS f32x4*)(sP + (k0 + u) * 8 + 4);
            acc[0] += pa[0] * vv[u]; acc[1] += pa[1] * vv[u]; acc[2] += pa[2] * vv[u]; acc[3] += pa[3] * vv[u];
            acc[4] += pb[0] * vv[u]; acc[5] += pb[1] * vv[u]; acc[6] += pb[2] * vv[u]; acc[7] += pb[3] * vv[u]; }
    }
#pragma unroll
    for (int q = 0; q < 8; ++q) Og[(size_t)(row0 + q) * D + h * XD + d] = (bf16)f2bf(acc[q]);
    __syncthreads();
}

__device__ __forceinline__ void ffn_conv_act(const Params& P, const Ctx& C) {
    const bf16* UP = (const bf16*)(P.ws + WS_UP); bf16* ACT = (bf16*)(P.ws + WS_ACT);
    const float* FW = P.in[I_FDW]; const float* FB = P.in[I_FDWB]; const float* SF = P.in[I_SFFN];
    constexpr int NG = DFF / 8;
    const long total = (long)M * NG;
    for (long it = (long)C.bid * NT + C.tid; it < total; it += (long)C.G * NT) {
        const int row = (int)(it / NG), cg8 = (int)(it - (long)row * NG) * 8;
        int t, sb = -1; if (row < MP) t = row & (SEQ - 1); else { const int rs = row - MP; t = rs & 7; sb = rs >> 3; }
        float res[2][8];
#pragma unroll
        for (int half = 0; half < 2; ++half) {
            const int c = half * DFF + cg8;
            float x[3][8];
#pragma unroll
            for (int j = 0; j < 3; ++j) {
                const int tt = t - 2 + j;
                if (tt >= 0) { const v4u u = *(const v4u*)(UP + (size_t)(row - 2 + j) * DFF2 + c);
                    x[j][0] = bflo(u.x); x[j][1] = bfhi(u.x); x[j][2] = bflo(u.y); x[j][3] = bfhi(u.y); x[j][4] = bflo(u.z); x[j][5] = bfhi(u.z); x[j][6] = bflo(u.w); x[j][7] = bfhi(u.w); }
                else if (sb >= 0) { const float* s = SF + ((size_t)sb * 2 + (tt + 2)) * DFF2 + c; const f32x4 a = *(const f32x4*)s, b2 = *(const f32x4*)(s + 4);
                    x[j][0] = a[0]; x[j][1] = a[1]; x[j][2] = a[2]; x[j][3] = a[3]; x[j][4] = b2[0]; x[j][5] = b2[1]; x[j][6] = b2[2]; x[j][7] = b2[3]; }
                else {
#pragma unroll
                    for (int e = 0; e < 8; ++e) x[j][e] = 0.f; }
            }
#pragma unroll
            for (int e = 0; e < 8; ++e) res[half][e] = FB[c + e] + FW[c + e] * x[0][e] + FW[DFF2 + c + e] * x[1][e] + FW[2 * DFF2 + c + e] * x[2][e];
        }
        v4u o;
        float a[8];
#pragma unroll
        for (int e = 0; e < 8; ++e) a[e] = res[0][e] * sigm(res[0][e]) * res[1][e];
        o.x = pk2(a[0], a[1]); o.y = pk2(a[2], a[3]); o.z = pk2(a[4], a[5]); o.w = pk2(a[6], a[7]);
        *(v4u*)(ACT + (size_t)row * DFF + cg8) = o;
    }
}

template <bool COOP>
__global__ void __launch_bounds__(NT, 2) mega(Params P) {
    extern __shared__ __attribute__((aligned(16))) unsigned char lds_raw[];
    LAS unsigned char* lds = (LAS unsigned char*)lds_raw;
    Ctx C; C.tid = threadIdx.x; C.lane = C.tid & 63; C.wave = __builtin_amdgcn_readfirstlane(C.tid >> 6); C.bid = blockIdx.x; C.G = gridDim.x;
    C.gw = C.bid * 8 + C.wave; C.NGW = C.G * 8;
    unsigned char* ws = P.ws;
    const int lo = P.ph_lo, hi = P.ph_hi;
#ifndef MK_ONLY
#define MK_ONLY -1
#endif
#define IN(k) ((MK_ONLY < 0 || MK_ONLY == (k)) && lo <= (k) && (k) < hi)
#define SEAM(k) do { if constexpr (COOP) { if (IN(k) && IN((k) + 1)) cg::this_grid().sync(); } } while (0)

    if (IN(0)) { p0_prologue(P, C, lds); __syncthreads(); }
    SEAM(0);
    if (IN(1)) {
        { pg8::Gemm g{(const pg8::bf16_t*)(ws + WS_HB), (const pg8::bf16_t*)(ws + WS_WIN), M, NINP, D}; pg8::StaticOrder S; S.init(M, NINP, C.G, C.bid);
          pg8::EpiIn E{(pg8::bf16_t*)(ws + WS_GLU), (pg8::bf16_t*)(ws + WS_PR), P.out + O_CP, P.out + O_CS, P.out + O_SP, P.out + O_SS};
          pg8::gemm_phase<pg8::EpiIn, pg8::StaticOrder, PG8_ALIGN, PG8_SP2>(lds, g, S, E); }
        { pg8::Gemm g{(const pg8::bf16_t*)(ws + WS_MB), (const pg8::bf16_t*)(ws + WS_WKV), 1024, 4096, D}; pg8::StaticOrder S; S.init(1024, 4096, C.G, (C.bid + C.G - 24) % C.G);
          pg8::EpiKV E{P.out + O_MK, P.out + O_MV, (pg8::bf16_t*)(ws + WS_KB), (pg8::bf16_t*)(ws + WS_VT)};
          pg8::gemm_phase<pg8::EpiKV, pg8::StaticOrder, PG8_ALIGN, PG8_SP2>(lds, g, S, E); }
    }
    SEAM(1);
    if (IN(2)) {
        for (int tk = C.bid; tk < 640; tk += C.G) {
            if (tk < 512) { const int b = tk >> 7, r0 = (tk & 127) * 16; conv_task<16>(P, C, lds, b * SEQ + r0, r0, -1); }
            else { const int sb = tk - 512; conv_task<8>(P, C, lds, MP + 8 * sb, 0, sb); }
        }
        for (int tk = C.bid; tk < 1152; tk += C.G) { const int rg = tk >> 2, hg = tk & 3; prep_wave(P, rg * 32 + (C.wave >> 2) * 16, hg * 4 + (C.wave & 3), C.lane); }
    }
    SEAM(2);
    if (IN(3)) {
        for (int tk = C.bid; tk < 256; tk += C.G) { const int chain = tk >> 2, rb = tk & 3, b = chain >> 4, h = chain & 15;
            scan_task(P, C, lds, b * SEQ, SEQ, h, rb, nullptr, P.out + O_WP + (size_t)chain * 4096); }
        for (int tk = C.bid; tk < 8192; tk += C.G) { const int chain = tk >> 2, rb = tk & 3, b = chain >> 4, h = chain & 15;
            scan_task(P, C, lds, MP + 8 * b, 8, h, rb, P.in[I_SWKV] + (size_t)chain * 4096, P.out + O_WS + (size_t)chain * 4096); }
    }
    SEAM(3);
    if (IN(4)) { for (int m = C.gw; m < M; m += C.NGW) post_row(P, m, C.lane); }
    SEAM(4);
    if (IN(5)) { pg8::Gemm g{(const pg8::bf16_t*)(ws + WS_A2), (const pg8::bf16_t*)(ws + WS_WOUT), M, D, D}; pg8::StaticOrder S; S.init(M, D, C.G, C.bid);
        pg8::EpiF32 E{(float*)(ws + WS_MIX), D}; pg8::gemm_phase<pg8::EpiF32, pg8::StaticOrder, PG8_ALIGN, PG8_SP2>(lds, g, S, E); }
    SEAM(5);
    if (IN(6)) { for (int m = C.gw; m < M; m += C.NGW) { const float* xr = m < MP ? P.in[I_XP] + (size_t)m * D : P.in[I_XS] + (size_t)(m - MP) * D;
        rowpass(xr, (const float*)(ws + WS_MIX) + (size_t)m * D, P.in[I_NMIXPOST], (float*)(ws + WS_X1) + (size_t)m * D, P.in[I_NXAPRE], (bf16*)(ws + WS_HB) + (size_t)m * D, C.lane); } }
    SEAM(6);
    if (IN(7)) { pg8::Gemm g{(const pg8::bf16_t*)(ws + WS_HB), (const pg8::bf16_t*)(ws + WS_WQ), M, D, D}; pg8::StaticOrder S; S.init(M, D, C.G, C.bid);
        pg8::EpiBf16S E{(pg8::bf16_t*)(ws + WS_Q), D, 0.06375871479f  , nullptr};
        pg8::gemm_phase<pg8::EpiBf16S, pg8::StaticOrder, PG8_ALIGN, PG8_SP2>(lds, g, S, E); }
    SEAM(7);
    if (IN(8)) {
        for (int tk = C.bid; tk < 256; tk += C.G) attn_prompt_task(P, C, lds, tk >> 6, (tk >> 4) & 3, tk & 15);
        for (int tk = C.bid; tk < 512; tk += C.G) attn_sample_task(P, C, lds, tk >> 2, tk & 3);
    }
    SEAM(8);
    if (IN(9)) { pg8::Gemm g{(const pg8::bf16_t*)(ws + WS_O), (const pg8::bf16_t*)(ws + WS_WO), M, D, D}; pg8::StaticOrder S; S.init(M, D, C.G, C.bid);
        pg8::EpiF32 E{(float*)(ws + WS_MIX), D}; pg8::gemm_phase<pg8::EpiF32, pg8::StaticOrder, PG8_ALIGN, PG8_SP2>(lds, g, S, E); }
    SEAM(9);
    if (IN(10)) { for (int m = C.gw; m < M; m += C.NGW) { float* x1 = (float*)(ws + WS_X1) + (size_t)m * D;
        rowpass(x1, (const float*)(ws + WS_MIX) + (size_t)m * D, P.in[I_NXAPOST], x1, P.in[I_NFFNPRE], (bf16*)(ws + WS_HB) + (size_t)m * D, C.lane); } }
    SEAM(10);
    if (IN(11)) { pg8::Gemm g{(const pg8::bf16_t*)(ws + WS_HB), (const pg8::bf16_t*)(ws + WS_WUP), M, DFF2, D}; pg8::StaticOrder S; S.init(M, DFF2, C.G, C.bid);
        pg8::EpiBf16S E{(pg8::bf16_t*)(ws + WS_UP), DFF2, 1.0f, P.out + O_FP};
        pg8::gemm_phase<pg8::EpiBf16S, pg8::StaticOrder, PG8_ALIGN, PG8_SP2>(lds, g, S, E); }
    SEAM(11);
    if (IN(12)) ffn_conv_act(P, C);
    SEAM(12);
    if (IN(13)) { pg8::Gemm g{(const pg8::bf16_t*)(ws + WS_ACT), (const pg8::bf16_t*)(ws + WS_WDN), M, D, DFF}; pg8::StaticOrder S; S.init(M, D, C.G, C.bid);
        pg8::EpiF32 E{(float*)(ws + WS_MIX), D}; pg8::gemm_phase<pg8::EpiF32, pg8::StaticOrder, PG8_ALIGN, PG8_SP2>(lds, g, S, E); }
    SEAM(13);
    if (IN(14)) { for (int m = C.gw; m < M; m += C.NGW) { const float* x2 = (const float*)(ws + WS_X1) + (size_t)m * D;
        float* yo = m < MP ? P.out + O_YP + (size_t)m * D : P.out + O_YS + (size_t)(m - MP) * D;
        rowpass(x2, (const float*)(ws + WS_MIX) + (size_t)m * D, P.in[I_NFFNPOST], yo, nullptr, nullptr, C.lane); } }
#undef IN
#undef SEAM
}

#ifndef MK_ONE_LAUNCH
#define MK_ONE_LAUNCH 0
#endif
extern "C" void kernel_launch(void* const* d_in, const int* in_sizes, int n_in, void* d_out, int out_size, void* d_ws, size_t ws_size, hipStream_t stream) {
    static int grid = 0;
    if (grid == 0) {
        if (n_in != N_IN || (size_t)out_size != O_END || ws_size < WS_END) { fprintf(stderr, "kernel_launch: unexpected sizes: n_in %d out %d ws %zu (need %zu)\n", n_in, out_size, ws_size, (size_t)WS_END); grid = -1; return; }
        int dev = 0, cus = 0, per_cu = 0;
        (void)hipGetDevice(&dev); (void)hipDeviceGetAttribute(&cus, hipDeviceAttributeMultiprocessorCount, dev);
        (void)hipFuncSetAttribute((const void*)mega<(MK_ONE_LAUNCH != 0)>, hipFuncAttributeMaxDynamicSharedMemorySize, LDS_BYTES);
        (void)hipOccupancyMaxActiveBlocksPerMultiprocessor(&per_cu, (const void*)mega<(MK_ONE_LAUNCH != 0)>, NT, LDS_BYTES);
        fprintf(stderr, "kernel_launch: cus %d, occupancy query %d block(s)/CU, ws %zu MiB\n", cus, per_cu, ws_size >> 20);
        (void)hipGetLastError();
        grid = cus;
        if (per_cu < 1) { fprintf(stderr, "kernel_launch: occupancy query says 0 blocks per CU\n"); }
    }
    if (grid < 0) return;
    Params p{};
    for (int i = 0; i < N_IN; ++i) p.in[i] = (const float*)d_in[i];
    p.out = (float*)d_out; p.ws = (unsigned char*)d_ws;
#if MK_ONE_LAUNCH
    p.ph_lo = 0; p.ph_hi = NPHASE;
    void* args[] = {&p};
    hipError_t e = hipLaunchCooperativeKernel((const void*)mega<true>, dim3(grid), dim3(NT), args, LDS_BYTES, stream);
    if (e != hipSuccess) fprintf(stderr, "cooperative launch failed: %s (grid %d)\n", hipGetErrorString(e), grid);
#else
    for (int ph = 0; ph < NPHASE; ++ph) { p.ph_lo = ph; p.ph_hi = ph + 1; hipLaunchKernelGGL((mega<false>), dim3(grid), dim3(NT), LDS_BYTES, stream, p); }
#endif
}
```

```cpp
#include <hip/hip_runtime.h>
#include <hip/hip_cooperative_groups.h>
#include <cstdio>
#include <cstdint>
namespace cg = cooperative_groups;
constexpr int D = 2048, MP = 8192, MS = 1024, M = MP + MS, SEQ = 2048, TS = 8, NBP = 4, NBS = 128;
constexpr int CC = 1024, CW = 31, RW = 1024, RH = 16, HD = 64;
constexpr int NRC = 3520, NRCP = 3584, NINP = 5632;
constexpr int NMEM = 256, XH = 4, XD = 512, DFF = 5632, DFF2 = 11264;
namespace pg8 {
#define PG8_LAS __attribute__((address_space(3)))
typedef unsigned short bf16_t;
typedef short bf16x8 __attribute__((ext_vector_type(8)));
typedef float f32x4 __attribute__((ext_vector_type(4)));
typedef unsigned u32x4 __attribute__((ext_vector_type(4)));
constexpr int BM = 256, BK = 64, HALF = 128, HTB = HALF * BK * 2  , STAGE_BYTES = 8 * HTB, NXCD = 8, WGM = 8;

__host__ __device__ __forceinline__ int lds_byte(int r, int c) { const int st = (r >> 4) * 2 + (c >> 5), rr = r & 15, cc = c & 31, ob = rr * 64 + cc * 2; return st * 1024 + (ob ^ (((ob >> 9) & 1) << 5)); }
__host__ __device__ __forceinline__ void stage_rc(int b, int& R, int& C) { const int st = b / 1024, sb = b % 1024, swz = sb ^ (((sb >> 9) & 1) << 5); R = (st >> 1) * 16 + swz / 64; C = (st & 1) * 32 + (swz % 64) / 2; }
__host__ __device__ __forceinline__ int perm32(int rho) { const int n = rho >> 4, i = rho & 15; return 8 * (i >> 2) + 4 * n + (i & 3); }

struct Unit { int pm, pn; };
struct Gemm { const bf16_t* A; const bf16_t* Bt; int M, N, K; };

struct StaticOrder {
    int nM, nN, nwg, G, c;
    __host__ __device__ void init(int M, int N, int G_, int c_) { nM = M / BM; nN = N / BM; nwg = nM * nN; G = G_; c = c_; }
    __host__ __device__ bool next(int i, Unit& u) const {
        const long L = (long)i * G + c; if (L >= nwg) return false;
        int wgid = (int)L; { const int q = nwg / NXCD, r = nwg % NXCD, xcd = wgid % NXCD, off = wgid / NXCD; wgid = (xcd < r ? xcd * (q + 1) : r * (q + 1) + (xcd - r) * q) + off; }
        const int nig = WGM * nN, gid = wgid / nig, fm = gid * WGM, gsz = (nM - fm) < WGM ? (nM - fm) : WGM;
        u.pm = fm + ((wgid % nig) % gsz); u.pn = (wgid % nig) / gsz; return true;
    }
    __device__ __forceinline__ void a_ready(const Unit&) const {}
    __device__ __forceinline__ void done(const Unit&) const {}
};

__device__ __forceinline__ unsigned cvt_pk_bf16(float lo, float hi) { unsigned r; asm volatile("v_cvt_pk_bf16_f32 %0, %1, %2" : "=v"(r) : "v"(lo), "v"(hi)); return r; }
typedef float f32x2 __attribute__((ext_vector_type(2)));
typedef unsigned u32x2 __attribute__((ext_vector_type(2)));
struct EpiIn {
    static constexpr bool PERM = true, AFTER_DRAIN = false;
    bf16_t* glu; bf16_t* pr; float* oconv_p; float* oconv_s; float* oshift_p; float* oshift_s;
    __device__ __forceinline__ void operator()(const f32x4 (&acc)[2][2][4][2], const Unit& u, int wr, int wc, int fr, int fq) const {
        const int row0 = u.pm * BM + wr * 64 + fr;
        if (u.pn < 8) {
#pragma unroll
            for (int ai = 0; ai < 2; ++ai)
#pragma unroll
                for (int m = 0; m < 4; ++m) {
                    const int row = row0 + ai * HALF + m * 16;
                    float* cdst = nullptr;
                    if (row < MP) { const int t = row & (SEQ - 1); if (t >= SEQ - 30) cdst = oconv_p + (size_t)((row >> 11) * 30 + (t - (SEQ - 30))) * CC; }
                    else { const int rs = row - MP; cdst = oconv_s + (size_t)((rs >> 3) * 30 + 22 + (rs & 7)) * CC; }
#pragma unroll
                    for (int bj = 0; bj < 2; ++bj) {
                        const int cgl = 16 * (8 * u.pn + 4 * bj + wc) + 4 * fq;
                        const f32x4 a = acc[ai][bj][m][0], g = acc[ai][bj][m][1];
                        f32x4 v;
#pragma unroll
                        for (int e = 0; e < 4; ++e) v[e] = a[e] / (1.0f + __expf(-g[e]));
                        u32x2 w; w.x = cvt_pk_bf16(v[0], v[1]); w.y = cvt_pk_bf16(v[2], v[3]);
                        *(u32x2*)(glu + (size_t)row * CC + cgl) = w;
                        if (cdst) *(f32x4*)(cdst + cgl) = v;
                    }
                }
        } else {
#pragma unroll
            for (int ai = 0; ai < 2; ++ai)
#pragma unroll
                for (int m = 0; m < 4; ++m) {
                    const int row = row0 + ai * HALF + m * 16;
                    float* sdst = nullptr;
                    if (row < MP) { if ((row & (SEQ - 1)) == SEQ - 1) sdst = oshift_p + (size_t)(row >> 11) * NRC; }
                    else { const int rs = row - MP; if ((rs & 7) == 7) sdst = oshift_s + (size_t)(rs >> 3) * NRC; }
#pragma unroll
                    for (int bj = 0; bj < 2; ++bj) {
                        const int jj0 = 256 * (u.pn - 8) + 128 * bj + 32 * wc + 8 * fq;
                        const f32x4 v0 = acc[ai][bj][m][0], v1 = acc[ai][bj][m][1];
                        u32x4 w; w.x = cvt_pk_bf16(v0[0], v0[1]); w.y = cvt_pk_bf16(v0[2], v0[3]); w.z = cvt_pk_bf16(v1[0], v1[1]); w.w = cvt_pk_bf16(v1[2], v1[3]);
                        *(u32x4*)(pr + (size_t)row * NRCP + jj0) = w;
                        if (sdst && jj0 < NRC) { *(f32x4*)(sdst + jj0) = v0; *(f32x4*)(sdst + jj0 + 4) = v1; }
                    }
                }
        }
    }
};
struct EpiKV {
    static constexpr bool PERM = false, AFTER_DRAIN = false;
    float* ok; float* ov; bf16_t* kb; bf16_t* vt;
    __device__ __forceinline__ void operator()(const f32x4 (&acc)[2][2][4][2], const Unit& u, int wr, int wc, int fr, int fq) const {
        const int row0 = u.pm * BM + wr * 64 + fr;
#pragma unroll
        for (int ai = 0; ai < 2; ++ai)
#pragma unroll
            for (int m = 0; m < 4; ++m) {
                const int r = row0 + ai * HALF + m * 16;
#pragma unroll
                for (int bj = 0; bj < 2; ++bj)
#pragma unroll
                    for (int n = 0; n < 2; ++n) {
                        const int c = 256 * u.pn + 128 * bj + 32 * wc + 16 * n + 4 * fq;
                        const f32x4 v = acc[ai][bj][m][n];
                        if (u.pn < 8) {
                            *(f32x4*)(ok + (size_t)r * 2048 + c) = v;
                            u32x2 w; w.x = cvt_pk_bf16(v[0], v[1]); w.y = cvt_pk_bf16(v[2], v[3]);
                            *(u32x2*)(kb + (size_t)r * 2048 + c) = w;
                        } else {
                            const int cv = c - 2048;
                            *(f32x4*)(ov + (size_t)r * 2048 + cv) = v;
                            const int b = r >> 8, key = r & 255, h = cv >> 9, d = cv & 511;
                            bf16_t* dst = vt + ((size_t)((b * 4 + h) * 512 + d)) * 256 + key;
                            const unsigned w0 = cvt_pk_bf16(v[0], v[1]), w1 = cvt_pk_bf16(v[2], v[3]);
                            dst[0] = (bf16_t)(w0 & 0xffffu); dst[256] = (bf16_t)(w0 >> 16); dst[512] = (bf16_t)(w1 & 0xffffu); dst[768] = (bf16_t)(w1 >> 16);
                        }
                    }
            }
    }
};
struct EpiF32 {
    static constexpr bool PERM = false, AFTER_DRAIN = false;
    float* C; int ldc;
    __device__ __forceinline__ void operator()(const f32x4 (&acc)[2][2][4][2], const Unit& u, int wr, int wc, int fr, int fq) const {
        const int row0 = u.pm * BM + wr * 64 + fr, col0 = u.pn * BM + wc * 32 + 4 * fq;
#pragma unroll
        for (int ai = 0; ai < 2; ++ai)
#pragma unroll
            for (int m = 0; m < 4; ++m) { float* rowp = C + (size_t)(row0 + ai * HALF + m * 16) * ldc + col0;
#pragma unroll
                for (int bj = 0; bj < 2; ++bj)
#pragma unroll
                    for (int n = 0; n < 2; ++n) *(f32x4*)(rowp + bj * HALF + n * 16) = acc[ai][bj][m][n]; }
    }
};
struct EpiBf16S {
    static constexpr bool PERM = true, AFTER_DRAIN = false;
    bf16_t* O; int ldc; float scale; float* f;
    __device__ __forceinline__ void operator()(const f32x4 (&acc)[2][2][4][2], const Unit& u, int wr, int wc, int fr, int fq) const {
        const int row0 = u.pm * BM + wr * 64 + fr, col0 = u.pn * BM + wc * 32 + 8 * fq;
#pragma unroll
        for (int ai = 0; ai < 2; ++ai)
#pragma unroll
            for (int m = 0; m < 4; ++m) {
                const int row = row0 + ai * HALF + m * 16;
                long foff = -1;
                if (f) {
                    if (row < MP) { const int t = row & (SEQ - 1); if (t >= SEQ - 2) foff = (long)((row >> 11) * 2 + (t - (SEQ - 2))) * DFF2; }
                    else { const int rs = row - MP, t = rs & 7; if (t >= 6) foff = (long)(NBP * 2 + (rs >> 3) * 2 + (t - 6)) * DFF2; }
                }
                float* fdst = f + (foff < 0 ? 0 : foff);
                bf16_t* rowp = O + (size_t)row * ldc + col0;
#pragma unroll
                for (int bj = 0; bj < 2; ++bj) {
                    const f32x4 v0 = acc[ai][bj][m][0] * scale, v1 = acc[ai][bj][m][1] * scale;
                    u32x4 w; w.x = cvt_pk_bf16(v0[0], v0[1]); w.y = cvt_pk_bf16(v0[2], v0[3]); w.z = cvt_pk_bf16(v1[0], v1[1]); w.w = cvt_pk_bf16(v1[2], v1[3]);
                    *(u32x4*)(rowp + bj * HALF) = w;
                    if (foff >= 0) { *(f32x4*)(fdst + col0 + bj * HALF) = v0; *(f32x4*)(fdst + col0 + bj * HALF + 4) = v1; }
                }
            }
    }
};

template <class Epi, class Sched, bool ALIGN_EPI = false, bool SP2 = false>
__device__ __forceinline__ void gemm_phase(PG8_LAS unsigned char* lds, const Gemm g, const Sched& S, const Epi& E) {
    const int tid = threadIdx.x, wid = __builtin_amdgcn_readfirstlane(tid >> 6), lane = tid & 63, wr = wid >> 2, wc = wid & 3, fr = lane & 15, fq = lane >> 4;
    const int K = g.K, nt = K / BK;
    unsigned voffA[2], voffB[2];
#pragma unroll
    for (int i = 0; i < 2; ++i) { int R, C; stage_rc(tid * 16 + i * 8192, R, C); const int Rb = Epi::PERM ? ((R & ~31) + perm32(R & 31)) : R;
        voffA[i] = (unsigned)(R * K + C) * 2u; voffB[i] = (unsigned)(Rb * K + C) * 2u; }
    const size_t kstep = (size_t)(BK * 2);
    const size_t hstep = (size_t)HALF * K * 2;
    const size_t tstep = 2 * hstep;
    const unsigned ldsw = (unsigned)wid * 1024u;
    const int aoff = lds_byte(wr * 64 + fr, fq * 8), boff = lds_byte(wc * 32 + fr, fq * 8);
#define PG8_SA(b, h) (((b) * 2 + (h)) * HTB)
#define PG8_SB(b, h) ((4 + (b) * 2 + (h)) * HTB)
#define PG8_STAGE(bufoff, gbase, voff) do { _Pragma("unroll") for (int _i = 0; _i < 2; ++_i) \
        __builtin_amdgcn_global_load_lds((const unsigned*)((const char*)(gbase) + (voff)[_i]), (PG8_LAS unsigned*)(lds + (bufoff) + ldsw + _i * 8192), 16, 0, 0); } while (0)
#define PG8_LDA(dst, b, h) do { _Pragma("unroll") for (int m = 0; m < 4; ++m) _Pragma("unroll") for (int k = 0; k < 2; ++k) dst[m][k] = *(const PG8_LAS bf16x8*)(lds + PG8_SA(b, h) + aoff + m * 2048 + k * 1024); } while (0)
#define PG8_LDB(dst, b, h) do { _Pragma("unroll") for (int n = 0; n < 2; ++n) _Pragma("unroll") for (int k = 0; k < 2; ++k) dst[n][k] = *(const PG8_LAS bf16x8*)(lds + PG8_SB(b, h) + boff + n * 2048 + k * 1024); } while (0)
#define PG8_MMA(ai, bj, At, Bt) do { __builtin_amdgcn_s_setprio(1); _Pragma("unroll") for (int m = 0; m < 4; ++m) _Pragma("unroll") for (int n = 0; n < 2; ++n) _Pragma("unroll") for (int k = 0; k < 2; ++k) \
        acc[ai][bj][m][n] = __builtin_amdgcn_mfma_f32_16x16x32_bf16(Bt[n][k], At[m][k], acc[ai][bj][m][n], 0, 0, 0); __builtin_amdgcn_s_setprio(0); } while (0)
#define PG8_WAIT_V(n) asm volatile("s_waitcnt vmcnt(" #n ")" ::: "memory")
#define PG8_WAIT_L(n) asm volatile("s_waitcnt lgkmcnt(" #n ")" ::: "memory")
#define PG8_BAR __builtin_amdgcn_s_barrier()
#define PG8_SCHED __builtin_amdgcn_sched_barrier(0)
    Unit cur, nxt; int ui = 0;
    if (!S.next(0, cur)) return;
    f32x4 acc[2][2][4][2];
#pragma unroll
    for (int a = 0; a < 2; ++a)
#pragma unroll
        for (int b = 0; b < 2; ++b)
#pragma unroll
            for (int m = 0; m < 4; ++m)
#pragma unroll
                for (int n = 0; n < 2; ++n) acc[a][b][m][n] = (f32x4){0.f, 0.f, 0.f, 0.f};
    bf16x8 At[4][2], B0[2][2], B1[2][2];
    const char* cA = (const char*)g.A + (size_t)cur.pm * tstep; const char* cB = (const char*)g.Bt + (size_t)cur.pn * tstep;
    S.a_ready(cur);
    if constexpr (SP2) {
        PG8_STAGE(PG8_SB(0, 0), cB, voffB); PG8_STAGE(PG8_SB(0, 1), cB + hstep, voffB); PG8_STAGE(PG8_SA(0, 0), cA, voffA); PG8_STAGE(PG8_SA(0, 1), cA + hstep, voffA);
        if (wr == 1) PG8_BAR;
        PG8_WAIT_V(2); PG8_BAR;
        PG8_STAGE(PG8_SB(1, 0), cB + kstep, voffB); PG8_STAGE(PG8_SA(1, 0), cA + kstep, voffA); PG8_STAGE(PG8_SB(1, 1), cB + hstep + kstep, voffB);
        PG8_WAIT_V(6); PG8_BAR;
    } else {
        PG8_STAGE(PG8_SB(0, 0), cB, voffB); PG8_STAGE(PG8_SA(0, 0), cA, voffA); PG8_STAGE(PG8_SB(0, 1), cB + hstep, voffB); PG8_STAGE(PG8_SA(0, 1), cA + hstep, voffA);
        if (wr == 1) PG8_BAR;
        PG8_WAIT_V(4); PG8_BAR;
        PG8_STAGE(PG8_SB(1, 0), cB + kstep, voffB); PG8_STAGE(PG8_SA(1, 0), cA + kstep, voffA); PG8_STAGE(PG8_SB(1, 1), cB + hstep + kstep, voffB);
        PG8_WAIT_V(6); PG8_BAR;
    }
    for (;;) {
        const bool has_next = S.next(ui + 1, nxt);
        const char* nA = has_next ? (const char*)g.A + (size_t)nxt.pm * tstep : cA; const char* nB = has_next ? (const char*)g.Bt + (size_t)nxt.pn * tstep : cB;
        for (int t = 0; t < nt; t += 2) {
            const bool last = (t == nt - 2);
            const char* a1 = cA + (size_t)(t + 1) * kstep;
            const char* a2 = last ? nA : cA + (size_t)(t + 2) * kstep; const char* b2 = last ? nB : cB + (size_t)(t + 2) * kstep;
            const char* a3 = a2 + kstep; const char* b3 = b2 + kstep;
            if (last && has_next) S.a_ready(nxt);
            if constexpr (SP2) {
            PG8_LDB(B0, 0, 0); PG8_LDB(B1, 0, 1); PG8_SCHED; PG8_LDA(At, 0, 0); PG8_STAGE(PG8_SA(1, 1), a1 + hstep, voffA);
            PG8_WAIT_V(8); PG8_WAIT_L(0); PG8_BAR; PG8_MMA(0, 0, At, B0); PG8_MMA(0, 1, At, B1); PG8_BAR; PG8_SCHED;
            PG8_LDA(At, 0, 1); PG8_STAGE(PG8_SB(0, 0), b2, voffB); PG8_STAGE(PG8_SB(0, 1), b2 + hstep, voffB); PG8_STAGE(PG8_SA(0, 0), a2, voffA);
            PG8_WAIT_V(8); PG8_WAIT_L(0); PG8_BAR; PG8_MMA(1, 0, At, B0); PG8_MMA(1, 1, At, B1); PG8_BAR; PG8_SCHED;
            PG8_LDB(B0, 1, 0); PG8_LDB(B1, 1, 1); PG8_SCHED; PG8_LDA(At, 1, 0); PG8_STAGE(PG8_SA(0, 1), a2 + hstep, voffA);
            PG8_WAIT_V(8); PG8_WAIT_L(0); PG8_BAR; PG8_MMA(0, 0, At, B0); PG8_MMA(0, 1, At, B1); PG8_BAR; PG8_SCHED;
            PG8_LDA(At, 1, 1); PG8_STAGE(PG8_SB(1, 0), b3, voffB); PG8_STAGE(PG8_SB(1, 1), b3 + hstep, voffB); PG8_STAGE(PG8_SA(1, 0), a3, voffA);
            PG8_WAIT_V(8); PG8_WAIT_L(0); PG8_BAR; PG8_MMA(1, 0, At, B0); PG8_MMA(1, 1, At, B1); PG8_BAR; PG8_SCHED;
            } else {
            PG8_LDB(B0, 0, 0); PG8_SCHED; PG8_LDA(At, 0, 0); PG8_STAGE(PG8_SA(1, 1), a1 + hstep, voffA);
            PG8_WAIT_L(8); PG8_BAR; PG8_WAIT_L(0); PG8_MMA(0, 0, At, B0); PG8_BAR; PG8_SCHED;
            PG8_LDB(B1, 0, 1); PG8_STAGE(PG8_SB(0, 0), b2, voffB);
            PG8_BAR; PG8_WAIT_L(0); PG8_MMA(0, 1, At, B1); PG8_BAR;
            PG8_LDA(At, 0, 1); PG8_STAGE(PG8_SA(0, 0), a2, voffA);
            PG8_BAR; PG8_WAIT_L(0); PG8_MMA(1, 0, At, B0); PG8_BAR; PG8_SCHED;
            PG8_STAGE(PG8_SB(0, 1), b2 + hstep, voffB);
            PG8_WAIT_V(6); PG8_BAR; PG8_MMA(1, 1, At, B1); PG8_BAR;
            PG8_LDB(B0, 1, 0); PG8_SCHED; PG8_LDA(At, 1, 0); PG8_STAGE(PG8_SA(0, 1), a2 + hstep, voffA);
            PG8_WAIT_L(8); PG8_BAR; PG8_WAIT_L(0); PG8_MMA(0, 0, At, B0); PG8_BAR; PG8_SCHED;
            PG8_LDB(B1, 1, 1); PG8_STAGE(PG8_SB(1, 0), b3, voffB);
            PG8_BAR; PG8_WAIT_L(0); PG8_MMA(0, 1, At, B1); PG8_BAR;
            PG8_LDA(At, 1, 1); PG8_STAGE(PG8_SA(1, 0), a3, voffA);
            PG8_BAR; PG8_WAIT_L(0); PG8_MMA(1, 0, At, B0); PG8_BAR; PG8_SCHED;
            PG8_STAGE(PG8_SB(1, 1), b3 + hstep, voffB);
            PG8_WAIT_V(6); PG8_BAR; PG8_MMA(1, 1, At, B1); PG8_BAR;
            }
        }
        if constexpr (ALIGN_EPI) { if (wr == 0) PG8_BAR; }
        if constexpr (!Epi::AFTER_DRAIN) { E(acc, cur, wr, wc, fr, fq); S.done(cur); }
        if (!has_next) break;
#pragma unroll
        for (int a = 0; a < 2; ++a)
#pragma unroll
            for (int b = 0; b < 2; ++b)
#pragma unroll
                for (int m = 0; m < 4; ++m)
#pragma unroll
                    for (int n = 0; n < 2; ++n) acc[a][b][m][n] = (f32x4){0.f, 0.f, 0.f, 0.f};
        cur = nxt; cA = nA; cB = nB; ++ui;
        if constexpr (ALIGN_EPI) { if (wr == 1) PG8_BAR; }
    }
    PG8_WAIT_V(0);
    if constexpr (!ALIGN_EPI) { if (wr == 0) PG8_BAR; }
    PG8_BAR;
    if constexpr (Epi::AFTER_DRAIN) { E.fused(acc, cur, wr, wc, fr, fq, lds, wid, lane); S.done(cur); }
#undef PG8_SA
#undef PG8_SB
#undef PG8_STAGE
#undef PG8_LDA
#undef PG8_LDB
#undef PG8_MMA
#undef PG8_WAIT_V
#undef PG8_WAIT_L
#undef PG8_BAR
#undef PG8_SCHED
}
}
#ifndef PG8_SP2
#define PG8_SP2 true
#endif
#ifndef PG8_ALIGN
#define PG8_ALIGN true
#endif
#define LAS __attribute__((address_space(3)))
typedef unsigned short bf16;
typedef unsigned v4u __attribute__((ext_vector_type(4)));
typedef unsigned v2u __attribute__((ext_vector_type(2)));
typedef float f32x4 __attribute__((ext_vector_type(4)));
typedef float f32x2 __attribute__((ext_vector_type(2)));
typedef short bf16x8 __attribute__((ext_vector_type(8)));
constexpr int NT = 512;
constexpr int LDS_BYTES = 147456;
constexpr int NPHASE = 15;

constexpr size_t MiB = 1u << 20;
constexpr size_t WS_WIN = 1 * MiB, WS_WKV = 23 * MiB, WS_WOUT = 39 * MiB, WS_WQ = 47 * MiB, WS_WO = 55 * MiB, WS_WUP = 63 * MiB, WS_WDN = 107 * MiB;
constexpr size_t WS_LW = 129 * MiB, WS_LA = 129 * MiB + 256 * 1024, WS_LG = 129 * MiB + 512 * 1024;
constexpr size_t WS_HB = 130 * MiB, WS_MB = 166 * MiB, WS_A2 = 170 * MiB, WS_MIX = 206 * MiB, WS_X1 = 278 * MiB, WS_Q = 350 * MiB, WS_O = 386 * MiB;
constexpr size_t WS_KB = 422 * MiB, WS_VT = 426 * MiB, WS_Y = 430 * MiB, WS_G = 466 * MiB, WS_BON = 502 * MiB;
constexpr size_t WS_SHB = 818 * MiB;
constexpr size_t WS_SI = 503 * MiB, SI_STRIDE = 36 * MiB;
constexpr size_t WS_UP = 503 * MiB;
constexpr size_t WS_GLU = 719 * MiB, WS_PR = 737 * MiB;
constexpr size_t WS_ACT = 719 * MiB;
constexpr size_t WS_END = 820 * MiB;
constexpr size_t O_YP = 0, O_YS = 16777216, O_CP = 18874368, O_CS = 18997248, O_SP = 22929408, O_SS = 22943488, O_WP = 23394048, O_WS = 23656192,
                 O_FP = 32044800, O_FS = 32134912, O_MK = 35018496, O_MV = 37115648, O_END = 39212800;

enum { I_XP = 0, I_XS, I_CK, I_CV, I_SCONV, I_SSHIFT, I_SWKV, I_SFFN, I_MEM, I_NMIXPRE, I_WIN, I_CDW, I_CDWB, I_CLNG, I_CLNB, I_MU, I_W0, I_WLORA, I_A0, I_ALORA,
       I_GLORA, I_KK, I_KA, I_RK, I_LNXG, I_LNXB, I_WOUT, I_NMIXPOST, I_NXAPRE, I_NMEM, I_WQ, I_WK, I_WV, I_WO, I_NXAPOST, I_NFFNPRE, I_WUP, I_FDW, I_FDWB, I_WDOWN,
       I_NFFNPOST, N_IN };

struct Params { const float* in[N_IN]; float* out; unsigned char* ws; int ph_lo, ph_hi; };

__device__ __forceinline__ unsigned f2bf(float f) { unsigned u = __builtin_bit_cast(unsigned, f); return (u + 0x7fffu + ((u >> 16) & 1u)) >> 16; }
__device__ __forceinline__ unsigned pk2(float lo, float hi) { return f2bf(lo) | (f2bf(hi) << 16); }
__device__ __forceinline__ float bflo(unsigned u) { return __builtin_bit_cast(float, u << 16); }
__device__ __forceinline__ float bfhi(unsigned u) { return __builtin_bit_cast(float, u & 0xffff0000u); }
__device__ __forceinline__ float wave_sum(float v) {
#pragma unroll
    for (int o = 1; o < 64; o <<= 1) v += __shfl_xor(v, o);
    return v;
}
__device__ __forceinline__ float wave_max(float v) {
#pragma unroll
    for (int o = 1; o < 64; o <<= 1) v = fmaxf(v, __shfl_xor(v, o));
    return v;
}
__device__ __forceinline__ float sigm(float x) { return 1.0f / (1.0f + __expf(-x)); }
#define LDS_WAIT() asm volatile("s_waitcnt lgkmcnt(0)" ::: "memory")

struct Ctx { int tid, lane, wave, bid, G, gw, NGW; };
__device__ __forceinline__ const float* inp(const Params& P, int i) { int z; asm volatile("s_mov_b32 %0, 0" : "=s"(z)); return P.in[i + z]; }

template <class ColMap>
__device__ __forceinline__ void transpose_item(const float* __restrict__ W, int K, int N, bf16* __restrict__ WT, LAS float* scr, int kb, int jb, int lane, ColMap cm) {
    const int k0 = 64 * kb, j0 = 32 * jb;
    const int sc = cm(j0 + (lane & 31));
#pragma unroll 8
    for (int i = 0; i < 32; ++i) { const int kk = 2 * i + (lane >> 5); scr[kk * 33 + (lane & 31)] = sc >= 0 ? W[(size_t)(k0 + kk) * N + sc] : 0.f; }
    LDS_WAIT(); asm volatile("" ::: "memory");
    const int c = lane & 7;
#pragma unroll
    for (int j = 0; j < 4; ++j) { const int n = (lane >> 3) + 8 * j; const LAS float* s = scr + (8 * c) * 33 + n;
        v4u o; o.x = pk2(s[0 * 33], s[1 * 33]); o.y = pk2(s[2 * 33], s[3 * 33]); o.z = pk2(s[4 * 33], s[5 * 33]); o.w = pk2(s[6 * 33], s[7 * 33]);
        *(v4u*)(WT + (size_t)(j0 + n) * K + k0 + 8 * c) = o; }
    LDS_WAIT(); asm volatile("" ::: "memory");
}
struct MapId { __device__ __forceinline__ int operator()(int j) const { return j; } };
struct MapIn {
    __device__ __forceinline__ int operator()(int j) const {
        if (j < 2048) { const int g = j >> 5, q = (j >> 3) & 3, n = (j >> 2) & 1, e = j & 3; return n * 1024 + 16 * g + 4 * q + e; }
        const int jj = j - 2048; return jj < NRC ? 2048 + jj : -1;
    }
};
__device__ __forceinline__ void rms_row_bf16(const float* __restrict__ xrow, const float* __restrict__ g, bf16* __restrict__ orow, int lane) {
    f32x4 v[8]; float s = 0.f;
#pragma unroll
    for (int j = 0; j < 8; ++j) { v[j] = *(const f32x4*)(xrow + 4 * (lane + 64 * j)); s += (v[j][0] * v[j][0] + v[j][1] * v[j][1]) + (v[j][2] * v[j][2] + v[j][3] * v[j][3]); }
    const float r = rsqrtf(wave_sum(s) * (1.0f / 2048.0f) + 1e-6f);
#pragma unroll
    for (int j = 0; j < 8; ++j) { const f32x4 gg = *(const f32x4*)(g + 4 * (lane + 64 * j));
        v2u o; o.x = pk2(v[j][0] * r * gg[0], v[j][1] * r * gg[1]); o.y = pk2(v[j][2] * r * gg[2], v[j][3] * r * gg[3]);
        *(v2u*)(orow + 4 * (lane + 64 * j)) = o; }
}
__device__ __forceinline__ void p0_prologue(const Params& P, const Ctx& C, LAS unsigned char* lds) {
    unsigned char* ws = P.ws;
    LAS float* scr = (LAS float*)(lds + C.wave * 16384);
    constexpr int I_IN = 32 * 176, I_SQ = 32 * 64, I_UP = 32 * 352, I_DN = 88 * 64;
    constexpr int NITEMS = I_IN + 5 * I_SQ + I_UP + I_DN;
    for (int it = C.gw; it < NITEMS; it += C.NGW) {
        int r = it;
        if (r < I_IN) { transpose_item(inp(P, I_WIN), 2048, 5568, (bf16*)(ws + WS_WIN), scr, r / 176, r % 176, C.lane, MapIn()); continue; } r -= I_IN;
        if (r < I_SQ) { transpose_item(inp(P, I_WK), 2048, 2048, (bf16*)(ws + WS_WKV), scr, r / 64, r % 64, C.lane, MapId()); continue; } r -= I_SQ;
        if (r < I_SQ) { transpose_item(inp(P, I_WV), 2048, 2048, (bf16*)(ws + WS_WKV) + (size_t)2048 * 2048, scr, r / 64, r % 64, C.lane, MapId()); continue; } r -= I_SQ;
        if (r < I_SQ) { transpose_item(inp(P, I_WOUT), 2048, 2048, (bf16*)(ws + WS_WOUT), scr, r / 64, r % 64, C.lane, MapId()); continue; } r -= I_SQ;
        if (r < I_SQ) { transpose_item(inp(P, I_WQ), 2048, 2048, (bf16*)(ws + WS_WQ), scr, r / 64, r % 64, C.lane, MapId()); continue; } r -= I_SQ;
        if (r < I_SQ) { transpose_item(inp(P, I_WO), 2048, 2048, (bf16*)(ws + WS_WO), scr, r / 64, r % 64, C.lane, MapId()); continue; } r -= I_SQ;
        if (r < I_UP) { transpose_item(inp(P, I_WUP), 2048, 11264, (bf16*)(ws + WS_WUP), scr, r / 352, r % 352, C.lane, MapId()); continue; } r -= I_UP;
        transpose_item(inp(P, I_WDOWN), 5632, 2048, (bf16*)(ws + WS_WDN), scr, r / 64, r % 64, C.lane, MapId());
    }
    const int gt = C.bid * NT + C.tid, ngt = C.G * NT;
    { bf16* d = (bf16*)(ws + WS_LW); const float* s = inp(P, I_WLORA); for (int i = gt; i < 1024 * 96; i += ngt) { const int n = i / 96, k = i - n * 96; d[i] = (bf16)f2bf(s[k * 1024 + n]); } }
    { bf16* d = (bf16*)(ws + WS_LA); const float* s = inp(P, I_ALORA); for (int i = gt; i < 1024 * 96; i += ngt) { const int n = i / 96, k = i - n * 96; d[i] = (bf16)f2bf(s[k * 1024 + n]); } }
    { bf16* d = (bf16*)(ws + WS_LG); const float* s = inp(P, I_GLORA); for (int i = gt; i < 1024 * 256; i += ngt) { const int n = i >> 8, k = i & 255; d[i] = (bf16)f2bf(s[k * 1024 + n]); } }
    for (int m = C.gw; m < M + 1024; m += C.NGW) {
        if (m < M) { const float* xr = m < MP ? inp(P, I_XP) + (size_t)m * D : inp(P, I_XS) + (size_t)(m - MP) * D; rms_row_bf16(xr, inp(P, I_NMIXPRE), (bf16*)(ws + WS_HB) + (size_t)m * D, C.lane); }
        else { const int r = m - M; rms_row_bf16(inp(P, I_MEM) + (size_t)r * D, inp(P, I_NMEM), (bf16*)(ws + WS_MB) + (size_t)r * D, C.lane); }
    }
    { bf16* d = (bf16*)(ws + WS_SHB); const float* sp = inp(P, I_SSHIFT);
      for (int i = gt; i < (NBS + 1) * NRCP; i += ngt) { const int b = i / NRCP, c = i - b * NRCP; d[i] = (b < NBS && c < NRC) ? (bf16)f2bf(sp[(size_t)b * NRC + c]) : (bf16)0; } }
    { const f32x4* s = (const f32x4*)inp(P, I_SCONV); f32x4* d = (f32x4*)(P.out + O_CS);
      for (int i = gt; i < NBS * 22 * 256; i += ngt) { const int b = i / (22 * 256), r = i - b * (22 * 256); d[(size_t)b * 30 * 256 + r] = s[(size_t)b * 30 * 256 + 8 * 256 + r]; } }
}

template <int R>
__device__ __forceinline__ void conv_task(const Params& P, const Ctx& C, LAS unsigned char* lds, int grow0  , int t0  , int sb  ) {
    const bf16* glu = (const bf16*)(P.ws + WS_GLU);
    LAS unsigned* st = (LAS unsigned*)lds;
    LAS float* red = (LAS float*)(lds + 98304);
    constexpr int NR = R + 30;
    const float* sconv = inp(P, I_SCONV); const float* cdw = inp(P, I_CDW);
    for (int p = C.tid; p < NR * 128; p += NT) {
        const int rr = p >> 7, ch = p & 127; const int t = t0 - 30 + rr;
        v4u v = (v4u){0u, 0u, 0u, 0u};
        if (t >= 0) v = *(const v4u*)(glu + (size_t)(grow0 - 30 + rr) * CC + ch * 8);
        else if (sb >= 0) { const float* s = sconv + ((size_t)sb * 30 + rr) * CC + ch * 8;
            const f32x4 a = *(const f32x4*)s, b = *(const f32x4*)(s + 4); v.x = pk2(a[0], a[1]); v.y = pk2(a[2], a[3]); v.z = pk2(b[0], b[1]); v.w = pk2(b[2], b[3]); }
        *(LAS v4u*)(st + rr * 512 + ch * 4) = v;
    }
    const int c = 2 * C.tid;
    f32x2 w[31];
#pragma unroll
    for (int j = 0; j < 31; ++j) w[j] = *(const f32x2*)(cdw + j * CC + c);
    const f32x2 bias = *(const f32x2*)(inp(P, I_CDWB) + c);
    f32x2 acc[R];
#pragma unroll
    for (int r = 0; r < R; ++r) acc[r] = bias;
    __syncthreads();
#pragma unroll
    for (int rr = 0; rr < NR; ++rr) {
        const unsigned u = st[rr * 512 + C.tid]; const float x0 = bflo(u), x1 = bfhi(u);
#pragma unroll
        for (int r = 0; r < R; ++r) { const int j = rr - r; if (j >= 0 && j < 31) { acc[r][0] += x0 * w[j][0]; acc[r][1] += x1 * w[j][1]; } }
    }
    float s[R];
#pragma unroll
    for (int r = 0; r < R; ++r) s[r] = wave_sum(acc[r][0] + acc[r][1]);
    if (C.lane == 0) {
#pragma unroll
        for (int r = 0; r < R; ++r) red[C.wave * 16 + r] = s[r]; }
    __syncthreads();
    float mean[R];
#pragma unroll
    for (int r = 0; r < R; ++r) { float t = 0.f;
#pragma unroll
        for (int wv = 0; wv < 8; ++wv) t += red[wv * 16 + r];
        mean[r] = t * (1.0f / 1024.0f); }
    __syncthreads();
#pragma unroll
    for (int r = 0; r < R; ++r) { const float d0 = acc[r][0] - mean[r], d1 = acc[r][1] - mean[r]; acc[r][0] = d0; acc[r][1] = d1; s[r] = wave_sum(d0 * d0 + d1 * d1); }
    if (C.lane == 0) {
#pragma unroll
        for (int r = 0; r < R; ++r) red[C.wave * 16 + r] = s[r]; }
    __syncthreads();
    const f32x2 lg = *(const f32x2*)(inp(P, I_CLNG) + c), lb = *(const f32x2*)(inp(P, I_CLNB) + c);
    bf16* a2 = (bf16*)(P.ws + WS_A2);
#pragma unroll
    for (int r = 0; r < R; ++r) { float t = 0.f;
#pragma unroll
        for (int wv = 0; wv < 8; ++wv) t += red[wv * 16 + r];
        const float rstd = rsqrtf(t * (1.0f / 1024.0f) + 1e-5f);
        float y0 = acc[r][0] * rstd * lg[0] + lb[0], y1 = acc[r][1] * rstd * lg[1] + lb[1];
        y0 = y0 * sigm(y0); y1 = y1 * sigm(y1);
        *(unsigned*)(a2 + (size_t)(grow0 + r) * D + c) = pk2(y0, y1); }
    __syncthreads();
}

#define XS8(col_, xs_) do { const v4u cu_ = *(const v4u*)(curp + (col_)); const v4u pu_ = *(const v4u*)(prvp + (col_)); \
        const f32x4 m0_ = *(const f32x4*)(mup + (col_)), m1_ = *(const f32x4*)(mup + (col_) + 4); float c_, p_; \
        c_ = bflo(cu_.x); p_ = bflo(pu_.x); xs_[0] = c_ + (p_ - c_) * m0_[0]; c_ = bfhi(cu_.x); p_ = bfhi(pu_.x); xs_[1] = c_ + (p_ - c_) * m0_[1]; \
        c_ = bflo(cu_.y); p_ = bflo(pu_.y); xs_[2] = c_ + (p_ - c_) * m0_[2]; c_ = bfhi(cu_.y); p_ = bfhi(pu_.y); xs_[3] = c_ + (p_ - c_) * m0_[3]; \
        c_ = bflo(cu_.z); p_ = bflo(pu_.z); xs_[4] = c_ + (p_ - c_) * m1_[0]; c_ = bfhi(cu_.z); p_ = bfhi(pu_.z); xs_[5] = c_ + (p_ - c_) * m1_[1]; \
        c_ = bflo(cu_.w); p_ = bflo(pu_.w); xs_[6] = c_ + (p_ - c_) * m1_[2]; c_ = bfhi(cu_.w); p_ = bfhi(pu_.w); xs_[7] = c_ + (p_ - c_) * m1_[3]; } while (0)
#define XS4(col_, xs_) do { const v2u cu_ = *(const v2u*)(curp + (col_)); const v2u pu_ = *(const v2u*)(prvp + (col_)); const f32x4 m0_ = *(const f32x4*)(mup + (col_)); float c_, p_; \
        c_ = bflo(cu_.x); p_ = bflo(pu_.x); xs_[0] = c_ + (p_ - c_) * m0_[0]; c_ = bfhi(cu_.x); p_ = bfhi(pu_.x); xs_[1] = c_ + (p_ - c_) * m0_[1]; \
        c_ = bflo(cu_.y); p_ = bflo(pu_.y); xs_[2] = c_ + (p_ - c_) * m0_[2]; c_ = bfhi(cu_.y); p_ = bfhi(pu_.y); xs_[3] = c_ + (p_ - c_) * m0_[3]; } while (0)
__device__ __forceinline__ bf16x8 pack8(const float (&x)[8]) {
    v4u o; o.x = pk2(x[0], x[1]); o.y = pk2(x[2], x[3]); o.z = pk2(x[4], x[5]); o.w = pk2(x[6], x[7]);
    return __builtin_bit_cast(bf16x8, o);
}
__device__ __forceinline__ float tanh_fast(float x) { return 1.0f - 2.0f / (1.0f + __expf(2.0f * x)); }
__device__ __forceinline__ void prep_wave(const Params& P, int rowbase, int h, int lane) {
    const int fr = lane & 15, fq = lane >> 4, row = rowbase + fr;
    unsigned char* ws = P.ws;
    const bf16* curp = (const bf16*)(ws + WS_PR) + (size_t)row * NRCP;
    const bf16* prvp = curp - NRCP;
    if (row < MP) { if ((row & (SEQ - 1)) == 0) prvp = (const bf16*)(ws + WS_SHB) + (size_t)NBS * NRCP; }
    else { const int rs = row - MP; if ((rs & 7) == 0) prvp = (const bf16*)(ws + WS_SHB) + (size_t)(rs >> 3) * NRCP; }
    const float* mup = inp(P, I_MU); const float* pkk = inp(P, I_KK); const float* pa0 = inp(P, I_A0); const float* pw0 = inp(P, I_W0); const float* pka = inp(P, I_KA); const float* prk = inp(P, I_RK);
    const bf16* lw = (const bf16*)(ws + WS_LW); const bf16* la = (const bf16*)(ws + WS_LA); const bf16* lg = (const bf16*)(ws + WS_LG);
    const f32x4 z4 = (f32x4){0.f, 0.f, 0.f, 0.f};
    f32x4 accW[4] = {z4, z4, z4, z4}, accA[4] = {z4, z4, z4, z4}, accG[4] = {z4, z4, z4, z4};
    {   bf16x8 A[3];
#pragma unroll
        for (int s = 0; s < 3; ++s) { float xs[8]; XS8(3072 + 32 * s + 8 * fq, xs);
#pragma unroll
            for (int e = 0; e < 8; ++e) xs[e] = tanh_fast(xs[e]);
            A[s] = pack8(xs); }
#pragma unroll
        for (int nt = 0; nt < 4; ++nt)
#pragma unroll
            for (int s = 0; s < 3; ++s) { const bf16x8 b = *(const bf16x8*)(lw + (size_t)(h * 64 + 16 * nt + fr) * 96 + 32 * s + 8 * fq); accW[nt] = __builtin_amdgcn_mfma_f32_16x16x32_bf16(b, A[s], accW[nt], 0, 0, 0); }
    }
    {   bf16x8 A[3];
#pragma unroll
        for (int s = 0; s < 3; ++s) { float xs[8]; XS8(3168 + 32 * s + 8 * fq, xs); A[s] = pack8(xs); }
#pragma unroll
        for (int nt = 0; nt < 4; ++nt)
#pragma unroll
            for (int s = 0; s < 3; ++s) { const bf16x8 b = *(const bf16x8*)(la + (size_t)(h * 64 + 16 * nt + fr) * 96 + 32 * s + 8 * fq); accA[nt] = __builtin_amdgcn_mfma_f32_16x16x32_bf16(b, A[s], accA[nt], 0, 0, 0); }
    }
    {   bf16x8 A[8];
#pragma unroll
        for (int s = 0; s < 8; ++s) { float xs[8]; XS8(3264 + 32 * s + 8 * fq, xs);
#pragma unroll
            for (int e = 0; e < 8; ++e) xs[e] = sigm(xs[e]);
            A[s] = pack8(xs); }
#pragma unroll
        for (int nt = 0; nt < 4; ++nt)
#pragma unroll
            for (int s = 0; s < 8; ++s) { const bf16x8 b = *(const bf16x8*)(lg + (size_t)(h * 64 + 16 * nt + fr) * 256 + 32 * s + 8 * fq); accG[nt] = __builtin_amdgcn_mfma_f32_16x16x32_bf16(b, A[s], accG[nt], 0, 0, 0); }
    }
    float xk[4][4];
    float ss = 0.f;
#pragma unroll
    for (int nt = 0; nt < 4; ++nt) {
        const int c = h * 64 + 16 * nt + 4 * fq;
        XS4(1024 + c, xk[nt]);
        const f32x4 kkw = *(const f32x4*)(pkk + c);
#pragma unroll
        for (int e = 0; e < 4; ++e) { const float t = xk[nt][e] * kkw[e]; ss += t * t; }
    }
    ss += __shfl_xor(ss, 16); ss += __shfl_xor(ss, 32);
    const float inv = 1.0f / fmaxf(sqrtf(ss), 1e-12f);
    float bon = 0.f;
    float* SI = (float*)(ws + WS_SI); constexpr size_t SS = SI_STRIDE / 4;
#pragma unroll
    for (int nt = 0; nt < 4; ++nt) {
        const int c = h * 64 + 16 * nt + 4 * fq; const size_t o = (size_t)row * RW + c;
        float xr[4], xv[4];
        XS4(c, xr); XS4(2048 + c, xv);
        const f32x4 w0 = *(const f32x4*)(pw0 + c), ka = *(const f32x4*)(pka + c), rk = *(const f32x4*)(prk + c);
        const f32x4 kkw = *(const f32x4*)(pkk + c), a0 = *(const f32x4*)(pa0 + c);
        f32x4 vr, vw, vk, vv, va, vb;
#pragma unroll
        for (int e = 0; e < 4; ++e) {
            const float ee = 0.6065306597126334f * sigm(w0[e] + accW[nt][e]);
            vw[e] = __expf(-ee);
            const float a = sigm(a0[e] + accA[nt][e]);
            const float kn = xk[nt][e] * kkw[e] * inv;
            const float k2 = xk[nt][e] * (1.0f + (a - 1.0f) * ka[e]);
            vr[e] = xr[e]; vk[e] = k2; vv[e] = xv[e]; va[e] = -kn; vb[e] = kn * a;
            bon += xr[e] * k2 * rk[e];
        }
        *(f32x4*)(SI + 0 * SS + o) = vr; *(f32x4*)(SI + 1 * SS + o) = vw; *(f32x4*)(SI + 2 * SS + o) = vk;
        *(f32x4*)(SI + 3 * SS + o) = vv; *(f32x4*)(SI + 4 * SS + o) = va; *(f32x4*)(SI + 5 * SS + o) = vb;
        *(f32x4*)((float*)(ws + WS_G) + o) = accG[nt];
    }
    bon += __shfl_xor(bon, 16); bon += __shfl_xor(bon, 32);
    if (fq == 0) ((float*)(ws + WS_BON))[(size_t)row * RH + h] = bon;
}

constexpr int TC = 32, STEPF = 5 * 64 + 16;
__device__ __forceinline__ float red32(float v) {
    v += __shfl_xor(v, 1); v += __shfl_xor(v, 2); v += __shfl_xor(v, 4); v += __shfl_xor(v, 8); v += __shfl_xor(v, 16); return v;
}
__device__ __forceinline__ void scan_task(const Params& P, const Ctx& C, LAS unsigned char* lds, int m0, int T, int h, int rb, const float* s_in, float* s_out) {
    LAS float* buf = (LAS float*)lds;
    const float* SI = (const float*)(P.ws + WS_SI); constexpr size_t SS = SI_STRIDE / 4;
    float* Y = (float*)(P.ws + WS_Y);
    const int rl = C.lane >> 5, cl = C.lane & 31, irow = rb * 16 + C.wave * 2 + rl;
    float S0 = 0.f, S1 = 0.f;
    if (s_in) { const f32x2 t = *(const f32x2*)(s_in + (size_t)irow * 64 + 2 * cl); S0 = t[0]; S1 = t[1]; }
    constexpr int NPF = TC * STEPF / NT;
    static_assert(TC * STEPF % NT == 0, "chunk image divides over the threads");
    float pf[NPF];
#define SCAN_GLOAD(tc0_) do { _Pragma("unroll") for (int q = 0; q < NPF; ++q) { const int idx = C.tid + q * NT; const int t = idx / STEPF, o = idx - t * STEPF; \
        float v = 0.f; \
        if ((tc0_) + t < T) { const size_t rowo = (size_t)(m0 + (tc0_) + t) * RW + h * 64; \
            if (o < 320) { const int vec = o >> 6, j = o & 63; const int arr = vec == 0 ? 0 : vec == 1 ? 1 : vec == 2 ? 2 : vec == 3 ? 4 : 5; v = SI[arr * SS + rowo + j]; } \
            else v = SI[3 * SS + rowo + rb * 16 + (o - 320)]; } \
        pf[q] = v; } } while (0)
    const int nchunk = (T + TC - 1) / TC;
    SCAN_GLOAD(0);
    for (int ck = 0; ck < nchunk; ++ck) {
        LAS float* cb = buf + (ck & 1) * (TC * STEPF);
#pragma unroll
        for (int q = 0; q < NPF; ++q) cb[C.tid + q * NT] = pf[q];
        if (ck + 1 < nchunk) SCAN_GLOAD((ck + 1) * TC);
        __syncthreads();
        const int nst = (T - ck * TC) < TC ? (T - ck * TC) : TC;
        for (int t = 0; t < nst; ++t) {
            const LAS float* sb = cb + t * STEPF;
            const f32x2 r2 = *(const LAS f32x2*)(sb + 0 * 64 + 2 * cl), w2 = *(const LAS f32x2*)(sb + 1 * 64 + 2 * cl), k2 = *(const LAS f32x2*)(sb + 2 * 64 + 2 * cl);
            const f32x2 a2 = *(const LAS f32x2*)(sb + 3 * 64 + 2 * cl), b2 = *(const LAS f32x2*)(sb + 4 * 64 + 2 * cl);
            const float v = sb[320 + C.wave * 2 + rl];
            const float sa = red32(S0 * a2[0] + S1 * a2[1]);
            S0 = S0 * w2[0] + sa * b2[0] + v * k2[0];
            S1 = S1 * w2[1] + sa * b2[1] + v * k2[1];
            const float y = red32(S0 * r2[0] + S1 * r2[1]);
            if (cl == 0) Y[(size_t)(m0 + ck * TC + t) * RW + h * 64 + irow] = y;
        }
    }
    *(f32x2*)(s_out + (size_t)irow * 64 + 2 * cl) = (f32x2){S0, S1};
    __syncthreads();
}

__device__ __forceinline__ void post_row(const Params& P, int row, int lane) {
    const float* Y = (const float*)(P.ws + WS_Y) + (size_t)row * RW + 16 * lane;
    const float* V = (const float*)(P.ws + WS_SI) + 3 * (SI_STRIDE / 4) + (size_t)row * RW + 16 * lane;
    const float* G = (const float*)(P.ws + WS_G) + (size_t)row * RW + 16 * lane;
    const float bon = ((const float*)(P.ws + WS_BON))[(size_t)row * RH + (lane >> 2)];
    float y[16], s = 0.f;
#pragma unroll
    for (int q = 0; q < 4; ++q) { const f32x4 t = *(const f32x4*)(Y + 4 * q); y[4 * q] = t[0]; y[4 * q + 1] = t[1]; y[4 * q + 2] = t[2]; y[4 * q + 3] = t[3]; s += (t[0] + t[1]) + (t[2] + t[3]); }
    s += __shfl_xor(s, 1); s += __shfl_xor(s, 2);
    const float mu = s * (1.0f / 64.0f); float q2 = 0.f;
#pragma unroll
    for (int e = 0; e < 16; ++e) { y[e] -= mu; q2 += y[e] * y[e]; }
    q2 += __shfl_xor(q2, 1); q2 += __shfl_xor(q2, 2);
    const float rstd = rsqrtf(q2 * (1.0f / 64.0f) + 64e-5f);
    const float* lg = inp(P, I_LNXG) + 16 * lane; const float* lb = inp(P, I_LNXB) + 16 * lane;
    unsigned o[8];
#pragma unroll
    for (int q = 0; q < 4; ++q) { const f32x4 g4 = *(const f32x4*)(lg + 4 * q), b4 = *(const f32x4*)(lb + 4 * q), v4 = *(const f32x4*)(V + 4 * q), gg = *(const f32x4*)(G + 4 * q);
        float r[4];
#pragma unroll
        for (int e = 0; e < 4; ++e) r[e] = (y[4 * q + e] * rstd * g4[e] + b4[e] + bon * v4[e]) * gg[e];
        o[2 * q] = pk2(r[0], r[1]); o[2 * q + 1] = pk2(r[2], r[3]); }
    bf16* dst = (bf16*)(P.ws + WS_A2) + (size_t)row * D + 1024 + 16 * lane;
    *(v4u*)dst = (v4u){o[0], o[1], o[2], o[3]}; *(v4u*)(dst + 8) = (v4u){o[4], o[5], o[6], o[7]};
}

__device__ __forceinline__ void rowpass(const float* xa, const float* __restrict__ mix, const float* __restrict__ g1, float* xo,
                                        const float* __restrict__ g2, bf16* __restrict__ hb, int lane) {
    f32x4 mv[8]; float s = 0.f;
#pragma unroll
    for (int j = 0; j < 8; ++j) { mv[j] = *(const f32x4*)(mix + 4 * (lane + 64 * j)); s += (mv[j][0] * mv[j][0] + mv[j][1] * mv[j][1]) + (mv[j][2] * mv[j][2] + mv[j][3] * mv[j][3]); }
    const float r = rsqrtf(wave_sum(s) * (1.0f / 2048.0f) + 1e-6f);
    float s2 = 0.f;
#pragma unroll
    for (int j = 0; j < 8; ++j) { const f32x4 a = *(const f32x4*)(xa + 4 * (lane + 64 * j)), gg = *(const f32x4*)(g1 + 4 * (lane + 64 * j));
        mv[j] = a + mv[j] * r * gg; *(f32x4*)(xo + 4 * (lane + 64 * j)) = mv[j];
        s2 += (mv[j][0] * mv[j][0] + mv[j][1] * mv[j][1]) + (mv[j][2] * mv[j][2] + mv[j][3] * mv[j][3]); }
    if (hb) {
        const float r2 = rsqrtf(wave_sum(s2) * (1.0f / 2048.0f) + 1e-6f);
#pragma unroll
        for (int j = 0; j < 8; ++j) { const f32x4 gg = *(const f32x4*)(g2 + 4 * (lane + 64 * j));
            v2u o; o.x = pk2(mv[j][0] * r2 * gg[0], mv[j][1] * r2 * gg[1]); o.y = pk2(mv[j][2] * r2 * gg[2], mv[j][3] * r2 * gg[3]);
            *(v2u*)(hb + 4 * (lane + 64 * j)) = o; }
    }
}
__device__ __forceinline__ void attn_prompt_task(const Params& P, const Ctx& C, LAS unsigned char* lds, int b, int h, int qt) {
    const bf16* Qg = (const bf16*)(P.ws + WS_Q); const bf16* Kg = (const bf16*)(P.ws + WS_KB); const bf16* VTg = (const bf16*)(P.ws + WS_VT);
    bf16* Og = (bf16*)(P.ws + WS_O);
    const int fr = C.lane & 15, fq = C.lane >> 4;
    const int qrow = b * SEQ + qt * 128 + C.wave * 16 + fr;
    constexpr int BUFB = 33792;
    bf16x8 Qf[16];
#pragma unroll
    for (int s = 0; s < 16; ++s) Qf[s] = *(const bf16x8*)(Qg + (size_t)qrow * D + h * XD + 32 * s + 8 * fq);
    f32x4 accS[16];
#pragma unroll
    for (int nt = 0; nt < 16; ++nt) accS[nt] = (f32x4){0.f, 0.f, 0.f, 0.f};
    v4u stg[4];
#define ATT_GLOAD(c_) do { if ((c_) < 8) { _Pragma("unroll") for (int i = 0; i < 4; ++i) { const int idx = C.tid + i * NT, key = idx >> 3, ch = idx & 7; \
            stg[i] = *(const v4u*)(Kg + (size_t)(b * NMEM + key) * D + h * XD + (c_) * 64 + ch * 8); } } \
        else { _Pragma("unroll") for (int i = 0; i < 4; ++i) { const int idx = C.tid + i * NT, dd = idx >> 5, ch = idx & 31; \
            stg[i] = *(const v4u*)(VTg + ((size_t)((b * XH + h) * XD + ((c_) - 8) * 64 + dd)) * NMEM + ch * 8); } } } while (0)
#define ATT_SWRITE(c_) do { LAS unsigned char* sbuf = lds + ((c_) & 1) * BUFB; if ((c_) < 8) { _Pragma("unroll") for (int i = 0; i < 4; ++i) { const int idx = C.tid + i * NT, key = idx >> 3, ch = idx & 7; \
            *(LAS v4u*)(sbuf + key * 128 + ((ch ^ (key & 7)) * 16)) = stg[i]; } } \
        else { _Pragma("unroll") for (int i = 0; i < 4; ++i) { const int idx = C.tid + i * NT, dd = idx >> 5, ch = idx & 31; \
            *(LAS v4u*)(sbuf + dd * 528 + ch * 16) = stg[i]; } } } while (0)
    ATT_GLOAD(0); ATT_SWRITE(0); __syncthreads();
    bf16x8 Pf[8];
#pragma unroll
    for (int c = 0; c < 8; ++c) {
        ATT_GLOAD(c + 1);
        const LAS unsigned char* sbuf = lds + (c & 1) * BUFB;
#pragma unroll
        for (int ss = 0; ss < 2; ++ss)
#pragma unroll
            for (int nt = 0; nt < 16; ++nt) {
                const int key = 16 * nt + fr, ch = ss * 4 + fq;
                const bf16x8 kf = *(const LAS bf16x8*)(sbuf + key * 128 + ((ch ^ (key & 7)) * 16));
                accS[nt] = __builtin_amdgcn_mfma_f32_16x16x32_bf16(kf, Qf[2 * c + ss], accS[nt], 0, 0, 0);
            }
        if (c == 7) {
            float mx = -3.0e38f;
#pragma unroll
            for (int nt = 0; nt < 16; ++nt) mx = fmaxf(mx, fmaxf(fmaxf(accS[nt][0], accS[nt][1]), fmaxf(accS[nt][2], accS[nt][3])));
            mx = fmaxf(mx, __shfl_xor(mx, 16)); mx = fmaxf(mx, __shfl_xor(mx, 32));
            float sum = 0.f;
#pragma unroll
            for (int nt = 0; nt < 16; ++nt) {
#pragma unroll
                for (int e = 0; e < 4; ++e) { const float p = exp2f(accS[nt][e] - mx); accS[nt][e] = p; sum += p; } }
            sum += __shfl_xor(sum, 16); sum += __shfl_xor(sum, 32);
            const float inv = 1.0f / sum;
#pragma unroll
            for (int s = 0; s < 8; ++s) { v4u o; o.x = pk2(accS[2 * s][0] * inv, accS[2 * s][1] * inv); o.y = pk2(accS[2 * s][2] * inv, accS[2 * s][3] * inv);
                o.z = pk2(accS[2 * s + 1][0] * inv, accS[2 * s + 1][1] * inv); o.w = pk2(accS[2 * s + 1][2] * inv, accS[2 * s + 1][3] * inv); Pf[s] = __builtin_bit_cast(bf16x8, o); }
        }
        ATT_SWRITE(c + 1);
        __syncthreads();
    }
    for (int c = 8; c < 16; ++c) {
        if (c + 1 < 16) ATT_GLOAD(c + 1);
        const LAS unsigned char* sbuf = lds + (c & 1) * BUFB;
        const int dv = c - 8;
        f32x4 accO[4];
#pragma unroll
        for (int nd = 0; nd < 4; ++nd) accO[nd] = (f32x4){0.f, 0.f, 0.f, 0.f};
#pragma unroll
        for (int s = 0; s < 8; ++s)
#pragma unroll
            for (int nd = 0; nd < 4; ++nd) {
                const LAS unsigned char* rp = sbuf + (nd * 16 + fr) * 528 + (32 * s + 4 * fq) * 2;
                const v2u lo = *(const LAS v2u*)rp, hi = *(const LAS v2u*)(rp + 32);
                const bf16x8 vf = __builtin_bit_cast(bf16x8, ((v4u){lo.x, lo.y, hi.x, hi.y}));
                accO[nd] = __builtin_amdgcn_mfma_f32_16x16x32_bf16(vf, Pf[s], accO[nd], 0, 0, 0);
            }
#pragma unroll
        for (int nd = 0; nd < 4; ++nd) { v2u o; o.x = pk2(accO[nd][0], accO[nd][1]); o.y = pk2(accO[nd][2], accO[nd][3]);
            *(v2u*)(Og + (size_t)qrow * D + h * XD + dv * 64 + nd * 16 + 4 * fq) = o; }
        if (c + 1 < 16) ATT_SWRITE(c + 1);
        __syncthreads();
    }
#undef ATT_GLOAD
#undef ATT_SWRITE
}
__device__ __forceinline__ void attn_sample_task(const Params& P, const Ctx& C, LAS unsigned char* lds, int b, int h) {
    const bf16* Qg = (const bf16*)(P.ws + WS_Q); bf16* Og = (bf16*)(P.ws + WS_O);
    const float* CK = inp(P, I_CK); const float* CV = inp(P, I_CV);
    LAS float* sS = (LAS float*)lds;
    LAS float* sP = (LAS float*)(lds + 8192);
    const int row0 = MP + 8 * b;
    float qv[8][8];
#pragma unroll
    for (int q = 0; q < 8; ++q) { const bf16* qp = Qg + (size_t)(row0 + q) * D + h * XD;
        const v2u a = *(const v2u*)(qp + 4 * C.lane), c2 = *(const v2u*)(qp + 256 + 4 * C.lane);
        qv[q][0] = bflo(a.x); qv[q][1] = bfhi(a.x); qv[q][2] = bflo(a.y); qv[q][3] = bfhi(a.y); qv[q][4] = bflo(c2.x); qv[q][5] = bfhi(c2.x); qv[q][6] = bflo(c2.y); qv[q][7] = bfhi(c2.y); }
    for (int k0 = 0; k0 < 32; k0 += 4) {
        f32x4 ka[4], kb2[4];
#pragma unroll
        for (int u = 0; u < 4; ++u) { const float* kp = CK + ((size_t)(b * NMEM + C.wave * 32 + k0 + u) * XH + h) * XD; ka[u] = *(const f32x4*)(kp + 4 * C.lane); kb2[u] = *(const f32x4*)(kp + 256 + 4 * C.lane); }
#pragma unroll
        for (int u = 0; u < 4; ++u) {
            float part[8];
#pragma unroll
            for (int q = 0; q < 8; ++q) part[q] = (qv[q][0] * ka[u][0] + qv[q][1] * ka[u][1]) + (qv[q][2] * ka[u][2] + qv[q][3] * ka[u][3]) + (qv[q][4] * kb2[u][0] + qv[q][5] * kb2[u][1]) + (qv[q][6] * kb2[u][2] + qv[q][7] * kb2[u][3]);
#pragma unroll
            for (int q = 0; q < 8; ++q) part[q] = wave_sum(part[q]);
            if (C.lane == 0) {
#pragma unroll
                for (int q = 0; q < 8; ++q) sS[q * 256 + C.wave * 32 + k0 + u] = part[q]; }
        }
    }
    __syncthreads();
    {
        const int q = C.wave; const f32x4 s4 = *(const LAS f32x4*)(sS + q * 256 + 4 * C.lane);
        const float mx = wave_max(fmaxf(fmaxf(s4[0], s4[1]), fmaxf(s4[2], s4[3])));
        const float p0 = exp2f(s4[0] - mx), p1 = exp2f(s4[1] - mx), p2 = exp2f(s4[2] - mx), p3 = exp2f(s4[3] - mx);
        const float inv = 1.0f / wave_sum((p0 + p1) + (p2 + p3));
        sP[(4 * C.lane + 0) * 8 + q] = p0 * inv; sP[(4 * C.lane + 1) * 8 + q] = p1 * inv; sP[(4 * C.lane + 2) * 8 + q] = p2 * inv; sP[(4 * C.lane + 3) * 8 + q] = p3 * inv;
    }
    __syncthreads();
    float acc[8];
#pragma unroll
    for (int q = 0; q < 8; ++q) acc[q] = 0.f;
    const int d = C.wave * 64 + C.lane;
    for (int k0 = 0; k0 < 256; k0 += 8) {
        float vv[8];
#pragma unroll
        for (int u = 0; u < 8; ++u) vv[u] = CV[((size_t)(b * NMEM + k0 + u) * XH + h) * XD + d];
#pragma unroll
        for (int u = 0; u < 8; ++u) { const f32x4 pa = *(const LAS f32x4*)(sP + (k0 + u) * 8), pb = *(const LAS f32x4*)(sP + (k0 + u) * 8 + 4);
            acc[0] += pa[0] * vv[u]; acc[1] += pa[1] * vv[u]; acc[2] += pa[2] * vv[u]; acc[3] += pa[3] * vv[u];
            acc[4] += pb[0] * vv[u]; acc[5] += pb[1] * vv[u]; acc[6] += pb[2] * vv[u]; acc[7] += pb[3] * vv[u]; }
    }
#pragma unroll
    for (int q = 0; q < 8; ++q) Og[(size_t)(row0 + q) * D + h * XD + d] = (bf16)f2bf(acc[q]);
    __syncthreads();
}

__device__ __forceinline__ void ffn_conv_act(const Params& P, const Ctx& C) {
    const bf16* UP = (const bf16*)(P.ws + WS_UP); bf16* ACT = (bf16*)(P.ws + WS_ACT);
    const float* FW = inp(P, I_FDW); const float* FB = inp(P, I_FDWB); const float* SF = inp(P, I_SFFN);
    constexpr int NG = DFF / 8;
    const long total = (long)M * NG;
    for (long it = (long)C.bid * NT + C.tid; it < total; it += (long)C.G * NT) {
        const int row = (int)(it / NG), cg8 = (int)(it - (long)row * NG) * 8;
        int t, sb = -1; if (row < MP) t = row & (SEQ - 1); else { const int rs = row - MP; t = rs & 7; sb = rs >> 3; }
        float res[2][8];
#pragma unroll
        for (int half = 0; half < 2; ++half) {
            const int c = half * DFF + cg8;
            float x[3][8];
#pragma unroll
            for (int j = 0; j < 3; ++j) {
                const int tt = t - 2 + j;
                if (tt >= 0) { const v4u u = *(const v4u*)(UP + (size_t)(row - 2 + j) * DFF2 + c);
                    x[j][0] = bflo(u.x); x[j][1] = bfhi(u.x); x[j][2] = bflo(u.y); x[j][3] = bfhi(u.y); x[j][4] = bflo(u.z); x[j][5] = bfhi(u.z); x[j][6] = bflo(u.w); x[j][7] = bfhi(u.w); }
                else if (sb >= 0) { const float* s = SF + ((size_t)sb * 2 + (tt + 2)) * DFF2 + c; const f32x4 a = *(const f32x4*)s, b2 = *(const f32x4*)(s + 4);
                    x[j][0] = a[0]; x[j][1] = a[1]; x[j][2] = a[2]; x[j][3] = a[3]; x[j][4] = b2[0]; x[j][5] = b2[1]; x[j][6] = b2[2]; x[j][7] = b2[3]; }
                else {
#pragma unroll
                    for (int e = 0; e < 8; ++e) x[j][e] = 0.f; }
            }
#pragma unroll
            for (int e = 0; e < 8; ++e) res[half][e] = FB[c + e] + FW[c + e] * x[0][e] + FW[DFF2 + c + e] * x[1][e] + FW[2 * DFF2 + c + e] * x[2][e];
        }
        v4u o;
        float a[8];
#pragma unroll
        for (int e = 0; e < 8; ++e) a[e] = res[0][e] * sigm(res[0][e]) * res[1][e];
        o.x = pk2(a[0], a[1]); o.y = pk2(a[2], a[3]); o.z = pk2(a[4], a[5]); o.w = pk2(a[6], a[7]);
        *(v4u*)(ACT + (size_t)row * DFF + cg8) = o;
    }
}

template <bool COOP>
__global__ void __launch_bounds__(NT, 2) mega(Params P) {
    extern __shared__ __attribute__((aligned(16))) unsigned char lds_raw[];
    LAS unsigned char* lds = (LAS unsigned char*)lds_raw;
    Ctx C; C.tid = threadIdx.x; C.lane = C.tid & 63; C.wave = __builtin_amdgcn_readfirstlane(C.tid >> 6); C.bid = blockIdx.x; C.G = gridDim.x;
    C.gw = C.bid * 8 + C.wave; C.NGW = C.G * 8;
    unsigned char* ws = P.ws;
    const int lo = P.ph_lo, hi = P.ph_hi;
#ifndef MK_ONLY
#define MK_ONLY -1
#endif
#define IN(k) ((MK_ONLY < 0 || MK_ONLY == (k)) && lo <= (k) && (k) < hi)
#define SEAM(k) do { if constexpr (COOP) { if (IN(k) && IN((k) + 1)) cg::this_grid().sync(); } } while (0)

    if (IN(0)) { p0_prologue(P, C, lds); __syncthreads(); }
    SEAM(0);
    if (IN(1)) {
        { pg8::Gemm g{(const pg8::bf16_t*)(ws + WS_HB), (const pg8::bf16_t*)(ws + WS_WIN), M, NINP, D}; pg8::StaticOrder S; S.init(M, NINP, C.G, C.bid);
          pg8::EpiIn E{(pg8::bf16_t*)(ws + WS_GLU), (pg8::bf16_t*)(ws + WS_PR), P.out + O_CP, P.out + O_CS, P.out + O_SP, P.out + O_SS};
          pg8::gemm_phase<pg8::EpiIn, pg8::StaticOrder, PG8_ALIGN, PG8_SP2>(lds, g, S, E); }
        { pg8::Gemm g{(const pg8::bf16_t*)(ws + WS_MB), (const pg8::bf16_t*)(ws + WS_WKV), 1024, 4096, D}; pg8::StaticOrder S; S.init(1024, 4096, C.G, (C.bid + C.G - 24) % C.G);
          pg8::EpiKV E{P.out + O_MK, P.out + O_MV, (pg8::bf16_t*)(ws + WS_KB), (pg8::bf16_t*)(ws + WS_VT)};
          pg8::gemm_phase<pg8::EpiKV, pg8::StaticOrder, PG8_ALIGN, PG8_SP2>(lds, g, S, E); }
    }
    SEAM(1);
    if (IN(2)) {
        for (int tk = C.bid; tk < 640; tk += C.G) {
            if (tk < 512) { const int b = tk >> 7, r0 = (tk & 127) * 16; conv_task<16>(P, C, lds, b * SEQ + r0, r0, -1); }
            else { const int sb = tk - 512; conv_task<8>(P, C, lds, MP + 8 * sb, 0, sb); }
        }
        for (int tk = C.bid; tk < 1152; tk += C.G) { const int rg = tk >> 2, hg = tk & 3; prep_wave(P, rg * 32 + (C.wave >> 2) * 16, hg * 4 + (C.wave & 3), C.lane); }
    }
    SEAM(2);
    if (IN(3)) {
        const float* swkv = inp(P, I_SWKV);
        for (int tk = C.bid; tk < 256; tk += C.G) { const int chain = tk >> 2, rb = tk & 3, b = chain >> 4, h = chain & 15;
            scan_task(P, C, lds, b * SEQ, SEQ, h, rb, nullptr, P.out + O_WP + (size_t)chain * 4096); }
        for (int tk = C.bid; tk < 8192; tk += C.G) { const int chain = tk >> 2, rb = tk & 3, b = chain >> 4, h = chain & 15;
            scan_task(P, C, lds, MP + 8 * b, 8, h, rb, swkv + (size_t)chain * 4096, P.out + O_WS + (size_t)chain * 4096); }
    }
    SEAM(3);
    if (IN(4)) { for (int m = C.gw; m < M; m += C.NGW) post_row(P, m, C.lane); }
    SEAM(4);
    if (IN(5)) { pg8::Gemm g{(const pg8::bf16_t*)(ws + WS_A2), (const pg8::bf16_t*)(ws + WS_WOUT), M, D, D}; pg8::StaticOrder S; S.init(M, D, C.G, C.bid);
        pg8::EpiF32 E{(float*)(ws + WS_MIX), D}; pg8::gemm_phase<pg8::EpiF32, pg8::StaticOrder, PG8_ALIGN, PG8_SP2>(lds, g, S, E); }
    SEAM(5);
    if (IN(6)) { const float* xp = inp(P, I_XP); const float* xs = inp(P, I_XS); const float* g1 = inp(P, I_NMIXPOST); const float* g2 = inp(P, I_NXAPRE);
        for (int m = C.gw; m < M; m += C.NGW) { const float* xr = m < MP ? xp + (size_t)m * D : xs + (size_t)(m - MP) * D;
        rowpass(xr, (const float*)(ws + WS_MIX) + (size_t)m * D, g1, (float*)(ws + WS_X1) + (size_t)m * D, g2, (bf16*)(ws + WS_HB) + (size_t)m * D, C.lane); } }
    SEAM(6);
    if (IN(7)) { pg8::Gemm g{(const pg8::bf16_t*)(ws + WS_HB), (const pg8::bf16_t*)(ws + WS_WQ), M, D, D}; pg8::StaticOrder S; S.init(M, D, C.G, C.bid);
        pg8::EpiBf16S E{(pg8::bf16_t*)(ws + WS_Q), D, 0.06375871479f  , nullptr};
        pg8::gemm_phase<pg8::EpiBf16S, pg8::StaticOrder, PG8_ALIGN, PG8_SP2>(lds, g, S, E); }
    SEAM(7);
    if (IN(8)) {
        for (int tk = C.bid; tk < 256; tk += C.G) attn_prompt_task(P, C, lds, tk >> 6, (tk >> 4) & 3, tk & 15);
        for (int tk = C.bid; tk < 512; tk += C.G) attn_sample_task(P, C, lds, tk >> 2, tk & 3);
    }
    SEAM(8);
    if (IN(9)) { pg8::Gemm g{(const pg8::bf16_t*)(ws + WS_O), (const pg8::bf16_t*)(ws + WS_WO), M, D, D}; pg8::StaticOrder S; S.init(M, D, C.G, C.bid);
        pg8::EpiF32 E{(float*)(ws + WS_MIX), D}; pg8::gemm_phase<pg8::EpiF32, pg8::StaticOrder, PG8_ALIGN, PG8_SP2>(lds, g, S, E); }
    SEAM(9);
    if (IN(10)) { const float* g1 = inp(P, I_NXAPOST); const float* g2 = inp(P, I_NFFNPRE);
        for (int m = C.gw; m < M; m += C.NGW) { float* x1 = (float*)(ws + WS_X1) + (size_t)m * D;
        rowpass(x1, (const float*)(ws + WS_MIX) + (size_t)m * D, g1, x1, g2, (bf16*)(ws + WS_HB) + (size_t)m * D, C.lane); } }
    SEAM(10);
    if (IN(11)) { pg8::Gemm g{(const pg8::bf16_t*)(ws + WS_HB), (const pg8::bf16_t*)(ws + WS_WUP), M, DFF2, D}; pg8::StaticOrder S; S.init(M, DFF2, C.G, C.bid);
        pg8::EpiBf16S E{(pg8::bf16_t*)(ws + WS_UP), DFF2, 1.0f, P.out + O_FP};
        pg8::gemm_phase<pg8::EpiBf16S, pg8::StaticOrder, PG8_ALIGN, PG8_SP2>(lds, g, S, E); }
    SEAM(11);
    if (IN(12)) ffn_conv_act(P, C);
    SEAM(12);
    if (IN(13)) { pg8::Gemm g{(const pg8::bf16_t*)(ws + WS_ACT), (const pg8::bf16_t*)(ws + WS_WDN), M, D, DFF}; pg8::StaticOrder S; S.init(M, D, C.G, C.bid);
        pg8::EpiF32 E{(float*)(ws + WS_MIX), D}; pg8::gemm_phase<pg8::EpiF32, pg8::StaticOrder, PG8_ALIGN, PG8_SP2>(lds, g, S, E); }
    SEAM(13);
    if (IN(14)) { const float* g1 = inp(P, I_NFFNPOST);
        for (int m = C.gw; m < M; m += C.NGW) { const float* x2 = (const float*)(ws + WS_X1) + (size_t)m * D;
        float* yo = m < MP ? P.out + O_YP + (size_t)m * D : P.out + O_YS + (size_t)(m - MP) * D;
        rowpass(x2, (const float*)(ws + WS_MIX) + (size_t)m * D, g1, yo, nullptr, nullptr, C.lane); } }
#undef IN
#undef SEAM
}

#ifndef MK_ONE_LAUNCH
#define MK_ONE_LAUNCH 1
#endif
extern "C" void kernel_launch(void* const* d_in, const int* in_sizes, int n_in, void* d_out, int out_size, void* d_ws, size_t ws_size, hipStream_t stream) {
    static int grid = 0;
    if (grid == 0) {
        if (n_in != N_IN || (size_t)out_size != O_END || ws_size < WS_END) { fprintf(stderr, "kernel_launch: unexpected sizes: n_in %d out %d ws %zu (need %zu)\n", n_in, out_size, ws_size, (size_t)WS_END); grid = -1; return; }
        int dev = 0, cus = 0, per_cu = 0;
        (void)hipGetDevice(&dev); (void)hipDeviceGetAttribute(&cus, hipDeviceAttributeMultiprocessorCount, dev);
        (void)hipFuncSetAttribute((const void*)mega<(MK_ONE_LAUNCH != 0)>, hipFuncAttributeMaxDynamicSharedMemorySize, LDS_BYTES);
        (void)hipOccupancyMaxActiveBlocksPerMultiprocessor(&per_cu, (const void*)mega<(MK_ONE_LAUNCH != 0)>, NT, LDS_BYTES);
        fprintf(stderr, "kernel_launch: cus %d, occupancy query %d block(s)/CU, ws %zu MiB\n", cus, per_cu, ws_size >> 20);
        (void)hipGetLastError();
        grid = cus;
        if (per_cu < 1) { fprintf(stderr, "kernel_launch: occupancy query says 0 blocks per CU\n"); }
    }
    if (grid < 0) return;
    Params p{};
    for (int i = 0; i < N_IN; ++i) p.in[i] = (const float*)d_in[i];
    p.out = (float*)d_out; p.ws = (unsigned char*)d_ws;
#if MK_ONE_LAUNCH
    p.ph_lo = 0; p.ph_hi = NPHASE;
    void* args[] = {&p};
    hipError_t e = hipLaunchCooperativeKernel((const void*)mega<true>, dim3(grid), dim3(NT), args, LDS_BYTES, stream);
    if (e != hipSuccess) fprintf(stderr, "cooperative launch failed: %s (grid %d)\n", hipGetErrorString(e), grid);
#else
    for (int ph = 0; ph < NPHASE; ++ph) { p.ph_lo = ph; p.ph_hi = ph + 1; hipLaunchKernelGGL((mega<false>), dim3(grid), dim3(NT), LDS_BYTES, stream, p); }
#endif
}
```

```cpp
#include <hip/hip_runtime.h>
#include <hip/hip_cooperative_groups.h>
#include <cstdio>
#include <cstdint>
namespace cg = cooperative_groups;
constexpr int D = 2048, MP = 8192, MS = 1024, M = MP + MS, SEQ = 2048, TS = 8, NBP = 4, NBS = 128;
constexpr int CC = 1024, CW = 31, RW = 1024, RH = 16, HD = 64;
constexpr int NRC = 3520, NRCP = 3584, NINP = 5632;
constexpr int NMEM = 256, XH = 4, XD = 512, DFF = 5632, DFF2 = 11264;
namespace pg8 {
#define PG8_LAS __attribute__((address_space(3)))
typedef unsigned short bf16_t;
typedef short bf16x8 __attribute__((ext_vector_type(8)));
typedef float f32x4 __attribute__((ext_vector_type(4)));
typedef unsigned u32x4 __attribute__((ext_vector_type(4)));
constexpr int BM = 256, BK = 64, HALF = 128, HTB = HALF * BK * 2  , STAGE_BYTES = 8 * HTB, NXCD = 8, WGM = 8;

__host__ __device__ __forceinline__ int lds_byte(int r, int c) { const int st = (r >> 4) * 2 + (c >> 5), rr = r & 15, cc = c & 31, ob = rr * 64 + cc * 2; return st * 1024 + (ob ^ (((ob >> 9) & 1) << 5)); }
__host__ __device__ __forceinline__ void stage_rc(int b, int& R, int& C) { const int st = b / 1024, sb = b % 1024, swz = sb ^ (((sb >> 9) & 1) << 5); R = (st >> 1) * 16 + swz / 64; C = (st & 1) * 32 + (swz % 64) / 2; }
__host__ __device__ __forceinline__ int perm32(int rho) { const int n = rho >> 4, i = rho & 15; return 8 * (i >> 2) + 4 * n + (i & 3); }

struct Unit { int pm, pn; };
struct Gemm { const bf16_t* A; const bf16_t* Bt; int M, N, K; };

struct StaticOrder {
    int nM, nN, nwg, G, c;
    __host__ __device__ void init(int M, int N, int G_, int c_) { nM = M / BM; nN = N / BM; nwg = nM * nN; G = G_; c = c_; }
    __host__ __device__ bool next(int i, Unit& u) const {
        const long L = (long)i * G + c; if (L >= nwg) return false;
        int wgid = (int)L; { const int q = nwg / NXCD, r = nwg % NXCD, xcd = wgid % NXCD, off = wgid / NXCD; wgid = (xcd < r ? xcd * (q + 1) : r * (q + 1) + (xcd - r) * q) + off; }
        const int nig = WGM * nN, gid = wgid / nig, fm = gid * WGM, gsz = (nM - fm) < WGM ? (nM - fm) : WGM;
        u.pm = fm + ((wgid % nig) % gsz); u.pn = (wgid % nig) / gsz; return true;
    }
    __device__ __forceinline__ void a_ready(const Unit&) const {}
    __device__ __forceinline__ void done(const Unit&) const {}
};

__device__ __forceinline__ unsigned cvt_pk_bf16(float lo, float hi) { unsigned r; asm volatile("v_cvt_pk_bf16_f32 %0, %1, %2" : "=v"(r) : "v"(lo), "v"(hi)); return r; }
typedef float f32x2 __attribute__((ext_vector_type(2)));
typedef unsigned u32x2 __attribute__((ext_vector_type(2)));
struct EpiIn {
    static constexpr bool PERM = true, AFTER_DRAIN = false;
    bf16_t* glu; bf16_t* pr; float* oconv_p; float* oconv_s; float* oshift_p; float* oshift_s;
    __device__ __forceinline__ void operator()(const f32x4 (&acc)[2][2][4][2], const Unit& u, int wr, int wc, int fr, int fq) const {
        const int row0 = u.pm * BM + wr * 64 + fr;
        if (u.pn < 8) {
#pragma unroll
            for (int ai = 0; ai < 2; ++ai)
#pragma unroll
                for (int m = 0; m < 4; ++m) {
                    const int row = row0 + ai * HALF + m * 16;
                    float* cdst = nullptr;
                    if (row < MP) { const int t = row & (SEQ - 1); if (t >= SEQ - 30) cdst = oconv_p + (size_t)((row >> 11) * 30 + (t - (SEQ - 30))) * CC; }
                    else { const int rs = row - MP; cdst = oconv_s + (size_t)((rs >> 3) * 30 + 22 + (rs & 7)) * CC; }
#pragma unroll
                    for (int bj = 0; bj < 2; ++bj) {
                        const int cgl = 16 * (8 * u.pn + 4 * bj + wc) + 4 * fq;
                        const f32x4 a = acc[ai][bj][m][0], g = acc[ai][bj][m][1];
                        f32x4 v;
#pragma unroll
                        for (int e = 0; e < 4; ++e) v[e] = a[e] / (1.0f + __expf(-g[e]));
                        u32x2 w; w.x = cvt_pk_bf16(v[0], v[1]); w.y = cvt_pk_bf16(v[2], v[3]);
                        *(u32x2*)(glu + (size_t)row * CC + cgl) = w;
                        if (cdst) *(f32x4*)(cdst + cgl) = v;
                    }
                }
        } else {
#pragma unroll
            for (int ai = 0; ai < 2; ++ai)
#pragma unroll
                for (int m = 0; m < 4; ++m) {
                    const int row = row0 + ai * HALF + m * 16;
                    float* sdst = nullptr;
                    if (row < MP) { if ((row & (SEQ - 1)) == SEQ - 1) sdst = oshift_p + (size_t)(row >> 11) * NRC; }
                    else { const int rs = row - MP; if ((rs & 7) == 7) sdst = oshift_s + (size_t)(rs >> 3) * NRC; }
#pragma unroll
                    for (int bj = 0; bj < 2; ++bj) {
                        const int jj0 = 256 * (u.pn - 8) + 128 * bj + 32 * wc + 8 * fq;
                        const f32x4 v0 = acc[ai][bj][m][0], v1 = acc[ai][bj][m][1];
                        u32x4 w; w.x = cvt_pk_bf16(v0[0], v0[1]); w.y = cvt_pk_bf16(v0[2], v0[3]); w.z = cvt_pk_bf16(v1[0], v1[1]); w.w = cvt_pk_bf16(v1[2], v1[3]);
                        *(u32x4*)(pr + (size_t)row * NRCP + jj0) = w;
                        if (sdst && jj0 < NRC) { *(f32x4*)(sdst + jj0) = v0; *(f32x4*)(sdst + jj0 + 4) = v1; }
                    }
                }
        }
    }
};
struct EpiKV {
    static constexpr bool PERM = false, AFTER_DRAIN = false;
    float* ok; float* ov; bf16_t* kb; bf16_t* vt;
    __device__ __forceinline__ void operator()(const f32x4 (&acc)[2][2][4][2], const Unit& u, int wr, int wc, int fr, int fq) const {
        const int row0 = u.pm * BM + wr * 64 + fr;
#pragma unroll
        for (int ai = 0; ai < 2; ++ai)
#pragma unroll
            for (int m = 0; m < 4; ++m) {
                const int r = row0 + ai * HALF + m * 16;
#pragma unroll
                for (int bj = 0; bj < 2; ++bj)
#pragma unroll
                    for (int n = 0; n < 2; ++n) {
                        const int c = 256 * u.pn + 128 * bj + 32 * wc + 16 * n + 4 * fq;
                        const f32x4 v = acc[ai][bj][m][n];
                        if (u.pn < 8) {
                            *(f32x4*)(ok + (size_t)r * 2048 + c) = v;
                            u32x2 w; w.x = cvt_pk_bf16(v[0], v[1]); w.y = cvt_pk_bf16(v[2], v[3]);
                            *(u32x2*)(kb + (size_t)r * 2048 + c) = w;
                        } else {
                            const int cv = c - 2048;
                            *(f32x4*)(ov + (size_t)r * 2048 + cv) = v;
                            const int b = r >> 8, key = r & 255, h = cv >> 9, d = cv & 511;
                            bf16_t* dst = vt + ((size_t)((b * 4 + h) * 512 + d)) * 256 + key;
                            const unsigned w0 = cvt_pk_bf16(v[0], v[1]), w1 = cvt_pk_bf16(v[2], v[3]);
                            dst[0] = (bf16_t)(w0 & 0xffffu); dst[256] = (bf16_t)(w0 >> 16); dst[512] = (bf16_t)(w1 & 0xffffu); dst[768] = (bf16_t)(w1 >> 16);
                        }
                    }
            }
    }
};
struct EpiF32 {
    static constexpr bool PERM = false, AFTER_DRAIN = false;
    float* C; int ldc;
    __device__ __forceinline__ void operator()(const f32x4 (&acc)[2][2][4][2], const Unit& u, int wr, int wc, int fr, int fq) const {
        const int row0 = u.pm * BM + wr * 64 + fr, col0 = u.pn * BM + wc * 32 + 4 * fq;
#pragma unroll
        for (int ai = 0; ai < 2; ++ai)
#pragma unroll
            for (int m = 0; m < 4; ++m) { float* rowp = C + (size_t)(row0 + ai * HALF + m * 16) * ldc + col0;
#pragma unroll
                for (int bj = 0; bj < 2; ++bj)
#pragma unroll
                    for (int n = 0; n < 2; ++n) *(f32x4*)(rowp + bj * HALF + n * 16) = acc[ai][bj][m][n]; }
    }
};
struct EpiBf16S {
    static constexpr bool PERM = true, AFTER_DRAIN = false;
    bf16_t* O; int ldc; float scale; float* f;
    __device__ __forceinline__ void operator()(const f32x4 (&acc)[2][2][4][2], const Unit& u, int wr, int wc, int fr, int fq) const {
        const int row0 = u.pm * BM + wr * 64 + fr, col0 = u.pn * BM + wc * 32 + 8 * fq;
#pragma unroll
        for (int ai = 0; ai < 2; ++ai)
#pragma unroll
            for (int m = 0; m < 4; ++m) {
                const int row = row0 + ai * HALF + m * 16;
                long foff = -1;
                if (f) {
                    if (row < MP) { const int t = row & (SEQ - 1); if (t >= SEQ - 2) foff = (long)((row >> 11) * 2 + (t - (SEQ - 2))) * DFF2; }
                    else { const int rs = row - MP, t = rs & 7; if (t >= 6) foff = (long)(NBP * 2 + (rs >> 3) * 2 + (t - 6)) * DFF2; }
                }
                float* fdst = f + (foff < 0 ? 0 : foff);
                bf16_t* rowp = O + (size_t)row * ldc + col0;
#pragma unroll
                for (int bj = 0; bj < 2; ++bj) {
                    const f32x4 v0 = acc[ai][bj][m][0] * scale, v1 = acc[ai][bj][m][1] * scale;
                    u32x4 w; w.x = cvt_pk_bf16(v0[0], v0[1]); w.y = cvt_pk_bf16(v0[2], v0[3]); w.z = cvt_pk_bf16(v1[0], v1[1]); w.w = cvt_pk_bf16(v1[2], v1[3]);
                    *(u32x4*)(rowp + bj * HALF) = w;
                    if (foff >= 0) { *(f32x4*)(fdst + col0 + bj * HALF) = v0; *(f32x4*)(fdst + col0 + bj * HALF + 4) = v1; }
                }
            }
    }
};

template <class Epi, class Sched, bool ALIGN_EPI = false, bool SP2 = false>
__device__ __forceinline__ void gemm_phase(PG8_LAS unsigned char* lds, const Gemm g, const Sched& S, const Epi& E) {
    int tid_ = threadIdx.x; asm volatile("" : "+v"(tid_));
    const int tid = tid_, wid = __builtin_amdgcn_readfirstlane(tid >> 6), lane = tid & 63, wr = wid >> 2, wc = wid & 3, fr = lane & 15, fq = lane >> 4;
    const int K = g.K, nt = K / BK;
    unsigned voffA[2], voffB[2];
#pragma unroll
    for (int i = 0; i < 2; ++i) { int R, C; stage_rc(tid * 16 + i * 8192, R, C); const int Rb = Epi::PERM ? ((R & ~31) + perm32(R & 31)) : R;
        voffA[i] = (unsigned)(R * K + C) * 2u; voffB[i] = (unsigned)(Rb * K + C) * 2u; }
    const size_t kstep = (size_t)(BK * 2);
    const size_t hstep = (size_t)HALF * K * 2;
    const size_t tstep = 2 * hstep;
    const unsigned ldsw = (unsigned)wid * 1024u;
    const int aoff = lds_byte(wr * 64 + fr, fq * 8), boff = lds_byte(wc * 32 + fr, fq * 8);
#define PG8_SA(b, h) (((b) * 2 + (h)) * HTB)
#define PG8_SB(b, h) ((4 + (b) * 2 + (h)) * HTB)
#define PG8_STAGE(bufoff, gbase, voff) do { _Pragma("unroll") for (int _i = 0; _i < 2; ++_i) \
        __builtin_amdgcn_global_load_lds((const unsigned*)((const char*)(gbase) + (voff)[_i]), (PG8_LAS unsigned*)(lds + (bufoff) + ldsw + _i * 8192), 16, 0, 0); } while (0)
#define PG8_LDA(dst, b, h) do { _Pragma("unroll") for (int m = 0; m < 4; ++m) _Pragma("unroll") for (int k = 0; k < 2; ++k) dst[m][k] = *(const PG8_LAS bf16x8*)(lds + PG8_SA(b, h) + aoff + m * 2048 + k * 1024); } while (0)
#define PG8_LDB(dst, b, h) do { _Pragma("unroll") for (int n = 0; n < 2; ++n) _Pragma("unroll") for (int k = 0; k < 2; ++k) dst[n][k] = *(const PG8_LAS bf16x8*)(lds + PG8_SB(b, h) + boff + n * 2048 + k * 1024); } while (0)
#define PG8_MMA(ai, bj, At, Bt) do { __builtin_amdgcn_s_setprio(1); _Pragma("unroll") for (int m = 0; m < 4; ++m) _Pragma("unroll") for (int n = 0; n < 2; ++n) _Pragma("unroll") for (int k = 0; k < 2; ++k) \
        acc[ai][bj][m][n] = __builtin_amdgcn_mfma_f32_16x16x32_bf16(Bt[n][k], At[m][k], acc[ai][bj][m][n], 0, 0, 0); __builtin_amdgcn_s_setprio(0); } while (0)
#define PG8_WAIT_V(n) asm volatile("s_waitcnt vmcnt(" #n ")" ::: "memory")
#define PG8_WAIT_L(n) asm volatile("s_waitcnt lgkmcnt(" #n ")" ::: "memory")
#define PG8_BAR __builtin_amdgcn_s_barrier()
#define PG8_SCHED __builtin_amdgcn_sched_barrier(0)
    Unit cur, nxt; int ui = 0;
    if (!S.next(0, cur)) return;
    f32x4 acc[2][2][4][2];
#pragma unroll
    for (int a = 0; a < 2; ++a)
#pragma unroll
        for (int b = 0; b < 2; ++b)
#pragma unroll
            for (int m = 0; m < 4; ++m)
#pragma unroll
                for (int n = 0; n < 2; ++n) acc[a][b][m][n] = (f32x4){0.f, 0.f, 0.f, 0.f};
    bf16x8 At[4][2], B0[2][2], B1[2][2];
    const char* cA = (const char*)g.A + (size_t)cur.pm * tstep; const char* cB = (const char*)g.Bt + (size_t)cur.pn * tstep;
    S.a_ready(cur);
    if constexpr (SP2) {
        PG8_STAGE(PG8_SB(0, 0), cB, voffB); PG8_STAGE(PG8_SB(0, 1), cB + hstep, voffB); PG8_STAGE(PG8_SA(0, 0), cA, voffA); PG8_STAGE(PG8_SA(0, 1), cA + hstep, voffA);
        if (wr == 1) PG8_BAR;
        PG8_WAIT_V(2); PG8_BAR;
        PG8_STAGE(PG8_SB(1, 0), cB + kstep, voffB); PG8_STAGE(PG8_SA(1, 0), cA + kstep, voffA); PG8_STAGE(PG8_SB(1, 1), cB + hstep + kstep, voffB);
        PG8_WAIT_V(6); PG8_BAR;
    } else {
        PG8_STAGE(PG8_SB(0, 0), cB, voffB); PG8_STAGE(PG8_SA(0, 0), cA, voffA); PG8_STAGE(PG8_SB(0, 1), cB + hstep, voffB); PG8_STAGE(PG8_SA(0, 1), cA + hstep, voffA);
        if (wr == 1) PG8_BAR;
        PG8_WAIT_V(4); PG8_BAR;
        PG8_STAGE(PG8_SB(1, 0), cB + kstep, voffB); PG8_STAGE(PG8_SA(1, 0), cA + kstep, voffA); PG8_STAGE(PG8_SB(1, 1), cB + hstep + kstep, voffB);
        PG8_WAIT_V(6); PG8_BAR;
    }
    for (;;) {
        const bool has_next = S.next(ui + 1, nxt);
        const char* nA = has_next ? (const char*)g.A + (size_t)nxt.pm * tstep : cA; const char* nB = has_next ? (const char*)g.Bt + (size_t)nxt.pn * tstep : cB;
        for (int t = 0; t < nt; t += 2) {
            const bool last = (t == nt - 2);
            const char* a1 = cA + (size_t)(t + 1) * kstep;
            const char* a2 = last ? nA : cA + (size_t)(t + 2) * kstep; const char* b2 = last ? nB : cB + (size_t)(t + 2) * kstep;
            const char* a3 = a2 + kstep; const char* b3 = b2 + kstep;
            if (last && has_next) S.a_ready(nxt);
            if constexpr (SP2) {
            PG8_LDB(B0, 0, 0); PG8_LDB(B1, 0, 1); PG8_SCHED; PG8_LDA(At, 0, 0); PG8_STAGE(PG8_SA(1, 1), a1 + hstep, voffA);
            PG8_WAIT_V(8); PG8_WAIT_L(0); PG8_BAR; PG8_MMA(0, 0, At, B0); PG8_MMA(0, 1, At, B1); PG8_BAR; PG8_SCHED;
            PG8_LDA(At, 0, 1); PG8_STAGE(PG8_SB(0, 0), b2, voffB); PG8_STAGE(PG8_SB(0, 1), b2 + hstep, voffB); PG8_STAGE(PG8_SA(0, 0), a2, voffA);
            PG8_WAIT_V(8); PG8_WAIT_L(0); PG8_BAR; PG8_MMA(1, 0, At, B0); PG8_MMA(1, 1, At, B1); PG8_BAR; PG8_SCHED;
            PG8_LDB(B0, 1, 0); PG8_LDB(B1, 1, 1); PG8_SCHED; PG8_LDA(At, 1, 0); PG8_STAGE(PG8_SA(0, 1), a2 + hstep, voffA);
            PG8_WAIT_V(8); PG8_WAIT_L(0); PG8_BAR; PG8_MMA(0, 0, At, B0); PG8_MMA(0, 1, At, B1); PG8_BAR; PG8_SCHED;
            PG8_LDA(At, 1, 1); PG8_STAGE(PG8_SB(1, 0), b3, voffB); PG8_STAGE(PG8_SB(1, 1), b3 + hstep, voffB); PG8_STAGE(PG8_SA(1, 0), a3, voffA);
            PG8_WAIT_V(8); PG8_WAIT_L(0); PG8_BAR; PG8_MMA(1, 0, At, B0); PG8_MMA(1, 1, At, B1); PG8_BAR; PG8_SCHED;
            } else {
            PG8_LDB(B0, 0, 0); PG8_SCHED; PG8_LDA(At, 0, 0); PG8_STAGE(PG8_SA(1, 1), a1 + hstep, voffA);
            PG8_WAIT_L(8); PG8_BAR; PG8_WAIT_L(0); PG8_MMA(0, 0, At, B0); PG8_BAR; PG8_SCHED;
            PG8_LDB(B1, 0, 1); PG8_STAGE(PG8_SB(0, 0), b2, voffB);
            PG8_BAR; PG8_WAIT_L(0); PG8_MMA(0, 1, At, B1); PG8_BAR;
            PG8_LDA(At, 0, 1); PG8_STAGE(PG8_SA(0, 0), a2, voffA);
            PG8_BAR; PG8_WAIT_L(0); PG8_MMA(1, 0, At, B0); PG8_BAR; PG8_SCHED;
            PG8_STAGE(PG8_SB(0, 1), b2 + hstep, voffB);
            PG8_WAIT_V(6); PG8_BAR; PG8_MMA(1, 1, At, B1); PG8_BAR;
            PG8_LDB(B0, 1, 0); PG8_SCHED; PG8_LDA(At, 1, 0); PG8_STAGE(PG8_SA(0, 1), a2 + hstep, voffA);
            PG8_WAIT_L(8); PG8_BAR; PG8_WAIT_L(0); PG8_MMA(0, 0, At, B0); PG8_BAR; PG8_SCHED;
            PG8_LDB(B1, 1, 1); PG8_STAGE(PG8_SB(1, 0), b3, voffB);
            PG8_BAR; PG8_WAIT_L(0); PG8_MMA(0, 1, At, B1); PG8_BAR;
            PG8_LDA(At, 1, 1); PG8_STAGE(PG8_SA(1, 0), a3, voffA);
            PG8_BAR; PG8_WAIT_L(0); PG8_MMA(1, 0, At, B0); PG8_BAR; PG8_SCHED;
            PG8_STAGE(PG8_SB(1, 1), b3 + hstep, voffB);
            PG8_WAIT_V(6); PG8_BAR; PG8_MMA(1, 1, At, B1); PG8_BAR;
            }
        }
        if constexpr (ALIGN_EPI) { if (wr == 0) PG8_BAR; }
        if constexpr (!Epi::AFTER_DRAIN) { E(acc, cur, wr, wc, fr, fq); S.done(cur); }
        if (!has_next) break;
#pragma unroll
        for (int a = 0; a < 2; ++a)
#pragma unroll
            for (int b = 0; b < 2; ++b)
#pragma unroll
                for (int m = 0; m < 4; ++m)
#pragma unroll
                    for (int n = 0; n < 2; ++n) acc[a][b][m][n] = (f32x4){0.f, 0.f, 0.f, 0.f};
        cur = nxt; cA = nA; cB = nB; ++ui;
        if constexpr (ALIGN_EPI) { if (wr == 1) PG8_BAR; }
    }
    PG8_WAIT_V(0);
    if constexpr (!ALIGN_EPI) { if (wr == 0) PG8_BAR; }
    PG8_BAR;
    if constexpr (Epi::AFTER_DRAIN) { E.fused(acc, cur, wr, wc, fr, fq, lds, wid, lane); S.done(cur); }
#undef PG8_SA
#undef PG8_SB
#undef PG8_STAGE
#undef PG8_LDA
#undef PG8_LDB
#undef PG8_MMA
#undef PG8_WAIT_V
#undef PG8_WAIT_L
#undef PG8_BAR
#undef PG8_SCHED
}
}
#ifndef PG8_SP2
#define PG8_SP2 true
#endif
#ifndef PG8_ALIGN
#define PG8_ALIGN true
#endif
#define LAS __attribute__((address_space(3)))
typedef unsigned short bf16;
typedef unsigned v4u __attribute__((ext_vector_type(4)));
typedef unsigned v2u __attribute__((ext_vector_type(2)));
typedef float f32x4 __attribute__((ext_vector_type(4)));
typedef float f32x2 __attribute__((ext_vector_type(2)));
typedef short bf16x8 __attribute__((ext_vector_type(8)));
constexpr int NT = 512;
constexpr int LDS_BYTES = 147456;
constexpr int NPHASE = 15;

constexpr size_t MiB = 1u << 20;
constexpr size_t WS_WIN = 1 * MiB, WS_WKV = 23 * MiB, WS_WOUT = 39 * MiB, WS_WQ = 47 * MiB, WS_WO = 55 * MiB, WS_WUP = 63 * MiB, WS_WDN = 107 * MiB;
constexpr size_t WS_LW = 129 * MiB, WS_LA = 129 * MiB + 256 * 1024, WS_LG = 129 * MiB + 512 * 1024;
constexpr size_t WS_HB = 130 * MiB, WS_MB = 166 * MiB, WS_A2 = 170 * MiB, WS_MIX = 206 * MiB, WS_X1 = 278 * MiB, WS_Q = 350 * MiB, WS_O = 386 * MiB;
constexpr size_t WS_KB = 422 * MiB, WS_VT = 426 * MiB, WS_Y = 430 * MiB, WS_G = 466 * MiB, WS_BON = 502 * MiB;
constexpr size_t WS_SHB = 818 * MiB;
constexpr size_t WS_SI = 503 * MiB, SI_STRIDE = 36 * MiB;
constexpr size_t WS_UP = 503 * MiB;
constexpr size_t WS_GLU = 719 * MiB, WS_PR = 737 * MiB;
constexpr size_t WS_ACT = 719 * MiB;
constexpr size_t WS_END = 820 * MiB;
constexpr size_t O_YP = 0, O_YS = 16777216, O_CP = 18874368, O_CS = 18997248, O_SP = 22929408, O_SS = 22943488, O_WP = 23394048, O_WS = 23656192,
                 O_FP = 32044800, O_FS = 32134912, O_MK = 35018496, O_MV = 37115648, O_END = 39212800;

enum { I_XP = 0, I_XS, I_CK, I_CV, I_SCONV, I_SSHIFT, I_SWKV, I_SFFN, I_MEM, I_NMIXPRE, I_WIN, I_CDW, I_CDWB, I_CLNG, I_CLNB, I_MU, I_W0, I_WLORA, I_A0, I_ALORA,
       I_GLORA, I_KK, I_KA, I_RK, I_LNXG, I_LNXB, I_WOUT, I_NMIXPOST, I_NXAPRE, I_NMEM, I_WQ, I_WK, I_WV, I_WO, I_NXAPOST, I_NFFNPRE, I_WUP, I_FDW, I_FDWB, I_WDOWN,
       I_NFFNPOST, N_IN };

struct Params { const float* in[N_IN]; float* out; unsigned char* ws; int ph_lo, ph_hi; };

__device__ __forceinline__ unsigned f2bf(float f) { unsigned u = __builtin_bit_cast(unsigned, f); return (u + 0x7fffu + ((u >> 16) & 1u)) >> 16; }
__device__ __forceinline__ unsigned pk2(float lo, float hi) { return f2bf(lo) | (f2bf(hi) << 16); }
__device__ __forceinline__ float bflo(unsigned u) { return __builtin_bit_cast(float, u << 16); }
__device__ __forceinline__ float bfhi(unsigned u) { return __builtin_bit_cast(float, u & 0xffff0000u); }
__device__ __forceinline__ float wave_sum(float v) {
#pragma unroll
    for (int o = 1; o < 64; o <<= 1) v += __shfl_xor(v, o);
    return v;
}
__device__ __forceinline__ float wave_max(float v) {
#pragma unroll
    for (int o = 1; o < 64; o <<= 1) v = fmaxf(v, __shfl_xor(v, o));
    return v;
}
__device__ __forceinline__ float sigm(float x) { return 1.0f / (1.0f + __expf(-x)); }
#define LDS_WAIT() asm volatile("s_waitcnt lgkmcnt(0)" ::: "memory")

struct Ctx { int tid, lane, wave, bid, G, gw, NGW; };
__device__ __forceinline__ unsigned char* wsbase(const Params& P) { unsigned char* w = P.ws; asm volatile("" : "+s"(w)); return w; }
__device__ __forceinline__ const float* inp(const Params& P, int i) { int z; asm volatile("s_mov_b32 %0, 0" : "=s"(z)); return P.in[i + z]; }

template <class ColMap>
__device__ __forceinline__ void transpose_item(const float* __restrict__ W, int K, int N, bf16* __restrict__ WT, LAS float* scr, int kb, int jb, int lane, ColMap cm) {
    const int k0 = 64 * kb, j0 = 32 * jb;
    const int sc = cm(j0 + (lane & 31));
#pragma unroll 8
    for (int i = 0; i < 32; ++i) { const int kk = 2 * i + (lane >> 5); scr[kk * 33 + (lane & 31)] = sc >= 0 ? W[(size_t)(k0 + kk) * N + sc] : 0.f; }
    LDS_WAIT(); asm volatile("" ::: "memory");
    const int c = lane & 7;
#pragma unroll
    for (int j = 0; j < 4; ++j) { const int n = (lane >> 3) + 8 * j; const LAS float* s = scr + (8 * c) * 33 + n;
        v4u o; o.x = pk2(s[0 * 33], s[1 * 33]); o.y = pk2(s[2 * 33], s[3 * 33]); o.z = pk2(s[4 * 33], s[5 * 33]); o.w = pk2(s[6 * 33], s[7 * 33]);
        *(v4u*)(WT + (size_t)(j0 + n) * K + k0 + 8 * c) = o; }
    LDS_WAIT(); asm volatile("" ::: "memory");
}
struct MapId { __device__ __forceinline__ int operator()(int j) const { return j; } };
struct MapIn {
    __device__ __forceinline__ int operator()(int j) const {
        if (j < 2048) { const int g = j >> 5, q = (j >> 3) & 3, n = (j >> 2) & 1, e = j & 3; return n * 1024 + 16 * g + 4 * q + e; }
        const int jj = j - 2048; return jj < NRC ? 2048 + jj : -1;
    }
};
__device__ __forceinline__ void rms_row_bf16(const float* __restrict__ xrow, const float* __restrict__ g, bf16* __restrict__ orow, int lane) {
    f32x4 v[8]; float s = 0.f;
#pragma unroll
    for (int j = 0; j < 8; ++j) { v[j] = *(const f32x4*)(xrow + 4 * (lane + 64 * j)); s += (v[j][0] * v[j][0] + v[j][1] * v[j][1]) + (v[j][2] * v[j][2] + v[j][3] * v[j][3]); }
    const float r = rsqrtf(wave_sum(s) * (1.0f / 2048.0f) + 1e-6f);
#pragma unroll
    for (int j = 0; j < 8; ++j) { const f32x4 gg = *(const f32x4*)(g + 4 * (lane + 64 * j));
        v2u o; o.x = pk2(v[j][0] * r * gg[0], v[j][1] * r * gg[1]); o.y = pk2(v[j][2] * r * gg[2], v[j][3] * r * gg[3]);
        *(v2u*)(orow + 4 * (lane + 64 * j)) = o; }
}
__device__ __forceinline__ void p0_prologue(const Params& P, const Ctx& C, LAS unsigned char* lds) {
    unsigned char* ws = wsbase(P);
    LAS float* scr = (LAS float*)(lds + C.wave * 16384);
    constexpr int I_IN = 32 * 176, I_SQ = 32 * 64, I_UP = 32 * 352, I_DN = 88 * 64;
    constexpr int NITEMS = I_IN + 5 * I_SQ + I_UP + I_DN;
    for (int it = C.gw; it < NITEMS; it += C.NGW) {
        int r = it;
        if (r < I_IN) { transpose_item(inp(P, I_WIN), 2048, 5568, (bf16*)(ws + WS_WIN), scr, r / 176, r % 176, C.lane, MapIn()); continue; } r -= I_IN;
        if (r < I_SQ) { transpose_item(inp(P, I_WK), 2048, 2048, (bf16*)(ws + WS_WKV), scr, r / 64, r % 64, C.lane, MapId()); continue; } r -= I_SQ;
        if (r < I_SQ) { transpose_item(inp(P, I_WV), 2048, 2048, (bf16*)(ws + WS_WKV) + (size_t)2048 * 2048, scr, r / 64, r % 64, C.lane, MapId()); continue; } r -= I_SQ;
        if (r < I_SQ) { transpose_item(inp(P, I_WOUT), 2048, 2048, (bf16*)(ws + WS_WOUT), scr, r / 64, r % 64, C.lane, MapId()); continue; } r -= I_SQ;
        if (r < I_SQ) { transpose_item(inp(P, I_WQ), 2048, 2048, (bf16*)(ws + WS_WQ), scr, r / 64, r % 64, C.lane, MapId()); continue; } r -= I_SQ;
        if (r < I_SQ) { transpose_item(inp(P, I_WO), 2048, 2048, (bf16*)(ws + WS_WO), scr, r / 64, r % 64, C.lane, MapId()); continue; } r -= I_SQ;
        if (r < I_UP) { transpose_item(inp(P, I_WUP), 2048, 11264, (bf16*)(ws + WS_WUP), scr, r / 352, r % 352, C.lane, MapId()); continue; } r -= I_UP;
        transpose_item(inp(P, I_WDOWN), 5632, 2048, (bf16*)(ws + WS_WDN), scr, r / 64, r % 64, C.lane, MapId());
    }
    const int gt = C.bid * NT + C.tid, ngt = C.G * NT;
    { bf16* d = (bf16*)(ws + WS_LW); const float* s = inp(P, I_WLORA); for (int i = gt; i < 1024 * 96; i += ngt) { const int n = i / 96, k = i - n * 96; d[i] = (bf16)f2bf(s[k * 1024 + n]); } }
    { bf16* d = (bf16*)(ws + WS_LA); const float* s = inp(P, I_ALORA); for (int i = gt; i < 1024 * 96; i += ngt) { const int n = i / 96, k = i - n * 96; d[i] = (bf16)f2bf(s[k * 1024 + n]); } }
    { bf16* d = (bf16*)(ws + WS_LG); const float* s = inp(P, I_GLORA); for (int i = gt; i < 1024 * 256; i += ngt) { const int n = i >> 8, k = i & 255; d[i] = (bf16)f2bf(s[k * 1024 + n]); } }
    for (int m = C.gw; m < M + 1024; m += C.NGW) {
        if (m < M) { const float* xr = m < MP ? inp(P, I_XP) + (size_t)m * D : inp(P, I_XS) + (size_t)(m - MP) * D; rms_row_bf16(xr, inp(P, I_NMIXPRE), (bf16*)(ws + WS_HB) + (size_t)m * D, C.lane); }
        else { const int r = m - M; rms_row_bf16(inp(P, I_MEM) + (size_t)r * D, inp(P, I_NMEM), (bf16*)(ws + WS_MB) + (size_t)r * D, C.lane); }
    }
    { bf16* d = (bf16*)(ws + WS_SHB); const float* sp = inp(P, I_SSHIFT);
      for (int i = gt; i < (NBS + 1) * NRCP; i += ngt) { const int b = i / NRCP, c = i - b * NRCP; d[i] = (b < NBS && c < NRC) ? (bf16)f2bf(sp[(size_t)b * NRC + c]) : (bf16)0; } }
    { const f32x4* s = (const f32x4*)inp(P, I_SCONV); f32x4* d = (f32x4*)(P.out + O_CS);
      for (int i = gt; i < NBS * 22 * 256; i += ngt) { const int b = i / (22 * 256), r = i - b * (22 * 256); d[(size_t)b * 30 * 256 + r] = s[(size_t)b * 30 * 256 + 8 * 256 + r]; } }
}

template <int R>
__device__ __forceinline__ void conv_task(const Params& P, const Ctx& C, LAS unsigned char* lds, int grow0  , int t0  , int sb  ) {
    unsigned char* ws = wsbase(P);
    const bf16* glu = (const bf16*)(ws + WS_GLU);
    LAS unsigned* st = (LAS unsigned*)lds;
    LAS float* red = (LAS float*)(lds + 98304);
    constexpr int NR = R + 30;
    const float* sconv = inp(P, I_SCONV); const float* cdw = inp(P, I_CDW);
    for (int p = C.tid; p < NR * 128; p += NT) {
        const int rr = p >> 7, ch = p & 127; const int t = t0 - 30 + rr;
        v4u v = (v4u){0u, 0u, 0u, 0u};
        if (t >= 0) v = *(const v4u*)(glu + (size_t)(grow0 - 30 + rr) * CC + ch * 8);
        else if (sb >= 0) { const float* s = sconv + ((size_t)sb * 30 + rr) * CC + ch * 8;
            const f32x4 a = *(const f32x4*)s, b = *(const f32x4*)(s + 4); v.x = pk2(a[0], a[1]); v.y = pk2(a[2], a[3]); v.z = pk2(b[0], b[1]); v.w = pk2(b[2], b[3]); }
        *(LAS v4u*)(st + rr * 512 + ch * 4) = v;
    }
    const int c = 2 * C.tid;
    f32x2 w[31];
#pragma unroll
    for (int j = 0; j < 31; ++j) w[j] = *(const f32x2*)(cdw + j * CC + c);
    const f32x2 bias = *(const f32x2*)(inp(P, I_CDWB) + c);
    f32x2 acc[R];
#pragma unroll
    for (int r = 0; r < R; ++r) acc[r] = bias;
    __syncthreads();
#pragma unroll
    for (int rr = 0; rr < NR; ++rr) {
        if ((rr & 3) == 0) asm volatile("" ::: "memory");
        const unsigned u = st[rr * 512 + C.tid]; const float x0 = bflo(u), x1 = bfhi(u);
#pragma unroll
        for (int r = 0; r < R; ++r) { const int j = rr - r; if (j >= 0 && j < 31) { acc[r][0] += x0 * w[j][0]; acc[r][1] += x1 * w[j][1]; } }
    }
    float s[R];
#pragma unroll
    for (int r = 0; r < R; ++r) s[r] = wave_sum(acc[r][0] + acc[r][1]);
    if (C.lane == 0) {
#pragma unroll
        for (int r = 0; r < R; ++r) red[C.wave * 16 + r] = s[r]; }
    __syncthreads();
    float mean[R];
#pragma unroll
    for (int r = 0; r < R; ++r) { float t = 0.f;
#pragma unroll
        for (int wv = 0; wv < 8; ++wv) t += red[wv * 16 + r];
        mean[r] = t * (1.0f / 1024.0f); }
    __syncthreads();
#pragma unroll
    for (int r = 0; r < R; ++r) { const float d0 = acc[r][0] - mean[r], d1 = acc[r][1] - mean[r]; acc[r][0] = d0; acc[r][1] = d1; s[r] = wave_sum(d0 * d0 + d1 * d1); }
    if (C.lane == 0) {
#pragma unroll
        for (int r = 0; r < R; ++r) red[C.wave * 16 + r] = s[r]; }
    __syncthreads();
    const f32x2 lg = *(const f32x2*)(inp(P, I_CLNG) + c), lb = *(const f32x2*)(inp(P, I_CLNB) + c);
    bf16* a2 = (bf16*)(ws + WS_A2);
#pragma unroll
    for (int r = 0; r < R; ++r) { float t = 0.f;
#pragma unroll
        for (int wv = 0; wv < 8; ++wv) t += red[wv * 16 + r];
        const float rstd = rsqrtf(t * (1.0f / 1024.0f) + 1e-5f);
        float y0 = acc[r][0] * rstd * lg[0] + lb[0], y1 = acc[r][1] * rstd * lg[1] + lb[1];
        y0 = y0 * sigm(y0); y1 = y1 * sigm(y1);
        *(unsigned*)(a2 + (size_t)(grow0 + r) * D + c) = pk2(y0, y1); }
    __syncthreads();
}

#define XS8(col_, xs_) do { const v4u cu_ = *(const v4u*)(curp + (col_)); const v4u pu_ = *(const v4u*)(prvp + (col_)); \
        const f32x4 m0_ = *(const f32x4*)(mup + (col_)), m1_ = *(const f32x4*)(mup + (col_) + 4); float c_, p_; \
        c_ = bflo(cu_.x); p_ = bflo(pu_.x); xs_[0] = c_ + (p_ - c_) * m0_[0]; c_ = bfhi(cu_.x); p_ = bfhi(pu_.x); xs_[1] = c_ + (p_ - c_) * m0_[1]; \
        c_ = bflo(cu_.y); p_ = bflo(pu_.y); xs_[2] = c_ + (p_ - c_) * m0_[2]; c_ = bfhi(cu_.y); p_ = bfhi(pu_.y); xs_[3] = c_ + (p_ - c_) * m0_[3]; \
        c_ = bflo(cu_.z); p_ = bflo(pu_.z); xs_[4] = c_ + (p_ - c_) * m1_[0]; c_ = bfhi(cu_.z); p_ = bfhi(pu_.z); xs_[5] = c_ + (p_ - c_) * m1_[1]; \
        c_ = bflo(cu_.w); p_ = bflo(pu_.w); xs_[6] = c_ + (p_ - c_) * m1_[2]; c_ = bfhi(cu_.w); p_ = bfhi(pu_.w); xs_[7] = c_ + (p_ - c_) * m1_[3]; } while (0)
#define XS4(col_, xs_) do { const v2u cu_ = *(const v2u*)(curp + (col_)); const v2u pu_ = *(const v2u*)(prvp + (col_)); const f32x4 m0_ = *(const f32x4*)(mup + (col_)); float c_, p_; \
        c_ = bflo(cu_.x); p_ = bflo(pu_.x); xs_[0] = c_ + (p_ - c_) * m0_[0]; c_ = bfhi(cu_.x); p_ = bfhi(pu_.x); xs_[1] = c_ + (p_ - c_) * m0_[1]; \
        c_ = bflo(cu_.y); p_ = bflo(pu_.y); xs_[2] = c_ + (p_ - c_) * m0_[2]; c_ = bfhi(cu_.y); p_ = bfhi(pu_.y); xs_[3] = c_ + (p_ - c_) * m0_[3]; } while (0)
__device__ __forceinline__ bf16x8 pack8(const float (&x)[8]) {
    v4u o; o.x = pk2(x[0], x[1]); o.y = pk2(x[2], x[3]); o.z = pk2(x[4], x[5]); o.w = pk2(x[6], x[7]);
    return __builtin_bit_cast(bf16x8, o);
}
__device__ __forceinline__ float tanh_fast(float x) { return 1.0f - 2.0f / (1.0f + __expf(2.0f * x)); }
__device__ __forceinline__ void prep_wave(const Params& P, int rowbase, int h, int lane) {
    const int fr = lane & 15, fq = lane >> 4, row = rowbase + fr;
    unsigned char* ws = wsbase(P);
    const bf16* curp = (const bf16*)(ws + WS_PR) + (size_t)row * NRCP;
    const bf16* prvp = curp - NRCP;
    if (row < MP) { if ((row & (SEQ - 1)) == 0) prvp = (const bf16*)(ws + WS_SHB) + (size_t)NBS * NRCP; }
    else { const int rs = row - MP; if ((rs & 7) == 0) prvp = (const bf16*)(ws + WS_SHB) + (size_t)(rs >> 3) * NRCP; }
    const float* mup = inp(P, I_MU); const float* pkk = inp(P, I_KK); const float* pa0 = inp(P, I_A0); const float* pw0 = inp(P, I_W0); const float* pka = inp(P, I_KA); const float* prk = inp(P, I_RK);
    const bf16* lw = (const bf16*)(ws + WS_LW); const bf16* la = (const bf16*)(ws + WS_LA); const bf16* lg = (const bf16*)(ws + WS_LG);
    const f32x4 z4 = (f32x4){0.f, 0.f, 0.f, 0.f};
    f32x4 accW[4] = {z4, z4, z4, z4}, accA[4] = {z4, z4, z4, z4}, accG[4] = {z4, z4, z4, z4};
    {   bf16x8 A[3];
#pragma unroll
        for (int s = 0; s < 3; ++s) { float xs[8]; XS8(3072 + 32 * s + 8 * fq, xs);
#pragma unroll
            for (int e = 0; e < 8; ++e) xs[e] = tanh_fast(xs[e]);
            A[s] = pack8(xs); }
#pragma unroll
        for (int nt = 0; nt < 4; ++nt)
#pragma unroll
            for (int s = 0; s < 3; ++s) { const bf16x8 b = *(const bf16x8*)(lw + (size_t)(h * 64 + 16 * nt + fr) * 96 + 32 * s + 8 * fq); accW[nt] = __builtin_amdgcn_mfma_f32_16x16x32_bf16(b, A[s], accW[nt], 0, 0, 0); }
    }
    {   bf16x8 A[3];
#pragma unroll
        for (int s = 0; s < 3; ++s) { float xs[8]; XS8(3168 + 32 * s + 8 * fq, xs); A[s] = pack8(xs); }
#pragma unroll
        for (int nt = 0; nt < 4; ++nt)
#pragma unroll
            for (int s = 0; s < 3; ++s) { const bf16x8 b = *(const bf16x8*)(la + (size_t)(h * 64 + 16 * nt + fr) * 96 + 32 * s + 8 * fq); accA[nt] = __builtin_amdgcn_mfma_f32_16x16x32_bf16(b, A[s], accA[nt], 0, 0, 0); }
    }
    {   bf16x8 A[8];
#pragma unroll
        for (int s = 0; s < 8; ++s) { float xs[8]; XS8(3264 + 32 * s + 8 * fq, xs);
#pragma unroll
            for (int e = 0; e < 8; ++e) xs[e] = sigm(xs[e]);
            A[s] = pack8(xs); }
#pragma unroll
        for (int nt = 0; nt < 4; ++nt)
#pragma unroll
            for (int s = 0; s < 8; ++s) { const bf16x8 b = *(const bf16x8*)(lg + (size_t)(h * 64 + 16 * nt + fr) * 256 + 32 * s + 8 * fq); accG[nt] = __builtin_amdgcn_mfma_f32_16x16x32_bf16(b, A[s], accG[nt], 0, 0, 0); }
    }
    float xk[4][4];
    float ss = 0.f;
#pragma unroll
    for (int nt = 0; nt < 4; ++nt) {
        const int c = h * 64 + 16 * nt + 4 * fq;
        XS4(1024 + c, xk[nt]);
        const f32x4 kkw = *(const f32x4*)(pkk + c);
#pragma unroll
        for (int e = 0; e < 4; ++e) { const float t = xk[nt][e] * kkw[e]; ss += t * t; }
    }
    ss += __shfl_xor(ss, 16); ss += __shfl_xor(ss, 32);
    const float inv = 1.0f / fmaxf(sqrtf(ss), 1e-12f);
    float bon = 0.f;
    float* SI = (float*)(ws + WS_SI); constexpr size_t SS = SI_STRIDE / 4;
#pragma unroll
    for (int nt = 0; nt < 4; ++nt) {
        const int c = h * 64 + 16 * nt + 4 * fq; const size_t o = (size_t)row * RW + c;
        float xr[4], xv[4];
        XS4(c, xr); XS4(2048 + c, xv);
        const f32x4 w0 = *(const f32x4*)(pw0 + c), ka = *(const f32x4*)(pka + c), rk = *(const f32x4*)(prk + c);
        const f32x4 kkw = *(const f32x4*)(pkk + c), a0 = *(const f32x4*)(pa0 + c);
        f32x4 vr, vw, vk, vv, va, vb;
#pragma unroll
        for (int e = 0; e < 4; ++e) {
            const float ee = 0.6065306597126334f * sigm(w0[e] + accW[nt][e]);
            vw[e] = __expf(-ee);
            const float a = sigm(a0[e] + accA[nt][e]);
            const float kn = xk[nt][e] * kkw[e] * inv;
            const float k2 = xk[nt][e] * (1.0f + (a - 1.0f) * ka[e]);
            vr[e] = xr[e]; vk[e] = k2; vv[e] = xv[e]; va[e] = -kn; vb[e] = kn * a;
            bon += xr[e] * k2 * rk[e];
        }
        *(f32x4*)(SI + 0 * SS + o) = vr; *(f32x4*)(SI + 1 * SS + o) = vw; *(f32x4*)(SI + 2 * SS + o) = vk;
        *(f32x4*)(SI + 3 * SS + o) = vv; *(f32x4*)(SI + 4 * SS + o) = va; *(f32x4*)(SI + 5 * SS + o) = vb;
        *(f32x4*)((float*)(ws + WS_G) + o) = accG[nt];
    }
    bon += __shfl_xor(bon, 16); bon += __shfl_xor(bon, 32);
    if (fq == 0) ((float*)(ws + WS_BON))[(size_t)row * RH + h] = bon;
}

constexpr int TC = 32, STEPF = 5 * 64 + 16, STEPQ = STEPF / 4, CHUNKQ = TC * STEPQ;
template <int CTRL> __device__ __forceinline__ float dppf(float x) { return __builtin_bit_cast(float, __builtin_amdgcn_update_dpp(0, __builtin_bit_cast(int, x), CTRL, 0xF, 0xF, true)); }
__device__ __forceinline__ float allred16(float x) {
    x += dppf<0xB1>(x);
    x += dppf<0x4E>(x);
    x += dppf<0x141>(x);
    x += dppf<0x140>(x);
    return x;
}
#define SCAN_BAR() do { asm volatile("s_waitcnt lgkmcnt(0)" ::: "memory"); __builtin_amdgcn_s_barrier(); asm volatile("" ::: "memory"); } while (0)
#define SCAN_STEP(S01, S23, r4, w4, k4, a4, b4, v, yout) do { \
        f32x2 p2 = S01 * (f32x2){a4[0], a4[1]}; p2 = S23 * (f32x2){a4[2], a4[3]} + p2; \
        const float sa = allred16(p2[0] + p2[1]); const f32x2 sa2 = (f32x2){sa, sa}, v2 = (f32x2){v, v}; \
        f32x2 t01 = v2 * (f32x2){k4[0], k4[1]}, t23 = v2 * (f32x2){k4[2], k4[3]}; \
        t01 = sa2 * (f32x2){b4[0], b4[1]} + t01; t23 = sa2 * (f32x2){b4[2], b4[3]} + t23; \
        S01 = S01 * (f32x2){w4[0], w4[1]} + t01; S23 = S23 * (f32x2){w4[2], w4[3]} + t23; \
        f32x2 q2 = S01 * (f32x2){r4[0], r4[1]}; q2 = S23 * (f32x2){r4[2], r4[3]} + q2; \
        yout = allred16(q2[0] + q2[1]); } while (0)
__device__ __forceinline__ void scan_prompt(const Params& P, const Ctx& C, LAS unsigned char* lds, int chain, int rb) {
    unsigned char* ws = wsbase(P);
    const float* SI = (const float*)(ws + WS_SI); constexpr size_t SS = SI_STRIDE / 4;
    const int b = chain >> 4, h = chain & 15, m0 = b * SEQ;
    LAS float* buf = (LAS float*)lds;
    constexpr int NCH = SEQ / TC;
    if (C.wave >= 4) {
        const int ht = C.tid - 256;
        f32x4 stg[11];
#define SCAN_HLOAD(ck_) do { _Pragma("unroll") for (int q = 0; q < 11; ++q) { const int i4 = ht + q * 256; if (i4 < CHUNKQ) { const int t = i4 / STEPQ, o4 = i4 - t * STEPQ; \
            const size_t rowo = (size_t)(m0 + (ck_) * TC + t) * RW + h * 64; const float* src; \
            if (o4 < 80) { const int vec = o4 >> 4; const int arr = vec < 3 ? vec : vec + 1; src = SI + arr * SS + rowo + 4 * (o4 & 15); } \
            else src = SI + 3 * SS + rowo + rb * 16 + 4 * (o4 - 80); \
            stg[q] = *(const f32x4*)src; } } } while (0)
#define SCAN_HWRITE(ck_) do { LAS f32x4* dst = (LAS f32x4*)(buf + ((ck_) & 1) * (TC * STEPF)); _Pragma("unroll") for (int q = 0; q < 11; ++q) { const int i4 = ht + q * 256; if (i4 < CHUNKQ) dst[i4] = stg[q]; } } while (0)
        SCAN_HLOAD(0); SCAN_HWRITE(0); SCAN_HLOAD(1);
        SCAN_BAR();
        for (int ck = 0; ck < NCH; ++ck) {
            if (ck + 1 < NCH) SCAN_HWRITE(ck + 1);
            if (ck + 2 < NCH) SCAN_HLOAD(ck + 2);
            SCAN_BAR();
        }
#undef SCAN_HLOAD
#undef SCAN_HWRITE
    } else {
        float* Y = (float*)(ws + WS_Y);
        const int rowl = C.lane >> 4, cl = C.lane & 15, irow = rb * 16 + C.wave * 4 + rowl;
        f32x2 S01 = (f32x2){0.f, 0.f}, S23 = (f32x2){0.f, 0.f};
        float yk = 0.f;
        SCAN_BAR();
        for (int ck = 0; ck < NCH; ++ck) {
            const LAS float* cb = buf + (ck & 1) * (TC * STEPF);
            f32x4 r4 = *(const LAS f32x4*)(cb + 0 * 64 + 4 * cl), w4 = *(const LAS f32x4*)(cb + 1 * 64 + 4 * cl), k4 = *(const LAS f32x4*)(cb + 2 * 64 + 4 * cl);
            f32x4 a4 = *(const LAS f32x4*)(cb + 3 * 64 + 4 * cl), b4 = *(const LAS f32x4*)(cb + 4 * 64 + 4 * cl); float v = cb[320 + C.wave * 4 + rowl];
#pragma unroll 4
            for (int t = 0; t < TC; ++t) {
                const LAS float* nb = cb + (t + 1 < TC ? t + 1 : t) * STEPF;
                const f32x4 nr = *(const LAS f32x4*)(nb + 0 * 64 + 4 * cl), nw = *(const LAS f32x4*)(nb + 1 * 64 + 4 * cl), nk = *(const LAS f32x4*)(nb + 2 * 64 + 4 * cl);
                const f32x4 na = *(const LAS f32x4*)(nb + 3 * 64 + 4 * cl), nbb = *(const LAS f32x4*)(nb + 4 * 64 + 4 * cl); const float nv = nb[320 + C.wave * 4 + rowl];
                float y; SCAN_STEP(S01, S23, r4, w4, k4, a4, b4, v, y);
                yk = (cl == (t & 15)) ? y : yk;
                if ((t & 15) == 15) Y[(size_t)(m0 + ck * TC + (t & ~15) + cl) * RW + h * 64 + irow] = yk;
                r4 = nr; w4 = nw; k4 = nk; a4 = na; b4 = nbb; v = nv;
            }
            SCAN_BAR();
        }
        float* so = P.out + O_WP + ((size_t)chain * 64 + irow) * 64 + 4 * cl;
        *(f32x4*)so = (f32x4){S01[0], S01[1], S23[0], S23[1]};
    }
    __syncthreads();
}
__device__ __forceinline__ void scan_sample(const Params& P, const Ctx& C, const float* swkv, int chain, int half) {
    unsigned char* ws = wsbase(P);
    const float* SI = (const float*)(ws + WS_SI); constexpr size_t SS = SI_STRIDE / 4;
    float* Y = (float*)(ws + WS_Y);
    const int b = chain >> 4, h = chain & 15, m0 = MP + 8 * b;
    const int rowl = C.lane >> 4, cl = C.lane & 15, irow = half * 32 + C.wave * 4 + rowl;
    const f32x4 s4 = *(const f32x4*)(swkv + ((size_t)chain * 64 + irow) * 64 + 4 * cl);
    f32x2 S01 = (f32x2){s4[0], s4[1]}, S23 = (f32x2){s4[2], s4[3]};
    float yk = 0.f;
#pragma unroll
    for (int t = 0; t < 8; ++t) {
        const size_t rowo = (size_t)(m0 + t) * RW + h * 64;
        const f32x4 r4 = *(const f32x4*)(SI + 0 * SS + rowo + 4 * cl), w4 = *(const f32x4*)(SI + 1 * SS + rowo + 4 * cl), k4 = *(const f32x4*)(SI + 2 * SS + rowo + 4 * cl);
        const f32x4 a4 = *(const f32x4*)(SI + 4 * SS + rowo + 4 * cl), b4 = *(const f32x4*)(SI + 5 * SS + rowo + 4 * cl); const float v = SI[3 * SS + rowo + irow];
        float y; SCAN_STEP(S01, S23, r4, w4, k4, a4, b4, v, y);
        yk = (cl == t) ? y : yk;
    }
    if (cl < 8) Y[(size_t)(m0 + cl) * RW + h * 64 + irow] = yk;
    *(f32x4*)(P.out + O_WS + ((size_t)chain * 64 + irow) * 64 + 4 * cl) = (f32x4){S01[0], S01[1], S23[0], S23[1]};
}

__device__ __forceinline__ void post_row(const Params& P, int row, int lane) {
    unsigned char* ws = wsbase(P);
    const float* Y = (const float*)(ws + WS_Y) + (size_t)row * RW + 16 * lane;
    const float* V = (const float*)(ws + WS_SI) + 3 * (SI_STRIDE / 4) + (size_t)row * RW + 16 * lane;
    const float* G = (const float*)(ws + WS_G) + (size_t)row * RW + 16 * lane;
    const float bon = ((const float*)(ws + WS_BON))[(size_t)row * RH + (lane >> 2)];
    float y[16], s = 0.f;
#pragma unroll
    for (int q = 0; q < 4; ++q) { const f32x4 t = *(const f32x4*)(Y + 4 * q); y[4 * q] = t[0]; y[4 * q + 1] = t[1]; y[4 * q + 2] = t[2]; y[4 * q + 3] = t[3]; s += (t[0] + t[1]) + (t[2] + t[3]); }
    s += __shfl_xor(s, 1); s += __shfl_xor(s, 2);
    const float mu = s * (1.0f / 64.0f); float q2 = 0.f;
#pragma unroll
    for (int e = 0; e < 16; ++e) { y[e] -= mu; q2 += y[e] * y[e]; }
    q2 += __shfl_xor(q2, 1); q2 += __shfl_xor(q2, 2);
    const float rstd = rsqrtf(q2 * (1.0f / 64.0f) + 64e-5f);
    const float* lg = inp(P, I_LNXG) + 16 * lane; const float* lb = inp(P, I_LNXB) + 16 * lane;
    unsigned o[8];
#pragma unroll
    for (int q = 0; q < 4; ++q) { const f32x4 g4 = *(const f32x4*)(lg + 4 * q), b4 = *(const f32x4*)(lb + 4 * q), v4 = *(const f32x4*)(V + 4 * q), gg = *(const f32x4*)(G + 4 * q);
        float r[4];
#pragma unroll
        for (int e = 0; e < 4; ++e) r[e] = (y[4 * q + e] * rstd * g4[e] + b4[e] + bon * v4[e]) * gg[e];
        o[2 * q] = pk2(r[0], r[1]); o[2 * q + 1] = pk2(r[2], r[3]); }
    bf16* dst = (bf16*)(ws + WS_A2) + (size_t)row * D + 1024 + 16 * lane;
    *(v4u*)dst = (v4u){o[0], o[1], o[2], o[3]}; *(v4u*)(dst + 8) = (v4u){o[4], o[5], o[6], o[7]};
}

__device__ __forceinline__ void rowpass(const float* xa, const float* __restrict__ mix, const float* __restrict__ g1, float* xo,
                                        const float* __restrict__ g2, bf16* __restrict__ hb, int lane) {
    f32x4 mv[8]; float s = 0.f;
#pragma unroll
    for (int j = 0; j < 8; ++j) { mv[j] = *(const f32x4*)(mix + 4 * (lane + 64 * j)); s += (mv[j][0] * mv[j][0] + mv[j][1] * mv[j][1]) + (mv[j][2] * mv[j][2] + mv[j][3] * mv[j][3]); }
    const float r = rsqrtf(wave_sum(s) * (1.0f / 2048.0f) + 1e-6f);
    float s2 = 0.f;
#pragma unroll
    for (int j = 0; j < 8; ++j) { const f32x4 a = *(const f32x4*)(xa + 4 * (lane + 64 * j)), gg = *(const f32x4*)(g1 + 4 * (lane + 64 * j));
        mv[j] = a + mv[j] * r * gg; *(f32x4*)(xo + 4 * (lane + 64 * j)) = mv[j];
        s2 += (mv[j][0] * mv[j][0] + mv[j][1] * mv[j][1]) + (mv[j][2] * mv[j][2] + mv[j][3] * mv[j][3]); }
    if (hb) {
        const float r2 = rsqrtf(wave_sum(s2) * (1.0f / 2048.0f) + 1e-6f);
#pragma unroll
        for (int j = 0; j < 8; ++j) { const f32x4 gg = *(const f32x4*)(g2 + 4 * (lane + 64 * j));
            v2u o; o.x = pk2(mv[j][0] * r2 * gg[0], mv[j][1] * r2 * gg[1]); o.y = pk2(mv[j][2] * r2 * gg[2], mv[j][3] * r2 * gg[3]);
            *(v2u*)(hb + 4 * (lane + 64 * j)) = o; }
    }
}
__device__ __forceinline__ void attn_prompt_task(const Params& P, const Ctx& C, LAS unsigned char* lds, int b, int h, int qt) {
    unsigned char* ws = wsbase(P);
    const bf16* Qg = (const bf16*)(ws + WS_Q); const bf16* Kg = (const bf16*)(ws + WS_KB); const bf16* VTg = (const bf16*)(ws + WS_VT);
    bf16* Og = (bf16*)(ws + WS_O);
    const int fr = C.lane & 15, fq = C.lane >> 4;
    const int qrow = b * SEQ + qt * 128 + C.wave * 16 + fr;
    constexpr int BUFB = 33792;
    bf16x8 Qf[16];
#pragma unroll
    for (int s = 0; s < 16; ++s) Qf[s] = *(const bf16x8*)(Qg + (size_t)qrow * D + h * XD + 32 * s + 8 * fq);
    f32x4 accS[16];
#pragma unroll
    for (int nt = 0; nt < 16; ++nt) accS[nt] = (f32x4){0.f, 0.f, 0.f, 0.f};
    v4u stg[4];
#define ATT_GLOAD(c_) do { if ((c_) < 8) { _Pragma("unroll") for (int i = 0; i < 4; ++i) { const int idx = C.tid + i * NT, key = idx >> 3, ch = idx & 7; \
            stg[i] = *(const v4u*)(Kg + (size_t)(b * NMEM + key) * D + h * XD + (c_) * 64 + ch * 8); } } \
        else { _Pragma("unroll") for (int i = 0; i < 4; ++i) { const int idx = C.tid + i * NT, dd = idx >> 5, ch = idx & 31; \
            stg[i] = *(const v4u*)(VTg + ((size_t)((b * XH + h) * XD + ((c_) - 8) * 64 + dd)) * NMEM + ch * 8); } } } while (0)
#define ATT_SWRITE(c_) do { LAS unsigned char* sbuf = lds + ((c_) & 1) * BUFB; if ((c_) < 8) { _Pragma("unroll") for (int i = 0; i < 4; ++i) { const int idx = C.tid + i * NT, key = idx >> 3, ch = idx & 7; \
            *(LAS v4u*)(sbuf + key * 128 + ((ch ^ (key & 7)) * 16)) = stg[i]; } } \
        else { _Pragma("unroll") for (int i = 0; i < 4; ++i) { const int idx = C.tid + i * NT, dd = idx >> 5, ch = idx & 31; \
            *(LAS v4u*)(sbuf + dd * 528 + ch * 16) = stg[i]; } } } while (0)
    ATT_GLOAD(0); ATT_SWRITE(0); __syncthreads();
    bf16x8 Pf[8];
#pragma unroll
    for (int c = 0; c < 8; ++c) {
        ATT_GLOAD(c + 1);
        const LAS unsigned char* sbuf = lds + (c & 1) * BUFB;
#pragma unroll
        for (int ss = 0; ss < 2; ++ss)
#pragma unroll
            for (int nt = 0; nt < 16; ++nt) {
                const int key = 16 * nt + fr, ch = ss * 4 + fq;
                const bf16x8 kf = *(const LAS bf16x8*)(sbuf + key * 128 + ((ch ^ (key & 7)) * 16));
                accS[nt] = __builtin_amdgcn_mfma_f32_16x16x32_bf16(kf, Qf[2 * c + ss], accS[nt], 0, 0, 0);
            }
        if (c == 7) {
            float mx = -3.0e38f;
#pragma unroll
            for (int nt = 0; nt < 16; ++nt) mx = fmaxf(mx, fmaxf(fmaxf(accS[nt][0], accS[nt][1]), fmaxf(accS[nt][2], accS[nt][3])));
            mx = fmaxf(mx, __shfl_xor(mx, 16)); mx = fmaxf(mx, __shfl_xor(mx, 32));
            float sum = 0.f;
#pragma unroll
            for (int nt = 0; nt < 16; ++nt) {
#pragma unroll
                for (int e = 0; e < 4; ++e) { const float p = exp2f(accS[nt][e] - mx); accS[nt][e] = p; sum += p; } }
            sum += __shfl_xor(sum, 16); sum += __shfl_xor(sum, 32);
            const float inv = 1.0f / sum;
#pragma unroll
            for (int s = 0; s < 8; ++s) { v4u o; o.x = pk2(accS[2 * s][0] * inv, accS[2 * s][1] * inv); o.y = pk2(accS[2 * s][2] * inv, accS[2 * s][3] * inv);
                o.z = pk2(accS[2 * s + 1][0] * inv, accS[2 * s + 1][1] * inv); o.w = pk2(accS[2 * s + 1][2] * inv, accS[2 * s + 1][3] * inv); Pf[s] = __builtin_bit_cast(bf16x8, o); }
        }
        ATT_SWRITE(c + 1);
        __syncthreads();
    }
    for (int c = 8; c < 16; ++c) {
        if (c + 1 < 16) ATT_GLOAD(c + 1);
        const LAS unsigned char* sbuf = lds + (c & 1) * BUFB;
        const int dv = c - 8;
        f32x4 accO[4];
#pragma unroll
        for (int nd = 0; nd < 4; ++nd) accO[nd] = (f32x4){0.f, 0.f, 0.f, 0.f};
#pragma unroll
        for (int s = 0; s < 8; ++s)
#pragma unroll
            for (int nd = 0; nd < 4; ++nd) {
                const LAS unsigned char* rp = sbuf + (nd * 16 + fr) * 528 + (32 * s + 4 * fq) * 2;
                const v2u lo = *(const LAS v2u*)rp, hi = *(const LAS v2u*)(rp + 32);
                const bf16x8 vf = __builtin_bit_cast(bf16x8, ((v4u){lo.x, lo.y, hi.x, hi.y}));
                accO[nd] = __builtin_amdgcn_mfma_f32_16x16x32_bf16(vf, Pf[s], accO[nd], 0, 0, 0);
            }
#pragma unroll
        for (int nd = 0; nd < 4; ++nd) { v2u o; o.x = pk2(accO[nd][0], accO[nd][1]); o.y = pk2(accO[nd][2], accO[nd][3]);
            *(v2u*)(Og + (size_t)qrow * D + h * XD + dv * 64 + nd * 16 + 4 * fq) = o; }
        if (c + 1 < 16) ATT_SWRITE(c + 1);
        __syncthreads();
    }
#undef ATT_GLOAD
#undef ATT_SWRITE
}
__device__ __forceinline__ void attn_sample_task(const Params& P, const Ctx& C, LAS unsigned char* lds, int b, int h) {
    unsigned char* ws = wsbase(P);
    const bf16* Qg = (const bf16*)(ws + WS_Q); bf16* Og = (bf16*)(ws + WS_O);
    const float* CK = inp(P, I_CK); const float* CV = inp(P, I_CV);
    LAS float* sS = (LAS float*)lds;
    LAS float* sP = (LAS float*)(lds + 8192);
    const int row0 = MP + 8 * b;
    float qv[8][8];
#pragma unroll
    for (int q = 0; q < 8; ++q) { const bf16* qp = Qg + (size_t)(row0 + q) * D + h * XD;
        const v2u a = *(const v2u*)(qp + 4 * C.lane), c2 = *(const v2u*)(qp + 256 + 4 * C.lane);
        qv[q][0] = bflo(a.x); qv[q][1] = bfhi(a.x); qv[q][2] = bflo(a.y); qv[q][3] = bfhi(a.y); qv[q][4] = bflo(c2.x); qv[q][5] = bfhi(c2.x); qv[q][6] = bflo(c2.y); qv[q][7] = bfhi(c2.y); }
    for (int k0 = 0; k0 < 32; k0 += 4) {
        f32x4 ka[4], kb2[4];
#pragma unroll
        for (int u = 0; u < 4; ++u) { const float* kp = CK + ((size_t)(b * NMEM + C.wave * 32 + k0 + u) * XH + h) * XD; ka[u] = *(const f32x4*)(kp + 4 * C.lane); kb2[u] = *(const f32x4*)(kp + 256 + 4 * C.lane); }
#pragma unroll
        for (int u = 0; u < 4; ++u) {
            float part[8];
#pragma unroll
            for (int q = 0; q < 8; ++q) part[q] = (qv[q][0] * ka[u][0] + qv[q][1] * ka[u][1]) + (qv[q][2] * ka[u][2] + qv[q][3] * ka[u][3]) + (qv[q][4] * kb2[u][0] + qv[q][5] * kb2[u][1]) + (qv[q][6] * kb2[u][2] + qv[q][7] * kb2[u][3]);
#pragma unroll
            for (int q = 0; q < 8; ++q) part[q] = wave_sum(part[q]);
            if (C.lane == 0) {
#pragma unroll
                for (int q = 0; q < 8; ++q) sS[q * 256 + C.wave * 32 + k0 + u] = part[q]; }
        }
    }
    __syncthreads();
    {
        const int q = C.wave; const f32x4 s4 = *(const LAS f32x4*)(sS + q * 256 + 4 * C.lane);
        const float mx = wave_max(fmaxf(fmaxf(s4[0], s4[1]), fmaxf(s4[2], s4[3])));
        const float p0 = exp2f(s4[0] - mx), p1 = exp2f(s4[1] - mx), p2 = exp2f(s4[2] - mx), p3 = exp2f(s4[3] - mx);
        const float inv = 1.0f / wave_sum((p0 + p1) + (p2 + p3));
        sP[(4 * C.lane + 0) * 8 + q] = p0 * inv; sP[(4 * C.lane + 1) * 8 + q] = p1 * inv; sP[(4 * C.lane + 2) * 8 + q] = p2 * inv; sP[(4 * C.lane + 3) * 8 + q] = p3 * inv;
    }
    __syncthreads();
    float acc[8];
#pragma unroll
    for (int q = 0; q < 8; ++q) acc[q] = 0.f;
    const int d = C.wave * 64 + C.lane;
    for (int k0 = 0; k0 < 256; k0 += 8) {
        float vv[8];
#pragma unroll
        for (int u = 0; u < 8; ++u) vv[u] = CV[((size_t)(b * NMEM + k0 + u) * XH + h) * XD + d];
#pragma unroll
        for (int u = 0; u < 8; ++u) { const f32x4 pa = *(const LAS f32x4*)(sP + (k0 + u) * 8), pb = *(const LAS f32x4*)(sP + (k0 + u) * 8 + 4);
            acc[0] += pa[0] * vv[u]; acc[1] += pa[1] * vv[u]; acc[2] += pa[2] * vv[u]; acc[3] += pa[3] * vv[u];
            acc[4] += pb[0] * vv[u]; acc[5] += pb[1] * vv[u]; acc[6] += pb[2] * vv[u]; acc[7] += pb[3] * vv[u]; }
    }
#pragma unroll
    for (int q = 0; q < 8; ++q) Og[(size_t)(row0 + q) * D + h * XD + d] = (bf16)f2bf(acc[q]);
    __syncthreads();
}

__device__ __forceinline__ void ffn_conv_act(const Params& P, const Ctx& C) {
    unsigned char* ws = wsbase(P);
    const bf16* UP = (const bf16*)(ws + WS_UP); bf16* ACT = (bf16*)(ws + WS_ACT);
    const float* FW = inp(P, I_FDW); const float* FB = inp(P, I_FDWB); const float* SF = inp(P, I_SFFN);
    constexpr int NG = DFF / 8;
    const long total = (long)M * NG;
    for (long it = (long)C.bid * NT + C.tid; it < total; it += (long)C.G * NT) {
        const int row = (int)(it / NG), cg8 = (int)(it - (long)row * NG) * 8;
        int t, sb = -1; if (row < MP) t = row & (SEQ - 1); else { const int rs = row - MP; t = rs & 7; sb = rs >> 3; }
        float res[2][8];
#pragma unroll
        for (int half = 0; half < 2; ++half) {
            const int c = half * DFF + cg8;
            float x[3][8];
#pragma unroll
            for (int j = 0; j < 3; ++j) {
                const int tt = t - 2 + j;
                if (tt >= 0) { const v4u u = *(const v4u*)(UP + (size_t)(row - 2 + j) * DFF2 + c);
                    x[j][0] = bflo(u.x); x[j][1] = bfhi(u.x); x[j][2] = bflo(u.y); x[j][3] = bfhi(u.y); x[j][4] = bflo(u.z); x[j][5] = bfhi(u.z); x[j][6] = bflo(u.w); x[j][7] = bfhi(u.w); }
                else if (sb >= 0) { const float* s = SF + ((size_t)sb * 2 + (tt + 2)) * DFF2 + c; const f32x4 a = *(const f32x4*)s, b2 = *(const f32x4*)(s + 4);
                    x[j][0] = a[0]; x[j][1] = a[1]; x[j][2] = a[2]; x[j][3] = a[3]; x[j][4] = b2[0]; x[j][5] = b2[1]; x[j][6] = b2[2]; x[j][7] = b2[3]; }
                else {
#pragma unroll
                    for (int e = 0; e < 8; ++e) x[j][e] = 0.f; }
            }
#pragma unroll
            for (int e = 0; e < 8; ++e) res[half][e] = FB[c + e] + FW[c + e] * x[0][e] + FW[DFF2 + c + e] * x[1][e] + FW[2 * DFF2 + c + e] * x[2][e];
        }
        v4u o;
        float a[8];
#pragma unroll
        for (int e = 0; e < 8; ++e) a[e] = res[0][e] * sigm(res[0][e]) * res[1][e];
        o.x = pk2(a[0], a[1]); o.y = pk2(a[2], a[3]); o.z = pk2(a[4], a[5]); o.w = pk2(a[6], a[7]);
        *(v4u*)(ACT + (size_t)row * DFF + cg8) = o;
    }
}

template <bool COOP>
__global__ void __launch_bounds__(NT, 2) mega(Params P) {
    extern __shared__ __attribute__((aligned(16))) unsigned char lds_raw[];
    LAS unsigned char* lds = (LAS unsigned char*)lds_raw;
    Ctx C0; C0.tid = threadIdx.x; C0.lane = C0.tid & 63; C0.wave = __builtin_amdgcn_readfirstlane(C0.tid >> 6); C0.bid = blockIdx.x; C0.G = gridDim.x;
    C0.gw = C0.bid * 8 + C0.wave; C0.NGW = C0.G * 8;
    const int lo = P.ph_lo, hi = P.ph_hi;
#ifndef MK_ONLY
#define MK_ONLY -1
#endif
#define IN(k) ((MK_ONLY < 0 || MK_ONLY == (k)) && lo <= (k) && (k) < hi)
#define PH_CTX() Ctx C = C0; unsigned char* ws = wsbase(P); (void)ws; asm volatile("" : "+v"(C.tid), "+v"(C.lane), "+s"(C.wave), "+s"(C.gw), "+s"(C.bid))
#ifndef MK_REPMASK
#define MK_REPMASK 0
#endif
#define NREP(k) (((MK_REPMASK >> (k)) & 1) ? 2 : 1)
#define SEAM(k) do { if constexpr (COOP) { if (IN(k) && IN((k) + 1)) cg::this_grid().sync(); } } while (0)

    for (int rep_ = 0; rep_ < NREP(0); ++rep_) if (IN(0)) { PH_CTX(); p0_prologue(P, C, lds); __syncthreads(); }
    SEAM(0);
    for (int rep_ = 0; rep_ < NREP(1); ++rep_) if (IN(1)) { PH_CTX();
        { pg8::Gemm g{(const pg8::bf16_t*)(ws + WS_HB), (const pg8::bf16_t*)(ws + WS_WIN), M, NINP, D}; pg8::StaticOrder S; S.init(M, NINP, C.G, C.bid);
          pg8::EpiIn E{(pg8::bf16_t*)(ws + WS_GLU), (pg8::bf16_t*)(ws + WS_PR), P.out + O_CP, P.out + O_CS, P.out + O_SP, P.out + O_SS};
          pg8::gemm_phase<pg8::EpiIn, pg8::StaticOrder, PG8_ALIGN, PG8_SP2>(lds, g, S, E); }
        { pg8::Gemm g{(const pg8::bf16_t*)(ws + WS_MB), (const pg8::bf16_t*)(ws + WS_WKV), 1024, 4096, D}; pg8::StaticOrder S; S.init(1024, 4096, C.G, (C.bid + C.G - 24) % C.G);
          pg8::EpiKV E{P.out + O_MK, P.out + O_MV, (pg8::bf16_t*)(ws + WS_KB), (pg8::bf16_t*)(ws + WS_VT)};
          pg8::gemm_phase<pg8::EpiKV, pg8::StaticOrder, PG8_ALIGN, PG8_SP2>(lds, g, S, E); }
    }
    SEAM(1);
    for (int rep_ = 0; rep_ < NREP(2); ++rep_) if (IN(2)) { PH_CTX();
        for (int tk = C.bid; tk < 640; tk += C.G) {
            if (tk < 512) { const int b = tk >> 7, r0 = (tk & 127) * 16; conv_task<16>(P, C, lds, b * SEQ + r0, r0, -1); }
            else { const int sb = tk - 512; conv_task<8>(P, C, lds, MP + 8 * sb, 0, sb); }
        }
        for (int tk = C.bid; tk < 1152; tk += C.G) { const int rg = tk >> 2, hg = tk & 3; prep_wave(P, rg * 32 + (C.wave >> 2) * 16, hg * 4 + (C.wave & 3), C.lane); }
    }
    SEAM(2);
    for (int rep_ = 0; rep_ < NREP(3); ++rep_) if (IN(3)) { PH_CTX();
        const float* swkv = inp(P, I_SWKV);
        for (int tk = C.bid; tk < 256; tk += C.G) scan_prompt(P, C, lds, tk >> 2, tk & 3);
        for (int tk = C.bid; tk < 4096; tk += C.G) scan_sample(P, C, swkv, tk >> 1, tk & 1);
    }
    SEAM(3);
    for (int rep_ = 0; rep_ < NREP(4); ++rep_) if (IN(4)) { PH_CTX(); for (int m = C.gw; m < M; m += C.NGW) post_row(P, m, C.lane); }
    SEAM(4);
    for (int rep_ = 0; rep_ < NREP(5); ++rep_) if (IN(5)) { PH_CTX(); pg8::Gemm g{(const pg8::bf16_t*)(ws + WS_A2), (const pg8::bf16_t*)(ws + WS_WOUT), M, D, D}; pg8::StaticOrder S; S.init(M, D, C.G, C.bid);
        pg8::EpiF32 E{(float*)(ws + WS_MIX), D}; pg8::gemm_phase<pg8::EpiF32, pg8::StaticOrder, PG8_ALIGN, PG8_SP2>(lds, g, S, E); }
    SEAM(5);
    for (int rep_ = 0; rep_ < NREP(6); ++rep_) if (IN(6)) { PH_CTX(); const float* xp = inp(P, I_XP); const float* xs = inp(P, I_XS); const float* g1 = inp(P, I_NMIXPOST); const float* g2 = inp(P, I_NXAPRE);
        for (int m = C.gw; m < M; m += C.NGW) { const float* xr = m < MP ? xp + (size_t)m * D : xs + (size_t)(m - MP) * D;
        rowpass(xr, (const float*)(ws + WS_MIX) + (size_t)m * D, g1, (float*)(ws + WS_X1) + (size_t)m * D, g2, (bf16*)(ws + WS_HB) + (size_t)m * D, C.lane); } }
    SEAM(6);
    for (int rep_ = 0; rep_ < NREP(7); ++rep_) if (IN(7)) { PH_CTX(); pg8::Gemm g{(const pg8::bf16_t*)(ws + WS_HB), (const pg8::bf16_t*)(ws + WS_WQ), M, D, D}; pg8::StaticOrder S; S.init(M, D, C.G, C.bid);
        pg8::EpiBf16S E{(pg8::bf16_t*)(ws + WS_Q), D, 0.06375871479f  , nullptr};
        pg8::gemm_phase<pg8::EpiBf16S, pg8::StaticOrder, PG8_ALIGN, PG8_SP2>(lds, g, S, E); }
    SEAM(7);
    for (int rep_ = 0; rep_ < NREP(8); ++rep_) if (IN(8)) { PH_CTX();
        for (int tk = C.bid; tk < 256; tk += C.G) attn_prompt_task(P, C, lds, tk >> 6, (tk >> 4) & 3, tk & 15);
        for (int tk = C.bid; tk < 512; tk += C.G) attn_sample_task(P, C, lds, tk >> 2, tk & 3);
    }
    SEAM(8);
    for (int rep_ = 0; rep_ < NREP(9); ++rep_) if (IN(9)) { PH_CTX(); pg8::Gemm g{(const pg8::bf16_t*)(ws + WS_O), (const pg8::bf16_t*)(ws + WS_WO), M, D, D}; pg8::StaticOrder S; S.init(M, D, C.G, C.bid);
        pg8::EpiF32 E{(float*)(ws + WS_MIX), D}; pg8::gemm_phase<pg8::EpiF32, pg8::StaticOrder, PG8_ALIGN, PG8_SP2>(lds, g, S, E); }
    SEAM(9);
    for (int rep_ = 0; rep_ < NREP(10); ++rep_) if (IN(10)) { PH_CTX(); const float* g1 = inp(P, I_NXAPOST); const float* g2 = inp(P, I_NFFNPRE);
        for (int m = C.gw; m < M; m += C.NGW) { float* x1 = (float*)(ws + WS_X1) + (size_t)m * D;
        rowpass(x1, (const float*)(ws + WS_MIX) + (size_t)m * D, g1, x1, g2, (bf16*)(ws + WS_HB) + (size_t)m * D, C.lane); } }
    SEAM(10);
    for (int rep_ = 0; rep_ < NREP(11); ++rep_) if (IN(11)) { PH_CTX(); pg8::Gemm g{(const pg8::bf16_t*)(ws + WS_HB), (const pg8::bf16_t*)(ws + WS_WUP), M, DFF2, D}; pg8::StaticOrder S; S.init(M, DFF2, C.G, C.bid);
        pg8::EpiBf16S E{(pg8::bf16_t*)(ws + WS_UP), DFF2, 1.0f, P.out + O_FP};
        pg8::gemm_phase<pg8::EpiBf16S, pg8::StaticOrder, PG8_ALIGN, PG8_SP2>(lds, g, S, E); }
    SEAM(11);
    for (int rep_ = 0; rep_ < NREP(12); ++rep_) if (IN(12)) { PH_CTX(); ffn_conv_act(P, C); }
    SEAM(12);
    for (int rep_ = 0; rep_ < NREP(13); ++rep_) if (IN(13)) { PH_CTX(); pg8::Gemm g{(const pg8::bf16_t*)(ws + WS_ACT), (const pg8::bf16_t*)(ws + WS_WDN), M, D, DFF}; pg8::StaticOrder S; S.init(M, D, C.G, C.bid);
        pg8::EpiF32 E{(float*)(ws + WS_MIX), D}; pg8::gemm_phase<pg8::EpiF32, pg8::StaticOrder, PG8_ALIGN, PG8_SP2>(lds, g, S, E); }
    SEAM(13);
    for (int rep_ = 0; rep_ < NREP(14); ++rep_) if (IN(14)) { PH_CTX(); const float* g1 = inp(P, I_NFFNPOST);
        for (int m = C.gw; m < M; m += C.NGW) { const float* x2 = (const float*)(ws + WS_X1) + (size_t)m * D;
        float* yo = m < MP ? P.out + O_YP + (size_t)m * D : P.out + O_YS + (size_t)(m - MP) * D;
        rowpass(x2, (const float*)(ws + WS_MIX) + (size_t)m * D, g1, yo, nullptr, nullptr, C.lane); } }
#undef IN
#undef SEAM
}

#ifndef MK_ONE_LAUNCH
#define MK_ONE_LAUNCH 1
#endif
extern "C" void kernel_launch(void* const* d_in, const int* in_sizes, int n_in, void* d_out, int out_size, void* d_ws, size_t ws_size, hipStream_t stream) {
    static int grid = 0;
    if (grid == 0) {
        if (n_in != N_IN || (size_t)out_size != O_END || ws_size < WS_END) { fprintf(stderr, "kernel_launch: unexpected sizes: n_in %d out %d ws %zu (need %zu)\n", n_in, out_size, ws_size, (size_t)WS_END); grid = -1; return; }
        int dev = 0, cus = 0, per_cu = 0;
        (void)hipGetDevice(&dev); (void)hipDeviceGetAttribute(&cus, hipDeviceAttributeMultiprocessorCount, dev);
        (void)hipFuncSetAttribute((const void*)mega<(MK_ONE_LAUNCH != 0)>, hipFuncAttributeMaxDynamicSharedMemorySize, LDS_BYTES);
        (void)hipOccupancyMaxActiveBlocksPerMultiprocessor(&per_cu, (const void*)mega<(MK_ONE_LAUNCH != 0)>, NT, LDS_BYTES);
        fprintf(stderr, "kernel_launch: cus %d, occupancy query %d block(s)/CU, ws %zu MiB\n", cus, per_cu, ws_size >> 20);
        (void)hipGetLastError();
        grid = cus;
        if (per_cu < 1) { fprintf(stderr, "kernel_launch: occupancy query says 0 blocks per CU\n"); }
    }
    if (grid < 0) return;
    Params p{};
    for (int i = 0; i < N_IN; ++i) p.in[i] = (const float*)d_in[i];
    p.out = (float*)d_out; p.ws = (unsigned char*)d_ws;
#if MK_ONE_LAUNCH
    p.ph_lo = 0; p.ph_hi = NPHASE;
    void* args[] = {&p};
    hipError_t e = hipLaunchCooperativeKernel((const void*)mega<true>, dim3(grid), dim3(NT), args, LDS_BYTES, stream);
    if (e != hipSuccess) fprintf(stderr, "cooperative launch failed: %s (grid %d)\n", hipGetErrorString(e), grid);
#else
    for (int ph = 0; ph < NPHASE; ++ph) { p.ph_lo = ph; p.ph_hi = ph + 1; hipLaunchKernelGGL((mega<false>), dim3(grid), dim3(NT), LDS_BYTES, stream, p); }
#endif
}
```

```cpp
#include <hip/hip_runtime.h>
#include <hip/hip_cooperative_groups.h>
#include <cstdio>
#include <cstdint>
namespace cg = cooperative_groups;
constexpr int D = 2048, MP = 8192, MS = 1024, M = MP + MS, SEQ = 2048, TS = 8, NBP = 4, NBS = 128;
constexpr int CC = 1024, CW = 31, RW = 1024, RH = 16, HD = 64;
constexpr int NRC = 3520, NRCP = 3584, NINP = 5632;
constexpr int NMEM = 256, XH = 4, XD = 512, DFF = 5632, DFF2 = 11264;
namespace pg8 {
#define PG8_LAS __attribute__((address_space(3)))
typedef unsigned short bf16_t;
typedef short bf16x8 __attribute__((ext_vector_type(8)));
typedef float f32x4 __attribute__((ext_vector_type(4)));
typedef unsigned u32x4 __attribute__((ext_vector_type(4)));
constexpr int BM = 256, BK = 64, HALF = 128, HTB = HALF * BK * 2  , STAGE_BYTES = 8 * HTB, NXCD = 8, WGM = 8;

__host__ __device__ __forceinline__ int lds_byte(int r, int c) { const int st = (r >> 4) * 2 + (c >> 5), rr = r & 15, cc = c & 31, ob = rr * 64 + cc * 2; return st * 1024 + (ob ^ (((ob >> 9) & 1) << 5)); }
__host__ __device__ __forceinline__ void stage_rc(int b, int& R, int& C) { const int st = b / 1024, sb = b % 1024, swz = sb ^ (((sb >> 9) & 1) << 5); R = (st >> 1) * 16 + swz / 64; C = (st & 1) * 32 + (swz % 64) / 2; }
__host__ __device__ __forceinline__ int perm32(int rho) { const int n = rho >> 4, i = rho & 15; return 8 * (i >> 2) + 4 * n + (i & 3); }

struct Unit { int pm, pn; };
struct Gemm { const bf16_t* A; const bf16_t* Bt; int M, N, K; };

struct StaticOrder {
    int nM, nN, nwg, G, c;
    __host__ __device__ void init(int M, int N, int G_, int c_) { nM = M / BM; nN = N / BM; nwg = nM * nN; G = G_; c = c_; }
    __host__ __device__ bool next(int i, Unit& u) const {
        const long L = (long)i * G + c; if (L >= nwg) return false;
        int wgid = (int)L; { const int q = nwg / NXCD, r = nwg % NXCD, xcd = wgid % NXCD, off = wgid / NXCD; wgid = (xcd < r ? xcd * (q + 1) : r * (q + 1) + (xcd - r) * q) + off; }
        const int nig = WGM * nN, gid = wgid / nig, fm = gid * WGM, gsz = (nM - fm) < WGM ? (nM - fm) : WGM;
        u.pm = fm + ((wgid % nig) % gsz); u.pn = (wgid % nig) / gsz; return true;
    }
    __device__ __forceinline__ void a_ready(const Unit&) const {}
    __device__ __forceinline__ void done(const Unit&) const {}
};

__device__ __forceinline__ unsigned cvt_pk_bf16(float lo, float hi) { unsigned r; asm volatile("v_cvt_pk_bf16_f32 %0, %1, %2" : "=v"(r) : "v"(lo), "v"(hi)); return r; }
typedef float f32x2 __attribute__((ext_vector_type(2)));
typedef unsigned u32x2 __attribute__((ext_vector_type(2)));
struct EpiIn {
    static constexpr bool PERM = true, AFTER_DRAIN = false;
    bf16_t* glu; bf16_t* pr; float* oconv_p; float* oconv_s; float* oshift_p; float* oshift_s;
    __device__ __forceinline__ void operator()(const f32x4 (&acc)[2][2][4][2], const Unit& u, int wr, int wc, int fr, int fq) const {
        const int row0 = u.pm * BM + wr * 64 + fr;
        if (u.pn < 8) {
#pragma unroll
            for (int ai = 0; ai < 2; ++ai)
#pragma unroll
                for (int m = 0; m < 4; ++m) {
                    const int row = row0 + ai * HALF + m * 16;
                    float* cdst = nullptr;
                    if (row < MP) { const int t = row & (SEQ - 1); if (t >= SEQ - 30) cdst = oconv_p + (size_t)((row >> 11) * 30 + (t - (SEQ - 30))) * CC; }
                    else { const int rs = row - MP; cdst = oconv_s + (size_t)((rs >> 3) * 30 + 22 + (rs & 7)) * CC; }
#pragma unroll
                    for (int bj = 0; bj < 2; ++bj) {
                        const int cgl = 16 * (8 * u.pn + 4 * bj + wc) + 4 * fq;
                        const f32x4 a = acc[ai][bj][m][0], g = acc[ai][bj][m][1];
                        f32x4 v;
#pragma unroll
                        for (int e = 0; e < 4; ++e) v[e] = a[e] / (1.0f + __expf(-g[e]));
                        u32x2 w; w.x = cvt_pk_bf16(v[0], v[1]); w.y = cvt_pk_bf16(v[2], v[3]);
                        *(u32x2*)(glu + (size_t)row * CC + cgl) = w;
                        if (cdst) *(f32x4*)(cdst + cgl) = v;
                    }
                }
        } else {
#pragma unroll
            for (int ai = 0; ai < 2; ++ai)
#pragma unroll
                for (int m = 0; m < 4; ++m) {
                    const int row = row0 + ai * HALF + m * 16;
                    float* sdst = nullptr;
                    if (row < MP) { if ((row & (SEQ - 1)) == SEQ - 1) sdst = oshift_p + (size_t)(row >> 11) * NRC; }
                    else { const int rs = row - MP; if ((rs & 7) == 7) sdst = oshift_s + (size_t)(rs >> 3) * NRC; }
#pragma unroll
                    for (int bj = 0; bj < 2; ++bj) {
                        const int jj0 = 256 * (u.pn - 8) + 128 * bj + 32 * wc + 8 * fq;
                        const f32x4 v0 = acc[ai][bj][m][0], v1 = acc[ai][bj][m][1];
                        u32x4 w; w.x = cvt_pk_bf16(v0[0], v0[1]); w.y = cvt_pk_bf16(v0[2], v0[3]); w.z = cvt_pk_bf16(v1[0], v1[1]); w.w = cvt_pk_bf16(v1[2], v1[3]);
                        *(u32x4*)(pr + (size_t)row * NRCP + jj0) = w;
                        if (sdst && jj0 < NRC) { *(f32x4*)(sdst + jj0) = v0; *(f32x4*)(sdst + jj0 + 4) = v1; }
                    }
                }
        }
    }
};
struct EpiKV {
    static constexpr bool PERM = false, AFTER_DRAIN = false;
    float* ok; float* ov; bf16_t* kb; bf16_t* vt;
    __device__ __forceinline__ void operator()(const f32x4 (&acc)[2][2][4][2], const Unit& u, int wr, int wc, int fr, int fq) const {
        const int row0 = u.pm * BM + wr * 64 + fr;
#pragma unroll
        for (int ai = 0; ai < 2; ++ai)
#pragma unroll
            for (int m = 0; m < 4; ++m) {
                const int r = row0 + ai * HALF + m * 16;
#pragma unroll
                for (int bj = 0; bj < 2; ++bj)
#pragma unroll
                    for (int n = 0; n < 2; ++n) {
                        const int c = 256 * u.pn + 128 * bj + 32 * wc + 16 * n + 4 * fq;
                        const f32x4 v = acc[ai][bj][m][n];
                        if (u.pn < 8) {
                            *(f32x4*)(ok + (size_t)r * 2048 + c) = v;
                            u32x2 w; w.x = cvt_pk_bf16(v[0], v[1]); w.y = cvt_pk_bf16(v[2], v[3]);
                            *(u32x2*)(kb + (size_t)r * 2048 + c) = w;
                        } else {
                            const int cv = c - 2048;
                            *(f32x4*)(ov + (size_t)r * 2048 + cv) = v;
                            const int b = r >> 8, key = r & 255, h = cv >> 9, d = cv & 511;
                            bf16_t* dst = vt + ((size_t)((b * 4 + h) * 512 + d)) * 256 + key;
                            const unsigned w0 = cvt_pk_bf16(v[0], v[1]), w1 = cvt_pk_bf16(v[2], v[3]);
                            dst[0] = (bf16_t)(w0 & 0xffffu); dst[256] = (bf16_t)(w0 >> 16); dst[512] = (bf16_t)(w1 & 0xffffu); dst[768] = (bf16_t)(w1 >> 16);
                        }
                    }
            }
    }
};
struct EpiF32 {
    static constexpr bool PERM = false, AFTER_DRAIN = false;
    float* C; int ldc;
    __device__ __forceinline__ void operator()(const f32x4 (&acc)[2][2][4][2], const Unit& u, int wr, int wc, int fr, int fq) const {
        const int row0 = u.pm * BM + wr * 64 + fr, col0 = u.pn * BM + wc * 32 + 4 * fq;
#pragma unroll
        for (int ai = 0; ai < 2; ++ai)
#pragma unroll
            for (int m = 0; m < 4; ++m) { float* rowp = C + (size_t)(row0 + ai * HALF + m * 16) * ldc + col0;
#pragma unroll
                for (int bj = 0; bj < 2; ++bj)
#pragma unroll
                    for (int n = 0; n < 2; ++n) *(f32x4*)(rowp + bj * HALF + n * 16) = acc[ai][bj][m][n]; }
    }
};
struct EpiBf16S {
    static constexpr bool PERM = true, AFTER_DRAIN = false;
    bf16_t* O; int ldc; float scale; float* f;
    __device__ __forceinline__ void operator()(const f32x4 (&acc)[2][2][4][2], const Unit& u, int wr, int wc, int fr, int fq) const {
        const int row0 = u.pm * BM + wr * 64 + fr, col0 = u.pn * BM + wc * 32 + 8 * fq;
#pragma unroll
        for (int ai = 0; ai < 2; ++ai)
#pragma unroll
            for (int m = 0; m < 4; ++m) {
                const int row = row0 + ai * HALF + m * 16;
                long foff = -1;
                if (f) {
                    if (row < MP) { const int t = row & (SEQ - 1); if (t >= SEQ - 2) foff = (long)((row >> 11) * 2 + (t - (SEQ - 2))) * DFF2; }
                    else { const int rs = row - MP, t = rs & 7; if (t >= 6) foff = (long)(NBP * 2 + (rs >> 3) * 2 + (t - 6)) * DFF2; }
                }
                float* fdst = f + (foff < 0 ? 0 : foff);
                bf16_t* rowp = O + (size_t)row * ldc + col0;
#pragma unroll
                for (int bj = 0; bj < 2; ++bj) {
                    const f32x4 v0 = acc[ai][bj][m][0] * scale, v1 = acc[ai][bj][m][1] * scale;
                    u32x4 w; w.x = cvt_pk_bf16(v0[0], v0[1]); w.y = cvt_pk_bf16(v0[2], v0[3]); w.z = cvt_pk_bf16(v1[0], v1[1]); w.w = cvt_pk_bf16(v1[2], v1[3]);
                    *(u32x4*)(rowp + bj * HALF) = w;
                    if (foff >= 0) { *(f32x4*)(fdst + col0 + bj * HALF) = v0; *(f32x4*)(fdst + col0 + bj * HALF + 4) = v1; }
                }
            }
    }
};

template <class Epi, class Sched, bool ALIGN_EPI = false, bool SP2 = false>
__device__ __forceinline__ void gemm_phase(PG8_LAS unsigned char* lds, const Gemm g, const Sched& S, const Epi& E) {
    int tid_ = threadIdx.x; asm volatile("" : "+v"(tid_));
    const int tid = tid_, wid = __builtin_amdgcn_readfirstlane(tid >> 6), lane = tid & 63, wr = wid >> 2, wc = wid & 3, fr = lane & 15, fq = lane >> 4;
    const int K = g.K, nt = K / BK;
    unsigned voffA[2], voffB[2];
#pragma unroll
    for (int i = 0; i < 2; ++i) { int R, C; stage_rc(tid * 16 + i * 8192, R, C); const int Rb = Epi::PERM ? ((R & ~31) + perm32(R & 31)) : R;
        voffA[i] = (unsigned)(R * K + C) * 2u; voffB[i] = (unsigned)(Rb * K + C) * 2u; }
    const size_t kstep = (size_t)(BK * 2);
    const size_t hstep = (size_t)HALF * K * 2;
    const size_t tstep = 2 * hstep;
    const unsigned ldsw = (unsigned)wid * 1024u;
    const int aoff = lds_byte(wr * 64 + fr, fq * 8), boff = lds_byte(wc * 32 + fr, fq * 8);
#define PG8_SA(b, h) (((b) * 2 + (h)) * HTB)
#define PG8_SB(b, h) ((4 + (b) * 2 + (h)) * HTB)
#define PG8_STAGE(bufoff, gbase, voff) do { _Pragma("unroll") for (int _i = 0; _i < 2; ++_i) \
        __builtin_amdgcn_global_load_lds((const unsigned*)((const char*)(gbase) + (voff)[_i]), (PG8_LAS unsigned*)(lds + (bufoff) + ldsw + _i * 8192), 16, 0, 0); } while (0)
#define PG8_LDA(dst, b, h) do { _Pragma("unroll") for (int m = 0; m < 4; ++m) _Pragma("unroll") for (int k = 0; k < 2; ++k) dst[m][k] = *(const PG8_LAS bf16x8*)(lds + PG8_SA(b, h) + aoff + m * 2048 + k * 1024); } while (0)
#define PG8_LDB(dst, b, h) do { _Pragma("unroll") for (int n = 0; n < 2; ++n) _Pragma("unroll") for (int k = 0; k < 2; ++k) dst[n][k] = *(const PG8_LAS bf16x8*)(lds + PG8_SB(b, h) + boff + n * 2048 + k * 1024); } while (0)
#define PG8_MMA(ai, bj, At, Bt) do { __builtin_amdgcn_s_setprio(1); _Pragma("unroll") for (int m = 0; m < 4; ++m) _Pragma("unroll") for (int n = 0; n < 2; ++n) _Pragma("unroll") for (int k = 0; k < 2; ++k) \
        acc[ai][bj][m][n] = __builtin_amdgcn_mfma_f32_16x16x32_bf16(Bt[n][k], At[m][k], acc[ai][bj][m][n], 0, 0, 0); __builtin_amdgcn_s_setprio(0); } while (0)
#define PG8_WAIT_V(n) asm volatile("s_waitcnt vmcnt(" #n ")" ::: "memory")
#define PG8_WAIT_L(n) asm volatile("s_waitcnt lgkmcnt(" #n ")" ::: "memory")
#define PG8_BAR __builtin_amdgcn_s_barrier()
#define PG8_SCHED __builtin_amdgcn_sched_barrier(0)
    Unit cur, nxt; int ui = 0;
    if (!S.next(0, cur)) return;
    f32x4 acc[2][2][4][2];
#pragma unroll
    for (int a = 0; a < 2; ++a)
#pragma unroll
        for (int b = 0; b < 2; ++b)
#pragma unroll
            for (int m = 0; m < 4; ++m)
#pragma unroll
                for (int n = 0; n < 2; ++n) acc[a][b][m][n] = (f32x4){0.f, 0.f, 0.f, 0.f};
    bf16x8 At[4][2], B0[2][2], B1[2][2];
    const char* cA = (const char*)g.A + (size_t)cur.pm * tstep; const char* cB = (const char*)g.Bt + (size_t)cur.pn * tstep;
    S.a_ready(cur);
    if constexpr (SP2) {
        PG8_STAGE(PG8_SB(0, 0), cB, voffB); PG8_STAGE(PG8_SB(0, 1), cB + hstep, voffB); PG8_STAGE(PG8_SA(0, 0), cA, voffA); PG8_STAGE(PG8_SA(0, 1), cA + hstep, voffA);
        if (wr == 1) PG8_BAR;
        PG8_WAIT_V(2); PG8_BAR;
        PG8_STAGE(PG8_SB(1, 0), cB + kstep, voffB); PG8_STAGE(PG8_SA(1, 0), cA + kstep, voffA); PG8_STAGE(PG8_SB(1, 1), cB + hstep + kstep, voffB);
        PG8_WAIT_V(6); PG8_BAR;
    } else {
        PG8_STAGE(PG8_SB(0, 0), cB, voffB); PG8_STAGE(PG8_SA(0, 0), cA, voffA); PG8_STAGE(PG8_SB(0, 1), cB + hstep, voffB); PG8_STAGE(PG8_SA(0, 1), cA + hstep, voffA);
        if (wr == 1) PG8_BAR;
        PG8_WAIT_V(4); PG8_BAR;
        PG8_STAGE(PG8_SB(1, 0), cB + kstep, voffB); PG8_STAGE(PG8_SA(1, 0), cA + kstep, voffA); PG8_STAGE(PG8_SB(1, 1), cB + hstep + kstep, voffB);
        PG8_WAIT_V(6); PG8_BAR;
    }
    for (;;) {
        const bool has_next = S.next(ui + 1, nxt);
        const char* nA = has_next ? (const char*)g.A + (size_t)nxt.pm * tstep : cA; const char* nB = has_next ? (const char*)g.Bt + (size_t)nxt.pn * tstep : cB;
        for (int t = 0; t < nt; t += 2) {
            const bool last = (t == nt - 2);
            const char* a1 = cA + (size_t)(t + 1) * kstep;
            const char* a2 = last ? nA : cA + (size_t)(t + 2) * kstep; const char* b2 = last ? nB : cB + (size_t)(t + 2) * kstep;
            const char* a3 = a2 + kstep; const char* b3 = b2 + kstep;
            if (last && has_next) S.a_ready(nxt);
            if constexpr (SP2) {
            PG8_LDB(B0, 0, 0); PG8_LDB(B1, 0, 1); PG8_SCHED; PG8_LDA(At, 0, 0); PG8_STAGE(PG8_SA(1, 1), a1 + hstep, voffA);
            PG8_WAIT_V(8); PG8_WAIT_L(0); PG8_BAR; PG8_MMA(0, 0, At, B0); PG8_MMA(0, 1, At, B1); PG8_BAR; PG8_SCHED;
            PG8_LDA(At, 0, 1); PG8_STAGE(PG8_SB(0, 0), b2, voffB); PG8_STAGE(PG8_SB(0, 1), b2 + hstep, voffB); PG8_STAGE(PG8_SA(0, 0), a2, voffA);
            PG8_WAIT_V(8); PG8_WAIT_L(0); PG8_BAR; PG8_MMA(1, 0, At, B0); PG8_MMA(1, 1, At, B1); PG8_BAR; PG8_SCHED;
            PG8_LDB(B0, 1, 0); PG8_LDB(B1, 1, 1); PG8_SCHED; PG8_LDA(At, 1, 0); PG8_STAGE(PG8_SA(0, 1), a2 + hstep, voffA);
            PG8_WAIT_V(8); PG8_WAIT_L(0); PG8_BAR; PG8_MMA(0, 0, At, B0); PG8_MMA(0, 1, At, B1); PG8_BAR; PG8_SCHED;
            PG8_LDA(At, 1, 1); PG8_STAGE(PG8_SB(1, 0), b3, voffB); PG8_STAGE(PG8_SB(1, 1), b3 + hstep, voffB); PG8_STAGE(PG8_SA(1, 0), a3, voffA);
            PG8_WAIT_V(8); PG8_WAIT_L(0); PG8_BAR; PG8_MMA(1, 0, At, B0); PG8_MMA(1, 1, At, B1); PG8_BAR; PG8_SCHED;
            } else {
            PG8_LDB(B0, 0, 0); PG8_SCHED; PG8_LDA(At, 0, 0); PG8_STAGE(PG8_SA(1, 1), a1 + hstep, voffA);
            PG8_WAIT_L(8); PG8_BAR; PG8_WAIT_L(0); PG8_MMA(0, 0, At, B0); PG8_BAR; PG8_SCHED;
            PG8_LDB(B1, 0, 1); PG8_STAGE(PG8_SB(0, 0), b2, voffB);
            PG8_BAR; PG8_WAIT_L(0); PG8_MMA(0, 1, At, B1); PG8_BAR;
            PG8_LDA(At, 0, 1); PG8_STAGE(PG8_SA(0, 0), a2, voffA);
            PG8_BAR; PG8_WAIT_L(0); PG8_MMA(1, 0, At, B0); PG8_BAR; PG8_SCHED;
            PG8_STAGE(PG8_SB(0, 1), b2 + hstep, voffB);
            PG8_WAIT_V(6); PG8_BAR; PG8_MMA(1, 1, At, B1); PG8_BAR;
            PG8_LDB(B0, 1, 0); PG8_SCHED; PG8_LDA(At, 1, 0); PG8_STAGE(PG8_SA(0, 1), a2 + hstep, voffA);
            PG8_WAIT_L(8); PG8_BAR; PG8_WAIT_L(0); PG8_MMA(0, 0, At, B0); PG8_BAR; PG8_SCHED;
            PG8_LDB(B1, 1, 1); PG8_STAGE(PG8_SB(1, 0), b3, voffB);
            PG8_BAR; PG8_WAIT_L(0); PG8_MMA(0, 1, At, B1); PG8_BAR;
            PG8_LDA(At, 1, 1); PG8_STAGE(PG8_SA(1, 0), a3, voffA);
            PG8_BAR; PG8_WAIT_L(0); PG8_MMA(1, 0, At, B0); PG8_BAR; PG8_SCHED;
            PG8_STAGE(PG8_SB(1, 1), b3 + hstep, voffB);
            PG8_WAIT_V(6); PG8_BAR; PG8_MMA(1, 1, At, B1); PG8_BAR;
            }
        }
        if constexpr (ALIGN_EPI) { if (wr == 0) PG8_BAR; }
        if constexpr (!Epi::AFTER_DRAIN) { E(acc, cur, wr, wc, fr, fq); S.done(cur); }
        if (!has_next) break;
#pragma unroll
        for (int a = 0; a < 2; ++a)
#pragma unroll
            for (int b = 0; b < 2; ++b)
#pragma unroll
                for (int m = 0; m < 4; ++m)
#pragma unroll
                    for (int n = 0; n < 2; ++n) acc[a][b][m][n] = (f32x4){0.f, 0.f, 0.f, 0.f};
        cur = nxt; cA = nA; cB = nB; ++ui;
        if constexpr (ALIGN_EPI) { if (wr == 1) PG8_BAR; }
    }
    PG8_WAIT_V(0);
    if constexpr (!ALIGN_EPI) { if (wr == 0) PG8_BAR; }
    PG8_BAR;
    if constexpr (Epi::AFTER_DRAIN) { E.fused(acc, cur, wr, wc, fr, fq, lds, wid, lane); S.done(cur); }
#undef PG8_SA
#undef PG8_SB
#undef PG8_STAGE
#undef PG8_LDA
#undef PG8_LDB
#undef PG8_MMA
#undef PG8_WAIT_V
#undef PG8_WAIT_L
#undef PG8_BAR
#undef PG8_SCHED
}
}
#ifndef PG8_SP2
#define PG8_SP2 true
#endif
#ifndef PG8_ALIGN
#define PG8_ALIGN true
#endif
#define LAS __attribute__((address_space(3)))
typedef unsigned short bf16;
typedef unsigned v4u __attribute__((ext_vector_type(4)));
typedef unsigned v2u __attribute__((ext_vector_type(2)));
typedef float f32x4 __attribute__((ext_vector_type(4)));
typedef float f32x2 __attribute__((ext_vector_type(2)));
typedef short bf16x8 __attribute__((ext_vector_type(8)));
constexpr int NT = 512;
constexpr int LDS_BYTES = 147456;
constexpr int NPHASE = 15;

constexpr size_t MiB = 1u << 20;
constexpr size_t WS_WIN = 1 * MiB, WS_WKV = 23 * MiB, WS_WOUT = 39 * MiB, WS_WQ = 47 * MiB, WS_WO = 55 * MiB, WS_WUP = 63 * MiB, WS_WDN = 107 * MiB;
constexpr size_t WS_LW = 129 * MiB, WS_LA = 129 * MiB + 256 * 1024, WS_LG = 129 * MiB + 512 * 1024;
constexpr size_t WS_HB = 130 * MiB, WS_MB = 166 * MiB, WS_A2 = 170 * MiB, WS_MIX = 206 * MiB, WS_X1 = 278 * MiB, WS_Q = 350 * MiB, WS_O = 386 * MiB;
constexpr size_t WS_KB = 422 * MiB, WS_VT = 426 * MiB, WS_Y = 430 * MiB, WS_G = 466 * MiB, WS_BON = 502 * MiB;
constexpr size_t WS_SHB = 818 * MiB;
constexpr size_t WS_SI = 503 * MiB, SI_STRIDE = 36 * MiB;
constexpr size_t WS_UP = 503 * MiB;
constexpr size_t WS_GLU = 719 * MiB, WS_PR = 737 * MiB;
constexpr size_t WS_ACT = 719 * MiB;
constexpr size_t WS_END = 820 * MiB;
constexpr size_t O_YP = 0, O_YS = 16777216, O_CP = 18874368, O_CS = 18997248, O_SP = 22929408, O_SS = 22943488, O_WP = 23394048, O_WS = 23656192,
                 O_FP = 32044800, O_FS = 32134912, O_MK = 35018496, O_MV = 37115648, O_END = 39212800;

enum { I_XP = 0, I_XS, I_CK, I_CV, I_SCONV, I_SSHIFT, I_SWKV, I_SFFN, I_MEM, I_NMIXPRE, I_WIN, I_CDW, I_CDWB, I_CLNG, I_CLNB, I_MU, I_W0, I_WLORA, I_A0, I_ALORA,
       I_GLORA, I_KK, I_KA, I_RK, I_LNXG, I_LNXB, I_WOUT, I_NMIXPOST, I_NXAPRE, I_NMEM, I_WQ, I_WK, I_WV, I_WO, I_NXAPOST, I_NFFNPRE, I_WUP, I_FDW, I_FDWB, I_WDOWN,
       I_NFFNPOST, N_IN };

struct Params { const float* in[N_IN]; float* out; unsigned char* ws; int ph_lo, ph_hi; };

__device__ __forceinline__ unsigned f2bf(float f) { unsigned u = __builtin_bit_cast(unsigned, f); return (u + 0x7fffu + ((u >> 16) & 1u)) >> 16; }
__device__ __forceinline__ unsigned pk2(float lo, float hi) { return f2bf(lo) | (f2bf(hi) << 16); }
__device__ __forceinline__ float bflo(unsigned u) { return __builtin_bit_cast(float, u << 16); }
__device__ __forceinline__ float bfhi(unsigned u) { return __builtin_bit_cast(float, u & 0xffff0000u); }
__device__ __forceinline__ float wave_sum(float v) {
#pragma unroll
    for (int o = 1; o < 64; o <<= 1) v += __shfl_xor(v, o);
    return v;
}
__device__ __forceinline__ float wave_max(float v) {
#pragma unroll
    for (int o = 1; o < 64; o <<= 1) v = fmaxf(v, __shfl_xor(v, o));
    return v;
}
__device__ __forceinline__ float sigm(float x) { return 1.0f / (1.0f + __expf(-x)); }
#define LDS_WAIT() asm volatile("s_waitcnt lgkmcnt(0)" ::: "memory")

typedef __attribute__((address_space(1))) unsigned gu32;
#define XB_TMO      128
#define XB_XCNT(j)  (256  + 64 * (j))
#define XB_XSUB(j)  (1280 + 64 * (j))
#define XB_XGEN(j)  (2304 + 64 * (j))
#define XB_TOP      3328
#define XB_TOPGEN   3392
#define XCD_BAR_WORDS 3456
#define XB_SPIN_CAP (1u << 18)

__device__ __forceinline__ unsigned xb_ld(unsigned* p)              { return __hip_atomic_load(p, __ATOMIC_RELAXED, __HIP_MEMORY_SCOPE_AGENT); }
__device__ __forceinline__ unsigned xb_add(unsigned* p, unsigned v) { return __hip_atomic_fetch_add(p, v, __ATOMIC_RELAXED, __HIP_MEMORY_SCOPE_AGENT); }
__device__ __forceinline__ unsigned xb_xcc_id() { return (unsigned)__builtin_amdgcn_s_getreg((3 << 11) | 20) & 0xFu; }
#define XB_SPIN(cond, bar) do { unsigned _sp = 0; while (cond) { __builtin_amdgcn_s_sleep(1); \
    if ((++_sp & 255u) == 0u) { if (xb_ld(&(bar)[XB_TMO])) break; if (_sp > XB_SPIN_CAP) { atomicAdd(&(bar)[XB_TMO], 1u); break; } } } } while (0)

struct XcdBarrier {
    unsigned* bar; unsigned x;
    volatile LAS unsigned* st;
};

__device__ __forceinline__ XcdBarrier xcd_barrier_post(unsigned* bar, volatile LAS unsigned* st) {
    XcdBarrier b; b.bar = bar; b.x = xb_xcc_id(); b.st = st;
    if (threadIdx.x == 0) (void)xb_add(&bar[XB_XCNT(b.x)], 1u);
    return b;
}
__device__ __forceinline__ void xcd_barrier_complete(unsigned* bar, unsigned x, unsigned& nloc, unsigned& nx) {
    const unsigned G = gridDim.x * gridDim.y * gridDim.z;
    unsigned sum, cnt, mine, sp = 0u;
    for (;;) {
        sum = 0u; cnt = 0u; mine = 0u;
#pragma unroll
        for (unsigned j = 0; j < 16; ++j) { const unsigned c = xb_ld(&bar[XB_XCNT(j)]); sum += c; cnt += (c > 0u) ? 1u : 0u; mine = (j == x) ? c : mine; }
        if (sum == G) break;
        __builtin_amdgcn_s_sleep(1);
        if ((++sp & 255u) == 0u) { if (xb_ld(&bar[XB_TMO])) break; if (sp > XB_SPIN_CAP) { atomicAdd(&bar[XB_TMO], 1u); break; } }
    }
    nloc = mine > 0u ? mine : 1u; nx = cnt > 0u ? cnt : 1u;
}

__device__ __forceinline__ void xcd_barrier(const XcdBarrier& b) {
    asm volatile("s_waitcnt vmcnt(0)" ::: "memory");
    __syncthreads();
    if (threadIdx.x == 0) {
        unsigned* bar = b.bar;
        __builtin_amdgcn_s_waitcnt(0);
        unsigned nloc = b.st[0], nx = b.st[1];
        if (nloc == 0u) { xcd_barrier_complete(bar, b.x, nloc, nx); b.st[0] = nloc; b.st[1] = nx; }
        const unsigned old = xb_add(&bar[XB_XSUB(b.x)], 1u);
        const unsigned gen = old / nloc;
        if (old + 1u == (gen + 1u) * nloc) {
            __builtin_amdgcn_fence(__ATOMIC_RELEASE, "agent");
            asm volatile("s_waitcnt vmcnt(0)" ::: "memory");
            const unsigned og = xb_add(&bar[XB_TOP], 1u);
            const unsigned tg = og / nx;
            if (og + 1u == (tg + 1u) * nx) xb_add(&bar[XB_TOPGEN], 1u);
            else XB_SPIN(xb_ld(&bar[XB_TOPGEN]) == tg, bar);
            __builtin_amdgcn_fence(__ATOMIC_ACQUIRE, "agent");
            xb_add(&bar[XB_XGEN(b.x)], 1u);
            asm volatile("s_waitcnt vmcnt(0)" ::: "memory");
        } else {
            XB_SPIN(xb_ld(&bar[XB_XGEN(b.x)]) == gen, bar);
            __builtin_amdgcn_fence(__ATOMIC_ACQUIRE, "agent");
            asm volatile("s_waitcnt vmcnt(0)" ::: "memory");
        }
    }
    __syncthreads();
}

constexpr int MISC_OFF = LDS_BYTES - 64;
struct Ctx { int tid, lane, wave, bid, G, gw, NGW; };
__device__ __forceinline__ unsigned char* wsbase(const Params& P) { unsigned char* w = P.ws; asm volatile("" : "+s"(w)); return w; }
__device__ __forceinline__ const float* inp(const Params& P, int i) { int z; asm volatile("s_mov_b32 %0, 0" : "=s"(z)); return P.in[i + z]; }

template <class ColMap>
__device__ __forceinline__ void transpose_item(const float* __restrict__ W, int K, int N, bf16* __restrict__ WT, LAS float* scr, int kb, int jb, int lane, ColMap cm) {
    const int k0 = 64 * kb, j0 = 32 * jb;
    const int sc = cm(j0 + (lane & 31));
#pragma unroll 8
    for (int i = 0; i < 32; ++i) { const int kk = 2 * i + (lane >> 5); scr[kk * 33 + (lane & 31)] = sc >= 0 ? W[(size_t)(k0 + kk) * N + sc] : 0.f; }
    LDS_WAIT(); asm volatile("" ::: "memory");
    const int c = lane & 7;
#pragma unroll
    for (int j = 0; j < 4; ++j) { const int n = (lane >> 3) + 8 * j; const LAS float* s = scr + (8 * c) * 33 + n;
        v4u o; o.x = pk2(s[0 * 33], s[1 * 33]); o.y = pk2(s[2 * 33], s[3 * 33]); o.z = pk2(s[4 * 33], s[5 * 33]); o.w = pk2(s[6 * 33], s[7 * 33]);
        *(v4u*)(WT + (size_t)(j0 + n) * K + k0 + 8 * c) = o; }
    LDS_WAIT(); asm volatile("" ::: "memory");
}
struct MapId { __device__ __forceinline__ int operator()(int j) const { return j; } };
struct MapIn {
    __device__ __forceinline__ int operator()(int j) const {
        if (j < 2048) { const int g = j >> 5, q = (j >> 3) & 3, n = (j >> 2) & 1, e = j & 3; return n * 1024 + 16 * g + 4 * q + e; }
        const int jj = j - 2048; return jj < NRC ? 2048 + jj : -1;
    }
};
__device__ __forceinline__ void rms_row_bf16(const float* __restrict__ xrow, const float* __restrict__ g, bf16* __restrict__ orow, int lane) {
    f32x4 v[8]; float s = 0.f;
#pragma unroll
    for (int j = 0; j < 8; ++j) { v[j] = *(const f32x4*)(xrow + 4 * (lane + 64 * j)); s += (v[j][0] * v[j][0] + v[j][1] * v[j][1]) + (v[j][2] * v[j][2] + v[j][3] * v[j][3]); }
    const float r = rsqrtf(wave_sum(s) * (1.0f / 2048.0f) + 1e-6f);
#pragma unroll
    for (int j = 0; j < 8; ++j) { const f32x4 gg = *(const f32x4*)(g + 4 * (lane + 64 * j));
        v2u o; o.x = pk2(v[j][0] * r * gg[0], v[j][1] * r * gg[1]); o.y = pk2(v[j][2] * r * gg[2], v[j][3] * r * gg[3]);
        *(v2u*)(orow + 4 * (lane + 64 * j)) = o; }
}
__device__ __forceinline__ void p0_prologue(const Params& P, const Ctx& C, LAS unsigned char* lds) {
    unsigned char* ws = wsbase(P);
    LAS float* scr = (LAS float*)(lds + C.wave * 16384);
    constexpr int I_IN = 32 * 176, I_SQ = 32 * 64, I_UP = 32 * 352, I_DN = 88 * 64;
    constexpr int NITEMS = I_IN + 5 * I_SQ + I_UP + I_DN;
    for (int it = C.gw; it < NITEMS; it += C.NGW) {
        int r = it;
        if (r < I_IN) { transpose_item(inp(P, I_WIN), 2048, 5568, (bf16*)(ws + WS_WIN), scr, r / 176, r % 176, C.lane, MapIn()); continue; } r -= I_IN;
        if (r < I_SQ) { transpose_item(inp(P, I_WK), 2048, 2048, (bf16*)(ws + WS_WKV), scr, r / 64, r % 64, C.lane, MapId()); continue; } r -= I_SQ;
        if (r < I_SQ) { transpose_item(inp(P, I_WV), 2048, 2048, (bf16*)(ws + WS_WKV) + (size_t)2048 * 2048, scr, r / 64, r % 64, C.lane, MapId()); continue; } r -= I_SQ;
        if (r < I_SQ) { transpose_item(inp(P, I_WOUT), 2048, 2048, (bf16*)(ws + WS_WOUT), scr, r / 64, r % 64, C.lane, MapId()); continue; } r -= I_SQ;
        if (r < I_SQ) { transpose_item(inp(P, I_WQ), 2048, 2048, (bf16*)(ws + WS_WQ), scr, r / 64, r % 64, C.lane, MapId()); continue; } r -= I_SQ;
        if (r < I_SQ) { transpose_item(inp(P, I_WO), 2048, 2048, (bf16*)(ws + WS_WO), scr, r / 64, r % 64, C.lane, MapId()); continue; } r -= I_SQ;
        if (r < I_UP) { transpose_item(inp(P, I_WUP), 2048, 11264, (bf16*)(ws + WS_WUP), scr, r / 352, r % 352, C.lane, MapId()); continue; } r -= I_UP;
        transpose_item(inp(P, I_WDOWN), 5632, 2048, (bf16*)(ws + WS_WDN), scr, r / 64, r % 64, C.lane, MapId());
    }
    const int gt = C.bid * NT + C.tid, ngt = C.G * NT;
    { bf16* d = (bf16*)(ws + WS_LW); const float* s = inp(P, I_WLORA); for (int i = gt; i < 1024 * 96; i += ngt) { const int n = i / 96, k = i - n * 96; d[i] = (bf16)f2bf(s[k * 1024 + n]); } }
    { bf16* d = (bf16*)(ws + WS_LA); const float* s = inp(P, I_ALORA); for (int i = gt; i < 1024 * 96; i += ngt) { const int n = i / 96, k = i - n * 96; d[i] = (bf16)f2bf(s[k * 1024 + n]); } }
    { bf16* d = (bf16*)(ws + WS_LG); const float* s = inp(P, I_GLORA); for (int i = gt; i < 1024 * 256; i += ngt) { const int n = i >> 8, k = i & 255; d[i] = (bf16)f2bf(s[k * 1024 + n]); } }
    for (int m = C.gw; m < M + 1024; m += C.NGW) {
        if (m < M) { const float* xr = m < MP ? inp(P, I_XP) + (size_t)m * D : inp(P, I_XS) + (size_t)(m - MP) * D; rms_row_bf16(xr, inp(P, I_NMIXPRE), (bf16*)(ws + WS_HB) + (size_t)m * D, C.lane); }
        else { const int r = m - M; rms_row_bf16(inp(P, I_MEM) + (size_t)r * D, inp(P, I_NMEM), (bf16*)(ws + WS_MB) + (size_t)r * D, C.lane); }
    }
    { bf16* d = (bf16*)(ws + WS_SHB); const float* sp = inp(P, I_SSHIFT);
      for (int i = gt; i < (NBS + 1) * NRCP; i += ngt) { const int b = i / NRCP, c = i - b * NRCP; d[i] = (b < NBS && c < NRC) ? (bf16)f2bf(sp[(size_t)b * NRC + c]) : (bf16)0; } }
    { const f32x4* s = (const f32x4*)inp(P, I_SCONV); f32x4* d = (f32x4*)(P.out + O_CS);
      for (int i = gt; i < NBS * 22 * 256; i += ngt) { const int b = i / (22 * 256), r = i - b * (22 * 256); d[(size_t)b * 30 * 256 + r] = s[(size_t)b * 30 * 256 + 8 * 256 + r]; } }
}

template <int R>
__device__ __forceinline__ void conv_task(const Params& P, const Ctx& C, LAS unsigned char* lds, int grow0  , int t0  , int sb  ) {
    unsigned char* ws = wsbase(P);
    const bf16* glu = (const bf16*)(ws + WS_GLU);
    LAS unsigned* st = (LAS unsigned*)lds;
    LAS float* red = (LAS float*)(lds + 98304);
    constexpr int NR = R + 30;
    const float* sconv = inp(P, I_SCONV); const float* cdw = inp(P, I_CDW);
    for (int p = C.tid; p < NR * 128; p += NT) {
        const int rr = p >> 7, ch = p & 127; const int t = t0 - 30 + rr;
        v4u v = (v4u){0u, 0u, 0u, 0u};
        if (t >= 0) v = *(const v4u*)(glu + (size_t)(grow0 - 30 + rr) * CC + ch * 8);
        else if (sb >= 0) { const float* s = sconv + ((size_t)sb * 30 + rr) * CC + ch * 8;
            const f32x4 a = *(const f32x4*)s, b = *(const f32x4*)(s + 4); v.x = pk2(a[0], a[1]); v.y = pk2(a[2], a[3]); v.z = pk2(b[0], b[1]); v.w = pk2(b[2], b[3]); }
        *(LAS v4u*)(st + rr * 512 + ch * 4) = v;
    }
    const int c = 2 * C.tid;
    f32x2 w[31];
#pragma unroll
    for (int j = 0; j < 31; ++j) w[j] = *(const f32x2*)(cdw + j * CC + c);
    const f32x2 bias = *(const f32x2*)(inp(P, I_CDWB) + c);
    f32x2 acc[R];
#pragma unroll
    for (int r = 0; r < R; ++r) acc[r] = bias;
    __syncthreads();
#pragma unroll
    for (int rr = 0; rr < NR; ++rr) {
        if ((rr & 3) == 0) asm volatile("" ::: "memory");
        const unsigned u = st[rr * 512 + C.tid]; const float x0 = bflo(u), x1 = bfhi(u);
#pragma unroll
        for (int r = 0; r < R; ++r) { const int j = rr - r; if (j >= 0 && j < 31) { acc[r][0] += x0 * w[j][0]; acc[r][1] += x1 * w[j][1]; } }
    }
    float s[R];
#pragma unroll
    for (int r = 0; r < R; ++r) s[r] = wave_sum(acc[r][0] + acc[r][1]);
    if (C.lane == 0) {
#pragma unroll
        for (int r = 0; r < R; ++r) red[C.wave * 16 + r] = s[r]; }
    __syncthreads();
    float mean[R];
#pragma unroll
    for (int r = 0; r < R; ++r) { float t = 0.f;
#pragma unroll
        for (int wv = 0; wv < 8; ++wv) t += red[wv * 16 + r];
        mean[r] = t * (1.0f / 1024.0f); }
    __syncthreads();
#pragma unroll
    for (int r = 0; r < R; ++r) { const float d0 = acc[r][0] - mean[r], d1 = acc[r][1] - mean[r]; acc[r][0] = d0; acc[r][1] = d1; s[r] = wave_sum(d0 * d0 + d1 * d1); }
    if (C.lane == 0) {
#pragma unroll
        for (int r = 0; r < R; ++r) red[C.wave * 16 + r] = s[r]; }
    __syncthreads();
    const f32x2 lg = *(const f32x2*)(inp(P, I_CLNG) + c), lb = *(const f32x2*)(inp(P, I_CLNB) + c);
    bf16* a2 = (bf16*)(ws + WS_A2);
#pragma unroll
    for (int r = 0; r < R; ++r) { float t = 0.f;
#pragma unroll
        for (int wv = 0; wv < 8; ++wv) t += red[wv * 16 + r];
        const float rstd = rsqrtf(t * (1.0f / 1024.0f) + 1e-5f);
        float y0 = acc[r][0] * rstd * lg[0] + lb[0], y1 = acc[r][1] * rstd * lg[1] + lb[1];
        y0 = y0 * sigm(y0); y1 = y1 * sigm(y1);
        *(unsigned*)(a2 + (size_t)(grow0 + r) * D + c) = pk2(y0, y1); }
    __syncthreads();
}

#define XS8(col_, xs_) do { const v4u cu_ = *(const v4u*)(curp + (col_)); const v4u pu_ = *(const v4u*)(prvp + (col_)); \
        const f32x4 m0_ = *(const f32x4*)(mup + (col_)), m1_ = *(const f32x4*)(mup + (col_) + 4); float c_, p_; \
        c_ = bflo(cu_.x); p_ = bflo(pu_.x); xs_[0] = c_ + (p_ - c_) * m0_[0]; c_ = bfhi(cu_.x); p_ = bfhi(pu_.x); xs_[1] = c_ + (p_ - c_) * m0_[1]; \
        c_ = bflo(cu_.y); p_ = bflo(pu_.y); xs_[2] = c_ + (p_ - c_) * m0_[2]; c_ = bfhi(cu_.y); p_ = bfhi(pu_.y); xs_[3] = c_ + (p_ - c_) * m0_[3]; \
        c_ = bflo(cu_.z); p_ = bflo(pu_.z); xs_[4] = c_ + (p_ - c_) * m1_[0]; c_ = bfhi(cu_.z); p_ = bfhi(pu_.z); xs_[5] = c_ + (p_ - c_) * m1_[1]; \
        c_ = bflo(cu_.w); p_ = bflo(pu_.w); xs_[6] = c_ + (p_ - c_) * m1_[2]; c_ = bfhi(cu_.w); p_ = bfhi(pu_.w); xs_[7] = c_ + (p_ - c_) * m1_[3]; } while (0)
#define XS4(col_, xs_) do { const v2u cu_ = *(const v2u*)(curp + (col_)); const v2u pu_ = *(const v2u*)(prvp + (col_)); const f32x4 m0_ = *(const f32x4*)(mup + (col_)); float c_, p_; \
        c_ = bflo(cu_.x); p_ = bflo(pu_.x); xs_[0] = c_ + (p_ - c_) * m0_[0]; c_ = bfhi(cu_.x); p_ = bfhi(pu_.x); xs_[1] = c_ + (p_ - c_) * m0_[1]; \
        c_ = bflo(cu_.y); p_ = bflo(pu_.y); xs_[2] = c_ + (p_ - c_) * m0_[2]; c_ = bfhi(cu_.y); p_ = bfhi(pu_.y); xs_[3] = c_ + (p_ - c_) * m0_[3]; } while (0)
__device__ __forceinline__ bf16x8 pack8(const float (&x)[8]) {
    v4u o; o.x = pk2(x[0], x[1]); o.y = pk2(x[2], x[3]); o.z = pk2(x[4], x[5]); o.w = pk2(x[6], x[7]);
    return __builtin_bit_cast(bf16x8, o);
}
__device__ __forceinline__ float tanh_fast(float x) { return 1.0f - 2.0f / (1.0f + __expf(2.0f * x)); }
__device__ __forceinline__ void prep_wave(const Params& P, int rowbase, int h, int lane) {
    const int fr = lane & 15, fq = lane >> 4, row = rowbase + fr;
    unsigned char* ws = wsbase(P);
    const bf16* curp = (const bf16*)(ws + WS_PR) + (size_t)row * NRCP;
    const bf16* prvp = curp - NRCP;
    if (row < MP) { if ((row & (SEQ - 1)) == 0) prvp = (const bf16*)(ws + WS_SHB) + (size_t)NBS * NRCP; }
    else { const int rs = row - MP; if ((rs & 7) == 0) prvp = (const bf16*)(ws + WS_SHB) + (size_t)(rs >> 3) * NRCP; }
    const float* mup = inp(P, I_MU); const float* pkk = inp(P, I_KK); const float* pa0 = inp(P, I_A0); const float* pw0 = inp(P, I_W0); const float* pka = inp(P, I_KA); const float* prk = inp(P, I_RK);
    const bf16* lw = (const bf16*)(ws + WS_LW); const bf16* la = (const bf16*)(ws + WS_LA); const bf16* lg = (const bf16*)(ws + WS_LG);
    const f32x4 z4 = (f32x4){0.f, 0.f, 0.f, 0.f};
    f32x4 accW[4] = {z4, z4, z4, z4}, accA[4] = {z4, z4, z4, z4}, accG[4] = {z4, z4, z4, z4};
    {   bf16x8 A[3];
#pragma unroll
        for (int s = 0; s < 3; ++s) { float xs[8]; XS8(3072 + 32 * s + 8 * fq, xs);
#pragma unroll
            for (int e = 0; e < 8; ++e) xs[e] = tanh_fast(xs[e]);
            A[s] = pack8(xs); }
#pragma unroll
        for (int nt = 0; nt < 4; ++nt)
#pragma unroll
            for (int s = 0; s < 3; ++s) { if (s == 0) asm volatile("" ::: "memory"); const bf16x8 b = *(const bf16x8*)(lw + (size_t)(h * 64 + 16 * nt + fr) * 96 + 32 * s + 8 * fq); accW[nt] = __builtin_amdgcn_mfma_f32_16x16x32_bf16(b, A[s], accW[nt], 0, 0, 0); }
    }
    {   bf16x8 A[3];
#pragma unroll
        for (int s = 0; s < 3; ++s) { float xs[8]; XS8(3168 + 32 * s + 8 * fq, xs); A[s] = pack8(xs); }
#pragma unroll
        for (int nt = 0; nt < 4; ++nt)
#pragma unroll
            for (int s = 0; s < 3; ++s) { if (s == 0) asm volatile("" ::: "memory"); const bf16x8 b = *(const bf16x8*)(la + (size_t)(h * 64 + 16 * nt + fr) * 96 + 32 * s + 8 * fq); accA[nt] = __builtin_amdgcn_mfma_f32_16x16x32_bf16(b, A[s], accA[nt], 0, 0, 0); }
    }
    {   bf16x8 A[8];
#pragma unroll
        for (int s = 0; s < 8; ++s) { float xs[8]; XS8(3264 + 32 * s + 8 * fq, xs);
#pragma unroll
            for (int e = 0; e < 8; ++e) xs[e] = sigm(xs[e]);
            A[s] = pack8(xs); }
#pragma unroll
        for (int nt = 0; nt < 4; ++nt)
#pragma unroll
            for (int s = 0; s < 8; ++s) { if (s == 0) asm volatile("" ::: "memory"); const bf16x8 b = *(const bf16x8*)(lg + (size_t)(h * 64 + 16 * nt + fr) * 256 + 32 * s + 8 * fq); accG[nt] = __builtin_amdgcn_mfma_f32_16x16x32_bf16(b, A[s], accG[nt], 0, 0, 0); }
    }
    float xk[4][4];
    float ss = 0.f;
#pragma unroll
    for (int nt = 0; nt < 4; ++nt) {
        const int c = h * 64 + 16 * nt + 4 * fq;
        XS4(1024 + c, xk[nt]);
        const f32x4 kkw = *(const f32x4*)(pkk + c);
#pragma unroll
        for (int e = 0; e < 4; ++e) { const float t = xk[nt][e] * kkw[e]; ss += t * t; }
    }
    ss += __shfl_xor(ss, 16); ss += __shfl_xor(ss, 32);
    const float inv = 1.0f / fmaxf(sqrtf(ss), 1e-12f);
    float bon = 0.f;
    float* SI = (float*)(ws + WS_SI); constexpr size_t SS = SI_STRIDE / 4;
#pragma unroll
    for (int nt = 0; nt < 4; ++nt) {
        const int c = h * 64 + 16 * nt + 4 * fq; const size_t o = (size_t)row * RW + c;
        asm volatile("" ::: "memory");
        float xr[4], xv[4];
        XS4(c, xr); XS4(2048 + c, xv);
        const f32x4 w0 = *(const f32x4*)(pw0 + c), ka = *(const f32x4*)(pka + c), rk = *(const f32x4*)(prk + c);
        const f32x4 kkw = *(const f32x4*)(pkk + c), a0 = *(const f32x4*)(pa0 + c);
        f32x4 vr, vw, vk, vv, va, vb;
#pragma unroll
        for (int e = 0; e < 4; ++e) {
            const float ee = 0.6065306597126334f * sigm(w0[e] + accW[nt][e]);
            vw[e] = __expf(-ee);
            const float a = sigm(a0[e] + accA[nt][e]);
            const float kn = xk[nt][e] * kkw[e] * inv;
            const float k2 = xk[nt][e] * (1.0f + (a - 1.0f) * ka[e]);
            vr[e] = xr[e]; vk[e] = k2; vv[e] = xv[e]; va[e] = -kn; vb[e] = kn * a;
            bon += xr[e] * k2 * rk[e];
        }
        *(f32x4*)(SI + 0 * SS + o) = vr; *(f32x4*)(SI + 1 * SS + o) = vw; *(f32x4*)(SI + 2 * SS + o) = vk;
        *(f32x4*)(SI + 3 * SS + o) = vv; *(f32x4*)(SI + 4 * SS + o) = va; *(f32x4*)(SI + 5 * SS + o) = vb;
        *(f32x4*)((float*)(ws + WS_G) + o) = accG[nt];
    }
    bon += __shfl_xor(bon, 16); bon += __shfl_xor(bon, 32);
    if (fq == 0) ((float*)(ws + WS_BON))[(size_t)row * RH + h] = bon;
}

constexpr int TC = 32, STEPF = 5 * 64 + 16, STEPQ = STEPF / 4, CHUNKQ = TC * STEPQ;
template <int CTRL> __device__ __forceinline__ float dppf(float x) { return __builtin_bit_cast(float, __builtin_amdgcn_update_dpp(0, __builtin_bit_cast(int, x), CTRL, 0xF, 0xF, true)); }
__device__ __forceinline__ float allred16(float x) {
    x += dppf<0xB1>(x);
    x += dppf<0x4E>(x);
    x += dppf<0x141>(x);
    x += dppf<0x140>(x);
    return x;
}
#define SCAN_BAR() do { asm volatile("s_waitcnt lgkmcnt(0)" ::: "memory"); __builtin_amdgcn_s_barrier(); asm volatile("" ::: "memory"); } while (0)
#define SCAN_STEP(S01, S23, r4, w4, k4, a4, b4, v, yout) do { \
        f32x2 p2 = S01 * (f32x2){a4[0], a4[1]}; p2 = S23 * (f32x2){a4[2], a4[3]} + p2; \
        const float sa = allred16(p2[0] + p2[1]); const f32x2 sa2 = (f32x2){sa, sa}, v2 = (f32x2){v, v}; \
        f32x2 t01 = v2 * (f32x2){k4[0], k4[1]}, t23 = v2 * (f32x2){k4[2], k4[3]}; \
        t01 = sa2 * (f32x2){b4[0], b4[1]} + t01; t23 = sa2 * (f32x2){b4[2], b4[3]} + t23; \
        S01 = S01 * (f32x2){w4[0], w4[1]} + t01; S23 = S23 * (f32x2){w4[2], w4[3]} + t23; \
        f32x2 q2 = S01 * (f32x2){r4[0], r4[1]}; q2 = S23 * (f32x2){r4[2], r4[3]} + q2; \
        yout = allred16(q2[0] + q2[1]); } while (0)
__device__ __forceinline__ void scan_prompt(const Params& P, const Ctx& C, LAS unsigned char* lds, int chain, int rb) {
    unsigned char* ws = wsbase(P);
    const float* SI = (const float*)(ws + WS_SI); constexpr size_t SS = SI_STRIDE / 4;
    const int b = chain >> 4, h = chain & 15, m0 = b * SEQ;
    LAS float* buf = (LAS float*)lds;
    constexpr int NCH = SEQ / TC;
    if (C.wave >= 4) {
        const int ht = C.tid - 256;
        f32x4 stg[11];
#define SCAN_HLOAD(ck_) do { _Pragma("unroll") for (int q = 0; q < 11; ++q) { const int i4 = ht + q * 256; if (i4 < CHUNKQ) { const int t = i4 / STEPQ, o4 = i4 - t * STEPQ; \
            const size_t rowo = (size_t)(m0 + (ck_) * TC + t) * RW + h * 64; const float* src; \
            if (o4 < 80) { const int vec = o4 >> 4; const int arr = vec < 3 ? vec : vec + 1; src = SI + arr * SS + rowo + 4 * (o4 & 15); } \
            else src = SI + 3 * SS + rowo + rb * 16 + 4 * (o4 - 80); \
            stg[q] = *(const f32x4*)src; } } } while (0)
#define SCAN_HWRITE(ck_) do { LAS f32x4* dst = (LAS f32x4*)(buf + ((ck_) & 1) * (TC * STEPF)); _Pragma("unroll") for (int q = 0; q < 11; ++q) { const int i4 = ht + q * 256; if (i4 < CHUNKQ) dst[i4] = stg[q]; } } while (0)
        SCAN_HLOAD(0); SCAN_HWRITE(0); SCAN_HLOAD(1);
        SCAN_BAR();
        for (int ck = 0; ck < NCH; ++ck) {
            if (ck + 1 < NCH) SCAN_HWRITE(ck + 1);
            if (ck + 2 < NCH) SCAN_HLOAD(ck + 2);
            SCAN_BAR();
        }
#undef SCAN_HLOAD
#undef SCAN_HWRITE
    } else {
        float* Y = (float*)(ws + WS_Y);
        const int rowl = C.lane >> 4, cl = C.lane & 15, irow = rb * 16 + C.wave * 4 + rowl;
        f32x2 S01 = (f32x2){0.f, 0.f}, S23 = (f32x2){0.f, 0.f};
        float yk = 0.f;
        SCAN_BAR();
        for (int ck = 0; ck < NCH; ++ck) {
            const LAS float* cb = buf + (ck & 1) * (TC * STEPF);
            f32x4 r4 = *(const LAS f32x4*)(cb + 0 * 64 + 4 * cl), w4 = *(const LAS f32x4*)(cb + 1 * 64 + 4 * cl), k4 = *(const LAS f32x4*)(cb + 2 * 64 + 4 * cl);
            f32x4 a4 = *(const LAS f32x4*)(cb + 3 * 64 + 4 * cl), b4 = *(const LAS f32x4*)(cb + 4 * 64 + 4 * cl); float v = cb[320 + C.wave * 4 + rowl];
#pragma unroll 4
            for (int t = 0; t < TC; ++t) {
                const LAS float* nb = cb + (t + 1 < TC ? t + 1 : t) * STEPF;
                const f32x4 nr = *(const LAS f32x4*)(nb + 0 * 64 + 4 * cl), nw = *(const LAS f32x4*)(nb + 1 * 64 + 4 * cl), nk = *(const LAS f32x4*)(nb + 2 * 64 + 4 * cl);
                const f32x4 na = *(const LAS f32x4*)(nb + 3 * 64 + 4 * cl), nbb = *(const LAS f32x4*)(nb + 4 * 64 + 4 * cl); const float nv = nb[320 + C.wave * 4 + rowl];
                float y; SCAN_STEP(S01, S23, r4, w4, k4, a4, b4, v, y);
                yk = (cl == (t & 15)) ? y : yk;
                if ((t & 15) == 15) Y[(size_t)(m0 + ck * TC + (t & ~15) + cl) * RW + h * 64 + irow] = yk;
                r4 = nr; w4 = nw; k4 = nk; a4 = na; b4 = nbb; v = nv;
            }
            SCAN_BAR();
        }
        float* so = P.out + O_WP + ((size_t)chain * 64 + irow) * 64 + 4 * cl;
        *(f32x4*)so = (f32x4){S01[0], S01[1], S23[0], S23[1]};
    }
    __syncthreads();
}
__device__ __forceinline__ void scan_sample(const Params& P, const Ctx& C, const float* swkv, int chain, int half) {
    unsigned char* ws = wsbase(P);
    const float* SI = (const float*)(ws + WS_SI); constexpr size_t SS = SI_STRIDE / 4;
    float* Y = (float*)(ws + WS_Y);
    const int b = chain >> 4, h = chain & 15, m0 = MP + 8 * b;
    const int rowl = C.lane >> 4, cl = C.lane & 15, irow = half * 32 + C.wave * 4 + rowl;
    const f32x4 s4 = *(const f32x4*)(swkv + ((size_t)chain * 64 + irow) * 64 + 4 * cl);
    f32x2 S01 = (f32x2){s4[0], s4[1]}, S23 = (f32x2){s4[2], s4[3]};
    float yk = 0.f;
#pragma unroll
    for (int t = 0; t < 8; ++t) {
        const size_t rowo = (size_t)(m0 + t) * RW + h * 64;
        const f32x4 r4 = *(const f32x4*)(SI + 0 * SS + rowo + 4 * cl), w4 = *(const f32x4*)(SI + 1 * SS + rowo + 4 * cl), k4 = *(const f32x4*)(SI + 2 * SS + rowo + 4 * cl);
        const f32x4 a4 = *(const f32x4*)(SI + 4 * SS + rowo + 4 * cl), b4 = *(const f32x4*)(SI + 5 * SS + rowo + 4 * cl); const float v = SI[3 * SS + rowo + irow];
        float y; SCAN_STEP(S01, S23, r4, w4, k4, a4, b4, v, y);
        yk = (cl == t) ? y : yk;
    }
    if (cl < 8) Y[(size_t)(m0 + cl) * RW + h * 64 + irow] = yk;
    *(f32x4*)(P.out + O_WS + ((size_t)chain * 64 + irow) * 64 + 4 * cl) = (f32x4){S01[0], S01[1], S23[0], S23[1]};
}

__device__ __forceinline__ void post_row(const Params& P, int row, int lane) {
    unsigned char* ws = wsbase(P);
    const float* Y = (const float*)(ws + WS_Y) + (size_t)row * RW + 16 * lane;
    const float* V = (const float*)(ws + WS_SI) + 3 * (SI_STRIDE / 4) + (size_t)row * RW + 16 * lane;
    const float* G = (const float*)(ws + WS_G) + (size_t)row * RW + 16 * lane;
    const float bon = ((const float*)(ws + WS_BON))[(size_t)row * RH + (lane >> 2)];
    float y[16], s = 0.f;
#pragma unroll
    for (int q = 0; q < 4; ++q) { const f32x4 t = *(const f32x4*)(Y + 4 * q); y[4 * q] = t[0]; y[4 * q + 1] = t[1]; y[4 * q + 2] = t[2]; y[4 * q + 3] = t[3]; s += (t[0] + t[1]) + (t[2] + t[3]); }
    s += __shfl_xor(s, 1); s += __shfl_xor(s, 2);
    const float mu = s * (1.0f / 64.0f); float q2 = 0.f;
#pragma unroll
    for (int e = 0; e < 16; ++e) { y[e] -= mu; q2 += y[e] * y[e]; }
    q2 += __shfl_xor(q2, 1); q2 += __shfl_xor(q2, 2);
    const float rstd = rsqrtf(q2 * (1.0f / 64.0f) + 64e-5f);
    const float* lg = inp(P, I_LNXG) + 16 * lane; const float* lb = inp(P, I_LNXB) + 16 * lane;
    unsigned o[8];
#pragma unroll
    for (int q = 0; q < 4; ++q) { const f32x4 g4 = *(const f32x4*)(lg + 4 * q), b4 = *(const f32x4*)(lb + 4 * q), v4 = *(const f32x4*)(V + 4 * q), gg = *(const f32x4*)(G + 4 * q);
        float r[4];
#pragma unroll
        for (int e = 0; e < 4; ++e) r[e] = (y[4 * q + e] * rstd * g4[e] + b4[e] + bon * v4[e]) * gg[e];
        o[2 * q] = pk2(r[0], r[1]); o[2 * q + 1] = pk2(r[2], r[3]); }
    bf16* dst = (bf16*)(ws + WS_A2) + (size_t)row * D + 1024 + 16 * lane;
    *(v4u*)dst = (v4u){o[0], o[1], o[2], o[3]}; *(v4u*)(dst + 8) = (v4u){o[4], o[5], o[6], o[7]};
}

__device__ __forceinline__ void rowpass(const float* xa, const float* __restrict__ mix, const float* __restrict__ g1, float* xo,
                                        const float* __restrict__ g2, bf16* __restrict__ hb, int lane) {
    f32x4 mv[8]; float s = 0.f;
#pragma unroll
    for (int j = 0; j < 8; ++j) { mv[j] = *(const f32x4*)(mix + 4 * (lane + 64 * j)); s += (mv[j][0] * mv[j][0] + mv[j][1] * mv[j][1]) + (mv[j][2] * mv[j][2] + mv[j][3] * mv[j][3]); }
    const float r = rsqrtf(wave_sum(s) * (1.0f / 2048.0f) + 1e-6f);
    float s2 = 0.f;
#pragma unroll
    for (int j = 0; j < 8; ++j) { const f32x4 a = *(const f32x4*)(xa + 4 * (lane + 64 * j)), gg = *(const f32x4*)(g1 + 4 * (lane + 64 * j));
        mv[j] = a + mv[j] * r * gg; *(f32x4*)(xo + 4 * (lane + 64 * j)) = mv[j];
        s2 += (mv[j][0] * mv[j][0] + mv[j][1] * mv[j][1]) + (mv[j][2] * mv[j][2] + mv[j][3] * mv[j][3]); }
    if (hb) {
        const float r2 = rsqrtf(wave_sum(s2) * (1.0f / 2048.0f) + 1e-6f);
#pragma unroll
        for (int j = 0; j < 8; ++j) { const f32x4 gg = *(const f32x4*)(g2 + 4 * (lane + 64 * j));
            v2u o; o.x = pk2(mv[j][0] * r2 * gg[0], mv[j][1] * r2 * gg[1]); o.y = pk2(mv[j][2] * r2 * gg[2], mv[j][3] * r2 * gg[3]);
            *(v2u*)(hb + 4 * (lane + 64 * j)) = o; }
    }
}
__device__ __forceinline__ void attn_prompt_task(const Params& P, const Ctx& C, LAS unsigned char* lds, int b, int h, int qt) {
    unsigned char* ws = wsbase(P);
    const bf16* Qg = (const bf16*)(ws + WS_Q); const bf16* Kg = (const bf16*)(ws + WS_KB); const bf16* VTg = (const bf16*)(ws + WS_VT);
    bf16* Og = (bf16*)(ws + WS_O);
    const int fr = C.lane & 15, fq = C.lane >> 4;
    const int qrow = b * SEQ + qt * 128 + C.wave * 16 + fr;
    constexpr int BUFB = 33792;
    bf16x8 Qf[16];
#pragma unroll
    for (int s = 0; s < 16; ++s) Qf[s] = *(const bf16x8*)(Qg + (size_t)qrow * D + h * XD + 32 * s + 8 * fq);
    f32x4 accS[16];
#pragma unroll
    for (int nt = 0; nt < 16; ++nt) accS[nt] = (f32x4){0.f, 0.f, 0.f, 0.f};
    v4u stg[4];
#define ATT_GLOAD(c_) do { if ((c_) < 8) { _Pragma("unroll") for (int i = 0; i < 4; ++i) { const int idx = C.tid + i * NT, key = idx >> 3, ch = idx & 7; \
            stg[i] = *(const v4u*)(Kg + (size_t)(b * NMEM + key) * D + h * XD + (c_) * 64 + ch * 8); } } \
        else { _Pragma("unroll") for (int i = 0; i < 4; ++i) { const int idx = C.tid + i * NT, dd = idx >> 5, ch = idx & 31; \
            stg[i] = *(const v4u*)(VTg + ((size_t)((b * XH + h) * XD + ((c_) - 8) * 64 + dd)) * NMEM + ch * 8); } } } while (0)
#define ATT_SWRITE(c_) do { LAS unsigned char* sbuf = lds + ((c_) & 1) * BUFB; if ((c_) < 8) { _Pragma("unroll") for (int i = 0; i < 4; ++i) { const int idx = C.tid + i * NT, key = idx >> 3, ch = idx & 7; \
            *(LAS v4u*)(sbuf + key * 128 + ((ch ^ (key & 7)) * 16)) = stg[i]; } } \
        else { _Pragma("unroll") for (int i = 0; i < 4; ++i) { const int idx = C.tid + i * NT, dd = idx >> 5, ch = idx & 31; \
            *(LAS v4u*)(sbuf + dd * 528 + ch * 16) = stg[i]; } } } while (0)
    ATT_GLOAD(0); ATT_SWRITE(0); __syncthreads();
    bf16x8 Pf[8];
#pragma unroll
    for (int c = 0; c < 8; ++c) {
        ATT_GLOAD(c + 1);
        const LAS unsigned char* sbuf = lds + (c & 1) * BUFB;
#pragma unroll
        for (int ss = 0; ss < 2; ++ss)
#pragma unroll
            for (int nt = 0; nt < 16; ++nt) {
                const int key = 16 * nt + fr, ch = ss * 4 + fq;
                const bf16x8 kf = *(const LAS bf16x8*)(sbuf + key * 128 + ((ch ^ (key & 7)) * 16));
                accS[nt] = __builtin_amdgcn_mfma_f32_16x16x32_bf16(kf, Qf[2 * c + ss], accS[nt], 0, 0, 0);
            }
        if (c == 7) {
            float mx = -3.0e38f;
#pragma unroll
            for (int nt = 0; nt < 16; ++nt) mx = fmaxf(mx, fmaxf(fmaxf(accS[nt][0], accS[nt][1]), fmaxf(accS[nt][2], accS[nt][3])));
            mx = fmaxf(mx, __shfl_xor(mx, 16)); mx = fmaxf(mx, __shfl_xor(mx, 32));
            float sum = 0.f;
#pragma unroll
            for (int nt = 0; nt < 16; ++nt) {
#pragma unroll
                for (int e = 0; e < 4; ++e) { const float p = exp2f(accS[nt][e] - mx); accS[nt][e] = p; sum += p; } }
            sum += __shfl_xor(sum, 16); sum += __shfl_xor(sum, 32);
            const float inv = 1.0f / sum;
#pragma unroll
            for (int s = 0; s < 8; ++s) { v4u o; o.x = pk2(accS[2 * s][0] * inv, accS[2 * s][1] * inv); o.y = pk2(accS[2 * s][2] * inv, accS[2 * s][3] * inv);
                o.z = pk2(accS[2 * s + 1][0] * inv, accS[2 * s + 1][1] * inv); o.w = pk2(accS[2 * s + 1][2] * inv, accS[2 * s + 1][3] * inv); Pf[s] = __builtin_bit_cast(bf16x8, o); }
        }
        ATT_SWRITE(c + 1);
        __syncthreads();
    }
    for (int c = 8; c < 16; ++c) {
        if (c + 1 < 16) ATT_GLOAD(c + 1);
        const LAS unsigned char* sbuf = lds + (c & 1) * BUFB;
        const int dv = c - 8;
        f32x4 accO[4];
#pragma unroll
        for (int nd = 0; nd < 4; ++nd) accO[nd] = (f32x4){0.f, 0.f, 0.f, 0.f};
#pragma unroll
        for (int s = 0; s < 8; ++s)
#pragma unroll
            for (int nd = 0; nd < 4; ++nd) {
                const LAS unsigned char* rp = sbuf + (nd * 16 + fr) * 528 + (32 * s + 4 * fq) * 2;
                const v2u lo = *(const LAS v2u*)rp, hi = *(const LAS v2u*)(rp + 32);
                const bf16x8 vf = __builtin_bit_cast(bf16x8, ((v4u){lo.x, lo.y, hi.x, hi.y}));
                accO[nd] = __builtin_amdgcn_mfma_f32_16x16x32_bf16(vf, Pf[s], accO[nd], 0, 0, 0);
            }
#pragma unroll
        for (int nd = 0; nd < 4; ++nd) { v2u o; o.x = pk2(accO[nd][0], accO[nd][1]); o.y = pk2(accO[nd][2], accO[nd][3]);
            *(v2u*)(Og + (size_t)qrow * D + h * XD + dv * 64 + nd * 16 + 4 * fq) = o; }
        if (c + 1 < 16) ATT_SWRITE(c + 1);
        __syncthreads();
    }
#undef ATT_GLOAD
#undef ATT_SWRITE
}
__device__ __forceinline__ void attn_sample_task(const Params& P, const Ctx& C, LAS unsigned char* lds, int b, int h) {
    unsigned char* ws = wsbase(P);
    const bf16* Qg = (const bf16*)(ws + WS_Q); bf16* Og = (bf16*)(ws + WS_O);
    const float* CK = inp(P, I_CK); const float* CV = inp(P, I_CV);
    LAS float* sS = (LAS float*)lds;
    LAS float* sP = (LAS float*)(lds + 8192);
    const int row0 = MP + 8 * b;
    float qv[8][8];
#pragma unroll
    for (int q = 0; q < 8; ++q) { const bf16* qp = Qg + (size_t)(row0 + q) * D + h * XD;
        const v2u a = *(const v2u*)(qp + 4 * C.lane), c2 = *(const v2u*)(qp + 256 + 4 * C.lane);
        qv[q][0] = bflo(a.x); qv[q][1] = bfhi(a.x); qv[q][2] = bflo(a.y); qv[q][3] = bfhi(a.y); qv[q][4] = bflo(c2.x); qv[q][5] = bfhi(c2.x); qv[q][6] = bflo(c2.y); qv[q][7] = bfhi(c2.y); }
    for (int k0 = 0; k0 < 32; k0 += 4) {
        f32x4 ka[4], kb2[4];
#pragma unroll
        for (int u = 0; u < 4; ++u) { const float* kp = CK + ((size_t)(b * NMEM + C.wave * 32 + k0 + u) * XH + h) * XD; ka[u] = *(const f32x4*)(kp + 4 * C.lane); kb2[u] = *(const f32x4*)(kp + 256 + 4 * C.lane); }
#pragma unroll
        for (int u = 0; u < 4; ++u) {
            float part[8];
#pragma unroll
            for (int q = 0; q < 8; ++q) part[q] = (qv[q][0] * ka[u][0] + qv[q][1] * ka[u][1]) + (qv[q][2] * ka[u][2] + qv[q][3] * ka[u][3]) + (qv[q][4] * kb2[u][0] + qv[q][5] * kb2[u][1]) + (qv[q][6] * kb2[u][2] + qv[q][7] * kb2[u][3]);
#pragma unroll
            for (int q = 0; q < 8; ++q) part[q] = wave_sum(part[q]);
            if (C.lane == 0) {
#pragma unroll
                for (int q = 0; q < 8; ++q) sS[q * 256 + C.wave * 32 + k0 + u] = part[q]; }
        }
    }
    __syncthreads();
    {
        const int q = C.wave; const f32x4 s4 = *(const LAS f32x4*)(sS + q * 256 + 4 * C.lane);
        const float mx = wave_max(fmaxf(fmaxf(s4[0], s4[1]), fmaxf(s4[2], s4[3])));
        const float p0 = exp2f(s4[0] - mx), p1 = exp2f(s4[1] - mx), p2 = exp2f(s4[2] - mx), p3 = exp2f(s4[3] - mx);
        const float inv = 1.0f / wave_sum((p0 + p1) + (p2 + p3));
        sP[(4 * C.lane + 0) * 8 + q] = p0 * inv; sP[(4 * C.lane + 1) * 8 + q] = p1 * inv; sP[(4 * C.lane + 2) * 8 + q] = p2 * inv; sP[(4 * C.lane + 3) * 8 + q] = p3 * inv;
    }
    __syncthreads();
    float acc[8];
#pragma unroll
    for (int q = 0; q < 8; ++q) acc[q] = 0.f;
    const int d = C.wave * 64 + C.lane;
    for (int k0 = 0; k0 < 256; k0 += 8) {
        float vv[8];
#pragma unroll
        for (int u = 0; u < 8; ++u) vv[u] = CV[((size_t)(b * NMEM + k0 + u) * XH + h) * XD + d];
#pragma unroll
        for (int u = 0; u < 8; ++u) { const f32x4 pa = *(const LAS f32x4*)(sP + (k0 + u) * 8), pb = *(const LAS f32x4*)(sP + (k0 + u) * 8 + 4);
            acc[0] += pa[0] * vv[u]; acc[1] += pa[1] * vv[u]; acc[2] += pa[2] * vv[u]; acc[3] += pa[3] * vv[u];
            acc[4] += pb[0] * vv[u]; acc[5] += pb[1] * vv[u]; acc[6] += pb[2] * vv[u]; acc[7] += pb[3] * vv[u]; }
    }
#pragma unroll
    for (int q = 0; q < 8; ++q) Og[(size_t)(row0 + q) * D + h * XD + d] = (bf16)f2bf(acc[q]);
    __syncthreads();
}

__device__ __forceinline__ void ffn_conv_act(const Params& P, const Ctx& C) {
    unsigned char* ws = wsbase(P);
    const bf16* UP = (const bf16*)(ws + WS_UP); bf16* ACT = (bf16*)(ws + WS_ACT);
    const float* FW = inp(P, I_FDW); const float* FB = inp(P, I_FDWB); const float* SF = inp(P, I_SFFN);
    constexpr int NG = DFF / 8;
    const long total = (long)M * NG;
    for (long it = (long)C.bid * NT + C.tid; it < total; it += (long)C.G * NT) {
        const int row = (int)(it / NG), cg8 = (int)(it - (long)row * NG) * 8;
        int t, sb = -1; if (row < MP) t = row & (SEQ - 1); else { const int rs = row - MP; t = rs & 7; sb = rs >> 3; }
        float res[2][8];
#pragma unroll
        for (int half = 0; half < 2; ++half) {
            const int c = half * DFF + cg8;
            float x[3][8];
#pragma unroll
            for (int j = 0; j < 3; ++j) {
                const int tt = t - 2 + j;
                if (tt >= 0) { const v4u u = *(const v4u*)(UP + (size_t)(row - 2 + j) * DFF2 + c);
                    x[j][0] = bflo(u.x); x[j][1] = bfhi(u.x); x[j][2] = bflo(u.y); x[j][3] = bfhi(u.y); x[j][4] = bflo(u.z); x[j][5] = bfhi(u.z); x[j][6] = bflo(u.w); x[j][7] = bfhi(u.w); }
                else if (sb >= 0) { const float* s = SF + ((size_t)sb * 2 + (tt + 2)) * DFF2 + c; const f32x4 a = *(const f32x4*)s, b2 = *(const f32x4*)(s + 4);
                    x[j][0] = a[0]; x[j][1] = a[1]; x[j][2] = a[2]; x[j][3] = a[3]; x[j][4] = b2[0]; x[j][5] = b2[1]; x[j][6] = b2[2]; x[j][7] = b2[3]; }
                else {
#pragma unroll
                    for (int e = 0; e < 8; ++e) x[j][e] = 0.f; }
            }
#pragma unroll
            for (int e = 0; e < 8; ++e) res[half][e] = FB[c + e] + FW[c + e] * x[0][e] + FW[DFF2 + c + e] * x[1][e] + FW[2 * DFF2 + c + e] * x[2][e];
        }
        v4u o;
        float a[8];
#pragma unroll
        for (int e = 0; e < 8; ++e) a[e] = res[0][e] * sigm(res[0][e]) * res[1][e];
        o.x = pk2(a[0], a[1]); o.y = pk2(a[2], a[3]); o.z = pk2(a[4], a[5]); o.w = pk2(a[6], a[7]);
        *(v4u*)(ACT + (size_t)row * DFF + cg8) = o;
    }
}

template <bool COOP>
__global__ void __launch_bounds__(NT, 2) mega(Params P) {
    extern __shared__ __attribute__((aligned(16))) unsigned char lds_raw[];
    LAS unsigned char* lds = (LAS unsigned char*)lds_raw;
    Ctx C0; C0.tid = threadIdx.x; C0.lane = C0.tid & 63; C0.wave = __builtin_amdgcn_readfirstlane(C0.tid >> 6); C0.bid = blockIdx.x; C0.G = gridDim.x;
    C0.gw = C0.bid * 8 + C0.wave; C0.NGW = C0.G * 8;
    const int lo = P.ph_lo, hi = P.ph_hi;
    if (threadIdx.x < 4) ((LAS unsigned*)(lds + MISC_OFF))[threadIdx.x] = 0u;
    __syncthreads();
    XcdBarrier xbar; xbar.bar = nullptr; xbar.x = 0; xbar.st = nullptr;
    if constexpr (COOP) xbar = xcd_barrier_post((unsigned*)P.ws, (volatile LAS unsigned*)(lds + MISC_OFF));
#ifndef MK_ONLY
#define MK_ONLY -1
#endif
#define IN(k) ((MK_ONLY < 0 || MK_ONLY == (k)) && lo <= (k) && (k) < hi)
#define PH_CTX() Ctx C = C0; unsigned char* ws = wsbase(P); (void)ws; asm volatile("" : "+v"(C.tid), "+v"(C.lane), "+s"(C.wave), "+s"(C.gw), "+s"(C.bid))
#ifndef MK_REPMASK
#define MK_REPMASK 0
#endif
#define NREP(k) (((MK_REPMASK >> (k)) & 1) ? 2 : 1)
#define SEAM(k) do { if constexpr (COOP) { if (IN(k) && IN((k) + 1)) { if ((k) == 0) cg::this_grid().sync(); else xcd_barrier(xbar); } } } while (0)

    for (int rep_ = 0; rep_ < NREP(0); ++rep_) if (IN(0)) { PH_CTX(); p0_prologue(P, C, lds); __syncthreads(); }
    SEAM(0);
    for (int rep_ = 0; rep_ < NREP(1); ++rep_) if (IN(1)) { PH_CTX();
        { pg8::Gemm g{(const pg8::bf16_t*)(ws + WS_HB), (const pg8::bf16_t*)(ws + WS_WIN), M, NINP, D}; pg8::StaticOrder S; S.init(M, NINP, C.G, C.bid);
          pg8::EpiIn E{(pg8::bf16_t*)(ws + WS_GLU), (pg8::bf16_t*)(ws + WS_PR), P.out + O_CP, P.out + O_CS, P.out + O_SP, P.out + O_SS};
          pg8::gemm_phase<pg8::EpiIn, pg8::StaticOrder, PG8_ALIGN, PG8_SP2>(lds, g, S, E); }
        { pg8::Gemm g{(const pg8::bf16_t*)(ws + WS_MB), (const pg8::bf16_t*)(ws + WS_WKV), 1024, 4096, D}; pg8::StaticOrder S; S.init(1024, 4096, C.G, (C.bid + C.G - 24) % C.G);
          pg8::EpiKV E{P.out + O_MK, P.out + O_MV, (pg8::bf16_t*)(ws + WS_KB), (pg8::bf16_t*)(ws + WS_VT)};
          pg8::gemm_phase<pg8::EpiKV, pg8::StaticOrder, PG8_ALIGN, PG8_SP2>(lds, g, S, E); }
    }
    SEAM(1);
    for (int rep_ = 0; rep_ < NREP(2); ++rep_) if (IN(2)) { PH_CTX();
        for (int tk = C.bid; tk < 640; tk += C.G) {
            if (tk < 512) { const int b = tk >> 7, r0 = (tk & 127) * 16; conv_task<16>(P, C, lds, b * SEQ + r0, r0, -1); }
            else { const int sb = tk - 512; conv_task<8>(P, C, lds, MP + 8 * sb, 0, sb); }
        }
        for (int tk = C.bid; tk < 1152; tk += C.G) { const int rg = tk >> 2, hg = tk & 3; prep_wave(P, rg * 32 + (C.wave >> 2) * 16, hg * 4 + (C.wave & 3), C.lane); }
    }
    SEAM(2);
    for (int rep_ = 0; rep_ < NREP(3); ++rep_) if (IN(3)) { PH_CTX();
        const float* swkv = inp(P, I_SWKV);
        for (int tk = C.bid; tk < 256; tk += C.G) scan_prompt(P, C, lds, tk >> 2, tk & 3);
        for (int tk = C.bid; tk < 4096; tk += C.G) scan_sample(P, C, swkv, tk >> 1, tk & 1);
    }
    SEAM(3);
    for (int rep_ = 0; rep_ < NREP(4); ++rep_) if (IN(4)) { PH_CTX(); for (int m = C.gw; m < M; m += C.NGW) post_row(P, m, C.lane); }
    SEAM(4);
    for (int rep_ = 0; rep_ < NREP(5); ++rep_) if (IN(5)) { PH_CTX(); pg8::Gemm g{(const pg8::bf16_t*)(ws + WS_A2), (const pg8::bf16_t*)(ws + WS_WOUT), M, D, D}; pg8::StaticOrder S; S.init(M, D, C.G, C.bid);
        pg8::EpiF32 E{(float*)(ws + WS_MIX), D}; pg8::gemm_phase<pg8::EpiF32, pg8::StaticOrder, PG8_ALIGN, PG8_SP2>(lds, g, S, E); }
    SEAM(5);
    for (int rep_ = 0; rep_ < NREP(6); ++rep_) if (IN(6)) { PH_CTX(); const float* xp = inp(P, I_XP); const float* xs = inp(P, I_XS); const float* g1 = inp(P, I_NMIXPOST); const float* g2 = inp(P, I_NXAPRE);
        for (int m = C.gw; m < M; m += C.NGW) { const float* xr = m < MP ? xp + (size_t)m * D : xs + (size_t)(m - MP) * D;
        rowpass(xr, (const float*)(ws + WS_MIX) + (size_t)m * D, g1, (float*)(ws + WS_X1) + (size_t)m * D, g2, (bf16*)(ws + WS_HB) + (size_t)m * D, C.lane); } }
    SEAM(6);
    for (int rep_ = 0; rep_ < NREP(7); ++rep_) if (IN(7)) { PH_CTX(); pg8::Gemm g{(const pg8::bf16_t*)(ws + WS_HB), (const pg8::bf16_t*)(ws + WS_WQ), M, D, D}; pg8::StaticOrder S; S.init(M, D, C.G, C.bid);
        pg8::EpiBf16S E{(pg8::bf16_t*)(ws + WS_Q), D, 0.06375871479f  , nullptr};
        pg8::gemm_phase<pg8::EpiBf16S, pg8::StaticOrder, PG8_ALIGN, PG8_SP2>(lds, g, S, E); }
    SEAM(7);
    for (int rep_ = 0; rep_ < NREP(8); ++rep_) if (IN(8)) { PH_CTX();
        for (int tk = C.bid; tk < 256; tk += C.G) attn_prompt_task(P, C, lds, tk >> 6, (tk >> 4) & 3, tk & 15);
        for (int tk = C.bid; tk < 512; tk += C.G) attn_sample_task(P, C, lds, tk >> 2, tk & 3);
    }
    SEAM(8);
    for (int rep_ = 0; rep_ < NREP(9); ++rep_) if (IN(9)) { PH_CTX(); pg8::Gemm g{(const pg8::bf16_t*)(ws + WS_O), (const pg8::bf16_t*)(ws + WS_WO), M, D, D}; pg8::StaticOrder S; S.init(M, D, C.G, C.bid);
        pg8::EpiF32 E{(float*)(ws + WS_MIX), D}; pg8::gemm_phase<pg8::EpiF32, pg8::StaticOrder, PG8_ALIGN, PG8_SP2>(lds, g, S, E); }
    SEAM(9);
    for (int rep_ = 0; rep_ < NREP(10); ++rep_) if (IN(10)) { PH_CTX(); const float* g1 = inp(P, I_NXAPOST); const float* g2 = inp(P, I_NFFNPRE);
        for (int m = C.gw; m < M; m += C.NGW) { float* x1 = (float*)(ws + WS_X1) + (size_t)m * D;
        rowpass(x1, (const float*)(ws + WS_MIX) + (size_t)m * D, g1, x1, g2, (bf16*)(ws + WS_HB) + (size_t)m * D, C.lane); } }
    SEAM(10);
    for (int rep_ = 0; rep_ < NREP(11); ++rep_) if (IN(11)) { PH_CTX(); pg8::Gemm g{(const pg8::bf16_t*)(ws + WS_HB), (const pg8::bf16_t*)(ws + WS_WUP), M, DFF2, D}; pg8::StaticOrder S; S.init(M, DFF2, C.G, C.bid);
        pg8::EpiBf16S E{(pg8::bf16_t*)(ws + WS_UP), DFF2, 1.0f, P.out + O_FP};
        pg8::gemm_phase<pg8::EpiBf16S, pg8::StaticOrder, PG8_ALIGN, PG8_SP2>(lds, g, S, E); }
    SEAM(11);
    for (int rep_ = 0; rep_ < NREP(12); ++rep_) if (IN(12)) { PH_CTX(); ffn_conv_act(P, C); }
    SEAM(12);
    for (int rep_ = 0; rep_ < NREP(13); ++rep_) if (IN(13)) { PH_CTX(); pg8::Gemm g{(const pg8::bf16_t*)(ws + WS_ACT), (const pg8::bf16_t*)(ws + WS_WDN), M, D, DFF}; pg8::StaticOrder S; S.init(M, D, C.G, C.bid);
        pg8::EpiF32 E{(float*)(ws + WS_MIX), D}; pg8::gemm_phase<pg8::EpiF32, pg8::StaticOrder, PG8_ALIGN, PG8_SP2>(lds, g, S, E); }
    SEAM(13);
    for (int rep_ = 0; rep_ < NREP(14); ++rep_) if (IN(14)) { PH_CTX(); const float* g1 = inp(P, I_NFFNPOST);
        for (int m = C.gw; m < M; m += C.NGW) { const float* x2 = (const float*)(ws + WS_X1) + (size_t)m * D;
        float* yo = m < MP ? P.out + O_YP + (size_t)m * D : P.out + O_YS + (size_t)(m - MP) * D;
        rowpass(x2, (const float*)(ws + WS_MIX) + (size_t)m * D, g1, yo, nullptr, nullptr, C.lane); } }
#undef IN
#undef SEAM
}

#ifndef MK_ONE_LAUNCH
#define MK_ONE_LAUNCH 1
#endif
extern "C" void kernel_launch(void* const* d_in, const int* in_sizes, int n_in, void* d_out, int out_size, void* d_ws, size_t ws_size, hipStream_t stream) {
    static int grid = 0;
    if (grid == 0) {
        if (n_in != N_IN || (size_t)out_size != O_END || ws_size < WS_END) { fprintf(stderr, "kernel_launch: unexpected sizes: n_in %d out %d ws %zu (need %zu)\n", n_in, out_size, ws_size, (size_t)WS_END); grid = -1; return; }
        int dev = 0, cus = 0, per_cu = 0;
        (void)hipGetDevice(&dev); (void)hipDeviceGetAttribute(&cus, hipDeviceAttributeMultiprocessorCount, dev);
        (void)hipFuncSetAttribute((const void*)mega<(MK_ONE_LAUNCH != 0)>, hipFuncAttributeMaxDynamicSharedMemorySize, LDS_BYTES);
        (void)hipOccupancyMaxActiveBlocksPerMultiprocessor(&per_cu, (const void*)mega<(MK_ONE_LAUNCH != 0)>, NT, LDS_BYTES);
        fprintf(stderr, "kernel_launch: cus %d, occupancy query %d block(s)/CU, ws %zu MiB\n", cus, per_cu, ws_size >> 20);
        (void)hipGetLastError();
        grid = cus;
        if (per_cu < 1) { fprintf(stderr, "kernel_launch: occupancy query says 0 blocks per CU\n"); }
    }
    if (grid < 0) return;
    if (hipMemsetAsync(d_ws, 0, 16384, stream) != hipSuccess) { fprintf(stderr, "kernel_launch: hipMemsetAsync failed\n"); return; }
    Params p{};
    for (int i = 0; i < N_IN; ++i) p.in[i] = (const float*)d_in[i];
    p.out = (float*)d_out; p.ws = (unsigned char*)d_ws;
#if MK_ONE_LAUNCH
    p.ph_lo = 0; p.ph_hi = NPHASE;
    void* args[] = {&p};
    hipError_t e = hipLaunchCooperativeKernel((const void*)mega<true>, dim3(grid), dim3(NT), args, LDS_BYTES, stream);
    if (e != hipSuccess) fprintf(stderr, "cooperative launch failed: %s (grid %d)\n", hipGetErrorString(e), grid);
#else
    for (int ph = 0; ph < NPHASE; ++ph) { p.ph_lo = ph; p.ph_hi = ph + 1; hipLaunchKernelGGL((mega<false>), dim3(grid), dim3(NT), LDS_BYTES, stream, p); }
#endif
}
```

```cpp
#include <hip/hip_runtime.h>
#include <hip/hip_cooperative_groups.h>
#include <cstdio>
#include <cstdint>
namespace cg = cooperative_groups;
constexpr int D = 2048, MP = 8192, MS = 1024, M = MP + MS, SEQ = 2048, TS = 8, NBP = 4, NBS = 128;
constexpr int CC = 1024, CW = 31, RW = 1024, RH = 16, HD = 64;
constexpr int NRC = 3520, NRCP = 3584, NINP = 5632;
constexpr int NMEM = 256, XH = 4, XD = 512, DFF = 5632, DFF2 = 11264;
namespace pg8 {
#define PG8_LAS __attribute__((address_space(3)))
typedef unsigned short bf16_t;
typedef short bf16x8 __attribute__((ext_vector_type(8)));
typedef float f32x4 __attribute__((ext_vector_type(4)));
typedef unsigned u32x4 __attribute__((ext_vector_type(4)));
constexpr int BM = 256, BK = 64, HALF = 128, HTB = HALF * BK * 2  , STAGE_BYTES = 8 * HTB, NXCD = 8, WGM = 8;

__host__ __device__ __forceinline__ int lds_byte(int r, int c) { const int st = (r >> 4) * 2 + (c >> 5), rr = r & 15, cc = c & 31, ob = rr * 64 + cc * 2; return st * 1024 + (ob ^ (((ob >> 9) & 1) << 5)); }
__host__ __device__ __forceinline__ void stage_rc(int b, int& R, int& C) { const int st = b / 1024, sb = b % 1024, swz = sb ^ (((sb >> 9) & 1) << 5); R = (st >> 1) * 16 + swz / 64; C = (st & 1) * 32 + (swz % 64) / 2; }
__host__ __device__ __forceinline__ int perm32(int rho) { const int n = rho >> 4, i = rho & 15; return 8 * (i >> 2) + 4 * n + (i & 3); }

struct Unit { int pm, pn; };
struct Gemm { const bf16_t* A; const bf16_t* Bt; int M, N, K; };

struct StaticOrder {
    int nM, nN, nwg, G, c;
    __host__ __device__ void init(int M, int N, int G_, int c_) { nM = M / BM; nN = N / BM; nwg = nM * nN; G = G_; c = c_; }
    __host__ __device__ bool next(int i, Unit& u) const {
        const long L = (long)i * G + c; if (L >= nwg) return false;
        int wgid = (int)L; { const int q = nwg / NXCD, r = nwg % NXCD, xcd = wgid % NXCD, off = wgid / NXCD; wgid = (xcd < r ? xcd * (q + 1) : r * (q + 1) + (xcd - r) * q) + off; }
        const int nig = WGM * nN, gid = wgid / nig, fm = gid * WGM, gsz = (nM - fm) < WGM ? (nM - fm) : WGM;
        u.pm = fm + ((wgid % nig) % gsz); u.pn = (wgid % nig) / gsz; return true;
    }
    __device__ __forceinline__ void a_ready(const Unit&) const {}
    __device__ __forceinline__ void done(const Unit&) const {}
};

__device__ __forceinline__ unsigned cvt_pk_bf16(float lo, float hi) { unsigned r; asm volatile("v_cvt_pk_bf16_f32 %0, %1, %2" : "=v"(r) : "v"(lo), "v"(hi)); return r; }
typedef float f32x2 __attribute__((ext_vector_type(2)));
typedef unsigned u32x2 __attribute__((ext_vector_type(2)));
struct EpiIn {
    static constexpr bool PERM = true, AFTER_DRAIN = false;
    bf16_t* glu; bf16_t* pr; float* oconv_p; float* oconv_s; float* oshift_p; float* oshift_s;
    __device__ __forceinline__ void operator()(const f32x4 (&acc)[2][2][4][2], const Unit& u, int wr, int wc, int fr, int fq) const {
        const int row0 = u.pm * BM + wr * 64 + fr;
        if (u.pn < 8) {
#pragma unroll
            for (int ai = 0; ai < 2; ++ai)
#pragma unroll
                for (int m = 0; m < 4; ++m) {
                    const int row = row0 + ai * HALF + m * 16;
                    float* cdst = nullptr;
                    if (row < MP) { const int t = row & (SEQ - 1); if (t >= SEQ - 30) cdst = oconv_p + (size_t)((row >> 11) * 30 + (t - (SEQ - 30))) * CC; }
                    else { const int rs = row - MP; cdst = oconv_s + (size_t)((rs >> 3) * 30 + 22 + (rs & 7)) * CC; }
#pragma unroll
                    for (int bj = 0; bj < 2; ++bj) {
                        const int cgl = 16 * (8 * u.pn + 4 * bj + wc) + 4 * fq;
                        const f32x4 a = acc[ai][bj][m][0], g = acc[ai][bj][m][1];
                        f32x4 v;
#pragma unroll
                        for (int e = 0; e < 4; ++e) v[e] = a[e] / (1.0f + __expf(-g[e]));
                        u32x2 w; w.x = cvt_pk_bf16(v[0], v[1]); w.y = cvt_pk_bf16(v[2], v[3]);
                        *(u32x2*)(glu + (size_t)row * CC + cgl) = w;
                        if (cdst) *(f32x4*)(cdst + cgl) = v;
                    }
                }
        } else {
#pragma unroll
            for (int ai = 0; ai < 2; ++ai)
#pragma unroll
                for (int m = 0; m < 4; ++m) {
                    const int row = row0 + ai * HALF + m * 16;
                    float* sdst = nullptr;
                    if (row < MP) { if ((row & (SEQ - 1)) == SEQ - 1) sdst = oshift_p + (size_t)(row >> 11) * NRC; }
                    else { const int rs = row - MP; if ((rs & 7) == 7) sdst = oshift_s + (size_t)(rs >> 3) * NRC; }
#pragma unroll
                    for (int bj = 0; bj < 2; ++bj) {
                        const int jj0 = 256 * (u.pn - 8) + 128 * bj + 32 * wc + 8 * fq;
                        const f32x4 v0 = acc[ai][bj][m][0], v1 = acc[ai][bj][m][1];
                        u32x4 w; w.x = cvt_pk_bf16(v0[0], v0[1]); w.y = cvt_pk_bf16(v0[2], v0[3]); w.z = cvt_pk_bf16(v1[0], v1[1]); w.w = cvt_pk_bf16(v1[2], v1[3]);
                        *(u32x4*)(pr + (size_t)row * NRCP + jj0) = w;
                        if (sdst && jj0 < NRC) { *(f32x4*)(sdst + jj0) = v0; *(f32x4*)(sdst + jj0 + 4) = v1; }
                    }
                }
        }
    }
};
struct EpiKV {
    static constexpr bool PERM = false, AFTER_DRAIN = false;
    float* ok; float* ov; bf16_t* kb; bf16_t* vt;
    __device__ __forceinline__ void operator()(const f32x4 (&acc)[2][2][4][2], const Unit& u, int wr, int wc, int fr, int fq) const {
        const int row0 = u.pm * BM + wr * 64 + fr;
#pragma unroll
        for (int ai = 0; ai < 2; ++ai)
#pragma unroll
            for (int m = 0; m < 4; ++m) {
                const int r = row0 + ai * HALF + m * 16;
#pragma unroll
                for (int bj = 0; bj < 2; ++bj)
#pragma unroll
                    for (int n = 0; n < 2; ++n) {
                        const int c = 256 * u.pn + 128 * bj + 32 * wc + 16 * n + 4 * fq;
                        const f32x4 v = acc[ai][bj][m][n];
                        if (u.pn < 8) {
                            *(f32x4*)(ok + (size_t)r * 2048 + c) = v;
                            u32x2 w; w.x = cvt_pk_bf16(v[0], v[1]); w.y = cvt_pk_bf16(v[2], v[3]);
                            *(u32x2*)(kb + (size_t)r * 2048 + c) = w;
                        } else {
                            const int cv = c - 2048;
                            *(f32x4*)(ov + (size_t)r * 2048 + cv) = v;
                            const int b = r >> 8, key = r & 255, h = cv >> 9, d = cv & 511;
                            bf16_t* dst = vt + ((size_t)((b * 4 + h) * 512 + d)) * 256 + key;
                            const unsigned w0 = cvt_pk_bf16(v[0], v[1]), w1 = cvt_pk_bf16(v[2], v[3]);
                            dst[0] = (bf16_t)(w0 & 0xffffu); dst[256] = (bf16_t)(w0 >> 16); dst[512] = (bf16_t)(w1 & 0xffffu); dst[768] = (bf16_t)(w1 >> 16);
                        }
                    }
            }
    }
};
struct EpiF32 {
    static constexpr bool PERM = false, AFTER_DRAIN = false;
    float* C; int ldc;
    __device__ __forceinline__ void operator()(const f32x4 (&acc)[2][2][4][2], const Unit& u, int wr, int wc, int fr, int fq) const {
        const int row0 = u.pm * BM + wr * 64 + fr, col0 = u.pn * BM + wc * 32 + 4 * fq;
#pragma unroll
        for (int ai = 0; ai < 2; ++ai)
#pragma unroll
            for (int m = 0; m < 4; ++m) { float* rowp = C + (size_t)(row0 + ai * HALF + m * 16) * ldc + col0;
#pragma unroll
                for (int bj = 0; bj < 2; ++bj)
#pragma unroll
                    for (int n = 0; n < 2; ++n) *(f32x4*)(rowp + bj * HALF + n * 16) = acc[ai][bj][m][n]; }
    }
};
struct EpiBf16S {
    static constexpr bool PERM = true, AFTER_DRAIN = false;
    bf16_t* O; int ldc; float scale; float* f;
    __device__ __forceinline__ void operator()(const f32x4 (&acc)[2][2][4][2], const Unit& u, int wr, int wc, int fr, int fq) const {
        const int row0 = u.pm * BM + wr * 64 + fr, col0 = u.pn * BM + wc * 32 + 8 * fq;
#pragma unroll
        for (int ai = 0; ai < 2; ++ai)
#pragma unroll
            for (int m = 0; m < 4; ++m) {
                const int row = row0 + ai * HALF + m * 16;
                long foff = -1;
                if (f) {
                    if (row < MP) { const int t = row & (SEQ - 1); if (t >= SEQ - 2) foff = (long)((row >> 11) * 2 + (t - (SEQ - 2))) * DFF2; }
                    else { const int rs = row - MP, t = rs & 7; if (t >= 6) foff = (long)(NBP * 2 + (rs >> 3) * 2 + (t - 6)) * DFF2; }
                }
                float* fdst = f + (foff < 0 ? 0 : foff);
                bf16_t* rowp = O + (size_t)row * ldc + col0;
#pragma unroll
                for (int bj = 0; bj < 2; ++bj) {
                    const f32x4 v0 = acc[ai][bj][m][0] * scale, v1 = acc[ai][bj][m][1] * scale;
                    u32x4 w; w.x = cvt_pk_bf16(v0[0], v0[1]); w.y = cvt_pk_bf16(v0[2], v0[3]); w.z = cvt_pk_bf16(v1[0], v1[1]); w.w = cvt_pk_bf16(v1[2], v1[3]);
                    *(u32x4*)(rowp + bj * HALF) = w;
                    if (foff >= 0) { *(f32x4*)(fdst + col0 + bj * HALF) = v0; *(f32x4*)(fdst + col0 + bj * HALF + 4) = v1; }
                }
            }
    }
};

template <class Epi, class Sched, bool ALIGN_EPI = false, bool SP2 = false>
__device__ __forceinline__ void gemm_phase(PG8_LAS unsigned char* lds, const Gemm g, const Sched& S, const Epi& E) {
    int tid_ = threadIdx.x; asm volatile("" : "+v"(tid_));
    const int tid = tid_, wid = __builtin_amdgcn_readfirstlane(tid >> 6), lane = tid & 63, wr = wid >> 2, wc = wid & 3, fr = lane & 15, fq = lane >> 4;
    const int K = g.K, nt = K / BK;
    unsigned voffA[2], voffB[2];
#pragma unroll
    for (int i = 0; i < 2; ++i) { int R, C; stage_rc(tid * 16 + i * 8192, R, C); const int Rb = Epi::PERM ? ((R & ~31) + perm32(R & 31)) : R;
        voffA[i] = (unsigned)(R * K + C) * 2u; voffB[i] = (unsigned)(Rb * K + C) * 2u; }
    const size_t kstep = (size_t)(BK * 2);
    const size_t hstep = (size_t)HALF * K * 2;
    const size_t tstep = 2 * hstep;
    const unsigned ldsw = (unsigned)wid * 1024u;
    const int aoff = lds_byte(wr * 64 + fr, fq * 8), boff = lds_byte(wc * 32 + fr, fq * 8);
#define PG8_SA(b, h) (((b) * 2 + (h)) * HTB)
#define PG8_SB(b, h) ((4 + (b) * 2 + (h)) * HTB)
#define PG8_STAGE(bufoff, gbase, voff) do { _Pragma("unroll") for (int _i = 0; _i < 2; ++_i) \
        __builtin_amdgcn_global_load_lds((const unsigned*)((const char*)(gbase) + (voff)[_i]), (PG8_LAS unsigned*)(lds + (bufoff) + ldsw + _i * 8192), 16, 0, 0); } while (0)
#define PG8_LDA(dst, b, h) do { _Pragma("unroll") for (int m = 0; m < 4; ++m) _Pragma("unroll") for (int k = 0; k < 2; ++k) dst[m][k] = *(const PG8_LAS bf16x8*)(lds + PG8_SA(b, h) + aoff + m * 2048 + k * 1024); } while (0)
#define PG8_LDB(dst, b, h) do { _Pragma("unroll") for (int n = 0; n < 2; ++n) _Pragma("unroll") for (int k = 0; k < 2; ++k) dst[n][k] = *(const PG8_LAS bf16x8*)(lds + PG8_SB(b, h) + boff + n * 2048 + k * 1024); } while (0)
#define PG8_MMA(ai, bj, At, Bt) do { __builtin_amdgcn_s_setprio(1); _Pragma("unroll") for (int m = 0; m < 4; ++m) _Pragma("unroll") for (int n = 0; n < 2; ++n) _Pragma("unroll") for (int k = 0; k < 2; ++k) \
        acc[ai][bj][m][n] = __builtin_amdgcn_mfma_f32_16x16x32_bf16(Bt[n][k], At[m][k], acc[ai][bj][m][n], 0, 0, 0); __builtin_amdgcn_s_setprio(0); } while (0)
#define PG8_WAIT_V(n) asm volatile("s_waitcnt vmcnt(" #n ")" ::: "memory")
#define PG8_WAIT_L(n) asm volatile("s_waitcnt lgkmcnt(" #n ")" ::: "memory")
#define PG8_BAR __builtin_amdgcn_s_barrier()
#define PG8_SCHED __builtin_amdgcn_sched_barrier(0)
    Unit cur, nxt; int ui = 0;
    if (!S.next(0, cur)) return;
    f32x4 acc[2][2][4][2];
#pragma unroll
    for (int a = 0; a < 2; ++a)
#pragma unroll
        for (int b = 0; b < 2; ++b)
#pragma unroll
            for (int m = 0; m < 4; ++m)
#pragma unroll
                for (int n = 0; n < 2; ++n) acc[a][b][m][n] = (f32x4){0.f, 0.f, 0.f, 0.f};
    bf16x8 At[4][2], B0[2][2], B1[2][2];
    const char* cA = (const char*)g.A + (size_t)cur.pm * tstep; const char* cB = (const char*)g.Bt + (size_t)cur.pn * tstep;
    S.a_ready(cur);
    if constexpr (SP2) {
        PG8_STAGE(PG8_SB(0, 0), cB, voffB); PG8_STAGE(PG8_SB(0, 1), cB + hstep, voffB); PG8_STAGE(PG8_SA(0, 0), cA, voffA); PG8_STAGE(PG8_SA(0, 1), cA + hstep, voffA);
        if (wr == 1) PG8_BAR;
        PG8_WAIT_V(2); PG8_BAR;
        PG8_STAGE(PG8_SB(1, 0), cB + kstep, voffB); PG8_STAGE(PG8_SA(1, 0), cA + kstep, voffA); PG8_STAGE(PG8_SB(1, 1), cB + hstep + kstep, voffB);
        PG8_WAIT_V(6); PG8_BAR;
    } else {
        PG8_STAGE(PG8_SB(0, 0), cB, voffB); PG8_STAGE(PG8_SA(0, 0), cA, voffA); PG8_STAGE(PG8_SB(0, 1), cB + hstep, voffB); PG8_STAGE(PG8_SA(0, 1), cA + hstep, voffA);
        if (wr == 1) PG8_BAR;
        PG8_WAIT_V(4); PG8_BAR;
        PG8_STAGE(PG8_SB(1, 0), cB + kstep, voffB); PG8_STAGE(PG8_SA(1, 0), cA + kstep, voffA); PG8_STAGE(PG8_SB(1, 1), cB + hstep + kstep, voffB);
        PG8_WAIT_V(6); PG8_BAR;
    }
    for (;;) {
        const bool has_next = S.next(ui + 1, nxt);
        const char* nA = has_next ? (const char*)g.A + (size_t)nxt.pm * tstep : cA; const char* nB = has_next ? (const char*)g.Bt + (size_t)nxt.pn * tstep : cB;
        for (int t = 0; t < nt; t += 2) {
            const bool last = (t == nt - 2);
            const char* a1 = cA + (size_t)(t + 1) * kstep;
            const char* a2 = last ? nA : cA + (size_t)(t + 2) * kstep; const char* b2 = last ? nB : cB + (size_t)(t + 2) * kstep;
            const char* a3 = a2 + kstep; const char* b3 = b2 + kstep;
            if (last && has_next) S.a_ready(nxt);
            if constexpr (SP2) {
            PG8_LDB(B0, 0, 0); PG8_LDB(B1, 0, 1); PG8_SCHED; PG8_LDA(At, 0, 0); PG8_STAGE(PG8_SA(1, 1), a1 + hstep, voffA);
            PG8_WAIT_V(8); PG8_WAIT_L(0); PG8_BAR; PG8_MMA(0, 0, At, B0); PG8_MMA(0, 1, At, B1); PG8_BAR; PG8_SCHED;
            PG8_LDA(At, 0, 1); PG8_STAGE(PG8_SB(0, 0), b2, voffB); PG8_STAGE(PG8_SB(0, 1), b2 + hstep, voffB); PG8_STAGE(PG8_SA(0, 0), a2, voffA);
            PG8_WAIT_V(8); PG8_WAIT_L(0); PG8_BAR; PG8_MMA(1, 0, At, B0); PG8_MMA(1, 1, At, B1); PG8_BAR; PG8_SCHED;
            PG8_LDB(B0, 1, 0); PG8_LDB(B1, 1, 1); PG8_SCHED; PG8_LDA(At, 1, 0); PG8_STAGE(PG8_SA(0, 1), a2 + hstep, voffA);
            PG8_WAIT_V(8); PG8_WAIT_L(0); PG8_BAR; PG8_MMA(0, 0, At, B0); PG8_MMA(0, 1, At, B1); PG8_BAR; PG8_SCHED;
            PG8_LDA(At, 1, 1); PG8_STAGE(PG8_SB(1, 0), b3, voffB); PG8_STAGE(PG8_SB(1, 1), b3 + hstep, voffB); PG8_STAGE(PG8_SA(1, 0), a3, voffA);
            PG8_WAIT_V(8); PG8_WAIT_L(0); PG8_BAR; PG8_MMA(1, 0, At, B0); PG8_MMA(1, 1, At, B1); PG8_BAR; PG8_SCHED;
            } else {
            PG8_LDB(B0, 0, 0); PG8_SCHED; PG8_LDA(At, 0, 0); PG8_STAGE(PG8_SA(1, 1), a1 + hstep, voffA);
            PG8_WAIT_L(8); PG8_BAR; PG8_WAIT_L(0); PG8_MMA(0, 0, At, B0); PG8_BAR; PG8_SCHED;
            PG8_LDB(B1, 0, 1); PG8_STAGE(PG8_SB(0, 0), b2, voffB);
            PG8_BAR; PG8_WAIT_L(0); PG8_MMA(0, 1, At, B1); PG8_BAR;
            PG8_LDA(At, 0, 1); PG8_STAGE(PG8_SA(0, 0), a2, voffA);
            PG8_BAR; PG8_WAIT_L(0); PG8_MMA(1, 0, At, B0); PG8_BAR; PG8_SCHED;
            PG8_STAGE(PG8_SB(0, 1), b2 + hstep, voffB);
            PG8_WAIT_V(6); PG8_BAR; PG8_MMA(1, 1, At, B1); PG8_BAR;
            PG8_LDB(B0, 1, 0); PG8_SCHED; PG8_LDA(At, 1, 0); PG8_STAGE(PG8_SA(0, 1), a2 + hstep, voffA);
            PG8_WAIT_L(8); PG8_BAR; PG8_WAIT_L(0); PG8_MMA(0, 0, At, B0); PG8_BAR; PG8_SCHED;
            PG8_LDB(B1, 1, 1); PG8_STAGE(PG8_SB(1, 0), b3, voffB);
            PG8_BAR; PG8_WAIT_L(0); PG8_MMA(0, 1, At, B1); PG8_BAR;
            PG8_LDA(At, 1, 1); PG8_STAGE(PG8_SA(1, 0), a3, voffA);
            PG8_BAR; PG8_WAIT_L(0); PG8_MMA(1, 0, At, B0); PG8_BAR; PG8_SCHED;
            PG8_STAGE(PG8_SB(1, 1), b3 + hstep, voffB);
            PG8_WAIT_V(6); PG8_BAR; PG8_MMA(1, 1, At, B1); PG8_BAR;
            }
        }
        if constexpr (ALIGN_EPI) { if (wr == 0) PG8_BAR; }
        if constexpr (!Epi::AFTER_DRAIN) { E(acc, cur, wr, wc, fr, fq); S.done(cur); }
        if (!has_next) break;
#pragma unroll
        for (int a = 0; a < 2; ++a)
#pragma unroll
            for (int b = 0; b < 2; ++b)
#pragma unroll
                for (int m = 0; m < 4; ++m)
#pragma unroll
                    for (int n = 0; n < 2; ++n) acc[a][b][m][n] = (f32x4){0.f, 0.f, 0.f, 0.f};
        cur = nxt; cA = nA; cB = nB; ++ui;
        if constexpr (ALIGN_EPI) { if (wr == 1) PG8_BAR; }
    }
    PG8_WAIT_V(0);
    if constexpr (!ALIGN_EPI) { if (wr == 0) PG8_BAR; }
    PG8_BAR;
    if constexpr (Epi::AFTER_DRAIN) { E.fused(acc, cur, wr, wc, fr, fq, lds, wid, lane); S.done(cur); }
#undef PG8_SA
#undef PG8_SB
#undef PG8_STAGE
#undef PG8_LDA
#undef PG8_LDB
#undef PG8_MMA
#undef PG8_WAIT_V
#undef PG8_WAIT_L
#undef PG8_BAR
#undef PG8_SCHED
}
}
#ifndef PG8_SP2
#define PG8_SP2 true
#endif
#ifndef PG8_ALIGN
#define PG8_ALIGN true
#endif
#define LAS __attribute__((address_space(3)))
typedef unsigned short bf16;
typedef unsigned v4u __attribute__((ext_vector_type(4)));
typedef unsigned v2u __attribute__((ext_vector_type(2)));
typedef float f32x4 __attribute__((ext_vector_type(4)));
typedef float f32x2 __attribute__((ext_vector_type(2)));
typedef short bf16x8 __attribute__((ext_vector_type(8)));
constexpr int NT = 512;
constexpr int LDS_BYTES = 147456;
constexpr int NPHASE = 15;

constexpr size_t MiB = 1u << 20;
constexpr size_t WS_WIN = 1 * MiB, WS_WKV = 23 * MiB, WS_WOUT = 39 * MiB, WS_WQ = 47 * MiB, WS_WO = 55 * MiB, WS_WUP = 63 * MiB, WS_WDN = 107 * MiB;
constexpr size_t WS_LW = 129 * MiB, WS_LA = 129 * MiB + 256 * 1024, WS_LG = 129 * MiB + 512 * 1024;
constexpr size_t WS_HB = 130 * MiB, WS_MB = 166 * MiB, WS_A2 = 170 * MiB, WS_MIX = 206 * MiB, WS_X1 = 278 * MiB, WS_Q = 350 * MiB, WS_O = 386 * MiB;
constexpr size_t WS_KB = 422 * MiB, WS_VT = 426 * MiB, WS_Y = 430 * MiB, WS_G = 466 * MiB, WS_BON = 502 * MiB;
constexpr size_t WS_SHB = 818 * MiB;
constexpr size_t WS_SI = 503 * MiB, SI_STRIDE = 36 * MiB;
constexpr size_t WS_UP = 503 * MiB;
constexpr size_t WS_GLU = 719 * MiB, WS_PR = 737 * MiB;
constexpr size_t WS_ACT = 719 * MiB;
constexpr size_t WS_END = 820 * MiB;
constexpr size_t O_YP = 0, O_YS = 16777216, O_CP = 18874368, O_CS = 18997248, O_SP = 22929408, O_SS = 22943488, O_WP = 23394048, O_WS = 23656192,
                 O_FP = 32044800, O_FS = 32134912, O_MK = 35018496, O_MV = 37115648, O_END = 39212800;

enum { I_XP = 0, I_XS, I_CK, I_CV, I_SCONV, I_SSHIFT, I_SWKV, I_SFFN, I_MEM, I_NMIXPRE, I_WIN, I_CDW, I_CDWB, I_CLNG, I_CLNB, I_MU, I_W0, I_WLORA, I_A0, I_ALORA,
       I_GLORA, I_KK, I_KA, I_RK, I_LNXG, I_LNXB, I_WOUT, I_NMIXPOST, I_NXAPRE, I_NMEM, I_WQ, I_WK, I_WV, I_WO, I_NXAPOST, I_NFFNPRE, I_WUP, I_FDW, I_FDWB, I_WDOWN,
       I_NFFNPOST, N_IN };

struct Params { const float* in[N_IN]; float* out; unsigned char* ws; int ph_lo, ph_hi; };

__device__ __forceinline__ unsigned f2bf(float f) { unsigned u = __builtin_bit_cast(unsigned, f); return (u + 0x7fffu + ((u >> 16) & 1u)) >> 16; }
__device__ __forceinline__ unsigned pk2(float lo, float hi) { return f2bf(lo) | (f2bf(hi) << 16); }
__device__ __forceinline__ float bflo(unsigned u) { return __builtin_bit_cast(float, u << 16); }
__device__ __forceinline__ float bfhi(unsigned u) { return __builtin_bit_cast(float, u & 0xffff0000u); }
__device__ __forceinline__ float wave_sum(float v) {
#pragma unroll
    for (int o = 1; o < 64; o <<= 1) v += __shfl_xor(v, o);
    return v;
}
__device__ __forceinline__ float wave_max(float v) {
#pragma unroll
    for (int o = 1; o < 64; o <<= 1) v = fmaxf(v, __shfl_xor(v, o));
    return v;
}
__device__ __forceinline__ float sigm(float x) { return 1.0f / (1.0f + __expf(-x)); }
#define LDS_WAIT() asm volatile("s_waitcnt lgkmcnt(0)" ::: "memory")

typedef __attribute__((address_space(1))) unsigned gu32;
#define XB_TMO      128
#define XB_XCNT(j)  (256  + 64 * (j))
#define XB_XSUB(j)  (1280 + 64 * (j))
#define XB_XGEN(j)  (2304 + 64 * (j))
#define XB_TOP      3328
#define XB_TOPGEN   3392
#define XCD_BAR_WORDS 3456
#define XB_SPIN_CAP (1u << 18)

__device__ __forceinline__ unsigned xb_ld(unsigned* p)              { return __hip_atomic_load(p, __ATOMIC_RELAXED, __HIP_MEMORY_SCOPE_AGENT); }
__device__ __forceinline__ unsigned xb_add(unsigned* p, unsigned v) { return __hip_atomic_fetch_add(p, v, __ATOMIC_RELAXED, __HIP_MEMORY_SCOPE_AGENT); }
__device__ __forceinline__ unsigned xb_xcc_id() { return (unsigned)__builtin_amdgcn_s_getreg((3 << 11) | 20) & 0xFu; }
#define XB_SPIN(cond, bar) do { unsigned _sp = 0; while (cond) { __builtin_amdgcn_s_sleep(1); \
    if ((++_sp & 255u) == 0u) { if (xb_ld(&(bar)[XB_TMO])) break; if (_sp > XB_SPIN_CAP) { atomicAdd(&(bar)[XB_TMO], 1u); break; } } } } while (0)

struct XcdBarrier {
    unsigned* bar; unsigned x;
    volatile LAS unsigned* st;
};

__device__ __forceinline__ XcdBarrier xcd_barrier_post(unsigned* bar, volatile LAS unsigned* st) {
    XcdBarrier b; b.bar = bar; b.x = xb_xcc_id(); b.st = st;
    if (threadIdx.x == 0) (void)xb_add(&bar[XB_XCNT(b.x)], 1u);
    return b;
}
__device__ __forceinline__ void xcd_barrier_complete(unsigned* bar, unsigned x, unsigned& nloc, unsigned& nx) {
    const unsigned G = gridDim.x * gridDim.y * gridDim.z;
    unsigned sum, cnt, mine, sp = 0u;
    for (;;) {
        sum = 0u; cnt = 0u; mine = 0u;
#pragma unroll
        for (unsigned j = 0; j < 16; ++j) { const unsigned c = xb_ld(&bar[XB_XCNT(j)]); sum += c; cnt += (c > 0u) ? 1u : 0u; mine = (j == x) ? c : mine; }
        if (sum == G) break;
        __builtin_amdgcn_s_sleep(1);
        if ((++sp & 255u) == 0u) { if (xb_ld(&bar[XB_TMO])) break; if (sp > XB_SPIN_CAP) { atomicAdd(&bar[XB_TMO], 1u); break; } }
    }
    nloc = mine > 0u ? mine : 1u; nx = cnt > 0u ? cnt : 1u;
}

__device__ __forceinline__ void xcd_barrier(const XcdBarrier& b) {
    asm volatile("s_waitcnt vmcnt(0)" ::: "memory");
    __syncthreads();
    if (threadIdx.x == 0) {
        unsigned* bar = b.bar;
        __builtin_amdgcn_s_waitcnt(0);
        unsigned nloc = b.st[0], nx = b.st[1];
        if (nloc == 0u) { xcd_barrier_complete(bar, b.x, nloc, nx); b.st[0] = nloc; b.st[1] = nx; }
        const unsigned old = xb_add(&bar[XB_XSUB(b.x)], 1u);
        const unsigned gen = old / nloc;
        if (old + 1u == (gen + 1u) * nloc) {
            __builtin_amdgcn_fence(__ATOMIC_RELEASE, "agent");
            asm volatile("s_waitcnt vmcnt(0)" ::: "memory");
            const unsigned og = xb_add(&bar[XB_TOP], 1u);
            const unsigned tg = og / nx;
            if (og + 1u == (tg + 1u) * nx) xb_add(&bar[XB_TOPGEN], 1u);
            else XB_SPIN(xb_ld(&bar[XB_TOPGEN]) == tg, bar);
            __builtin_amdgcn_fence(__ATOMIC_ACQUIRE, "agent");
            xb_add(&bar[XB_XGEN(b.x)], 1u);
            asm volatile("s_waitcnt vmcnt(0)" ::: "memory");
        } else {
            XB_SPIN(xb_ld(&bar[XB_XGEN(b.x)]) == gen, bar);
            __builtin_amdgcn_fence(__ATOMIC_ACQUIRE, "agent");
            asm volatile("s_waitcnt vmcnt(0)" ::: "memory");
        }
    }
    __syncthreads();
}

constexpr int MISC_OFF = LDS_BYTES - 64;
struct Ctx { int tid, lane, wave, bid, G, gw, NGW; };
__device__ __forceinline__ unsigned char* wsbase(const Params& P) { unsigned char* w = P.ws; asm volatile("" : "+s"(w)); return w; }
__device__ __forceinline__ const float* inp(const Params& P, int i) { int z; asm volatile("s_mov_b32 %0, 0" : "=s"(z)); return P.in[i + z]; }

template <class ColMap>
__device__ __forceinline__ void transpose_item(const float* __restrict__ W, int K, int N, bf16* __restrict__ WT, int kb, int jb, int lane, ColMap cm) {
    const int kr = lane >> 4, l16 = lane & 15, k0 = 64 * kb + 16 * kr, j = 64 * jb + 4 * l16;
    const int sc = cm(j);
    f32x4 v[16];
    if (sc >= 0) {
        const float* src = W + (size_t)k0 * N + sc;
#pragma unroll
        for (int q = 0; q < 16; ++q) v[q] = __builtin_nontemporal_load((const f32x4*)(src + (size_t)q * N));
    } else {
#pragma unroll
        for (int q = 0; q < 16; ++q) v[q] = (f32x4){0.f, 0.f, 0.f, 0.f};
    }
#pragma unroll
    for (int e = 0; e < 4; ++e) {
        bf16* dst = WT + (size_t)(j + e) * K + k0;
        v4u o0, o1;
        o0.x = pk2(v[0][e], v[1][e]); o0.y = pk2(v[2][e], v[3][e]); o0.z = pk2(v[4][e], v[5][e]); o0.w = pk2(v[6][e], v[7][e]);
        o1.x = pk2(v[8][e], v[9][e]); o1.y = pk2(v[10][e], v[11][e]); o1.z = pk2(v[12][e], v[13][e]); o1.w = pk2(v[14][e], v[15][e]);
        *(v4u*)dst = o0; *(v4u*)(dst + 8) = o1;
    }
}
struct MapId { __device__ __forceinline__ int operator()(int j) const { return j; } };
struct MapIn {
    __device__ __forceinline__ int operator()(int j) const {
        if (j < 2048) { const int g = j >> 5, q = (j >> 3) & 3, n = (j >> 2) & 1, e = j & 3; return n * 1024 + 16 * g + 4 * q + e; }
        const int jj = j - 2048; return jj < NRC ? 2048 + jj : -1;
    }
};
__device__ __forceinline__ void rms_row_bf16(const float* __restrict__ xrow, const float* __restrict__ g, bf16* __restrict__ orow, int lane) {
    f32x4 v[8]; float s = 0.f;
#pragma unroll
    for (int j = 0; j < 8; ++j) { v[j] = *(const f32x4*)(xrow + 4 * (lane + 64 * j)); s += (v[j][0] * v[j][0] + v[j][1] * v[j][1]) + (v[j][2] * v[j][2] + v[j][3] * v[j][3]); }
    const float r = rsqrtf(wave_sum(s) * (1.0f / 2048.0f) + 1e-6f);
#pragma unroll
    for (int j = 0; j < 8; ++j) { const f32x4 gg = *(const f32x4*)(g + 4 * (lane + 64 * j));
        v2u o; o.x = pk2(v[j][0] * r * gg[0], v[j][1] * r * gg[1]); o.y = pk2(v[j][2] * r * gg[2], v[j][3] * r * gg[3]);
        *(v2u*)(orow + 4 * (lane + 64 * j)) = o; }
}
__device__ __forceinline__ void p0_prologue(const Params& P, const Ctx& C, LAS unsigned char* lds) {
    unsigned char* ws = wsbase(P);
    constexpr int I_IN = 32 * 88, I_SQ = 32 * 32, I_UP = 32 * 176, I_DN = 88 * 32;
    constexpr int NITEMS = I_IN + 5 * I_SQ + I_UP + I_DN;
    for (int it = C.gw; it < NITEMS; it += C.NGW) {
        int r = it;
        if (r < I_IN) { transpose_item(inp(P, I_WIN), 2048, 5568, (bf16*)(ws + WS_WIN), r / 88, r % 88, C.lane, MapIn()); continue; } r -= I_IN;
        if (r < I_SQ) { transpose_item(inp(P, I_WK), 2048, 2048, (bf16*)(ws + WS_WKV), r / 32, r % 32, C.lane, MapId()); continue; } r -= I_SQ;
        if (r < I_SQ) { transpose_item(inp(P, I_WV), 2048, 2048, (bf16*)(ws + WS_WKV) + (size_t)2048 * 2048, r / 32, r % 32, C.lane, MapId()); continue; } r -= I_SQ;
        if (r < I_SQ) { transpose_item(inp(P, I_WOUT), 2048, 2048, (bf16*)(ws + WS_WOUT), r / 32, r % 32, C.lane, MapId()); continue; } r -= I_SQ;
        if (r < I_SQ) { transpose_item(inp(P, I_WQ), 2048, 2048, (bf16*)(ws + WS_WQ), r / 32, r % 32, C.lane, MapId()); continue; } r -= I_SQ;
        if (r < I_SQ) { transpose_item(inp(P, I_WO), 2048, 2048, (bf16*)(ws + WS_WO), r / 32, r % 32, C.lane, MapId()); continue; } r -= I_SQ;
        if (r < I_UP) { transpose_item(inp(P, I_WUP), 2048, 11264, (bf16*)(ws + WS_WUP), r / 176, r % 176, C.lane, MapId()); continue; } r -= I_UP;
        transpose_item(inp(P, I_WDOWN), 5632, 2048, (bf16*)(ws + WS_WDN), r / 32, r % 32, C.lane, MapId());
    }
    const int gt = C.bid * NT + C.tid, ngt = C.G * NT;
    { bf16* d = (bf16*)(ws + WS_LW); const float* s = inp(P, I_WLORA); for (int i = gt; i < 1024 * 96; i += ngt) { const int n = i / 96, k = i - n * 96; d[i] = (bf16)f2bf(s[k * 1024 + n]); } }
    { bf16* d = (bf16*)(ws + WS_LA); const float* s = inp(P, I_ALORA); for (int i = gt; i < 1024 * 96; i += ngt) { const int n = i / 96, k = i - n * 96; d[i] = (bf16)f2bf(s[k * 1024 + n]); } }
    { bf16* d = (bf16*)(ws + WS_LG); const float* s = inp(P, I_GLORA); for (int i = gt; i < 1024 * 256; i += ngt) { const int n = i >> 8, k = i & 255; d[i] = (bf16)f2bf(s[k * 1024 + n]); } }
    for (int m = C.gw; m < M + 1024; m += C.NGW) {
        if (m < M) { const float* xr = m < MP ? inp(P, I_XP) + (size_t)m * D : inp(P, I_XS) + (size_t)(m - MP) * D; rms_row_bf16(xr, inp(P, I_NMIXPRE), (bf16*)(ws + WS_HB) + (size_t)m * D, C.lane); }
        else { const int r = m - M; rms_row_bf16(inp(P, I_MEM) + (size_t)r * D, inp(P, I_NMEM), (bf16*)(ws + WS_MB) + (size_t)r * D, C.lane); }
    }
    { bf16* d = (bf16*)(ws + WS_SHB); const float* sp = inp(P, I_SSHIFT);
      for (int i = gt; i < (NBS + 1) * NRCP; i += ngt) { const int b = i / NRCP, c = i - b * NRCP; d[i] = (b < NBS && c < NRC) ? (bf16)f2bf(sp[(size_t)b * NRC + c]) : (bf16)0; } }
    { const f32x4* s = (const f32x4*)inp(P, I_SCONV); f32x4* d = (f32x4*)(P.out + O_CS);
      for (int i = gt; i < NBS * 22 * 256; i += ngt) { const int b = i / (22 * 256), r = i - b * (22 * 256); d[(size_t)b * 30 * 256 + r] = s[(size_t)b * 30 * 256 + 8 * 256 + r]; } }
}

template <int R>
__device__ __forceinline__ void conv_task(const Params& P, const Ctx& C, LAS unsigned char* lds, int grow0  , int t0  , int sb  ) {
    unsigned char* ws = wsbase(P);
    const bf16* glu = (const bf16*)(ws + WS_GLU);
    LAS unsigned* st = (LAS unsigned*)lds;
    LAS float* red = (LAS float*)(lds + 98304);
    constexpr int NR = R + 30;
    const float* sconv = inp(P, I_SCONV); const float* cdw = inp(P, I_CDW);
    for (int p = C.tid; p < NR * 128; p += NT) {
        const int rr = p >> 7, ch = p & 127; const int t = t0 - 30 + rr;
        v4u v = (v4u){0u, 0u, 0u, 0u};
        if (t >= 0) v = *(const v4u*)(glu + (size_t)(grow0 - 30 + rr) * CC + ch * 8);
        else if (sb >= 0) { const float* s = sconv + ((size_t)sb * 30 + rr) * CC + ch * 8;
            const f32x4 a = *(const f32x4*)s, b = *(const f32x4*)(s + 4); v.x = pk2(a[0], a[1]); v.y = pk2(a[2], a[3]); v.z = pk2(b[0], b[1]); v.w = pk2(b[2], b[3]); }
        *(LAS v4u*)(st + rr * 512 + ch * 4) = v;
    }
    const int c = 2 * C.tid;
    f32x2 w[31];
#pragma unroll
    for (int j = 0; j < 31; ++j) w[j] = *(const f32x2*)(cdw + j * CC + c);
    const f32x2 bias = *(const f32x2*)(inp(P, I_CDWB) + c);
    f32x2 acc[R];
#pragma unroll
    for (int r = 0; r < R; ++r) acc[r] = bias;
    __syncthreads();
#pragma unroll
    for (int rr = 0; rr < NR; ++rr) {
        if ((rr & 3) == 0) asm volatile("" ::: "memory");
        const unsigned u = st[rr * 512 + C.tid]; const float x0 = bflo(u), x1 = bfhi(u);
#pragma unroll
        for (int r = 0; r < R; ++r) { const int j = rr - r; if (j >= 0 && j < 31) { acc[r][0] += x0 * w[j][0]; acc[r][1] += x1 * w[j][1]; } }
    }
    float s[R];
#pragma unroll
    for (int r = 0; r < R; ++r) s[r] = wave_sum(acc[r][0] + acc[r][1]);
    if (C.lane == 0) {
#pragma unroll
        for (int r = 0; r < R; ++r) red[C.wave * 16 + r] = s[r]; }
    __syncthreads();
    float mean[R];
#pragma unroll
    for (int r = 0; r < R; ++r) { float t = 0.f;
#pragma unroll
        for (int wv = 0; wv < 8; ++wv) t += red[wv * 16 + r];
        mean[r] = t * (1.0f / 1024.0f); }
    __syncthreads();
#pragma unroll
    for (int r = 0; r < R; ++r) { const float d0 = acc[r][0] - mean[r], d1 = acc[r][1] - mean[r]; acc[r][0] = d0; acc[r][1] = d1; s[r] = wave_sum(d0 * d0 + d1 * d1); }
    if (C.lane == 0) {
#pragma unroll
        for (int r = 0; r < R; ++r) red[C.wave * 16 + r] = s[r]; }
    __syncthreads();
    const f32x2 lg = *(const f32x2*)(inp(P, I_CLNG) + c), lb = *(const f32x2*)(inp(P, I_CLNB) + c);
    bf16* a2 = (bf16*)(ws + WS_A2);
#pragma unroll
    for (int r = 0; r < R; ++r) { float t = 0.f;
#pragma unroll
        for (int wv = 0; wv < 8; ++wv) t += red[wv * 16 + r];
        const float rstd = rsqrtf(t * (1.0f / 1024.0f) + 1e-5f);
        float y0 = acc[r][0] * rstd * lg[0] + lb[0], y1 = acc[r][1] * rstd * lg[1] + lb[1];
        y0 = y0 * sigm(y0); y1 = y1 * sigm(y1);
        *(unsigned*)(a2 + (size_t)(grow0 + r) * D + c) = pk2(y0, y1); }
    __syncthreads();
}

#define XS8(col_, xs_) do { const v4u cu_ = *(const v4u*)(curp + (col_)); const v4u pu_ = *(const v4u*)(prvp + (col_)); \
        const f32x4 m0_ = *(const f32x4*)(mup + (col_)), m1_ = *(const f32x4*)(mup + (col_) + 4); float c_, p_; \
        c_ = bflo(cu_.x); p_ = bflo(pu_.x); xs_[0] = c_ + (p_ - c_) * m0_[0]; c_ = bfhi(cu_.x); p_ = bfhi(pu_.x); xs_[1] = c_ + (p_ - c_) * m0_[1]; \
        c_ = bflo(cu_.y); p_ = bflo(pu_.y); xs_[2] = c_ + (p_ - c_) * m0_[2]; c_ = bfhi(cu_.y); p_ = bfhi(pu_.y); xs_[3] = c_ + (p_ - c_) * m0_[3]; \
        c_ = bflo(cu_.z); p_ = bflo(pu_.z); xs_[4] = c_ + (p_ - c_) * m1_[0]; c_ = bfhi(cu_.z); p_ = bfhi(pu_.z); xs_[5] = c_ + (p_ - c_) * m1_[1]; \
        c_ = bflo(cu_.w); p_ = bflo(pu_.w); xs_[6] = c_ + (p_ - c_) * m1_[2]; c_ = bfhi(cu_.w); p_ = bfhi(pu_.w); xs_[7] = c_ + (p_ - c_) * m1_[3]; } while (0)
#define XS4(col_, xs_) do { const v2u cu_ = *(const v2u*)(curp + (col_)); const v2u pu_ = *(const v2u*)(prvp + (col_)); const f32x4 m0_ = *(const f32x4*)(mup + (col_)); float c_, p_; \
        c_ = bflo(cu_.x); p_ = bflo(pu_.x); xs_[0] = c_ + (p_ - c_) * m0_[0]; c_ = bfhi(cu_.x); p_ = bfhi(pu_.x); xs_[1] = c_ + (p_ - c_) * m0_[1]; \
        c_ = bflo(cu_.y); p_ = bflo(pu_.y); xs_[2] = c_ + (p_ - c_) * m0_[2]; c_ = bfhi(cu_.y); p_ = bfhi(pu_.y); xs_[3] = c_ + (p_ - c_) * m0_[3]; } while (0)
__device__ __forceinline__ bf16x8 pack8(const float (&x)[8]) {
    v4u o; o.x = pk2(x[0], x[1]); o.y = pk2(x[2], x[3]); o.z = pk2(x[4], x[5]); o.w = pk2(x[6], x[7]);
    return __builtin_bit_cast(bf16x8, o);
}
__device__ __forceinline__ float tanh_fast(float x) { return 1.0f - 2.0f / (1.0f + __expf(2.0f * x)); }
__device__ __forceinline__ void prep_wave(const Params& P, int rowbase, int h, int lane) {
    const int fr = lane & 15, fq = lane >> 4, row = rowbase + fr;
    unsigned char* ws = wsbase(P);
    const bf16* curp = (const bf16*)(ws + WS_PR) + (size_t)row * NRCP;
    const bf16* prvp = curp - NRCP;
    if (row < MP) { if ((row & (SEQ - 1)) == 0) prvp = (const bf16*)(ws + WS_SHB) + (size_t)NBS * NRCP; }
    else { const int rs = row - MP; if ((rs & 7) == 0) prvp = (const bf16*)(ws + WS_SHB) + (size_t)(rs >> 3) * NRCP; }
    const float* mup = inp(P, I_MU); const float* pkk = inp(P, I_KK); const float* pa0 = inp(P, I_A0); const float* pw0 = inp(P, I_W0); const float* pka = inp(P, I_KA); const float* prk = inp(P, I_RK);
    const bf16* lw = (const bf16*)(ws + WS_LW); const bf16* la = (const bf16*)(ws + WS_LA); const bf16* lg = (const bf16*)(ws + WS_LG);
    const f32x4 z4 = (f32x4){0.f, 0.f, 0.f, 0.f};
    f32x4 accW[4] = {z4, z4, z4, z4}, accA[4] = {z4, z4, z4, z4}, accG[4] = {z4, z4, z4, z4};
    {   bf16x8 A[3];
#pragma unroll
        for (int s = 0; s < 3; ++s) { float xs[8]; XS8(3072 + 32 * s + 8 * fq, xs);
#pragma unroll
            for (int e = 0; e < 8; ++e) xs[e] = tanh_fast(xs[e]);
            A[s] = pack8(xs); }
#pragma unroll
        for (int nt = 0; nt < 4; ++nt)
#pragma unroll
            for (int s = 0; s < 3; ++s) { if (s == 0) asm volatile("" ::: "memory"); const bf16x8 b = *(const bf16x8*)(lw + (size_t)(h * 64 + 16 * nt + fr) * 96 + 32 * s + 8 * fq); accW[nt] = __builtin_amdgcn_mfma_f32_16x16x32_bf16(b, A[s], accW[nt], 0, 0, 0); }
    }
    {   bf16x8 A[3];
#pragma unroll
        for (int s = 0; s < 3; ++s) { float xs[8]; XS8(3168 + 32 * s + 8 * fq, xs); A[s] = pack8(xs); }
#pragma unroll
        for (int nt = 0; nt < 4; ++nt)
#pragma unroll
            for (int s = 0; s < 3; ++s) { if (s == 0) asm volatile("" ::: "memory"); const bf16x8 b = *(const bf16x8*)(la + (size_t)(h * 64 + 16 * nt + fr) * 96 + 32 * s + 8 * fq); accA[nt] = __builtin_amdgcn_mfma_f32_16x16x32_bf16(b, A[s], accA[nt], 0, 0, 0); }
    }
    {   bf16x8 A[8];
#pragma unroll
        for (int s = 0; s < 8; ++s) { float xs[8]; XS8(3264 + 32 * s + 8 * fq, xs);
#pragma unroll
            for (int e = 0; e < 8; ++e) xs[e] = sigm(xs[e]);
            A[s] = pack8(xs); }
#pragma unroll
        for (int nt = 0; nt < 4; ++nt)
#pragma unroll
            for (int s = 0; s < 8; ++s) { if (s == 0) asm volatile("" ::: "memory"); const bf16x8 b = *(const bf16x8*)(lg + (size_t)(h * 64 + 16 * nt + fr) * 256 + 32 * s + 8 * fq); accG[nt] = __builtin_amdgcn_mfma_f32_16x16x32_bf16(b, A[s], accG[nt], 0, 0, 0); }
    }
    float xk[4][4];
    float ss = 0.f;
#pragma unroll
    for (int nt = 0; nt < 4; ++nt) {
        const int c = h * 64 + 16 * nt + 4 * fq;
        XS4(1024 + c, xk[nt]);
        const f32x4 kkw = *(const f32x4*)(pkk + c);
#pragma unroll
        for (int e = 0; e < 4; ++e) { const float t = xk[nt][e] * kkw[e]; ss += t * t; }
    }
    ss += __shfl_xor(ss, 16); ss += __shfl_xor(ss, 32);
    const float inv = 1.0f / fmaxf(sqrtf(ss), 1e-12f);
    float bon = 0.f;
    float* SI = (float*)(ws + WS_SI); constexpr size_t SS = SI_STRIDE / 4;
#pragma unroll
    for (int nt = 0; nt < 4; ++nt) {
        const int c = h * 64 + 16 * nt + 4 * fq; const size_t o = (size_t)row * RW + c;
        asm volatile("" ::: "memory");
        float xr[4], xv[4];
        XS4(c, xr); XS4(2048 + c, xv);
        const f32x4 w0 = *(const f32x4*)(pw0 + c), ka = *(const f32x4*)(pka + c), rk = *(const f32x4*)(prk + c);
        const f32x4 kkw = *(const f32x4*)(pkk + c), a0 = *(const f32x4*)(pa0 + c);
        f32x4 vr, vw, vk, vv, va, vb;
#pragma unroll
        for (int e = 0; e < 4; ++e) {
            const float ee = 0.6065306597126334f * sigm(w0[e] + accW[nt][e]);
            vw[e] = __expf(-ee);
            const float a = sigm(a0[e] + accA[nt][e]);
            const float kn = xk[nt][e] * kkw[e] * inv;
            const float k2 = xk[nt][e] * (1.0f + (a - 1.0f) * ka[e]);
            vr[e] = xr[e]; vk[e] = k2; vv[e] = xv[e]; va[e] = -kn; vb[e] = kn * a;
            bon += xr[e] * k2 * rk[e];
        }
        *(f32x4*)(SI + 0 * SS + o) = vr; *(f32x4*)(SI + 1 * SS + o) = vw; *(f32x4*)(SI + 2 * SS + o) = vk;
        *(f32x4*)(SI + 3 * SS + o) = vv; *(f32x4*)(SI + 4 * SS + o) = va; *(f32x4*)(SI + 5 * SS + o) = vb;
        *(f32x4*)((float*)(ws + WS_G) + o) = accG[nt];
    }
    bon += __shfl_xor(bon, 16); bon += __shfl_xor(bon, 32);
    if (fq == 0) ((float*)(ws + WS_BON))[(size_t)row * RH + h] = bon;
}

constexpr int TC = 32, STEPF = 5 * 64 + 16, STEPQ = STEPF / 4, CHUNKQ = TC * STEPQ;
template <int CTRL> __device__ __forceinline__ float dppf(float x) { return __builtin_bit_cast(float, __builtin_amdgcn_update_dpp(0, __builtin_bit_cast(int, x), CTRL, 0xF, 0xF, true)); }
__device__ __forceinline__ float allred16(float x) {
    x += dppf<0xB1>(x);
    x += dppf<0x4E>(x);
    x += dppf<0x141>(x);
    x += dppf<0x140>(x);
    return x;
}
#define SCAN_BAR() do { asm volatile("s_waitcnt lgkmcnt(0)" ::: "memory"); __builtin_amdgcn_s_barrier(); asm volatile("" ::: "memory"); } while (0)
#define SCAN_STEP(S01, S23, r4, w4, k4, a4, b4, v, yout) do { \
        f32x2 p2 = S01 * (f32x2){a4[0], a4[1]}; p2 = S23 * (f32x2){a4[2], a4[3]} + p2; \
        const float sa = allred16(p2[0] + p2[1]); const f32x2 sa2 = (f32x2){sa, sa}, v2 = (f32x2){v, v}; \
        f32x2 t01 = v2 * (f32x2){k4[0], k4[1]}, t23 = v2 * (f32x2){k4[2], k4[3]}; \
        t01 = sa2 * (f32x2){b4[0], b4[1]} + t01; t23 = sa2 * (f32x2){b4[2], b4[3]} + t23; \
        S01 = S01 * (f32x2){w4[0], w4[1]} + t01; S23 = S23 * (f32x2){w4[2], w4[3]} + t23; \
        f32x2 q2 = S01 * (f32x2){r4[0], r4[1]}; q2 = S23 * (f32x2){r4[2], r4[3]} + q2; \
        yout = allred16(q2[0] + q2[1]); } while (0)
__device__ __forceinline__ void scan_prompt(const Params& P, const Ctx& C, LAS unsigned char* lds, int chain, int rb) {
    unsigned char* ws = wsbase(P);
    const float* SI = (const float*)(ws + WS_SI); constexpr size_t SS = SI_STRIDE / 4;
    const int b = chain >> 4, h = chain & 15, m0 = b * SEQ;
    LAS float* buf = (LAS float*)lds;
    constexpr int NCH = SEQ / TC;
    if (C.wave >= 4) {
        const int ht = C.tid - 256;
        f32x4 stg[11];
#define SCAN_HLOAD(ck_) do { _Pragma("unroll") for (int q = 0; q < 11; ++q) { const int i4 = ht + q * 256; if (i4 < CHUNKQ) { const int t = i4 / STEPQ, o4 = i4 - t * STEPQ; \
            const size_t rowo = (size_t)(m0 + (ck_) * TC + t) * RW + h * 64; const float* src; \
            if (o4 < 80) { const int vec = o4 >> 4; const int arr = vec < 3 ? vec : vec + 1; src = SI + arr * SS + rowo + 4 * (o4 & 15); } \
            else src = SI + 3 * SS + rowo + rb * 16 + 4 * (o4 - 80); \
            stg[q] = *(const f32x4*)src; } } } while (0)
#define SCAN_HWRITE(ck_) do { LAS f32x4* dst = (LAS f32x4*)(buf + ((ck_) & 1) * (TC * STEPF)); _Pragma("unroll") for (int q = 0; q < 11; ++q) { const int i4 = ht + q * 256; if (i4 < CHUNKQ) dst[i4] = stg[q]; } } while (0)
        SCAN_HLOAD(0); SCAN_HWRITE(0); SCAN_HLOAD(1);
        SCAN_BAR();
        for (int ck = 0; ck < NCH; ++ck) {
            if (ck + 1 < NCH) SCAN_HWRITE(ck + 1);
            if (ck + 2 < NCH) SCAN_HLOAD(ck + 2);
            SCAN_BAR();
        }
#undef SCAN_HLOAD
#undef SCAN_HWRITE
    } else {
        float* Y = (float*)(ws + WS_Y);
        const int rowl = C.lane >> 4, cl = C.lane & 15, irow = rb * 16 + C.wave * 4 + rowl;
        f32x2 S01 = (f32x2){0.f, 0.f}, S23 = (f32x2){0.f, 0.f};
        float yk = 0.f;
        SCAN_BAR();
        for (int ck = 0; ck < NCH; ++ck) {
            const LAS float* cb = buf + (ck & 1) * (TC * STEPF);
            f32x4 r4 = *(const LAS f32x4*)(cb + 0 * 64 + 4 * cl), w4 = *(const LAS f32x4*)(cb + 1 * 64 + 4 * cl), k4 = *(const LAS f32x4*)(cb + 2 * 64 + 4 * cl);
            f32x4 a4 = *(const LAS f32x4*)(cb + 3 * 64 + 4 * cl), b4 = *(const LAS f32x4*)(cb + 4 * 64 + 4 * cl); float v = cb[320 + C.wave * 4 + rowl];
#pragma unroll 4
            for (int t = 0; t < TC; ++t) {
                const LAS float* nb = cb + (t + 1 < TC ? t + 1 : t) * STEPF;
                const f32x4 nr = *(const LAS f32x4*)(nb + 0 * 64 + 4 * cl), nw = *(const LAS f32x4*)(nb + 1 * 64 + 4 * cl), nk = *(const LAS f32x4*)(nb + 2 * 64 + 4 * cl);
                const f32x4 na = *(const LAS f32x4*)(nb + 3 * 64 + 4 * cl), nbb = *(const LAS f32x4*)(nb + 4 * 64 + 4 * cl); const float nv = nb[320 + C.wave * 4 + rowl];
                float y; SCAN_STEP(S01, S23, r4, w4, k4, a4, b4, v, y);
                yk = (cl == (t & 15)) ? y : yk;
                if ((t & 15) == 15) Y[(size_t)(m0 + ck * TC + (t & ~15) + cl) * RW + h * 64 + irow] = yk;
                r4 = nr; w4 = nw; k4 = nk; a4 = na; b4 = nbb; v = nv;
            }
            SCAN_BAR();
        }
        float* so = P.out + O_WP + ((size_t)chain * 64 + irow) * 64 + 4 * cl;
        *(f32x4*)so = (f32x4){S01[0], S01[1], S23[0], S23[1]};
    }
    __syncthreads();
}
__device__ __forceinline__ void scan_sample(const Params& P, const Ctx& C, const float* swkv, int chain, int half) {
    unsigned char* ws = wsbase(P);
    const float* SI = (const float*)(ws + WS_SI); constexpr size_t SS = SI_STRIDE / 4;
    float* Y = (float*)(ws + WS_Y);
    const int b = chain >> 4, h = chain & 15, m0 = MP + 8 * b;
    const int rowl = C.lane >> 4, cl = C.lane & 15, irow = half * 32 + C.wave * 4 + rowl;
    const f32x4 s4 = *(const f32x4*)(swkv + ((size_t)chain * 64 + irow) * 64 + 4 * cl);
    f32x2 S01 = (f32x2){s4[0], s4[1]}, S23 = (f32x2){s4[2], s4[3]};
    float yk = 0.f;
#pragma unroll
    for (int t = 0; t < 8; ++t) {
        const size_t rowo = (size_t)(m0 + t) * RW + h * 64;
        const f32x4 r4 = *(const f32x4*)(SI + 0 * SS + rowo + 4 * cl), w4 = *(const f32x4*)(SI + 1 * SS + rowo + 4 * cl), k4 = *(const f32x4*)(SI + 2 * SS + rowo + 4 * cl);
        const f32x4 a4 = *(const f32x4*)(SI + 4 * SS + rowo + 4 * cl), b4 = *(const f32x4*)(SI + 5 * SS + rowo + 4 * cl); const float v = SI[3 * SS + rowo + irow];
        float y; SCAN_STEP(S01, S23, r4, w4, k4, a4, b4, v, y);
        yk = (cl == t) ? y : yk;
    }
    if (cl < 8) Y[(size_t)(m0 + cl) * RW + h * 64 + irow] = yk;
    *(f32x4*)(P.out + O_WS + ((size_t)chain * 64 + irow) * 64 + 4 * cl) = (f32x4){S01[0], S01[1], S23[0], S23[1]};
}

__device__ __forceinline__ void post_row(const Params& P, int row, int lane) {
    unsigned char* ws = wsbase(P);
    const float* Y = (const float*)(ws + WS_Y) + (size_t)row * RW + 16 * lane;
    const float* V = (const float*)(ws + WS_SI) + 3 * (SI_STRIDE / 4) + (size_t)row * RW + 16 * lane;
    const float* G = (const float*)(ws + WS_G) + (size_t)row * RW + 16 * lane;
    const float bon = ((const float*)(ws + WS_BON))[(size_t)row * RH + (lane >> 2)];
    float y[16], s = 0.f;
#pragma unroll
    for (int q = 0; q < 4; ++q) { const f32x4 t = *(const f32x4*)(Y + 4 * q); y[4 * q] = t[0]; y[4 * q + 1] = t[1]; y[4 * q + 2] = t[2]; y[4 * q + 3] = t[3]; s += (t[0] + t[1]) + (t[2] + t[3]); }
    s += __shfl_xor(s, 1); s += __shfl_xor(s, 2);
    const float mu = s * (1.0f / 64.0f); float q2 = 0.f;
#pragma unroll
    for (int e = 0; e < 16; ++e) { y[e] -= mu; q2 += y[e] * y[e]; }
    q2 += __shfl_xor(q2, 1); q2 += __shfl_xor(q2, 2);
    const float rstd = rsqrtf(q2 * (1.0f / 64.0f) + 64e-5f);
    const float* lg = inp(P, I_LNXG) + 16 * lane; const float* lb = inp(P, I_LNXB) + 16 * lane;
    unsigned o[8];
#pragma unroll
    for (int q = 0; q < 4; ++q) { const f32x4 g4 = *(const f32x4*)(lg + 4 * q), b4 = *(const f32x4*)(lb + 4 * q), v4 = *(const f32x4*)(V + 4 * q), gg = *(const f32x4*)(G + 4 * q);
        float r[4];
#pragma unroll
        for (int e = 0; e < 4; ++e) r[e] = (y[4 * q + e] * rstd * g4[e] + b4[e] + bon * v4[e]) * gg[e];
        o[2 * q] = pk2(r[0], r[1]); o[2 * q + 1] = pk2(r[2], r[3]); }
    bf16* dst = (bf16*)(ws + WS_A2) + (size_t)row * D + 1024 + 16 * lane;
    *(v4u*)dst = (v4u){o[0], o[1], o[2], o[3]}; *(v4u*)(dst + 8) = (v4u){o[4], o[5], o[6], o[7]};
}

__device__ __forceinline__ void rowpass(const float* xa, const float* __restrict__ mix, const float* __restrict__ g1, float* xo,
                                        const float* __restrict__ g2, bf16* __restrict__ hb, int lane) {
    f32x4 mv[8]; float s = 0.f;
#pragma unroll
    for (int j = 0; j < 8; ++j) { mv[j] = *(const f32x4*)(mix + 4 * (lane + 64 * j)); s += (mv[j][0] * mv[j][0] + mv[j][1] * mv[j][1]) + (mv[j][2] * mv[j][2] + mv[j][3] * mv[j][3]); }
    const float r = rsqrtf(wave_sum(s) * (1.0f / 2048.0f) + 1e-6f);
    float s2 = 0.f;
#pragma unroll
    for (int j = 0; j < 8; ++j) { const f32x4 a = *(const f32x4*)(xa + 4 * (lane + 64 * j)), gg = *(const f32x4*)(g1 + 4 * (lane + 64 * j));
        mv[j] = a + mv[j] * r * gg; *(f32x4*)(xo + 4 * (lane + 64 * j)) = mv[j];
        s2 += (mv[j][0] * mv[j][0] + mv[j][1] * mv[j][1]) + (mv[j][2] * mv[j][2] + mv[j][3] * mv[j][3]); }
    if (hb) {
        const float r2 = rsqrtf(wave_sum(s2) * (1.0f / 2048.0f) + 1e-6f);
#pragma unroll
        for (int j = 0; j < 8; ++j) { const f32x4 gg = *(const f32x4*)(g2 + 4 * (lane + 64 * j));
            v2u o; o.x = pk2(mv[j][0] * r2 * gg[0], mv[j][1] * r2 * gg[1]); o.y = pk2(mv[j][2] * r2 * gg[2], mv[j][3] * r2 * gg[3]);
            *(v2u*)(hb + 4 * (lane + 64 * j)) = o; }
    }
}
__device__ __forceinline__ void attn_prompt_task(const Params& P, const Ctx& C, LAS unsigned char* lds, int b, int h, int qt) {
    unsigned char* ws = wsbase(P);
    const bf16* Qg = (const bf16*)(ws + WS_Q); const bf16* Kg = (const bf16*)(ws + WS_KB); const bf16* VTg = (const bf16*)(ws + WS_VT);
    bf16* Og = (bf16*)(ws + WS_O);
    const int fr = C.lane & 15, fq = C.lane >> 4;
    const int qrow = b * SEQ + qt * 128 + C.wave * 16 + fr;
    constexpr int BUFB = 33792;
    bf16x8 Qf[16];
#pragma unroll
    for (int s = 0; s < 16; ++s) Qf[s] = *(const bf16x8*)(Qg + (size_t)qrow * D + h * XD + 32 * s + 8 * fq);
    f32x4 accS[16];
#pragma unroll
    for (int nt = 0; nt < 16; ++nt) accS[nt] = (f32x4){0.f, 0.f, 0.f, 0.f};
    v4u stg[4];
#define ATT_GLOAD(c_) do { if ((c_) < 8) { _Pragma("unroll") for (int i = 0; i < 4; ++i) { const int idx = C.tid + i * NT, key = idx >> 3, ch = idx & 7; \
            stg[i] = *(const v4u*)(Kg + (size_t)(b * NMEM + key) * D + h * XD + (c_) * 64 + ch * 8); } } \
        else { _Pragma("unroll") for (int i = 0; i < 4; ++i) { const int idx = C.tid + i * NT, dd = idx >> 5, ch = idx & 31; \
            stg[i] = *(const v4u*)(VTg + ((size_t)((b * XH + h) * XD + ((c_) - 8) * 64 + dd)) * NMEM + ch * 8); } } } while (0)
#define ATT_SWRITE(c_) do { LAS unsigned char* sbuf = lds + ((c_) & 1) * BUFB; if ((c_) < 8) { _Pragma("unroll") for (int i = 0; i < 4; ++i) { const int idx = C.tid + i * NT, key = idx >> 3, ch = idx & 7; \
            *(LAS v4u*)(sbuf + key * 128 + ((ch ^ (key & 7)) * 16)) = stg[i]; } } \
        else { _Pragma("unroll") for (int i = 0; i < 4; ++i) { const int idx = C.tid + i * NT, dd = idx >> 5, ch = idx & 31; \
            *(LAS v4u*)(sbuf + dd * 528 + ch * 16) = stg[i]; } } } while (0)
    ATT_GLOAD(0); ATT_SWRITE(0); __syncthreads();
    bf16x8 Pf[8];
#pragma unroll
    for (int c = 0; c < 8; ++c) {
        ATT_GLOAD(c + 1);
        const LAS unsigned char* sbuf = lds + (c & 1) * BUFB;
#pragma unroll
        for (int ss = 0; ss < 2; ++ss)
#pragma unroll
            for (int nt = 0; nt < 16; ++nt) {
                const int key = 16 * nt + fr, ch = ss * 4 + fq;
                const bf16x8 kf = *(const LAS bf16x8*)(sbuf + key * 128 + ((ch ^ (key & 7)) * 16));
                accS[nt] = __builtin_amdgcn_mfma_f32_16x16x32_bf16(kf, Qf[2 * c + ss], accS[nt], 0, 0, 0);
            }
        if (c == 7) {
            float mx = -3.0e38f;
#pragma unroll
            for (int nt = 0; nt < 16; ++nt) mx = fmaxf(mx, fmaxf(fmaxf(accS[nt][0], accS[nt][1]), fmaxf(accS[nt][2], accS[nt][3])));
            mx = fmaxf(mx, __shfl_xor(mx, 16)); mx = fmaxf(mx, __shfl_xor(mx, 32));
            float sum = 0.f;
#pragma unroll
            for (int nt = 0; nt < 16; ++nt) {
#pragma unroll
                for (int e = 0; e < 4; ++e) { const float p = exp2f(accS[nt][e] - mx); accS[nt][e] = p; sum += p; } }
            sum += __shfl_xor(sum, 16); sum += __shfl_xor(sum, 32);
            const float inv = 1.0f / sum;
#pragma unroll
            for (int s = 0; s < 8; ++s) { v4u o; o.x = pk2(accS[2 * s][0] * inv, accS[2 * s][1] * inv); o.y = pk2(accS[2 * s][2] * inv, accS[2 * s][3] * inv);
                o.z = pk2(accS[2 * s + 1][0] * inv, accS[2 * s + 1][1] * inv); o.w = pk2(accS[2 * s + 1][2] * inv, accS[2 * s + 1][3] * inv); Pf[s] = __builtin_bit_cast(bf16x8, o); }
        }
        ATT_SWRITE(c + 1);
        __syncthreads();
    }
    for (int c = 8; c < 16; ++c) {
        if (c + 1 < 16) ATT_GLOAD(c + 1);
        const LAS unsigned char* sbuf = lds + (c & 1) * BUFB;
        const int dv = c - 8;
        f32x4 accO[4];
#pragma unroll
        for (int nd = 0; nd < 4; ++nd) accO[nd] = (f32x4){0.f, 0.f, 0.f, 0.f};
#pragma unroll
        for (int s = 0; s < 8; ++s)
#pragma unroll
            for (int nd = 0; nd < 4; ++nd) {
                const LAS unsigned char* rp = sbuf + (nd * 16 + fr) * 528 + (32 * s + 4 * fq) * 2;
                const v2u lo = *(const LAS v2u*)rp, hi = *(const LAS v2u*)(rp + 32);
                const bf16x8 vf = __builtin_bit_cast(bf16x8, ((v4u){lo.x, lo.y, hi.x, hi.y}));
                accO[nd] = __builtin_amdgcn_mfma_f32_16x16x32_bf16(vf, Pf[s], accO[nd], 0, 0, 0);
            }
#pragma unroll
        for (int nd = 0; nd < 4; ++nd) { v2u o; o.x = pk2(accO[nd][0], accO[nd][1]); o.y = pk2(accO[nd][2], accO[nd][3]);
            *(v2u*)(Og + (size_t)qrow * D + h * XD + dv * 64 + nd * 16 + 4 * fq) = o; }
        if (c + 1 < 16) ATT_SWRITE(c + 1);
        __syncthreads();
    }
#undef ATT_GLOAD
#undef ATT_SWRITE
}
__device__ __forceinline__ void attn_sample_task(const Params& P, const Ctx& C, LAS unsigned char* lds, int b, int h) {
    unsigned char* ws = wsbase(P);
    const bf16* Qg = (const bf16*)(ws + WS_Q); bf16* Og = (bf16*)(ws + WS_O);
    const float* CK = inp(P, I_CK); const float* CV = inp(P, I_CV);
    LAS float* sS = (LAS float*)lds;
    LAS float* sP = (LAS float*)(lds + 8192);
    const int row0 = MP + 8 * b;
    float qv[8][8];
#pragma unroll
    for (int q = 0; q < 8; ++q) { const bf16* qp = Qg + (size_t)(row0 + q) * D + h * XD;
        const v2u a = *(const v2u*)(qp + 4 * C.lane), c2 = *(const v2u*)(qp + 256 + 4 * C.lane);
        qv[q][0] = bflo(a.x); qv[q][1] = bfhi(a.x); qv[q][2] = bflo(a.y); qv[q][3] = bfhi(a.y); qv[q][4] = bflo(c2.x); qv[q][5] = bfhi(c2.x); qv[q][6] = bflo(c2.y); qv[q][7] = bfhi(c2.y); }
    for (int k0 = 0; k0 < 32; k0 += 4) {
        f32x4 ka[4], kb2[4];
#pragma unroll
        for (int u = 0; u < 4; ++u) { const float* kp = CK + ((size_t)(b * NMEM + C.wave * 32 + k0 + u) * XH + h) * XD; ka[u] = *(const f32x4*)(kp + 4 * C.lane); kb2[u] = *(const f32x4*)(kp + 256 + 4 * C.lane); }
#pragma unroll
        for (int u = 0; u < 4; ++u) {
            float part[8];
#pragma unroll
            for (int q = 0; q < 8; ++q) part[q] = (qv[q][0] * ka[u][0] + qv[q][1] * ka[u][1]) + (qv[q][2] * ka[u][2] + qv[q][3] * ka[u][3]) + (qv[q][4] * kb2[u][0] + qv[q][5] * kb2[u][1]) + (qv[q][6] * kb2[u][2] + qv[q][7] * kb2[u][3]);
#pragma unroll
            for (int q = 0; q < 8; ++q) part[q] = wave_sum(part[q]);
            if (C.lane == 0) {
#pragma unroll
                for (int q = 0; q < 8; ++q) sS[q * 256 + C.wave * 32 + k0 + u] = part[q]; }
        }
    }
    __syncthreads();
    {
        const int q = C.wave; const f32x4 s4 = *(const LAS f32x4*)(sS + q * 256 + 4 * C.lane);
        const float mx = wave_max(fmaxf(fmaxf(s4[0], s4[1]), fmaxf(s4[2], s4[3])));
        const float p0 = exp2f(s4[0] - mx), p1 = exp2f(s4[1] - mx), p2 = exp2f(s4[2] - mx), p3 = exp2f(s4[3] - mx);
        const float inv = 1.0f / wave_sum((p0 + p1) + (p2 + p3));
        sP[(4 * C.lane + 0) * 8 + q] = p0 * inv; sP[(4 * C.lane + 1) * 8 + q] = p1 * inv; sP[(4 * C.lane + 2) * 8 + q] = p2 * inv; sP[(4 * C.lane + 3) * 8 + q] = p3 * inv;
    }
    __syncthreads();
    float acc[8];
#pragma unroll
    for (int q = 0; q < 8; ++q) acc[q] = 0.f;
    const int d = C.wave * 64 + C.lane;
    for (int k0 = 0; k0 < 256; k0 += 8) {
        float vv[8];
#pragma unroll
        for (int u = 0; u < 8; ++u) vv[u] = CV[((size_t)(b * NMEM + k0 + u) * XH + h) * XD + d];
#pragma unroll
        for (int u = 0; u < 8; ++u) { const f32x4 pa = *(const LAS f32x4*)(sP + (k0 + u) * 8), pb = *(const LAS f32x4*)(sP + (k0 + u) * 8 + 4);
            acc[0] += pa[0] * vv[u]; acc[1] += pa[1] * vv[u]; acc[2] += pa[2] * vv[u]; acc[3] += pa[3] * vv[u];
            acc[4] += pb[0] * vv[u]; acc[5] += pb[1] * vv[u]; acc[6] += pb[2] * vv[u]; acc[7] += pb[3] * vv[u]; }
    }
#pragma unroll
    for (int q = 0; q < 8; ++q) Og[(size_t)(row0 + q) * D + h * XD + d] = (bf16)f2bf(acc[q]);
    __syncthreads();
}

__device__ __forceinline__ void unpack8(const v4u u, float (&x)[8]) { x[0] = bflo(u.x); x[1] = bfhi(u.x); x[2] = bflo(u.y); x[3] = bfhi(u.y); x[4] = bflo(u.z); x[5] = bfhi(u.z); x[6] = bflo(u.w); x[7] = bfhi(u.w); }
__device__ __forceinline__ void ffn_conv_act(const Params& P, const Ctx& C) {
    unsigned char* ws = wsbase(P);
    const bf16* UP = (const bf16*)(ws + WS_UP); bf16* ACT = (bf16*)(ws + WS_ACT);
    const float* FW = inp(P, I_FDW); const float* FB = inp(P, I_FDWB); const float* SF = inp(P, I_SFFN);
    constexpr int NG = DFF / 8;
    constexpr int NRUN = 256 + 128;
    for (int it = C.bid * NT + C.tid; it < NRUN * NG; it += C.G * NT) {
        const int run = it / NG, c = (it - run * NG) * 8;
        int row0, nrow, sb = -1, t0;
        if (run < 256) { row0 = run * 32; nrow = 32; t0 = row0 & (SEQ - 1); } else { sb = run - 256; row0 = MP + 8 * sb; nrow = 8; t0 = 0; }
        float w[2][3][8], bs[2][8];
#pragma unroll
        for (int hf = 0; hf < 2; ++hf) {
#pragma unroll
            for (int j = 0; j < 3; ++j) { const f32x4 a = *(const f32x4*)(FW + j * DFF2 + hf * DFF + c), b2 = *(const f32x4*)(FW + j * DFF2 + hf * DFF + c + 4);
                w[hf][j][0] = a[0]; w[hf][j][1] = a[1]; w[hf][j][2] = a[2]; w[hf][j][3] = a[3]; w[hf][j][4] = b2[0]; w[hf][j][5] = b2[1]; w[hf][j][6] = b2[2]; w[hf][j][7] = b2[3]; }
            const f32x4 a = *(const f32x4*)(FB + hf * DFF + c), b2 = *(const f32x4*)(FB + hf * DFF + c + 4);
            bs[hf][0] = a[0]; bs[hf][1] = a[1]; bs[hf][2] = a[2]; bs[hf][3] = a[3]; bs[hf][4] = b2[0]; bs[hf][5] = b2[1]; bs[hf][6] = b2[2]; bs[hf][7] = b2[3];
        }
        float xm2[2][8], xm1[2][8];
#pragma unroll
        for (int hf = 0; hf < 2; ++hf) {
            if (sb >= 0) { const float* s = SF + (size_t)sb * 2 * DFF2 + hf * DFF + c;
                const f32x4 a = *(const f32x4*)s, b2 = *(const f32x4*)(s + 4), a1 = *(const f32x4*)(s + DFF2), b1 = *(const f32x4*)(s + DFF2 + 4);
                xm2[hf][0] = a[0]; xm2[hf][1] = a[1]; xm2[hf][2] = a[2]; xm2[hf][3] = a[3]; xm2[hf][4] = b2[0]; xm2[hf][5] = b2[1]; xm2[hf][6] = b2[2]; xm2[hf][7] = b2[3];
                xm1[hf][0] = a1[0]; xm1[hf][1] = a1[1]; xm1[hf][2] = a1[2]; xm1[hf][3] = a1[3]; xm1[hf][4] = b1[0]; xm1[hf][5] = b1[1]; xm1[hf][6] = b1[2]; xm1[hf][7] = b1[3]; }
            else if (t0 > 0) { unpack8(*(const v4u*)(UP + (size_t)(row0 - 2) * DFF2 + hf * DFF + c), xm2[hf]); unpack8(*(const v4u*)(UP + (size_t)(row0 - 1) * DFF2 + hf * DFF + c), xm1[hf]); }
            else {
#pragma unroll
                for (int e = 0; e < 8; ++e) { xm2[hf][e] = 0.f; xm1[hf][e] = 0.f; } }
        }
        for (int r0 = 0; r0 < nrow; r0 += 4) {
            v4u u[4][2];
#pragma unroll
            for (int i = 0; i < 4; ++i) { u[i][0] = *(const v4u*)(UP + (size_t)(row0 + r0 + i) * DFF2 + c); u[i][1] = *(const v4u*)(UP + (size_t)(row0 + r0 + i) * DFF2 + DFF + c); }
#pragma unroll
            for (int i = 0; i < 4; ++i) {
                float x[2][8], uc[2][8];
                unpack8(u[i][0], x[0]); unpack8(u[i][1], x[1]);
#pragma unroll
                for (int hf = 0; hf < 2; ++hf)
#pragma unroll
                    for (int e = 0; e < 8; ++e) { uc[hf][e] = bs[hf][e] + w[hf][0][e] * xm2[hf][e] + w[hf][1][e] * xm1[hf][e] + w[hf][2][e] * x[hf][e]; xm2[hf][e] = xm1[hf][e]; xm1[hf][e] = x[hf][e]; }
                float a[8];
#pragma unroll
                for (int e = 0; e < 8; ++e) a[e] = uc[0][e] * sigm(uc[0][e]) * uc[1][e];
                v4u o; o.x = pk2(a[0], a[1]); o.y = pk2(a[2], a[3]); o.z = pk2(a[4], a[5]); o.w = pk2(a[6], a[7]);
                *(v4u*)(ACT + (size_t)(row0 + r0 + i) * DFF + c) = o;
            }
        }
    }
}

template <bool COOP>
__global__ void __launch_bounds__(NT, 2) mega(Params P) {
    extern __shared__ __attribute__((aligned(16))) unsigned char lds_raw[];
    LAS unsigned char* lds = (LAS unsigned char*)lds_raw;
    Ctx C0; C0.tid = threadIdx.x; C0.lane = C0.tid & 63; C0.wave = __builtin_amdgcn_readfirstlane(C0.tid >> 6); C0.bid = blockIdx.x; C0.G = gridDim.x;
    C0.gw = C0.bid * 8 + C0.wave; C0.NGW = C0.G * 8;
    const int lo = P.ph_lo, hi = P.ph_hi;
    if (threadIdx.x < 4) ((LAS unsigned*)(lds + MISC_OFF))[threadIdx.x] = 0u;
    __syncthreads();
    XcdBarrier xbar; xbar.bar = nullptr; xbar.x = 0; xbar.st = nullptr;
    if constexpr (COOP) xbar = xcd_barrier_post((unsigned*)P.ws, (volatile LAS unsigned*)(lds + MISC_OFF));
#ifndef MK_ONLY
#define MK_ONLY -1
#endif
#define IN(k) ((MK_ONLY < 0 || MK_ONLY == (k)) && lo <= (k) && (k) < hi)
#define PH_CTX() Ctx C = C0; unsigned char* ws = wsbase(P); (void)ws; asm volatile("" : "+v"(C.tid), "+v"(C.lane), "+s"(C.wave), "+s"(C.gw), "+s"(C.bid))
#ifndef MK_REPMASK
#define MK_REPMASK 0
#endif
#define NREP(k) (((MK_REPMASK >> (k)) & 1) ? 2 : 1)
#ifndef MK_SUBMASK
#define MK_SUBMASK 0
#endif
#define SUBREP(i) for (int sr_ = 0; sr_ < ((((MK_SUBMASK) >> (i)) & 1) ? 2 : 1); ++sr_)
#define SEAM(k) do { if constexpr (COOP) { if (IN(k) && IN((k) + 1)) { if ((k) == 0) cg::this_grid().sync(); else xcd_barrier(xbar); } } } while (0)

    for (int rep_ = 0; rep_ < NREP(0); ++rep_) if (IN(0)) { PH_CTX(); p0_prologue(P, C, lds); __syncthreads(); }
    SEAM(0);
    for (int rep_ = 0; rep_ < NREP(1); ++rep_) if (IN(1)) { PH_CTX();
        { pg8::Gemm g{(const pg8::bf16_t*)(ws + WS_HB), (const pg8::bf16_t*)(ws + WS_WIN), M, NINP, D}; pg8::StaticOrder S; S.init(M, NINP, C.G, C.bid);
          pg8::EpiIn E{(pg8::bf16_t*)(ws + WS_GLU), (pg8::bf16_t*)(ws + WS_PR), P.out + O_CP, P.out + O_CS, P.out + O_SP, P.out + O_SS};
          pg8::gemm_phase<pg8::EpiIn, pg8::StaticOrder, PG8_ALIGN, PG8_SP2>(lds, g, S, E); }
        { pg8::Gemm g{(const pg8::bf16_t*)(ws + WS_MB), (const pg8::bf16_t*)(ws + WS_WKV), 1024, 4096, D}; pg8::StaticOrder S; S.init(1024, 4096, C.G, (C.bid + C.G - 24) % C.G);
          pg8::EpiKV E{P.out + O_MK, P.out + O_MV, (pg8::bf16_t*)(ws + WS_KB), (pg8::bf16_t*)(ws + WS_VT)};
          pg8::gemm_phase<pg8::EpiKV, pg8::StaticOrder, PG8_ALIGN, PG8_SP2>(lds, g, S, E); }
    }
    SEAM(1);
    for (int rep_ = 0; rep_ < NREP(2); ++rep_) if (IN(2)) { PH_CTX();
        SUBREP(0) for (int tk = C.bid; tk < 640; tk += C.G) {
            if (tk < 512) { const int b = tk >> 7, r0 = (tk & 127) * 16; conv_task<16>(P, C, lds, b * SEQ + r0, r0, -1); }
            else { const int sb = tk - 512; conv_task<8>(P, C, lds, MP + 8 * sb, 0, sb); }
        }
        SUBREP(1) for (int tk = C.bid; tk < 1152; tk += C.G) { const int rg = tk >> 2, hg = tk & 3; prep_wave(P, rg * 32 + (C.wave >> 2) * 16, hg * 4 + (C.wave & 3), C.lane); }
    }
    SEAM(2);
    for (int rep_ = 0; rep_ < NREP(3); ++rep_) if (IN(3)) { PH_CTX();
        const float* swkv = inp(P, I_SWKV);
        SUBREP(2) for (int tk = C.bid; tk < 256; tk += C.G) scan_prompt(P, C, lds, tk >> 2, tk & 3);
        SUBREP(3) for (int tk = C.bid; tk < 4096; tk += C.G) scan_sample(P, C, swkv, tk >> 1, tk & 1);
    }
    SEAM(3);
    for (int rep_ = 0; rep_ < NREP(4); ++rep_) if (IN(4)) { PH_CTX(); for (int m = C.gw; m < M; m += C.NGW) post_row(P, m, C.lane); }
    SEAM(4);
    for (int rep_ = 0; rep_ < NREP(5); ++rep_) if (IN(5)) { PH_CTX(); pg8::Gemm g{(const pg8::bf16_t*)(ws + WS_A2), (const pg8::bf16_t*)(ws + WS_WOUT), M, D, D}; pg8::StaticOrder S; S.init(M, D, C.G, C.bid);
        pg8::EpiF32 E{(float*)(ws + WS_MIX), D}; pg8::gemm_phase<pg8::EpiF32, pg8::StaticOrder, PG8_ALIGN, PG8_SP2>(lds, g, S, E); }
    SEAM(5);
    for (int rep_ = 0; rep_ < NREP(6); ++rep_) if (IN(6)) { PH_CTX(); const float* xp = inp(P, I_XP); const float* xs = inp(P, I_XS); const float* g1 = inp(P, I_NMIXPOST); const float* g2 = inp(P, I_NXAPRE);
        for (int m = C.gw; m < M; m += C.NGW) { const float* xr = m < MP ? xp + (size_t)m * D : xs + (size_t)(m - MP) * D;
        rowpass(xr, (const float*)(ws + WS_MIX) + (size_t)m * D, g1, (float*)(ws + WS_X1) + (size_t)m * D, g2, (bf16*)(ws + WS_HB) + (size_t)m * D, C.lane); } }
    SEAM(6);
    for (int rep_ = 0; rep_ < NREP(7); ++rep_) if (IN(7)) { PH_CTX(); pg8::Gemm g{(const pg8::bf16_t*)(ws + WS_HB), (const pg8::bf16_t*)(ws + WS_WQ), M, D, D}; pg8::StaticOrder S; S.init(M, D, C.G, C.bid);
        pg8::EpiBf16S E{(pg8::bf16_t*)(ws + WS_Q), D, 0.06375871479f  , nullptr};
        pg8::gemm_phase<pg8::EpiBf16S, pg8::StaticOrder, PG8_ALIGN, PG8_SP2>(lds, g, S, E); }
    SEAM(7);
    for (int rep_ = 0; rep_ < NREP(8); ++rep_) if (IN(8)) { PH_CTX();
        SUBREP(4) for (int tk = C.bid; tk < 256; tk += C.G) attn_prompt_task(P, C, lds, tk >> 6, (tk >> 4) & 3, tk & 15);
        SUBREP(5) for (int tk = C.bid; tk < 512; tk += C.G) attn_sample_task(P, C, lds, tk >> 2, tk & 3);
    }
    SEAM(8);
    for (int rep_ = 0; rep_ < NREP(9); ++rep_) if (IN(9)) { PH_CTX(); pg8::Gemm g{(const pg8::bf16_t*)(ws + WS_O), (const pg8::bf16_t*)(ws + WS_WO), M, D, D}; pg8::StaticOrder S; S.init(M, D, C.G, C.bid);
        pg8::EpiF32 E{(float*)(ws + WS_MIX), D}; pg8::gemm_phase<pg8::EpiF32, pg8::StaticOrder, PG8_ALIGN, PG8_SP2>(lds, g, S, E); }
    SEAM(9);
    for (int rep_ = 0; rep_ < NREP(10); ++rep_) if (IN(10)) { PH_CTX(); const float* g1 = inp(P, I_NXAPOST); const float* g2 = inp(P, I_NFFNPRE);
        for (int m = C.gw; m < M; m += C.NGW) { float* x1 = (float*)(ws + WS_X1) + (size_t)m * D;
        rowpass(x1, (const float*)(ws + WS_MIX) + (size_t)m * D, g1, x1, g2, (bf16*)(ws + WS_HB) + (size_t)m * D, C.lane); } }
    SEAM(10);
    for (int rep_ = 0; rep_ < NREP(11); ++rep_) if (IN(11)) { PH_CTX(); pg8::Gemm g{(const pg8::bf16_t*)(ws + WS_HB), (const pg8::bf16_t*)(ws + WS_WUP), M, DFF2, D}; pg8::StaticOrder S; S.init(M, DFF2, C.G, C.bid);
        pg8::EpiBf16S E{(pg8::bf16_t*)(ws + WS_UP), DFF2, 1.0f, P.out + O_FP};
        pg8::gemm_phase<pg8::EpiBf16S, pg8::StaticOrder, PG8_ALIGN, PG8_SP2>(lds, g, S, E); }
    SEAM(11);
    for (int rep_ = 0; rep_ < NREP(12); ++rep_) if (IN(12)) { PH_CTX(); ffn_conv_act(P, C); }
    SEAM(12);
    for (int rep_ = 0; rep_ < NREP(13); ++rep_) if (IN(13)) { PH_CTX(); pg8::Gemm g{(const pg8::bf16_t*)(ws + WS_ACT), (const pg8::bf16_t*)(ws + WS_WDN), M, D, DFF}; pg8::StaticOrder S; S.init(M, D, C.G, C.bid);
        pg8::EpiF32 E{(float*)(ws + WS_MIX), D}; pg8::gemm_phase<pg8::EpiF32, pg8::StaticOrder, PG8_ALIGN, PG8_SP2>(lds, g, S, E); }
    SEAM(13);
    for (int rep_ = 0; rep_ < NREP(14); ++rep_) if (IN(14)) { PH_CTX(); const float* g1 = inp(P, I_NFFNPOST);
        for (int m = C.gw; m < M; m += C.NGW) { const float* x2 = (const float*)(ws + WS_X1) + (size_t)m * D;
        float* yo = m < MP ? P.out + O_YP + (size_t)m * D : P.out + O_YS + (size_t)(m - MP) * D;
        rowpass(x2, (const float*)(ws + WS_MIX) + (size_t)m * D, g1, yo, nullptr, nullptr, C.lane); } }
#undef IN
#undef SEAM
}

#ifndef MK_ONE_LAUNCH
#define MK_ONE_LAUNCH 1
#endif
extern "C" void kernel_launch(void* const* d_in, const int* in_sizes, int n_in, void* d_out, int out_size, void* d_ws, size_t ws_size, hipStream_t stream) {
    static int grid = 0;
    if (grid == 0) {
        if (n_in != N_IN || (size_t)out_size != O_END || ws_size < WS_END) { fprintf(stderr, "kernel_launch: unexpected sizes: n_in %d out %d ws %zu (need %zu)\n", n_in, out_size, ws_size, (size_t)WS_END); grid = -1; return; }
        int dev = 0, cus = 0, per_cu = 0;
        (void)hipGetDevice(&dev); (void)hipDeviceGetAttribute(&cus, hipDeviceAttributeMultiprocessorCount, dev);
        (void)hipFuncSetAttribute((const void*)mega<(MK_ONE_LAUNCH != 0)>, hipFuncAttributeMaxDynamicSharedMemorySize, LDS_BYTES);
        (void)hipOccupancyMaxActiveBlocksPerMultiprocessor(&per_cu, (const void*)mega<(MK_ONE_LAUNCH != 0)>, NT, LDS_BYTES);
        fprintf(stderr, "kernel_launch: cus %d, occupancy query %d block(s)/CU, ws %zu MiB\n", cus, per_cu, ws_size >> 20);
        (void)hipGetLastError();
        grid = cus;
        if (per_cu < 1) { fprintf(stderr, "kernel_launch: occupancy query says 0 blocks per CU\n"); }
    }
    if (grid < 0) return;
    if (hipMemsetAsync(d_ws, 0, 16384, stream) != hipSuccess) { fprintf(stderr, "kernel_launch: hipMemsetAsync failed\n"); return; }
    Params p{};
    for (int i = 0; i < N_IN; ++i) p.in[i] = (const float*)d_in[i];
    p.out = (float*)d_out; p.ws = (unsigned char*)d_ws;
#if MK_ONE_LAUNCH
    p.ph_lo = 0; p.ph_hi = NPHASE;
    void* args[] = {&p};
    hipError_t e = hipLaunchCooperativeKernel((const void*)mega<true>, dim3(grid), dim3(NT), args, LDS_BYTES, stream);
    if (e != hipSuccess) fprintf(stderr, "cooperative launch failed: %s (grid %d)\n", hipGetErrorString(e), grid);
#else
    for (int ph = 0; ph < NPHASE; ++ph) { p.ph_lo = ph; p.ph_hi = ph + 1; hipLaunchKernelGGL((mega<false>), dim3(grid), dim3(NT), LDS_BYTES, stream, p); }
#endif
}
```

```cpp
#include <hip/hip_runtime.h>
#include <hip/hip_cooperative_groups.h>
#include <cstdio>
#include <cstdint>
namespace cg = cooperative_groups;
constexpr int D = 2048, MP = 8192, MS = 1024, M = MP + MS, SEQ = 2048, TS = 8, NBP = 4, NBS = 128;
constexpr int CC = 1024, CW = 31, RW = 1024, RH = 16, HD = 64;
constexpr int NRC = 3520, NRCP = 3584, NINP = 5632;
constexpr int NMEM = 256, XH = 4, XD = 512, DFF = 5632, DFF2 = 11264;
namespace pg8 {
#define PG8_LAS __attribute__((address_space(3)))
typedef unsigned short bf16_t;
typedef short bf16x8 __attribute__((ext_vector_type(8)));
typedef float f32x4 __attribute__((ext_vector_type(4)));
typedef unsigned u32x4 __attribute__((ext_vector_type(4)));
constexpr int BM = 256, BK = 64, HALF = 128, HTB = HALF * BK * 2  , STAGE_BYTES = 8 * HTB, NXCD = 8, WGM = 8;

__host__ __device__ __forceinline__ int lds_byte(int r, int c) { const int st = (r >> 4) * 2 + (c >> 5), rr = r & 15, cc = c & 31, ob = rr * 64 + cc * 2; return st * 1024 + (ob ^ (((ob >> 9) & 1) << 5)); }
__host__ __device__ __forceinline__ void stage_rc(int b, int& R, int& C) { const int st = b / 1024, sb = b % 1024, swz = sb ^ (((sb >> 9) & 1) << 5); R = (st >> 1) * 16 + swz / 64; C = (st & 1) * 32 + (swz % 64) / 2; }
__host__ __device__ __forceinline__ int perm32(int rho) { const int n = rho >> 4, i = rho & 15; return 8 * (i >> 2) + 4 * n + (i & 3); }

struct Unit { int pm, pn; };
struct Gemm { const bf16_t* A; const bf16_t* Bt; int M, N, K; };

struct StaticOrder {
    int nM, nN, nwg, G, c;
    __host__ __device__ void init(int M, int N, int G_, int c_) { nM = M / BM; nN = N / BM; nwg = nM * nN; G = G_; c = c_; }
    __host__ __device__ bool next(int i, Unit& u) const {
        const long L = (long)i * G + c; if (L >= nwg) return false;
        int wgid = (int)L; { const int q = nwg / NXCD, r = nwg % NXCD, xcd = wgid % NXCD, off = wgid / NXCD; wgid = (xcd < r ? xcd * (q + 1) : r * (q + 1) + (xcd - r) * q) + off; }
        const int nig = WGM * nN, gid = wgid / nig, fm = gid * WGM, gsz = (nM - fm) < WGM ? (nM - fm) : WGM;
        u.pm = fm + ((wgid % nig) % gsz); u.pn = (wgid % nig) / gsz; return true;
    }
    __device__ __forceinline__ void a_ready(const Unit&) const {}
    __device__ __forceinline__ void done(const Unit&) const {}
};

__device__ __forceinline__ unsigned cvt_pk_bf16(float lo, float hi) { unsigned r; asm volatile("v_cvt_pk_bf16_f32 %0, %1, %2" : "=v"(r) : "v"(lo), "v"(hi)); return r; }
typedef float f32x2 __attribute__((ext_vector_type(2)));
typedef unsigned u32x2 __attribute__((ext_vector_type(2)));
struct EpiIn {
    static constexpr bool PERM = true, AFTER_DRAIN = false;
    bf16_t* glu; bf16_t* pr; float* oconv_p; float* oconv_s; float* oshift_p; float* oshift_s;
    __device__ __forceinline__ void operator()(const f32x4 (&acc)[2][2][4][2], const Unit& u, int wr, int wc, int fr, int fq) const {
        const int row0 = u.pm * BM + wr * 64 + fr;
        if (u.pn < 8) {
#pragma unroll
            for (int ai = 0; ai < 2; ++ai)
#pragma unroll
                for (int m = 0; m < 4; ++m) {
                    const int row = row0 + ai * HALF + m * 16;
                    float* cdst = nullptr;
                    if (row < MP) { const int t = row & (SEQ - 1); if (t >= SEQ - 30) cdst = oconv_p + (size_t)((row >> 11) * 30 + (t - (SEQ - 30))) * CC; }
                    else { const int rs = row - MP; cdst = oconv_s + (size_t)((rs >> 3) * 30 + 22 + (rs & 7)) * CC; }
#pragma unroll
                    for (int bj = 0; bj < 2; ++bj) {
                        const int cgl = 16 * (8 * u.pn + 4 * bj + wc) + 4 * fq;
                        const f32x4 a = acc[ai][bj][m][0], g = acc[ai][bj][m][1];
                        f32x4 v;
#pragma unroll
                        for (int e = 0; e < 4; ++e) v[e] = a[e] / (1.0f + __expf(-g[e]));
                        u32x2 w; w.x = cvt_pk_bf16(v[0], v[1]); w.y = cvt_pk_bf16(v[2], v[3]);
                        *(u32x2*)(glu + (size_t)row * CC + cgl) = w;
                        if (cdst) *(f32x4*)(cdst + cgl) = v;
                    }
                }
        } else {
#pragma unroll
            for (int ai = 0; ai < 2; ++ai)
#pragma unroll
                for (int m = 0; m < 4; ++m) {
                    const int row = row0 + ai * HALF + m * 16;
                    float* sdst = nullptr;
                    if (row < MP) { if ((row & (SEQ - 1)) == SEQ - 1) sdst = oshift_p + (size_t)(row >> 11) * NRC; }
                    else { const int rs = row - MP; if ((rs & 7) == 7) sdst = oshift_s + (size_t)(rs >> 3) * NRC; }
#pragma unroll
                    for (int bj = 0; bj < 2; ++bj) {
                        const int jj0 = 256 * (u.pn - 8) + 128 * bj + 32 * wc + 8 * fq;
                        const f32x4 v0 = acc[ai][bj][m][0], v1 = acc[ai][bj][m][1];
                        u32x4 w; w.x = cvt_pk_bf16(v0[0], v0[1]); w.y = cvt_pk_bf16(v0[2], v0[3]); w.z = cvt_pk_bf16(v1[0], v1[1]); w.w = cvt_pk_bf16(v1[2], v1[3]);
                        *(u32x4*)(pr + (size_t)row * NRCP + jj0) = w;
                        if (sdst && jj0 < NRC) { *(f32x4*)(sdst + jj0) = v0; *(f32x4*)(sdst + jj0 + 4) = v1; }
                    }
                }
        }
    }
};
struct EpiKV {
    static constexpr bool PERM = false, AFTER_DRAIN = false;
    float* ok; float* ov; bf16_t* kb; bf16_t* vt;
    __device__ __forceinline__ void operator()(const f32x4 (&acc)[2][2][4][2], const Unit& u, int wr, int wc, int fr, int fq) const {
        const int row0 = u.pm * BM + wr * 64 + fr;
#pragma unroll
        for (int ai = 0; ai < 2; ++ai)
#pragma unroll
            for (int m = 0; m < 4; ++m) {
                const int r = row0 + ai * HALF + m * 16;
#pragma unroll
                for (int bj = 0; bj < 2; ++bj)
#pragma unroll
                    for (int n = 0; n < 2; ++n) {
                        const int c = 256 * u.pn + 128 * bj + 32 * wc + 16 * n + 4 * fq;
                        const f32x4 v = acc[ai][bj][m][n];
                        if (u.pn < 8) {
                            *(f32x4*)(ok + (size_t)r * 2048 + c) = v;
                            u32x2 w; w.x = cvt_pk_bf16(v[0], v[1]); w.y = cvt_pk_bf16(v[2], v[3]);
                            *(u32x2*)(kb + (size_t)r * 2048 + c) = w;
                        } else {
                            const int cv = c - 2048;
                            *(f32x4*)(ov + (size_t)r * 2048 + cv) = v;
                            const int b = r >> 8, key = r & 255, h = cv >> 9, d = cv & 511;
                            bf16_t* dst = vt + ((size_t)((b * 4 + h) * 512 + d)) * 256 + key;
                            const unsigned w0 = cvt_pk_bf16(v[0], v[1]), w1 = cvt_pk_bf16(v[2], v[3]);
                            dst[0] = (bf16_t)(w0 & 0xffffu); dst[256] = (bf16_t)(w0 >> 16); dst[512] = (bf16_t)(w1 & 0xffffu); dst[768] = (bf16_t)(w1 >> 16);
                        }
                    }
            }
    }
};
struct EpiF32 {
    static constexpr bool PERM = false, AFTER_DRAIN = false;
    float* C; int ldc;
    __device__ __forceinline__ void operator()(const f32x4 (&acc)[2][2][4][2], const Unit& u, int wr, int wc, int fr, int fq) const {
        const int row0 = u.pm * BM + wr * 64 + fr, col0 = u.pn * BM + wc * 32 + 4 * fq;
#pragma unroll
        for (int ai = 0; ai < 2; ++ai)
#pragma unroll
            for (int m = 0; m < 4; ++m) { float* rowp = C + (size_t)(row0 + ai * HALF + m * 16) * ldc + col0;
#pragma unroll
                for (int bj = 0; bj < 2; ++bj)
#pragma unroll
                    for (int n = 0; n < 2; ++n) *(f32x4*)(rowp + bj * HALF + n * 16) = acc[ai][bj][m][n]; }
    }
};
struct EpiBf16S {
    static constexpr bool PERM = true, AFTER_DRAIN = false;
    bf16_t* O; int ldc; float scale; float* f;
    __device__ __forceinline__ void operator()(const f32x4 (&acc)[2][2][4][2], const Unit& u, int wr, int wc, int fr, int fq) const {
        const int row0 = u.pm * BM + wr * 64 + fr, col0 = u.pn * BM + wc * 32 + 8 * fq;
#pragma unroll
        for (int ai = 0; ai < 2; ++ai)
#pragma unroll
            for (int m = 0; m < 4; ++m) {
                const int row = row0 + ai * HALF + m * 16;
                long foff = -1;
                if (f) {
                    if (row < MP) { const int t = row & (SEQ - 1); if (t >= SEQ - 2) foff = (long)((row >> 11) * 2 + (t - (SEQ - 2))) * DFF2; }
                    else { const int rs = row - MP, t = rs & 7; if (t >= 6) foff = (long)(NBP * 2 + (rs >> 3) * 2 + (t - 6)) * DFF2; }
                }
                float* fdst = f + (foff < 0 ? 0 : foff);
                bf16_t* rowp = O + (size_t)row * ldc + col0;
#pragma unroll
                for (int bj = 0; bj < 2; ++bj) {
                    const f32x4 v0 = acc[ai][bj][m][0] * scale, v1 = acc[ai][bj][m][1] * scale;
                    u32x4 w; w.x = cvt_pk_bf16(v0[0], v0[1]); w.y = cvt_pk_bf16(v0[2], v0[3]); w.z = cvt_pk_bf16(v1[0], v1[1]); w.w = cvt_pk_bf16(v1[2], v1[3]);
                    *(u32x4*)(rowp + bj * HALF) = w;
                    if (foff >= 0) { *(f32x4*)(fdst + col0 + bj * HALF) = v0; *(f32x4*)(fdst + col0 + bj * HALF + 4) = v1; }
                }
            }
    }
};

template <class Epi, class Sched, bool ALIGN_EPI = false, bool SP2 = false>
__device__ __forceinline__ void gemm_phase(PG8_LAS unsigned char* lds, const Gemm g, const Sched& S, const Epi& E) {
    int tid_ = threadIdx.x; asm volatile("" : "+v"(tid_));
    const int tid = tid_, wid = __builtin_amdgcn_readfirstlane(tid >> 6), lane = tid & 63, wr = wid >> 2, wc = wid & 3, fr = lane & 15, fq = lane >> 4;
    const int K = g.K, nt = K / BK;
    unsigned voffA[2], voffB[2];
#pragma unroll
    for (int i = 0; i < 2; ++i) { int R, C; stage_rc(tid * 16 + i * 8192, R, C); const int Rb = Epi::PERM ? ((R & ~31) + perm32(R & 31)) : R;
        voffA[i] = (unsigned)(R * K + C) * 2u; voffB[i] = (unsigned)(Rb * K + C) * 2u; }
    const size_t kstep = (size_t)(BK * 2);
    const size_t hstep = (size_t)HALF * K * 2;
    const size_t tstep = 2 * hstep;
    const unsigned ldsw = (unsigned)wid * 1024u;
    const int aoff = lds_byte(wr * 64 + fr, fq * 8), boff = lds_byte(wc * 32 + fr, fq * 8);
#define PG8_SA(b, h) (((b) * 2 + (h)) * HTB)
#define PG8_SB(b, h) ((4 + (b) * 2 + (h)) * HTB)
#define PG8_STAGE(bufoff, gbase, voff) do { _Pragma("unroll") for (int _i = 0; _i < 2; ++_i) \
        __builtin_amdgcn_global_load_lds((const unsigned*)((const char*)(gbase) + (voff)[_i]), (PG8_LAS unsigned*)(lds + (bufoff) + ldsw + _i * 8192), 16, 0, 0); } while (0)
#define PG8_LDA(dst, b, h) do { _Pragma("unroll") for (int m = 0; m < 4; ++m) _Pragma("unroll") for (int k = 0; k < 2; ++k) dst[m][k] = *(const PG8_LAS bf16x8*)(lds + PG8_SA(b, h) + aoff + m * 2048 + k * 1024); } while (0)
#define PG8_LDB(dst, b, h) do { _Pragma("unroll") for (int n = 0; n < 2; ++n) _Pragma("unroll") for (int k = 0; k < 2; ++k) dst[n][k] = *(const PG8_LAS bf16x8*)(lds + PG8_SB(b, h) + boff + n * 2048 + k * 1024); } while (0)
#define PG8_MMA(ai, bj, At, Bt) do { __builtin_amdgcn_s_setprio(1); _Pragma("unroll") for (int m = 0; m < 4; ++m) _Pragma("unroll") for (int n = 0; n < 2; ++n) _Pragma("unroll") for (int k = 0; k < 2; ++k) \
        acc[ai][bj][m][n] = __builtin_amdgcn_mfma_f32_16x16x32_bf16(Bt[n][k], At[m][k], acc[ai][bj][m][n], 0, 0, 0); __builtin_amdgcn_s_setprio(0); } while (0)
#define PG8_WAIT_V(n) asm volatile("s_waitcnt vmcnt(" #n ")" ::: "memory")
#define PG8_WAIT_L(n) asm volatile("s_waitcnt lgkmcnt(" #n ")" ::: "memory")
#define PG8_BAR __builtin_amdgcn_s_barrier()
#define PG8_SCHED __builtin_amdgcn_sched_barrier(0)
    Unit cur, nxt; int ui = 0;
    if (!S.next(0, cur)) return;
    f32x4 acc[2][2][4][2];
#pragma unroll
    for (int a = 0; a < 2; ++a)
#pragma unroll
        for (int b = 0; b < 2; ++b)
#pragma unroll
            for (int m = 0; m < 4; ++m)
#pragma unroll
                for (int n = 0; n < 2; ++n) acc[a][b][m][n] = (f32x4){0.f, 0.f, 0.f, 0.f};
    bf16x8 At[4][2], B0[2][2], B1[2][2];
    const char* cA = (const char*)g.A + (size_t)cur.pm * tstep; const char* cB = (const char*)g.Bt + (size_t)cur.pn * tstep;
    S.a_ready(cur);
    if constexpr (SP2) {
        PG8_STAGE(PG8_SB(0, 0), cB, voffB); PG8_STAGE(PG8_SB(0, 1), cB + hstep, voffB); PG8_STAGE(PG8_SA(0, 0), cA, voffA); PG8_STAGE(PG8_SA(0, 1), cA + hstep, voffA);
        if (wr == 1) PG8_BAR;
        PG8_WAIT_V(2); PG8_BAR;
        PG8_STAGE(PG8_SB(1, 0), cB + kstep, voffB); PG8_STAGE(PG8_SA(1, 0), cA + kstep, voffA); PG8_STAGE(PG8_SB(1, 1), cB + hstep + kstep, voffB);
        PG8_WAIT_V(6); PG8_BAR;
    } else {
        PG8_STAGE(PG8_SB(0, 0), cB, voffB); PG8_STAGE(PG8_SA(0, 0), cA, voffA); PG8_STAGE(PG8_SB(0, 1), cB + hstep, voffB); PG8_STAGE(PG8_SA(0, 1), cA + hstep, voffA);
        if (wr == 1) PG8_BAR;
        PG8_WAIT_V(4); PG8_BAR;
        PG8_STAGE(PG8_SB(1, 0), cB + kstep, voffB); PG8_STAGE(PG8_SA(1, 0), cA + kstep, voffA); PG8_STAGE(PG8_SB(1, 1), cB + hstep + kstep, voffB);
        PG8_WAIT_V(6); PG8_BAR;
    }
    for (;;) {
        const bool has_next = S.next(ui + 1, nxt);
        const char* nA = has_next ? (const char*)g.A + (size_t)nxt.pm * tstep : cA; const char* nB = has_next ? (const char*)g.Bt + (size_t)nxt.pn * tstep : cB;
        for (int t = 0; t < nt; t += 2) {
            const bool last = (t == nt - 2);
            const char* a1 = cA + (size_t)(t + 1) * kstep;
            const char* a2 = last ? nA : cA + (size_t)(t + 2) * kstep; const char* b2 = last ? nB : cB + (size_t)(t + 2) * kstep;
            const char* a3 = a2 + kstep; const char* b3 = b2 + kstep;
            if (last && has_next) S.a_ready(nxt);
            if constexpr (SP2) {
            PG8_LDB(B0, 0, 0); PG8_LDB(B1, 0, 1); PG8_SCHED; PG8_LDA(At, 0, 0); PG8_STAGE(PG8_SA(1, 1), a1 + hstep, voffA);
            PG8_WAIT_V(8); PG8_WAIT_L(0); PG8_BAR; PG8_MMA(0, 0, At, B0); PG8_MMA(0, 1, At, B1); PG8_BAR; PG8_SCHED;
            PG8_LDA(At, 0, 1); PG8_STAGE(PG8_SB(0, 0), b2, voffB); PG8_STAGE(PG8_SB(0, 1), b2 + hstep, voffB); PG8_STAGE(PG8_SA(0, 0), a2, voffA);
            PG8_WAIT_V(8); PG8_WAIT_L(0); PG8_BAR; PG8_MMA(1, 0, At, B0); PG8_MMA(1, 1, At, B1); PG8_BAR; PG8_SCHED;
            PG8_LDB(B0, 1, 0); PG8_LDB(B1, 1, 1); PG8_SCHED; PG8_LDA(At, 1, 0); PG8_STAGE(PG8_SA(0, 1), a2 + hstep, voffA);
            PG8_WAIT_V(8); PG8_WAIT_L(0); PG8_BAR; PG8_MMA(0, 0, At, B0); PG8_MMA(0, 1, At, B1); PG8_BAR; PG8_SCHED;
            PG8_LDA(At, 1, 1); PG8_STAGE(PG8_SB(1, 0), b3, voffB); PG8_STAGE(PG8_SB(1, 1), b3 + hstep, voffB); PG8_STAGE(PG8_SA(1, 0), a3, voffA);
            PG8_WAIT_V(8); PG8_WAIT_L(0); PG8_BAR; PG8_MMA(1, 0, At, B0); PG8_MMA(1, 1, At, B1); PG8_BAR; PG8_SCHED;
            } else {
            PG8_LDB(B0, 0, 0); PG8_SCHED; PG8_LDA(At, 0, 0); PG8_STAGE(PG8_SA(1, 1), a1 + hstep, voffA);
            PG8_WAIT_L(8); PG8_BAR; PG8_WAIT_L(0); PG8_MMA(0, 0, At, B0); PG8_BAR; PG8_SCHED;
            PG8_LDB(B1, 0, 1); PG8_STAGE(PG8_SB(0, 0), b2, voffB);
            PG8_BAR; PG8_WAIT_L(0); PG8_MMA(0, 1, At, B1); PG8_BAR;
            PG8_LDA(At, 0, 1); PG8_STAGE(PG8_SA(0, 0), a2, voffA);
            PG8_BAR; PG8_WAIT_L(0); PG8_MMA(1, 0, At, B0); PG8_BAR; PG8_SCHED;
            PG8_STAGE(PG8_SB(0, 1), b2 + hstep, voffB);
            PG8_WAIT_V(6); PG8_BAR; PG8_MMA(1, 1, At, B1); PG8_BAR;
            PG8_LDB(B0, 1, 0); PG8_SCHED; PG8_LDA(At, 1, 0); PG8_STAGE(PG8_SA(0, 1), a2 + hstep, voffA);
            PG8_WAIT_L(8); PG8_BAR; PG8_WAIT_L(0); PG8_MMA(0, 0, At, B0); PG8_BAR; PG8_SCHED;
            PG8_LDB(B1, 1, 1); PG8_STAGE(PG8_SB(1, 0), b3, voffB);
            PG8_BAR; PG8_WAIT_L(0); PG8_MMA(0, 1, At, B1); PG8_BAR;
            PG8_LDA(At, 1, 1); PG8_STAGE(PG8_SA(1, 0), a3, voffA);
            PG8_BAR; PG8_WAIT_L(0); PG8_MMA(1, 0, At, B0); PG8_BAR; PG8_SCHED;
            PG8_STAGE(PG8_SB(1, 1), b3 + hstep, voffB);
            PG8_WAIT_V(6); PG8_BAR; PG8_MMA(1, 1, At, B1); PG8_BAR;
            }
        }
        if constexpr (ALIGN_EPI) { if (wr == 0) PG8_BAR; }
        if constexpr (!Epi::AFTER_DRAIN) { E(acc, cur, wr, wc, fr, fq); S.done(cur); }
        if (!has_next) break;
#pragma unroll
        for (int a = 0; a < 2; ++a)
#pragma unroll
            for (int b = 0; b < 2; ++b)
#pragma unroll
                for (int m = 0; m < 4; ++m)
#pragma unroll
                    for (int n = 0; n < 2; ++n) acc[a][b][m][n] = (f32x4){0.f, 0.f, 0.f, 0.f};
        cur = nxt; cA = nA; cB = nB; ++ui;
        if constexpr (ALIGN_EPI) { if (wr == 1) PG8_BAR; }
    }
    PG8_WAIT_V(0);
    if constexpr (!ALIGN_EPI) { if (wr == 0) PG8_BAR; }
    PG8_BAR;
    if constexpr (Epi::AFTER_DRAIN) { E.fused(acc, cur, wr, wc, fr, fq, lds, wid, lane); S.done(cur); }
#undef PG8_SA
#undef PG8_SB
#undef PG8_STAGE
#undef PG8_LDA
#undef PG8_LDB
#undef PG8_MMA
#undef PG8_WAIT_V
#undef PG8_WAIT_L
#undef PG8_BAR
#undef PG8_SCHED
}
}
#ifndef PG8_SP2
#define PG8_SP2 true
#endif
#ifndef PG8_ALIGN
#define PG8_ALIGN true
#endif
#define LAS __attribute__((address_space(3)))
typedef unsigned short bf16;
typedef unsigned v4u __attribute__((ext_vector_type(4)));
typedef unsigned v2u __attribute__((ext_vector_type(2)));
typedef float f32x4 __attribute__((ext_vector_type(4)));
typedef float f32x2 __attribute__((ext_vector_type(2)));
typedef short bf16x8 __attribute__((ext_vector_type(8)));
constexpr int NT = 512;
constexpr int LDS_BYTES = 147456;
constexpr int NPHASE = 15;

constexpr size_t MiB = 1u << 20;
constexpr size_t WS_WIN = 1 * MiB, WS_WKV = 23 * MiB, WS_WOUT = 39 * MiB, WS_WQ = 47 * MiB, WS_WO = 55 * MiB, WS_WUP = 63 * MiB, WS_WDN = 107 * MiB;
constexpr size_t WS_LW = 129 * MiB, WS_LA = 129 * MiB + 256 * 1024, WS_LG = 129 * MiB + 512 * 1024;
constexpr size_t WS_HB = 130 * MiB, WS_MB = 166 * MiB, WS_A2 = 170 * MiB, WS_MIX = 206 * MiB, WS_X1 = 278 * MiB, WS_Q = 350 * MiB, WS_O = 386 * MiB;
constexpr size_t WS_KB = 422 * MiB, WS_VT = 426 * MiB, WS_Y = 430 * MiB, WS_G = 466 * MiB, WS_BON = 502 * MiB;
constexpr size_t WS_SHB = 818 * MiB;
constexpr size_t WS_SI = 503 * MiB, SB_STRIDE = 18 * MiB;
constexpr size_t WS_SW = WS_SI + 5 * SB_STRIDE;
constexpr size_t WS_UP = 503 * MiB;
constexpr size_t WS_GLU = 719 * MiB, WS_PR = 737 * MiB;
constexpr size_t WS_ACT = 719 * MiB;
constexpr size_t WS_END = 820 * MiB;
constexpr size_t O_YP = 0, O_YS = 16777216, O_CP = 18874368, O_CS = 18997248, O_SP = 22929408, O_SS = 22943488, O_WP = 23394048, O_WS = 23656192,
                 O_FP = 32044800, O_FS = 32134912, O_MK = 35018496, O_MV = 37115648, O_END = 39212800;

enum { I_XP = 0, I_XS, I_CK, I_CV, I_SCONV, I_SSHIFT, I_SWKV, I_SFFN, I_MEM, I_NMIXPRE, I_WIN, I_CDW, I_CDWB, I_CLNG, I_CLNB, I_MU, I_W0, I_WLORA, I_A0, I_ALORA,
       I_GLORA, I_KK, I_KA, I_RK, I_LNXG, I_LNXB, I_WOUT, I_NMIXPOST, I_NXAPRE, I_NMEM, I_WQ, I_WK, I_WV, I_WO, I_NXAPOST, I_NFFNPRE, I_WUP, I_FDW, I_FDWB, I_WDOWN,
       I_NFFNPOST, N_IN };

struct Params { const float* in[N_IN]; float* out; unsigned char* ws; int ph_lo, ph_hi; };

__device__ __forceinline__ unsigned f2bf(float f) { unsigned u = __builtin_bit_cast(unsigned, f); return (u + 0x7fffu + ((u >> 16) & 1u)) >> 16; }
__device__ __forceinline__ unsigned pk2(float lo, float hi) { return f2bf(lo) | (f2bf(hi) << 16); }
__device__ __forceinline__ float bflo(unsigned u) { return __builtin_bit_cast(float, u << 16); }
__device__ __forceinline__ float bfhi(unsigned u) { return __builtin_bit_cast(float, u & 0xffff0000u); }
__device__ __forceinline__ float wave_sum(float v) {
#pragma unroll
    for (int o = 1; o < 64; o <<= 1) v += __shfl_xor(v, o);
    return v;
}
__device__ __forceinline__ float wave_max(float v) {
#pragma unroll
    for (int o = 1; o < 64; o <<= 1) v = fmaxf(v, __shfl_xor(v, o));
    return v;
}
__device__ __forceinline__ float sigm(float x) { return 1.0f / (1.0f + __expf(-x)); }
#define LDS_WAIT() asm volatile("s_waitcnt lgkmcnt(0)" ::: "memory")

typedef __attribute__((address_space(1))) unsigned gu32;
#define XB_TMO      128
#define XB_XCNT(j)  (256  + 64 * (j))
#define XB_XSUB(j)  (1280 + 64 * (j))
#define XB_XGEN(j)  (2304 + 64 * (j))
#define XB_TOP      3328
#define XB_TOPGEN   3392
#define XCD_BAR_WORDS 3456
#define XB_SPIN_CAP (1u << 18)

__device__ __forceinline__ unsigned xb_ld(unsigned* p)              { return __hip_atomic_load(p, __ATOMIC_RELAXED, __HIP_MEMORY_SCOPE_AGENT); }
__device__ __forceinline__ unsigned xb_add(unsigned* p, unsigned v) { return __hip_atomic_fetch_add(p, v, __ATOMIC_RELAXED, __HIP_MEMORY_SCOPE_AGENT); }
__device__ __forceinline__ unsigned xb_xcc_id() { return (unsigned)__builtin_amdgcn_s_getreg((3 << 11) | 20) & 0xFu; }
#define XB_SPIN(cond, bar) do { unsigned _sp = 0; while (cond) { __builtin_amdgcn_s_sleep(1); \
    if ((++_sp & 255u) == 0u) { if (xb_ld(&(bar)[XB_TMO])) break; if (_sp > XB_SPIN_CAP) { atomicAdd(&(bar)[XB_TMO], 1u); break; } } } } while (0)

struct XcdBarrier {
    unsigned* bar; unsigned x;
    volatile LAS unsigned* st;
};

__device__ __forceinline__ XcdBarrier xcd_barrier_post(unsigned* bar, volatile LAS unsigned* st) {
    XcdBarrier b; b.bar = bar; b.x = xb_xcc_id(); b.st = st;
    if (threadIdx.x == 0) (void)xb_add(&bar[XB_XCNT(b.x)], 1u);
    return b;
}
__device__ __forceinline__ void xcd_barrier_complete(unsigned* bar, unsigned x, unsigned& nloc, unsigned& nx) {
    const unsigned G = gridDim.x * gridDim.y * gridDim.z;
    unsigned sum, cnt, mine, sp = 0u;
    for (;;) {
        sum = 0u; cnt = 0u; mine = 0u;
#pragma unroll
        for (unsigned j = 0; j < 16; ++j) { const unsigned c = xb_ld(&bar[XB_XCNT(j)]); sum += c; cnt += (c > 0u) ? 1u : 0u; mine = (j == x) ? c : mine; }
        if (sum == G) break;
        __builtin_amdgcn_s_sleep(1);
        if ((++sp & 255u) == 0u) { if (xb_ld(&bar[XB_TMO])) break; if (sp > XB_SPIN_CAP) { atomicAdd(&bar[XB_TMO], 1u); break; } }
    }
    nloc = mine > 0u ? mine : 1u; nx = cnt > 0u ? cnt : 1u;
}

__device__ __forceinline__ void xcd_barrier(const XcdBarrier& b) {
    asm volatile("s_waitcnt vmcnt(0)" ::: "memory");
    __syncthreads();
    if (threadIdx.x == 0) {
        unsigned* bar = b.bar;
        __builtin_amdgcn_s_waitcnt(0);
        unsigned nloc = b.st[0], nx = b.st[1];
        if (nloc == 0u) { xcd_barrier_complete(bar, b.x, nloc, nx); b.st[0] = nloc; b.st[1] = nx; }
        const unsigned old = xb_add(&bar[XB_XSUB(b.x)], 1u);
        const unsigned gen = old / nloc;
        if (old + 1u == (gen + 1u) * nloc) {
            __builtin_amdgcn_fence(__ATOMIC_RELEASE, "agent");
            asm volatile("s_waitcnt vmcnt(0)" ::: "memory");
            const unsigned og = xb_add(&bar[XB_TOP], 1u);
            const unsigned tg = og / nx;
            if (og + 1u == (tg + 1u) * nx) xb_add(&bar[XB_TOPGEN], 1u);
            else XB_SPIN(xb_ld(&bar[XB_TOPGEN]) == tg, bar);
            __builtin_amdgcn_fence(__ATOMIC_ACQUIRE, "agent");
            xb_add(&bar[XB_XGEN(b.x)], 1u);
            asm volatile("s_waitcnt vmcnt(0)" ::: "memory");
        } else {
            XB_SPIN(xb_ld(&bar[XB_XGEN(b.x)]) == gen, bar);
            __builtin_amdgcn_fence(__ATOMIC_ACQUIRE, "agent");
            asm volatile("s_waitcnt vmcnt(0)" ::: "memory");
        }
    }
    __syncthreads();
}

constexpr int MISC_OFF = LDS_BYTES - 64;
struct Ctx { int tid, lane, wave, bid, G, gw, NGW; };
__device__ __forceinline__ unsigned char* wsbase(const Params& P) { const unsigned long long x = (unsigned long long)P.ws; int lo = __builtin_amdgcn_readfirstlane((int)(unsigned)x), hi = __builtin_amdgcn_readfirstlane((int)(unsigned)(x >> 32));
    asm volatile("" : "+s"(lo), "+s"(hi)); return (unsigned char*)(((unsigned long long)(unsigned)hi << 32) | (unsigned)lo); }
__device__ __forceinline__ const float* inp(const Params& P, int i) { int z; asm volatile("s_mov_b32 %0, 0" : "=s"(z)); return P.in[i + z]; }

#ifndef MK_SUBMASK
#define MK_SUBMASK 0
#endif
#define SUBREP(i) for (int sr_ = 0; sr_ < ((((MK_SUBMASK) >> (i)) & 1) ? 2 : 1); ++sr_)
template <class ColMap>
__device__ __forceinline__ void transpose_item(const float* __restrict__ W, int K, int N, bf16* __restrict__ WT, int kb, int jb, int lane, ColMap cm) {
    const int kr = lane >> 4, l16 = lane & 15, k0 = 64 * kb + 16 * kr, j = 64 * jb + 4 * l16;
    const int sc = cm(j);
    f32x4 v[16];
    if (sc >= 0) {
        const float* src = W + (size_t)k0 * N + sc;
#pragma unroll
        for (int q = 0; q < 16; ++q) v[q] = __builtin_nontemporal_load((const f32x4*)(src + (size_t)q * N));
    } else {
#pragma unroll
        for (int q = 0; q < 16; ++q) v[q] = (f32x4){0.f, 0.f, 0.f, 0.f};
    }
#pragma unroll
    for (int e = 0; e < 4; ++e) {
        bf16* dst = WT + (size_t)(j + e) * K + k0;
        v4u o0, o1;
        o0.x = pk2(v[0][e], v[1][e]); o0.y = pk2(v[2][e], v[3][e]); o0.z = pk2(v[4][e], v[5][e]); o0.w = pk2(v[6][e], v[7][e]);
        o1.x = pk2(v[8][e], v[9][e]); o1.y = pk2(v[10][e], v[11][e]); o1.z = pk2(v[12][e], v[13][e]); o1.w = pk2(v[14][e], v[15][e]);
        *(v4u*)dst = o0; *(v4u*)(dst + 8) = o1;
    }
}
struct MapId { __device__ __forceinline__ int operator()(int j) const { return j; } };
struct MapIn {
    __device__ __forceinline__ int operator()(int j) const {
        if (j < 2048) { const int g = j >> 5, q = (j >> 3) & 3, n = (j >> 2) & 1, e = j & 3; return n * 1024 + 16 * g + 4 * q + e; }
        const int jj = j - 2048; return jj < NRC ? 2048 + jj : -1;
    }
};
__device__ __forceinline__ void rms_row_bf16(const float* __restrict__ xrow, const float* __restrict__ g, bf16* __restrict__ orow, int lane) {
    f32x4 v[8]; float s = 0.f;
#pragma unroll
    for (int j = 0; j < 8; ++j) { v[j] = *(const f32x4*)(xrow + 4 * (lane + 64 * j)); s += (v[j][0] * v[j][0] + v[j][1] * v[j][1]) + (v[j][2] * v[j][2] + v[j][3] * v[j][3]); }
    const float r = rsqrtf(wave_sum(s) * (1.0f / 2048.0f) + 1e-6f);
#pragma unroll
    for (int j = 0; j < 8; ++j) { const f32x4 gg = *(const f32x4*)(g + 4 * (lane + 64 * j));
        v2u o; o.x = pk2(v[j][0] * r * gg[0], v[j][1] * r * gg[1]); o.y = pk2(v[j][2] * r * gg[2], v[j][3] * r * gg[3]);
        *(v2u*)(orow + 4 * (lane + 64 * j)) = o; }
}
__device__ __forceinline__ void p0_prologue(const Params& P, const Ctx& C, LAS unsigned char* lds) {
    unsigned char* ws = wsbase(P);
    constexpr int I_IN = 32 * 88, I_SQ = 32 * 32, I_UP = 32 * 176, I_DN = 88 * 32;
    constexpr int NITEMS = I_IN + 5 * I_SQ + I_UP + I_DN;
    SUBREP(6) for (int it = C.gw; it < NITEMS; it += C.NGW) {
        int r = it;
        if (r < I_IN) { transpose_item(inp(P, I_WIN), 2048, 5568, (bf16*)(ws + WS_WIN), r / 88, r % 88, C.lane, MapIn()); continue; } r -= I_IN;
        if (r < I_SQ) { transpose_item(inp(P, I_WK), 2048, 2048, (bf16*)(ws + WS_WKV), r / 32, r % 32, C.lane, MapId()); continue; } r -= I_SQ;
        if (r < I_SQ) { transpose_item(inp(P, I_WV), 2048, 2048, (bf16*)(ws + WS_WKV) + (size_t)2048 * 2048, r / 32, r % 32, C.lane, MapId()); continue; } r -= I_SQ;
        if (r < I_SQ) { transpose_item(inp(P, I_WOUT), 2048, 2048, (bf16*)(ws + WS_WOUT), r / 32, r % 32, C.lane, MapId()); continue; } r -= I_SQ;
        if (r < I_SQ) { transpose_item(inp(P, I_WQ), 2048, 2048, (bf16*)(ws + WS_WQ), r / 32, r % 32, C.lane, MapId()); continue; } r -= I_SQ;
        if (r < I_SQ) { transpose_item(inp(P, I_WO), 2048, 2048, (bf16*)(ws + WS_WO), r / 32, r % 32, C.lane, MapId()); continue; } r -= I_SQ;
        if (r < I_UP) { transpose_item(inp(P, I_WUP), 2048, 11264, (bf16*)(ws + WS_WUP), r / 176, r % 176, C.lane, MapId()); continue; } r -= I_UP;
        transpose_item(inp(P, I_WDOWN), 5632, 2048, (bf16*)(ws + WS_WDN), r / 32, r % 32, C.lane, MapId());
    }
    const int gt = C.bid * NT + C.tid, ngt = C.G * NT;
    { bf16* d = (bf16*)(ws + WS_LW); const float* s = inp(P, I_WLORA); for (int i = gt; i < 1024 * 96; i += ngt) { const int n = i / 96, k = i - n * 96; d[i] = (bf16)f2bf(s[k * 1024 + n]); } }
    { bf16* d = (bf16*)(ws + WS_LA); const float* s = inp(P, I_ALORA); for (int i = gt; i < 1024 * 96; i += ngt) { const int n = i / 96, k = i - n * 96; d[i] = (bf16)f2bf(s[k * 1024 + n]); } }
    { bf16* d = (bf16*)(ws + WS_LG); const float* s = inp(P, I_GLORA); for (int i = gt; i < 1024 * 256; i += ngt) { const int n = i >> 8, k = i & 255; d[i] = (bf16)f2bf(s[k * 1024 + n]); } }
    SUBREP(7) for (int m = C.gw; m < M + 1024; m += C.NGW) {
        if (m < M) { const float* xr = m < MP ? inp(P, I_XP) + (size_t)m * D : inp(P, I_XS) + (size_t)(m - MP) * D; rms_row_bf16(xr, inp(P, I_NMIXPRE), (bf16*)(ws + WS_HB) + (size_t)m * D, C.lane); }
        else { const int r = m - M; rms_row_bf16(inp(P, I_MEM) + (size_t)r * D, inp(P, I_NMEM), (bf16*)(ws + WS_MB) + (size_t)r * D, C.lane); }
    }
    { bf16* d = (bf16*)(ws + WS_SHB); const float* sp = inp(P, I_SSHIFT);
      for (int i = gt; i < (NBS + 1) * NRCP; i += ngt) { const int b = i / NRCP, c = i - b * NRCP; d[i] = (b < NBS && c < NRC) ? (bf16)f2bf(sp[(size_t)b * NRC + c]) : (bf16)0; } }
    { const f32x4* s = (const f32x4*)inp(P, I_SCONV); f32x4* d = (f32x4*)(P.out + O_CS);
      for (int i = gt; i < NBS * 22 * 256; i += ngt) { const int b = i / (22 * 256), r = i - b * (22 * 256); d[(size_t)b * 30 * 256 + r] = s[(size_t)b * 30 * 256 + 8 * 256 + r]; } }
}

template <int R>
__device__ __forceinline__ void conv_task(const Params& P, const Ctx& C, LAS unsigned char* lds, int grow0  , int t0  , int sb  ) {
    unsigned char* ws = wsbase(P);
    const bf16* glu = (const bf16*)(ws + WS_GLU);
    LAS unsigned* st = (LAS unsigned*)lds;
    LAS float* red = (LAS float*)(lds + 98304);
    constexpr int NR = R + 30;
    const float* sconv = inp(P, I_SCONV); const float* cdw = inp(P, I_CDW);
    for (int p = C.tid; p < NR * 128; p += NT) {
        const int rr = p >> 7, ch = p & 127; const int t = t0 - 30 + rr;
        v4u v = (v4u){0u, 0u, 0u, 0u};
        if (t >= 0) v = *(const v4u*)(glu + (size_t)(grow0 - 30 + rr) * CC + ch * 8);
        else if (sb >= 0) { const float* s = sconv + ((size_t)sb * 30 + rr) * CC + ch * 8;
            const f32x4 a = *(const f32x4*)s, b = *(const f32x4*)(s + 4); v.x = pk2(a[0], a[1]); v.y = pk2(a[2], a[3]); v.z = pk2(b[0], b[1]); v.w = pk2(b[2], b[3]); }
        *(LAS v4u*)(st + rr * 512 + ch * 4) = v;
    }
    const int c = 2 * C.tid;
    f32x2 w[31];
#pragma unroll
    for (int j = 0; j < 31; ++j) w[j] = *(const f32x2*)(cdw + j * CC + c);
    const f32x2 bias = *(const f32x2*)(inp(P, I_CDWB) + c);
    f32x2 acc[R];
#pragma unroll
    for (int r = 0; r < R; ++r) acc[r] = bias;
    __syncthreads();
#pragma unroll
    for (int rr = 0; rr < NR; ++rr) {
        if ((rr & 3) == 0) asm volatile("" ::: "memory");
        const unsigned u = st[rr * 512 + C.tid]; const float x0 = bflo(u), x1 = bfhi(u);
#pragma unroll
        for (int r = 0; r < R; ++r) { const int j = rr - r; if (j >= 0 && j < 31) { acc[r][0] += x0 * w[j][0]; acc[r][1] += x1 * w[j][1]; } }
    }
    float s[R];
#pragma unroll
    for (int r = 0; r < R; ++r) s[r] = wave_sum(acc[r][0] + acc[r][1]);
    if (C.lane == 0) {
#pragma unroll
        for (int r = 0; r < R; ++r) red[C.wave * 16 + r] = s[r]; }
    __syncthreads();
    float mean[R];
#pragma unroll
    for (int r = 0; r < R; ++r) { float t = 0.f;
#pragma unroll
        for (int wv = 0; wv < 8; ++wv) t += red[wv * 16 + r];
        mean[r] = t * (1.0f / 1024.0f); }
    __syncthreads();
#pragma unroll
    for (int r = 0; r < R; ++r) { const float d0 = acc[r][0] - mean[r], d1 = acc[r][1] - mean[r]; acc[r][0] = d0; acc[r][1] = d1; s[r] = wave_sum(d0 * d0 + d1 * d1); }
    if (C.lane == 0) {
#pragma unroll
        for (int r = 0; r < R; ++r) red[C.wave * 16 + r] = s[r]; }
    __syncthreads();
    const f32x2 lg = *(const f32x2*)(inp(P, I_CLNG) + c), lb = *(const f32x2*)(inp(P, I_CLNB) + c);
    bf16* a2 = (bf16*)(ws + WS_A2);
#pragma unroll
    for (int r = 0; r < R; ++r) { float t = 0.f;
#pragma unroll
        for (int wv = 0; wv < 8; ++wv) t += red[wv * 16 + r];
        const float rstd = rsqrtf(t * (1.0f / 1024.0f) + 1e-5f);
        float y0 = acc[r][0] * rstd * lg[0] + lb[0], y1 = acc[r][1] * rstd * lg[1] + lb[1];
        y0 = y0 * sigm(y0); y1 = y1 * sigm(y1);
        *(unsigned*)(a2 + (size_t)(grow0 + r) * D + c) = pk2(y0, y1); }
    __syncthreads();
}

#define XS8(cp_, pp_, mp_, off_, xs_) do { const v4u cu_ = *(const v4u*)((cp_) + (off_)); const v4u pu_ = *(const v4u*)((pp_) + (off_)); \
        const f32x4 m0_ = *(const f32x4*)((mp_) + (off_)), m1_ = *(const f32x4*)((mp_) + (off_) + 4); float c_, p_; \
        c_ = bflo(cu_.x); p_ = bflo(pu_.x); xs_[0] = c_ + (p_ - c_) * m0_[0]; c_ = bfhi(cu_.x); p_ = bfhi(pu_.x); xs_[1] = c_ + (p_ - c_) * m0_[1]; \
        c_ = bflo(cu_.y); p_ = bflo(pu_.y); xs_[2] = c_ + (p_ - c_) * m0_[2]; c_ = bfhi(cu_.y); p_ = bfhi(pu_.y); xs_[3] = c_ + (p_ - c_) * m0_[3]; \
        c_ = bflo(cu_.z); p_ = bflo(pu_.z); xs_[4] = c_ + (p_ - c_) * m1_[0]; c_ = bfhi(cu_.z); p_ = bfhi(pu_.z); xs_[5] = c_ + (p_ - c_) * m1_[1]; \
        c_ = bflo(cu_.w); p_ = bflo(pu_.w); xs_[6] = c_ + (p_ - c_) * m1_[2]; c_ = bfhi(cu_.w); p_ = bfhi(pu_.w); xs_[7] = c_ + (p_ - c_) * m1_[3]; } while (0)
#define XS4(cp_, pp_, mp_, off_, xs_) do { const v2u cu_ = *(const v2u*)((cp_) + (off_)); const v2u pu_ = *(const v2u*)((pp_) + (off_)); const f32x4 m0_ = *(const f32x4*)((mp_) + (off_)); float c_, p_; \
        c_ = bflo(cu_.x); p_ = bflo(pu_.x); xs_[0] = c_ + (p_ - c_) * m0_[0]; c_ = bfhi(cu_.x); p_ = bfhi(pu_.x); xs_[1] = c_ + (p_ - c_) * m0_[1]; \
        c_ = bflo(cu_.y); p_ = bflo(pu_.y); xs_[2] = c_ + (p_ - c_) * m0_[2]; c_ = bfhi(cu_.y); p_ = bfhi(pu_.y); xs_[3] = c_ + (p_ - c_) * m0_[3]; } while (0)
__device__ __forceinline__ bf16x8 pack8(const float (&x)[8]) {
    v4u o; o.x = pk2(x[0], x[1]); o.y = pk2(x[2], x[3]); o.z = pk2(x[4], x[5]); o.w = pk2(x[6], x[7]);
    return __builtin_bit_cast(bf16x8, o);
}
__device__ __forceinline__ float tanh_fast(float x) { return 1.0f - 2.0f / (1.0f + __expf(2.0f * x)); }
template <int NH>
__device__ __forceinline__ void prep_wave(const Params& P, int rowbase, int hbase, int lane) {
    const int fr = lane & 15, fq = lane >> 4, row = rowbase + fr;
    unsigned char* ws = wsbase(P);
    const bf16* curp = (const bf16*)(ws + WS_PR) + (size_t)row * NRCP;
    const bf16* prvp = curp - NRCP;
    if (row < MP) { if ((row & (SEQ - 1)) == 0) prvp = (const bf16*)(ws + WS_SHB) + (size_t)NBS * NRCP; }
    else { const int rs = row - MP; if ((rs & 7) == 0) prvp = (const bf16*)(ws + WS_SHB) + (size_t)(rs >> 3) * NRCP; }
    const float* mup = inp(P, I_MU); const float* pkk = inp(P, I_KK); const float* pa0 = inp(P, I_A0); const float* pw0 = inp(P, I_W0); const float* pka = inp(P, I_KA); const float* prk = inp(P, I_RK);
    bf16x8 Aw[3], Aa[3], Ag[8];
    {   const bf16* c8 = curp + 3072 + 8 * fq; const bf16* p8 = prvp + 3072 + 8 * fq; const float* m8 = mup + 3072 + 8 * fq;
#pragma unroll
        for (int s = 0; s < 3; ++s) { float xs[8]; XS8(c8, p8, m8, 32 * s, xs);
#pragma unroll
            for (int e = 0; e < 8; ++e) xs[e] = tanh_fast(xs[e]);
            Aw[s] = pack8(xs); }
#pragma unroll
        for (int s = 0; s < 3; ++s) { float xs[8]; XS8(c8, p8, m8, 96 + 32 * s, xs); Aa[s] = pack8(xs); }
        asm volatile("" ::: "memory");
#pragma unroll
        for (int s = 0; s < 8; ++s) { if (s == 4) asm volatile("" ::: "memory");
            float xs[8]; XS8(c8, p8, m8, 192 + 32 * s, xs);
#pragma unroll
            for (int e = 0; e < 8; ++e) xs[e] = sigm(xs[e]);
            Ag[s] = pack8(xs); }
        asm volatile("" ::: "memory");
    }
    constexpr size_t SS = SB_STRIDE / 2;
    const f32x4 z4 = (f32x4){0.f, 0.f, 0.f, 0.f};
    const int c00 = hbase * 64 + 4 * fq;
    const bf16* c4 = curp + c00; const bf16* p4 = prvp + c00; const float* m4 = mup + c00;
    const float* qkk = pkk + c00; const float* qa0 = pa0 + c00; const float* qw0 = pw0 + c00; const float* qka = pka + c00; const float* qrk = prk + c00;
    const bf16* lw = (const bf16*)(ws + WS_LW) + (size_t)(hbase * 64 + fr) * 96 + 8 * fq; const bf16* la = (const bf16*)(ws + WS_LA) + (size_t)(hbase * 64 + fr) * 96 + 8 * fq;
    const bf16* lg = (const bf16*)(ws + WS_LG) + (size_t)(hbase * 64 + fr) * 256 + 8 * fq;
    bf16* sb = (bf16*)(ws + WS_SI) + (size_t)row * RW + c00; float* sw = (float*)(ws + WS_SW) + (size_t)row * RW + c00; bf16* gb = (bf16*)(ws + WS_G) + (size_t)row * RW + c00;
    float* bonp = (float*)(ws + WS_BON) + (size_t)row * RH + hbase;
#pragma unroll 1
    for (int hh = 0; hh < NH; ++hh) {
        float ss = 0.f;
#pragma unroll
        for (int nt = 0; nt < 4; ++nt) {
            float xk0[4]; XS4(c4, p4, m4, 1024 + 16 * nt, xk0);
            const f32x4 kkw = *(const f32x4*)(qkk + 16 * nt);
#pragma unroll
            for (int e = 0; e < 4; ++e) { const float t = xk0[e] * kkw[e]; ss += t * t; }
        }
        ss += __shfl_xor(ss, 16); ss += __shfl_xor(ss, 32);
        const float inv = 1.0f / fmaxf(sqrtf(ss), 1e-12f);
        float bon = 0.f;
#pragma unroll
        for (int nt = 0; nt < 4; ++nt) {
            asm volatile("" ::: "memory");
            f32x4 accW = z4, accA = z4, accG = z4;
            {   const bf16* lwn = lw + nt * (16 * 96); const bf16* lan = la + nt * (16 * 96); bf16x8 bw[3], ba[3];
#pragma unroll
                for (int s = 0; s < 3; ++s) { bw[s] = *(const bf16x8*)(lwn + 32 * s); ba[s] = *(const bf16x8*)(lan + 32 * s); }
#pragma unroll
                for (int s = 0; s < 3; ++s) { accW = __builtin_amdgcn_mfma_f32_16x16x32_bf16(bw[s], Aw[s], accW, 0, 0, 0); accA = __builtin_amdgcn_mfma_f32_16x16x32_bf16(ba[s], Aa[s], accA, 0, 0, 0); } }
            {   const bf16* lgn = lg + nt * (16 * 256); bf16x8 bg[8];
#pragma unroll
                for (int s = 0; s < 8; ++s) bg[s] = *(const bf16x8*)(lgn + 32 * s);
#pragma unroll
                for (int s = 0; s < 8; ++s) accG = __builtin_amdgcn_mfma_f32_16x16x32_bf16(bg[s], Ag[s], accG, 0, 0, 0); }
            float xr[4], xv[4], xkk[4];
            XS4(c4, p4, m4, 16 * nt, xr); XS4(c4, p4, m4, 1024 + 16 * nt, xkk); XS4(c4 + 2048, p4 + 2048, m4 + 2048, 16 * nt, xv);
            const f32x4 w0 = *(const f32x4*)(qw0 + 16 * nt), ka = *(const f32x4*)(qka + 16 * nt), rk = *(const f32x4*)(qrk + 16 * nt);
            const f32x4 kkw = *(const f32x4*)(qkk + 16 * nt), a0 = *(const f32x4*)(qa0 + 16 * nt);
            f32x4 vw; float vk[4], va[4], vb[4];
#pragma unroll
            for (int e = 0; e < 4; ++e) {
                const float ee = 0.6065306597126334f * sigm(w0[e] + accW[e]);
                vw[e] = __expf(-ee);
                const float a = sigm(a0[e] + accA[e]);
                const float kn = xkk[e] * kkw[e] * inv;
                const float k2 = xkk[e] * (1.0f + (a - 1.0f) * ka[e]);
                vk[e] = k2; va[e] = -kn; vb[e] = kn * a;
                bon += xr[e] * k2 * rk[e];
            }
            bf16* so = sb + 16 * nt;
            *(v2u*)(so + 0 * SS) = (v2u){pk2(xr[0], xr[1]), pk2(xr[2], xr[3])};
            *(v2u*)(so + 1 * SS) = (v2u){pk2(vk[0], vk[1]), pk2(vk[2], vk[3])};
            *(v2u*)(so + 2 * SS) = (v2u){pk2(xv[0], xv[1]), pk2(xv[2], xv[3])};
            *(v2u*)(so + 3 * SS) = (v2u){pk2(va[0], va[1]), pk2(va[2], va[3])};
            *(v2u*)(so + 4 * SS) = (v2u){pk2(vb[0], vb[1]), pk2(vb[2], vb[3])};
            *(f32x4*)(sw + 16 * nt) = vw;
            *(v2u*)(gb + 16 * nt) = (v2u){pk2(accG[0], accG[1]), pk2(accG[2], accG[3])};
        }
        bon += __shfl_xor(bon, 16); bon += __shfl_xor(bon, 32);
        if (fq == 0) bonp[hh] = bon;
        c4 += 64; p4 += 64; m4 += 64; qkk += 64; qa0 += 64; qw0 += 64; qka += 64; qrk += 64; lw += 64 * 96; la += 64 * 96; lg += 64 * 256; sb += 64; sw += 64; gb += 64;
    }
}

constexpr int TC = 32, STEPF = 5 * 64 + 16, STEPQ = STEPF / 4, CHUNKQ = TC * STEPQ;
template <int CTRL> __device__ __forceinline__ float dppf(float x) { return __builtin_bit_cast(float, __builtin_amdgcn_update_dpp(0, __builtin_bit_cast(int, x), CTRL, 0xF, 0xF, true)); }
__device__ __forceinline__ float allred16(float x) {
    x += dppf<0xB1>(x);
    x += dppf<0x4E>(x);
    x += dppf<0x141>(x);
    x += dppf<0x140>(x);
    return x;
}
#define SCAN_BAR() do { asm volatile("s_waitcnt lgkmcnt(0)" ::: "memory"); __builtin_amdgcn_s_barrier(); asm volatile("" ::: "memory"); } while (0)
#define SCAN_STEP(S01, S23, r4, w4, k4, a4, b4, v, yout) do { \
        f32x2 p2 = S01 * (f32x2){a4[0], a4[1]}; p2 = S23 * (f32x2){a4[2], a4[3]} + p2; \
        const float sa = allred16(p2[0] + p2[1]); const f32x2 sa2 = (f32x2){sa, sa}, v2 = (f32x2){v, v}; \
        f32x2 t01 = v2 * (f32x2){k4[0], k4[1]}, t23 = v2 * (f32x2){k4[2], k4[3]}; \
        t01 = sa2 * (f32x2){b4[0], b4[1]} + t01; t23 = sa2 * (f32x2){b4[2], b4[3]} + t23; \
        S01 = S01 * (f32x2){w4[0], w4[1]} + t01; S23 = S23 * (f32x2){w4[2], w4[3]} + t23; \
        f32x2 q2 = S01 * (f32x2){r4[0], r4[1]}; q2 = S23 * (f32x2){r4[2], r4[3]} + q2; \
        yout = allred16(q2[0] + q2[1]); } while (0)
__device__ __forceinline__ void scan_prompt(const Params& P, const Ctx& C, LAS unsigned char* lds, int chain, int rb) {
    unsigned char* ws = wsbase(P);
    const int b = chain >> 4, h = chain & 15, m0 = b * SEQ;
    LAS float* buf = (LAS float*)lds;
    constexpr int NCH = SEQ / TC;
    if (C.wave >= 4) {
        const int ht = C.tid - 256;
        const bf16* SB = (const bf16*)(ws + WS_SI); constexpr size_t SBS = SB_STRIDE / 2; const float* SW = (const float*)(ws + WS_SW);
        v4u stg[7];
#define SCAN_HLOAD(ck_) do { int htl = ht; asm volatile("" : "+v"(htl)); _Pragma("unroll") for (int q = 0; q < 7; ++q) { const int ip = htl + q * 256; if (ip < TC * 50) { const int t = ip / 50, p = ip - t * 50; \
            const size_t rowo = (size_t)(m0 + (ck_) * TC + t) * RW + h * 64; const void* src; \
            if (p < 32) { const int g = p >> 3; const int arr = g == 0 ? 0 : g == 1 ? 1 : g == 2 ? 3 : 4; src = SB + arr * SBS + rowo + 8 * (p & 7); } \
            else if (p < 34) src = SB + 2 * SBS + rowo + rb * 16 + 8 * (p - 32); \
            else src = SW + rowo + 4 * (p - 34); \
            stg[q] = *(const v4u*)src; } } } while (0)
#define SCAN_HWRITE(ck_) do { int htl = ht; asm volatile("" : "+v"(htl)); LAS float* dbase = buf + ((ck_) & 1) * (TC * STEPF); _Pragma("unroll") for (int q = 0; q < 7; ++q) { const int ip = htl + q * 256; if (ip < TC * 50) { const int t = ip / 50, p = ip - t * 50; \
            LAS float* d = dbase + t * STEPF; \
            if (p >= 34) *(LAS v4u*)(d + 64 + 4 * (p - 34)) = stg[q]; \
            else { const int g = p >> 3; const int off = p < 32 ? (g == 0 ? 0 : g == 1 ? 128 : g == 2 ? 192 : 256) + 8 * (p & 7) : 320 + 8 * (p - 32); \
                const v4u u = stg[q]; \
                *(LAS v4u*)(d + off) = (v4u){u.x << 16, u.x & 0xffff0000u, u.y << 16, u.y & 0xffff0000u}; \
                *(LAS v4u*)(d + off + 4) = (v4u){u.z << 16, u.z & 0xffff0000u, u.w << 16, u.w & 0xffff0000u}; } } } } while (0)
        SCAN_HLOAD(0); SCAN_HWRITE(0); SCAN_HLOAD(1);
        SCAN_BAR();
        for (int ck = 0; ck < NCH; ++ck) {
            if (ck + 1 < NCH) SCAN_HWRITE(ck + 1);
            if (ck + 2 < NCH) SCAN_HLOAD(ck + 2);
            SCAN_BAR();
        }
#undef SCAN_HLOAD
#undef SCAN_HWRITE
    } else {
        float* Y = (float*)(ws + WS_Y);
        const int rowl = C.lane >> 4, cl = C.lane & 15, irow = rb * 16 + C.wave * 4 + rowl;
        f32x2 S01 = (f32x2){0.f, 0.f}, S23 = (f32x2){0.f, 0.f};
        float yk = 0.f;
        SCAN_BAR();
        for (int ck = 0; ck < NCH; ++ck) {
            const LAS float* cb = buf + (ck & 1) * (TC * STEPF);
            f32x4 r4 = *(const LAS f32x4*)(cb + 0 * 64 + 4 * cl), w4 = *(const LAS f32x4*)(cb + 1 * 64 + 4 * cl), k4 = *(const LAS f32x4*)(cb + 2 * 64 + 4 * cl);
            f32x4 a4 = *(const LAS f32x4*)(cb + 3 * 64 + 4 * cl), b4 = *(const LAS f32x4*)(cb + 4 * 64 + 4 * cl); float v = cb[320 + C.wave * 4 + rowl];
#pragma unroll 4
            for (int t = 0; t < TC; ++t) {
                const LAS float* nb = cb + (t + 1 < TC ? t + 1 : t) * STEPF;
                const f32x4 nr = *(const LAS f32x4*)(nb + 0 * 64 + 4 * cl), nw = *(const LAS f32x4*)(nb + 1 * 64 + 4 * cl), nk = *(const LAS f32x4*)(nb + 2 * 64 + 4 * cl);
                const f32x4 na = *(const LAS f32x4*)(nb + 3 * 64 + 4 * cl), nbb = *(const LAS f32x4*)(nb + 4 * 64 + 4 * cl); const float nv = nb[320 + C.wave * 4 + rowl];
                float y; SCAN_STEP(S01, S23, r4, w4, k4, a4, b4, v, y);
                yk = (cl == (t & 15)) ? y : yk;
                if ((t & 15) == 15) Y[(size_t)(m0 + ck * TC + (t & ~15) + cl) * RW + h * 64 + irow] = yk;
                r4 = nr; w4 = nw; k4 = nk; a4 = na; b4 = nbb; v = nv;
            }
            SCAN_BAR();
        }
        float* so = P.out + O_WP + ((size_t)chain * 64 + irow) * 64 + 4 * cl;
        *(f32x4*)so = (f32x4){S01[0], S01[1], S23[0], S23[1]};
    }
    __syncthreads();
}
__device__ __forceinline__ f32x4 ld_bf4(const bf16* p) { const v2u u = *(const v2u*)p; return (f32x4){bflo(u.x), bfhi(u.x), bflo(u.y), bfhi(u.y)}; }
__device__ __forceinline__ void scan_sample(const Params& P, const Ctx& C, const float* swkv, int chain, int half) {
    unsigned char* ws = wsbase(P);
    const int b = chain >> 4, h = chain & 15, m0 = MP + 8 * b;
    const bf16* ub = (const bf16*)(ws + WS_SI) + (size_t)m0 * RW + h * 64; constexpr size_t SBS = SB_STRIDE / 2;
    const float* uw = (const float*)(ws + WS_SW) + (size_t)m0 * RW + h * 64;
    float* Y = (float*)(ws + WS_Y);
    const int rowl = C.lane >> 4, cl = C.lane & 15, irow = half * 32 + C.wave * 4 + rowl, lo = 4 * cl;
    const f32x4 s4 = *(const f32x4*)(swkv + ((size_t)chain * 64 + irow) * 64 + 4 * cl);
    f32x2 S01 = (f32x2){s4[0], s4[1]}, S23 = (f32x2){s4[2], s4[3]};
    float yk = 0.f;
#pragma unroll 2
    for (int t = 0; t < 8; ++t) {
        const bf16* ut = ub + t * RW;
        const f32x4 r4 = ld_bf4(ut + 0 * SBS + lo), k4 = ld_bf4(ut + 1 * SBS + lo), a4 = ld_bf4(ut + 3 * SBS + lo), b4 = ld_bf4(ut + 4 * SBS + lo);
        const f32x4 w4 = *(const f32x4*)(uw + t * RW + lo); const float v = bflo((unsigned)(ut + 2 * SBS)[irow]);
        float y; SCAN_STEP(S01, S23, r4, w4, k4, a4, b4, v, y);
        yk = (cl == t) ? y : yk;
    }
    if (cl < 8) Y[(size_t)(m0 + cl) * RW + h * 64 + irow] = yk;
    *(f32x4*)(P.out + O_WS + ((size_t)chain * 64 + irow) * 64 + 4 * cl) = (f32x4){S01[0], S01[1], S23[0], S23[1]};
}

__device__ __forceinline__ void post_row(const Params& P, int row, int lane) {
    unsigned char* ws = wsbase(P);
    const float* Y = (const float*)(ws + WS_Y) + (size_t)row * RW + 16 * lane;
    const bf16* V = (const bf16*)(ws + WS_SI) + 2 * (SB_STRIDE / 2) + (size_t)row * RW + 16 * lane;
    const bf16* G = (const bf16*)(ws + WS_G) + (size_t)row * RW + 16 * lane;
    const float bon = ((const float*)(ws + WS_BON))[(size_t)row * RH + (lane >> 2)];
    float y[16], s = 0.f;
#pragma unroll
    for (int q = 0; q < 4; ++q) { const f32x4 t = *(const f32x4*)(Y + 4 * q); y[4 * q] = t[0]; y[4 * q + 1] = t[1]; y[4 * q + 2] = t[2]; y[4 * q + 3] = t[3]; s += (t[0] + t[1]) + (t[2] + t[3]); }
    s += __shfl_xor(s, 1); s += __shfl_xor(s, 2);
    const float mu = s * (1.0f / 64.0f); float q2 = 0.f;
#pragma unroll
    for (int e = 0; e < 16; ++e) { y[e] -= mu; q2 += y[e] * y[e]; }
    q2 += __shfl_xor(q2, 1); q2 += __shfl_xor(q2, 2);
    const float rstd = rsqrtf(q2 * (1.0f / 64.0f) + 64e-5f);
    const float* lg = inp(P, I_LNXG) + 16 * lane; const float* lb = inp(P, I_LNXB) + 16 * lane;
    unsigned o[8];
#pragma unroll
    for (int q = 0; q < 4; ++q) { const f32x4 g4 = *(const f32x4*)(lg + 4 * q), b4 = *(const f32x4*)(lb + 4 * q), v4 = ld_bf4(V + 4 * q), gg = ld_bf4(G + 4 * q);
        float r[4];
#pragma unroll
        for (int e = 0; e < 4; ++e) r[e] = (y[4 * q + e] * rstd * g4[e] + b4[e] + bon * v4[e]) * gg[e];
        o[2 * q] = pk2(r[0], r[1]); o[2 * q + 1] = pk2(r[2], r[3]); }
    bf16* dst = (bf16*)(ws + WS_A2) + (size_t)row * D + 1024 + 16 * lane;
    *(v4u*)dst = (v4u){o[0], o[1], o[2], o[3]}; *(v4u*)(dst + 8) = (v4u){o[4], o[5], o[6], o[7]};
}

__device__ __forceinline__ void rowpass(const float* xa, const float* __restrict__ mix, const float* __restrict__ g1, float* xo,
                                        const float* __restrict__ g2, bf16* __restrict__ hb, int lane) {
    f32x4 mv[8]; float s = 0.f;
#pragma unroll
    for (int j = 0; j < 8; ++j) { mv[j] = *(const f32x4*)(mix + 4 * (lane + 64 * j)); s += (mv[j][0] * mv[j][0] + mv[j][1] * mv[j][1]) + (mv[j][2] * mv[j][2] + mv[j][3] * mv[j][3]); }
    const float r = rsqrtf(wave_sum(s) * (1.0f / 2048.0f) + 1e-6f);
    float s2 = 0.f;
#pragma unroll
    for (int j = 0; j < 8; ++j) { const f32x4 a = *(const f32x4*)(xa + 4 * (lane + 64 * j)), gg = *(const f32x4*)(g1 + 4 * (lane + 64 * j));
        mv[j] = a + mv[j] * r * gg; *(f32x4*)(xo + 4 * (lane + 64 * j)) = mv[j];
        s2 += (mv[j][0] * mv[j][0] + mv[j][1] * mv[j][1]) + (mv[j][2] * mv[j][2] + mv[j][3] * mv[j][3]); }
    if (hb) {
        const float r2 = rsqrtf(wave_sum(s2) * (1.0f / 2048.0f) + 1e-6f);
#pragma unroll
        for (int j = 0; j < 8; ++j) { const f32x4 gg = *(const f32x4*)(g2 + 4 * (lane + 64 * j));
            v2u o; o.x = pk2(mv[j][0] * r2 * gg[0], mv[j][1] * r2 * gg[1]); o.y = pk2(mv[j][2] * r2 * gg[2], mv[j][3] * r2 * gg[3]);
            *(v2u*)(hb + 4 * (lane + 64 * j)) = o; }
    }
}
__device__ __forceinline__ void attn_prompt_task(const Params& P, const Ctx& C, LAS unsigned char* lds, int b, int h, int qt) {
    unsigned char* ws = wsbase(P);
    const bf16* Qg = (const bf16*)(ws + WS_Q); const bf16* Kg = (const bf16*)(ws + WS_KB); const bf16* VTg = (const bf16*)(ws + WS_VT);
    bf16* Og = (bf16*)(ws + WS_O);
    const int fr = C.lane & 15, fq = C.lane >> 4;
    const int qrow = b * SEQ + qt * 128 + C.wave * 16 + fr;
    constexpr int BUFB = 33792;
    bf16x8 Qf[16];
#pragma unroll
    for (int s = 0; s < 16; ++s) Qf[s] = *(const bf16x8*)(Qg + (size_t)qrow * D + h * XD + 32 * s + 8 * fq);
    f32x4 accS[16];
#pragma unroll
    for (int nt = 0; nt < 16; ++nt) accS[nt] = (f32x4){0.f, 0.f, 0.f, 0.f};
    v4u stg[4];
#define ATT_GLOAD(c_) do { if ((c_) < 8) { _Pragma("unroll") for (int i = 0; i < 4; ++i) { const int idx = C.tid + i * NT, key = idx >> 3, ch = idx & 7; \
            stg[i] = *(const v4u*)(Kg + (size_t)(b * NMEM + key) * D + h * XD + (c_) * 64 + ch * 8); } } \
        else { _Pragma("unroll") for (int i = 0; i < 4; ++i) { const int idx = C.tid + i * NT, dd = idx >> 5, ch = idx & 31; \
            stg[i] = *(const v4u*)(VTg + ((size_t)((b * XH + h) * XD + ((c_) - 8) * 64 + dd)) * NMEM + ch * 8); } } } while (0)
#define ATT_SWRITE(c_) do { LAS unsigned char* sbuf = lds + ((c_) & 1) * BUFB; if ((c_) < 8) { _Pragma("unroll") for (int i = 0; i < 4; ++i) { const int idx = C.tid + i * NT, key = idx >> 3, ch = idx & 7; \
            *(LAS v4u*)(sbuf + key * 128 + ((ch ^ (key & 7)) * 16)) = stg[i]; } } \
        else { _Pragma("unroll") for (int i = 0; i < 4; ++i) { const int idx = C.tid + i * NT, dd = idx >> 5, ch = idx & 31; \
            *(LAS v4u*)(sbuf + dd * 528 + ch * 16) = stg[i]; } } } while (0)
    ATT_GLOAD(0); ATT_SWRITE(0); __syncthreads();
    bf16x8 Pf[8];
#pragma unroll
    for (int c = 0; c < 8; ++c) {
        ATT_GLOAD(c + 1);
        const LAS unsigned char* sbuf = lds + (c & 1) * BUFB;
#pragma unroll
        for (int ss = 0; ss < 2; ++ss)
#pragma unroll
            for (int nt = 0; nt < 16; ++nt) {
                const int key = 16 * nt + fr, ch = ss * 4 + fq;
                const bf16x8 kf = *(const LAS bf16x8*)(sbuf + key * 128 + ((ch ^ (key & 7)) * 16));
                accS[nt] = __builtin_amdgcn_mfma_f32_16x16x32_bf16(kf, Qf[2 * c + ss], accS[nt], 0, 0, 0);
            }
        if (c == 7) {
            float mx = -3.0e38f;
#pragma unroll
            for (int nt = 0; nt < 16; ++nt) mx = fmaxf(mx, fmaxf(fmaxf(accS[nt][0], accS[nt][1]), fmaxf(accS[nt][2], accS[nt][3])));
            mx = fmaxf(mx, __shfl_xor(mx, 16)); mx = fmaxf(mx, __shfl_xor(mx, 32));
            float sum = 0.f;
#pragma unroll
            for (int nt = 0; nt < 16; ++nt) {
#pragma unroll
                for (int e = 0; e < 4; ++e) { const float p = exp2f(accS[nt][e] - mx); accS[nt][e] = p; sum += p; } }
            sum += __shfl_xor(sum, 16); sum += __shfl_xor(sum, 32);
            const float inv = 1.0f / sum;
#pragma unroll
            for (int s = 0; s < 8; ++s) { v4u o; o.x = pk2(accS[2 * s][0] * inv, accS[2 * s][1] * inv); o.y = pk2(accS[2 * s][2] * inv, accS[2 * s][3] * inv);
                o.z = pk2(accS[2 * s + 1][0] * inv, accS[2 * s + 1][1] * inv); o.w = pk2(accS[2 * s + 1][2] * inv, accS[2 * s + 1][3] * inv); Pf[s] = __builtin_bit_cast(bf16x8, o); }
        }
        ATT_SWRITE(c + 1);
        __syncthreads();
    }
    for (int c = 8; c < 16; ++c) {
        if (c + 1 < 16) ATT_GLOAD(c + 1);
        const LAS unsigned char* sbuf = lds + (c & 1) * BUFB;
        const int dv = c - 8;
        f32x4 accO[4];
#pragma unroll
        for (int nd = 0; nd < 4; ++nd) accO[nd] = (f32x4){0.f, 0.f, 0.f, 0.f};
#pragma unroll
        for (int s = 0; s < 8; ++s)
#pragma unroll
            for (int nd = 0; nd < 4; ++nd) {
                const LAS unsigned char* rp = sbuf + (nd * 16 + fr) * 528 + (32 * s + 4 * fq) * 2;
                const v2u lo = *(const LAS v2u*)rp, hi = *(const LAS v2u*)(rp + 32);
                const bf16x8 vf = __builtin_bit_cast(bf16x8, ((v4u){lo.x, lo.y, hi.x, hi.y}));
                accO[nd] = __builtin_amdgcn_mfma_f32_16x16x32_bf16(vf, Pf[s], accO[nd], 0, 0, 0);
            }
#pragma unroll
        for (int nd = 0; nd < 4; ++nd) { v2u o; o.x = pk2(accO[nd][0], accO[nd][1]); o.y = pk2(accO[nd][2], accO[nd][3]);
            *(v2u*)(Og + (size_t)qrow * D + h * XD + dv * 64 + nd * 16 + 4 * fq) = o; }
        if (c + 1 < 16) ATT_SWRITE(c + 1);
        __syncthreads();
    }
#undef ATT_GLOAD
#undef ATT_SWRITE
}
__device__ __forceinline__ void attn_sample_task(const Params& P, const Ctx& C, LAS unsigned char* lds, int b, int h) {
    unsigned char* ws = wsbase(P);
    const bf16* Qg = (const bf16*)(ws + WS_Q); bf16* Og = (bf16*)(ws + WS_O);
    const float* CK = inp(P, I_CK); const float* CV = inp(P, I_CV);
    LAS float* sS = (LAS float*)lds;
    LAS float* sP = (LAS float*)(lds + 8192);
    const int row0 = MP + 8 * b;
    float qv[8][8];
#pragma unroll
    for (int q = 0; q < 8; ++q) { const bf16* qp = Qg + (size_t)(row0 + q) * D + h * XD;
        const v2u a = *(const v2u*)(qp + 4 * C.lane), c2 = *(const v2u*)(qp + 256 + 4 * C.lane);
        qv[q][0] = bflo(a.x); qv[q][1] = bfhi(a.x); qv[q][2] = bflo(a.y); qv[q][3] = bfhi(a.y); qv[q][4] = bflo(c2.x); qv[q][5] = bfhi(c2.x); qv[q][6] = bflo(c2.y); qv[q][7] = bfhi(c2.y); }
    for (int k0 = 0; k0 < 32; k0 += 4) {
        f32x4 ka[4], kb2[4];
#pragma unroll
        for (int u = 0; u < 4; ++u) { const float* kp = CK + ((size_t)(b * NMEM + C.wave * 32 + k0 + u) * XH + h) * XD; ka[u] = *(const f32x4*)(kp + 4 * C.lane); kb2[u] = *(const f32x4*)(kp + 256 + 4 * C.lane); }
#pragma unroll
        for (int u = 0; u < 4; ++u) {
            float part[8];
#pragma unroll
            for (int q = 0; q < 8; ++q) part[q] = (qv[q][0] * ka[u][0] + qv[q][1] * ka[u][1]) + (qv[q][2] * ka[u][2] + qv[q][3] * ka[u][3]) + (qv[q][4] * kb2[u][0] + qv[q][5] * kb2[u][1]) + (qv[q][6] * kb2[u][2] + qv[q][7] * kb2[u][3]);
#pragma unroll
            for (int q = 0; q < 8; ++q) part[q] = wave_sum(part[q]);
            if (C.lane == 0) {
#pragma unroll
                for (int q = 0; q < 8; ++q) sS[q * 256 + C.wave * 32 + k0 + u] = part[q]; }
        }
    }
    __syncthreads();
    {
        const int q = C.wave; const f32x4 s4 = *(const LAS f32x4*)(sS + q * 256 + 4 * C.lane);
        const float mx = wave_max(fmaxf(fmaxf(s4[0], s4[1]), fmaxf(s4[2], s4[3])));
        const float p0 = exp2f(s4[0] - mx), p1 = exp2f(s4[1] - mx), p2 = exp2f(s4[2] - mx), p3 = exp2f(s4[3] - mx);
        const float inv = 1.0f / wave_sum((p0 + p1) + (p2 + p3));
        sP[(4 * C.lane + 0) * 8 + q] = p0 * inv; sP[(4 * C.lane + 1) * 8 + q] = p1 * inv; sP[(4 * C.lane + 2) * 8 + q] = p2 * inv; sP[(4 * C.lane + 3) * 8 + q] = p3 * inv;
    }
    __syncthreads();
    float acc[8];
#pragma unroll
    for (int q = 0; q < 8; ++q) acc[q] = 0.f;
    const int d = C.wave * 64 + C.lane;
    for (int k0 = 0; k0 < 256; k0 += 8) {
        float vv[8];
#pragma unroll
        for (int u = 0; u < 8; ++u) vv[u] = CV[((size_t)(b * NMEM + k0 + u) * XH + h) * XD + d];
#pragma unroll
        for (int u = 0; u < 8; ++u) { const f32x4 pa = *(const LAS f32x4*)(sP + (k0 + u) * 8), pb = *(const LAS f32x4*)(sP + (k0 + u) * 8 + 4);
            acc[0] += pa[0] * vv[u]; acc[1] += pa[1] * vv[u]; acc[2] += pa[2] * vv[u]; acc[3] += pa[3] * vv[u];
            acc[4] += pb[0] * vv[u]; acc[5] += pb[1] * vv[u]; acc[6] += pb[2] * vv[u]; acc[7] += pb[3] * vv[u]; }
    }
#pragma unroll
    for (int q = 0; q < 8; ++q) Og[(size_t)(row0 + q) * D + h * XD + d] = (bf16)f2bf(acc[q]);
    __syncthreads();
}

__device__ __forceinline__ void unpack8(const v4u u, float (&x)[8]) { x[0] = bflo(u.x); x[1] = bfhi(u.x); x[2] = bflo(u.y); x[3] = bfhi(u.y); x[4] = bflo(u.z); x[5] = bfhi(u.z); x[6] = bflo(u.w); x[7] = bfhi(u.w); }
__device__ __forceinline__ void ffn_conv_act(const Params& P, const Ctx& C) {
    unsigned char* ws = wsbase(P);
    const bf16* UP = (const bf16*)(ws + WS_UP); bf16* ACT = (bf16*)(ws + WS_ACT);
    const float* FW = inp(P, I_FDW); const float* FB = inp(P, I_FDWB); const float* SF = inp(P, I_SFFN);
    constexpr int NG = DFF / 8;
    constexpr int NRUN = 256 + 128;
    for (int it = C.bid * NT + C.tid; it < NRUN * NG; it += C.G * NT) {
        const int run = it / NG, c = (it - run * NG) * 8;
        int row0, nrow, sb = -1, t0;
        if (run < 256) { row0 = run * 32; nrow = 32; t0 = row0 & (SEQ - 1); } else { sb = run - 256; row0 = MP + 8 * sb; nrow = 8; t0 = 0; }
        float w[2][3][8], bs[2][8];
#pragma unroll
        for (int hf = 0; hf < 2; ++hf) {
#pragma unroll
            for (int j = 0; j < 3; ++j) { const f32x4 a = *(const f32x4*)(FW + j * DFF2 + hf * DFF + c), b2 = *(const f32x4*)(FW + j * DFF2 + hf * DFF + c + 4);
                w[hf][j][0] = a[0]; w[hf][j][1] = a[1]; w[hf][j][2] = a[2]; w[hf][j][3] = a[3]; w[hf][j][4] = b2[0]; w[hf][j][5] = b2[1]; w[hf][j][6] = b2[2]; w[hf][j][7] = b2[3]; }
            const f32x4 a = *(const f32x4*)(FB + hf * DFF + c), b2 = *(const f32x4*)(FB + hf * DFF + c + 4);
            bs[hf][0] = a[0]; bs[hf][1] = a[1]; bs[hf][2] = a[2]; bs[hf][3] = a[3]; bs[hf][4] = b2[0]; bs[hf][5] = b2[1]; bs[hf][6] = b2[2]; bs[hf][7] = b2[3];
        }
        float xm2[2][8], xm1[2][8];
#pragma unroll
        for (int hf = 0; hf < 2; ++hf) {
            if (sb >= 0) { const float* s = SF + (size_t)sb * 2 * DFF2 + hf * DFF + c;
                const f32x4 a = *(const f32x4*)s, b2 = *(const f32x4*)(s + 4), a1 = *(const f32x4*)(s + DFF2), b1 = *(const f32x4*)(s + DFF2 + 4);
                xm2[hf][0] = a[0]; xm2[hf][1] = a[1]; xm2[hf][2] = a[2]; xm2[hf][3] = a[3]; xm2[hf][4] = b2[0]; xm2[hf][5] = b2[1]; xm2[hf][6] = b2[2]; xm2[hf][7] = b2[3];
                xm1[hf][0] = a1[0]; xm1[hf][1] = a1[1]; xm1[hf][2] = a1[2]; xm1[hf][3] = a1[3]; xm1[hf][4] = b1[0]; xm1[hf][5] = b1[1]; xm1[hf][6] = b1[2]; xm1[hf][7] = b1[3]; }
            else if (t0 > 0) { unpack8(*(const v4u*)(UP + (size_t)(row0 - 2) * DFF2 + hf * DFF + c), xm2[hf]); unpack8(*(const v4u*)(UP + (size_t)(row0 - 1) * DFF2 + hf * DFF + c), xm1[hf]); }
            else {
#pragma unroll
                for (int e = 0; e < 8; ++e) { xm2[hf][e] = 0.f; xm1[hf][e] = 0.f; } }
        }
        for (int r0 = 0; r0 < nrow; r0 += 4) {
            v4u u[4][2];
#pragma unroll
            for (int i = 0; i < 4; ++i) { u[i][0] = *(const v4u*)(UP + (size_t)(row0 + r0 + i) * DFF2 + c); u[i][1] = *(const v4u*)(UP + (size_t)(row0 + r0 + i) * DFF2 + DFF + c); }
#pragma unroll
            for (int i = 0; i < 4; ++i) {
                float x[2][8], uc[2][8];
                unpack8(u[i][0], x[0]); unpack8(u[i][1], x[1]);
#pragma unroll
                for (int hf = 0; hf < 2; ++hf)
#pragma unroll
                    for (int e = 0; e < 8; ++e) { uc[hf][e] = bs[hf][e] + w[hf][0][e] * xm2[hf][e] + w[hf][1][e] * xm1[hf][e] + w[hf][2][e] * x[hf][e]; xm2[hf][e] = xm1[hf][e]; xm1[hf][e] = x[hf][e]; }
                float a[8];
#pragma unroll
                for (int e = 0; e < 8; ++e) a[e] = uc[0][e] * sigm(uc[0][e]) * uc[1][e];
                v4u o; o.x = pk2(a[0], a[1]); o.y = pk2(a[2], a[3]); o.z = pk2(a[4], a[5]); o.w = pk2(a[6], a[7]);
                *(v4u*)(ACT + (size_t)(row0 + r0 + i) * DFF + c) = o;
            }
        }
    }
}

template <bool COOP>
__global__ void __launch_bounds__(NT, 2) mega(Params P) {
    extern __shared__ __attribute__((aligned(16))) unsigned char lds_raw[];
    LAS unsigned char* lds = (LAS unsigned char*)lds_raw;
    Ctx C0; C0.tid = threadIdx.x; C0.lane = C0.tid & 63; C0.wave = __builtin_amdgcn_readfirstlane(C0.tid >> 6); C0.bid = blockIdx.x; C0.G = gridDim.x;
    C0.gw = C0.bid * 8 + C0.wave; C0.NGW = C0.G * 8;
    const int lo = P.ph_lo, hi = P.ph_hi;
    if (threadIdx.x < 4) ((LAS unsigned*)(lds + MISC_OFF))[threadIdx.x] = 0u;
    __syncthreads();
    XcdBarrier xbar; xbar.bar = nullptr; xbar.x = 0; xbar.st = nullptr;
    if constexpr (COOP) xbar = xcd_barrier_post((unsigned*)P.ws, (volatile LAS unsigned*)(lds + MISC_OFF));
#ifndef MK_ONLY
#define MK_ONLY -1
#endif
#define IN(k) ((MK_ONLY < 0 || MK_ONLY == (k)) && lo <= (k) && (k) < hi)
#define PH_CTX() Ctx C = C0; unsigned char* ws = wsbase(P); (void)ws; asm volatile("" : "+v"(C.tid), "+v"(C.lane), "+s"(C.wave), "+s"(C.gw), "+s"(C.bid))
#ifndef MK_REPMASK
#define MK_REPMASK 0
#endif
#define NREP(k) (((MK_REPMASK >> (k)) & 1) ? 2 : 1)
#define SEAM(k) do { if constexpr (COOP) { if (IN(k) && IN((k) + 1)) { if ((k) == 0) cg::this_grid().sync(); else xcd_barrier(xbar); } } } while (0)

    for (int rep_ = 0; rep_ < NREP(0); ++rep_) if (IN(0)) { PH_CTX(); p0_prologue(P, C, lds); __syncthreads(); }
    SEAM(0);
    for (int rep_ = 0; rep_ < NREP(1); ++rep_) if (IN(1)) { PH_CTX();
        { pg8::Gemm g{(const pg8::bf16_t*)(ws + WS_HB), (const pg8::bf16_t*)(ws + WS_WIN), M, NINP, D}; pg8::StaticOrder S; S.init(M, NINP, C.G, C.bid);
          pg8::EpiIn E{(pg8::bf16_t*)(ws + WS_GLU), (pg8::bf16_t*)(ws + WS_PR), P.out + O_CP, P.out + O_CS, P.out + O_SP, P.out + O_SS};
          pg8::gemm_phase<pg8::EpiIn, pg8::StaticOrder, PG8_ALIGN, PG8_SP2>(lds, g, S, E); }
        { pg8::Gemm g{(const pg8::bf16_t*)(ws + WS_MB), (const pg8::bf16_t*)(ws + WS_WKV), 1024, 4096, D}; pg8::StaticOrder S; S.init(1024, 4096, C.G, (C.bid + C.G - 24) % C.G);
          pg8::EpiKV E{P.out + O_MK, P.out + O_MV, (pg8::bf16_t*)(ws + WS_KB), (pg8::bf16_t*)(ws + WS_VT)};
          pg8::gemm_phase<pg8::EpiKV, pg8::StaticOrder, PG8_ALIGN, PG8_SP2>(lds, g, S, E); }
    }
    SEAM(1);
    for (int rep_ = 0; rep_ < NREP(2); ++rep_) if (IN(2)) { PH_CTX();
        SUBREP(0) for (int tk = C.bid; tk < 640; tk += C.G) {
            if (tk < 512) { const int b = tk >> 7, r0 = (tk & 127) * 16; conv_task<16>(P, C, lds, b * SEQ + r0, r0, -1); }
            else { const int sb = tk - 512; conv_task<8>(P, C, lds, MP + 8 * sb, 0, sb); }
        }
        SUBREP(1) for (int wt = C.gw; wt < 1152; wt += C.NGW) prep_wave<8>(P, (wt >> 1) * 16, (wt & 1) * 8, C.lane);
    }
    SEAM(2);
    for (int rep_ = 0; rep_ < NREP(3); ++rep_) if (IN(3)) { PH_CTX();
        const float* swkv = inp(P, I_SWKV);
        SUBREP(2) for (int tk = C.bid; tk < 256; tk += C.G) scan_prompt(P, C, lds, tk >> 2, tk & 3);
        SUBREP(3) for (int tk = C.bid; tk < 4096; tk += C.G) scan_sample(P, C, swkv, tk >> 1, tk & 1);
    }
    SEAM(3);
    for (int rep_ = 0; rep_ < NREP(4); ++rep_) if (IN(4)) { PH_CTX(); for (int m = C.gw; m < M; m += C.NGW) post_row(P, m, C.lane); }
    SEAM(4);
    for (int rep_ = 0; rep_ < NREP(5); ++rep_) if (IN(5)) { PH_CTX(); pg8::Gemm g{(const pg8::bf16_t*)(ws + WS_A2), (const pg8::bf16_t*)(ws + WS_WOUT), M, D, D}; pg8::StaticOrder S; S.init(M, D, C.G, C.bid);
        pg8::EpiF32 E{(float*)(ws + WS_MIX), D}; pg8::gemm_phase<pg8::EpiF32, pg8::StaticOrder, PG8_ALIGN, PG8_SP2>(lds, g, S, E); }
    SEAM(5);
    for (int rep_ = 0; rep_ < NREP(6); ++rep_) if (IN(6)) { PH_CTX(); const float* xp = inp(P, I_XP); const float* xs = inp(P, I_XS); const float* g1 = inp(P, I_NMIXPOST); const float* g2 = inp(P, I_NXAPRE);
        for (int m = C.gw; m < M; m += C.NGW) { const float* xr = m < MP ? xp + (size_t)m * D : xs + (size_t)(m - MP) * D;
        rowpass(xr, (const float*)(ws + WS_MIX) + (size_t)m * D, g1, (float*)(ws + WS_X1) + (size_t)m * D, g2, (bf16*)(ws + WS_HB) + (size_t)m * D, C.lane); } }
    SEAM(6);
    for (int rep_ = 0; rep_ < NREP(7); ++rep_) if (IN(7)) { PH_CTX(); pg8::Gemm g{(const pg8::bf16_t*)(ws + WS_HB), (const pg8::bf16_t*)(ws + WS_WQ), M, D, D}; pg8::StaticOrder S; S.init(M, D, C.G, C.bid);
        pg8::EpiBf16S E{(pg8::bf16_t*)(ws + WS_Q), D, 0.06375871479f  , nullptr};
        pg8::gemm_phase<pg8::EpiBf16S, pg8::StaticOrder, PG8_ALIGN, PG8_SP2>(lds, g, S, E); }
    SEAM(7);
    for (int rep_ = 0; rep_ < NREP(8); ++rep_) if (IN(8)) { PH_CTX();
        SUBREP(4) for (int tk = C.bid; tk < 256; tk += C.G) attn_prompt_task(P, C, lds, tk >> 6, (tk >> 4) & 3, tk & 15);
        SUBREP(5) for (int tk = C.bid; tk < 512; tk += C.G) attn_sample_task(P, C, lds, tk >> 2, tk & 3);
    }
    SEAM(8);
    for (int rep_ = 0; rep_ < NREP(9); ++rep_) if (IN(9)) { PH_CTX(); pg8::Gemm g{(const pg8::bf16_t*)(ws + WS_O), (const pg8::bf16_t*)(ws + WS_WO), M, D, D}; pg8::StaticOrder S; S.init(M, D, C.G, C.bid);
        pg8::EpiF32 E{(float*)(ws + WS_MIX), D}; pg8::gemm_phase<pg8::EpiF32, pg8::StaticOrder, PG8_ALIGN, PG8_SP2>(lds, g, S, E); }
    SEAM(9);
    for (int rep_ = 0; rep_ < NREP(10); ++rep_) if (IN(10)) { PH_CTX(); const float* g1 = inp(P, I_NXAPOST); const float* g2 = inp(P, I_NFFNPRE);
        for (int m = C.gw; m < M; m += C.NGW) { float* x1 = (float*)(ws + WS_X1) + (size_t)m * D;
        rowpass(x1, (const float*)(ws + WS_MIX) + (size_t)m * D, g1, x1, g2, (bf16*)(ws + WS_HB) + (size_t)m * D, C.lane); } }
    SEAM(10);
    for (int rep_ = 0; rep_ < NREP(11); ++rep_) if (IN(11)) { PH_CTX(); pg8::Gemm g{(const pg8::bf16_t*)(ws + WS_HB), (const pg8::bf16_t*)(ws + WS_WUP), M, DFF2, D}; pg8::StaticOrder S; S.init(M, DFF2, C.G, C.bid);
        pg8::EpiBf16S E{(pg8::bf16_t*)(ws + WS_UP), DFF2, 1.0f, P.out + O_FP};
        pg8::gemm_phase<pg8::EpiBf16S, pg8::StaticOrder, PG8_ALIGN, PG8_SP2>(lds, g, S, E); }
    SEAM(11);
    for (int rep_ = 0; rep_ < NREP(12); ++rep_) if (IN(12)) { PH_CTX(); ffn_conv_act(P, C); }
    SEAM(12);
    for (int rep_ = 0; rep_ < NREP(13); ++rep_) if (IN(13)) { PH_CTX(); pg8::Gemm g{(const pg8::bf16_t*)(ws + WS_ACT), (const pg8::bf16_t*)(ws + WS_WDN), M, D, DFF}; pg8::StaticOrder S; S.init(M, D, C.G, C.bid);
        pg8::EpiF32 E{(float*)(ws + WS_MIX), D}; pg8::gemm_phase<pg8::EpiF32, pg8::StaticOrder, PG8_ALIGN, PG8_SP2>(lds, g, S, E); }
    SEAM(13);
    for (int rep_ = 0; rep_ < NREP(14); ++rep_) if (IN(14)) { PH_CTX(); const float* g1 = inp(P, I_NFFNPOST);
        for (int m = C.gw; m < M; m += C.NGW) { const float* x2 = (const float*)(ws + WS_X1) + (size_t)m * D;
        float* yo = m < MP ? P.out + O_YP + (size_t)m * D : P.out + O_YS + (size_t)(m - MP) * D;
        rowpass(x2, (const float*)(ws + WS_MIX) + (size_t)m * D, g1, yo, nullptr, nullptr, C.lane); } }
#undef IN
#undef SEAM
}

#ifndef MK_ONE_LAUNCH
#define MK_ONE_LAUNCH 1
#endif
extern "C" void kernel_launch(void* const* d_in, const int* in_sizes, int n_in, void* d_out, int out_size, void* d_ws, size_t ws_size, hipStream_t stream) {
    static int grid = 0;
    if (grid == 0) {
        if (n_in != N_IN || (size_t)out_size != O_END || ws_size < WS_END) { fprintf(stderr, "kernel_launch: unexpected sizes: n_in %d out %d ws %zu (need %zu)\n", n_in, out_size, ws_size, (size_t)WS_END); grid = -1; return; }
        int dev = 0, cus = 0, per_cu = 0;
        (void)hipGetDevice(&dev); (void)hipDeviceGetAttribute(&cus, hipDeviceAttributeMultiprocessorCount, dev);
        (void)hipFuncSetAttribute((const void*)mega<(MK_ONE_LAUNCH != 0)>, hipFuncAttributeMaxDynamicSharedMemorySize, LDS_BYTES);
        (void)hipOccupancyMaxActiveBlocksPerMultiprocessor(&per_cu, (const void*)mega<(MK_ONE_LAUNCH != 0)>, NT, LDS_BYTES);
        fprintf(stderr, "kernel_launch: cus %d, occupancy query %d block(s)/CU, ws %zu MiB\n", cus, per_cu, ws_size >> 20);
        (void)hipGetLastError();
        grid = cus;
        if (per_cu < 1) { fprintf(stderr, "kernel_launch: occupancy query says 0 blocks per CU\n"); }
    }
    if (grid < 0) return;
    if (hipMemsetAsync(d_ws, 0, 16384, stream) != hipSuccess) { fprintf(stderr, "kernel_launch: hipMemsetAsync failed\n"); return; }
    Params p{};
    for (int i = 0; i < N_IN; ++i) p.in[i] = (const float*)d_in[i];
    p.out = (float*)d_out; p.ws = (unsigned char*)d_ws;
#if MK_ONE_LAUNCH
    p.ph_lo = 0; p.ph_hi = NPHASE;
    void* args[] = {&p};
    hipError_t e = hipLaunchCooperativeKernel((const void*)mega<true>, dim3(grid), dim3(NT), args, LDS_BYTES, stream);
    if (e != hipSuccess) fprintf(stderr, "cooperative launch failed: %s (grid %d)\n", hipGetErrorString(e), grid);
#else
    for (int ph = 0; ph < NPHASE; ++ph) { p.ph_lo = ph; p.ph_hi = ph + 1; hipLaunchKernelGGL((mega<false>), dim3(grid), dim3(NT), LDS_BYTES, stream, p); }
#endif
}
```

```cpp
#include <hip/hip_runtime.h>
#include <hip/hip_cooperative_groups.h>
#include <cstdio>
#include <cstdint>
namespace cg = cooperative_groups;
constexpr int D = 2048, MP = 8192, MS = 1024, M = MP + MS, SEQ = 2048, TS = 8, NBP = 4, NBS = 128;
constexpr int CC = 1024, CW = 31, RW = 1024, RH = 16, HD = 64;
constexpr int NRC = 3520, NRCP = 3584, NINP = 5632;
constexpr int NMEM = 256, XH = 4, XD = 512, DFF = 5632, DFF2 = 11264;
namespace pg8 {
#define PG8_LAS __attribute__((address_space(3)))
typedef unsigned short bf16_t;
typedef short bf16x8 __attribute__((ext_vector_type(8)));
typedef float f32x4 __attribute__((ext_vector_type(4)));
typedef unsigned u32x4 __attribute__((ext_vector_type(4)));
constexpr int BM = 256, BK = 64, HALF = 128, HTB = HALF * BK * 2  , STAGE_BYTES = 8 * HTB, NXCD = 8, WGM = 8;

__host__ __device__ __forceinline__ int lds_byte(int r, int c) { const int st = (r >> 4) * 2 + (c >> 5), rr = r & 15, cc = c & 31, ob = rr * 64 + cc * 2; return st * 1024 + (ob ^ (((ob >> 9) & 1) << 5)); }
__host__ __device__ __forceinline__ void stage_rc(int b, int& R, int& C) { const int st = b / 1024, sb = b % 1024, swz = sb ^ (((sb >> 9) & 1) << 5); R = (st >> 1) * 16 + swz / 64; C = (st & 1) * 32 + (swz % 64) / 2; }
__host__ __device__ __forceinline__ int perm32(int rho) { const int n = rho >> 4, i = rho & 15; return 8 * (i >> 2) + 4 * n + (i & 3); }

struct Unit { int pm, pn; };
struct Gemm { const bf16_t* A; const bf16_t* Bt; int M, N, K; };

struct StaticOrder {
    int nM, nN, nwg, G, c;
    __host__ __device__ void init(int M, int N, int G_, int c_) { nM = M / BM; nN = N / BM; nwg = nM * nN; G = G_; c = c_; }
    __host__ __device__ bool next(int i, Unit& u) const {
        const long L = (long)i * G + c; if (L >= nwg) return false;
        int wgid = (int)L; { const int q = nwg / NXCD, r = nwg % NXCD, xcd = wgid % NXCD, off = wgid / NXCD; wgid = (xcd < r ? xcd * (q + 1) : r * (q + 1) + (xcd - r) * q) + off; }
        const int nig = WGM * nN, gid = wgid / nig, fm = gid * WGM, gsz = (nM - fm) < WGM ? (nM - fm) : WGM;
        u.pm = fm + ((wgid % nig) % gsz); u.pn = (wgid % nig) / gsz; return true;
    }
    __device__ __forceinline__ void a_ready(const Unit&) const {}
    __device__ __forceinline__ void done(const Unit&) const {}
};

__device__ __forceinline__ unsigned cvt_pk_bf16(float lo, float hi) { unsigned r; asm volatile("v_cvt_pk_bf16_f32 %0, %1, %2" : "=v"(r) : "v"(lo), "v"(hi)); return r; }
typedef float f32x2 __attribute__((ext_vector_type(2)));
typedef unsigned u32x2 __attribute__((ext_vector_type(2)));
struct EpiIn {
    static constexpr bool PERM = true, AFTER_DRAIN = false;
    bf16_t* glu; bf16_t* pr; float* oconv_p; float* oconv_s; float* oshift_p; float* oshift_s;
    __device__ __forceinline__ void operator()(const f32x4 (&acc)[2][2][4][2], const Unit& u, int wr, int wc, int fr, int fq) const {
        const int row0 = u.pm * BM + wr * 64 + fr;
        if (u.pn < 8) {
#pragma unroll
            for (int ai = 0; ai < 2; ++ai)
#pragma unroll
                for (int m = 0; m < 4; ++m) {
                    const int row = row0 + ai * HALF + m * 16;
                    float* cdst = nullptr;
                    if (row < MP) { const int t = row & (SEQ - 1); if (t >= SEQ - 30) cdst = oconv_p + (size_t)((row >> 11) * 30 + (t - (SEQ - 30))) * CC; }
                    else { const int rs = row - MP; cdst = oconv_s + (size_t)((rs >> 3) * 30 + 22 + (rs & 7)) * CC; }
#pragma unroll
                    for (int bj = 0; bj < 2; ++bj) {
                        const int cgl = 16 * (8 * u.pn + 4 * bj + wc) + 4 * fq;
                        const f32x4 a = acc[ai][bj][m][0], g = acc[ai][bj][m][1];
                        f32x4 v;
#pragma unroll
                        for (int e = 0; e < 4; ++e) v[e] = a[e] / (1.0f + __expf(-g[e]));
                        u32x2 w; w.x = cvt_pk_bf16(v[0], v[1]); w.y = cvt_pk_bf16(v[2], v[3]);
                        *(u32x2*)(glu + (size_t)row * CC + cgl) = w;
                        if (cdst) *(f32x4*)(cdst + cgl) = v;
                    }
                }
        } else {
#pragma unroll
            for (int ai = 0; ai < 2; ++ai)
#pragma unroll
                for (int m = 0; m < 4; ++m) {
                    const int row = row0 + ai * HALF + m * 16;
                    float* sdst = nullptr;
                    if (row < MP) { if ((row & (SEQ - 1)) == SEQ - 1) sdst = oshift_p + (size_t)(row >> 11) * NRC; }
                    else { const int rs = row - MP; if ((rs & 7) == 7) sdst = oshift_s + (size_t)(rs >> 3) * NRC; }
#pragma unroll
                    for (int bj = 0; bj < 2; ++bj) {
                        const int jj0 = 256 * (u.pn - 8) + 128 * bj + 32 * wc + 8 * fq;
                        const f32x4 v0 = acc[ai][bj][m][0], v1 = acc[ai][bj][m][1];
                        u32x4 w; w.x = cvt_pk_bf16(v0[0], v0[1]); w.y = cvt_pk_bf16(v0[2], v0[3]); w.z = cvt_pk_bf16(v1[0], v1[1]); w.w = cvt_pk_bf16(v1[2], v1[3]);
                        *(u32x4*)(pr + (size_t)row * NRCP + jj0) = w;
                        if (sdst && jj0 < NRC) { *(f32x4*)(sdst + jj0) = v0; *(f32x4*)(sdst + jj0 + 4) = v1; }
                    }
                }
        }
    }
};
struct EpiKV {
    static constexpr bool PERM = false, AFTER_DRAIN = false;
    float* ok; float* ov; bf16_t* kb; bf16_t* vt;
    __device__ __forceinline__ void operator()(const f32x4 (&acc)[2][2][4][2], const Unit& u, int wr, int wc, int fr, int fq) const {
        const int row0 = u.pm * BM + wr * 64 + fr;
#pragma unroll
        for (int ai = 0; ai < 2; ++ai)
#pragma unroll
            for (int m = 0; m < 4; ++m) {
                const int r = row0 + ai * HALF + m * 16;
#pragma unroll
                for (int bj = 0; bj < 2; ++bj)
#pragma unroll
                    for (int n = 0; n < 2; ++n) {
                        const int c = 256 * u.pn + 128 * bj + 32 * wc + 16 * n + 4 * fq;
                        const f32x4 v = acc[ai][bj][m][n];
                        if (u.pn < 8) {
                            *(f32x4*)(ok + (size_t)r * 2048 + c) = v;
                            u32x2 w; w.x = cvt_pk_bf16(v[0], v[1]); w.y = cvt_pk_bf16(v[2], v[3]);
                            *(u32x2*)(kb + (size_t)r * 2048 + c) = w;
                        } else {
                            const int cv = c - 2048;
                            *(f32x4*)(ov + (size_t)r * 2048 + cv) = v;
                            const int b = r >> 8, key = r & 255, h = cv >> 9, d = cv & 511;
                            bf16_t* dst = vt + ((size_t)((b * 4 + h) * 512 + d)) * 256 + key;
                            const unsigned w0 = cvt_pk_bf16(v[0], v[1]), w1 = cvt_pk_bf16(v[2], v[3]);
                            dst[0] = (bf16_t)(w0 & 0xffffu); dst[256] = (bf16_t)(w0 >> 16); dst[512] = (bf16_t)(w1 & 0xffffu); dst[768] = (bf16_t)(w1 >> 16);
                        }
                    }
            }
    }
};
struct EpiF32 {
    static constexpr bool PERM = false, AFTER_DRAIN = false;
    float* C; int ldc;
    __device__ __forceinline__ void operator()(const f32x4 (&acc)[2][2][4][2], const Unit& u, int wr, int wc, int fr, int fq) const {
        const int row0 = u.pm * BM + wr * 64 + fr, col0 = u.pn * BM + wc * 32 + 4 * fq;
#pragma unroll
        for (int ai = 0; ai < 2; ++ai)
#pragma unroll
            for (int m = 0; m < 4; ++m) { float* rowp = C + (size_t)(row0 + ai * HALF + m * 16) * ldc + col0;
#pragma unroll
                for (int bj = 0; bj < 2; ++bj)
#pragma unroll
                    for (int n = 0; n < 2; ++n) *(f32x4*)(rowp + bj * HALF + n * 16) = acc[ai][bj][m][n]; }
    }
};
struct EpiBf16S {
    static constexpr bool PERM = true, AFTER_DRAIN = false;
    bf16_t* O; int ldc; float scale; float* f;
    __device__ __forceinline__ void operator()(const f32x4 (&acc)[2][2][4][2], const Unit& u, int wr, int wc, int fr, int fq) const {
        const int row0 = u.pm * BM + wr * 64 + fr, col0 = u.pn * BM + wc * 32 + 8 * fq;
#pragma unroll
        for (int ai = 0; ai < 2; ++ai)
#pragma unroll
            for (int m = 0; m < 4; ++m) {
                const int row = row0 + ai * HALF + m * 16;
                long foff = -1;
                if (f) {
                    if (row < MP) { const int t = row & (SEQ - 1); if (t >= SEQ - 2) foff = (long)((row >> 11) * 2 + (t - (SEQ - 2))) * DFF2; }
                    else { const int rs = row - MP, t = rs & 7; if (t >= 6) foff = (long)(NBP * 2 + (rs >> 3) * 2 + (t - 6)) * DFF2; }
                }
                float* fdst = f + (foff < 0 ? 0 : foff);
                bf16_t* rowp = O + (size_t)row * ldc + col0;
#pragma unroll
                for (int bj = 0; bj < 2; ++bj) {
                    const f32x4 v0 = acc[ai][bj][m][0] * scale, v1 = acc[ai][bj][m][1] * scale;
                    u32x4 w; w.x = cvt_pk_bf16(v0[0], v0[1]); w.y = cvt_pk_bf16(v0[2], v0[3]); w.z = cvt_pk_bf16(v1[0], v1[1]); w.w = cvt_pk_bf16(v1[2], v1[3]);
                    *(u32x4*)(rowp + bj * HALF) = w;
                    if (foff >= 0) { *(f32x4*)(fdst + col0 + bj * HALF) = v0; *(f32x4*)(fdst + col0 + bj * HALF + 4) = v1; }
                }
            }
    }
};

template <class Epi, class Sched, bool ALIGN_EPI = false, bool SP2 = false>
__device__ __forceinline__ void gemm_phase(PG8_LAS unsigned char* lds, const Gemm g, const Sched& S, const Epi& E) {
    int tid_ = threadIdx.x; asm volatile("" : "+v"(tid_));
    const int tid = tid_, wid = __builtin_amdgcn_readfirstlane(tid >> 6), lane = tid & 63, wr = wid >> 2, wc = wid & 3, fr = lane & 15, fq = lane >> 4;
    const int K = g.K, nt = K / BK;
    unsigned voffA[2], voffB[2];
#pragma unroll
    for (int i = 0; i < 2; ++i) { int R, C; stage_rc(tid * 16 + i * 8192, R, C); const int Rb = Epi::PERM ? ((R & ~31) + perm32(R & 31)) : R;
        voffA[i] = (unsigned)(R * K + C) * 2u; voffB[i] = (unsigned)(Rb * K + C) * 2u; }
    const size_t kstep = (size_t)(BK * 2);
    const size_t hstep = (size_t)HALF * K * 2;
    const size_t tstep = 2 * hstep;
    const unsigned ldsw = (unsigned)wid * 1024u;
    const int aoff = lds_byte(wr * 64 + fr, fq * 8), boff = lds_byte(wc * 32 + fr, fq * 8);
#define PG8_SA(b, h) (((b) * 2 + (h)) * HTB)
#define PG8_SB(b, h) ((4 + (b) * 2 + (h)) * HTB)
#define PG8_STAGE(bufoff, gbase, voff) do { _Pragma("unroll") for (int _i = 0; _i < 2; ++_i) \
        __builtin_amdgcn_global_load_lds((const unsigned*)((const char*)(gbase) + (voff)[_i]), (PG8_LAS unsigned*)(lds + (bufoff) + ldsw + _i * 8192), 16, 0, 0); } while (0)
#define PG8_LDA(dst, b, h) do { _Pragma("unroll") for (int m = 0; m < 4; ++m) _Pragma("unroll") for (int k = 0; k < 2; ++k) dst[m][k] = *(const PG8_LAS bf16x8*)(lds + PG8_SA(b, h) + aoff + m * 2048 + k * 1024); } while (0)
#define PG8_LDB(dst, b, h) do { _Pragma("unroll") for (int n = 0; n < 2; ++n) _Pragma("unroll") for (int k = 0; k < 2; ++k) dst[n][k] = *(const PG8_LAS bf16x8*)(lds + PG8_SB(b, h) + boff + n * 2048 + k * 1024); } while (0)
#define PG8_MMA(ai, bj, At, Bt) do { __builtin_amdgcn_s_setprio(1); _Pragma("unroll") for (int m = 0; m < 4; ++m) _Pragma("unroll") for (int n = 0; n < 2; ++n) _Pragma("unroll") for (int k = 0; k < 2; ++k) \
        acc[ai][bj][m][n] = __builtin_amdgcn_mfma_f32_16x16x32_bf16(Bt[n][k], At[m][k], acc[ai][bj][m][n], 0, 0, 0); __builtin_amdgcn_s_setprio(0); } while (0)
#define PG8_WAIT_V(n) asm volatile("s_waitcnt vmcnt(" #n ")" ::: "memory")
#define PG8_WAIT_L(n) asm volatile("s_waitcnt lgkmcnt(" #n ")" ::: "memory")
#define PG8_BAR __builtin_amdgcn_s_barrier()
#define PG8_SCHED __builtin_amdgcn_sched_barrier(0)
    Unit cur, nxt; int ui = 0;
    if (!S.next(0, cur)) return;
    f32x4 acc[2][2][4][2];
#pragma unroll
    for (int a = 0; a < 2; ++a)
#pragma unroll
        for (int b = 0; b < 2; ++b)
#pragma unroll
            for (int m = 0; m < 4; ++m)
#pragma unroll
                for (int n = 0; n < 2; ++n) acc[a][b][m][n] = (f32x4){0.f, 0.f, 0.f, 0.f};
    bf16x8 At[4][2], B0[2][2], B1[2][2];
    const char* cA = (const char*)g.A + (size_t)cur.pm * tstep; const char* cB = (const char*)g.Bt + (size_t)cur.pn * tstep;
    S.a_ready(cur);
    if constexpr (SP2) {
        PG8_STAGE(PG8_SB(0, 0), cB, voffB); PG8_STAGE(PG8_SB(0, 1), cB + hstep, voffB); PG8_STAGE(PG8_SA(0, 0), cA, voffA); PG8_STAGE(PG8_SA(0, 1), cA + hstep, voffA);
        if (wr == 1) PG8_BAR;
        PG8_WAIT_V(2); PG8_BAR;
        PG8_STAGE(PG8_SB(1, 0), cB + kstep, voffB); PG8_STAGE(PG8_SA(1, 0), cA + kstep, voffA); PG8_STAGE(PG8_SB(1, 1), cB + hstep + kstep, voffB);
        PG8_WAIT_V(6); PG8_BAR;
    } else {
        PG8_STAGE(PG8_SB(0, 0), cB, voffB); PG8_STAGE(PG8_SA(0, 0), cA, voffA); PG8_STAGE(PG8_SB(0, 1), cB + hstep, voffB); PG8_STAGE(PG8_SA(0, 1), cA + hstep, voffA);
        if (wr == 1) PG8_BAR;
        PG8_WAIT_V(4); PG8_BAR;
        PG8_STAGE(PG8_SB(1, 0), cB + kstep, voffB); PG8_STAGE(PG8_SA(1, 0), cA + kstep, voffA); PG8_STAGE(PG8_SB(1, 1), cB + hstep + kstep, voffB);
        PG8_WAIT_V(6); PG8_BAR;
    }
    for (;;) {
        const bool has_next = S.next(ui + 1, nxt);
        const char* nA = has_next ? (const char*)g.A + (size_t)nxt.pm * tstep : cA; const char* nB = has_next ? (const char*)g.Bt + (size_t)nxt.pn * tstep : cB;
        for (int t = 0; t < nt; t += 2) {
            const bool last = (t == nt - 2);
            const char* a1 = cA + (size_t)(t + 1) * kstep;
            const char* a2 = last ? nA : cA + (size_t)(t + 2) * kstep; const char* b2 = last ? nB : cB + (size_t)(t + 2) * kstep;
            const char* a3 = a2 + kstep; const char* b3 = b2 + kstep;
            if (last && has_next) S.a_ready(nxt);
            if constexpr (SP2) {
            PG8_LDB(B0, 0, 0); PG8_LDB(B1, 0, 1); PG8_SCHED; PG8_LDA(At, 0, 0); PG8_STAGE(PG8_SA(1, 1), a1 + hstep, voffA);
            PG8_WAIT_V(8); PG8_WAIT_L(0); PG8_BAR; PG8_MMA(0, 0, At, B0); PG8_MMA(0, 1, At, B1); PG8_BAR; PG8_SCHED;
            PG8_LDA(At, 0, 1); PG8_STAGE(PG8_SB(0, 0), b2, voffB); PG8_STAGE(PG8_SB(0, 1), b2 + hstep, voffB); PG8_STAGE(PG8_SA(0, 0), a2, voffA);
            PG8_WAIT_V(8); PG8_WAIT_L(0); PG8_BAR; PG8_MMA(1, 0, At, B0); PG8_MMA(1, 1, At, B1); PG8_BAR; PG8_SCHED;
            PG8_LDB(B0, 1, 0); PG8_LDB(B1, 1, 1); PG8_SCHED; PG8_LDA(At, 1, 0); PG8_STAGE(PG8_SA(0, 1), a2 + hstep, voffA);
            PG8_WAIT_V(8); PG8_WAIT_L(0); PG8_BAR; PG8_MMA(0, 0, At, B0); PG8_MMA(0, 1, At, B1); PG8_BAR; PG8_SCHED;
            PG8_LDA(At, 1, 1); PG8_STAGE(PG8_SB(1, 0), b3, voffB); PG8_STAGE(PG8_SB(1, 1), b3 + hstep, voffB); PG8_STAGE(PG8_SA(1, 0), a3, voffA);
            PG8_WAIT_V(8); PG8_WAIT_L(0); PG8_BAR; PG8_MMA(1, 0, At, B0); PG8_MMA(1, 1, At, B1); PG8_BAR; PG8_SCHED;
            } else {
            PG8_LDB(B0, 0, 0); PG8_SCHED; PG8_LDA(At, 0, 0); PG8_STAGE(PG8_SA(1, 1), a1 + hstep, voffA);
            PG8_WAIT_L(8); PG8_BAR; PG8_WAIT_L(0); PG8_MMA(0, 0, At, B0); PG8_BAR; PG8_SCHED;
            PG8_LDB(B1, 0, 1); PG8_STAGE(PG8_SB(0, 0), b2, voffB);
            PG8_BAR; PG8_WAIT_L(0); PG8_MMA(0, 1, At, B1); PG8_BAR;
            PG8_LDA(At, 0, 1); PG8_STAGE(PG8_SA(0, 0), a2, voffA);
            PG8_BAR; PG8_WAIT_L(0); PG8_MMA(1, 0, At, B0); PG8_BAR; PG8_SCHED;
            PG8_STAGE(PG8_SB(0, 1), b2 + hstep, voffB);
            PG8_WAIT_V(6); PG8_BAR; PG8_MMA(1, 1, At, B1); PG8_BAR;
            PG8_LDB(B0, 1, 0); PG8_SCHED; PG8_LDA(At, 1, 0); PG8_STAGE(PG8_SA(0, 1), a2 + hstep, voffA);
            PG8_WAIT_L(8); PG8_BAR; PG8_WAIT_L(0); PG8_MMA(0, 0, At, B0); PG8_BAR; PG8_SCHED;
            PG8_LDB(B1, 1, 1); PG8_STAGE(PG8_SB(1, 0), b3, voffB);
            PG8_BAR; PG8_WAIT_L(0); PG8_MMA(0, 1, At, B1); PG8_BAR;
            PG8_LDA(At, 1, 1); PG8_STAGE(PG8_SA(1, 0), a3, voffA);
            PG8_BAR; PG8_WAIT_L(0); PG8_MMA(1, 0, At, B0); PG8_BAR; PG8_SCHED;
            PG8_STAGE(PG8_SB(1, 1), b3 + hstep, voffB);
            PG8_WAIT_V(6); PG8_BAR; PG8_MMA(1, 1, At, B1); PG8_BAR;
            }
        }
        if constexpr (ALIGN_EPI) { if (wr == 0) PG8_BAR; }
        if constexpr (!Epi::AFTER_DRAIN) { E(acc, cur, wr, wc, fr, fq); S.done(cur); }
        if (!has_next) break;
#pragma unroll
        for (int a = 0; a < 2; ++a)
#pragma unroll
            for (int b = 0; b < 2; ++b)
#pragma unroll
                for (int m = 0; m < 4; ++m)
#pragma unroll
                    for (int n = 0; n < 2; ++n) acc[a][b][m][n] = (f32x4){0.f, 0.f, 0.f, 0.f};
        cur = nxt; cA = nA; cB = nB; ++ui;
        if constexpr (ALIGN_EPI) { if (wr == 1) PG8_BAR; }
    }
    PG8_WAIT_V(0);
    if constexpr (!ALIGN_EPI) { if (wr == 0) PG8_BAR; }
    PG8_BAR;
    if constexpr (Epi::AFTER_DRAIN) { E.fused(acc, cur, wr, wc, fr, fq, lds, wid, lane); S.done(cur); }
#undef PG8_SA
#undef PG8_SB
#undef PG8_STAGE
#undef PG8_LDA
#undef PG8_LDB
#undef PG8_MMA
#undef PG8_WAIT_V
#undef PG8_WAIT_L
#undef PG8_BAR
#undef PG8_SCHED
}
}
#ifndef PG8_SP2
#define PG8_SP2 true
#endif
#ifndef PG8_ALIGN
#define PG8_ALIGN true
#endif
#define LAS __attribute__((address_space(3)))
typedef unsigned short bf16;
typedef unsigned v4u __attribute__((ext_vector_type(4)));
typedef unsigned v2u __attribute__((ext_vector_type(2)));
typedef float f32x4 __attribute__((ext_vector_type(4)));
typedef float f32x2 __attribute__((ext_vector_type(2)));
typedef short bf16x8 __attribute__((ext_vector_type(8)));
constexpr int NT = 512;
constexpr int LDS_BYTES = 147456;
constexpr int NPHASE = 15;

constexpr size_t MiB = 1u << 20;
constexpr size_t WS_WIN = 1 * MiB, WS_WKV = 23 * MiB, WS_WOUT = 39 * MiB, WS_WQ = 47 * MiB, WS_WO = 55 * MiB, WS_WUP = 63 * MiB, WS_WDN = 107 * MiB;
constexpr size_t WS_LW = 129 * MiB, WS_LA = 129 * MiB + 256 * 1024, WS_LG = 129 * MiB + 512 * 1024;
constexpr size_t WS_HB = 130 * MiB, WS_MB = 166 * MiB, WS_A2 = 170 * MiB, WS_MIX = 206 * MiB, WS_X1 = 278 * MiB, WS_Q = 350 * MiB, WS_O = 386 * MiB;
constexpr size_t WS_KB = 422 * MiB, WS_VT = 426 * MiB, WS_Y = 430 * MiB, WS_G = 466 * MiB, WS_BON = 502 * MiB;
constexpr size_t WS_SHB = 818 * MiB;
constexpr size_t WS_SI = 503 * MiB, SB_STRIDE = 18 * MiB;
constexpr size_t WS_SW = WS_SI + 5 * SB_STRIDE;
constexpr size_t WS_UP = 503 * MiB;
constexpr size_t WS_GLU = 719 * MiB, WS_PR = 737 * MiB;
constexpr size_t WS_ACT = 719 * MiB;
constexpr size_t WS_END = 820 * MiB;
constexpr size_t O_YP = 0, O_YS = 16777216, O_CP = 18874368, O_CS = 18997248, O_SP = 22929408, O_SS = 22943488, O_WP = 23394048, O_WS = 23656192,
                 O_FP = 32044800, O_FS = 32134912, O_MK = 35018496, O_MV = 37115648, O_END = 39212800;

enum { I_XP = 0, I_XS, I_CK, I_CV, I_SCONV, I_SSHIFT, I_SWKV, I_SFFN, I_MEM, I_NMIXPRE, I_WIN, I_CDW, I_CDWB, I_CLNG, I_CLNB, I_MU, I_W0, I_WLORA, I_A0, I_ALORA,
       I_GLORA, I_KK, I_KA, I_RK, I_LNXG, I_LNXB, I_WOUT, I_NMIXPOST, I_NXAPRE, I_NMEM, I_WQ, I_WK, I_WV, I_WO, I_NXAPOST, I_NFFNPRE, I_WUP, I_FDW, I_FDWB, I_WDOWN,
       I_NFFNPOST, N_IN };

struct Params { const float* in[N_IN]; float* out; unsigned char* ws; int ph_lo, ph_hi; };

__device__ __forceinline__ unsigned f2bf(float f) { unsigned u = __builtin_bit_cast(unsigned, f); return (u + 0x7fffu + ((u >> 16) & 1u)) >> 16; }
__device__ __forceinline__ unsigned pk2(float lo, float hi) { return f2bf(lo) | (f2bf(hi) << 16); }
__device__ __forceinline__ float bflo(unsigned u) { return __builtin_bit_cast(float, u << 16); }
__device__ __forceinline__ float bfhi(unsigned u) { return __builtin_bit_cast(float, u & 0xffff0000u); }
__device__ __forceinline__ float wave_sum(float v) {
#pragma unroll
    for (int o = 1; o < 64; o <<= 1) v += __shfl_xor(v, o);
    return v;
}
__device__ __forceinline__ float wave_max(float v) {
#pragma unroll
    for (int o = 1; o < 64; o <<= 1) v = fmaxf(v, __shfl_xor(v, o));
    return v;
}
__device__ __forceinline__ float sigm(float x) { return 1.0f / (1.0f + __expf(-x)); }
#define LDS_WAIT() asm volatile("s_waitcnt lgkmcnt(0)" ::: "memory")

typedef __attribute__((address_space(1))) unsigned gu32;
#define XB_TMO      128
#define XB_XCNT(j)  (256  + 64 * (j))
#define XB_XSUB(j)  (1280 + 64 * (j))
#define XB_XGEN(j)  (2304 + 64 * (j))
#define XB_TOP      3328
#define XB_TOPGEN   3392
#define XCD_BAR_WORDS 3456
#define XB_SPIN_CAP (1u << 18)

__device__ __forceinline__ unsigned xb_ld(unsigned* p)              { return __hip_atomic_load(p, __ATOMIC_RELAXED, __HIP_MEMORY_SCOPE_AGENT); }
__device__ __forceinline__ unsigned xb_add(unsigned* p, unsigned v) { return __hip_atomic_fetch_add(p, v, __ATOMIC_RELAXED, __HIP_MEMORY_SCOPE_AGENT); }
__device__ __forceinline__ unsigned xb_xcc_id() { return (unsigned)__builtin_amdgcn_s_getreg((3 << 11) | 20) & 0xFu; }
#define XB_SPIN(cond, bar) do { unsigned _sp = 0; while (cond) { __builtin_amdgcn_s_sleep(1); \
    if ((++_sp & 255u) == 0u) { if (xb_ld(&(bar)[XB_TMO])) break; if (_sp > XB_SPIN_CAP) { atomicAdd(&(bar)[XB_TMO], 1u); break; } } } } while (0)

struct XcdBarrier {
    unsigned* bar; unsigned x;
    volatile LAS unsigned* st;
};

__device__ __forceinline__ XcdBarrier xcd_barrier_post(unsigned* bar, volatile LAS unsigned* st) {
    XcdBarrier b; b.bar = bar; b.x = xb_xcc_id(); b.st = st;
    if (threadIdx.x == 0) (void)xb_add(&bar[XB_XCNT(b.x)], 1u);
    return b;
}
__device__ __forceinline__ void xcd_barrier_complete(unsigned* bar, unsigned x, unsigned& nloc, unsigned& nx) {
    const unsigned G = gridDim.x * gridDim.y * gridDim.z;
    unsigned sum, cnt, mine, sp = 0u;
    for (;;) {
        sum = 0u; cnt = 0u; mine = 0u;
#pragma unroll
        for (unsigned j = 0; j < 16; ++j) { const unsigned c = xb_ld(&bar[XB_XCNT(j)]); sum += c; cnt += (c > 0u) ? 1u : 0u; mine = (j == x) ? c : mine; }
        if (sum == G) break;
        __builtin_amdgcn_s_sleep(1);
        if ((++sp & 255u) == 0u) { if (xb_ld(&bar[XB_TMO])) break; if (sp > XB_SPIN_CAP) { atomicAdd(&bar[XB_TMO], 1u); break; } }
    }
    nloc = mine > 0u ? mine : 1u; nx = cnt > 0u ? cnt : 1u;
}

__device__ __forceinline__ void xcd_barrier(const XcdBarrier& b) {
    asm volatile("s_waitcnt vmcnt(0)" ::: "memory");
    __syncthreads();
    if (threadIdx.x == 0) {
        unsigned* bar = b.bar;
        __builtin_amdgcn_s_waitcnt(0);
        unsigned nloc = b.st[0], nx = b.st[1];
        if (nloc == 0u) { xcd_barrier_complete(bar, b.x, nloc, nx); b.st[0] = nloc; b.st[1] = nx; }
        const unsigned old = xb_add(&bar[XB_XSUB(b.x)], 1u);
        const unsigned gen = old / nloc;
        if (old + 1u == (gen + 1u) * nloc) {
            __builtin_amdgcn_fence(__ATOMIC_RELEASE, "agent");
            asm volatile("s_waitcnt vmcnt(0)" ::: "memory");
            const unsigned og = xb_add(&bar[XB_TOP], 1u);
            const unsigned tg = og / nx;
            if (og + 1u == (tg + 1u) * nx) xb_add(&bar[XB_TOPGEN], 1u);
            else XB_SPIN(xb_ld(&bar[XB_TOPGEN]) == tg, bar);
            __builtin_amdgcn_fence(__ATOMIC_ACQUIRE, "agent");
            xb_add(&bar[XB_XGEN(b.x)], 1u);
            asm volatile("s_waitcnt vmcnt(0)" ::: "memory");
        } else {
            XB_SPIN(xb_ld(&bar[XB_XGEN(b.x)]) == gen, bar);
            __builtin_amdgcn_fence(__ATOMIC_ACQUIRE, "agent");
            asm volatile("s_waitcnt vmcnt(0)" ::: "memory");
        }
    }
    __syncthreads();
}

constexpr int MISC_OFF = LDS_BYTES - 64;
struct Ctx { int tid, lane, wave, bid, G, gw, NGW; };
__device__ __forceinline__ unsigned char* wsbase(const Params& P) { const unsigned long long x = (unsigned long long)P.ws; int lo = __builtin_amdgcn_readfirstlane((int)(unsigned)x), hi = __builtin_amdgcn_readfirstlane((int)(unsigned)(x >> 32));
    asm volatile("" : "+s"(lo), "+s"(hi)); return (unsigned char*)(((unsigned long long)(unsigned)hi << 32) | (unsigned)lo); }
__device__ __forceinline__ const float* inp(const Params& P, int i) { int z; asm volatile("s_mov_b32 %0, 0" : "=s"(z)); return P.in[i + z]; }

#ifndef MK_SUBMASK
#define MK_SUBMASK 0
#endif
#define SUBREP(i) for (int sr_ = 0; sr_ < ((((MK_SUBMASK) >> (i)) & 1) ? 2 : 1); ++sr_)
template <class ColMap>
__device__ __forceinline__ void transpose_item(const float* __restrict__ W, int K, int N, bf16* __restrict__ WT, int kb, int jb, int lane, ColMap cm) {
    const int kr = lane >> 4, l16 = lane & 15, k0 = 64 * kb + 16 * kr, j = 64 * jb + 4 * l16;
    const int sc = cm(j);
    f32x4 v[16];
    if (sc >= 0) {
        const float* src = W + (size_t)k0 * N + sc;
#pragma unroll
        for (int q = 0; q < 16; ++q) v[q] = __builtin_nontemporal_load((const f32x4*)(src + (size_t)q * N));
    } else {
#pragma unroll
        for (int q = 0; q < 16; ++q) v[q] = (f32x4){0.f, 0.f, 0.f, 0.f};
    }
#pragma unroll
    for (int e = 0; e < 4; ++e) {
        bf16* dst = WT + (size_t)(j + e) * K + k0;
        v4u o0, o1;
        o0.x = pk2(v[0][e], v[1][e]); o0.y = pk2(v[2][e], v[3][e]); o0.z = pk2(v[4][e], v[5][e]); o0.w = pk2(v[6][e], v[7][e]);
        o1.x = pk2(v[8][e], v[9][e]); o1.y = pk2(v[10][e], v[11][e]); o1.z = pk2(v[12][e], v[13][e]); o1.w = pk2(v[14][e], v[15][e]);
        *(v4u*)dst = o0; *(v4u*)(dst + 8) = o1;
    }
}
struct MapId { __device__ __forceinline__ int operator()(int j) const { return j; } };
struct MapIn {
    __device__ __forceinline__ int operator()(int j) const {
        if (j < 2048) { const int g = j >> 5, q = (j >> 3) & 3, n = (j >> 2) & 1, e = j & 3; return n * 1024 + 16 * g + 4 * q + e; }
        const int jj = j - 2048; return jj < NRC ? 2048 + jj : -1;
    }
};
__device__ __forceinline__ void rms_row_bf16(const float* __restrict__ xrow, const float* __restrict__ g, bf16* __restrict__ orow, int lane) {
    f32x4 v[8]; float s = 0.f;
#pragma unroll
    for (int j = 0; j < 8; ++j) { v[j] = *(const f32x4*)(xrow + 4 * (lane + 64 * j)); s += (v[j][0] * v[j][0] + v[j][1] * v[j][1]) + (v[j][2] * v[j][2] + v[j][3] * v[j][3]); }
    const float r = rsqrtf(wave_sum(s) * (1.0f / 2048.0f) + 1e-6f);
#pragma unroll
    for (int j = 0; j < 8; ++j) { const f32x4 gg = *(const f32x4*)(g + 4 * (lane + 64 * j));
        v2u o; o.x = pk2(v[j][0] * r * gg[0], v[j][1] * r * gg[1]); o.y = pk2(v[j][2] * r * gg[2], v[j][3] * r * gg[3]);
        *(v2u*)(orow + 4 * (lane + 64 * j)) = o; }
}
__device__ __forceinline__ void p0_prologue(const Params& P, const Ctx& C, LAS unsigned char* lds) {
    unsigned char* ws = wsbase(P);
    constexpr int I_IN = 32 * 88, I_SQ = 32 * 32, I_UP = 32 * 176, I_DN = 88 * 32;
    constexpr int NITEMS = I_IN + 5 * I_SQ + I_UP + I_DN;
    SUBREP(6) for (int it = C.gw; it < NITEMS; it += C.NGW) {
        int r = it;
        if (r < I_IN) { transpose_item(inp(P, I_WIN), 2048, 5568, (bf16*)(ws + WS_WIN), r / 88, r % 88, C.lane, MapIn()); continue; } r -= I_IN;
        if (r < I_SQ) { transpose_item(inp(P, I_WK), 2048, 2048, (bf16*)(ws + WS_WKV), r / 32, r % 32, C.lane, MapId()); continue; } r -= I_SQ;
        if (r < I_SQ) { transpose_item(inp(P, I_WV), 2048, 2048, (bf16*)(ws + WS_WKV) + (size_t)2048 * 2048, r / 32, r % 32, C.lane, MapId()); continue; } r -= I_SQ;
        if (r < I_SQ) { transpose_item(inp(P, I_WOUT), 2048, 2048, (bf16*)(ws + WS_WOUT), r / 32, r % 32, C.lane, MapId()); continue; } r -= I_SQ;
        if (r < I_SQ) { transpose_item(inp(P, I_WQ), 2048, 2048, (bf16*)(ws + WS_WQ), r / 32, r % 32, C.lane, MapId()); continue; } r -= I_SQ;
        if (r < I_SQ) { transpose_item(inp(P, I_WO), 2048, 2048, (bf16*)(ws + WS_WO), r / 32, r % 32, C.lane, MapId()); continue; } r -= I_SQ;
        if (r < I_UP) { transpose_item(inp(P, I_WUP), 2048, 11264, (bf16*)(ws + WS_WUP), r / 176, r % 176, C.lane, MapId()); continue; } r -= I_UP;
        transpose_item(inp(P, I_WDOWN), 5632, 2048, (bf16*)(ws + WS_WDN), r / 32, r % 32, C.lane, MapId());
    }
    const int gt = C.bid * NT + C.tid, ngt = C.G * NT;
    { bf16* d = (bf16*)(ws + WS_LW); const float* s = inp(P, I_WLORA); for (int i = gt; i < 1024 * 96; i += ngt) { const int n = i / 96, k = i - n * 96; d[i] = (bf16)f2bf(s[k * 1024 + n]); } }
    { bf16* d = (bf16*)(ws + WS_LA); const float* s = inp(P, I_ALORA); for (int i = gt; i < 1024 * 96; i += ngt) { const int n = i / 96, k = i - n * 96; d[i] = (bf16)f2bf(s[k * 1024 + n]); } }
    { bf16* d = (bf16*)(ws + WS_LG); const float* s = inp(P, I_GLORA); for (int i = gt; i < 1024 * 256; i += ngt) { const int n = i >> 8, k = i & 255; d[i] = (bf16)f2bf(s[k * 1024 + n]); } }
    SUBREP(7) for (int m = C.gw; m < M + 1024; m += C.NGW) {
        if (m < M) { const float* xr = m < MP ? inp(P, I_XP) + (size_t)m * D : inp(P, I_XS) + (size_t)(m - MP) * D; rms_row_bf16(xr, inp(P, I_NMIXPRE), (bf16*)(ws + WS_HB) + (size_t)m * D, C.lane); }
        else { const int r = m - M; rms_row_bf16(inp(P, I_MEM) + (size_t)r * D, inp(P, I_NMEM), (bf16*)(ws + WS_MB) + (size_t)r * D, C.lane); }
    }
    { bf16* d = (bf16*)(ws + WS_SHB); const float* sp = inp(P, I_SSHIFT);
      for (int i = gt; i < (NBS + 1) * NRCP; i += ngt) { const int b = i / NRCP, c = i - b * NRCP; d[i] = (b < NBS && c < NRC) ? (bf16)f2bf(sp[(size_t)b * NRC + c]) : (bf16)0; } }
    { const f32x4* s = (const f32x4*)inp(P, I_SCONV); f32x4* d = (f32x4*)(P.out + O_CS);
      for (int i = gt; i < NBS * 22 * 256; i += ngt) { const int b = i / (22 * 256), r = i - b * (22 * 256); d[(size_t)b * 30 * 256 + r] = s[(size_t)b * 30 * 256 + 8 * 256 + r]; } }
}

template <int R>
__device__ __forceinline__ void conv_task(const Params& P, const Ctx& C, LAS unsigned char* lds, int grow0  , int t0  , int sb  ) {
    unsigned char* ws = wsbase(P);
    const bf16* glu = (const bf16*)(ws + WS_GLU);
    LAS unsigned* st = (LAS unsigned*)lds;
    LAS float* red = (LAS float*)(lds + 98304);
    constexpr int NR = R + 30;
    const float* sconv = inp(P, I_SCONV); const float* cdw = inp(P, I_CDW);
    for (int p = C.tid; p < NR * 128; p += NT) {
        const int rr = p >> 7, ch = p & 127; const int t = t0 - 30 + rr;
        v4u v = (v4u){0u, 0u, 0u, 0u};
        if (t >= 0) v = *(const v4u*)(glu + (size_t)(grow0 - 30 + rr) * CC + ch * 8);
        else if (sb >= 0) { const float* s = sconv + ((size_t)sb * 30 + rr) * CC + ch * 8;
            const f32x4 a = *(const f32x4*)s, b = *(const f32x4*)(s + 4); v.x = pk2(a[0], a[1]); v.y = pk2(a[2], a[3]); v.z = pk2(b[0], b[1]); v.w = pk2(b[2], b[3]); }
        *(LAS v4u*)(st + rr * 512 + ch * 4) = v;
    }
    const int c = 2 * C.tid;
    f32x2 w[31];
#pragma unroll
    for (int j = 0; j < 31; ++j) w[j] = *(const f32x2*)(cdw + j * CC + c);
    const f32x2 bias = *(const f32x2*)(inp(P, I_CDWB) + c);
    f32x2 acc[R];
#pragma unroll
    for (int r = 0; r < R; ++r) acc[r] = bias;
    __syncthreads();
#pragma unroll
    for (int rr = 0; rr < NR; ++rr) {
        if ((rr & 3) == 0) asm volatile("" ::: "memory");
        const unsigned u = st[rr * 512 + C.tid]; const float x0 = bflo(u), x1 = bfhi(u);
#pragma unroll
        for (int r = 0; r < R; ++r) { const int j = rr - r; if (j >= 0 && j < 31) { acc[r][0] += x0 * w[j][0]; acc[r][1] += x1 * w[j][1]; } }
    }
    float s[R];
#pragma unroll
    for (int r = 0; r < R; ++r) s[r] = wave_sum(acc[r][0] + acc[r][1]);
    if (C.lane == 0) {
#pragma unroll
        for (int r = 0; r < R; ++r) red[C.wave * 16 + r] = s[r]; }
    __syncthreads();
    float mean[R];
#pragma unroll
    for (int r = 0; r < R; ++r) { float t = 0.f;
#pragma unroll
        for (int wv = 0; wv < 8; ++wv) t += red[wv * 16 + r];
        mean[r] = t * (1.0f / 1024.0f); }
    __syncthreads();
#pragma unroll
    for (int r = 0; r < R; ++r) { const float d0 = acc[r][0] - mean[r], d1 = acc[r][1] - mean[r]; acc[r][0] = d0; acc[r][1] = d1; s[r] = wave_sum(d0 * d0 + d1 * d1); }
    if (C.lane == 0) {
#pragma unroll
        for (int r = 0; r < R; ++r) red[C.wave * 16 + r] = s[r]; }
    __syncthreads();
    const f32x2 lg = *(const f32x2*)(inp(P, I_CLNG) + c), lb = *(const f32x2*)(inp(P, I_CLNB) + c);
    bf16* a2 = (bf16*)(ws + WS_A2);
#pragma unroll
    for (int r = 0; r < R; ++r) { float t = 0.f;
#pragma unroll
        for (int wv = 0; wv < 8; ++wv) t += red[wv * 16 + r];
        const float rstd = rsqrtf(t * (1.0f / 1024.0f) + 1e-5f);
        float y0 = acc[r][0] * rstd * lg[0] + lb[0], y1 = acc[r][1] * rstd * lg[1] + lb[1];
        y0 = y0 * sigm(y0); y1 = y1 * sigm(y1);
        *(unsigned*)(a2 + (size_t)(grow0 + r) * D + c) = pk2(y0, y1); }
    __syncthreads();
}

#define XS8(cp_, pp_, mp_, off_, xs_) do { const v4u cu_ = *(const v4u*)((cp_) + (off_)); const v4u pu_ = *(const v4u*)((pp_) + (off_)); \
        const f32x4 m0_ = *(const f32x4*)((mp_) + (off_)), m1_ = *(const f32x4*)((mp_) + (off_) + 4); float c_, p_; \
        c_ = bflo(cu_.x); p_ = bflo(pu_.x); xs_[0] = c_ + (p_ - c_) * m0_[0]; c_ = bfhi(cu_.x); p_ = bfhi(pu_.x); xs_[1] = c_ + (p_ - c_) * m0_[1]; \
        c_ = bflo(cu_.y); p_ = bflo(pu_.y); xs_[2] = c_ + (p_ - c_) * m0_[2]; c_ = bfhi(cu_.y); p_ = bfhi(pu_.y); xs_[3] = c_ + (p_ - c_) * m0_[3]; \
        c_ = bflo(cu_.z); p_ = bflo(pu_.z); xs_[4] = c_ + (p_ - c_) * m1_[0]; c_ = bfhi(cu_.z); p_ = bfhi(pu_.z); xs_[5] = c_ + (p_ - c_) * m1_[1]; \
        c_ = bflo(cu_.w); p_ = bflo(pu_.w); xs_[6] = c_ + (p_ - c_) * m1_[2]; c_ = bfhi(cu_.w); p_ = bfhi(pu_.w); xs_[7] = c_ + (p_ - c_) * m1_[3]; } while (0)
#define XS4(cp_, pp_, mp_, off_, xs_) do { const v2u cu_ = *(const v2u*)((cp_) + (off_)); const v2u pu_ = *(const v2u*)((pp_) + (off_)); const f32x4 m0_ = *(const f32x4*)((mp_) + (off_)); float c_, p_; \
        c_ = bflo(cu_.x); p_ = bflo(pu_.x); xs_[0] = c_ + (p_ - c_) * m0_[0]; c_ = bfhi(cu_.x); p_ = bfhi(pu_.x); xs_[1] = c_ + (p_ - c_) * m0_[1]; \
        c_ = bflo(cu_.y); p_ = bflo(pu_.y); xs_[2] = c_ + (p_ - c_) * m0_[2]; c_ = bfhi(cu_.y); p_ = bfhi(pu_.y); xs_[3] = c_ + (p_ - c_) * m0_[3]; } while (0)
__device__ __forceinline__ bf16x8 pack8(const float (&x)[8]) {
    v4u o; o.x = pk2(x[0], x[1]); o.y = pk2(x[2], x[3]); o.z = pk2(x[4], x[5]); o.w = pk2(x[6], x[7]);
    return __builtin_bit_cast(bf16x8, o);
}
__device__ __forceinline__ float tanh_fast(float x) { return 1.0f - 2.0f / (1.0f + __expf(2.0f * x)); }
constexpr int PBUF = 57344;
template <int NH>
__device__ __forceinline__ void prep_task(const Params& P, const Ctx& C, LAS unsigned char* lds, int rowblock, int hbase) {
    const int lane = C.lane, fr = lane & 15, fq = lane >> 4, row = rowblock * 128 + C.wave * 16 + fr;
    unsigned char* ws = wsbase(P);
    const bf16* curp = (const bf16*)(ws + WS_PR) + (size_t)row * NRCP;
    const bf16* prvp = curp - NRCP;
    if (row < MP) { if ((row & (SEQ - 1)) == 0) prvp = (const bf16*)(ws + WS_SHB) + (size_t)NBS * NRCP; }
    else { const int rs = row - MP; if ((rs & 7) == 0) prvp = (const bf16*)(ws + WS_SHB) + (size_t)(rs >> 3) * NRCP; }
    const float* mup = inp(P, I_MU); const float* pkk = inp(P, I_KK); const float* pa0 = inp(P, I_A0); const float* pw0 = inp(P, I_W0); const float* pka = inp(P, I_KA); const float* prk = inp(P, I_RK);
    const bf16* gw = (const bf16*)(ws + WS_LW); const bf16* ga = (const bf16*)(ws + WS_LA); const bf16* gg = (const bf16*)(ws + WS_LG);
#define PREP_STAGE(h_, b_) do { int ll = lane; asm volatile("" : "+v"(ll)); _Pragma("unroll") for (int q = 0; q < 7; ++q) { const int i = C.wave + 8 * q; const int pi = 64 * i + ll; const bf16* src; \
        if (i < 12) src = gw + (size_t)(h_) * 6144 + pi * 8; else if (i < 24) src = ga + (size_t)(h_) * 6144 + (pi - 768) * 8; \
        else { const int p2_ = pi - 1536, r = p2_ >> 5, c = (p2_ & 31) ^ (r & 15); src = gg + (size_t)(h_) * 16384 + r * 256 + c * 8; } \
        __builtin_amdgcn_global_load_lds((const unsigned*)src, (LAS unsigned*)(lds + (b_) * PBUF + i * 1024), 16, 0, 0); } } while (0)
    PREP_STAGE(hbase, 0);
    bf16x8 Aw[3], Aa[3], Ag[8];
    {   const bf16* c8 = curp + 3072 + 8 * fq; const bf16* p8 = prvp + 3072 + 8 * fq; const float* m8 = mup + 3072 + 8 * fq;
#pragma unroll
        for (int s = 0; s < 3; ++s) { float xs[8]; XS8(c8, p8, m8, 32 * s, xs);
#pragma unroll
            for (int e = 0; e < 8; ++e) xs[e] = tanh_fast(xs[e]);
            Aw[s] = pack8(xs); }
#pragma unroll
        for (int s = 0; s < 3; ++s) { float xs[8]; XS8(c8, p8, m8, 96 + 32 * s, xs); Aa[s] = pack8(xs); }
        asm volatile("" ::: "memory");
#pragma unroll
        for (int s = 0; s < 8; ++s) { if (s == 4) asm volatile("" ::: "memory");
            float xs[8]; XS8(c8, p8, m8, 192 + 32 * s, xs);
#pragma unroll
            for (int e = 0; e < 8; ++e) xs[e] = sigm(xs[e]);
            Ag[s] = pack8(xs); }
        asm volatile("" ::: "memory");
    }
    asm volatile("s_waitcnt vmcnt(0)" ::: "memory");
    __syncthreads();
    constexpr size_t SS = SB_STRIDE / 2;
    const f32x4 z4 = (f32x4){0.f, 0.f, 0.f, 0.f};
    const int c00 = hbase * 64 + 4 * fq;
    const bf16* c4 = curp + c00; const bf16* p4 = prvp + c00; const float* m4 = mup + c00;
    const float* qkk = pkk + c00; const float* qa0 = pa0 + c00; const float* qw0 = pw0 + c00; const float* qka = pka + c00; const float* qrk = prk + c00;
    bf16* sb = (bf16*)(ws + WS_SI) + (size_t)row * RW + c00; float* sw = (float*)(ws + WS_SW) + (size_t)row * RW + c00; bf16* gb = (bf16*)(ws + WS_G) + (size_t)row * RW + c00;
    float* bonp = (float*)(ws + WS_BON) + (size_t)row * RH + hbase;
    const int lwo = fr * 192 + fq * 16, lgo = 24576 + fr * 512;
#pragma unroll 1
    for (int hh = 0; hh < NH; ++hh) {
        if (hh + 1 < NH) PREP_STAGE(hbase + hh + 1, (hh + 1) & 1);
        const LAS unsigned char* wb = lds + (hh & 1) * PBUF;
        float ss = 0.f;
#pragma unroll
        for (int nt = 0; nt < 4; ++nt) {
            float xk0[4]; XS4(c4, p4, m4, 1024 + 16 * nt, xk0);
            const f32x4 kkw = *(const f32x4*)(qkk + 16 * nt);
#pragma unroll
            for (int e = 0; e < 4; ++e) { const float t = xk0[e] * kkw[e]; ss += t * t; }
        }
        ss += __shfl_xor(ss, 16); ss += __shfl_xor(ss, 32);
        const float inv = 1.0f / fmaxf(sqrtf(ss), 1e-12f);
        float bon = 0.f;
#pragma unroll
        for (int nt = 0; nt < 4; ++nt) {
            asm volatile("" ::: "memory");
            f32x4 accW = z4, accA = z4, accG = z4;
#pragma unroll
            for (int s = 0; s < 3; ++s) { const bf16x8 bw = *(const LAS bf16x8*)(wb + lwo + nt * 3072 + s * 64), ba = *(const LAS bf16x8*)(wb + 12288 + lwo + nt * 3072 + s * 64);
                accW = __builtin_amdgcn_mfma_f32_16x16x32_bf16(bw, Aw[s], accW, 0, 0, 0); accA = __builtin_amdgcn_mfma_f32_16x16x32_bf16(ba, Aa[s], accA, 0, 0, 0); }
#pragma unroll
            for (int s = 0; s < 8; ++s) { const bf16x8 bg = *(const LAS bf16x8*)(wb + lgo + nt * 8192 + (((4 * s + fq) ^ fr) * 16)); accG = __builtin_amdgcn_mfma_f32_16x16x32_bf16(bg, Ag[s], accG, 0, 0, 0); }
            float xr[4], xv[4], xkk[4];
            XS4(c4, p4, m4, 16 * nt, xr); XS4(c4, p4, m4, 1024 + 16 * nt, xkk); XS4(c4 + 2048, p4 + 2048, m4 + 2048, 16 * nt, xv);
            const f32x4 w0 = *(const f32x4*)(qw0 + 16 * nt), ka = *(const f32x4*)(qka + 16 * nt), rk = *(const f32x4*)(qrk + 16 * nt);
            const f32x4 kkw = *(const f32x4*)(qkk + 16 * nt), a0 = *(const f32x4*)(qa0 + 16 * nt);
            f32x4 vw; float vk[4], va[4], vb[4];
#pragma unroll
            for (int e = 0; e < 4; ++e) {
                const float ee = 0.6065306597126334f * sigm(w0[e] + accW[e]);
                vw[e] = __expf(-ee);
                const float a = sigm(a0[e] + accA[e]);
                const float kn = xkk[e] * kkw[e] * inv;
                const float k2 = xkk[e] * (1.0f + (a - 1.0f) * ka[e]);
                vk[e] = k2; va[e] = -kn; vb[e] = kn * a;
                bon += xr[e] * k2 * rk[e];
            }
            bf16* so = sb + 16 * nt;
            *(v2u*)(so + 0 * SS) = (v2u){pk2(xr[0], xr[1]), pk2(xr[2], xr[3])};
            *(v2u*)(so + 1 * SS) = (v2u){pk2(vk[0], vk[1]), pk2(vk[2], vk[3])};
            *(v2u*)(so + 2 * SS) = (v2u){pk2(xv[0], xv[1]), pk2(xv[2], xv[3])};
            *(v2u*)(so + 3 * SS) = (v2u){pk2(va[0], va[1]), pk2(va[2], va[3])};
            *(v2u*)(so + 4 * SS) = (v2u){pk2(vb[0], vb[1]), pk2(vb[2], vb[3])};
            *(f32x4*)(sw + 16 * nt) = vw;
            *(v2u*)(gb + 16 * nt) = (v2u){pk2(accG[0], accG[1]), pk2(accG[2], accG[3])};
        }
        bon += __shfl_xor(bon, 16); bon += __shfl_xor(bon, 32);
        if (fq == 0) bonp[hh] = bon;
        c4 += 64; p4 += 64; m4 += 64; qkk += 64; qa0 += 64; qw0 += 64; qka += 64; qrk += 64; sb += 64; sw += 64; gb += 64;
        asm volatile("s_waitcnt vmcnt(0)" ::: "memory");
        __syncthreads();
    }
#undef PREP_STAGE
}

constexpr int TC = 32, STEPF = 5 * 64 + 16, STEPQ = STEPF / 4, CHUNKQ = TC * STEPQ;
template <int CTRL> __device__ __forceinline__ float dppf(float x) { return __builtin_bit_cast(float, __builtin_amdgcn_update_dpp(0, __builtin_bit_cast(int, x), CTRL, 0xF, 0xF, true)); }
__device__ __forceinline__ float allred16(float x) {
    x += dppf<0xB1>(x);
    x += dppf<0x4E>(x);
    x += dppf<0x141>(x);
    x += dppf<0x140>(x);
    return x;
}
#define SCAN_BAR() do { asm volatile("s_waitcnt lgkmcnt(0)" ::: "memory"); __builtin_amdgcn_s_barrier(); asm volatile("" ::: "memory"); } while (0)
#define SCAN_STEP(S01, S23, r4, w4, k4, a4, b4, v, yout) do { \
        f32x2 p2 = S01 * (f32x2){a4[0], a4[1]}; p2 = S23 * (f32x2){a4[2], a4[3]} + p2; \
        const float sa = allred16(p2[0] + p2[1]); const f32x2 sa2 = (f32x2){sa, sa}, v2 = (f32x2){v, v}; \
        f32x2 t01 = v2 * (f32x2){k4[0], k4[1]}, t23 = v2 * (f32x2){k4[2], k4[3]}; \
        t01 = sa2 * (f32x2){b4[0], b4[1]} + t01; t23 = sa2 * (f32x2){b4[2], b4[3]} + t23; \
        S01 = S01 * (f32x2){w4[0], w4[1]} + t01; S23 = S23 * (f32x2){w4[2], w4[3]} + t23; \
        f32x2 q2 = S01 * (f32x2){r4[0], r4[1]}; q2 = S23 * (f32x2){r4[2], r4[3]} + q2; \
        yout = allred16(q2[0] + q2[1]); } while (0)
__device__ __forceinline__ void scan_prompt(const Params& P, const Ctx& C, LAS unsigned char* lds, int chain, int rb) {
    unsigned char* ws = wsbase(P);
    const int b = chain >> 4, h = chain & 15, m0 = b * SEQ;
    LAS float* buf = (LAS float*)lds;
    constexpr int NCH = SEQ / TC;
    if (C.wave >= 4) {
        const int ht = C.tid - 256;
        const bf16* SB = (const bf16*)(ws + WS_SI); constexpr size_t SBS = SB_STRIDE / 2; const float* SW = (const float*)(ws + WS_SW);
        v4u stg[7];
#define SCAN_HLOAD(ck_) do { int htl = ht; asm volatile("" : "+v"(htl)); _Pragma("unroll") for (int q = 0; q < 7; ++q) { const int ip = htl + q * 256; if (ip < TC * 50) { const int t = ip / 50, p = ip - t * 50; \
            const size_t rowo = (size_t)(m0 + (ck_) * TC + t) * RW + h * 64; const void* src; \
            if (p < 32) { const int g = p >> 3; const int arr = g == 0 ? 0 : g == 1 ? 1 : g == 2 ? 3 : 4; src = SB + arr * SBS + rowo + 8 * (p & 7); } \
            else if (p < 34) src = SB + 2 * SBS + rowo + rb * 16 + 8 * (p - 32); \
            else src = SW + rowo + 4 * (p - 34); \
            stg[q] = *(const v4u*)src; } } } while (0)
#define SCAN_HWRITE(ck_) do { int htl = ht; asm volatile("" : "+v"(htl)); LAS float* dbase = buf + ((ck_) & 1) * (TC * STEPF); _Pragma("unroll") for (int q = 0; q < 7; ++q) { const int ip = htl + q * 256; if (ip < TC * 50) { const int t = ip / 50, p = ip - t * 50; \
            LAS float* d = dbase + t * STEPF; \
            if (p >= 34) *(LAS v4u*)(d + 64 + 4 * (p - 34)) = stg[q]; \
            else { const int g = p >> 3; const int off = p < 32 ? (g == 0 ? 0 : g == 1 ? 128 : g == 2 ? 192 : 256) + 8 * (p & 7) : 320 + 8 * (p - 32); \
                const v4u u = stg[q]; \
                *(LAS v4u*)(d + off) = (v4u){u.x << 16, u.x & 0xffff0000u, u.y << 16, u.y & 0xffff0000u}; \
                *(LAS v4u*)(d + off + 4) = (v4u){u.z << 16, u.z & 0xffff0000u, u.w << 16, u.w & 0xffff0000u}; } } } } while (0)
        SCAN_HLOAD(0); SCAN_HWRITE(0); SCAN_HLOAD(1);
        SCAN_BAR();
        for (int ck = 0; ck < NCH; ++ck) {
            if (ck + 1 < NCH) SCAN_HWRITE(ck + 1);
            if (ck + 2 < NCH) SCAN_HLOAD(ck + 2);
            SCAN_BAR();
        }
#undef SCAN_HLOAD
#undef SCAN_HWRITE
    } else {
        float* Y = (float*)(ws + WS_Y);
        const int rowl = C.lane >> 4, cl = C.lane & 15, irow = rb * 16 + C.wave * 4 + rowl;
        f32x2 S01 = (f32x2){0.f, 0.f}, S23 = (f32x2){0.f, 0.f};
        float yk = 0.f;
        SCAN_BAR();
        for (int ck = 0; ck < NCH; ++ck) {
            const LAS float* cb = buf + (ck & 1) * (TC * STEPF);
            f32x4 r4 = *(const LAS f32x4*)(cb + 0 * 64 + 4 * cl), w4 = *(const LAS f32x4*)(cb + 1 * 64 + 4 * cl), k4 = *(const LAS f32x4*)(cb + 2 * 64 + 4 * cl);
            f32x4 a4 = *(const LAS f32x4*)(cb + 3 * 64 + 4 * cl), b4 = *(const LAS f32x4*)(cb + 4 * 64 + 4 * cl); float v = cb[320 + C.wave * 4 + rowl];
#pragma unroll 4
            for (int t = 0; t < TC; ++t) {
                const LAS float* nb = cb + (t + 1 < TC ? t + 1 : t) * STEPF;
                const f32x4 nr = *(const LAS f32x4*)(nb + 0 * 64 + 4 * cl), nw = *(const LAS f32x4*)(nb + 1 * 64 + 4 * cl), nk = *(const LAS f32x4*)(nb + 2 * 64 + 4 * cl);
                const f32x4 na = *(const LAS f32x4*)(nb + 3 * 64 + 4 * cl), nbb = *(const LAS f32x4*)(nb + 4 * 64 + 4 * cl); const float nv = nb[320 + C.wave * 4 + rowl];
                float y; SCAN_STEP(S01, S23, r4, w4, k4, a4, b4, v, y);
                yk = (cl == (t & 15)) ? y : yk;
                if ((t & 15) == 15) Y[(size_t)(m0 + ck * TC + (t & ~15) + cl) * RW + h * 64 + irow] = yk;
                r4 = nr; w4 = nw; k4 = nk; a4 = na; b4 = nbb; v = nv;
            }
            SCAN_BAR();
        }
        float* so = P.out + O_WP + ((size_t)chain * 64 + irow) * 64 + 4 * cl;
        *(f32x4*)so = (f32x4){S01[0], S01[1], S23[0], S23[1]};
    }
    __syncthreads();
}
__device__ __forceinline__ f32x4 ld_bf4(const bf16* p) { const v2u u = *(const v2u*)p; return (f32x4){bflo(u.x), bfhi(u.x), bflo(u.y), bfhi(u.y)}; }
__device__ __forceinline__ void scan_sample(const Params& P, const Ctx& C, const float* swkv, int chain, int half) {
    unsigned char* ws = wsbase(P);
    const int b = chain >> 4, h = chain & 15, m0 = MP + 8 * b;
    const bf16* ub = (const bf16*)(ws + WS_SI) + (size_t)m0 * RW + h * 64; constexpr size_t SBS = SB_STRIDE / 2;
    const float* uw = (const float*)(ws + WS_SW) + (size_t)m0 * RW + h * 64;
    float* Y = (float*)(ws + WS_Y);
    const int rowl = C.lane >> 4, cl = C.lane & 15, irow = half * 32 + C.wave * 4 + rowl, lo = 4 * cl;
    const f32x4 s4 = *(const f32x4*)(swkv + ((size_t)chain * 64 + irow) * 64 + 4 * cl);
    f32x2 S01 = (f32x2){s4[0], s4[1]}, S23 = (f32x2){s4[2], s4[3]};
    float yk = 0.f;
#pragma unroll 2
    for (int t = 0; t < 8; ++t) {
        const bf16* ut = ub + t * RW;
        const f32x4 r4 = ld_bf4(ut + 0 * SBS + lo), k4 = ld_bf4(ut + 1 * SBS + lo), a4 = ld_bf4(ut + 3 * SBS + lo), b4 = ld_bf4(ut + 4 * SBS + lo);
        const f32x4 w4 = *(const f32x4*)(uw + t * RW + lo); const float v = bflo((unsigned)(ut + 2 * SBS)[irow]);
        float y; SCAN_STEP(S01, S23, r4, w4, k4, a4, b4, v, y);
        yk = (cl == t) ? y : yk;
    }
    if (cl < 8) Y[(size_t)(m0 + cl) * RW + h * 64 + irow] = yk;
    *(f32x4*)(P.out + O_WS + ((size_t)chain * 64 + irow) * 64 + 4 * cl) = (f32x4){S01[0], S01[1], S23[0], S23[1]};
}

__device__ __forceinline__ void post_row(const Params& P, int row, int lane) {
    unsigned char* ws = wsbase(P);
    const float* Y = (const float*)(ws + WS_Y) + (size_t)row * RW + 16 * lane;
    const bf16* V = (const bf16*)(ws + WS_SI) + 2 * (SB_STRIDE / 2) + (size_t)row * RW + 16 * lane;
    const bf16* G = (const bf16*)(ws + WS_G) + (size_t)row * RW + 16 * lane;
    const float bon = ((const float*)(ws + WS_BON))[(size_t)row * RH + (lane >> 2)];
    float y[16], s = 0.f;
#pragma unroll
    for (int q = 0; q < 4; ++q) { const f32x4 t = *(const f32x4*)(Y + 4 * q); y[4 * q] = t[0]; y[4 * q + 1] = t[1]; y[4 * q + 2] = t[2]; y[4 * q + 3] = t[3]; s += (t[0] + t[1]) + (t[2] + t[3]); }
    s += __shfl_xor(s, 1); s += __shfl_xor(s, 2);
    const float mu = s * (1.0f / 64.0f); float q2 = 0.f;
#pragma unroll
    for (int e = 0; e < 16; ++e) { y[e] -= mu; q2 += y[e] * y[e]; }
    q2 += __shfl_xor(q2, 1); q2 += __shfl_xor(q2, 2);
    const float rstd = rsqrtf(q2 * (1.0f / 64.0f) + 64e-5f);
    const float* lg = inp(P, I_LNXG) + 16 * lane; const float* lb = inp(P, I_LNXB) + 16 * lane;
    unsigned o[8];
#pragma unroll
    for (int q = 0; q < 4; ++q) { const f32x4 g4 = *(const f32x4*)(lg + 4 * q), b4 = *(const f32x4*)(lb + 4 * q), v4 = ld_bf4(V + 4 * q), gg = ld_bf4(G + 4 * q);
        float r[4];
#pragma unroll
        for (int e = 0; e < 4; ++e) r[e] = (y[4 * q + e] * rstd * g4[e] + b4[e] + bon * v4[e]) * gg[e];
        o[2 * q] = pk2(r[0], r[1]); o[2 * q + 1] = pk2(r[2], r[3]); }
    bf16* dst = (bf16*)(ws + WS_A2) + (size_t)row * D + 1024 + 16 * lane;
    *(v4u*)dst = (v4u){o[0], o[1], o[2], o[3]}; *(v4u*)(dst + 8) = (v4u){o[4], o[5], o[6], o[7]};
}

__device__ __forceinline__ void rowpass(const float* xa, const float* __restrict__ mix, const float* __restrict__ g1, float* xo,
                                        const float* __restrict__ g2, bf16* __restrict__ hb, int lane) {
    f32x4 mv[8]; float s = 0.f;
#pragma unroll
    for (int j = 0; j < 8; ++j) { mv[j] = *(const f32x4*)(mix + 4 * (lane + 64 * j)); s += (mv[j][0] * mv[j][0] + mv[j][1] * mv[j][1]) + (mv[j][2] * mv[j][2] + mv[j][3] * mv[j][3]); }
    const float r = rsqrtf(wave_sum(s) * (1.0f / 2048.0f) + 1e-6f);
    float s2 = 0.f;
#pragma unroll
    for (int j = 0; j < 8; ++j) { const f32x4 a = *(const f32x4*)(xa + 4 * (lane + 64 * j)), gg = *(const f32x4*)(g1 + 4 * (lane + 64 * j));
        mv[j] = a + mv[j] * r * gg; *(f32x4*)(xo + 4 * (lane + 64 * j)) = mv[j];
        s2 += (mv[j][0] * mv[j][0] + mv[j][1] * mv[j][1]) + (mv[j][2] * mv[j][2] + mv[j][3] * mv[j][3]); }
    if (hb) {
        const float r2 = rsqrtf(wave_sum(s2) * (1.0f / 2048.0f) + 1e-6f);
#pragma unroll
        for (int j = 0; j < 8; ++j) { const f32x4 gg = *(const f32x4*)(g2 + 4 * (lane + 64 * j));
            v2u o; o.x = pk2(mv[j][0] * r2 * gg[0], mv[j][1] * r2 * gg[1]); o.y = pk2(mv[j][2] * r2 * gg[2], mv[j][3] * r2 * gg[3]);
            *(v2u*)(hb + 4 * (lane + 64 * j)) = o; }
    }
}
__device__ __forceinline__ void attn_prompt_task(const Params& P, const Ctx& C, LAS unsigned char* lds, int b, int h, int qt) {
    unsigned char* ws = wsbase(P);
    const bf16* Qg = (const bf16*)(ws + WS_Q); const bf16* Kg = (const bf16*)(ws + WS_KB); const bf16* VTg = (const bf16*)(ws + WS_VT);
    bf16* Og = (bf16*)(ws + WS_O);
    const int fr = C.lane & 15, fq = C.lane >> 4;
    const int qrow = b * SEQ + qt * 128 + C.wave * 16 + fr;
    constexpr int BUFB = 33792;
    bf16x8 Qf[16];
#pragma unroll
    for (int s = 0; s < 16; ++s) Qf[s] = *(const bf16x8*)(Qg + (size_t)qrow * D + h * XD + 32 * s + 8 * fq);
    f32x4 accS[16];
#pragma unroll
    for (int nt = 0; nt < 16; ++nt) accS[nt] = (f32x4){0.f, 0.f, 0.f, 0.f};
    v4u stg[4];
#define ATT_GLOAD(c_) do { if ((c_) < 8) { _Pragma("unroll") for (int i = 0; i < 4; ++i) { const int idx = C.tid + i * NT, key = idx >> 3, ch = idx & 7; \
            stg[i] = *(const v4u*)(Kg + (size_t)(b * NMEM + key) * D + h * XD + (c_) * 64 + ch * 8); } } \
        else { _Pragma("unroll") for (int i = 0; i < 4; ++i) { const int idx = C.tid + i * NT, dd = idx >> 5, ch = idx & 31; \
            stg[i] = *(const v4u*)(VTg + ((size_t)((b * XH + h) * XD + ((c_) - 8) * 64 + dd)) * NMEM + ch * 8); } } } while (0)
#define ATT_SWRITE(c_) do { LAS unsigned char* sbuf = lds + ((c_) & 1) * BUFB; if ((c_) < 8) { _Pragma("unroll") for (int i = 0; i < 4; ++i) { const int idx = C.tid + i * NT, key = idx >> 3, ch = idx & 7; \
            *(LAS v4u*)(sbuf + key * 128 + ((ch ^ (key & 7)) * 16)) = stg[i]; } } \
        else { _Pragma("unroll") for (int i = 0; i < 4; ++i) { const int idx = C.tid + i * NT, dd = idx >> 5, ch = idx & 31; \
            *(LAS v4u*)(sbuf + dd * 528 + ch * 16) = stg[i]; } } } while (0)
    ATT_GLOAD(0); ATT_SWRITE(0); __syncthreads();
    bf16x8 Pf[8];
#pragma unroll
    for (int c = 0; c < 8; ++c) {
        ATT_GLOAD(c + 1);
        const LAS unsigned char* sbuf = lds + (c & 1) * BUFB;
#pragma unroll
        for (int ss = 0; ss < 2; ++ss)
#pragma unroll
            for (int nt = 0; nt < 16; ++nt) {
                const int key = 16 * nt + fr, ch = ss * 4 + fq;
                const bf16x8 kf = *(const LAS bf16x8*)(sbuf + key * 128 + ((ch ^ (key & 7)) * 16));
                accS[nt] = __builtin_amdgcn_mfma_f32_16x16x32_bf16(kf, Qf[2 * c + ss], accS[nt], 0, 0, 0);
            }
        if (c == 7) {
            float mx = -3.0e38f;
#pragma unroll
            for (int nt = 0; nt < 16; ++nt) mx = fmaxf(mx, fmaxf(fmaxf(accS[nt][0], accS[nt][1]), fmaxf(accS[nt][2], accS[nt][3])));
            mx = fmaxf(mx, __shfl_xor(mx, 16)); mx = fmaxf(mx, __shfl_xor(mx, 32));
            float sum = 0.f;
#pragma unroll
            for (int nt = 0; nt < 16; ++nt) {
#pragma unroll
                for (int e = 0; e < 4; ++e) { const float p = exp2f(accS[nt][e] - mx); accS[nt][e] = p; sum += p; } }
            sum += __shfl_xor(sum, 16); sum += __shfl_xor(sum, 32);
            const float inv = 1.0f / sum;
#pragma unroll
            for (int s = 0; s < 8; ++s) { v4u o; o.x = pk2(accS[2 * s][0] * inv, accS[2 * s][1] * inv); o.y = pk2(accS[2 * s][2] * inv, accS[2 * s][3] * inv);
                o.z = pk2(accS[2 * s + 1][0] * inv, accS[2 * s + 1][1] * inv); o.w = pk2(accS[2 * s + 1][2] * inv, accS[2 * s + 1][3] * inv); Pf[s] = __builtin_bit_cast(bf16x8, o); }
        }
        ATT_SWRITE(c + 1);
        __syncthreads();
    }
    for (int c = 8; c < 16; ++c) {
        if (c + 1 < 16) ATT_GLOAD(c + 1);
        const LAS unsigned char* sbuf = lds + (c & 1) * BUFB;
        const int dv = c - 8;
        f32x4 accO[4];
#pragma unroll
        for (int nd = 0; nd < 4; ++nd) accO[nd] = (f32x4){0.f, 0.f, 0.f, 0.f};
#pragma unroll
        for (int s = 0; s < 8; ++s)
#pragma unroll
            for (int nd = 0; nd < 4; ++nd) {
                const LAS unsigned char* rp = sbuf + (nd * 16 + fr) * 528 + (32 * s + 4 * fq) * 2;
                const v2u lo = *(const LAS v2u*)rp, hi = *(const LAS v2u*)(rp + 32);
                const bf16x8 vf = __builtin_bit_cast(bf16x8, ((v4u){lo.x, lo.y, hi.x, hi.y}));
                accO[nd] = __builtin_amdgcn_mfma_f32_16x16x32_bf16(vf, Pf[s], accO[nd], 0, 0, 0);
            }
#pragma unroll
        for (int nd = 0; nd < 4; ++nd) { v2u o; o.x = pk2(accO[nd][0], accO[nd][1]); o.y = pk2(accO[nd][2], accO[nd][3]);
            *(v2u*)(Og + (size_t)qrow * D + h * XD + dv * 64 + nd * 16 + 4 * fq) = o; }
        if (c + 1 < 16) ATT_SWRITE(c + 1);
        __syncthreads();
    }
#undef ATT_GLOAD
#undef ATT_SWRITE
}
__device__ __forceinline__ void attn_sample_task(const Params& P, const Ctx& C, LAS unsigned char* lds, int b, int h) {
    unsigned char* ws = wsbase(P);
    const bf16* Qg = (const bf16*)(ws + WS_Q); bf16* Og = (bf16*)(ws + WS_O);
    const float* CK = inp(P, I_CK); const float* CV = inp(P, I_CV);
    LAS float* sS = (LAS float*)lds;
    LAS float* sP = (LAS float*)(lds + 8192);
    const int row0 = MP + 8 * b;
    float qv[8][8];
#pragma unroll
    for (int q = 0; q < 8; ++q) { const bf16* qp = Qg + (size_t)(row0 + q) * D + h * XD;
        const v2u a = *(const v2u*)(qp + 4 * C.lane), c2 = *(const v2u*)(qp + 256 + 4 * C.lane);
        qv[q][0] = bflo(a.x); qv[q][1] = bfhi(a.x); qv[q][2] = bflo(a.y); qv[q][3] = bfhi(a.y); qv[q][4] = bflo(c2.x); qv[q][5] = bfhi(c2.x); qv[q][6] = bflo(c2.y); qv[q][7] = bfhi(c2.y); }
    for (int k0 = 0; k0 < 32; k0 += 4) {
        f32x4 ka[4], kb2[4];
#pragma unroll
        for (int u = 0; u < 4; ++u) { const float* kp = CK + ((size_t)(b * NMEM + C.wave * 32 + k0 + u) * XH + h) * XD; ka[u] = *(const f32x4*)(kp + 4 * C.lane); kb2[u] = *(const f32x4*)(kp + 256 + 4 * C.lane); }
#pragma unroll
        for (int u = 0; u < 4; ++u) {
            float part[8];
#pragma unroll
            for (int q = 0; q < 8; ++q) part[q] = (qv[q][0] * ka[u][0] + qv[q][1] * ka[u][1]) + (qv[q][2] * ka[u][2] + qv[q][3] * ka[u][3]) + (qv[q][4] * kb2[u][0] + qv[q][5] * kb2[u][1]) + (qv[q][6] * kb2[u][2] + qv[q][7] * kb2[u][3]);
#pragma unroll
            for (int q = 0; q < 8; ++q) part[q] = wave_sum(part[q]);
            if (C.lane == 0) {
#pragma unroll
                for (int q = 0; q < 8; ++q) sS[q * 256 + C.wave * 32 + k0 + u] = part[q]; }
        }
    }
    __syncthreads();
    {
        const int q = C.wave; const f32x4 s4 = *(const LAS f32x4*)(sS + q * 256 + 4 * C.lane);
        const float mx = wave_max(fmaxf(fmaxf(s4[0], s4[1]), fmaxf(s4[2], s4[3])));
        const float p0 = exp2f(s4[0] - mx), p1 = exp2f(s4[1] - mx), p2 = exp2f(s4[2] - mx), p3 = exp2f(s4[3] - mx);
        const float inv = 1.0f / wave_sum((p0 + p1) + (p2 + p3));
        sP[(4 * C.lane + 0) * 8 + q] = p0 * inv; sP[(4 * C.lane + 1) * 8 + q] = p1 * inv; sP[(4 * C.lane + 2) * 8 + q] = p2 * inv; sP[(4 * C.lane + 3) * 8 + q] = p3 * inv;
    }
    __syncthreads();
    float acc[8];
#pragma unroll
    for (int q = 0; q < 8; ++q) acc[q] = 0.f;
    const int d = C.wave * 64 + C.lane;
    for (int k0 = 0; k0 < 256; k0 += 8) {
        float vv[8];
#pragma unroll
        for (int u = 0; u < 8; ++u) vv[u] = CV[((size_t)(b * NMEM + k0 + u) * XH + h) * XD + d];
#pragma unroll
        for (int u = 0; u < 8; ++u) { const f32x4 pa = *(const LAS f32x4*)(sP + (k0 + u) * 8), pb = *(const LAS f32x4*)(sP + (k0 + u) * 8 + 4);
            acc[0] += pa[0] * vv[u]; acc[1] += pa[1] * vv[u]; acc[2] += pa[2] * vv[u]; acc[3] += pa[3] * vv[u];
            acc[4] += pb[0] * vv[u]; acc[5] += pb[1] * vv[u]; acc[6] += pb[2] * vv[u]; acc[7] += pb[3] * vv[u]; }
    }
#pragma unroll
    for (int q = 0; q < 8; ++q) Og[(size_t)(row0 + q) * D + h * XD + d] = (bf16)f2bf(acc[q]);
    __syncthreads();
}

__device__ __forceinline__ void unpack8(const v4u u, float (&x)[8]) { x[0] = bflo(u.x); x[1] = bfhi(u.x); x[2] = bflo(u.y); x[3] = bfhi(u.y); x[4] = bflo(u.z); x[5] = bfhi(u.z); x[6] = bflo(u.w); x[7] = bfhi(u.w); }
__device__ __forceinline__ void ffn_conv_act(const Params& P, const Ctx& C) {
    unsigned char* ws = wsbase(P);
    const bf16* UP = (const bf16*)(ws + WS_UP); bf16* ACT = (bf16*)(ws + WS_ACT);
    const float* FW = inp(P, I_FDW); const float* FB = inp(P, I_FDWB); const float* SF = inp(P, I_SFFN);
    constexpr int NG = DFF / 8;
    constexpr int NRUN = 256 + 128;
    for (int it = C.bid * NT + C.tid; it < NRUN * NG; it += C.G * NT) {
        const int run = it / NG, c = (it - run * NG) * 8;
        int row0, nrow, sb = -1, t0;
        if (run < 256) { row0 = run * 32; nrow = 32; t0 = row0 & (SEQ - 1); } else { sb = run - 256; row0 = MP + 8 * sb; nrow = 8; t0 = 0; }
        float w[2][3][8], bs[2][8];
#pragma unroll
        for (int hf = 0; hf < 2; ++hf) {
#pragma unroll
            for (int j = 0; j < 3; ++j) { const f32x4 a = *(const f32x4*)(FW + j * DFF2 + hf * DFF + c), b2 = *(const f32x4*)(FW + j * DFF2 + hf * DFF + c + 4);
                w[hf][j][0] = a[0]; w[hf][j][1] = a[1]; w[hf][j][2] = a[2]; w[hf][j][3] = a[3]; w[hf][j][4] = b2[0]; w[hf][j][5] = b2[1]; w[hf][j][6] = b2[2]; w[hf][j][7] = b2[3]; }
            const f32x4 a = *(const f32x4*)(FB + hf * DFF + c), b2 = *(const f32x4*)(FB + hf * DFF + c + 4);
            bs[hf][0] = a[0]; bs[hf][1] = a[1]; bs[hf][2] = a[2]; bs[hf][3] = a[3]; bs[hf][4] = b2[0]; bs[hf][5] = b2[1]; bs[hf][6] = b2[2]; bs[hf][7] = b2[3];
        }
        float xm2[2][8], xm1[2][8];
#pragma unroll
        for (int hf = 0; hf < 2; ++hf) {
            if (sb >= 0) { const float* s = SF + (size_t)sb * 2 * DFF2 + hf * DFF + c;
                const f32x4 a = *(const f32x4*)s, b2 = *(const f32x4*)(s + 4), a1 = *(const f32x4*)(s + DFF2), b1 = *(const f32x4*)(s + DFF2 + 4);
                xm2[hf][0] = a[0]; xm2[hf][1] = a[1]; xm2[hf][2] = a[2]; xm2[hf][3] = a[3]; xm2[hf][4] = b2[0]; xm2[hf][5] = b2[1]; xm2[hf][6] = b2[2]; xm2[hf][7] = b2[3];
                xm1[hf][0] = a1[0]; xm1[hf][1] = a1[1]; xm1[hf][2] = a1[2]; xm1[hf][3] = a1[3]; xm1[hf][4] = b1[0]; xm1[hf][5] = b1[1]; xm1[hf][6] = b1[2]; xm1[hf][7] = b1[3]; }
            else if (t0 > 0) { unpack8(*(const v4u*)(UP + (size_t)(row0 - 2) * DFF2 + hf * DFF + c), xm2[hf]); unpack8(*(const v4u*)(UP + (size_t)(row0 - 1) * DFF2 + hf * DFF + c), xm1[hf]); }
            else {
#pragma unroll
                for (int e = 0; e < 8; ++e) { xm2[hf][e] = 0.f; xm1[hf][e] = 0.f; } }
        }
        for (int r0 = 0; r0 < nrow; r0 += 4) {
            v4u u[4][2];
#pragma unroll
            for (int i = 0; i < 4; ++i) { u[i][0] = *(const v4u*)(UP + (size_t)(row0 + r0 + i) * DFF2 + c); u[i][1] = *(const v4u*)(UP + (size_t)(row0 + r0 + i) * DFF2 + DFF + c); }
#pragma unroll
            for (int i = 0; i < 4; ++i) {
                float x[2][8], uc[2][8];
                unpack8(u[i][0], x[0]); unpack8(u[i][1], x[1]);
#pragma unroll
                for (int hf = 0; hf < 2; ++hf)
#pragma unroll
                    for (int e = 0; e < 8; ++e) { uc[hf][e] = bs[hf][e] + w[hf][0][e] * xm2[hf][e] + w[hf][1][e] * xm1[hf][e] + w[hf][2][e] * x[hf][e]; xm2[hf][e] = xm1[hf][e]; xm1[hf][e] = x[hf][e]; }
                float a[8];
#pragma unroll
                for (int e = 0; e < 8; ++e) a[e] = uc[0][e] * sigm(uc[0][e]) * uc[1][e];
                v4u o; o.x = pk2(a[0], a[1]); o.y = pk2(a[2], a[3]); o.z = pk2(a[4], a[5]); o.w = pk2(a[6], a[7]);
                *(v4u*)(ACT + (size_t)(row0 + r0 + i) * DFF + c) = o;
            }
        }
    }
}

template <bool COOP>
__global__ void __launch_bounds__(NT, 2) mega(Params P) {
    extern __shared__ __attribute__((aligned(16))) unsigned char lds_raw[];
    LAS unsigned char* lds = (LAS unsigned char*)lds_raw;
    Ctx C0; C0.tid = threadIdx.x; C0.lane = C0.tid & 63; C0.wave = __builtin_amdgcn_readfirstlane(C0.tid >> 6); C0.bid = blockIdx.x; C0.G = gridDim.x;
    C0.gw = C0.bid * 8 + C0.wave; C0.NGW = C0.G * 8;
    const int lo = P.ph_lo, hi = P.ph_hi;
    if (threadIdx.x < 4) ((LAS unsigned*)(lds + MISC_OFF))[threadIdx.x] = 0u;
    __syncthreads();
    XcdBarrier xbar; xbar.bar = nullptr; xbar.x = 0; xbar.st = nullptr;
    if constexpr (COOP) xbar = xcd_barrier_post((unsigned*)P.ws, (volatile LAS unsigned*)(lds + MISC_OFF));
#ifndef MK_ONLY
#define MK_ONLY -1
#endif
#define IN(k) ((MK_ONLY < 0 || MK_ONLY == (k)) && lo <= (k) && (k) < hi)
#define PH_CTX() Ctx C = C0; unsigned char* ws = wsbase(P); (void)ws; asm volatile("" : "+v"(C.tid), "+v"(C.lane), "+s"(C.wave), "+s"(C.gw), "+s"(C.bid))
#ifndef MK_REPMASK
#define MK_REPMASK 0
#endif
#define NREP(k) (((MK_REPMASK >> (k)) & 1) ? 2 : 1)
#define SEAM(k) do { if constexpr (COOP) { if (IN(k) && IN((k) + 1)) { if ((k) == 0) cg::this_grid().sync(); else xcd_barrier(xbar); } } } while (0)

    for (int rep_ = 0; rep_ < NREP(0); ++rep_) if (IN(0)) { PH_CTX(); p0_prologue(P, C, lds); __syncthreads(); }
    SEAM(0);
    for (int rep_ = 0; rep_ < NREP(1); ++rep_) if (IN(1)) { PH_CTX();
        { pg8::Gemm g{(const pg8::bf16_t*)(ws + WS_HB), (const pg8::bf16_t*)(ws + WS_WIN), M, NINP, D}; pg8::StaticOrder S; S.init(M, NINP, C.G, C.bid);
          pg8::EpiIn E{(pg8::bf16_t*)(ws + WS_GLU), (pg8::bf16_t*)(ws + WS_PR), P.out + O_CP, P.out + O_CS, P.out + O_SP, P.out + O_SS};
          pg8::gemm_phase<pg8::EpiIn, pg8::StaticOrder, PG8_ALIGN, PG8_SP2>(lds, g, S, E); }
        { pg8::Gemm g{(const pg8::bf16_t*)(ws + WS_MB), (const pg8::bf16_t*)(ws + WS_WKV), 1024, 4096, D}; pg8::StaticOrder S; S.init(1024, 4096, C.G, (C.bid + C.G - 24) % C.G);
          pg8::EpiKV E{P.out + O_MK, P.out + O_MV, (pg8::bf16_t*)(ws + WS_KB), (pg8::bf16_t*)(ws + WS_VT)};
          pg8::gemm_phase<pg8::EpiKV, pg8::StaticOrder, PG8_ALIGN, PG8_SP2>(lds, g, S, E); }
    }
    SEAM(1);
    for (int rep_ = 0; rep_ < NREP(2); ++rep_) if (IN(2)) { PH_CTX();
        SUBREP(0) for (int tk = C.bid; tk < 640; tk += C.G) {
            if (tk < 512) { const int b = tk >> 7, r0 = (tk & 127) * 16; conv_task<16>(P, C, lds, b * SEQ + r0, r0, -1); }
            else { const int sb = tk - 512; conv_task<8>(P, C, lds, MP + 8 * sb, 0, sb); }
        }
        SUBREP(1) for (int tk = C.bid; tk < 144; tk += C.G) prep_task<8>(P, C, lds, tk >> 1, (tk & 1) * 8);
    }
    SEAM(2);
    for (int rep_ = 0; rep_ < NREP(3); ++rep_) if (IN(3)) { PH_CTX();
        const float* swkv = inp(P, I_SWKV);
        SUBREP(2) for (int tk = C.bid; tk < 256; tk += C.G) scan_prompt(P, C, lds, tk >> 2, tk & 3);
        SUBREP(3) for (int tk = C.bid; tk < 4096; tk += C.G) scan_sample(P, C, swkv, tk >> 1, tk & 1);
    }
    SEAM(3);
    for (int rep_ = 0; rep_ < NREP(4); ++rep_) if (IN(4)) { PH_CTX(); for (int m = C.gw; m < M; m += C.NGW) post_row(P, m, C.lane); }
    SEAM(4);
    for (int rep_ = 0; rep_ < NREP(5); ++rep_) if (IN(5)) { PH_CTX(); pg8::Gemm g{(const pg8::bf16_t*)(ws + WS_A2), (const pg8::bf16_t*)(ws + WS_WOUT), M, D, D}; pg8::StaticOrder S; S.init(M, D, C.G, C.bid);
        pg8::EpiF32 E{(float*)(ws + WS_MIX), D}; pg8::gemm_phase<pg8::EpiF32, pg8::StaticOrder, PG8_ALIGN, PG8_SP2>(lds, g, S, E); }
    SEAM(5);
    for (int rep_ = 0; rep_ < NREP(6); ++rep_) if (IN(6)) { PH_CTX(); const float* xp = inp(P, I_XP); const float* xs = inp(P, I_XS); const float* g1 = inp(P, I_NMIXPOST); const float* g2 = inp(P, I_NXAPRE);
        for (int m = C.gw; m < M; m += C.NGW) { const float* xr = m < MP ? xp + (size_t)m * D : xs + (size_t)(m - MP) * D;
        rowpass(xr, (const float*)(ws + WS_MIX) + (size_t)m * D, g1, (float*)(ws + WS_X1) + (size_t)m * D, g2, (bf16*)(ws + WS_HB) + (size_t)m * D, C.lane); } }
    SEAM(6);
    for (int rep_ = 0; rep_ < NREP(7); ++rep_) if (IN(7)) { PH_CTX(); pg8::Gemm g{(const pg8::bf16_t*)(ws + WS_HB), (const pg8::bf16_t*)(ws + WS_WQ), M, D, D}; pg8::StaticOrder S; S.init(M, D, C.G, C.bid);
        pg8::EpiBf16S E{(pg8::bf16_t*)(ws + WS_Q), D, 0.06375871479f  , nullptr};
        pg8::gemm_phase<pg8::EpiBf16S, pg8::StaticOrder, PG8_ALIGN, PG8_SP2>(lds, g, S, E); }
    SEAM(7);
    for (int rep_ = 0; rep_ < NREP(8); ++rep_) if (IN(8)) { PH_CTX();
        SUBREP(4) for (int tk = C.bid; tk < 256; tk += C.G) attn_prompt_task(P, C, lds, tk >> 6, (tk >> 4) & 3, tk & 15);
        SUBREP(5) for (int tk = C.bid; tk < 512; tk += C.G) attn_sample_task(P, C, lds, tk >> 2, tk & 3);
    }
    SEAM(8);
    for (int rep_ = 0; rep_ < NREP(9); ++rep_) if (IN(9)) { PH_CTX(); pg8::Gemm g{(const pg8::bf16_t*)(ws + WS_O), (const pg8::bf16_t*)(ws + WS_WO), M, D, D}; pg8::StaticOrder S; S.init(M, D, C.G, C.bid);
        pg8::EpiF32 E{(float*)(ws + WS_MIX), D}; pg8::gemm_phase<pg8::EpiF32, pg8::StaticOrder, PG8_ALIGN, PG8_SP2>(lds, g, S, E); }
    SEAM(9);
    for (int rep_ = 0; rep_ < NREP(10); ++rep_) if (IN(10)) { PH_CTX(); const float* g1 = inp(P, I_NXAPOST); const float* g2 = inp(P, I_NFFNPRE);
        for (int m = C.gw; m < M; m += C.NGW) { float* x1 = (float*)(ws + WS_X1) + (size_t)m * D;
        rowpass(x1, (const float*)(ws + WS_MIX) + (size_t)m * D, g1, x1, g2, (bf16*)(ws + WS_HB) + (size_t)m * D, C.lane); } }
    SEAM(10);
    for (int rep_ = 0; rep_ < NREP(11); ++rep_) if (IN(11)) { PH_CTX(); pg8::Gemm g{(const pg8::bf16_t*)(ws + WS_HB), (const pg8::bf16_t*)(ws + WS_WUP), M, DFF2, D}; pg8::StaticOrder S; S.init(M, DFF2, C.G, C.bid);
        pg8::EpiBf16S E{(pg8::bf16_t*)(ws + WS_UP), DFF2, 1.0f, P.out + O_FP};
        pg8::gemm_phase<pg8::EpiBf16S, pg8::StaticOrder, PG8_ALIGN, PG8_SP2>(lds, g, S, E); }
    SEAM(11);
    for (int rep_ = 0; rep_ < NREP(12); ++rep_) if (IN(12)) { PH_CTX(); ffn_conv_act(P, C); }
    SEAM(12);
    for (int rep_ = 0; rep_ < NREP(13); ++rep_) if (IN(13)) { PH_CTX(); pg8::Gemm g{(const pg8::bf16_t*)(ws + WS_ACT), (const pg8::bf16_t*)(ws + WS_WDN), M, D, DFF}; pg8::StaticOrder S; S.init(M, D, C.G, C.bid);
        pg8::EpiF32 E{(float*)(ws + WS_MIX), D}; pg8::gemm_phase<pg8::EpiF32, pg8::StaticOrder, PG8_ALIGN, PG8_SP2>(lds, g, S, E); }
    SEAM(13);
    for (int rep_ = 0; rep_ < NREP(14); ++rep_) if (IN(14)) { PH_CTX(); const float* g1 = inp(P, I_NFFNPOST);
        for (int m = C.gw; m < M; m += C.NGW) { const float* x2 = (const float*)(ws + WS_X1) + (size_t)m * D;
        float* yo = m < MP ? P.out + O_YP + (size_t)m * D : P.out + O_YS + (size_t)(m - MP) * D;
        rowpass(x2, (const float*)(ws + WS_MIX) + (size_t)m * D, g1, yo, nullptr, nullptr, C.lane); } }
#undef IN
#undef SEAM
}

#ifndef MK_ONE_LAUNCH
#define MK_ONE_LAUNCH 1
#endif
extern "C" void kernel_launch(void* const* d_in, const int* in_sizes, int n_in, void* d_out, int out_size, void* d_ws, size_t ws_size, hipStream_t stream) {
    static int grid = 0;
    if (grid == 0) {
        if (n_in != N_IN || (size_t)out_size != O_END || ws_size < WS_END) { fprintf(stderr, "kernel_launch: unexpected sizes: n_in %d out %d ws %zu (need %zu)\n", n_in, out_size, ws_size, (size_t)WS_END); grid = -1; return; }
        int dev = 0, cus = 0, per_cu = 0;
        (void)hipGetDevice(&dev); (void)hipDeviceGetAttribute(&cus, hipDeviceAttributeMultiprocessorCount, dev);
        (void)hipFuncSetAttribute((const void*)mega<(MK_ONE_LAUNCH != 0)>, hipFuncAttributeMaxDynamicSharedMemorySize, LDS_BYTES);
        (void)hipOccupancyMaxActiveBlocksPerMultiprocessor(&per_cu, (const void*)mega<(MK_ONE_LAUNCH != 0)>, NT, LDS_BYTES);
        fprintf(stderr, "kernel_launch: cus %d, occupancy query %d block(s)/CU, ws %zu MiB\n", cus, per_cu, ws_size >> 20);
        (void)hipGetLastError();
        grid = cus;
        if (per_cu < 1) { fprintf(stderr, "kernel_launch: occupancy query says 0 blocks per CU\n"); }
    }
    if (grid < 0) return;
    if (hipMemsetAsync(d_ws, 0, 16384, stream) != hipSuccess) { fprintf(stderr, "kernel_launch: hipMemsetAsync failed\n"); return; }
    Params p{};
    for (int i = 0; i < N_IN; ++i) p.in[i] = (const float*)d_in[i];
    p.out = (float*)d_out; p.ws = (unsigned char*)d_ws;
#if MK_ONE_LAUNCH
    p.ph_lo = 0; p.ph_hi = NPHASE;
    void* args[] = {&p};
    hipError_t e = hipLaunchCooperativeKernel((const void*)mega<true>, dim3(grid), dim3(NT), args, LDS_BYTES, stream);
    if (e != hipSuccess) fprintf(stderr, "cooperative launch failed: %s (grid %d)\n", hipGetErrorString(e), grid);
#else
    for (int ph = 0; ph < NPHASE; ++ph) { p.ph_lo = ph; p.ph_hi = ph + 1; hipLaunchKernelGGL((mega<false>), dim3(grid), dim3(NT), LDS_BYTES, stream, p); }
#endif
}
```

```cpp
#include <hip/hip_runtime.h>
#include <hip/hip_cooperative_groups.h>
#include <cstdio>
#include <cstdint>
namespace cg = cooperative_groups;
constexpr int D = 2048, MP = 8192, MS = 1024, M = MP + MS, SEQ = 2048, TS = 8, NBP = 4, NBS = 128;
constexpr int CC = 1024, CW = 31, RW = 1024, RH = 16, HD = 64;
constexpr int NRC = 3520, NRCP = 3584, NINP = 5632;
constexpr int NMEM = 256, XH = 4, XD = 512, DFF = 5632, DFF2 = 11264;
namespace pg8 {
#define PG8_LAS __attribute__((address_space(3)))
typedef unsigned short bf16_t;
typedef short bf16x8 __attribute__((ext_vector_type(8)));
typedef float f32x4 __attribute__((ext_vector_type(4)));
typedef unsigned u32x4 __attribute__((ext_vector_type(4)));
constexpr int BM = 256, BK = 64, HALF = 128, HTB = HALF * BK * 2  , STAGE_BYTES = 8 * HTB, NXCD = 8, WGM = 8;

__host__ __device__ __forceinline__ int lds_byte(int r, int c) { const int st = (r >> 4) * 2 + (c >> 5), rr = r & 15, cc = c & 31, ob = rr * 64 + cc * 2; return st * 1024 + (ob ^ (((ob >> 9) & 1) << 5)); }
__host__ __device__ __forceinline__ void stage_rc(int b, int& R, int& C) { const int st = b / 1024, sb = b % 1024, swz = sb ^ (((sb >> 9) & 1) << 5); R = (st >> 1) * 16 + swz / 64; C = (st & 1) * 32 + (swz % 64) / 2; }
__host__ __device__ __forceinline__ int perm32(int rho) { const int n = rho >> 4, i = rho & 15; return 8 * (i >> 2) + 4 * n + (i & 3); }

struct Unit { int pm, pn, ks; };
struct Gemm { const bf16_t* A; const bf16_t* Bt; int M, N, K, ld; };

struct StaticOrder {
    int nM, nN, nwg, G, c;
    __host__ __device__ void init(int M, int N, int G_, int c_) { nM = M / BM; nN = N / BM; nwg = nM * nN; G = G_; c = c_; }
    __host__ __device__ bool next(int i, Unit& u) const {
        const long L = (long)i * G + c; if (L >= nwg) return false;
        int wgid = (int)L; { const int q = nwg / NXCD, r = nwg % NXCD, xcd = wgid % NXCD, off = wgid / NXCD; wgid = (xcd < r ? xcd * (q + 1) : r * (q + 1) + (xcd - r) * q) + off; }
        const int nig = WGM * nN, gid = wgid / nig, fm = gid * WGM, gsz = (nM - fm) < WGM ? (nM - fm) : WGM;
        u.pm = fm + ((wgid % nig) % gsz); u.pn = (wgid % nig) / gsz; u.ks = 0; return true;
    }
    __device__ __forceinline__ void a_ready(const Unit&) const {}
    __device__ __forceinline__ void done(const Unit&) const {}
};

struct SplitOrder {
    int nN, nsplit, nitems, G, c;
    __host__ __device__ void init(int M, int N, int nsplit_, int G_, int c_) { nN = N / BM; nsplit = nsplit_; nitems = (M / BM) * nN * nsplit_; G = G_; c = c_; }
    __host__ __device__ bool next(int i, Unit& u) const { const int L = i * G + c; if (L >= nitems) return false; u.ks = L % nsplit; const int t = L / nsplit; u.pn = t % nN; u.pm = t / nN; return true; }
    __device__ __forceinline__ void a_ready(const Unit&) const {}
    __device__ __forceinline__ void done(const Unit&) const {}
};
__device__ __forceinline__ unsigned cvt_pk_bf16(float lo, float hi) { unsigned r; asm volatile("v_cvt_pk_bf16_f32 %0, %1, %2" : "=v"(r) : "v"(lo), "v"(hi)); return r; }
typedef float f32x2 __attribute__((ext_vector_type(2)));
typedef unsigned u32x2 __attribute__((ext_vector_type(2)));
struct EpiIn {
    static constexpr bool PERM = true, AFTER_DRAIN = false;
    bf16_t* glu; bf16_t* pr; float* oconv_p; float* oconv_s; float* oshift_p; float* oshift_s;
    __device__ __forceinline__ void operator()(const f32x4 (&acc)[2][2][4][2], const Unit& u, int wr, int wc, int fr, int fq) const {
        const int row0 = u.pm * BM + wr * 64 + fr;
        if (u.pn < 8) {
#pragma unroll
            for (int ai = 0; ai < 2; ++ai)
#pragma unroll
                for (int m = 0; m < 4; ++m) {
                    const int row = row0 + ai * HALF + m * 16;
                    float* cdst = nullptr;
                    if (row < MP) { const int t = row & (SEQ - 1); if (t >= SEQ - 30) cdst = oconv_p + (size_t)((row >> 11) * 30 + (t - (SEQ - 30))) * CC; }
                    else { const int rs = row - MP; cdst = oconv_s + (size_t)((rs >> 3) * 30 + 22 + (rs & 7)) * CC; }
#pragma unroll
                    for (int bj = 0; bj < 2; ++bj) {
                        const int cgl = 16 * (8 * u.pn + 4 * bj + wc) + 4 * fq;
                        const f32x4 a = acc[ai][bj][m][0], g = acc[ai][bj][m][1];
                        f32x4 v;
#pragma unroll
                        for (int e = 0; e < 4; ++e) v[e] = a[e] / (1.0f + __expf(-g[e]));
                        u32x2 w; w.x = cvt_pk_bf16(v[0], v[1]); w.y = cvt_pk_bf16(v[2], v[3]);
                        *(u32x2*)(glu + (size_t)row * CC + cgl) = w;
                        if (cdst) *(f32x4*)(cdst + cgl) = v;
                    }
                }
        } else {
#pragma unroll
            for (int ai = 0; ai < 2; ++ai)
#pragma unroll
                for (int m = 0; m < 4; ++m) {
                    const int row = row0 + ai * HALF + m * 16;
                    float* sdst = nullptr;
                    if (row < MP) { if ((row & (SEQ - 1)) == SEQ - 1) sdst = oshift_p + (size_t)(row >> 11) * NRC; }
                    else { const int rs = row - MP; if ((rs & 7) == 7) sdst = oshift_s + (size_t)(rs >> 3) * NRC; }
#pragma unroll
                    for (int bj = 0; bj < 2; ++bj) {
                        const int jj0 = 256 * (u.pn - 8) + 128 * bj + 32 * wc + 8 * fq;
                        const f32x4 v0 = acc[ai][bj][m][0], v1 = acc[ai][bj][m][1];
                        u32x4 w; w.x = cvt_pk_bf16(v0[0], v0[1]); w.y = cvt_pk_bf16(v0[2], v0[3]); w.z = cvt_pk_bf16(v1[0], v1[1]); w.w = cvt_pk_bf16(v1[2], v1[3]);
                        *(u32x4*)(pr + (size_t)row * NRCP + jj0) = w;
                        if (sdst && jj0 < NRC) { *(f32x4*)(sdst + jj0) = v0; *(f32x4*)(sdst + jj0 + 4) = v1; }
                    }
                }
        }
    }
};
struct EpiKV {
    static constexpr bool PERM = false, AFTER_DRAIN = false;
    float* ok; float* ov; bf16_t* kb; bf16_t* vt;
    __device__ __forceinline__ void operator()(const f32x4 (&acc)[2][2][4][2], const Unit& u, int wr, int wc, int fr, int fq) const {
        const int row0 = u.pm * BM + wr * 64 + fr;
#pragma unroll
        for (int ai = 0; ai < 2; ++ai)
#pragma unroll
            for (int m = 0; m < 4; ++m) {
                const int r = row0 + ai * HALF + m * 16;
#pragma unroll
                for (int bj = 0; bj < 2; ++bj)
#pragma unroll
                    for (int n = 0; n < 2; ++n) {
                        const int c = 256 * u.pn + 128 * bj + 32 * wc + 16 * n + 4 * fq;
                        const f32x4 v = acc[ai][bj][m][n];
                        if (u.pn < 8) {
                            *(f32x4*)(ok + (size_t)r * 2048 + c) = v;
                            u32x2 w; w.x = cvt_pk_bf16(v[0], v[1]); w.y = cvt_pk_bf16(v[2], v[3]);
                            *(u32x2*)(kb + (size_t)r * 2048 + c) = w;
                        } else {
                            const int cv = c - 2048;
                            *(f32x4*)(ov + (size_t)r * 2048 + cv) = v;
                            const int b = r >> 8, key = r & 255, h = cv >> 9, d = cv & 511;
                            bf16_t* dst = vt + ((size_t)((b * 4 + h) * 512 + d)) * 256 + key;
                            const unsigned w0 = cvt_pk_bf16(v[0], v[1]), w1 = cvt_pk_bf16(v[2], v[3]);
                            dst[0] = (bf16_t)(w0 & 0xffffu); dst[256] = (bf16_t)(w0 >> 16); dst[512] = (bf16_t)(w1 & 0xffffu); dst[768] = (bf16_t)(w1 >> 16);
                        }
                    }
            }
    }
};
struct EpiF32 {
    static constexpr bool PERM = false, AFTER_DRAIN = false;
    float* C; int ldc; size_t slab;
    __device__ __forceinline__ void operator()(const f32x4 (&acc)[2][2][4][2], const Unit& u, int wr, int wc, int fr, int fq) const {
        const int row0 = u.pm * BM + wr * 64 + fr, col0 = u.pn * BM + wc * 32 + 4 * fq;
#pragma unroll
        for (int ai = 0; ai < 2; ++ai)
#pragma unroll
            for (int m = 0; m < 4; ++m) { float* rowp = C + (size_t)u.ks * slab + (size_t)(row0 + ai * HALF + m * 16) * ldc + col0;
#pragma unroll
                for (int bj = 0; bj < 2; ++bj)
#pragma unroll
                    for (int n = 0; n < 2; ++n) *(f32x4*)(rowp + bj * HALF + n * 16) = acc[ai][bj][m][n]; }
    }
};
struct EpiBf16S {
    static constexpr bool PERM = true, AFTER_DRAIN = false;
    bf16_t* O; int ldc; float scale; float* f;
    __device__ __forceinline__ void operator()(const f32x4 (&acc)[2][2][4][2], const Unit& u, int wr, int wc, int fr, int fq) const {
        const int row0 = u.pm * BM + wr * 64 + fr, col0 = u.pn * BM + wc * 32 + 8 * fq;
#pragma unroll
        for (int ai = 0; ai < 2; ++ai)
#pragma unroll
            for (int m = 0; m < 4; ++m) {
                const int row = row0 + ai * HALF + m * 16;
                long foff = -1;
                if (f) {
                    if (row < MP) { const int t = row & (SEQ - 1); if (t >= SEQ - 2) foff = (long)((row >> 11) * 2 + (t - (SEQ - 2))) * DFF2; }
                    else { const int rs = row - MP, t = rs & 7; if (t >= 6) foff = (long)(NBP * 2 + (rs >> 3) * 2 + (t - 6)) * DFF2; }
                }
                float* fdst = f + (foff < 0 ? 0 : foff);
                bf16_t* rowp = O + (size_t)row * ldc + col0;
#pragma unroll
                for (int bj = 0; bj < 2; ++bj) {
                    const f32x4 v0 = acc[ai][bj][m][0] * scale, v1 = acc[ai][bj][m][1] * scale;
                    u32x4 w; w.x = cvt_pk_bf16(v0[0], v0[1]); w.y = cvt_pk_bf16(v0[2], v0[3]); w.z = cvt_pk_bf16(v1[0], v1[1]); w.w = cvt_pk_bf16(v1[2], v1[3]);
                    *(u32x4*)(rowp + bj * HALF) = w;
                    if (foff >= 0) { *(f32x4*)(fdst + col0 + bj * HALF) = v0; *(f32x4*)(fdst + col0 + bj * HALF + 4) = v1; }
                }
            }
    }
};

template <class Epi, class Sched, bool ALIGN_EPI = false, bool SP2 = false>
__device__ __forceinline__ void gemm_phase(PG8_LAS unsigned char* lds, const Gemm g, const Sched& S, const Epi& E) {
    int tid_ = threadIdx.x; asm volatile("" : "+v"(tid_));
    const int tid = tid_, wid = __builtin_amdgcn_readfirstlane(tid >> 6), lane = tid & 63, wr = wid >> 2, wc = wid & 3, fr = lane & 15, fq = lane >> 4;
    const int K = g.K, nt = K / BK;
    unsigned voffA[2], voffB[2];
#pragma unroll
    for (int i = 0; i < 2; ++i) { int R, C; stage_rc(tid * 16 + i * 8192, R, C); const int Rb = Epi::PERM ? ((R & ~31) + perm32(R & 31)) : R;
        voffA[i] = (unsigned)(R * g.ld + C) * 2u; voffB[i] = (unsigned)(Rb * g.ld + C) * 2u; }
    const size_t kstep = (size_t)(BK * 2);
    const size_t hstep = (size_t)HALF * g.ld * 2;
    const size_t tstep = 2 * hstep;
    const unsigned ldsw = (unsigned)wid * 1024u;
    const int aoff = lds_byte(wr * 64 + fr, fq * 8), boff = lds_byte(wc * 32 + fr, fq * 8);
#define PG8_SA(b, h) (((b) * 2 + (h)) * HTB)
#define PG8_SB(b, h) ((4 + (b) * 2 + (h)) * HTB)
#define PG8_STAGE(bufoff, gbase, voff) do { _Pragma("unroll") for (int _i = 0; _i < 2; ++_i) \
        __builtin_amdgcn_global_load_lds((const unsigned*)((const char*)(gbase) + (voff)[_i]), (PG8_LAS unsigned*)(lds + (bufoff) + ldsw + _i * 8192), 16, 0, 0); } while (0)
#define PG8_LDA(dst, b, h) do { _Pragma("unroll") for (int m = 0; m < 4; ++m) _Pragma("unroll") for (int k = 0; k < 2; ++k) dst[m][k] = *(const PG8_LAS bf16x8*)(lds + PG8_SA(b, h) + aoff + m * 2048 + k * 1024); } while (0)
#define PG8_LDB(dst, b, h) do { _Pragma("unroll") for (int n = 0; n < 2; ++n) _Pragma("unroll") for (int k = 0; k < 2; ++k) dst[n][k] = *(const PG8_LAS bf16x8*)(lds + PG8_SB(b, h) + boff + n * 2048 + k * 1024); } while (0)
#define PG8_MMA(ai, bj, At, Bt) do { __builtin_amdgcn_s_setprio(1); _Pragma("unroll") for (int m = 0; m < 4; ++m) _Pragma("unroll") for (int n = 0; n < 2; ++n) _Pragma("unroll") for (int k = 0; k < 2; ++k) \
        acc[ai][bj][m][n] = __builtin_amdgcn_mfma_f32_16x16x32_bf16(Bt[n][k], At[m][k], acc[ai][bj][m][n], 0, 0, 0); __builtin_amdgcn_s_setprio(0); } while (0)
#define PG8_WAIT_V(n) asm volatile("s_waitcnt vmcnt(" #n ")" ::: "memory")
#define PG8_WAIT_L(n) asm volatile("s_waitcnt lgkmcnt(" #n ")" ::: "memory")
#define PG8_BAR __builtin_amdgcn_s_barrier()
#define PG8_SCHED __builtin_amdgcn_sched_barrier(0)
    Unit cur, nxt; int ui = 0;
    if (!S.next(0, cur)) return;
    f32x4 acc[2][2][4][2];
#pragma unroll
    for (int a = 0; a < 2; ++a)
#pragma unroll
        for (int b = 0; b < 2; ++b)
#pragma unroll
            for (int m = 0; m < 4; ++m)
#pragma unroll
                for (int n = 0; n < 2; ++n) acc[a][b][m][n] = (f32x4){0.f, 0.f, 0.f, 0.f};
    bf16x8 At[4][2], B0[2][2], B1[2][2];
    const size_t sstep = (size_t)K * 2;
    const char* cA = (const char*)g.A + (size_t)cur.pm * tstep + (size_t)cur.ks * sstep; const char* cB = (const char*)g.Bt + (size_t)cur.pn * tstep + (size_t)cur.ks * sstep;
    S.a_ready(cur);
    if constexpr (SP2) {
        PG8_STAGE(PG8_SB(0, 0), cB, voffB); PG8_STAGE(PG8_SB(0, 1), cB + hstep, voffB); PG8_STAGE(PG8_SA(0, 0), cA, voffA); PG8_STAGE(PG8_SA(0, 1), cA + hstep, voffA);
        if (wr == 1) PG8_BAR;
        PG8_WAIT_V(2); PG8_BAR;
        PG8_STAGE(PG8_SB(1, 0), cB + kstep, voffB); PG8_STAGE(PG8_SA(1, 0), cA + kstep, voffA); PG8_STAGE(PG8_SB(1, 1), cB + hstep + kstep, voffB);
        PG8_WAIT_V(6); PG8_BAR;
    } else {
        PG8_STAGE(PG8_SB(0, 0), cB, voffB); PG8_STAGE(PG8_SA(0, 0), cA, voffA); PG8_STAGE(PG8_SB(0, 1), cB + hstep, voffB); PG8_STAGE(PG8_SA(0, 1), cA + hstep, voffA);
        if (wr == 1) PG8_BAR;
        PG8_WAIT_V(4); PG8_BAR;
        PG8_STAGE(PG8_SB(1, 0), cB + kstep, voffB); PG8_STAGE(PG8_SA(1, 0), cA + kstep, voffA); PG8_STAGE(PG8_SB(1, 1), cB + hstep + kstep, voffB);
        PG8_WAIT_V(6); PG8_BAR;
    }
    for (;;) {
        const bool has_next = S.next(ui + 1, nxt);
        const char* nA = has_next ? (const char*)g.A + (size_t)nxt.pm * tstep + (size_t)nxt.ks * sstep : cA; const char* nB = has_next ? (const char*)g.Bt + (size_t)nxt.pn * tstep + (size_t)nxt.ks * sstep : cB;
        for (int t = 0; t < nt; t += 2) {
            const bool last = (t == nt - 2);
            const char* a1 = cA + (size_t)(t + 1) * kstep;
            const char* a2 = last ? nA : cA + (size_t)(t + 2) * kstep; const char* b2 = last ? nB : cB + (size_t)(t + 2) * kstep;
            const char* a3 = a2 + kstep; const char* b3 = b2 + kstep;
            if (last && has_next) S.a_ready(nxt);
            if constexpr (SP2) {
            PG8_LDB(B0, 0, 0); PG8_LDB(B1, 0, 1); PG8_SCHED; PG8_LDA(At, 0, 0); PG8_STAGE(PG8_SA(1, 1), a1 + hstep, voffA);
            PG8_WAIT_V(8); PG8_WAIT_L(0); PG8_BAR; PG8_MMA(0, 0, At, B0); PG8_MMA(0, 1, At, B1); PG8_BAR; PG8_SCHED;
            PG8_LDA(At, 0, 1); PG8_STAGE(PG8_SB(0, 0), b2, voffB); PG8_STAGE(PG8_SB(0, 1), b2 + hstep, voffB); PG8_STAGE(PG8_SA(0, 0), a2, voffA);
            PG8_WAIT_V(8); PG8_WAIT_L(0); PG8_BAR; PG8_MMA(1, 0, At, B0); PG8_MMA(1, 1, At, B1); PG8_BAR; PG8_SCHED;
            PG8_LDB(B0, 1, 0); PG8_LDB(B1, 1, 1); PG8_SCHED; PG8_LDA(At, 1, 0); PG8_STAGE(PG8_SA(0, 1), a2 + hstep, voffA);
            PG8_WAIT_V(8); PG8_WAIT_L(0); PG8_BAR; PG8_MMA(0, 0, At, B0); PG8_MMA(0, 1, At, B1); PG8_BAR; PG8_SCHED;
            PG8_LDA(At, 1, 1); PG8_STAGE(PG8_SB(1, 0), b3, voffB); PG8_STAGE(PG8_SB(1, 1), b3 + hstep, voffB); PG8_STAGE(PG8_SA(1, 0), a3, voffA);
            PG8_WAIT_V(8); PG8_WAIT_L(0); PG8_BAR; PG8_MMA(1, 0, At, B0); PG8_MMA(1, 1, At, B1); PG8_BAR; PG8_SCHED;
            } else {
            PG8_LDB(B0, 0, 0); PG8_SCHED; PG8_LDA(At, 0, 0); PG8_STAGE(PG8_SA(1, 1), a1 + hstep, voffA);
            PG8_WAIT_L(8); PG8_BAR; PG8_WAIT_L(0); PG8_MMA(0, 0, At, B0); PG8_BAR; PG8_SCHED;
            PG8_LDB(B1, 0, 1); PG8_STAGE(PG8_SB(0, 0), b2, voffB);
            PG8_BAR; PG8_WAIT_L(0); PG8_MMA(0, 1, At, B1); PG8_BAR;
            PG8_LDA(At, 0, 1); PG8_STAGE(PG8_SA(0, 0), a2, voffA);
            PG8_BAR; PG8_WAIT_L(0); PG8_MMA(1, 0, At, B0); PG8_BAR; PG8_SCHED;
            PG8_STAGE(PG8_SB(0, 1), b2 + hstep, voffB);
            PG8_WAIT_V(6); PG8_BAR; PG8_MMA(1, 1, At, B1); PG8_BAR;
            PG8_LDB(B0, 1, 0); PG8_SCHED; PG8_LDA(At, 1, 0); PG8_STAGE(PG8_SA(0, 1), a2 + hstep, voffA);
            PG8_WAIT_L(8); PG8_BAR; PG8_WAIT_L(0); PG8_MMA(0, 0, At, B0); PG8_BAR; PG8_SCHED;
            PG8_LDB(B1, 1, 1); PG8_STAGE(PG8_SB(1, 0), b3, voffB);
            PG8_BAR; PG8_WAIT_L(0); PG8_MMA(0, 1, At, B1); PG8_BAR;
            PG8_LDA(At, 1, 1); PG8_STAGE(PG8_SA(1, 0), a3, voffA);
            PG8_BAR; PG8_WAIT_L(0); PG8_MMA(1, 0, At, B0); PG8_BAR; PG8_SCHED;
            PG8_STAGE(PG8_SB(1, 1), b3 + hstep, voffB);
            PG8_WAIT_V(6); PG8_BAR; PG8_MMA(1, 1, At, B1); PG8_BAR;
            }
        }
        if constexpr (ALIGN_EPI) { if (wr == 0) PG8_BAR; }
        if constexpr (!Epi::AFTER_DRAIN) { E(acc, cur, wr, wc, fr, fq); S.done(cur); }
        if (!has_next) break;
#pragma unroll
        for (int a = 0; a < 2; ++a)
#pragma unroll
            for (int b = 0; b < 2; ++b)
#pragma unroll
                for (int m = 0; m < 4; ++m)
#pragma unroll
                    for (int n = 0; n < 2; ++n) acc[a][b][m][n] = (f32x4){0.f, 0.f, 0.f, 0.f};
        cur = nxt; cA = nA; cB = nB; ++ui;
        if constexpr (ALIGN_EPI) { if (wr == 1) PG8_BAR; }
    }
    PG8_WAIT_V(0);
    if constexpr (!ALIGN_EPI) { if (wr == 0) PG8_BAR; }
    PG8_BAR;
    if constexpr (Epi::AFTER_DRAIN) { E.fused(acc, cur, wr, wc, fr, fq, lds, wid, lane); S.done(cur); }
#undef PG8_SA
#undef PG8_SB
#undef PG8_STAGE
#undef PG8_LDA
#undef PG8_LDB
#undef PG8_MMA
#undef PG8_WAIT_V
#undef PG8_WAIT_L
#undef PG8_BAR
#undef PG8_SCHED
}
}
#ifndef PG8_SP2
#define PG8_SP2 true
#endif
#ifndef PG8_ALIGN
#define PG8_ALIGN true
#endif
#define LAS __attribute__((address_space(3)))
typedef unsigned short bf16;
typedef unsigned v4u __attribute__((ext_vector_type(4)));
typedef unsigned v2u __attribute__((ext_vector_type(2)));
typedef float f32x4 __attribute__((ext_vector_type(4)));
typedef float f32x2 __attribute__((ext_vector_type(2)));
typedef short bf16x8 __attribute__((ext_vector_type(8)));
constexpr int NT = 512;
constexpr int LDS_BYTES = 147456;
constexpr int NPHASE = 15;

constexpr size_t MiB = 1u << 20;
constexpr size_t WS_WIN = 1 * MiB, WS_WKV = 23 * MiB, WS_WOUT = 39 * MiB, WS_WQ = 47 * MiB, WS_WO = 55 * MiB, WS_WUP = 63 * MiB, WS_WDN = 107 * MiB;
constexpr size_t WS_LW = 129 * MiB, WS_LA = 129 * MiB + 256 * 1024, WS_LG = 129 * MiB + 512 * 1024;
constexpr size_t WS_HB = 130 * MiB, WS_MB = 166 * MiB, WS_A2 = 170 * MiB, WS_MIX = 206 * MiB, WS_X1 = 278 * MiB, WS_Q = 350 * MiB, WS_O = 386 * MiB;
constexpr size_t WS_KB = 422 * MiB, WS_VT = 426 * MiB, WS_Y = 430 * MiB, WS_G = 466 * MiB, WS_BON = 502 * MiB;
constexpr size_t WS_SHB = 818 * MiB;
constexpr size_t WS_SI = 503 * MiB, SB_STRIDE = 18 * MiB;
constexpr size_t WS_SW = WS_SI + 5 * SB_STRIDE;
constexpr size_t WS_UP = 503 * MiB;
constexpr size_t WS_GLU = 719 * MiB, WS_PR = 737 * MiB;
constexpr size_t WS_ACT = 719 * MiB;
constexpr size_t WS_HIMG = 820 * MiB;
constexpr size_t WS_SLAB = 822 * MiB, SLAB_F = (size_t)MS * D;
constexpr size_t WS_END = 886 * MiB;
constexpr size_t O_YP = 0, O_YS = 16777216, O_CP = 18874368, O_CS = 18997248, O_SP = 22929408, O_SS = 22943488, O_WP = 23394048, O_WS = 23656192,
                 O_FP = 32044800, O_FS = 32134912, O_MK = 35018496, O_MV = 37115648, O_END = 39212800;

enum { I_XP = 0, I_XS, I_CK, I_CV, I_SCONV, I_SSHIFT, I_SWKV, I_SFFN, I_MEM, I_NMIXPRE, I_WIN, I_CDW, I_CDWB, I_CLNG, I_CLNB, I_MU, I_W0, I_WLORA, I_A0, I_ALORA,
       I_GLORA, I_KK, I_KA, I_RK, I_LNXG, I_LNXB, I_WOUT, I_NMIXPOST, I_NXAPRE, I_NMEM, I_WQ, I_WK, I_WV, I_WO, I_NXAPOST, I_NFFNPRE, I_WUP, I_FDW, I_FDWB, I_WDOWN,
       I_NFFNPOST, N_IN };

struct Params { const float* in[N_IN]; float* out; unsigned char* ws; int ph_lo, ph_hi; };

__device__ __forceinline__ unsigned f2bf(float f) { unsigned u = __builtin_bit_cast(unsigned, f); return (u + 0x7fffu + ((u >> 16) & 1u)) >> 16; }
__device__ __forceinline__ unsigned pk2(float lo, float hi) { return f2bf(lo) | (f2bf(hi) << 16); }
__device__ __forceinline__ float bflo(unsigned u) { return __builtin_bit_cast(float, u << 16); }
__device__ __forceinline__ float bfhi(unsigned u) { return __builtin_bit_cast(float, u & 0xffff0000u); }
__device__ __forceinline__ float wave_sum(float v) {
#pragma unroll
    for (int o = 1; o < 64; o <<= 1) v += __shfl_xor(v, o);
    return v;
}
__device__ __forceinline__ float wave_max(float v) {
#pragma unroll
    for (int o = 1; o < 64; o <<= 1) v = fmaxf(v, __shfl_xor(v, o));
    return v;
}
__device__ __forceinline__ float sigm(float x) { return 1.0f / (1.0f + __expf(-x)); }
#define LDS_WAIT() asm volatile("s_waitcnt lgkmcnt(0)" ::: "memory")

typedef __attribute__((address_space(1))) unsigned gu32;
#define XB_TMO      128
#define XB_XCNT(j)  (256  + 64 * (j))
#define XB_XSUB(j)  (1280 + 64 * (j))
#define XB_XGEN(j)  (2304 + 64 * (j))
#define XB_TOP      3328
#define XB_TOPGEN   3392
#define XCD_BAR_WORDS 3456
#define XB_SPIN_CAP (1u << 18)

__device__ __forceinline__ unsigned xb_ld(unsigned* p)              { return __hip_atomic_load(p, __ATOMIC_RELAXED, __HIP_MEMORY_SCOPE_AGENT); }
__device__ __forceinline__ unsigned xb_add(unsigned* p, unsigned v) { return __hip_atomic_fetch_add(p, v, __ATOMIC_RELAXED, __HIP_MEMORY_SCOPE_AGENT); }
__device__ __forceinline__ unsigned xb_xcc_id() { return (unsigned)__builtin_amdgcn_s_getreg((3 << 11) | 20) & 0xFu; }
#define XB_SPIN(cond, bar) do { unsigned _sp = 0; while (cond) { __builtin_amdgcn_s_sleep(1); \
    if ((++_sp & 255u) == 0u) { if (xb_ld(&(bar)[XB_TMO])) break; if (_sp > XB_SPIN_CAP) { atomicAdd(&(bar)[XB_TMO], 1u); break; } } } } while (0)

struct XcdBarrier {
    unsigned* bar; unsigned x;
    volatile LAS unsigned* st;
};

__device__ __forceinline__ XcdBarrier xcd_barrier_post(unsigned* bar, volatile LAS unsigned* st) {
    XcdBarrier b; b.bar = bar; b.x = xb_xcc_id(); b.st = st;
    if (threadIdx.x == 0) (void)xb_add(&bar[XB_XCNT(b.x)], 1u);
    return b;
}
__device__ __forceinline__ void xcd_barrier_complete(unsigned* bar, unsigned x, unsigned& nloc, unsigned& nx) {
    const unsigned G = gridDim.x * gridDim.y * gridDim.z;
    unsigned sum, cnt, mine, sp = 0u;
    for (;;) {
        sum = 0u; cnt = 0u; mine = 0u;
#pragma unroll
        for (unsigned j = 0; j < 16; ++j) { const unsigned c = xb_ld(&bar[XB_XCNT(j)]); sum += c; cnt += (c > 0u) ? 1u : 0u; mine = (j == x) ? c : mine; }
        if (sum == G) break;
        __builtin_amdgcn_s_sleep(1);
        if ((++sp & 255u) == 0u) { if (xb_ld(&bar[XB_TMO])) break; if (sp > XB_SPIN_CAP) { atomicAdd(&bar[XB_TMO], 1u); break; } }
    }
    nloc = mine > 0u ? mine : 1u; nx = cnt > 0u ? cnt : 1u;
}

__device__ __forceinline__ void xcd_barrier(const XcdBarrier& b) {
    asm volatile("s_waitcnt vmcnt(0)" ::: "memory");
    __syncthreads();
    if (threadIdx.x == 0) {
        unsigned* bar = b.bar;
        __builtin_amdgcn_s_waitcnt(0);
        unsigned nloc = b.st[0], nx = b.st[1];
        if (nloc == 0u) { xcd_barrier_complete(bar, b.x, nloc, nx); b.st[0] = nloc; b.st[1] = nx; }
        const unsigned old = xb_add(&bar[XB_XSUB(b.x)], 1u);
        const unsigned gen = old / nloc;
        if (old + 1u == (gen + 1u) * nloc) {
            __builtin_amdgcn_fence(__ATOMIC_RELEASE, "agent");
            asm volatile("s_waitcnt vmcnt(0)" ::: "memory");
            const unsigned og = xb_add(&bar[XB_TOP], 1u);
            const unsigned tg = og / nx;
            if (og + 1u == (tg + 1u) * nx) xb_add(&bar[XB_TOPGEN], 1u);
            else XB_SPIN(xb_ld(&bar[XB_TOPGEN]) == tg, bar);
            __builtin_amdgcn_fence(__ATOMIC_ACQUIRE, "agent");
            xb_add(&bar[XB_XGEN(b.x)], 1u);
            asm volatile("s_waitcnt vmcnt(0)" ::: "memory");
        } else {
            XB_SPIN(xb_ld(&bar[XB_XGEN(b.x)]) == gen, bar);
            __builtin_amdgcn_fence(__ATOMIC_ACQUIRE, "agent");
            asm volatile("s_waitcnt vmcnt(0)" ::: "memory");
        }
    }
    __syncthreads();
}

constexpr int MISC_OFF = LDS_BYTES - 64;
struct Ctx { int tid, lane, wave, bid, G, gw, NGW; };
__device__ __forceinline__ unsigned char* wsbase(const Params& P) { const unsigned long long x = (unsigned long long)P.ws; int lo = __builtin_amdgcn_readfirstlane((int)(unsigned)x), hi = __builtin_amdgcn_readfirstlane((int)(unsigned)(x >> 32));
    asm volatile("" : "+s"(lo), "+s"(hi)); return (unsigned char*)(((unsigned long long)(unsigned)hi << 32) | (unsigned)lo); }
__device__ __forceinline__ const float* inp(const Params& P, int i) { int z; asm volatile("s_mov_b32 %0, 0" : "=s"(z)); return P.in[i + z]; }

#ifndef MK_SUBMASK
#define MK_SUBMASK 0
#endif
#define SUBREP(i) for (int sr_ = 0; sr_ < ((((MK_SUBMASK) >> (i)) & 1) ? 2 : 1); ++sr_)
template <class ColMap>
__device__ __forceinline__ void transpose_item(const float* __restrict__ W, int K, int N, bf16* __restrict__ WT, int kb, int jb, int lane, ColMap cm) {
    const int kr = lane >> 4, l16 = lane & 15, k0 = 64 * kb + 16 * kr, j = 64 * jb + 4 * l16;
    const int sc = cm(j);
    f32x4 v[16];
    if (sc >= 0) {
        const float* src = W + (size_t)k0 * N + sc;
#pragma unroll
        for (int q = 0; q < 16; ++q) v[q] = __builtin_nontemporal_load((const f32x4*)(src + (size_t)q * N));
    } else {
#pragma unroll
        for (int q = 0; q < 16; ++q) v[q] = (f32x4){0.f, 0.f, 0.f, 0.f};
    }
#pragma unroll
    for (int e = 0; e < 4; ++e) {
        bf16* dst = WT + (size_t)(j + e) * K + k0;
        v4u o0, o1;
        o0.x = pk2(v[0][e], v[1][e]); o0.y = pk2(v[2][e], v[3][e]); o0.z = pk2(v[4][e], v[5][e]); o0.w = pk2(v[6][e], v[7][e]);
        o1.x = pk2(v[8][e], v[9][e]); o1.y = pk2(v[10][e], v[11][e]); o1.z = pk2(v[12][e], v[13][e]); o1.w = pk2(v[14][e], v[15][e]);
        *(v4u*)dst = o0; *(v4u*)(dst + 8) = o1;
    }
}
struct MapId { __device__ __forceinline__ int operator()(int j) const { return j; } };
struct MapIn {
    __device__ __forceinline__ int operator()(int j) const {
        if (j < 2048) { const int g = j >> 5, q = (j >> 3) & 3, n = (j >> 2) & 1, e = j & 3; return n * 1024 + 16 * g + 4 * q + e; }
        const int jj = j - 2048; return jj < NRC ? 2048 + jj : -1;
    }
};
__device__ __forceinline__ void rms_row_bf16(const float* __restrict__ xrow, const float* __restrict__ g, bf16* __restrict__ orow, int lane) {
    f32x4 v[8]; float s = 0.f;
#pragma unroll
    for (int j = 0; j < 8; ++j) { v[j] = *(const f32x4*)(xrow + 4 * (lane + 64 * j)); s += (v[j][0] * v[j][0] + v[j][1] * v[j][1]) + (v[j][2] * v[j][2] + v[j][3] * v[j][3]); }
    const float r = rsqrtf(wave_sum(s) * (1.0f / 2048.0f) + 1e-6f);
#pragma unroll
    for (int j = 0; j < 8; ++j) { const f32x4 gg = *(const f32x4*)(g + 4 * (lane + 64 * j));
        v2u o; o.x = pk2(v[j][0] * r * gg[0], v[j][1] * r * gg[1]); o.y = pk2(v[j][2] * r * gg[2], v[j][3] * r * gg[3]);
        *(v2u*)(orow + 4 * (lane + 64 * j)) = o; }
}
__device__ __forceinline__ void p0_prologue(const Params& P, const Ctx& C, LAS unsigned char* lds) {
    unsigned char* ws = wsbase(P);
    constexpr int I_IN = 32 * 88, I_SQ = 32 * 32, I_UP = 32 * 176, I_DN = 88 * 32;
    constexpr int NITEMS = I_IN + 5 * I_SQ + I_UP + I_DN;
    SUBREP(6) for (int it = C.gw; it < NITEMS; it += C.NGW) {
        int r = it;
        if (r < I_IN) { transpose_item(inp(P, I_WIN), 2048, 5568, (bf16*)(ws + WS_WIN), r / 88, r % 88, C.lane, MapIn()); continue; } r -= I_IN;
        if (r < I_SQ) { transpose_item(inp(P, I_WK), 2048, 2048, (bf16*)(ws + WS_WKV), r / 32, r % 32, C.lane, MapId()); continue; } r -= I_SQ;
        if (r < I_SQ) { transpose_item(inp(P, I_WV), 2048, 2048, (bf16*)(ws + WS_WKV) + (size_t)2048 * 2048, r / 32, r % 32, C.lane, MapId()); continue; } r -= I_SQ;
        if (r < I_SQ) { transpose_item(inp(P, I_WOUT), 2048, 2048, (bf16*)(ws + WS_WOUT), r / 32, r % 32, C.lane, MapId()); continue; } r -= I_SQ;
        if (r < I_SQ) { transpose_item(inp(P, I_WQ), 2048, 2048, (bf16*)(ws + WS_WQ), r / 32, r % 32, C.lane, MapId()); continue; } r -= I_SQ;
        if (r < I_SQ) { transpose_item(inp(P, I_WO), 2048, 2048, (bf16*)(ws + WS_WO), r / 32, r % 32, C.lane, MapId()); continue; } r -= I_SQ;
        if (r < I_UP) { transpose_item(inp(P, I_WUP), 2048, 11264, (bf16*)(ws + WS_WUP), r / 176, r % 176, C.lane, MapId()); continue; } r -= I_UP;
        transpose_item(inp(P, I_WDOWN), 5632, 2048, (bf16*)(ws + WS_WDN), r / 32, r % 32, C.lane, MapId());
    }
    const int gt = C.bid * NT + C.tid, ngt = C.G * NT;
    {   const float* s_w = inp(P, I_WLORA); const float* s_a = inp(P, I_ALORA); const float* s_g = inp(P, I_GLORA);
        for (int i = gt; i < 1024 * 96; i += ngt) { const int n = i / 96, k = i - n * 96, h = n >> 6, r = n & 63;
            bf16* img = (bf16*)(ws + WS_HIMG + (size_t)h * 65536);
            img[r * 96 + k] = (bf16)f2bf(s_w[k * 1024 + n]); img[6144 + r * 96 + k] = (bf16)f2bf(s_a[k * 1024 + n]); }
        for (int i = gt; i < 1024 * 256; i += ngt) { const int n = i >> 8, k = i & 255, h = n >> 6, r = n & 63;
            bf16* img = (bf16*)(ws + WS_HIMG + (size_t)h * 65536);
            img[12288 + r * 256 + (((k >> 3) ^ (r & 15)) << 3) + (k & 7)] = (bf16)f2bf(s_g[k * 1024 + n]); }
        const float* mu = inp(P, I_MU); const float* kk = inp(P, I_KK); const float* a0 = inp(P, I_A0); const float* w0 = inp(P, I_W0); const float* ka = inp(P, I_KA); const float* rk = inp(P, I_RK);
        for (int i = gt; i < 16 * 512; i += ngt) { const int h = i >> 9, ar = (i >> 6) & 7, j = i & 63;
            const float* bp = ar == 0 ? mu : ar == 1 ? mu + 1024 : ar == 2 ? mu + 2048 : ar == 3 ? kk : ar == 4 ? a0 : ar == 5 ? w0 : ar == 6 ? ka : rk;
            ((float*)(ws + WS_HIMG + (size_t)h * 65536 + 57344))[ar * 64 + j] = bp[h * 64 + j]; }
    }
    SUBREP(7) for (int m = C.gw; m < M + 1024; m += C.NGW) {
        if (m < M) { const float* xr = m < MP ? inp(P, I_XP) + (size_t)m * D : inp(P, I_XS) + (size_t)(m - MP) * D; rms_row_bf16(xr, inp(P, I_NMIXPRE), (bf16*)(ws + WS_HB) + (size_t)m * D, C.lane); }
        else { const int r = m - M; rms_row_bf16(inp(P, I_MEM) + (size_t)r * D, inp(P, I_NMEM), (bf16*)(ws + WS_MB) + (size_t)r * D, C.lane); }
    }
    { bf16* d = (bf16*)(ws + WS_SHB); const float* sp = inp(P, I_SSHIFT);
      for (int i = gt; i < (NBS + 1) * NRCP; i += ngt) { const int b = i / NRCP, c = i - b * NRCP; d[i] = (b < NBS && c < NRC) ? (bf16)f2bf(sp[(size_t)b * NRC + c]) : (bf16)0; } }
    { const f32x4* s = (const f32x4*)inp(P, I_SCONV); f32x4* d = (f32x4*)(P.out + O_CS);
      for (int i = gt; i < NBS * 22 * 256; i += ngt) { const int b = i / (22 * 256), r = i - b * (22 * 256); d[(size_t)b * 30 * 256 + r] = s[(size_t)b * 30 * 256 + 8 * 256 + r]; } }
}

template <int R>
__device__ __forceinline__ void conv_task(const Params& P, const Ctx& C, LAS unsigned char* lds, int grow0  , int t0  , int sb  ) {
    unsigned char* ws = wsbase(P);
    const bf16* glu = (const bf16*)(ws + WS_GLU);
    LAS unsigned* st = (LAS unsigned*)lds;
    LAS float* red = (LAS float*)(lds + 98304);
    constexpr int NR = R + 30;
    const float* sconv = inp(P, I_SCONV); const float* cdw = inp(P, I_CDW);
    for (int p = C.tid; p < NR * 128; p += NT) {
        const int rr = p >> 7, ch = p & 127; const int t = t0 - 30 + rr;
        v4u v = (v4u){0u, 0u, 0u, 0u};
        if (t >= 0) v = *(const v4u*)(glu + (size_t)(grow0 - 30 + rr) * CC + ch * 8);
        else if (sb >= 0) { const float* s = sconv + ((size_t)sb * 30 + rr) * CC + ch * 8;
            const f32x4 a = *(const f32x4*)s, b = *(const f32x4*)(s + 4); v.x = pk2(a[0], a[1]); v.y = pk2(a[2], a[3]); v.z = pk2(b[0], b[1]); v.w = pk2(b[2], b[3]); }
        *(LAS v4u*)(st + rr * 512 + ch * 4) = v;
    }
    const int c = 2 * C.tid;
    f32x2 w[31];
#pragma unroll
    for (int j = 0; j < 31; ++j) w[j] = *(const f32x2*)(cdw + j * CC + c);
    const f32x2 bias = *(const f32x2*)(inp(P, I_CDWB) + c);
    f32x2 acc[R];
#pragma unroll
    for (int r = 0; r < R; ++r) acc[r] = bias;
    __syncthreads();
#pragma unroll
    for (int rr = 0; rr < NR; ++rr) {
        if ((rr & 3) == 0) asm volatile("" ::: "memory");
        const unsigned u = st[rr * 512 + C.tid]; const float x0 = bflo(u), x1 = bfhi(u);
#pragma unroll
        for (int r = 0; r < R; ++r) { const int j = rr - r; if (j >= 0 && j < 31) { acc[r][0] += x0 * w[j][0]; acc[r][1] += x1 * w[j][1]; } }
    }
    float s[R];
#pragma unroll
    for (int r = 0; r < R; ++r) s[r] = wave_sum(acc[r][0] + acc[r][1]);
    if (C.lane == 0) {
#pragma unroll
        for (int r = 0; r < R; ++r) red[C.wave * 16 + r] = s[r]; }
    __syncthreads();
    float mean[R];
#pragma unroll
    for (int r = 0; r < R; ++r) { float t = 0.f;
#pragma unroll
        for (int wv = 0; wv < 8; ++wv) t += red[wv * 16 + r];
        mean[r] = t * (1.0f / 1024.0f); }
    __syncthreads();
#pragma unroll
    for (int r = 0; r < R; ++r) { const float d0 = acc[r][0] - mean[r], d1 = acc[r][1] - mean[r]; acc[r][0] = d0; acc[r][1] = d1; s[r] = wave_sum(d0 * d0 + d1 * d1); }
    if (C.lane == 0) {
#pragma unroll
        for (int r = 0; r < R; ++r) red[C.wave * 16 + r] = s[r]; }
    __syncthreads();
    const f32x2 lg = *(const f32x2*)(inp(P, I_CLNG) + c), lb = *(const f32x2*)(inp(P, I_CLNB) + c);
    bf16* a2 = (bf16*)(ws + WS_A2);
#pragma unroll
    for (int r = 0; r < R; ++r) { float t = 0.f;
#pragma unroll
        for (int wv = 0; wv < 8; ++wv) t += red[wv * 16 + r];
        const float rstd = rsqrtf(t * (1.0f / 1024.0f) + 1e-5f);
        float y0 = acc[r][0] * rstd * lg[0] + lb[0], y1 = acc[r][1] * rstd * lg[1] + lb[1];
        y0 = y0 * sigm(y0); y1 = y1 * sigm(y1);
        *(unsigned*)(a2 + (size_t)(grow0 + r) * D + c) = pk2(y0, y1); }
    __syncthreads();
}

#define XS8(cp_, pp_, mp_, off_, xs_) do { const v4u cu_ = *(const v4u*)((cp_) + (off_)); const v4u pu_ = *(const v4u*)((pp_) + (off_)); \
        const f32x4 m0_ = *(const f32x4*)((mp_) + (off_)), m1_ = *(const f32x4*)((mp_) + (off_) + 4); float c_, p_; \
        c_ = bflo(cu_.x); p_ = bflo(pu_.x); xs_[0] = c_ + (p_ - c_) * m0_[0]; c_ = bfhi(cu_.x); p_ = bfhi(pu_.x); xs_[1] = c_ + (p_ - c_) * m0_[1]; \
        c_ = bflo(cu_.y); p_ = bflo(pu_.y); xs_[2] = c_ + (p_ - c_) * m0_[2]; c_ = bfhi(cu_.y); p_ = bfhi(pu_.y); xs_[3] = c_ + (p_ - c_) * m0_[3]; \
        c_ = bflo(cu_.z); p_ = bflo(pu_.z); xs_[4] = c_ + (p_ - c_) * m1_[0]; c_ = bfhi(cu_.z); p_ = bfhi(pu_.z); xs_[5] = c_ + (p_ - c_) * m1_[1]; \
        c_ = bflo(cu_.w); p_ = bflo(pu_.w); xs_[6] = c_ + (p_ - c_) * m1_[2]; c_ = bfhi(cu_.w); p_ = bfhi(pu_.w); xs_[7] = c_ + (p_ - c_) * m1_[3]; } while (0)
#define XS4(cp_, pp_, mp_, off_, xs_) do { const v2u cu_ = *(const v2u*)((cp_) + (off_)); const v2u pu_ = *(const v2u*)((pp_) + (off_)); const f32x4 m0_ = *(const f32x4*)((mp_) + (off_)); float c_, p_; \
        c_ = bflo(cu_.x); p_ = bflo(pu_.x); xs_[0] = c_ + (p_ - c_) * m0_[0]; c_ = bfhi(cu_.x); p_ = bfhi(pu_.x); xs_[1] = c_ + (p_ - c_) * m0_[1]; \
        c_ = bflo(cu_.y); p_ = bflo(pu_.y); xs_[2] = c_ + (p_ - c_) * m0_[2]; c_ = bfhi(cu_.y); p_ = bfhi(pu_.y); xs_[3] = c_ + (p_ - c_) * m0_[3]; } while (0)
__device__ __forceinline__ bf16x8 pack8(const float (&x)[8]) {
    v4u o; o.x = pk2(x[0], x[1]); o.y = pk2(x[2], x[3]); o.z = pk2(x[4], x[5]); o.w = pk2(x[6], x[7]);
    return __builtin_bit_cast(bf16x8, o);
}
__device__ __forceinline__ float tanh_fast(float x) { return 1.0f - 2.0f / (1.0f + __expf(2.0f * x)); }
constexpr int PBUF = 65536;
__device__ __forceinline__ void mix4(const v2u cu, const v2u pu, const f32x4 m, float (&xs)[4]) {
    float c_, p_;
    c_ = bflo(cu.x); p_ = bflo(pu.x); xs[0] = c_ + (p_ - c_) * m[0]; c_ = bfhi(cu.x); p_ = bfhi(pu.x); xs[1] = c_ + (p_ - c_) * m[1];
    c_ = bflo(cu.y); p_ = bflo(pu.y); xs[2] = c_ + (p_ - c_) * m[2]; c_ = bfhi(cu.y); p_ = bfhi(pu.y); xs[3] = c_ + (p_ - c_) * m[3];
}
template <int NH>
__device__ __forceinline__ void prep_task(const Params& P, const Ctx& C, LAS unsigned char* lds, int rowblock, int hbase) {
    const int lane = C.lane, fr = lane & 15, fq = lane >> 4, row = rowblock * 128 + C.wave * 16 + fr;
    unsigned char* ws = wsbase(P);
    const bf16* curp = (const bf16*)(ws + WS_PR) + (size_t)row * NRCP;
    const bf16* prvp = curp - NRCP;
    if (row < MP) { if ((row & (SEQ - 1)) == 0) prvp = (const bf16*)(ws + WS_SHB) + (size_t)NBS * NRCP; }
    else { const int rs = row - MP; if ((rs & 7) == 0) prvp = (const bf16*)(ws + WS_SHB) + (size_t)(rs >> 3) * NRCP; }
    const float* mup = inp(P, I_MU);
    const unsigned char* himg = ws + WS_HIMG;
#define PREP_STAGE(h_, b_) do { int ll = lane; asm volatile("" : "+v"(ll)); _Pragma("unroll") for (int q = 0; q < 8; ++q) { const int i = C.wave + 8 * q; \
        __builtin_amdgcn_global_load_lds((const unsigned*)(himg + (size_t)(h_) * PBUF + i * 1024 + ll * 16), (LAS unsigned*)(lds + (b_) * PBUF + i * 1024), 16, 0, 0); } } while (0)
    PREP_STAGE(hbase, 0);
    const int c00 = hbase * 64 + 4 * fq;
    const bf16* c4 = curp + c00; const bf16* p4 = prvp + c00;
    v2u cu[3][4], pu[3][4];
#pragma unroll
    for (int x = 0; x < 3; ++x)
#pragma unroll
        for (int nt = 0; nt < 4; ++nt) { cu[x][nt] = *(const v2u*)(c4 + 1024 * x + 16 * nt); pu[x][nt] = *(const v2u*)(p4 + 1024 * x + 16 * nt); }
    bf16x8 Aw[3], Aa[3], Ag[8];
    {   const bf16* c8 = curp + 3072 + 8 * fq; const bf16* p8 = prvp + 3072 + 8 * fq; const float* m8 = mup + 3072 + 8 * fq;
#pragma unroll
        for (int s = 0; s < 3; ++s) { float xs[8]; XS8(c8, p8, m8, 32 * s, xs);
#pragma unroll
            for (int e = 0; e < 8; ++e) xs[e] = tanh_fast(xs[e]);
            Aw[s] = pack8(xs); }
#pragma unroll
        for (int s = 0; s < 3; ++s) { float xs[8]; XS8(c8, p8, m8, 96 + 32 * s, xs); Aa[s] = pack8(xs); }
        asm volatile("" ::: "memory");
#pragma unroll
        for (int s = 0; s < 8; ++s) { if (s == 4) asm volatile("" ::: "memory");
            float xs[8]; XS8(c8, p8, m8, 192 + 32 * s, xs);
#pragma unroll
            for (int e = 0; e < 8; ++e) xs[e] = sigm(xs[e]);
            Ag[s] = pack8(xs); }
    }
    asm volatile("s_waitcnt vmcnt(0)" ::: "memory");
    __syncthreads();
    constexpr size_t SS = SB_STRIDE / 2;
    const f32x4 z4 = (f32x4){0.f, 0.f, 0.f, 0.f};
    bf16* sb = (bf16*)(ws + WS_SI) + (size_t)row * RW + c00; float* sw = (float*)(ws + WS_SW) + (size_t)row * RW + c00; bf16* gb = (bf16*)(ws + WS_G) + (size_t)row * RW + c00;
    float* bonp = (float*)(ws + WS_BON) + (size_t)row * RH + hbase;
    const int lwo = fr * 192 + fq * 16, lgo = 24576 + fr * 512, lpo = 57344 + fq * 16;
#pragma unroll 1
    for (int hh = 0; hh < NH; ++hh) {
        if (hh + 1 < NH) PREP_STAGE(hbase + hh + 1, (hh + 1) & 1);
        const LAS unsigned char* wb = lds + (hh & 1) * PBUF;
        float ss = 0.f;
#pragma unroll
        for (int nt = 0; nt < 4; ++nt) {
            float xk0[4]; mix4(cu[1][nt], pu[1][nt], *(const LAS f32x4*)(wb + lpo + 1 * 256 + nt * 64), xk0);
            const f32x4 kkw = *(const LAS f32x4*)(wb + lpo + 3 * 256 + nt * 64);
#pragma unroll
            for (int e = 0; e < 4; ++e) { const float t = xk0[e] * kkw[e]; ss += t * t; }
        }
        ss += __shfl_xor(ss, 16); ss += __shfl_xor(ss, 32);
        const float inv = 1.0f / fmaxf(sqrtf(ss), 1e-12f);
        float bon = 0.f;
#pragma unroll
        for (int nt = 0; nt < 4; ++nt) {
            f32x4 accW = z4, accA = z4, accG = z4;
#pragma unroll
            for (int s = 0; s < 3; ++s) { const bf16x8 bw = *(const LAS bf16x8*)(wb + lwo + nt * 3072 + s * 64), ba = *(const LAS bf16x8*)(wb + 12288 + lwo + nt * 3072 + s * 64);
                accW = __builtin_amdgcn_mfma_f32_16x16x32_bf16(bw, Aw[s], accW, 0, 0, 0); accA = __builtin_amdgcn_mfma_f32_16x16x32_bf16(ba, Aa[s], accA, 0, 0, 0); }
#pragma unroll
            for (int s = 0; s < 8; ++s) { const bf16x8 bg = *(const LAS bf16x8*)(wb + lgo + nt * 8192 + (((4 * s + fq) ^ fr) * 16)); accG = __builtin_amdgcn_mfma_f32_16x16x32_bf16(bg, Ag[s], accG, 0, 0, 0); }
            float xr[4], xv[4], xkk[4];
            mix4(cu[0][nt], pu[0][nt], *(const LAS f32x4*)(wb + lpo + 0 * 256 + nt * 64), xr);
            mix4(cu[1][nt], pu[1][nt], *(const LAS f32x4*)(wb + lpo + 1 * 256 + nt * 64), xkk);
            mix4(cu[2][nt], pu[2][nt], *(const LAS f32x4*)(wb + lpo + 2 * 256 + nt * 64), xv);
            const f32x4 kkw = *(const LAS f32x4*)(wb + lpo + 3 * 256 + nt * 64), a0 = *(const LAS f32x4*)(wb + lpo + 4 * 256 + nt * 64), w0 = *(const LAS f32x4*)(wb + lpo + 5 * 256 + nt * 64);
            const f32x4 ka = *(const LAS f32x4*)(wb + lpo + 6 * 256 + nt * 64), rk = *(const LAS f32x4*)(wb + lpo + 7 * 256 + nt * 64);
            f32x4 vw; float vk[4], va[4], vb[4];
#pragma unroll
            for (int e = 0; e < 4; ++e) {
                const float ee = 0.6065306597126334f * sigm(w0[e] + accW[e]);
                vw[e] = __expf(-ee);
                const float a = sigm(a0[e] + accA[e]);
                const float kn = xkk[e] * kkw[e] * inv;
                const float k2 = xkk[e] * (1.0f + (a - 1.0f) * ka[e]);
                vk[e] = k2; va[e] = -kn; vb[e] = kn * a;
                bon += xr[e] * k2 * rk[e];
            }
            bf16* so = sb + 16 * nt;
            *(v2u*)(so + 0 * SS) = (v2u){pk2(xr[0], xr[1]), pk2(xr[2], xr[3])};
            *(v2u*)(so + 1 * SS) = (v2u){pk2(vk[0], vk[1]), pk2(vk[2], vk[3])};
            *(v2u*)(so + 2 * SS) = (v2u){pk2(xv[0], xv[1]), pk2(xv[2], xv[3])};
            *(v2u*)(so + 3 * SS) = (v2u){pk2(va[0], va[1]), pk2(va[2], va[3])};
            *(v2u*)(so + 4 * SS) = (v2u){pk2(vb[0], vb[1]), pk2(vb[2], vb[3])};
            *(f32x4*)(sw + 16 * nt) = vw;
            *(v2u*)(gb + 16 * nt) = (v2u){pk2(accG[0], accG[1]), pk2(accG[2], accG[3])};
        }
        bon += __shfl_xor(bon, 16); bon += __shfl_xor(bon, 32);
        if (fq == 0) bonp[hh] = bon;
        sb += 64; sw += 64; gb += 64;
        if (hh + 1 < NH) { c4 += 64; p4 += 64;
#pragma unroll
            for (int x = 0; x < 3; ++x)
#pragma unroll
                for (int nt = 0; nt < 4; ++nt) { cu[x][nt] = *(const v2u*)(c4 + 1024 * x + 16 * nt); pu[x][nt] = *(const v2u*)(p4 + 1024 * x + 16 * nt); } }
        asm volatile("s_waitcnt vmcnt(0)" ::: "memory");
        __syncthreads();
    }
#undef PREP_STAGE
}

constexpr int TC = 32, STEPF = 5 * 64 + 16, STEPQ = STEPF / 4, CHUNKQ = TC * STEPQ;
template <int CTRL> __device__ __forceinline__ float dppf(float x) { return __builtin_bit_cast(float, __builtin_amdgcn_update_dpp(0, __builtin_bit_cast(int, x), CTRL, 0xF, 0xF, true)); }
__device__ __forceinline__ float allred16(float x) {
    x += dppf<0xB1>(x);
    x += dppf<0x4E>(x);
    x += dppf<0x141>(x);
    x += dppf<0x140>(x);
    return x;
}
#define SCAN_BAR() do { asm volatile("s_waitcnt lgkmcnt(0)" ::: "memory"); __builtin_amdgcn_s_barrier(); asm volatile("" ::: "memory"); } while (0)
#define SCAN_STEP(S01, S23, r4, w4, k4, a4, b4, v, yout) do { \
        f32x2 p2 = S01 * (f32x2){a4[0], a4[1]}; p2 = S23 * (f32x2){a4[2], a4[3]} + p2; \
        const float sa = allred16(p2[0] + p2[1]); const f32x2 sa2 = (f32x2){sa, sa}, v2 = (f32x2){v, v}; \
        f32x2 t01 = v2 * (f32x2){k4[0], k4[1]}, t23 = v2 * (f32x2){k4[2], k4[3]}; \
        t01 = sa2 * (f32x2){b4[0], b4[1]} + t01; t23 = sa2 * (f32x2){b4[2], b4[3]} + t23; \
        S01 = S01 * (f32x2){w4[0], w4[1]} + t01; S23 = S23 * (f32x2){w4[2], w4[3]} + t23; \
        f32x2 q2 = S01 * (f32x2){r4[0], r4[1]}; q2 = S23 * (f32x2){r4[2], r4[3]} + q2; \
        yout = allred16(q2[0] + q2[1]); } while (0)
__device__ __forceinline__ void scan_prompt(const Params& P, const Ctx& C, LAS unsigned char* lds, int chain, int rb) {
    unsigned char* ws = wsbase(P);
    const int b = chain >> 4, h = chain & 15, m0 = b * SEQ;
    LAS float* buf = (LAS float*)lds;
    constexpr int NCH = SEQ / TC;
    if (C.wave >= 4) {
        const int ht = C.tid - 256;
        const bf16* SB = (const bf16*)(ws + WS_SI); constexpr size_t SBS = SB_STRIDE / 2; const float* SW = (const float*)(ws + WS_SW);
        v4u stg[7];
#define SCAN_HLOAD(ck_) do { int htl = ht; asm volatile("" : "+v"(htl)); _Pragma("unroll") for (int q = 0; q < 7; ++q) { const int ip = htl + q * 256; if (ip < TC * 50) { const int t = ip / 50, p = ip - t * 50; \
            const size_t rowo = (size_t)(m0 + (ck_) * TC + t) * RW + h * 64; const void* src; \
            if (p < 32) { const int g = p >> 3; const int arr = g == 0 ? 0 : g == 1 ? 1 : g == 2 ? 3 : 4; src = SB + arr * SBS + rowo + 8 * (p & 7); } \
            else if (p < 34) src = SB + 2 * SBS + rowo + rb * 16 + 8 * (p - 32); \
            else src = SW + rowo + 4 * (p - 34); \
            stg[q] = *(const v4u*)src; } } } while (0)
#define SCAN_HWRITE(ck_) do { int htl = ht; asm volatile("" : "+v"(htl)); LAS float* dbase = buf + ((ck_) & 1) * (TC * STEPF); _Pragma("unroll") for (int q = 0; q < 7; ++q) { const int ip = htl + q * 256; if (ip < TC * 50) { const int t = ip / 50, p = ip - t * 50; \
            LAS float* d = dbase + t * STEPF; \
            if (p >= 34) *(LAS v4u*)(d + 64 + 4 * (p - 34)) = stg[q]; \
            else { const int g = p >> 3; const int off = p < 32 ? (g == 0 ? 0 : g == 1 ? 128 : g == 2 ? 192 : 256) + 8 * (p & 7) : 320 + 8 * (p - 32); \
                const v4u u = stg[q]; \
                *(LAS v4u*)(d + off) = (v4u){u.x << 16, u.x & 0xffff0000u, u.y << 16, u.y & 0xffff0000u}; \
                *(LAS v4u*)(d + off + 4) = (v4u){u.z << 16, u.z & 0xffff0000u, u.w << 16, u.w & 0xffff0000u}; } } } } while (0)
        SCAN_HLOAD(0); SCAN_HWRITE(0); SCAN_HLOAD(1);
        SCAN_BAR();
        for (int ck = 0; ck < NCH; ++ck) {
            if (ck + 1 < NCH) SCAN_HWRITE(ck + 1);
            if (ck + 2 < NCH) SCAN_HLOAD(ck + 2);
            SCAN_BAR();
        }
#undef SCAN_HLOAD
#undef SCAN_HWRITE
    } else {
        float* Y = (float*)(ws + WS_Y);
        const int rowl = C.lane >> 4, cl = C.lane & 15, irow = rb * 16 + C.wave * 4 + rowl;
        f32x2 S01 = (f32x2){0.f, 0.f}, S23 = (f32x2){0.f, 0.f};
        float yk = 0.f;
        SCAN_BAR();
        for (int ck = 0; ck < NCH; ++ck) {
            const LAS float* cb = buf + (ck & 1) * (TC * STEPF);
            f32x4 r4 = *(const LAS f32x4*)(cb + 0 * 64 + 4 * cl), w4 = *(const LAS f32x4*)(cb + 1 * 64 + 4 * cl), k4 = *(const LAS f32x4*)(cb + 2 * 64 + 4 * cl);
            f32x4 a4 = *(const LAS f32x4*)(cb + 3 * 64 + 4 * cl), b4 = *(const LAS f32x4*)(cb + 4 * 64 + 4 * cl); float v = cb[320 + C.wave * 4 + rowl];
#pragma unroll 4
            for (int t = 0; t < TC; ++t) {
                const LAS float* nb = cb + (t + 1 < TC ? t + 1 : t) * STEPF;
                const f32x4 nr = *(const LAS f32x4*)(nb + 0 * 64 + 4 * cl), nw = *(const LAS f32x4*)(nb + 1 * 64 + 4 * cl), nk = *(const LAS f32x4*)(nb + 2 * 64 + 4 * cl);
                const f32x4 na = *(const LAS f32x4*)(nb + 3 * 64 + 4 * cl), nbb = *(const LAS f32x4*)(nb + 4 * 64 + 4 * cl); const float nv = nb[320 + C.wave * 4 + rowl];
                float y; SCAN_STEP(S01, S23, r4, w4, k4, a4, b4, v, y);
                yk = (cl == (t & 15)) ? y : yk;
                if ((t & 15) == 15) Y[(size_t)(m0 + ck * TC + (t & ~15) + cl) * RW + h * 64 + irow] = yk;
                r4 = nr; w4 = nw; k4 = nk; a4 = na; b4 = nbb; v = nv;
            }
            SCAN_BAR();
        }
        float* so = P.out + O_WP + ((size_t)chain * 64 + irow) * 64 + 4 * cl;
        *(f32x4*)so = (f32x4){S01[0], S01[1], S23[0], S23[1]};
    }
    __syncthreads();
}
__device__ __forceinline__ f32x4 ld_bf4(const bf16* p) { const v2u u = *(const v2u*)p; return (f32x4){bflo(u.x), bfhi(u.x), bflo(u.y), bfhi(u.y)}; }
__device__ __forceinline__ void scan_sample(const Params& P, const Ctx& C, const float* swkv, int chain, int half) {
    unsigned char* ws = wsbase(P);
    const int b = chain >> 4, h = chain & 15, m0 = MP + 8 * b;
    const bf16* ub = (const bf16*)(ws + WS_SI) + (size_t)m0 * RW + h * 64; constexpr size_t SBS = SB_STRIDE / 2;
    const float* uw = (const float*)(ws + WS_SW) + (size_t)m0 * RW + h * 64;
    float* Y = (float*)(ws + WS_Y);
    const int rowl = C.lane >> 4, cl = C.lane & 15, irow = half * 32 + C.wave * 4 + rowl, lo = 4 * cl;
    const f32x4 s4 = *(const f32x4*)(swkv + ((size_t)chain * 64 + irow) * 64 + 4 * cl);
    f32x2 S01 = (f32x2){s4[0], s4[1]}, S23 = (f32x2){s4[2], s4[3]};
    float yk = 0.f;
#pragma unroll 2
    for (int t = 0; t < 8; ++t) {
        const bf16* ut = ub + t * RW;
        const f32x4 r4 = ld_bf4(ut + 0 * SBS + lo), k4 = ld_bf4(ut + 1 * SBS + lo), a4 = ld_bf4(ut + 3 * SBS + lo), b4 = ld_bf4(ut + 4 * SBS + lo);
        const f32x4 w4 = *(const f32x4*)(uw + t * RW + lo); const float v = bflo((unsigned)(ut + 2 * SBS)[irow]);
        float y; SCAN_STEP(S01, S23, r4, w4, k4, a4, b4, v, y);
        yk = (cl == t) ? y : yk;
    }
    if (cl < 8) Y[(size_t)(m0 + cl) * RW + h * 64 + irow] = yk;
    *(f32x4*)(P.out + O_WS + ((size_t)chain * 64 + irow) * 64 + 4 * cl) = (f32x4){S01[0], S01[1], S23[0], S23[1]};
}

__device__ __forceinline__ void post_row(const Params& P, int row, int lane) {
    unsigned char* ws = wsbase(P);
    const float* Y = (const float*)(ws + WS_Y) + (size_t)row * RW + 16 * lane;
    const bf16* V = (const bf16*)(ws + WS_SI) + 2 * (SB_STRIDE / 2) + (size_t)row * RW + 16 * lane;
    const bf16* G = (const bf16*)(ws + WS_G) + (size_t)row * RW + 16 * lane;
    const float bon = ((const float*)(ws + WS_BON))[(size_t)row * RH + (lane >> 2)];
    float y[16], s = 0.f;
#pragma unroll
    for (int q = 0; q < 4; ++q) { const f32x4 t = *(const f32x4*)(Y + 4 * q); y[4 * q] = t[0]; y[4 * q + 1] = t[1]; y[4 * q + 2] = t[2]; y[4 * q + 3] = t[3]; s += (t[0] + t[1]) + (t[2] + t[3]); }
    s += __shfl_xor(s, 1); s += __shfl_xor(s, 2);
    const float mu = s * (1.0f / 64.0f); float q2 = 0.f;
#pragma unroll
    for (int e = 0; e < 16; ++e) { y[e] -= mu; q2 += y[e] * y[e]; }
    q2 += __shfl_xor(q2, 1); q2 += __shfl_xor(q2, 2);
    const float rstd = rsqrtf(q2 * (1.0f / 64.0f) + 64e-5f);
    const float* lg = inp(P, I_LNXG) + 16 * lane; const float* lb = inp(P, I_LNXB) + 16 * lane;
    unsigned o[8];
#pragma unroll
    for (int q = 0; q < 4; ++q) { const f32x4 g4 = *(const f32x4*)(lg + 4 * q), b4 = *(const f32x4*)(lb + 4 * q), v4 = ld_bf4(V + 4 * q), gg = ld_bf4(G + 4 * q);
        float r[4];
#pragma unroll
        for (int e = 0; e < 4; ++e) r[e] = (y[4 * q + e] * rstd * g4[e] + b4[e] + bon * v4[e]) * gg[e];
        o[2 * q] = pk2(r[0], r[1]); o[2 * q + 1] = pk2(r[2], r[3]); }
    bf16* dst = (bf16*)(ws + WS_A2) + (size_t)row * D + 1024 + 16 * lane;
    *(v4u*)dst = (v4u){o[0], o[1], o[2], o[3]}; *(v4u*)(dst + 8) = (v4u){o[4], o[5], o[6], o[7]};
}

__device__ __forceinline__ void rowpass(const float* xa, const float* __restrict__ mix, int nslab, const float* __restrict__ g1, float* xo,
                                        const float* __restrict__ g2, bf16* __restrict__ hb, int lane) {
    f32x4 mv[8]; float s = 0.f;
#pragma unroll
    for (int j = 0; j < 8; ++j) { mv[j] = *(const f32x4*)(mix + 4 * (lane + 64 * j));
        for (int sl = 1; sl < nslab; ++sl) mv[j] += *(const f32x4*)(mix + sl * SLAB_F + 4 * (lane + 64 * j));
        s += (mv[j][0] * mv[j][0] + mv[j][1] * mv[j][1]) + (mv[j][2] * mv[j][2] + mv[j][3] * mv[j][3]); }
    const float r = rsqrtf(wave_sum(s) * (1.0f / 2048.0f) + 1e-6f);
    float s2 = 0.f;
#pragma unroll
    for (int j = 0; j < 8; ++j) { const f32x4 a = *(const f32x4*)(xa + 4 * (lane + 64 * j)), gg = *(const f32x4*)(g1 + 4 * (lane + 64 * j));
        mv[j] = a + mv[j] * r * gg; *(f32x4*)(xo + 4 * (lane + 64 * j)) = mv[j];
        s2 += (mv[j][0] * mv[j][0] + mv[j][1] * mv[j][1]) + (mv[j][2] * mv[j][2] + mv[j][3] * mv[j][3]); }
    if (hb) {
        const float r2 = rsqrtf(wave_sum(s2) * (1.0f / 2048.0f) + 1e-6f);
#pragma unroll
        for (int j = 0; j < 8; ++j) { const f32x4 gg = *(const f32x4*)(g2 + 4 * (lane + 64 * j));
            v2u o; o.x = pk2(mv[j][0] * r2 * gg[0], mv[j][1] * r2 * gg[1]); o.y = pk2(mv[j][2] * r2 * gg[2], mv[j][3] * r2 * gg[3]);
            *(v2u*)(hb + 4 * (lane + 64 * j)) = o; }
    }
}
__device__ __forceinline__ void attn_prompt_task(const Params& P, const Ctx& C, LAS unsigned char* lds, int b, int h, int qt) {
    unsigned char* ws = wsbase(P);
    const bf16* Qg = (const bf16*)(ws + WS_Q); const bf16* Kg = (const bf16*)(ws + WS_KB); const bf16* VTg = (const bf16*)(ws + WS_VT);
    bf16* Og = (bf16*)(ws + WS_O);
    const int fr = C.lane & 15, fq = C.lane >> 4;
    const int qrow = b * SEQ + qt * 128 + C.wave * 16 + fr;
    constexpr int BUFB = 33792;
    bf16x8 Qf[16];
#pragma unroll
    for (int s = 0; s < 16; ++s) Qf[s] = *(const bf16x8*)(Qg + (size_t)qrow * D + h * XD + 32 * s + 8 * fq);
    f32x4 accS[16];
#pragma unroll
    for (int nt = 0; nt < 16; ++nt) accS[nt] = (f32x4){0.f, 0.f, 0.f, 0.f};
    v4u stg[4];
#define ATT_GLOAD(c_) do { if ((c_) < 8) { _Pragma("unroll") for (int i = 0; i < 4; ++i) { const int idx = C.tid + i * NT, key = idx >> 3, ch = idx & 7; \
            stg[i] = *(const v4u*)(Kg + (size_t)(b * NMEM + key) * D + h * XD + (c_) * 64 + ch * 8); } } \
        else { _Pragma("unroll") for (int i = 0; i < 4; ++i) { const int idx = C.tid + i * NT, dd = idx >> 5, ch = idx & 31; \
            stg[i] = *(const v4u*)(VTg + ((size_t)((b * XH + h) * XD + ((c_) - 8) * 64 + dd)) * NMEM + ch * 8); } } } while (0)
#define ATT_SWRITE(c_) do { LAS unsigned char* sbuf = lds + ((c_) & 1) * BUFB; if ((c_) < 8) { _Pragma("unroll") for (int i = 0; i < 4; ++i) { const int idx = C.tid + i * NT, key = idx >> 3, ch = idx & 7; \
            *(LAS v4u*)(sbuf + key * 128 + ((ch ^ (key & 7)) * 16)) = stg[i]; } } \
        else { _Pragma("unroll") for (int i = 0; i < 4; ++i) { const int idx = C.tid + i * NT, dd = idx >> 5, ch = idx & 31; \
            *(LAS v4u*)(sbuf + dd * 528 + ch * 16) = stg[i]; } } } while (0)
    ATT_GLOAD(0); ATT_SWRITE(0); __syncthreads();
    bf16x8 Pf[8];
#pragma unroll
    for (int c = 0; c < 8; ++c) {
        ATT_GLOAD(c + 1);
        const LAS unsigned char* sbuf = lds + (c & 1) * BUFB;
#pragma unroll
        for (int ss = 0; ss < 2; ++ss)
#pragma unroll
            for (int nt = 0; nt < 16; ++nt) {
                const int key = 16 * nt + fr, ch = ss * 4 + fq;
                const bf16x8 kf = *(const LAS bf16x8*)(sbuf + key * 128 + ((ch ^ (key & 7)) * 16));
                accS[nt] = __builtin_amdgcn_mfma_f32_16x16x32_bf16(kf, Qf[2 * c + ss], accS[nt], 0, 0, 0);
            }
        if (c == 7) {
            float mx = -3.0e38f;
#pragma unroll
            for (int nt = 0; nt < 16; ++nt) mx = fmaxf(mx, fmaxf(fmaxf(accS[nt][0], accS[nt][1]), fmaxf(accS[nt][2], accS[nt][3])));
            mx = fmaxf(mx, __shfl_xor(mx, 16)); mx = fmaxf(mx, __shfl_xor(mx, 32));
            float sum = 0.f;
#pragma unroll
            for (int nt = 0; nt < 16; ++nt) {
#pragma unroll
                for (int e = 0; e < 4; ++e) { const float p = exp2f(accS[nt][e] - mx); accS[nt][e] = p; sum += p; } }
            sum += __shfl_xor(sum, 16); sum += __shfl_xor(sum, 32);
            const float inv = 1.0f / sum;
#pragma unroll
            for (int s = 0; s < 8; ++s) { v4u o; o.x = pk2(accS[2 * s][0] * inv, accS[2 * s][1] * inv); o.y = pk2(accS[2 * s][2] * inv, accS[2 * s][3] * inv);
                o.z = pk2(accS[2 * s + 1][0] * inv, accS[2 * s + 1][1] * inv); o.w = pk2(accS[2 * s + 1][2] * inv, accS[2 * s + 1][3] * inv); Pf[s] = __builtin_bit_cast(bf16x8, o); }
        }
        ATT_SWRITE(c + 1);
        __syncthreads();
    }
    for (int c = 8; c < 16; ++c) {
        if (c + 1 < 16) ATT_GLOAD(c + 1);
        const LAS unsigned char* sbuf = lds + (c & 1) * BUFB;
        const int dv = c - 8;
        f32x4 accO[4];
#pragma unroll
        for (int nd = 0; nd < 4; ++nd) accO[nd] = (f32x4){0.f, 0.f, 0.f, 0.f};
#pragma unroll
        for (int s = 0; s < 8; ++s)
#pragma unroll
            for (int nd = 0; nd < 4; ++nd) {
                const LAS unsigned char* rp = sbuf + (nd * 16 + fr) * 528 + (32 * s + 4 * fq) * 2;
                const v2u lo = *(const LAS v2u*)rp, hi = *(const LAS v2u*)(rp + 32);
                const bf16x8 vf = __builtin_bit_cast(bf16x8, ((v4u){lo.x, lo.y, hi.x, hi.y}));
                accO[nd] = __builtin_amdgcn_mfma_f32_16x16x32_bf16(vf, Pf[s], accO[nd], 0, 0, 0);
            }
#pragma unroll
        for (int nd = 0; nd < 4; ++nd) { v2u o; o.x = pk2(accO[nd][0], accO[nd][1]); o.y = pk2(accO[nd][2], accO[nd][3]);
            *(v2u*)(Og + (size_t)qrow * D + h * XD + dv * 64 + nd * 16 + 4 * fq) = o; }
        if (c + 1 < 16) ATT_SWRITE(c + 1);
        __syncthreads();
    }
#undef ATT_GLOAD
#undef ATT_SWRITE
}
__device__ __forceinline__ void attn_sample_task(const Params& P, const Ctx& C, LAS unsigned char* lds, int b, int h) {
    unsigned char* ws = wsbase(P);
    bf16* Og = (bf16*)(ws + WS_O);
    const float* CK = inp(P, I_CK); const float* CV = inp(P, I_CV);
    LAS float* sS = (LAS float*)lds;
    LAS float* sP = (LAS float*)(lds + 8192);
    const int row0 = MP + 8 * b;
    float qv[8][8];
#pragma unroll
    for (int q = 0; q < 8; ++q) { const float* qp = (const float*)(ws + WS_SLAB) + (size_t)(8 * b + q) * D + h * XD;
        f32x4 a = *(const f32x4*)(qp + 4 * C.lane), c2 = *(const f32x4*)(qp + 256 + 4 * C.lane);
        for (int sl = 1; sl < 8; ++sl) { a += *(const f32x4*)(qp + sl * SLAB_F + 4 * C.lane); c2 += *(const f32x4*)(qp + sl * SLAB_F + 256 + 4 * C.lane); }
        a *= 0.06375871479f; c2 *= 0.06375871479f;
        qv[q][0] = a[0]; qv[q][1] = a[1]; qv[q][2] = a[2]; qv[q][3] = a[3]; qv[q][4] = c2[0]; qv[q][5] = c2[1]; qv[q][6] = c2[2]; qv[q][7] = c2[3]; }
    for (int k0 = 0; k0 < 32; k0 += 4) {
        f32x4 ka[4], kb2[4];
#pragma unroll
        for (int u = 0; u < 4; ++u) { const float* kp = CK + ((size_t)(b * NMEM + C.wave * 32 + k0 + u) * XH + h) * XD; ka[u] = *(const f32x4*)(kp + 4 * C.lane); kb2[u] = *(const f32x4*)(kp + 256 + 4 * C.lane); }
#pragma unroll
        for (int u = 0; u < 4; ++u) {
            float part[8];
#pragma unroll
            for (int q = 0; q < 8; ++q) part[q] = (qv[q][0] * ka[u][0] + qv[q][1] * ka[u][1]) + (qv[q][2] * ka[u][2] + qv[q][3] * ka[u][3]) + (qv[q][4] * kb2[u][0] + qv[q][5] * kb2[u][1]) + (qv[q][6] * kb2[u][2] + qv[q][7] * kb2[u][3]);
#pragma unroll
            for (int q = 0; q < 8; ++q) part[q] = wave_sum(part[q]);
            if (C.lane == 0) {
#pragma unroll
                for (int q = 0; q < 8; ++q) sS[q * 256 + C.wave * 32 + k0 + u] = part[q]; }
        }
    }
    __syncthreads();
    {
        const int q = C.wave; const f32x4 s4 = *(const LAS f32x4*)(sS + q * 256 + 4 * C.lane);
        const float mx = wave_max(fmaxf(fmaxf(s4[0], s4[1]), fmaxf(s4[2], s4[3])));
        const float p0 = exp2f(s4[0] - mx), p1 = exp2f(s4[1] - mx), p2 = exp2f(s4[2] - mx), p3 = exp2f(s4[3] - mx);
        const float inv = 1.0f / wave_sum((p0 + p1) + (p2 + p3));
        sP[(4 * C.lane + 0) * 8 + q] = p0 * inv; sP[(4 * C.lane + 1) * 8 + q] = p1 * inv; sP[(4 * C.lane + 2) * 8 + q] = p2 * inv; sP[(4 * C.lane + 3) * 8 + q] = p3 * inv;
    }
    __syncthreads();
    float acc[8];
#pragma unroll
    for (int q = 0; q < 8; ++q) acc[q] = 0.f;
    const int d = C.wave * 64 + C.lane;
    for (int k0 = 0; k0 < 256; k0 += 8) {
        float vv[8];
#pragma unroll
        for (int u = 0; u < 8; ++u) vv[u] = CV[((size_t)(b * NMEM + k0 + u) * XH + h) * XD + d];
#pragma unroll
        for (int u = 0; u < 8; ++u) { const f32x4 pa = *(const LAS f32x4*)(sP + (k0 + u) * 8), pb = *(const LAS f32x4*)(sP + (k0 + u) * 8 + 4);
            acc[0] += pa[0] * vv[u]; acc[1] += pa[1] * vv[u]; acc[2] += pa[2] * vv[u]; acc[3] += pa[3] * vv[u];
            acc[4] += pb[0] * vv[u]; acc[5] += pb[1] * vv[u]; acc[6] += pb[2] * vv[u]; acc[7] += pb[3] * vv[u]; }
    }
#pragma unroll
    for (int q = 0; q < 8; ++q) Og[(size_t)(row0 + q) * D + h * XD + d] = (bf16)f2bf(acc[q]);
    __syncthreads();
}

__device__ __forceinline__ void unpack8(const v4u u, float (&x)[8]) { x[0] = bflo(u.x); x[1] = bfhi(u.x); x[2] = bflo(u.y); x[3] = bfhi(u.y); x[4] = bflo(u.z); x[5] = bfhi(u.z); x[6] = bflo(u.w); x[7] = bfhi(u.w); }
__device__ __forceinline__ void ffn_conv_act(const Params& P, const Ctx& C) {
    unsigned char* ws = wsbase(P);
    const bf16* UP = (const bf16*)(ws + WS_UP); bf16* ACT = (bf16*)(ws + WS_ACT);
    const float* FW = inp(P, I_FDW); const float* FB = inp(P, I_FDWB); const float* SF = inp(P, I_SFFN);
    constexpr int NG = DFF / 8;
    constexpr int NRUN = 256 + 128;
    for (int it = C.bid * NT + C.tid; it < NRUN * NG; it += C.G * NT) {
        const int run = it / NG, c = (it - run * NG) * 8;
        int row0, nrow, sb = -1, t0;
        if (run < 256) { row0 = run * 32; nrow = 32; t0 = row0 & (SEQ - 1); } else { sb = run - 256; row0 = MP + 8 * sb; nrow = 8; t0 = 0; }
        float w[2][3][8], bs[2][8];
#pragma unroll
        for (int hf = 0; hf < 2; ++hf) {
#pragma unroll
            for (int j = 0; j < 3; ++j) { const f32x4 a = *(const f32x4*)(FW + j * DFF2 + hf * DFF + c), b2 = *(const f32x4*)(FW + j * DFF2 + hf * DFF + c + 4);
                w[hf][j][0] = a[0]; w[hf][j][1] = a[1]; w[hf][j][2] = a[2]; w[hf][j][3] = a[3]; w[hf][j][4] = b2[0]; w[hf][j][5] = b2[1]; w[hf][j][6] = b2[2]; w[hf][j][7] = b2[3]; }
            const f32x4 a = *(const f32x4*)(FB + hf * DFF + c), b2 = *(const f32x4*)(FB + hf * DFF + c + 4);
            bs[hf][0] = a[0]; bs[hf][1] = a[1]; bs[hf][2] = a[2]; bs[hf][3] = a[3]; bs[hf][4] = b2[0]; bs[hf][5] = b2[1]; bs[hf][6] = b2[2]; bs[hf][7] = b2[3];
        }
        float xm2[2][8], xm1[2][8];
#pragma unroll
        for (int hf = 0; hf < 2; ++hf) {
            if (sb >= 0) { const float* s = SF + (size_t)sb * 2 * DFF2 + hf * DFF + c;
                const f32x4 a = *(const f32x4*)s, b2 = *(const f32x4*)(s + 4), a1 = *(const f32x4*)(s + DFF2), b1 = *(const f32x4*)(s + DFF2 + 4);
                xm2[hf][0] = a[0]; xm2[hf][1] = a[1]; xm2[hf][2] = a[2]; xm2[hf][3] = a[3]; xm2[hf][4] = b2[0]; xm2[hf][5] = b2[1]; xm2[hf][6] = b2[2]; xm2[hf][7] = b2[3];
                xm1[hf][0] = a1[0]; xm1[hf][1] = a1[1]; xm1[hf][2] = a1[2]; xm1[hf][3] = a1[3]; xm1[hf][4] = b1[0]; xm1[hf][5] = b1[1]; xm1[hf][6] = b1[2]; xm1[hf][7] = b1[3]; }
            else if (t0 > 0) { unpack8(*(const v4u*)(UP + (size_t)(row0 - 2) * DFF2 + hf * DFF + c), xm2[hf]); unpack8(*(const v4u*)(UP + (size_t)(row0 - 1) * DFF2 + hf * DFF + c), xm1[hf]); }
            else {
#pragma unroll
                for (int e = 0; e < 8; ++e) { xm2[hf][e] = 0.f; xm1[hf][e] = 0.f; } }
        }
        for (int r0 = 0; r0 < nrow; r0 += 4) {
            v4u u[4][2];
#pragma unroll
            for (int i = 0; i < 4; ++i) { u[i][0] = *(const v4u*)(UP + (size_t)(row0 + r0 + i) * DFF2 + c); u[i][1] = *(const v4u*)(UP + (size_t)(row0 + r0 + i) * DFF2 + DFF + c); }
#pragma unroll
            for (int i = 0; i < 4; ++i) {
                float x[2][8], uc[2][8];
                unpack8(u[i][0], x[0]); unpack8(u[i][1], x[1]);
#pragma unroll
                for (int hf = 0; hf < 2; ++hf)
#pragma unroll
                    for (int e = 0; e < 8; ++e) { uc[hf][e] = bs[hf][e] + w[hf][0][e] * xm2[hf][e] + w[hf][1][e] * xm1[hf][e] + w[hf][2][e] * x[hf][e]; xm2[hf][e] = xm1[hf][e]; xm1[hf][e] = x[hf][e]; }
                float a[8];
#pragma unroll
                for (int e = 0; e < 8; ++e) a[e] = uc[0][e] * sigm(uc[0][e]) * uc[1][e];
                v4u o; o.x = pk2(a[0], a[1]); o.y = pk2(a[2], a[3]); o.z = pk2(a[4], a[5]); o.w = pk2(a[6], a[7]);
                *(v4u*)(ACT + (size_t)(row0 + r0 + i) * DFF + c) = o;
            }
        }
    }
}

template <bool COOP>
__global__ void __launch_bounds__(NT, 2) mega(Params P) {
    extern __shared__ __attribute__((aligned(16))) unsigned char lds_raw[];
    LAS unsigned char* lds = (LAS unsigned char*)lds_raw;
    Ctx C0; C0.tid = threadIdx.x; C0.lane = C0.tid & 63; C0.wave = __builtin_amdgcn_readfirstlane(C0.tid >> 6); C0.bid = blockIdx.x; C0.G = gridDim.x;
    C0.gw = C0.bid * 8 + C0.wave; C0.NGW = C0.G * 8;
    const int lo = P.ph_lo, hi = P.ph_hi;
    if (threadIdx.x < 4) ((LAS unsigned*)(lds + MISC_OFF))[threadIdx.x] = 0u;
    __syncthreads();
    XcdBarrier xbar; xbar.bar = nullptr; xbar.x = 0; xbar.st = nullptr;
    if constexpr (COOP) xbar = xcd_barrier_post((unsigned*)P.ws, (volatile LAS unsigned*)(lds + MISC_OFF));
#ifndef MK_ONLY
#define MK_ONLY -1
#endif
#define IN(k) ((MK_ONLY < 0 || MK_ONLY == (k)) && lo <= (k) && (k) < hi)
#define PH_CTX() Ctx C = C0; unsigned char* ws = wsbase(P); (void)ws; asm volatile("" : "+v"(C.tid), "+v"(C.lane), "+s"(C.wave), "+s"(C.gw), "+s"(C.bid))
#ifndef MK_REPMASK
#define MK_REPMASK 0
#endif
#define NREP(k) (((MK_REPMASK >> (k)) & 1) ? 2 : 1)
#define SEAM(k) do { if constexpr (COOP) { if (IN(k) && IN((k) + 1)) { if ((k) == 0) cg::this_grid().sync(); else xcd_barrier(xbar); } } } while (0)

    for (int rep_ = 0; rep_ < NREP(0); ++rep_) if (IN(0)) { PH_CTX(); p0_prologue(P, C, lds); __syncthreads(); }
    SEAM(0);
    for (int rep_ = 0; rep_ < NREP(1); ++rep_) if (IN(1)) { PH_CTX();
        { pg8::Gemm g{(const pg8::bf16_t*)(ws + WS_HB), (const pg8::bf16_t*)(ws + WS_WIN), M, NINP, D, D}; pg8::StaticOrder S; S.init(M, NINP, C.G, C.bid);
          pg8::EpiIn E{(pg8::bf16_t*)(ws + WS_GLU), (pg8::bf16_t*)(ws + WS_PR), P.out + O_CP, P.out + O_CS, P.out + O_SP, P.out + O_SS};
          pg8::gemm_phase<pg8::EpiIn, pg8::StaticOrder, PG8_ALIGN, PG8_SP2>(lds, g, S, E); }
        { pg8::Gemm g{(const pg8::bf16_t*)(ws + WS_MB), (const pg8::bf16_t*)(ws + WS_WKV), 1024, 4096, D, D}; pg8::StaticOrder S; S.init(1024, 4096, C.G, (C.bid + C.G - 24) % C.G);
          pg8::EpiKV E{P.out + O_MK, P.out + O_MV, (pg8::bf16_t*)(ws + WS_KB), (pg8::bf16_t*)(ws + WS_VT)};
          pg8::gemm_phase<pg8::EpiKV, pg8::StaticOrder, PG8_ALIGN, PG8_SP2>(lds, g, S, E); }
    }
    SEAM(1);
    for (int rep_ = 0; rep_ < NREP(2); ++rep_) if (IN(2)) { PH_CTX();
        SUBREP(0) for (int tk = C.bid; tk < 640; tk += C.G) {
            if (tk < 512) { const int b = tk >> 7, r0 = (tk & 127) * 16; conv_task<16>(P, C, lds, b * SEQ + r0, r0, -1); }
            else { const int sb = tk - 512; conv_task<8>(P, C, lds, MP + 8 * sb, 0, sb); }
        }
        SUBREP(1) for (int tk = C.bid; tk < 144; tk += C.G) prep_task<8>(P, C, lds, tk >> 1, (tk & 1) * 8);
    }
    SEAM(2);
    for (int rep_ = 0; rep_ < NREP(3); ++rep_) if (IN(3)) { PH_CTX();
        const float* swkv = inp(P, I_SWKV);
        SUBREP(2) for (int tk = C.bid; tk < 256; tk += C.G) scan_prompt(P, C, lds, tk >> 2, tk & 3);
        SUBREP(3) for (int tk = C.bid; tk < 4096; tk += C.G) scan_sample(P, C, swkv, tk >> 1, tk & 1);
    }
    SEAM(3);
    for (int rep_ = 0; rep_ < NREP(4); ++rep_) if (IN(4)) { PH_CTX(); for (int m = C.gw; m < M; m += C.NGW) post_row(P, m, C.lane); }
    SEAM(4);
    for (int rep_ = 0; rep_ < NREP(5); ++rep_) if (IN(5)) { PH_CTX();
        { pg8::Gemm g{(const pg8::bf16_t*)(ws + WS_A2), (const pg8::bf16_t*)(ws + WS_WOUT), MP, D, D, D}; pg8::StaticOrder S; S.init(MP, D, C.G, C.bid);
          pg8::EpiF32 E{(float*)(ws + WS_MIX), D, 0}; pg8::gemm_phase<pg8::EpiF32, pg8::StaticOrder, PG8_ALIGN, PG8_SP2>(lds, g, S, E); }
        { pg8::Gemm g{(const pg8::bf16_t*)(ws + WS_A2) + (size_t)MP * D, (const pg8::bf16_t*)(ws + WS_WOUT), MS, D, D / 8, D}; pg8::SplitOrder S; S.init(MS, D, 8, C.G, C.bid);
          pg8::EpiF32 E{(float*)(ws + WS_SLAB), D, SLAB_F}; pg8::gemm_phase<pg8::EpiF32, pg8::SplitOrder, PG8_ALIGN, PG8_SP2>(lds, g, S, E); } }
    SEAM(5);
    for (int rep_ = 0; rep_ < NREP(6); ++rep_) if (IN(6)) { PH_CTX(); const float* xp = inp(P, I_XP); const float* xs = inp(P, I_XS); const float* g1 = inp(P, I_NMIXPOST); const float* g2 = inp(P, I_NXAPRE);
        for (int m = C.gw; m < M; m += C.NGW) { const float* xr = m < MP ? xp + (size_t)m * D : xs + (size_t)(m - MP) * D;
        const float* mx = m < MP ? (const float*)(ws + WS_MIX) + (size_t)m * D : (const float*)(ws + WS_SLAB) + (size_t)(m - MP) * D;
        rowpass(xr, mx, m < MP ? 1 : 8, g1, (float*)(ws + WS_X1) + (size_t)m * D, g2, (bf16*)(ws + WS_HB) + (size_t)m * D, C.lane); } }
    SEAM(6);
    for (int rep_ = 0; rep_ < NREP(7); ++rep_) if (IN(7)) { PH_CTX();
        { pg8::Gemm g{(const pg8::bf16_t*)(ws + WS_HB), (const pg8::bf16_t*)(ws + WS_WQ), MP, D, D, D}; pg8::StaticOrder S; S.init(MP, D, C.G, C.bid);
          pg8::EpiBf16S E{(pg8::bf16_t*)(ws + WS_Q), D, 0.06375871479f  , nullptr};
          pg8::gemm_phase<pg8::EpiBf16S, pg8::StaticOrder, PG8_ALIGN, PG8_SP2>(lds, g, S, E); }
        { pg8::Gemm g{(const pg8::bf16_t*)(ws + WS_HB) + (size_t)MP * D, (const pg8::bf16_t*)(ws + WS_WQ), MS, D, D / 8, D}; pg8::SplitOrder S; S.init(MS, D, 8, C.G, C.bid);
          pg8::EpiF32 E{(float*)(ws + WS_SLAB), D, SLAB_F}; pg8::gemm_phase<pg8::EpiF32, pg8::SplitOrder, PG8_ALIGN, PG8_SP2>(lds, g, S, E); } }
    SEAM(7);
    for (int rep_ = 0; rep_ < NREP(8); ++rep_) if (IN(8)) { PH_CTX();
        SUBREP(4) for (int tk = C.bid; tk < 256; tk += C.G) attn_prompt_task(P, C, lds, tk >> 6, (tk >> 4) & 3, tk & 15);
        SUBREP(5) for (int tk = C.bid; tk < 512; tk += C.G) attn_sample_task(P, C, lds, tk >> 2, tk & 3);
    }
    SEAM(8);
    for (int rep_ = 0; rep_ < NREP(9); ++rep_) if (IN(9)) { PH_CTX();
        { pg8::Gemm g{(const pg8::bf16_t*)(ws + WS_O), (const pg8::bf16_t*)(ws + WS_WO), MP, D, D, D}; pg8::StaticOrder S; S.init(MP, D, C.G, C.bid);
          pg8::EpiF32 E{(float*)(ws + WS_MIX), D, 0}; pg8::gemm_phase<pg8::EpiF32, pg8::StaticOrder, PG8_ALIGN, PG8_SP2>(lds, g, S, E); }
        { pg8::Gemm g{(const pg8::bf16_t*)(ws + WS_O) + (size_t)MP * D, (const pg8::bf16_t*)(ws + WS_WO), MS, D, D / 8, D}; pg8::SplitOrder S; S.init(MS, D, 8, C.G, C.bid);
          pg8::EpiF32 E{(float*)(ws + WS_SLAB), D, SLAB_F}; pg8::gemm_phase<pg8::EpiF32, pg8::SplitOrder, PG8_ALIGN, PG8_SP2>(lds, g, S, E); } }
    SEAM(9);
    for (int rep_ = 0; rep_ < NREP(10); ++rep_) if (IN(10)) { PH_CTX(); const float* g1 = inp(P, I_NXAPOST); const float* g2 = inp(P, I_NFFNPRE);
        for (int m = C.gw; m < M; m += C.NGW) { float* x1 = (float*)(ws + WS_X1) + (size_t)m * D;
        const float* mx = m < MP ? (const float*)(ws + WS_MIX) + (size_t)m * D : (const float*)(ws + WS_SLAB) + (size_t)(m - MP) * D;
        rowpass(x1, mx, m < MP ? 1 : 8, g1, x1, g2, (bf16*)(ws + WS_HB) + (size_t)m * D, C.lane); } }
    SEAM(10);
    for (int rep_ = 0; rep_ < NREP(11); ++rep_) if (IN(11)) { PH_CTX(); pg8::Gemm g{(const pg8::bf16_t*)(ws + WS_HB), (const pg8::bf16_t*)(ws + WS_WUP), M, DFF2, D, D}; pg8::StaticOrder S; S.init(M, DFF2, C.G, C.bid);
        pg8::EpiBf16S E{(pg8::bf16_t*)(ws + WS_UP), DFF2, 1.0f, P.out + O_FP};
        pg8::gemm_phase<pg8::EpiBf16S, pg8::StaticOrder, PG8_ALIGN, PG8_SP2>(lds, g, S, E); }
    SEAM(11);
    for (int rep_ = 0; rep_ < NREP(12); ++rep_) if (IN(12)) { PH_CTX(); ffn_conv_act(P, C); }
    SEAM(12);
    for (int rep_ = 0; rep_ < NREP(13); ++rep_) if (IN(13)) { PH_CTX();
        { pg8::Gemm g{(const pg8::bf16_t*)(ws + WS_ACT), (const pg8::bf16_t*)(ws + WS_WDN), MP, D, DFF, DFF}; pg8::StaticOrder S; S.init(MP, D, C.G, C.bid);
          pg8::EpiF32 E{(float*)(ws + WS_MIX), D, 0}; pg8::gemm_phase<pg8::EpiF32, pg8::StaticOrder, PG8_ALIGN, PG8_SP2>(lds, g, S, E); }
        { pg8::Gemm g{(const pg8::bf16_t*)(ws + WS_ACT) + (size_t)MP * DFF, (const pg8::bf16_t*)(ws + WS_WDN), MS, D, DFF / 4, DFF}; pg8::SplitOrder S; S.init(MS, D, 4, C.G, (C.bid + 128) % C.G);
          pg8::EpiF32 E{(float*)(ws + WS_SLAB), D, SLAB_F}; pg8::gemm_phase<pg8::EpiF32, pg8::SplitOrder, PG8_ALIGN, PG8_SP2>(lds, g, S, E); } }
    SEAM(13);
    for (int rep_ = 0; rep_ < NREP(14); ++rep_) if (IN(14)) { PH_CTX(); const float* g1 = inp(P, I_NFFNPOST);
        for (int m = C.gw; m < M; m += C.NGW) { const float* x2 = (const float*)(ws + WS_X1) + (size_t)m * D;
        float* yo = m < MP ? P.out + O_YP + (size_t)m * D : P.out + O_YS + (size_t)(m - MP) * D;
        const float* mx = m < MP ? (const float*)(ws + WS_MIX) + (size_t)m * D : (const float*)(ws + WS_SLAB) + (size_t)(m - MP) * D;
        rowpass(x2, mx, m < MP ? 1 : 4, g1, yo, nullptr, nullptr, C.lane); } }
#undef IN
#undef SEAM
}

#ifndef MK_ONE_LAUNCH
#define MK_ONE_LAUNCH 1
#endif
extern "C" void kernel_launch(void* const* d_in, const int* in_sizes, int n_in, void* d_out, int out_size, void* d_ws, size_t ws_size, hipStream_t stream) {
    static int grid = 0;
    if (grid == 0) {
        if (n_in != N_IN || (size_t)out_size != O_END || ws_size < WS_END) { fprintf(stderr, "kernel_launch: unexpected sizes: n_in %d out %d ws %zu (need %zu)\n", n_in, out_size, ws_size, (size_t)WS_END); grid = -1; return; }
        int dev = 0, cus = 0, per_cu = 0;
        (void)hipGetDevice(&dev); (void)hipDeviceGetAttribute(&cus, hipDeviceAttributeMultiprocessorCount, dev);
        (void)hipFuncSetAttribute((const void*)mega<(MK_ONE_LAUNCH != 0)>, hipFuncAttributeMaxDynamicSharedMemorySize, LDS_BYTES);
        (void)hipOccupancyMaxActiveBlocksPerMultiprocessor(&per_cu, (const void*)mega<(MK_ONE_LAUNCH != 0)>, NT, LDS_BYTES);
        fprintf(stderr, "kernel_launch: cus %d, occupancy query %d block(s)/CU, ws %zu MiB\n", cus, per_cu, ws_size >> 20);
        (void)hipGetLastError();
        grid = cus;
        if (per_cu < 1) { fprintf(stderr, "kernel_launch: occupancy query says 0 blocks per CU\n"); }
    }
    if (grid < 0) return;
    if (hipMemsetAsync(d_ws, 0, 16384, stream) != hipSuccess) { fprintf(stderr, "kernel_launch: hipMemsetAsync failed\n"); return; }
    Params p{};
    for (int i = 0; i < N_IN; ++i) p.in[i] = (const float*)d_in[i];
    p.out = (float*)d_out; p.ws = (unsigned char*)d_ws;
#if MK_ONE_LAUNCH
    p.ph_lo = 0; p.ph_hi = NPHASE;
    void* args[] = {&p};
    hipError_t e = hipLaunchCooperativeKernel((const void*)mega<true>, dim3(grid), dim3(NT), args, LDS_BYTES, stream);
    if (e != hipSuccess) fprintf(stderr, "cooperative launch failed: %s (grid %d)\n", hipGetErrorString(e), grid);
#else
    for (int ph = 0; ph < NPHASE; ++ph) { p.ph_lo = ph; p.ph_hi = ph + 1; hipLaunchKernelGGL((mega<false>), dim3(grid), dim3(NT), LDS_BYTES, stream, p); }
#endif
}
```

```cpp
#include <hip/hip_runtime.h>
#include <hip/hip_cooperative_groups.h>
#include <cstdio>
#include <cstdint>
namespace cg = cooperative_groups;
constexpr int D = 2048, MP = 8192, MS = 1024, M = MP + MS, SEQ = 2048, TS = 8, NBP = 4, NBS = 128;
constexpr int CC = 1024, CW = 31, RW = 1024, RH = 16, HD = 64;
constexpr int NRC = 3520, NRCP = 3584, NINP = 5632;
constexpr int NMEM = 256, XH = 4, XD = 512, DFF = 5632, DFF2 = 11264;
namespace pg8 {
#define PG8_LAS __attribute__((address_space(3)))
typedef unsigned short bf16_t;
typedef short bf16x8 __attribute__((ext_vector_type(8)));
typedef float f32x4 __attribute__((ext_vector_type(4)));
typedef unsigned u32x4 __attribute__((ext_vector_type(4)));
constexpr int BM = 256, BK = 64, HALF = 128, HTB = HALF * BK * 2  , STAGE_BYTES = 8 * HTB, NXCD = 8, WGM = 8;

__host__ __device__ __forceinline__ int lds_byte(int r, int c) { const int st = (r >> 4) * 2 + (c >> 5), rr = r & 15, cc = c & 31, ob = rr * 64 + cc * 2; return st * 1024 + (ob ^ (((ob >> 9) & 1) << 5)); }
__host__ __device__ __forceinline__ void stage_rc(int b, int& R, int& C) { const int st = b / 1024, sb = b % 1024, swz = sb ^ (((sb >> 9) & 1) << 5); R = (st >> 1) * 16 + swz / 64; C = (st & 1) * 32 + (swz % 64) / 2; }
__host__ __device__ __forceinline__ int perm32(int rho) { const int n = rho >> 4, i = rho & 15; return 8 * (i >> 2) + 4 * n + (i & 3); }

struct Unit { int pm, pn, ks; };
struct Gemm { const bf16_t* A; const bf16_t* Bt; int M, N, K, ld; };

struct StaticOrder {
    int nM, nN, nwg, G, c;
    __host__ __device__ void init(int M, int N, int G_, int c_) { nM = M / BM; nN = N / BM; nwg = nM * nN; G = G_; c = c_; }
    __host__ __device__ bool next(int i, Unit& u) const {
        const long L = (long)i * G + c; if (L >= nwg) return false;
        int wgid = (int)L; { const int q = nwg / NXCD, r = nwg % NXCD, xcd = wgid % NXCD, off = wgid / NXCD; wgid = (xcd < r ? xcd * (q + 1) : r * (q + 1) + (xcd - r) * q) + off; }
        const int nig = WGM * nN, gid = wgid / nig, fm = gid * WGM, gsz = (nM - fm) < WGM ? (nM - fm) : WGM;
        u.pm = fm + ((wgid % nig) % gsz); u.pn = (wgid % nig) / gsz; u.ks = 0; return true;
    }
    __device__ __forceinline__ void a_ready(const Unit&) const {}
    __device__ __forceinline__ void done(const Unit&) const {}
};

struct SplitOrder {
    int nN, nsplit, nitems, G, c;
    __host__ __device__ void init(int M, int N, int nsplit_, int G_, int c_) { nN = N / BM; nsplit = nsplit_; nitems = (M / BM) * nN * nsplit_; G = G_; c = c_; }
    __host__ __device__ bool next(int i, Unit& u) const { const int L = i * G + c; if (L >= nitems) return false; u.ks = L % nsplit; const int t = L / nsplit; u.pn = t % nN; u.pm = t / nN; return true; }
    __device__ __forceinline__ void a_ready(const Unit&) const {}
    __device__ __forceinline__ void done(const Unit&) const {}
};
__device__ __forceinline__ unsigned cvt_pk_bf16(float lo, float hi) { unsigned r; asm volatile("v_cvt_pk_bf16_f32 %0, %1, %2" : "=v"(r) : "v"(lo), "v"(hi)); return r; }
typedef float f32x2 __attribute__((ext_vector_type(2)));
typedef unsigned u32x2 __attribute__((ext_vector_type(2)));
struct EpiIn {
    static constexpr bool PERM = true, AFTER_DRAIN = false;
    bf16_t* glu; bf16_t* pr; float* oconv_p; float* oconv_s; float* oshift_p; float* oshift_s;
    __device__ __forceinline__ void operator()(const f32x4 (&acc)[2][2][4][2], const Unit& u, int wr, int wc, int fr, int fq) const {
        const int row0 = u.pm * BM + wr * 64 + fr;
        if (u.pn < 8) {
#pragma unroll
            for (int ai = 0; ai < 2; ++ai)
#pragma unroll
                for (int m = 0; m < 4; ++m) {
                    const int row = row0 + ai * HALF + m * 16;
                    float* cdst = nullptr;
                    if (row < MP) { const int t = row & (SEQ - 1); if (t >= SEQ - 30) cdst = oconv_p + (size_t)((row >> 11) * 30 + (t - (SEQ - 30))) * CC; }
                    else { const int rs = row - MP; cdst = oconv_s + (size_t)((rs >> 3) * 30 + 22 + (rs & 7)) * CC; }
#pragma unroll
                    for (int bj = 0; bj < 2; ++bj) {
                        const int cgl = 16 * (8 * u.pn + 4 * bj + wc) + 4 * fq;
                        const f32x4 a = acc[ai][bj][m][0], g = acc[ai][bj][m][1];
                        f32x4 v;
#pragma unroll
                        for (int e = 0; e < 4; ++e) v[e] = a[e] / (1.0f + __expf(-g[e]));
                        u32x2 w; w.x = cvt_pk_bf16(v[0], v[1]); w.y = cvt_pk_bf16(v[2], v[3]);
                        *(u32x2*)(glu + (size_t)row * CC + cgl) = w;
                        if (cdst) *(f32x4*)(cdst + cgl) = v;
                    }
                }
        } else {
#pragma unroll
            for (int ai = 0; ai < 2; ++ai)
#pragma unroll
                for (int m = 0; m < 4; ++m) {
                    const int row = row0 + ai * HALF + m * 16;
                    float* sdst = nullptr;
                    if (row < MP) { if ((row & (SEQ - 1)) == SEQ - 1) sdst = oshift_p + (size_t)(row >> 11) * NRC; }
                    else { const int rs = row - MP; if ((rs & 7) == 7) sdst = oshift_s + (size_t)(rs >> 3) * NRC; }
#pragma unroll
                    for (int bj = 0; bj < 2; ++bj) {
                        const int jj0 = 256 * (u.pn - 8) + 128 * bj + 32 * wc + 8 * fq;
                        const f32x4 v0 = acc[ai][bj][m][0], v1 = acc[ai][bj][m][1];
                        u32x4 w; w.x = cvt_pk_bf16(v0[0], v0[1]); w.y = cvt_pk_bf16(v0[2], v0[3]); w.z = cvt_pk_bf16(v1[0], v1[1]); w.w = cvt_pk_bf16(v1[2], v1[3]);
                        *(u32x4*)(pr + (size_t)row * NRCP + jj0) = w;
                        if (sdst && jj0 < NRC) { *(f32x4*)(sdst + jj0) = v0; *(f32x4*)(sdst + jj0 + 4) = v1; }
                    }
                }
        }
    }
};
struct EpiKV {
    static constexpr bool PERM = false, AFTER_DRAIN = false;
    float* ok; float* ov; bf16_t* kb; bf16_t* vt;
    __device__ __forceinline__ void operator()(const f32x4 (&acc)[2][2][4][2], const Unit& u, int wr, int wc, int fr, int fq) const {
        const int row0 = u.pm * BM + wr * 64 + fr;
#pragma unroll
        for (int ai = 0; ai < 2; ++ai)
#pragma unroll
            for (int m = 0; m < 4; ++m) {
                const int r = row0 + ai * HALF + m * 16;
#pragma unroll
                for (int bj = 0; bj < 2; ++bj)
#pragma unroll
                    for (int n = 0; n < 2; ++n) {
                        const int c = 256 * u.pn + 128 * bj + 32 * wc + 16 * n + 4 * fq;
                        const f32x4 v = acc[ai][bj][m][n];
                        if (u.pn < 8) {
                            *(f32x4*)(ok + (size_t)r * 2048 + c) = v;
                            u32x2 w; w.x = cvt_pk_bf16(v[0], v[1]); w.y = cvt_pk_bf16(v[2], v[3]);
                            *(u32x2*)(kb + (size_t)r * 2048 + c) = w;
                        } else {
                            const int cv = c - 2048;
                            *(f32x4*)(ov + (size_t)r * 2048 + cv) = v;
                            const int b = r >> 8, key = r & 255, h = cv >> 9, d = cv & 511;
                            bf16_t* dst = vt + ((size_t)((b * 4 + h) * 512 + d)) * 256 + key;
                            const unsigned w0 = cvt_pk_bf16(v[0], v[1]), w1 = cvt_pk_bf16(v[2], v[3]);
                            dst[0] = (bf16_t)(w0 & 0xffffu); dst[256] = (bf16_t)(w0 >> 16); dst[512] = (bf16_t)(w1 & 0xffffu); dst[768] = (bf16_t)(w1 >> 16);
                        }
                    }
            }
    }
};
struct EpiF32 {
    static constexpr bool PERM = false, AFTER_DRAIN = false;
    float* C; int ldc; size_t slab;
    __device__ __forceinline__ void operator()(const f32x4 (&acc)[2][2][4][2], const Unit& u, int wr, int wc, int fr, int fq) const {
        const int row0 = u.pm * BM + wr * 64 + fr, col0 = u.pn * BM + wc * 32 + 4 * fq;
#pragma unroll
        for (int ai = 0; ai < 2; ++ai)
#pragma unroll
            for (int m = 0; m < 4; ++m) { float* rowp = C + (size_t)u.ks * slab + (size_t)(row0 + ai * HALF + m * 16) * ldc + col0;
#pragma unroll
                for (int bj = 0; bj < 2; ++bj)
#pragma unroll
                    for (int n = 0; n < 2; ++n) *(f32x4*)(rowp + bj * HALF + n * 16) = acc[ai][bj][m][n]; }
    }
};
struct EpiBf16S {
    static constexpr bool PERM = true, AFTER_DRAIN = false;
    bf16_t* O; int ldc; float scale; float* f;
    __device__ __forceinline__ void operator()(const f32x4 (&acc)[2][2][4][2], const Unit& u, int wr, int wc, int fr, int fq) const {
        const int row0 = u.pm * BM + wr * 64 + fr, col0 = u.pn * BM + wc * 32 + 8 * fq;
#pragma unroll
        for (int ai = 0; ai < 2; ++ai)
#pragma unroll
            for (int m = 0; m < 4; ++m) {
                const int row = row0 + ai * HALF + m * 16;
                long foff = -1;
                if (f) {
                    if (row < MP) { const int t = row & (SEQ - 1); if (t >= SEQ - 2) foff = (long)((row >> 11) * 2 + (t - (SEQ - 2))) * DFF2; }
                    else { const int rs = row - MP, t = rs & 7; if (t >= 6) foff = (long)(NBP * 2 + (rs >> 3) * 2 + (t - 6)) * DFF2; }
                }
                float* fdst = f + (foff < 0 ? 0 : foff);
                bf16_t* rowp = O + (size_t)row * ldc + col0;
#pragma unroll
                for (int bj = 0; bj < 2; ++bj) {
                    const f32x4 v0 = acc[ai][bj][m][0] * scale, v1 = acc[ai][bj][m][1] * scale;
                    u32x4 w; w.x = cvt_pk_bf16(v0[0], v0[1]); w.y = cvt_pk_bf16(v0[2], v0[3]); w.z = cvt_pk_bf16(v1[0], v1[1]); w.w = cvt_pk_bf16(v1[2], v1[3]);
                    *(u32x4*)(rowp + bj * HALF) = w;
                    if (foff >= 0) { *(f32x4*)(fdst + col0 + bj * HALF) = v0; *(f32x4*)(fdst + col0 + bj * HALF + 4) = v1; }
                }
            }
    }
};

template <class Epi, class Sched, bool ALIGN_EPI = false, bool SP2 = false>
__device__ __forceinline__ void gemm_phase(PG8_LAS unsigned char* lds, const Gemm g, const Sched& S, const Epi& E) {
    int tid_ = threadIdx.x; asm volatile("" : "+v"(tid_));
    const int tid = tid_, wid = __builtin_amdgcn_readfirstlane(tid >> 6), lane = tid & 63, wr = wid >> 2, wc = wid & 3, fr = lane & 15, fq = lane >> 4;
    const int K = g.K, nt = K / BK;
    unsigned voffA[2], voffB[2];
#pragma unroll
    for (int i = 0; i < 2; ++i) { int R, C; stage_rc(tid * 16 + i * 8192, R, C); const int Rb = Epi::PERM ? ((R & ~31) + perm32(R & 31)) : R;
        voffA[i] = (unsigned)(R * g.ld + C) * 2u; voffB[i] = (unsigned)(Rb * g.ld + C) * 2u; }
    const size_t kstep = (size_t)(BK * 2);
    const size_t hstep = (size_t)HALF * g.ld * 2;
    const size_t tstep = 2 * hstep;
    const unsigned ldsw = (unsigned)wid * 1024u;
    const int aoff = lds_byte(wr * 64 + fr, fq * 8), boff = lds_byte(wc * 32 + fr, fq * 8);
#define PG8_SA(b, h) (((b) * 2 + (h)) * HTB)
#define PG8_SB(b, h) ((4 + (b) * 2 + (h)) * HTB)
#define PG8_STAGE(bufoff, gbase, voff) do { _Pragma("unroll") for (int _i = 0; _i < 2; ++_i) \
        __builtin_amdgcn_global_load_lds((const unsigned*)((const char*)(gbase) + (voff)[_i]), (PG8_LAS unsigned*)(lds + (bufoff) + ldsw + _i * 8192), 16, 0, 0); } while (0)
#define PG8_LDA(dst, b, h) do { _Pragma("unroll") for (int m = 0; m < 4; ++m) _Pragma("unroll") for (int k = 0; k < 2; ++k) dst[m][k] = *(const PG8_LAS bf16x8*)(lds + PG8_SA(b, h) + aoff + m * 2048 + k * 1024); } while (0)
#define PG8_LDB(dst, b, h) do { _Pragma("unroll") for (int n = 0; n < 2; ++n) _Pragma("unroll") for (int k = 0; k < 2; ++k) dst[n][k] = *(const PG8_LAS bf16x8*)(lds + PG8_SB(b, h) + boff + n * 2048 + k * 1024); } while (0)
#define PG8_MMA(ai, bj, At, Bt) do { __builtin_amdgcn_s_setprio(1); _Pragma("unroll") for (int m = 0; m < 4; ++m) _Pragma("unroll") for (int n = 0; n < 2; ++n) _Pragma("unroll") for (int k = 0; k < 2; ++k) \
        acc[ai][bj][m][n] = __builtin_amdgcn_mfma_f32_16x16x32_bf16(Bt[n][k], At[m][k], acc[ai][bj][m][n], 0, 0, 0); __builtin_amdgcn_s_setprio(0); } while (0)
#define PG8_WAIT_V(n) asm volatile("s_waitcnt vmcnt(" #n ")" ::: "memory")
#define PG8_WAIT_L(n) asm volatile("s_waitcnt lgkmcnt(" #n ")" ::: "memory")
#define PG8_BAR __builtin_amdgcn_s_barrier()
#define PG8_SCHED __builtin_amdgcn_sched_barrier(0)
    Unit cur, nxt; int ui = 0;
    if (!S.next(0, cur)) return;
    f32x4 acc[2][2][4][2];
#pragma unroll
    for (int a = 0; a < 2; ++a)
#pragma unroll
        for (int b = 0; b < 2; ++b)
#pragma unroll
            for (int m = 0; m < 4; ++m)
#pragma unroll
                for (int n = 0; n < 2; ++n) acc[a][b][m][n] = (f32x4){0.f, 0.f, 0.f, 0.f};
    bf16x8 At[4][2], B0[2][2], B1[2][2];
    const size_t sstep = (size_t)K * 2;
    const char* cA = (const char*)g.A + (size_t)cur.pm * tstep + (size_t)cur.ks * sstep; const char* cB = (const char*)g.Bt + (size_t)cur.pn * tstep + (size_t)cur.ks * sstep;
    S.a_ready(cur);
    if constexpr (SP2) {
        PG8_STAGE(PG8_SB(0, 0), cB, voffB); PG8_STAGE(PG8_SB(0, 1), cB + hstep, voffB); PG8_STAGE(PG8_SA(0, 0), cA, voffA); PG8_STAGE(PG8_SA(0, 1), cA + hstep, voffA);
        if (wr == 1) PG8_BAR;
        PG8_WAIT_V(2); PG8_BAR;
        PG8_STAGE(PG8_SB(1, 0), cB + kstep, voffB); PG8_STAGE(PG8_SA(1, 0), cA + kstep, voffA); PG8_STAGE(PG8_SB(1, 1), cB + hstep + kstep, voffB);
        PG8_WAIT_V(6); PG8_BAR;
    } else {
        PG8_STAGE(PG8_SB(0, 0), cB, voffB); PG8_STAGE(PG8_SA(0, 0), cA, voffA); PG8_STAGE(PG8_SB(0, 1), cB + hstep, voffB); PG8_STAGE(PG8_SA(0, 1), cA + hstep, voffA);
        if (wr == 1) PG8_BAR;
        PG8_WAIT_V(4); PG8_BAR;
        PG8_STAGE(PG8_SB(1, 0), cB + kstep, voffB); PG8_STAGE(PG8_SA(1, 0), cA + kstep, voffA); PG8_STAGE(PG8_SB(1, 1), cB + hstep + kstep, voffB);
        PG8_WAIT_V(6); PG8_BAR;
    }
    for (;;) {
        const bool has_next = S.next(ui + 1, nxt);
        const char* nA = has_next ? (const char*)g.A + (size_t)nxt.pm * tstep + (size_t)nxt.ks * sstep : cA; const char* nB = has_next ? (const char*)g.Bt + (size_t)nxt.pn * tstep + (size_t)nxt.ks * sstep : cB;
        for (int t = 0; t < nt; t += 2) {
            const bool last = (t == nt - 2);
            const char* a1 = cA + (size_t)(t + 1) * kstep;
            const char* a2 = last ? nA : cA + (size_t)(t + 2) * kstep; const char* b2 = last ? nB : cB + (size_t)(t + 2) * kstep;
            const char* a3 = a2 + kstep; const char* b3 = b2 + kstep;
            if (last && has_next) S.a_ready(nxt);
            if constexpr (SP2) {
            PG8_LDB(B0, 0, 0); PG8_LDB(B1, 0, 1); PG8_SCHED; PG8_LDA(At, 0, 0); PG8_STAGE(PG8_SA(1, 1), a1 + hstep, voffA);
            PG8_WAIT_V(8); PG8_WAIT_L(0); PG8_BAR; PG8_MMA(0, 0, At, B0); PG8_MMA(0, 1, At, B1); PG8_BAR; PG8_SCHED;
            PG8_LDA(At, 0, 1); PG8_STAGE(PG8_SB(0, 0), b2, voffB); PG8_STAGE(PG8_SB(0, 1), b2 + hstep, voffB); PG8_STAGE(PG8_SA(0, 0), a2, voffA);
            PG8_WAIT_V(8); PG8_WAIT_L(0); PG8_BAR; PG8_MMA(1, 0, At, B0); PG8_MMA(1, 1, At, B1); PG8_BAR; PG8_SCHED;
            PG8_LDB(B0, 1, 0); PG8_LDB(B1, 1, 1); PG8_SCHED; PG8_LDA(At, 1, 0); PG8_STAGE(PG8_SA(0, 1), a2 + hstep, voffA);
            PG8_WAIT_V(8); PG8_WAIT_L(0); PG8_BAR; PG8_MMA(0, 0, At, B0); PG8_MMA(0, 1, At, B1); PG8_BAR; PG8_SCHED;
            PG8_LDA(At, 1, 1); PG8_STAGE(PG8_SB(1, 0), b3, voffB); PG8_STAGE(PG8_SB(1, 1), b3 + hstep, voffB); PG8_STAGE(PG8_SA(1, 0), a3, voffA);
            PG8_WAIT_V(8); PG8_WAIT_L(0); PG8_BAR; PG8_MMA(1, 0, At, B0); PG8_MMA(1, 1, At, B1); PG8_BAR; PG8_SCHED;
            } else {
            PG8_LDB(B0, 0, 0); PG8_SCHED; PG8_LDA(At, 0, 0); PG8_STAGE(PG8_SA(1, 1), a1 + hstep, voffA);
            PG8_WAIT_L(8); PG8_BAR; PG8_WAIT_L(0); PG8_MMA(0, 0, At, B0); PG8_BAR; PG8_SCHED;
            PG8_LDB(B1, 0, 1); PG8_STAGE(PG8_SB(0, 0), b2, voffB);
            PG8_BAR; PG8_WAIT_L(0); PG8_MMA(0, 1, At, B1); PG8_BAR;
            PG8_LDA(At, 0, 1); PG8_STAGE(PG8_SA(0, 0), a2, voffA);
            PG8_BAR; PG8_WAIT_L(0); PG8_MMA(1, 0, At, B0); PG8_BAR; PG8_SCHED;
            PG8_STAGE(PG8_SB(0, 1), b2 + hstep, voffB);
            PG8_WAIT_V(6); PG8_BAR; PG8_MMA(1, 1, At, B1); PG8_BAR;
            PG8_LDB(B0, 1, 0); PG8_SCHED; PG8_LDA(At, 1, 0); PG8_STAGE(PG8_SA(0, 1), a2 + hstep, voffA);
            PG8_WAIT_L(8); PG8_BAR; PG8_WAIT_L(0); PG8_MMA(0, 0, At, B0); PG8_BAR; PG8_SCHED;
            PG8_LDB(B1, 1, 1); PG8_STAGE(PG8_SB(1, 0), b3, voffB);
            PG8_BAR; PG8_WAIT_L(0); PG8_MMA(0, 1, At, B1); PG8_BAR;
            PG8_LDA(At, 1, 1); PG8_STAGE(PG8_SA(1, 0), a3, voffA);
            PG8_BAR; PG8_WAIT_L(0); PG8_MMA(1, 0, At, B0); PG8_BAR; PG8_SCHED;
            PG8_STAGE(PG8_SB(1, 1), b3 + hstep, voffB);
            PG8_WAIT_V(6); PG8_BAR; PG8_MMA(1, 1, At, B1); PG8_BAR;
            }
        }
        if constexpr (ALIGN_EPI) { if (wr == 0) PG8_BAR; }
        if constexpr (!Epi::AFTER_DRAIN) { E(acc, cur, wr, wc, fr, fq); S.done(cur); }
        if (!has_next) break;
#pragma unroll
        for (int a = 0; a < 2; ++a)
#pragma unroll
            for (int b = 0; b < 2; ++b)
#pragma unroll
                for (int m = 0; m < 4; ++m)
#pragma unroll
                    for (int n = 0; n < 2; ++n) acc[a][b][m][n] = (f32x4){0.f, 0.f, 0.f, 0.f};
        cur = nxt; cA = nA; cB = nB; ++ui;
        if constexpr (ALIGN_EPI) { if (wr == 1) PG8_BAR; }
    }
    PG8_WAIT_V(0);
    if constexpr (!ALIGN_EPI) { if (wr == 0) PG8_BAR; }
    PG8_BAR;
    if constexpr (Epi::AFTER_DRAIN) { E.fused(acc, cur, wr, wc, fr, fq, lds, wid, lane); S.done(cur); }
#undef PG8_SA
#undef PG8_SB
#undef PG8_STAGE
#undef PG8_LDA
#undef PG8_LDB
#undef PG8_MMA
#undef PG8_WAIT_V
#undef PG8_WAIT_L
#undef PG8_BAR
#undef PG8_SCHED
}
}
#ifndef PG8_SP2
#define PG8_SP2 true
#endif
#ifndef PG8_ALIGN
#define PG8_ALIGN true
#endif
#define LAS __attribute__((address_space(3)))
typedef unsigned short bf16;
typedef unsigned v4u __attribute__((ext_vector_type(4)));
typedef unsigned v2u __attribute__((ext_vector_type(2)));
typedef float f32x4 __attribute__((ext_vector_type(4)));
typedef float f32x2 __attribute__((ext_vector_type(2)));
typedef short bf16x8 __attribute__((ext_vector_type(8)));
constexpr int NT = 512;
constexpr int LDS_BYTES = 147456;
constexpr int NPHASE = 15;

constexpr size_t MiB = 1u << 20;
constexpr size_t WS_WIN = 1 * MiB, WS_WKV = 23 * MiB, WS_WOUT = 39 * MiB, WS_WQ = 47 * MiB, WS_WO = 55 * MiB, WS_WUP = 63 * MiB, WS_WDN = 107 * MiB;
constexpr size_t WS_LW = 129 * MiB, WS_LA = 129 * MiB + 256 * 1024, WS_LG = 129 * MiB + 512 * 1024;
constexpr size_t WS_HB = 130 * MiB, WS_MB = 166 * MiB, WS_A2 = 170 * MiB, WS_MIX = 206 * MiB, WS_X1 = 278 * MiB, WS_Q = 350 * MiB, WS_O = 386 * MiB;
constexpr size_t WS_KB = 422 * MiB, WS_VT = 426 * MiB, WS_Y = 430 * MiB, WS_G = 466 * MiB, WS_BON = 502 * MiB;
constexpr size_t WS_SHB = 818 * MiB;
constexpr size_t WS_SI = 503 * MiB, SB_STRIDE = 18 * MiB;
constexpr size_t WS_SW = WS_SI + 5 * SB_STRIDE;
constexpr size_t WS_UP = 503 * MiB;
constexpr size_t WS_GLU = 719 * MiB, WS_PR = 737 * MiB;
constexpr size_t WS_ACT = 719 * MiB;
constexpr size_t WS_HIMG = 820 * MiB;
constexpr size_t WS_SLAB = 822 * MiB, SLAB_F = (size_t)MS * D;
constexpr size_t WS_END = 886 * MiB;
constexpr size_t O_YP = 0, O_YS = 16777216, O_CP = 18874368, O_CS = 18997248, O_SP = 22929408, O_SS = 22943488, O_WP = 23394048, O_WS = 23656192,
                 O_FP = 32044800, O_FS = 32134912, O_MK = 35018496, O_MV = 37115648, O_END = 39212800;

enum { I_XP = 0, I_XS, I_CK, I_CV, I_SCONV, I_SSHIFT, I_SWKV, I_SFFN, I_MEM, I_NMIXPRE, I_WIN, I_CDW, I_CDWB, I_CLNG, I_CLNB, I_MU, I_W0, I_WLORA, I_A0, I_ALORA,
       I_GLORA, I_KK, I_KA, I_RK, I_LNXG, I_LNXB, I_WOUT, I_NMIXPOST, I_NXAPRE, I_NMEM, I_WQ, I_WK, I_WV, I_WO, I_NXAPOST, I_NFFNPRE, I_WUP, I_FDW, I_FDWB, I_WDOWN,
       I_NFFNPOST, N_IN };

struct Params { const float* in[N_IN]; float* out; unsigned char* ws; int ph_lo, ph_hi; };

__device__ __forceinline__ unsigned f2bf(float f) { unsigned u = __builtin_bit_cast(unsigned, f); return (u + 0x7fffu + ((u >> 16) & 1u)) >> 16; }
__device__ __forceinline__ unsigned pk2(float lo, float hi) { return f2bf(lo) | (f2bf(hi) << 16); }
__device__ __forceinline__ float bflo(unsigned u) { return __builtin_bit_cast(float, u << 16); }
__device__ __forceinline__ float bfhi(unsigned u) { return __builtin_bit_cast(float, u & 0xffff0000u); }
__device__ __forceinline__ float wave_sum(float v) {
#pragma unroll
    for (int o = 1; o < 64; o <<= 1) v += __shfl_xor(v, o);
    return v;
}
__device__ __forceinline__ float wave_max(float v) {
#pragma unroll
    for (int o = 1; o < 64; o <<= 1) v = fmaxf(v, __shfl_xor(v, o));
    return v;
}
__device__ __forceinline__ float sigm(float x) { return 1.0f / (1.0f + __expf(-x)); }
#define LDS_WAIT() asm volatile("s_waitcnt lgkmcnt(0)" ::: "memory")

typedef __attribute__((address_space(1))) unsigned gu32;
#define XB_TMO      128
#define XB_XCNT(j)  (256  + 64 * (j))
#define XB_XSUB(j)  (1280 + 64 * (j))
#define XB_XGEN(j)  (2304 + 64 * (j))
#define XB_TOP      3328
#define XB_TOPGEN   3392
#define XCD_BAR_WORDS 3456
#define XB_SPIN_CAP (1u << 18)

__device__ __forceinline__ unsigned xb_ld(unsigned* p)              { return __hip_atomic_load(p, __ATOMIC_RELAXED, __HIP_MEMORY_SCOPE_AGENT); }
__device__ __forceinline__ unsigned xb_add(unsigned* p, unsigned v) { return __hip_atomic_fetch_add(p, v, __ATOMIC_RELAXED, __HIP_MEMORY_SCOPE_AGENT); }
__device__ __forceinline__ unsigned xb_xcc_id() { return (unsigned)__builtin_amdgcn_s_getreg((3 << 11) | 20) & 0xFu; }
#define XB_SPIN(cond, bar) do { unsigned _sp = 0; while (cond) { __builtin_amdgcn_s_sleep(1); \
    if ((++_sp & 255u) == 0u) { if (xb_ld(&(bar)[XB_TMO])) break; if (_sp > XB_SPIN_CAP) { atomicAdd(&(bar)[XB_TMO], 1u); break; } } } } while (0)

struct XcdBarrier {
    unsigned* bar; unsigned x;
    volatile LAS unsigned* st;
};

__device__ __forceinline__ XcdBarrier xcd_barrier_post(unsigned* bar, volatile LAS unsigned* st) {
    XcdBarrier b; b.bar = bar; b.x = xb_xcc_id(); b.st = st;
    if (threadIdx.x == 0) (void)xb_add(&bar[XB_XCNT(b.x)], 1u);
    return b;
}
__device__ __forceinline__ void xcd_barrier_complete(unsigned* bar, unsigned x, unsigned& nloc, unsigned& nx) {
    const unsigned G = gridDim.x * gridDim.y * gridDim.z;
    unsigned sum, cnt, mine, sp = 0u;
    for (;;) {
        sum = 0u; cnt = 0u; mine = 0u;
#pragma unroll
        for (unsigned j = 0; j < 16; ++j) { const unsigned c = xb_ld(&bar[XB_XCNT(j)]); sum += c; cnt += (c > 0u) ? 1u : 0u; mine = (j == x) ? c : mine; }
        if (sum == G) break;
        __builtin_amdgcn_s_sleep(1);
        if ((++sp & 255u) == 0u) { if (xb_ld(&bar[XB_TMO])) break; if (sp > XB_SPIN_CAP) { atomicAdd(&bar[XB_TMO], 1u); break; } }
    }
    nloc = mine > 0u ? mine : 1u; nx = cnt > 0u ? cnt : 1u;
}

__device__ __forceinline__ void xcd_barrier(const XcdBarrier& b) {
    asm volatile("s_waitcnt vmcnt(0)" ::: "memory");
    __syncthreads();
    if (threadIdx.x == 0) {
        unsigned* bar = b.bar;
        __builtin_amdgcn_s_waitcnt(0);
        unsigned nloc = b.st[0], nx = b.st[1];
        if (nloc == 0u) { xcd_barrier_complete(bar, b.x, nloc, nx); b.st[0] = nloc; b.st[1] = nx; }
        const unsigned old = xb_add(&bar[XB_XSUB(b.x)], 1u);
        const unsigned gen = old / nloc;
        if (old + 1u == (gen + 1u) * nloc) {
            __builtin_amdgcn_fence(__ATOMIC_RELEASE, "agent");
            asm volatile("s_waitcnt vmcnt(0)" ::: "memory");
            const unsigned og = xb_add(&bar[XB_TOP], 1u);
            const unsigned tg = og / nx;
            if (og + 1u == (tg + 1u) * nx) xb_add(&bar[XB_TOPGEN], 1u);
            else XB_SPIN(xb_ld(&bar[XB_TOPGEN]) == tg, bar);
            __builtin_amdgcn_fence(__ATOMIC_ACQUIRE, "agent");
            xb_add(&bar[XB_XGEN(b.x)], 1u);
            asm volatile("s_waitcnt vmcnt(0)" ::: "memory");
        } else {
            XB_SPIN(xb_ld(&bar[XB_XGEN(b.x)]) == gen, bar);
            __builtin_amdgcn_fence(__ATOMIC_ACQUIRE, "agent");
            asm volatile("s_waitcnt vmcnt(0)" ::: "memory");
        }
    }
    __syncthreads();
}

constexpr int MISC_OFF = LDS_BYTES - 64;
struct Ctx { int tid, lane, wave, bid, G, gw, NGW; };
__device__ __forceinline__ unsigned char* wsbase(const Params& P) { const unsigned long long x = (unsigned long long)P.ws; int lo = __builtin_amdgcn_readfirstlane((int)(unsigned)x), hi = __builtin_amdgcn_readfirstlane((int)(unsigned)(x >> 32));
    asm volatile("" : "+s"(lo), "+s"(hi)); return (unsigned char*)(((unsigned long long)(unsigned)hi << 32) | (unsigned)lo); }
__device__ __forceinline__ const float* inp(const Params& P, int i) { int z; asm volatile("s_mov_b32 %0, 0" : "=s"(z)); return P.in[i + z]; }

#ifndef MK_SUBMASK
#define MK_SUBMASK 0
#endif
#define SUBREP(i) for (int sr_ = 0; sr_ < ((((MK_SUBMASK) >> (i)) & 1) ? 2 : 1); ++sr_)
template <class ColMap>
__device__ __forceinline__ void transpose_load(const float* __restrict__ W, int N, int kb, int jb, int lane, ColMap cm, f32x4 (&v)[16]) {
    const int kr = lane >> 4, l16 = lane & 15, k0 = 64 * kb + 16 * kr, j = 64 * jb + 4 * l16;
    const int sc = cm(j);
    if (sc >= 0) {
        const float* src = W + (size_t)k0 * N + sc;
#pragma unroll
        for (int q = 0; q < 16; ++q) v[q] = __builtin_nontemporal_load((const f32x4*)(src + (size_t)q * N));
    } else {
#pragma unroll
        for (int q = 0; q < 16; ++q) v[q] = (f32x4){0.f, 0.f, 0.f, 0.f};
    }
}
__device__ __forceinline__ void transpose_store(int K, bf16* __restrict__ WT, int kb, int jb, int lane, const f32x4 (&v)[16]) {
    const int kr = lane >> 4, l16 = lane & 15, k0 = 64 * kb + 16 * kr, j = 64 * jb + 4 * l16;
#pragma unroll
    for (int e = 0; e < 4; ++e) {
        bf16* dst = WT + (size_t)(j + e) * K + k0;
        v4u o0, o1;
        o0.x = pk2(v[0][e], v[1][e]); o0.y = pk2(v[2][e], v[3][e]); o0.z = pk2(v[4][e], v[5][e]); o0.w = pk2(v[6][e], v[7][e]);
        o1.x = pk2(v[8][e], v[9][e]); o1.y = pk2(v[10][e], v[11][e]); o1.z = pk2(v[12][e], v[13][e]); o1.w = pk2(v[14][e], v[15][e]);
        *(v4u*)dst = o0; *(v4u*)(dst + 8) = o1;
    }
}
template <class ColMap>
__device__ __forceinline__ void transpose_item(const float* __restrict__ W, int K, int N, bf16* __restrict__ WT, int kb, int jb, int lane, ColMap cm) {
    f32x4 v[16]; transpose_load(W, N, kb, jb, lane, cm, v); transpose_store(K, WT, kb, jb, lane, v);
}
struct MapId { __device__ __forceinline__ int operator()(int j) const { return j; } };
struct MapIn {
    __device__ __forceinline__ int operator()(int j) const {
        if (j < 2048) { const int g = j >> 5, q = (j >> 3) & 3, n = (j >> 2) & 1, e = j & 3; return n * 1024 + 16 * g + 4 * q + e; }
        const int jj = j - 2048; return jj < NRC ? 2048 + jj : -1;
    }
};
__device__ __forceinline__ void rms_row_bf16(const float* __restrict__ xrow, const float* __restrict__ g, bf16* __restrict__ orow, int lane) {
    f32x4 v[8]; float s = 0.f;
#pragma unroll
    for (int j = 0; j < 8; ++j) { v[j] = *(const f32x4*)(xrow + 4 * (lane + 64 * j)); s += (v[j][0] * v[j][0] + v[j][1] * v[j][1]) + (v[j][2] * v[j][2] + v[j][3] * v[j][3]); }
    const float r = rsqrtf(wave_sum(s) * (1.0f / 2048.0f) + 1e-6f);
#pragma unroll
    for (int j = 0; j < 8; ++j) { const f32x4 gg = *(const f32x4*)(g + 4 * (lane + 64 * j));
        v2u o; o.x = pk2(v[j][0] * r * gg[0], v[j][1] * r * gg[1]); o.y = pk2(v[j][2] * r * gg[2], v[j][3] * r * gg[3]);
        *(v2u*)(orow + 4 * (lane + 64 * j)) = o; }
}
constexpr int I_SQ_ = 32 * 32, I_UP_ = 32 * 176, I_DN_ = 88 * 32, NDEF = 3 * I_SQ_ + I_UP_ + I_DN_;
struct DefItem { const float* W; bf16* WT; int K, N, kb, jb; };
__device__ __forceinline__ DefItem def_item(const Params& P, unsigned char* ws, int r) {
    DefItem d;
    if (r < I_SQ_) { d.W = inp(P, I_WOUT); d.WT = (bf16*)(ws + WS_WOUT); d.K = 2048; d.N = 2048; d.kb = r / 32; d.jb = r % 32; return d; } r -= I_SQ_;
    if (r < I_SQ_) { d.W = inp(P, I_WQ); d.WT = (bf16*)(ws + WS_WQ); d.K = 2048; d.N = 2048; d.kb = r / 32; d.jb = r % 32; return d; } r -= I_SQ_;
    if (r < I_SQ_) { d.W = inp(P, I_WO); d.WT = (bf16*)(ws + WS_WO); d.K = 2048; d.N = 2048; d.kb = r / 32; d.jb = r % 32; return d; } r -= I_SQ_;
    if (r < I_UP_) { d.W = inp(P, I_WUP); d.WT = (bf16*)(ws + WS_WUP); d.K = 2048; d.N = 11264; d.kb = r / 176; d.jb = r % 176; return d; } r -= I_UP_;
    d.W = inp(P, I_WDOWN); d.WT = (bf16*)(ws + WS_WDN); d.K = 5632; d.N = 2048; d.kb = r / 32; d.jb = r % 32; return d;
}
__device__ __forceinline__ void p0_prologue(const Params& P, const Ctx& C, LAS unsigned char* lds) {
    unsigned char* ws = wsbase(P);
    constexpr int I_IN = 32 * 88, I_SQ = 32 * 32;
    constexpr int NITEMS = I_IN + 2 * I_SQ;
    SUBREP(6) for (int it = C.gw; it < NITEMS; it += C.NGW) {
        int r = it;
        if (r < I_IN) { transpose_item(inp(P, I_WIN), 2048, 5568, (bf16*)(ws + WS_WIN), r / 88, r % 88, C.lane, MapIn()); continue; } r -= I_IN;
        if (r < I_SQ) { transpose_item(inp(P, I_WK), 2048, 2048, (bf16*)(ws + WS_WKV), r / 32, r % 32, C.lane, MapId()); continue; } r -= I_SQ;
        transpose_item(inp(P, I_WV), 2048, 2048, (bf16*)(ws + WS_WKV) + (size_t)2048 * 2048, r / 32, r % 32, C.lane, MapId());
    }
    const int gt = C.bid * NT + C.tid, ngt = C.G * NT;
    {   const float* s_w = inp(P, I_WLORA); const float* s_a = inp(P, I_ALORA); const float* s_g = inp(P, I_GLORA);
        for (int i = gt; i < 1024 * 96; i += ngt) { const int n = i / 96, k = i - n * 96, h = n >> 6, r = n & 63;
            bf16* img = (bf16*)(ws + WS_HIMG + (size_t)h * 65536);
            img[r * 96 + k] = (bf16)f2bf(s_w[k * 1024 + n]); img[6144 + r * 96 + k] = (bf16)f2bf(s_a[k * 1024 + n]); }
        for (int i = gt; i < 1024 * 256; i += ngt) { const int n = i >> 8, k = i & 255, h = n >> 6, r = n & 63;
            bf16* img = (bf16*)(ws + WS_HIMG + (size_t)h * 65536);
            img[12288 + r * 256 + (((k >> 3) ^ (r & 15)) << 3) + (k & 7)] = (bf16)f2bf(s_g[k * 1024 + n]); }
        const float* mu = inp(P, I_MU); const float* kk = inp(P, I_KK); const float* a0 = inp(P, I_A0); const float* w0 = inp(P, I_W0); const float* ka = inp(P, I_KA); const float* rk = inp(P, I_RK);
        for (int i = gt; i < 16 * 512; i += ngt) { const int h = i >> 9, ar = (i >> 6) & 7, j = i & 63;
            const float* bp = ar == 0 ? mu : ar == 1 ? mu + 1024 : ar == 2 ? mu + 2048 : ar == 3 ? kk : ar == 4 ? a0 : ar == 5 ? w0 : ar == 6 ? ka : rk;
            ((float*)(ws + WS_HIMG + (size_t)h * 65536 + 57344))[ar * 64 + j] = bp[h * 64 + j]; }
    }
    SUBREP(7) for (int m = C.gw; m < M + 1024; m += C.NGW) {
        if (m < M) { const float* xr = m < MP ? inp(P, I_XP) + (size_t)m * D : inp(P, I_XS) + (size_t)(m - MP) * D; rms_row_bf16(xr, inp(P, I_NMIXPRE), (bf16*)(ws + WS_HB) + (size_t)m * D, C.lane); }
        else { const int r = m - M; rms_row_bf16(inp(P, I_MEM) + (size_t)r * D, inp(P, I_NMEM), (bf16*)(ws + WS_MB) + (size_t)r * D, C.lane); }
    }
    { bf16* d = (bf16*)(ws + WS_SHB); const float* sp = inp(P, I_SSHIFT);
      for (int i = gt; i < (NBS + 1) * NRCP; i += ngt) { const int b = i / NRCP, c = i - b * NRCP; d[i] = (b < NBS && c < NRC) ? (bf16)f2bf(sp[(size_t)b * NRC + c]) : (bf16)0; } }
    { const f32x4* s = (const f32x4*)inp(P, I_SCONV); f32x4* d = (f32x4*)(P.out + O_CS);
      for (int i = gt; i < NBS * 22 * 256; i += ngt) { const int b = i / (22 * 256), r = i - b * (22 * 256); d[(size_t)b * 30 * 256 + r] = s[(size_t)b * 30 * 256 + 8 * 256 + r]; } }
}

template <int R>
__device__ __forceinline__ void conv_task(const Params& P, const Ctx& C, LAS unsigned char* lds, int grow0  , int t0  , int sb  ) {
    unsigned char* ws = wsbase(P);
    const bf16* glu = (const bf16*)(ws + WS_GLU);
    LAS unsigned* st = (LAS unsigned*)lds;
    LAS float* red = (LAS float*)(lds + 98304);
    constexpr int NR = R + 30;
    const float* sconv = inp(P, I_SCONV); const float* cdw = inp(P, I_CDW);
    for (int p = C.tid; p < NR * 128; p += NT) {
        const int rr = p >> 7, ch = p & 127; const int t = t0 - 30 + rr;
        v4u v = (v4u){0u, 0u, 0u, 0u};
        if (t >= 0) v = *(const v4u*)(glu + (size_t)(grow0 - 30 + rr) * CC + ch * 8);
        else if (sb >= 0) { const float* s = sconv + ((size_t)sb * 30 + rr) * CC + ch * 8;
            const f32x4 a = *(const f32x4*)s, b = *(const f32x4*)(s + 4); v.x = pk2(a[0], a[1]); v.y = pk2(a[2], a[3]); v.z = pk2(b[0], b[1]); v.w = pk2(b[2], b[3]); }
        *(LAS v4u*)(st + rr * 512 + ch * 4) = v;
    }
    const int c = 2 * C.tid;
    f32x2 w[31];
#pragma unroll
    for (int j = 0; j < 31; ++j) w[j] = *(const f32x2*)(cdw + j * CC + c);
    const f32x2 bias = *(const f32x2*)(inp(P, I_CDWB) + c);
    f32x2 acc[R];
#pragma unroll
    for (int r = 0; r < R; ++r) acc[r] = bias;
    __syncthreads();
#pragma unroll
    for (int rr = 0; rr < NR; ++rr) {
        if ((rr & 3) == 0) asm volatile("" ::: "memory");
        const unsigned u = st[rr * 512 + C.tid]; const float x0 = bflo(u), x1 = bfhi(u);
#pragma unroll
        for (int r = 0; r < R; ++r) { const int j = rr - r; if (j >= 0 && j < 31) { acc[r][0] += x0 * w[j][0]; acc[r][1] += x1 * w[j][1]; } }
    }
    float s[R];
#pragma unroll
    for (int r = 0; r < R; ++r) s[r] = wave_sum(acc[r][0] + acc[r][1]);
    if (C.lane == 0) {
#pragma unroll
        for (int r = 0; r < R; ++r) red[C.wave * 16 + r] = s[r]; }
    __syncthreads();
    float mean[R];
#pragma unroll
    for (int r = 0; r < R; ++r) { float t = 0.f;
#pragma unroll
        for (int wv = 0; wv < 8; ++wv) t += red[wv * 16 + r];
        mean[r] = t * (1.0f / 1024.0f); }
    __syncthreads();
#pragma unroll
    for (int r = 0; r < R; ++r) { const float d0 = acc[r][0] - mean[r], d1 = acc[r][1] - mean[r]; acc[r][0] = d0; acc[r][1] = d1; s[r] = wave_sum(d0 * d0 + d1 * d1); }
    if (C.lane == 0) {
#pragma unroll
        for (int r = 0; r < R; ++r) red[C.wave * 16 + r] = s[r]; }
    __syncthreads();
    const f32x2 lg = *(const f32x2*)(inp(P, I_CLNG) + c), lb = *(const f32x2*)(inp(P, I_CLNB) + c);
    bf16* a2 = (bf16*)(ws + WS_A2);
#pragma unroll
    for (int r = 0; r < R; ++r) { float t = 0.f;
#pragma unroll
        for (int wv = 0; wv < 8; ++wv) t += red[wv * 16 + r];
        const float rstd = rsqrtf(t * (1.0f / 1024.0f) + 1e-5f);
        float y0 = acc[r][0] * rstd * lg[0] + lb[0], y1 = acc[r][1] * rstd * lg[1] + lb[1];
        y0 = y0 * sigm(y0); y1 = y1 * sigm(y1);
        *(unsigned*)(a2 + (size_t)(grow0 + r) * D + c) = pk2(y0, y1); }
    __syncthreads();
}

#define XS8(cp_, pp_, mp_, off_, xs_) do { const v4u cu_ = *(const v4u*)((cp_) + (off_)); const v4u pu_ = *(const v4u*)((pp_) + (off_)); \
        const f32x4 m0_ = *(const f32x4*)((mp_) + (off_)), m1_ = *(const f32x4*)((mp_) + (off_) + 4); float c_, p_; \
        c_ = bflo(cu_.x); p_ = bflo(pu_.x); xs_[0] = c_ + (p_ - c_) * m0_[0]; c_ = bfhi(cu_.x); p_ = bfhi(pu_.x); xs_[1] = c_ + (p_ - c_) * m0_[1]; \
        c_ = bflo(cu_.y); p_ = bflo(pu_.y); xs_[2] = c_ + (p_ - c_) * m0_[2]; c_ = bfhi(cu_.y); p_ = bfhi(pu_.y); xs_[3] = c_ + (p_ - c_) * m0_[3]; \
        c_ = bflo(cu_.z); p_ = bflo(pu_.z); xs_[4] = c_ + (p_ - c_) * m1_[0]; c_ = bfhi(cu_.z); p_ = bfhi(pu_.z); xs_[5] = c_ + (p_ - c_) * m1_[1]; \
        c_ = bflo(cu_.w); p_ = bflo(pu_.w); xs_[6] = c_ + (p_ - c_) * m1_[2]; c_ = bfhi(cu_.w); p_ = bfhi(pu_.w); xs_[7] = c_ + (p_ - c_) * m1_[3]; } while (0)
#define XS4(cp_, pp_, mp_, off_, xs_) do { const v2u cu_ = *(const v2u*)((cp_) + (off_)); const v2u pu_ = *(const v2u*)((pp_) + (off_)); const f32x4 m0_ = *(const f32x4*)((mp_) + (off_)); float c_, p_; \
        c_ = bflo(cu_.x); p_ = bflo(pu_.x); xs_[0] = c_ + (p_ - c_) * m0_[0]; c_ = bfhi(cu_.x); p_ = bfhi(pu_.x); xs_[1] = c_ + (p_ - c_) * m0_[1]; \
        c_ = bflo(cu_.y); p_ = bflo(pu_.y); xs_[2] = c_ + (p_ - c_) * m0_[2]; c_ = bfhi(cu_.y); p_ = bfhi(pu_.y); xs_[3] = c_ + (p_ - c_) * m0_[3]; } while (0)
__device__ __forceinline__ bf16x8 pack8(const float (&x)[8]) {
    v4u o; o.x = pk2(x[0], x[1]); o.y = pk2(x[2], x[3]); o.z = pk2(x[4], x[5]); o.w = pk2(x[6], x[7]);
    return __builtin_bit_cast(bf16x8, o);
}
__device__ __forceinline__ float tanh_fast(float x) { return 1.0f - 2.0f / (1.0f + __expf(2.0f * x)); }
constexpr int PBUF = 65536;
__device__ __forceinline__ void mix4(const v2u cu, const v2u pu, const f32x4 m, float (&xs)[4]) {
    float c_, p_;
    c_ = bflo(cu.x); p_ = bflo(pu.x); xs[0] = c_ + (p_ - c_) * m[0]; c_ = bfhi(cu.x); p_ = bfhi(pu.x); xs[1] = c_ + (p_ - c_) * m[1];
    c_ = bflo(cu.y); p_ = bflo(pu.y); xs[2] = c_ + (p_ - c_) * m[2]; c_ = bfhi(cu.y); p_ = bfhi(pu.y); xs[3] = c_ + (p_ - c_) * m[3];
}
template <int NH>
__device__ __forceinline__ void prep_task(const Params& P, const Ctx& C, LAS unsigned char* lds, int rowblock, int hbase) {
    const int lane = C.lane, fr = lane & 15, fq = lane >> 4, row = rowblock * 128 + C.wave * 16 + fr;
    unsigned char* ws = wsbase(P);
    const bf16* curp = (const bf16*)(ws + WS_PR) + (size_t)row * NRCP;
    const bf16* prvp = curp - NRCP;
    if (row < MP) { if ((row & (SEQ - 1)) == 0) prvp = (const bf16*)(ws + WS_SHB) + (size_t)NBS * NRCP; }
    else { const int rs = row - MP; if ((rs & 7) == 0) prvp = (const bf16*)(ws + WS_SHB) + (size_t)(rs >> 3) * NRCP; }
    const float* mup = inp(P, I_MU);
    const unsigned char* himg = ws + WS_HIMG;
    const bf16* c8 = curp + 3072 + 8 * fq; const bf16* p8 = prvp + 3072 + 8 * fq; const float* m8 = mup + 3072 + 8 * fq;
    const f32x4 z4 = (f32x4){0.f, 0.f, 0.f, 0.f};
    const int c00 = hbase * 64 + 4 * fq;
#define PREP_STAGE(h_, b_, i0_, n_) do { int ll = lane; asm volatile("" : "+v"(ll)); _Pragma("unroll") for (int q = 0; q < (n_); ++q) { const int i = (i0_) + C.wave + 8 * q; \
        __builtin_amdgcn_global_load_lds((const unsigned*)(himg + (size_t)(h_) * PBUF + i * 1024 + ll * 16), (LAS unsigned*)(lds + (b_) * PBUF + i * 1024), 16, 0, 0); } } while (0)
#define PREP_SYNC() do { asm volatile("s_waitcnt vmcnt(0)" ::: "memory"); __syncthreads(); } while (0)
    {
        PREP_STAGE(hbase, 0, 24, 4);
        bf16x8 Ag[8];
#pragma unroll
        for (int s = 0; s < 8; ++s) { if (s == 4) asm volatile("" ::: "memory");
            float xs[8]; XS8(c8, p8, m8, 192 + 32 * s, xs);
#pragma unroll
            for (int e = 0; e < 8; ++e) xs[e] = sigm(xs[e]);
            Ag[s] = pack8(xs); }
        PREP_SYNC();
        bf16* gb = (bf16*)(ws + WS_G) + (size_t)row * RW + c00;
        const int lgo = 24576 + fr * 512;
#pragma unroll 1
        for (int hh = 0; hh < NH; ++hh) {
            if (hh + 1 < NH) PREP_STAGE(hbase + hh + 1, (hh + 1) & 1, 24, 4);
            const LAS unsigned char* wb = lds + (hh & 1) * PBUF;
#pragma unroll
            for (int nt = 0; nt < 4; ++nt) {
                f32x4 accG = z4;
#pragma unroll
                for (int s = 0; s < 8; ++s) { const bf16x8 bg = *(const LAS bf16x8*)(wb + lgo + nt * 8192 + (((4 * s + fq) ^ fr) * 16)); accG = __builtin_amdgcn_mfma_f32_16x16x32_bf16(bg, Ag[s], accG, 0, 0, 0); }
                *(v2u*)(gb + 16 * nt) = (v2u){pk2(accG[0], accG[1]), pk2(accG[2], accG[3])};
            }
            gb += 64;
            PREP_SYNC();
        }
    }
    PREP_STAGE(hbase, 0, 0, 3); if (C.wave < 2) PREP_STAGE(hbase, 0, 56, 1);
    const bf16* c4 = curp + c00; const bf16* p4 = prvp + c00;
    v2u cu[3][4], pu[3][4];
#pragma unroll
    for (int x = 0; x < 3; ++x)
#pragma unroll
        for (int nt = 0; nt < 4; ++nt) { cu[x][nt] = *(const v2u*)(c4 + 1024 * x + 16 * nt); pu[x][nt] = *(const v2u*)(p4 + 1024 * x + 16 * nt); }
    bf16x8 Aw[3], Aa[3];
#pragma unroll
    for (int s = 0; s < 3; ++s) { float xs[8]; XS8(c8, p8, m8, 32 * s, xs);
#pragma unroll
        for (int e = 0; e < 8; ++e) xs[e] = tanh_fast(xs[e]);
        Aw[s] = pack8(xs); }
#pragma unroll
    for (int s = 0; s < 3; ++s) { float xs[8]; XS8(c8, p8, m8, 96 + 32 * s, xs); Aa[s] = pack8(xs); }
    PREP_SYNC();
    constexpr size_t SS = SB_STRIDE / 2;
    bf16* sb = (bf16*)(ws + WS_SI) + (size_t)row * RW + c00; float* sw = (float*)(ws + WS_SW) + (size_t)row * RW + c00;
    float* bonp = (float*)(ws + WS_BON) + (size_t)row * RH + hbase;
    const int lwo = fr * 192 + fq * 16, lpo = 57344 + fq * 16;
#pragma unroll 1
    for (int hh = 0; hh < NH; ++hh) {
        if (hh + 1 < NH) { PREP_STAGE(hbase + hh + 1, (hh + 1) & 1, 0, 3); if (C.wave < 2) PREP_STAGE(hbase + hh + 1, (hh + 1) & 1, 56, 1); }
        const LAS unsigned char* wb = lds + (hh & 1) * PBUF;
        float ss = 0.f;
#pragma unroll
        for (int nt = 0; nt < 4; ++nt) {
            float xk0[4]; mix4(cu[1][nt], pu[1][nt], *(const LAS f32x4*)(wb + lpo + 1 * 256 + nt * 64), xk0);
            const f32x4 kkw = *(const LAS f32x4*)(wb + lpo + 3 * 256 + nt * 64);
#pragma unroll
            for (int e = 0; e < 4; ++e) { const float t = xk0[e] * kkw[e]; ss += t * t; }
        }
        ss += __shfl_xor(ss, 16); ss += __shfl_xor(ss, 32);
        const float inv = 1.0f / fmaxf(sqrtf(ss), 1e-12f);
        float bon = 0.f;
#pragma unroll
        for (int nt = 0; nt < 4; ++nt) {
            f32x4 accW = z4, accA = z4;
#pragma unroll
            for (int s = 0; s < 3; ++s) { const bf16x8 bw = *(const LAS bf16x8*)(wb + lwo + nt * 3072 + s * 64), ba = *(const LAS bf16x8*)(wb + 12288 + lwo + nt * 3072 + s * 64);
                accW = __builtin_amdgcn_mfma_f32_16x16x32_bf16(bw, Aw[s], accW, 0, 0, 0); accA = __builtin_amdgcn_mfma_f32_16x16x32_bf16(ba, Aa[s], accA, 0, 0, 0); }
            float xr[4], xv[4], xkk[4];
            mix4(cu[0][nt], pu[0][nt], *(const LAS f32x4*)(wb + lpo + 0 * 256 + nt * 64), xr);
            mix4(cu[1][nt], pu[1][nt], *(const LAS f32x4*)(wb + lpo + 1 * 256 + nt * 64), xkk);
            mix4(cu[2][nt], pu[2][nt], *(const LAS f32x4*)(wb + lpo + 2 * 256 + nt * 64), xv);
            const f32x4 kkw = *(const LAS f32x4*)(wb + lpo + 3 * 256 + nt * 64), a0 = *(const LAS f32x4*)(wb + lpo + 4 * 256 + nt * 64), w0 = *(const LAS f32x4*)(wb + lpo + 5 * 256 + nt * 64);
            const f32x4 ka = *(const LAS f32x4*)(wb + lpo + 6 * 256 + nt * 64), rk = *(const LAS f32x4*)(wb + lpo + 7 * 256 + nt * 64);
            f32x4 vw; float vk[4], va[4], vb[4];
#pragma unroll
            for (int e = 0; e < 4; ++e) {
                const float ee = 0.6065306597126334f * sigm(w0[e] + accW[e]);
                vw[e] = __expf(-ee);
                const float a = sigm(a0[e] + accA[e]);
                const float kn = xkk[e] * kkw[e] * inv;
                const float k2 = xkk[e] * (1.0f + (a - 1.0f) * ka[e]);
                vk[e] = k2; va[e] = -kn; vb[e] = kn * a;
                bon += xr[e] * k2 * rk[e];
            }
            bf16* so = sb + 16 * nt;
            *(v2u*)(so + 0 * SS) = (v2u){pk2(xr[0], xr[1]), pk2(xr[2], xr[3])};
            *(v2u*)(so + 1 * SS) = (v2u){pk2(vk[0], vk[1]), pk2(vk[2], vk[3])};
            *(v2u*)(so + 2 * SS) = (v2u){pk2(xv[0], xv[1]), pk2(xv[2], xv[3])};
            *(v2u*)(so + 3 * SS) = (v2u){pk2(va[0], va[1]), pk2(va[2], va[3])};
            *(v2u*)(so + 4 * SS) = (v2u){pk2(vb[0], vb[1]), pk2(vb[2], vb[3])};
            *(f32x4*)(sw + 16 * nt) = vw;
        }
        bon += __shfl_xor(bon, 16); bon += __shfl_xor(bon, 32);
        if (fq == 0) bonp[hh] = bon;
        sb += 64; sw += 64;
        if (hh + 1 < NH) { c4 += 64; p4 += 64;
#pragma unroll
            for (int x = 0; x < 3; ++x)
#pragma unroll
                for (int nt = 0; nt < 4; ++nt) { cu[x][nt] = *(const v2u*)(c4 + 1024 * x + 16 * nt); pu[x][nt] = *(const v2u*)(p4 + 1024 * x + 16 * nt); } }
        PREP_SYNC();
    }
#undef PREP_STAGE
#undef PREP_SYNC
}

constexpr int TC = 32, STEPF = 340;
template <int CTRL> __device__ __forceinline__ float dppf(float x) { return __builtin_bit_cast(float, __builtin_amdgcn_update_dpp(0, __builtin_bit_cast(int, x), CTRL, 0xF, 0xF, true)); }
__device__ __forceinline__ float allred16(float x) {
    x += dppf<0xB1>(x);
    x += dppf<0x4E>(x);
    x += dppf<0x141>(x);
    x += dppf<0x140>(x);
    return x;
}
#define SCAN_BAR() do { asm volatile("s_waitcnt lgkmcnt(0)" ::: "memory"); __builtin_amdgcn_s_barrier(); asm volatile("" ::: "memory"); } while (0)
#define SCAN_STEP(S01, S23, r4, w4, k4, a4, b4, v, yout) do { \
        f32x2 p2 = S01 * (f32x2){a4[0], a4[1]}; p2 = S23 * (f32x2){a4[2], a4[3]} + p2; \
        const float sa = allred16(p2[0] + p2[1]); const f32x2 sa2 = (f32x2){sa, sa}, v2 = (f32x2){v, v}; \
        f32x2 t01 = v2 * (f32x2){k4[0], k4[1]}, t23 = v2 * (f32x2){k4[2], k4[3]}; \
        t01 = sa2 * (f32x2){b4[0], b4[1]} + t01; t23 = sa2 * (f32x2){b4[2], b4[3]} + t23; \
        S01 = S01 * (f32x2){w4[0], w4[1]} + t01; S23 = S23 * (f32x2){w4[2], w4[3]} + t23; \
        f32x2 q2 = S01 * (f32x2){r4[0], r4[1]}; q2 = S23 * (f32x2){r4[2], r4[3]} + q2; \
        yout = allred16(q2[0] + q2[1]); } while (0)
__device__ __forceinline__ void ld_bf8(const bf16* p, float (&x)[8]) { const v4u u = *(const v4u*)p; x[0] = bflo(u.x); x[1] = bfhi(u.x); x[2] = bflo(u.y); x[3] = bfhi(u.y); x[4] = bflo(u.z); x[5] = bfhi(u.z); x[6] = bflo(u.w); x[7] = bfhi(u.w); }
__device__ __forceinline__ void scan_prompt(const Params& P, const Ctx& C, LAS unsigned char* lds, int chain, int rb, bool dodef) {
    unsigned char* ws = wsbase(P);
    const int b = chain >> 4, h = chain & 15, m0 = b * SEQ;
    LAS float* buf = (LAS float*)lds;
    constexpr int NCH = SEQ / TC;
    if (C.wave >= 4) {
        const int ht = C.tid - 256, t = ht >> 3, g = ht & 7;
        const bf16* SB = (const bf16*)(ws + WS_SI) + (size_t)m0 * RW + h * 64 + 8 * g; constexpr size_t SBS = SB_STRIDE / 2;
        const float* SW = (const float*)(ws + WS_SW) + (size_t)m0 * RW + h * 64 + 8 * g;
        const bf16* SV = (const bf16*)(ws + WS_SI) + 2 * SBS + (size_t)m0 * RW + h * 64 + rb * 16 + 8 * (g & 1);
        v4u lr, lk, lb, la, lv; f32x4 lw0, lw1;
#define SCAN_HLOAD(ck_) do { const int tg = (ck_) * TC + t; const size_t ro = (size_t)tg * RW; \
            lr = *(const v4u*)(SB + 0 * SBS + ro); lk = *(const v4u*)(SB + 1 * SBS + ro); lb = *(const v4u*)(SB + 4 * SBS + ro); \
            la = tg + 1 < SEQ ? *(const v4u*)(SB + 3 * SBS + ro + RW) : (v4u){0u, 0u, 0u, 0u}; \
            lw0 = *(const f32x4*)(SW + ro); lw1 = *(const f32x4*)(SW + ro + 4); lv = *(const v4u*)(SV + ro); } while (0)
#define SCAN_HWRITE(ck_) do { LAS float* d = buf + ((ck_) & 1) * (TC * STEPF) + t * STEPF; \
            const float an[8] = {bflo(la.x), bfhi(la.x), bflo(la.y), bfhi(la.y), bflo(la.z), bfhi(la.z), bflo(la.w), bfhi(la.w)}; \
            const float bb[8] = {bflo(lb.x), bfhi(lb.x), bflo(lb.y), bfhi(lb.y), bflo(lb.z), bfhi(lb.z), bflo(lb.w), bfhi(lb.w)}; \
            const float kk_[8] = {bflo(lk.x), bfhi(lk.x), bflo(lk.y), bfhi(lk.y), bflo(lk.z), bfhi(lk.z), bflo(lk.w), bfhi(lk.w)}; \
            float be = 0.f, ka_ = 0.f; _Pragma("unroll") for (int e = 0; e < 8; ++e) { be += bb[e] * an[e]; ka_ += kk_[e] * an[e]; } \
            be += __shfl_xor(be, 1); be += __shfl_xor(be, 2); be += __shfl_xor(be, 4); ka_ += __shfl_xor(ka_, 1); ka_ += __shfl_xor(ka_, 2); ka_ += __shfl_xor(ka_, 4); \
            *(LAS v4u*)(d + 0 + 8 * g) = (v4u){lr.x << 16, lr.x & 0xffff0000u, lr.y << 16, lr.y & 0xffff0000u}; *(LAS v4u*)(d + 4 + 8 * g) = (v4u){lr.z << 16, lr.z & 0xffff0000u, lr.w << 16, lr.w & 0xffff0000u}; \
            *(LAS f32x4*)(d + 64 + 8 * g) = lw0; *(LAS f32x4*)(d + 68 + 8 * g) = lw1; \
            *(LAS f32x4*)(d + 128 + 8 * g) = (f32x4){kk_[0], kk_[1], kk_[2], kk_[3]}; *(LAS f32x4*)(d + 132 + 8 * g) = (f32x4){kk_[4], kk_[5], kk_[6], kk_[7]}; \
            *(LAS f32x4*)(d + 192 + 8 * g) = (f32x4){lw0[0] * an[0], lw0[1] * an[1], lw0[2] * an[2], lw0[3] * an[3]}; *(LAS f32x4*)(d + 196 + 8 * g) = (f32x4){lw1[0] * an[4], lw1[1] * an[5], lw1[2] * an[6], lw1[3] * an[7]}; \
            *(LAS f32x4*)(d + 256 + 8 * g) = (f32x4){bb[0], bb[1], bb[2], bb[3]}; *(LAS f32x4*)(d + 260 + 8 * g) = (f32x4){bb[4], bb[5], bb[6], bb[7]}; \
            if (g < 2) { *(LAS v4u*)(d + 320 + 8 * g) = (v4u){lv.x << 16, lv.x & 0xffff0000u, lv.y << 16, lv.y & 0xffff0000u}; *(LAS v4u*)(d + 324 + 8 * g) = (v4u){lv.z << 16, lv.z & 0xffff0000u, lv.w << 16, lv.w & 0xffff0000u}; } \
            if (g == 2) *(LAS f32x2*)(d + 336) = (f32x2){be, ka_}; } while (0)
        SCAN_HLOAD(0); SCAN_HWRITE(0); SCAN_HLOAD(1);
        SCAN_BAR();
        const int sw = C.bid * 4 + (C.wave - 4), nsw = C.G * 4;
        f32x4 tv[16]; DefItem di; di.W = nullptr; di.WT = nullptr; di.K = 0; di.N = 0; di.kb = 0; di.jb = 0; bool have = false;
        for (int ck = 0; ck < NCH; ++ck) {
            if (ck + 1 < NCH) SCAN_HWRITE(ck + 1);
            if (ck + 2 < NCH) SCAN_HLOAD(ck + 2);
            if (dodef) {
                const int ph = ck % 5, it = sw + nsw * (ck / 5);
                if (ph == 0 && it < NDEF) { di = def_item(P, ws, it); transpose_load(di.W, di.N, di.kb, di.jb, C.lane, MapId(), tv); have = true; }
                if (ph == 2 && have) { transpose_store(di.K, di.WT, di.kb, di.jb, C.lane, tv); have = false; }
            }
            SCAN_BAR();
        }
#undef SCAN_HLOAD
#undef SCAN_HWRITE
    } else {
        float* Y = (float*)(ws + WS_Y);
        const int rowl = C.lane >> 4, cl = C.lane & 15, irow = rb * 16 + C.wave * 4 + rowl;
        f32x2 S01 = (f32x2){0.f, 0.f}, S23 = (f32x2){0.f, 0.f};
        float sa = 0.f, yk = 0.f;
        SCAN_BAR();
        for (int ck = 0; ck < NCH; ++ck) {
            const LAS float* cb = buf + (ck & 1) * (TC * STEPF);
            f32x4 r4 = *(const LAS f32x4*)(cb + 0 * 64 + 4 * cl), w4 = *(const LAS f32x4*)(cb + 1 * 64 + 4 * cl), k4 = *(const LAS f32x4*)(cb + 2 * 64 + 4 * cl);
            f32x4 q4 = *(const LAS f32x4*)(cb + 3 * 64 + 4 * cl), b4 = *(const LAS f32x4*)(cb + 4 * 64 + 4 * cl); float v = cb[320 + C.wave * 4 + rowl]; f32x2 bk = *(const LAS f32x2*)(cb + 336);
#pragma unroll 4
            for (int t = 0; t < TC; ++t) {
                const LAS float* nb = cb + (t + 1 < TC ? t + 1 : t) * STEPF;
                const f32x4 nr = *(const LAS f32x4*)(nb + 0 * 64 + 4 * cl), nw = *(const LAS f32x4*)(nb + 1 * 64 + 4 * cl), nk = *(const LAS f32x4*)(nb + 2 * 64 + 4 * cl);
                const f32x4 nq = *(const LAS f32x4*)(nb + 3 * 64 + 4 * cl), nbb = *(const LAS f32x4*)(nb + 4 * 64 + 4 * cl); const float nv = nb[320 + C.wave * 4 + rowl]; const f32x2 nbk = *(const LAS f32x2*)(nb + 336);
                f32x2 d2 = S01 * (f32x2){q4[0], q4[1]}; d2 = S23 * (f32x2){q4[2], q4[3]} + d2;
                const float dd = allred16(d2[0] + d2[1]);
                const float san = sa * bk[0] + (v * bk[1] + dd);
                const f32x2 sa2 = (f32x2){sa, sa}, v2 = (f32x2){v, v};
                f32x2 t01 = v2 * (f32x2){k4[0], k4[1]}, t23 = v2 * (f32x2){k4[2], k4[3]};
                t01 = sa2 * (f32x2){b4[0], b4[1]} + t01; t23 = sa2 * (f32x2){b4[2], b4[3]} + t23;
                S01 = S01 * (f32x2){w4[0], w4[1]} + t01; S23 = S23 * (f32x2){w4[2], w4[3]} + t23;
                f32x2 y2 = S01 * (f32x2){r4[0], r4[1]}; y2 = S23 * (f32x2){r4[2], r4[3]} + y2;
                const float y = allred16(y2[0] + y2[1]);
                sa = san;
                yk = (cl == (t & 15)) ? y : yk;
                if ((t & 15) == 15) Y[(size_t)(m0 + ck * TC + (t & ~15) + cl) * RW + h * 64 + irow] = yk;
                r4 = nr; w4 = nw; k4 = nk; q4 = nq; b4 = nbb; v = nv; bk = nbk;
            }
            SCAN_BAR();
        }
        float* so = P.out + O_WP + ((size_t)chain * 64 + irow) * 64 + 4 * cl;
        *(f32x4*)so = (f32x4){S01[0], S01[1], S23[0], S23[1]};
    }
    __syncthreads();
}
__device__ __forceinline__ f32x4 ld_bf4(const bf16* p) { const v2u u = *(const v2u*)p; return (f32x4){bflo(u.x), bfhi(u.x), bflo(u.y), bfhi(u.y)}; }
__device__ __forceinline__ void scan_sample(const Params& P, const Ctx& C, const float* swkv, int chain, int half) {
    unsigned char* ws = wsbase(P);
    const int b = chain >> 4, h = chain & 15, m0 = MP + 8 * b;
    const bf16* ub = (const bf16*)(ws + WS_SI) + (size_t)m0 * RW + h * 64; constexpr size_t SBS = SB_STRIDE / 2;
    const float* uw = (const float*)(ws + WS_SW) + (size_t)m0 * RW + h * 64;
    float* Y = (float*)(ws + WS_Y);
    const int rowl = C.lane >> 4, cl = C.lane & 15, irow = half * 32 + C.wave * 4 + rowl, lo = 4 * cl;
    const f32x4 s4 = *(const f32x4*)(swkv + ((size_t)chain * 64 + irow) * 64 + 4 * cl);
    f32x2 S01 = (f32x2){s4[0], s4[1]}, S23 = (f32x2){s4[2], s4[3]};
    float yk = 0.f;
#pragma unroll 4
    for (int t = 0; t < 8; ++t) {
        const bf16* ut = ub + t * RW;
        const f32x4 r4 = ld_bf4(ut + 0 * SBS + lo), k4 = ld_bf4(ut + 1 * SBS + lo), a4 = ld_bf4(ut + 3 * SBS + lo), b4 = ld_bf4(ut + 4 * SBS + lo);
        const f32x4 w4 = *(const f32x4*)(uw + t * RW + lo); const float v = bflo((unsigned)(ut + 2 * SBS)[irow]);
        float y; SCAN_STEP(S01, S23, r4, w4, k4, a4, b4, v, y);
        yk = (cl == t) ? y : yk;
    }
    if (cl < 8) Y[(size_t)(m0 + cl) * RW + h * 64 + irow] = yk;
    *(f32x4*)(P.out + O_WS + ((size_t)chain * 64 + irow) * 64 + 4 * cl) = (f32x4){S01[0], S01[1], S23[0], S23[1]};
}

__device__ __forceinline__ void post_row(const Params& P, int row, int lane) {
    unsigned char* ws = wsbase(P);
    const float* Y = (const float*)(ws + WS_Y) + (size_t)row * RW + 16 * lane;
    const bf16* V = (const bf16*)(ws + WS_SI) + 2 * (SB_STRIDE / 2) + (size_t)row * RW + 16 * lane;
    const bf16* G = (const bf16*)(ws + WS_G) + (size_t)row * RW + 16 * lane;
    const float bon = ((const float*)(ws + WS_BON))[(size_t)row * RH + (lane >> 2)];
    float y[16], s = 0.f;
#pragma unroll
    for (int q = 0; q < 4; ++q) { const f32x4 t = *(const f32x4*)(Y + 4 * q); y[4 * q] = t[0]; y[4 * q + 1] = t[1]; y[4 * q + 2] = t[2]; y[4 * q + 3] = t[3]; s += (t[0] + t[1]) + (t[2] + t[3]); }
    s += __shfl_xor(s, 1); s += __shfl_xor(s, 2);
    const float mu = s * (1.0f / 64.0f); float q2 = 0.f;
#pragma unroll
    for (int e = 0; e < 16; ++e) { y[e] -= mu; q2 += y[e] * y[e]; }
    q2 += __shfl_xor(q2, 1); q2 += __shfl_xor(q2, 2);
    const float rstd = rsqrtf(q2 * (1.0f / 64.0f) + 64e-5f);
    const float* lg = inp(P, I_LNXG) + 16 * lane; const float* lb = inp(P, I_LNXB) + 16 * lane;
    unsigned o[8];
#pragma unroll
    for (int q = 0; q < 4; ++q) { const f32x4 g4 = *(const f32x4*)(lg + 4 * q), b4 = *(const f32x4*)(lb + 4 * q), v4 = ld_bf4(V + 4 * q), gg = ld_bf4(G + 4 * q);
        float r[4];
#pragma unroll
        for (int e = 0; e < 4; ++e) r[e] = (y[4 * q + e] * rstd * g4[e] + b4[e] + bon * v4[e]) * gg[e];
        o[2 * q] = pk2(r[0], r[1]); o[2 * q + 1] = pk2(r[2], r[3]); }
    bf16* dst = (bf16*)(ws + WS_A2) + (size_t)row * D + 1024 + 16 * lane;
    *(v4u*)dst = (v4u){o[0], o[1], o[2], o[3]}; *(v4u*)(dst + 8) = (v4u){o[4], o[5], o[6], o[7]};
}

__device__ __forceinline__ void rowpass(const float* xa, const float* __restrict__ mix, int nslab, const float* __restrict__ g1, float* xo,
                                        const float* __restrict__ g2, bf16* __restrict__ hb, int lane) {
    f32x4 mv[8]; float s = 0.f;
#pragma unroll
    for (int j = 0; j < 8; ++j) { mv[j] = *(const f32x4*)(mix + 4 * (lane + 64 * j));
        for (int sl = 1; sl < nslab; ++sl) mv[j] += *(const f32x4*)(mix + sl * SLAB_F + 4 * (lane + 64 * j));
        s += (mv[j][0] * mv[j][0] + mv[j][1] * mv[j][1]) + (mv[j][2] * mv[j][2] + mv[j][3] * mv[j][3]); }
    const float r = rsqrtf(wave_sum(s) * (1.0f / 2048.0f) + 1e-6f);
    float s2 = 0.f;
#pragma unroll
    for (int j = 0; j < 8; ++j) { const f32x4 a = *(const f32x4*)(xa + 4 * (lane + 64 * j)), gg = *(const f32x4*)(g1 + 4 * (lane + 64 * j));
        mv[j] = a + mv[j] * r * gg; *(f32x4*)(xo + 4 * (lane + 64 * j)) = mv[j];
        s2 += (mv[j][0] * mv[j][0] + mv[j][1] * mv[j][1]) + (mv[j][2] * mv[j][2] + mv[j][3] * mv[j][3]); }
    if (hb) {
        const float r2 = rsqrtf(wave_sum(s2) * (1.0f / 2048.0f) + 1e-6f);
#pragma unroll
        for (int j = 0; j < 8; ++j) { const f32x4 gg = *(const f32x4*)(g2 + 4 * (lane + 64 * j));
            v2u o; o.x = pk2(mv[j][0] * r2 * gg[0], mv[j][1] * r2 * gg[1]); o.y = pk2(mv[j][2] * r2 * gg[2], mv[j][3] * r2 * gg[3]);
            *(v2u*)(hb + 4 * (lane + 64 * j)) = o; }
    }
}
__device__ __forceinline__ void attn_prompt_task(const Params& P, const Ctx& C, LAS unsigned char* lds, int b, int h, int qt) {
    unsigned char* ws = wsbase(P);
    const bf16* Qg = (const bf16*)(ws + WS_Q); const bf16* Kg = (const bf16*)(ws + WS_KB); const bf16* VTg = (const bf16*)(ws + WS_VT);
    bf16* Og = (bf16*)(ws + WS_O);
    const int fr = C.lane & 15, fq = C.lane >> 4;
    const int qrow = b * SEQ + qt * 128 + C.wave * 16 + fr;
    constexpr int BUFB = 33792;
    bf16x8 Qf[16];
#pragma unroll
    for (int s = 0; s < 16; ++s) Qf[s] = *(const bf16x8*)(Qg + (size_t)qrow * D + h * XD + 32 * s + 8 * fq);
    f32x4 accS[16];
#pragma unroll
    for (int nt = 0; nt < 16; ++nt) accS[nt] = (f32x4){0.f, 0.f, 0.f, 0.f};
    v4u stg[4];
#define ATT_GLOAD(c_) do { if ((c_) < 8) { _Pragma("unroll") for (int i = 0; i < 4; ++i) { const int idx = C.tid + i * NT, key = idx >> 3, ch = idx & 7; \
            stg[i] = *(const v4u*)(Kg + (size_t)(b * NMEM + key) * D + h * XD + (c_) * 64 + ch * 8); } } \
        else { _Pragma("unroll") for (int i = 0; i < 4; ++i) { const int idx = C.tid + i * NT, dd = idx >> 5, ch = idx & 31; \
            stg[i] = *(const v4u*)(VTg + ((size_t)((b * XH + h) * XD + ((c_) - 8) * 64 + dd)) * NMEM + ch * 8); } } } while (0)
#define ATT_SWRITE(c_) do { LAS unsigned char* sbuf = lds + ((c_) & 1) * BUFB; if ((c_) < 8) { _Pragma("unroll") for (int i = 0; i < 4; ++i) { const int idx = C.tid + i * NT, key = idx >> 3, ch = idx & 7; \
            *(LAS v4u*)(sbuf + key * 128 + ((ch ^ (key & 7)) * 16)) = stg[i]; } } \
        else { _Pragma("unroll") for (int i = 0; i < 4; ++i) { const int idx = C.tid + i * NT, dd = idx >> 5, ch = idx & 31; \
            *(LAS v4u*)(sbuf + dd * 528 + ch * 16) = stg[i]; } } } while (0)
    ATT_GLOAD(0); ATT_SWRITE(0); __syncthreads();
    bf16x8 Pf[8];
#pragma unroll
    for (int c = 0; c < 8; ++c) {
        ATT_GLOAD(c + 1);
        const LAS unsigned char* sbuf = lds + (c & 1) * BUFB;
#pragma unroll
        for (int ss = 0; ss < 2; ++ss)
#pragma unroll
            for (int nt = 0; nt < 16; ++nt) {
                const int key = 16 * nt + fr, ch = ss * 4 + fq;
                const bf16x8 kf = *(const LAS bf16x8*)(sbuf + key * 128 + ((ch ^ (key & 7)) * 16));
                accS[nt] = __builtin_amdgcn_mfma_f32_16x16x32_bf16(kf, Qf[2 * c + ss], accS[nt], 0, 0, 0);
            }
        if (c == 7) {
            float mx = -3.0e38f;
#pragma unroll
            for (int nt = 0; nt < 16; ++nt) mx = fmaxf(mx, fmaxf(fmaxf(accS[nt][0], accS[nt][1]), fmaxf(accS[nt][2], accS[nt][3])));
            mx = fmaxf(mx, __shfl_xor(mx, 16)); mx = fmaxf(mx, __shfl_xor(mx, 32));
            float sum = 0.f;
#pragma unroll
            for (int nt = 0; nt < 16; ++nt) {
#pragma unroll
                for (int e = 0; e < 4; ++e) { const float p = exp2f(accS[nt][e] - mx); accS[nt][e] = p; sum += p; } }
            sum += __shfl_xor(sum, 16); sum += __shfl_xor(sum, 32);
            const float inv = 1.0f / sum;
#pragma unroll
            for (int s = 0; s < 8; ++s) { v4u o; o.x = pk2(accS[2 * s][0] * inv, accS[2 * s][1] * inv); o.y = pk2(accS[2 * s][2] * inv, accS[2 * s][3] * inv);
                o.z = pk2(accS[2 * s + 1][0] * inv, accS[2 * s + 1][1] * inv); o.w = pk2(accS[2 * s + 1][2] * inv, accS[2 * s + 1][3] * inv); Pf[s] = __builtin_bit_cast(bf16x8, o); }
        }
        ATT_SWRITE(c + 1);
        __syncthreads();
    }
    for (int c = 8; c < 16; ++c) {
        if (c + 1 < 16) ATT_GLOAD(c + 1);
        const LAS unsigned char* sbuf = lds + (c & 1) * BUFB;
        const int dv = c - 8;
        f32x4 accO[4];
#pragma unroll
        for (int nd = 0; nd < 4; ++nd) accO[nd] = (f32x4){0.f, 0.f, 0.f, 0.f};
#pragma unroll
        for (int s = 0; s < 8; ++s)
#pragma unroll
            for (int nd = 0; nd < 4; ++nd) {
                const LAS unsigned char* rp = sbuf + (nd * 16 + fr) * 528 + (32 * s + 4 * fq) * 2;
                const v2u lo = *(const LAS v2u*)rp, hi = *(const LAS v2u*)(rp + 32);
                const bf16x8 vf = __builtin_bit_cast(bf16x8, ((v4u){lo.x, lo.y, hi.x, hi.y}));
                accO[nd] = __builtin_amdgcn_mfma_f32_16x16x32_bf16(vf, Pf[s], accO[nd], 0, 0, 0);
            }
#pragma unroll
        for (int nd = 0; nd < 4; ++nd) { v2u o; o.x = pk2(accO[nd][0], accO[nd][1]); o.y = pk2(accO[nd][2], accO[nd][3]);
            *(v2u*)(Og + (size_t)qrow * D + h * XD + dv * 64 + nd * 16 + 4 * fq) = o; }
        if (c + 1 < 16) ATT_SWRITE(c + 1);
        __syncthreads();
    }
#undef ATT_GLOAD
#undef ATT_SWRITE
}
__device__ __forceinline__ void attn_sample_task(const Params& P, const Ctx& C, LAS unsigned char* lds, int b, int h) {
    unsigned char* ws = wsbase(P);
    bf16* Og = (bf16*)(ws + WS_O);
    const float* CK = inp(P, I_CK); const float* CV = inp(P, I_CV);
    LAS float* sS = (LAS float*)lds;
    LAS float* sP = (LAS float*)(lds + 8192);
    const int row0 = MP + 8 * b;
    float qv[8][8];
#pragma unroll
    for (int q = 0; q < 8; ++q) { const float* qp = (const float*)(ws + WS_SLAB) + (size_t)(8 * b + q) * D + h * XD;
        f32x4 a = *(const f32x4*)(qp + 4 * C.lane), c2 = *(const f32x4*)(qp + 256 + 4 * C.lane);
        for (int sl = 1; sl < 8; ++sl) { a += *(const f32x4*)(qp + sl * SLAB_F + 4 * C.lane); c2 += *(const f32x4*)(qp + sl * SLAB_F + 256 + 4 * C.lane); }
        a *= 0.06375871479f; c2 *= 0.06375871479f;
        qv[q][0] = a[0]; qv[q][1] = a[1]; qv[q][2] = a[2]; qv[q][3] = a[3]; qv[q][4] = c2[0]; qv[q][5] = c2[1]; qv[q][6] = c2[2]; qv[q][7] = c2[3]; }
    for (int k0 = 0; k0 < 32; k0 += 4) {
        f32x4 ka[4], kb2[4];
#pragma unroll
        for (int u = 0; u < 4; ++u) { const float* kp = CK + ((size_t)(b * NMEM + C.wave * 32 + k0 + u) * XH + h) * XD; ka[u] = *(const f32x4*)(kp + 4 * C.lane); kb2[u] = *(const f32x4*)(kp + 256 + 4 * C.lane); }
#pragma unroll
        for (int u = 0; u < 4; ++u) {
            float part[8];
#pragma unroll
            for (int q = 0; q < 8; ++q) part[q] = (qv[q][0] * ka[u][0] + qv[q][1] * ka[u][1]) + (qv[q][2] * ka[u][2] + qv[q][3] * ka[u][3]) + (qv[q][4] * kb2[u][0] + qv[q][5] * kb2[u][1]) + (qv[q][6] * kb2[u][2] + qv[q][7] * kb2[u][3]);
#pragma unroll
            for (int q = 0; q < 8; ++q) part[q] = wave_sum(part[q]);
            if (C.lane == 0) {
#pragma unroll
                for (int q = 0; q < 8; ++q) sS[q * 256 + C.wave * 32 + k0 + u] = part[q]; }
        }
    }
    __syncthreads();
    {
        const int q = C.wave; const f32x4 s4 = *(const LAS f32x4*)(sS + q * 256 + 4 * C.lane);
        const float mx = wave_max(fmaxf(fmaxf(s4[0], s4[1]), fmaxf(s4[2], s4[3])));
        const float p0 = exp2f(s4[0] - mx), p1 = exp2f(s4[1] - mx), p2 = exp2f(s4[2] - mx), p3 = exp2f(s4[3] - mx);
        const float inv = 1.0f / wave_sum((p0 + p1) + (p2 + p3));
        sP[(4 * C.lane + 0) * 8 + q] = p0 * inv; sP[(4 * C.lane + 1) * 8 + q] = p1 * inv; sP[(4 * C.lane + 2) * 8 + q] = p2 * inv; sP[(4 * C.lane + 3) * 8 + q] = p3 * inv;
    }
    __syncthreads();
    float acc[8];
#pragma unroll
    for (int q = 0; q < 8; ++q) acc[q] = 0.f;
    const int d = C.wave * 64 + C.lane;
    for (int k0 = 0; k0 < 256; k0 += 8) {
        float vv[8];
#pragma unroll
        for (int u = 0; u < 8; ++u) vv[u] = CV[((size_t)(b * NMEM + k0 + u) * XH + h) * XD + d];
#pragma unroll
        for (int u = 0; u < 8; ++u) { const f32x4 pa = *(const LAS f32x4*)(sP + (k0 + u) * 8), pb = *(const LAS f32x4*)(sP + (k0 + u) * 8 + 4);
            acc[0] += pa[0] * vv[u]; acc[1] += pa[1] * vv[u]; acc[2] += pa[2] * vv[u]; acc[3] += pa[3] * vv[u];
            acc[4] += pb[0] * vv[u]; acc[5] += pb[1] * vv[u]; acc[6] += pb[2] * vv[u]; acc[7] += pb[3] * vv[u]; }
    }
#pragma unroll
    for (int q = 0; q < 8; ++q) Og[(size_t)(row0 + q) * D + h * XD + d] = (bf16)f2bf(acc[q]);
    __syncthreads();
}

__device__ __forceinline__ void unpack8(const v4u u, float (&x)[8]) { x[0] = bflo(u.x); x[1] = bfhi(u.x); x[2] = bflo(u.y); x[3] = bfhi(u.y); x[4] = bflo(u.z); x[5] = bfhi(u.z); x[6] = bflo(u.w); x[7] = bfhi(u.w); }
__device__ __forceinline__ void ffn_conv_act(const Params& P, const Ctx& C) {
    unsigned char* ws = wsbase(P);
    const bf16* UP = (const bf16*)(ws + WS_UP); bf16* ACT = (bf16*)(ws + WS_ACT);
    const float* FW = inp(P, I_FDW); const float* FB = inp(P, I_FDWB); const float* SF = inp(P, I_SFFN);
    constexpr int NG = DFF / 8;
    constexpr int NRUN = 256 + 128;
    for (int it = C.bid * NT + C.tid; it < NRUN * NG; it += C.G * NT) {
        const int run = it / NG, c = (it - run * NG) * 8;
        int row0, nrow, sb = -1, t0;
        if (run < 256) { row0 = run * 32; nrow = 32; t0 = row0 & (SEQ - 1); } else { sb = run - 256; row0 = MP + 8 * sb; nrow = 8; t0 = 0; }
        float w[2][3][8], bs[2][8];
#pragma unroll
        for (int hf = 0; hf < 2; ++hf) {
#pragma unroll
            for (int j = 0; j < 3; ++j) { const f32x4 a = *(const f32x4*)(FW + j * DFF2 + hf * DFF + c), b2 = *(const f32x4*)(FW + j * DFF2 + hf * DFF + c + 4);
                w[hf][j][0] = a[0]; w[hf][j][1] = a[1]; w[hf][j][2] = a[2]; w[hf][j][3] = a[3]; w[hf][j][4] = b2[0]; w[hf][j][5] = b2[1]; w[hf][j][6] = b2[2]; w[hf][j][7] = b2[3]; }
            const f32x4 a = *(const f32x4*)(FB + hf * DFF + c), b2 = *(const f32x4*)(FB + hf * DFF + c + 4);
            bs[hf][0] = a[0]; bs[hf][1] = a[1]; bs[hf][2] = a[2]; bs[hf][3] = a[3]; bs[hf][4] = b2[0]; bs[hf][5] = b2[1]; bs[hf][6] = b2[2]; bs[hf][7] = b2[3];
        }
        float xm2[2][8], xm1[2][8];
#pragma unroll
        for (int hf = 0; hf < 2; ++hf) {
            if (sb >= 0) { const float* s = SF + (size_t)sb * 2 * DFF2 + hf * DFF + c;
                const f32x4 a = *(const f32x4*)s, b2 = *(const f32x4*)(s + 4), a1 = *(const f32x4*)(s + DFF2), b1 = *(const f32x4*)(s + DFF2 + 4);
                xm2[hf][0] = a[0]; xm2[hf][1] = a[1]; xm2[hf][2] = a[2]; xm2[hf][3] = a[3]; xm2[hf][4] = b2[0]; xm2[hf][5] = b2[1]; xm2[hf][6] = b2[2]; xm2[hf][7] = b2[3];
                xm1[hf][0] = a1[0]; xm1[hf][1] = a1[1]; xm1[hf][2] = a1[2]; xm1[hf][3] = a1[3]; xm1[hf][4] = b1[0]; xm1[hf][5] = b1[1]; xm1[hf][6] = b1[2]; xm1[hf][7] = b1[3]; }
            else if (t0 > 0) { unpack8(*(const v4u*)(UP + (size_t)(row0 - 2) * DFF2 + hf * DFF + c), xm2[hf]); unpack8(*(const v4u*)(UP + (size_t)(row0 - 1) * DFF2 + hf * DFF + c), xm1[hf]); }
            else {
#pragma unroll
                for (int e = 0; e < 8; ++e) { xm2[hf][e] = 0.f; xm1[hf][e] = 0.f; } }
        }
        for (int r0 = 0; r0 < nrow; r0 += 4) {
            v4u u[4][2];
#pragma unroll
            for (int i = 0; i < 4; ++i) { u[i][0] = *(const v4u*)(UP + (size_t)(row0 + r0 + i) * DFF2 + c); u[i][1] = *(const v4u*)(UP + (size_t)(row0 + r0 + i) * DFF2 + DFF + c); }
#pragma unroll
            for (int i = 0; i < 4; ++i) {
                float x[2][8], uc[2][8];
                unpack8(u[i][0], x[0]); unpack8(u[i][1], x[1]);
#pragma unroll
                for (int hf = 0; hf < 2; ++hf)
#pragma unroll
                    for (int e = 0; e < 8; ++e) { uc[hf][e] = bs[hf][e] + w[hf][0][e] * xm2[hf][e] + w[hf][1][e] * xm1[hf][e] + w[hf][2][e] * x[hf][e]; xm2[hf][e] = xm1[hf][e]; xm1[hf][e] = x[hf][e]; }
                float a[8];
#pragma unroll
                for (int e = 0; e < 8; ++e) a[e] = uc[0][e] * sigm(uc[0][e]) * uc[1][e];
                v4u o; o.x = pk2(a[0], a[1]); o.y = pk2(a[2], a[3]); o.z = pk2(a[4], a[5]); o.w = pk2(a[6], a[7]);
                *(v4u*)(ACT + (size_t)(row0 + r0 + i) * DFF + c) = o;
            }
        }
    }
}

template <bool COOP>
__global__ void __launch_bounds__(NT, 2) mega(Params P) {
    extern __shared__ __attribute__((aligned(16))) unsigned char lds_raw[];
    LAS unsigned char* lds = (LAS unsigned char*)lds_raw;
    Ctx C0; C0.tid = threadIdx.x; C0.lane = C0.tid & 63; C0.wave = __builtin_amdgcn_readfirstlane(C0.tid >> 6); C0.bid = blockIdx.x; C0.G = gridDim.x;
    C0.gw = C0.bid * 8 + C0.wave; C0.NGW = C0.G * 8;
    const int lo = P.ph_lo, hi = P.ph_hi;
    if (threadIdx.x < 4) ((LAS unsigned*)(lds + MISC_OFF))[threadIdx.x] = 0u;
    __syncthreads();
    XcdBarrier xbar; xbar.bar = nullptr; xbar.x = 0; xbar.st = nullptr;
    if constexpr (COOP) xbar = xcd_barrier_post((unsigned*)P.ws, (volatile LAS unsigned*)(lds + MISC_OFF));
#ifndef MK_ONLY
#define MK_ONLY -1
#endif
#define IN(k) ((MK_ONLY < 0 || MK_ONLY == (k)) && lo <= (k) && (k) < hi)
#define PH_CTX() Ctx C = C0; unsigned char* ws = wsbase(P); (void)ws; asm volatile("" : "+v"(C.tid), "+v"(C.lane), "+s"(C.wave), "+s"(C.gw), "+s"(C.bid))
#ifndef MK_REPMASK
#define MK_REPMASK 0
#endif
#define NREP(k) (((MK_REPMASK >> (k)) & 1) ? 2 : 1)
#define SEAM(k) do { if constexpr (COOP) { if (IN(k) && IN((k) + 1)) { if ((k) == 0) cg::this_grid().sync(); else xcd_barrier(xbar); } } } while (0)

    for (int rep_ = 0; rep_ < NREP(0); ++rep_) if (IN(0)) { PH_CTX(); p0_prologue(P, C, lds); __syncthreads(); }
    SEAM(0);
    for (int rep_ = 0; rep_ < NREP(1); ++rep_) if (IN(1)) { PH_CTX();
        { pg8::Gemm g{(const pg8::bf16_t*)(ws + WS_HB), (const pg8::bf16_t*)(ws + WS_WIN), M, NINP, D, D}; pg8::StaticOrder S; S.init(M, NINP, C.G, C.bid);
          pg8::EpiIn E{(pg8::bf16_t*)(ws + WS_GLU), (pg8::bf16_t*)(ws + WS_PR), P.out + O_CP, P.out + O_CS, P.out + O_SP, P.out + O_SS};
          pg8::gemm_phase<pg8::EpiIn, pg8::StaticOrder, PG8_ALIGN, PG8_SP2>(lds, g, S, E); }
        { pg8::Gemm g{(const pg8::bf16_t*)(ws + WS_MB), (const pg8::bf16_t*)(ws + WS_WKV), 1024, 4096, D, D}; pg8::StaticOrder S; S.init(1024, 4096, C.G, (C.bid + C.G - 24) % C.G);
          pg8::EpiKV E{P.out + O_MK, P.out + O_MV, (pg8::bf16_t*)(ws + WS_KB), (pg8::bf16_t*)(ws + WS_VT)};
          pg8::gemm_phase<pg8::EpiKV, pg8::StaticOrder, PG8_ALIGN, PG8_SP2>(lds, g, S, E); }
    }
    SEAM(1);
    for (int rep_ = 0; rep_ < NREP(2); ++rep_) if (IN(2)) { PH_CTX();
        {   int cs = C.bid, cst = C.G, cn = (640 - C.bid + C.G - 1) / C.G;
            if (C.G == 256) { if (C.bid < 112) { cst = 112; cn = 4; } else { cs = 448 + (C.bid - 112); cst = 144; cn = (cs + 144 < 640) ? 2 : 1; } }
            SUBREP(0) for (int i = 0; i < cn; ++i) { const int tk = cs + i * cst;
                if (tk < 512) { const int b = tk >> 7, r0 = (tk & 127) * 16; conv_task<16>(P, C, lds, b * SEQ + r0, r0, -1); }
                else { const int sb = tk - 512; conv_task<8>(P, C, lds, MP + 8 * sb, 0, sb); } } }
        SUBREP(1) for (int tk = (C.G == 256 ? C.bid - 112 : C.bid); tk < 144; tk += C.G) if (tk >= 0) prep_task<8>(P, C, lds, tk >> 1, (tk & 1) * 8);
    }
    SEAM(2);
    for (int rep_ = 0; rep_ < NREP(3); ++rep_) if (IN(3)) { PH_CTX();
        const float* swkv = inp(P, I_SWKV);
        SUBREP(2) for (int tk = C.bid; tk < 256; tk += C.G) scan_prompt(P, C, lds, tk >> 2, tk & 3, C.G == 256 && sr_ == 0);
        { const int nsw = C.G * 4, per = (SEQ / TC + 2) / 5; const int done_upto = (C.G == 256 ? nsw * per : 0);
          for (int it = done_upto + C.gw; it < NDEF; it += C.NGW) { const DefItem di = def_item(P, ws, it); transpose_item(di.W, di.K, di.N, di.WT, di.kb, di.jb, C.lane, MapId()); } }
        SUBREP(3) for (int tk = C.bid; tk < 4096; tk += C.G) scan_sample(P, C, swkv, tk >> 1, tk & 1);
    }
    SEAM(3);
    for (int rep_ = 0; rep_ < NREP(4); ++rep_) if (IN(4)) { PH_CTX(); for (int m = C.gw; m < M; m += C.NGW) post_row(P, m, C.lane); }
    SEAM(4);
    for (int rep_ = 0; rep_ < NREP(5); ++rep_) if (IN(5)) { PH_CTX();
        { pg8::Gemm g{(const pg8::bf16_t*)(ws + WS_A2), (const pg8::bf16_t*)(ws + WS_WOUT), MP, D, D, D}; pg8::StaticOrder S; S.init(MP, D, C.G, C.bid);
          pg8::EpiF32 E{(float*)(ws + WS_MIX), D, 0}; pg8::gemm_phase<pg8::EpiF32, pg8::StaticOrder, PG8_ALIGN, PG8_SP2>(lds, g, S, E); }
        { pg8::Gemm g{(const pg8::bf16_t*)(ws + WS_A2) + (size_t)MP * D, (const pg8::bf16_t*)(ws + WS_WOUT), MS, D, D / 8, D}; pg8::SplitOrder S; S.init(MS, D, 8, C.G, C.bid);
          pg8::EpiF32 E{(float*)(ws + WS_SLAB), D, SLAB_F}; pg8::gemm_phase<pg8::EpiF32, pg8::SplitOrder, PG8_ALIGN, PG8_SP2>(lds, g, S, E); } }
    SEAM(5);
    for (int rep_ = 0; rep_ < NREP(6); ++rep_) if (IN(6)) { PH_CTX(); const float* xp = inp(P, I_XP); const float* xs = inp(P, I_XS); const float* g1 = inp(P, I_NMIXPOST); const float* g2 = inp(P, I_NXAPRE);
        for (int m = C.gw; m < M; m += C.NGW) { const float* xr = m < MP ? xp + (size_t)m * D : xs + (size_t)(m - MP) * D;
        const float* mx = m < MP ? (const float*)(ws + WS_MIX) + (size_t)m * D : (const float*)(ws + WS_SLAB) + (size_t)(m - MP) * D;
        rowpass(xr, mx, m < MP ? 1 : 8, g1, (float*)(ws + WS_X1) + (size_t)m * D, g2, (bf16*)(ws + WS_HB) + (size_t)m * D, C.lane); } }
    SEAM(6);
    for (int rep_ = 0; rep_ < NREP(7); ++rep_) if (IN(7)) { PH_CTX();
        { pg8::Gemm g{(const pg8::bf16_t*)(ws + WS_HB), (const pg8::bf16_t*)(ws + WS_WQ), MP, D, D, D}; pg8::StaticOrder S; S.init(MP, D, C.G, C.bid);
          pg8::EpiBf16S E{(pg8::bf16_t*)(ws + WS_Q), D, 0.06375871479f  , nullptr};
          pg8::gemm_phase<pg8::EpiBf16S, pg8::StaticOrder, PG8_ALIGN, PG8_SP2>(lds, g, S, E); }
        { pg8::Gemm g{(const pg8::bf16_t*)(ws + WS_HB) + (size_t)MP * D, (const pg8::bf16_t*)(ws + WS_WQ), MS, D, D / 8, D}; pg8::SplitOrder S; S.init(MS, D, 8, C.G, C.bid);
          pg8::EpiF32 E{(float*)(ws + WS_SLAB), D, SLAB_F}; pg8::gemm_phase<pg8::EpiF32, pg8::SplitOrder, PG8_ALIGN, PG8_SP2>(lds, g, S, E); } }
    SEAM(7);
    for (int rep_ = 0; rep_ < NREP(8); ++rep_) if (IN(8)) { PH_CTX();
        SUBREP(4) for (int tk = C.bid; tk < 256; tk += C.G) attn_prompt_task(P, C, lds, tk >> 6, (tk >> 4) & 3, tk & 15);
        SUBREP(5) for (int tk = C.bid; tk < 512; tk += C.G) attn_sample_task(P, C, lds, tk >> 2, tk & 3);
    }
    SEAM(8);
    for (int rep_ = 0; rep_ < NREP(9); ++rep_) if (IN(9)) { PH_CTX();
        { pg8::Gemm g{(const pg8::bf16_t*)(ws + WS_O), (const pg8::bf16_t*)(ws + WS_WO), MP, D, D, D}; pg8::StaticOrder S; S.init(MP, D, C.G, C.bid);
          pg8::EpiF32 E{(float*)(ws + WS_MIX), D, 0}; pg8::gemm_phase<pg8::EpiF32, pg8::StaticOrder, PG8_ALIGN, PG8_SP2>(lds, g, S, E); }
        { pg8::Gemm g{(const pg8::bf16_t*)(ws + WS_O) + (size_t)MP * D, (const pg8::bf16_t*)(ws + WS_WO), MS, D, D / 8, D}; pg8::SplitOrder S; S.init(MS, D, 8, C.G, C.bid);
          pg8::EpiF32 E{(float*)(ws + WS_SLAB), D, SLAB_F}; pg8::gemm_phase<pg8::EpiF32, pg8::SplitOrder, PG8_ALIGN, PG8_SP2>(lds, g, S, E); } }
    SEAM(9);
    for (int rep_ = 0; rep_ < NREP(10); ++rep_) if (IN(10)) { PH_CTX(); const float* g1 = inp(P, I_NXAPOST); const float* g2 = inp(P, I_NFFNPRE);
        for (int m = C.gw; m < M; m += C.NGW) { float* x1 = (float*)(ws + WS_X1) + (size_t)m * D;
        const float* mx = m < MP ? (const float*)(ws + WS_MIX) + (size_t)m * D : (const float*)(ws + WS_SLAB) + (size_t)(m - MP) * D;
        rowpass(x1, mx, m < MP ? 1 : 8, g1, x1, g2, (bf16*)(ws + WS_HB) + (size_t)m * D, C.lane); } }
    SEAM(10);
    for (int rep_ = 0; rep_ < NREP(11); ++rep_) if (IN(11)) { PH_CTX(); pg8::Gemm g{(const pg8::bf16_t*)(ws + WS_HB), (const pg8::bf16_t*)(ws + WS_WUP), M, DFF2, D, D}; pg8::StaticOrder S; S.init(M, DFF2, C.G, C.bid);
        pg8::EpiBf16S E{(pg8::bf16_t*)(ws + WS_UP), DFF2, 1.0f, P.out + O_FP};
        pg8::gemm_phase<pg8::EpiBf16S, pg8::StaticOrder, PG8_ALIGN, PG8_SP2>(lds, g, S, E); }
    SEAM(11);
    for (int rep_ = 0; rep_ < NREP(12); ++rep_) if (IN(12)) { PH_CTX(); ffn_conv_act(P, C); }
    SEAM(12);
    for (int rep_ = 0; rep_ < NREP(13); ++rep_) if (IN(13)) { PH_CTX();
        { pg8::Gemm g{(const pg8::bf16_t*)(ws + WS_ACT), (const pg8::bf16_t*)(ws + WS_WDN), MP, D, DFF, DFF}; pg8::StaticOrder S; S.init(MP, D, C.G, C.bid);
          pg8::EpiF32 E{(float*)(ws + WS_MIX), D, 0}; pg8::gemm_phase<pg8::EpiF32, pg8::StaticOrder, PG8_ALIGN, PG8_SP2>(lds, g, S, E); }
        { pg8::Gemm g{(const pg8::bf16_t*)(ws + WS_ACT) + (size_t)MP * DFF, (const pg8::bf16_t*)(ws + WS_WDN), MS, D, DFF / 4, DFF}; pg8::SplitOrder S; S.init(MS, D, 4, C.G, (C.bid + 128) % C.G);
          pg8::EpiF32 E{(float*)(ws + WS_SLAB), D, SLAB_F}; pg8::gemm_phase<pg8::EpiF32, pg8::SplitOrder, PG8_ALIGN, PG8_SP2>(lds, g, S, E); } }
    SEAM(13);
    for (int rep_ = 0; rep_ < NREP(14); ++rep_) if (IN(14)) { PH_CTX(); const float* g1 = inp(P, I_NFFNPOST);
        for (int m = C.gw; m < M; m += C.NGW) { const float* x2 = (const float*)(ws + WS_X1) + (size_t)m * D;
        float* yo = m < MP ? P.out + O_YP + (size_t)m * D : P.out + O_YS + (size_t)(m - MP) * D;
        const float* mx = m < MP ? (const float*)(ws + WS_MIX) + (size_t)m * D : (const float*)(ws + WS_SLAB) + (size_t)(m - MP) * D;
        rowpass(x2, mx, m < MP ? 1 : 4, g1, yo, nullptr, nullptr, C.lane); } }
#undef IN
#undef SEAM
}

#ifndef MK_ONE_LAUNCH
#define MK_ONE_LAUNCH 1
#endif
extern "C" void kernel_launch(void* const* d_in, const int* in_sizes, int n_in, void* d_out, int out_size, void* d_ws, size_t ws_size, hipStream_t stream) {
    static int grid = 0;
    if (grid == 0) {
        if (n_in != N_IN || (size_t)out_size != O_END || ws_size < WS_END) { fprintf(stderr, "kernel_launch: unexpected sizes: n_in %d out %d ws %zu (need %zu)\n", n_in, out_size, ws_size, (size_t)WS_END); grid = -1; return; }
        int dev = 0, cus = 0, per_cu = 0;
        (void)hipGetDevice(&dev); (void)hipDeviceGetAttribute(&cus, hipDeviceAttributeMultiprocessorCount, dev);
        (void)hipFuncSetAttribute((const void*)mega<(MK_ONE_LAUNCH != 0)>, hipFuncAttributeMaxDynamicSharedMemorySize, LDS_BYTES);
        (void)hipOccupancyMaxActiveBlocksPerMultiprocessor(&per_cu, (const void*)mega<(MK_ONE_LAUNCH != 0)>, NT, LDS_BYTES);
        fprintf(stderr, "kernel_launch: cus %d, occupancy query %d block(s)/CU, ws %zu MiB\n", cus, per_cu, ws_size >> 20);
        (void)hipGetLastError();
        grid = cus;
        if (per_cu < 1) { fprintf(stderr, "kernel_launch: occupancy query says 0 blocks per CU\n"); }
    }
    if (grid < 0) return;
    if (hipMemsetAsync(d_ws, 0, 16384, stream) != hipSuccess) { fprintf(stderr, "kernel_launch: hipMemsetAsync failed\n"); return; }
    Params p{};
    for (int i = 0; i < N_IN; ++i) p.in[i] = (const float*)d_in[i];
    p.out = (float*)d_out; p.ws = (unsigned char*)d_ws;
#if MK_ONE_LAUNCH
    p.ph_lo = 0; p.ph_hi = NPHASE;
    void* args[] = {&p};
    hipError_t e = hipLaunchCooperativeKernel((const void*)mega<true>, dim3(grid), dim3(NT), args, LDS_BYTES, stream);
    if (e != hipSuccess) fprintf(stderr, "cooperative launch failed: %s (grid %d)\n", hipGetErrorString(e), grid);
#else
    for (int ph = 0; ph < NPHASE; ++ph) { p.ph_lo = ph; p.ph_hi = ph + 1; hipLaunchKernelGGL((mega<false>), dim3(grid), dim3(NT), LDS_BYTES, stream, p); }
#endif
}
```

```cpp
#include <hip/hip_runtime.h>
#include <hip/hip_cooperative_groups.h>
#include <cstdio>
#include <cstdint>
namespace cg = cooperative_groups;
constexpr int D = 2048, MP = 8192, MS = 1024, M = MP + MS, SEQ = 2048, TS = 8, NBP = 4, NBS = 128;
constexpr int CC = 1024, CW = 31, RW = 1024, RH = 16, HD = 64;
constexpr int NRC = 3520, NRCP = 3584, NINP = 5632;
constexpr int NMEM = 256, XH = 4, XD = 512, DFF = 5632, DFF2 = 11264;
namespace pg8 {
#define PG8_LAS __attribute__((address_space(3)))
typedef unsigned short bf16_t;
typedef short bf16x8 __attribute__((ext_vector_type(8)));
typedef float f32x4 __attribute__((ext_vector_type(4)));
typedef unsigned u32x4 __attribute__((ext_vector_type(4)));
constexpr int BM = 256, BK = 64, HALF = 128, HTB = HALF * BK * 2  , STAGE_BYTES = 8 * HTB, NXCD = 8, WGM = 8;

__host__ __device__ __forceinline__ int lds_byte(int r, int c) { const int st = (r >> 4) * 2 + (c >> 5), rr = r & 15, cc = c & 31, ob = rr * 64 + cc * 2; return st * 1024 + (ob ^ (((ob >> 9) & 1) << 5)); }
__host__ __device__ __forceinline__ void stage_rc(int b, int& R, int& C) { const int st = b / 1024, sb = b % 1024, swz = sb ^ (((sb >> 9) & 1) << 5); R = (st >> 1) * 16 + swz / 64; C = (st & 1) * 32 + (swz % 64) / 2; }
__host__ __device__ __forceinline__ int perm32(int rho) { const int n = rho >> 4, i = rho & 15; return 8 * (i >> 2) + 4 * n + (i & 3); }

struct Unit { int pm, pn, ks; };
struct Gemm { const bf16_t* A; const bf16_t* Bt; int M, N, K, ld; };

struct StaticOrder {
    int nM, nN, nwg, G, c;
    __host__ __device__ void init(int M, int N, int G_, int c_) { nM = M / BM; nN = N / BM; nwg = nM * nN; G = G_; c = c_; }
    __host__ __device__ bool next(int i, Unit& u) const {
        const long L = (long)i * G + c; if (L >= nwg) return false;
        int wgid = (int)L; { const int q = nwg / NXCD, r = nwg % NXCD, xcd = wgid % NXCD, off = wgid / NXCD; wgid = (xcd < r ? xcd * (q + 1) : r * (q + 1) + (xcd - r) * q) + off; }
        const int nig = WGM * nN, gid = wgid / nig, fm = gid * WGM, gsz = (nM - fm) < WGM ? (nM - fm) : WGM;
        u.pm = fm + ((wgid % nig) % gsz); u.pn = (wgid % nig) / gsz; u.ks = 0; return true;
    }
    __device__ __forceinline__ void a_ready(const Unit&) const {}
    __device__ __forceinline__ void done(const Unit&) const {}
};

struct SplitOrder {
    int nN, nsplit, nitems, G, c;
    __host__ __device__ void init(int M, int N, int nsplit_, int G_, int c_) { nN = N / BM; nsplit = nsplit_; nitems = (M / BM) * nN * nsplit_; G = G_; c = c_; }
    __host__ __device__ bool next(int i, Unit& u) const { const int L = i * G + c; if (L >= nitems) return false; u.ks = L % nsplit; const int t = L / nsplit; u.pn = t % nN; u.pm = t / nN; return true; }
    __device__ __forceinline__ void a_ready(const Unit&) const {}
    __device__ __forceinline__ void done(const Unit&) const {}
};
__device__ __forceinline__ unsigned cvt_pk_bf16(float lo, float hi) { unsigned r; asm volatile("v_cvt_pk_bf16_f32 %0, %1, %2" : "=v"(r) : "v"(lo), "v"(hi)); return r; }
typedef float f32x2 __attribute__((ext_vector_type(2)));
typedef unsigned u32x2 __attribute__((ext_vector_type(2)));
struct EpiIn {
    static constexpr bool PERM = true, AFTER_DRAIN = false;
    bf16_t* glu; bf16_t* pr; float* oconv_p; float* oconv_s; float* oshift_p; float* oshift_s;
    __device__ __forceinline__ void operator()(const f32x4 (&acc)[2][2][4][2], const Unit& u, int wr, int wc, int fr, int fq) const {
        const int row0 = u.pm * BM + wr * 64 + fr;
        if (u.pn < 8) {
#pragma unroll
            for (int ai = 0; ai < 2; ++ai)
#pragma unroll
                for (int m = 0; m < 4; ++m) {
                    const int row = row0 + ai * HALF + m * 16;
                    float* cdst = nullptr;
                    if (row < MP) { const int t = row & (SEQ - 1); if (t >= SEQ - 30) cdst = oconv_p + (size_t)((row >> 11) * 30 + (t - (SEQ - 30))) * CC; }
                    else { const int rs = row - MP; cdst = oconv_s + (size_t)((rs >> 3) * 30 + 22 + (rs & 7)) * CC; }
#pragma unroll
                    for (int bj = 0; bj < 2; ++bj) {
                        const int cgl = 16 * (8 * u.pn + 4 * bj + wc) + 4 * fq;
                        const f32x4 a = acc[ai][bj][m][0], g = acc[ai][bj][m][1];
                        f32x4 v;
#pragma unroll
                        for (int e = 0; e < 4; ++e) v[e] = a[e] / (1.0f + __expf(-g[e]));
                        u32x2 w; w.x = cvt_pk_bf16(v[0], v[1]); w.y = cvt_pk_bf16(v[2], v[3]);
                        *(u32x2*)(glu + (size_t)row * CC + cgl) = w;
                        if (cdst) *(f32x4*)(cdst + cgl) = v;
                    }
                }
        } else {
#pragma unroll
            for (int ai = 0; ai < 2; ++ai)
#pragma unroll
                for (int m = 0; m < 4; ++m) {
                    const int row = row0 + ai * HALF + m * 16;
                    float* sdst = nullptr;
                    if (row < MP) { if ((row & (SEQ - 1)) == SEQ - 1) sdst = oshift_p + (size_t)(row >> 11) * NRC; }
                    else { const int rs = row - MP; if ((rs & 7) == 7) sdst = oshift_s + (size_t)(rs >> 3) * NRC; }
#pragma unroll
                    for (int bj = 0; bj < 2; ++bj) {
                        const int jj0 = 256 * (u.pn - 8) + 128 * bj + 32 * wc + 8 * fq;
                        const f32x4 v0 = acc[ai][bj][m][0], v1 = acc[ai][bj][m][1];
                        u32x4 w; w.x = cvt_pk_bf16(v0[0], v0[1]); w.y = cvt_pk_bf16(v0[2], v0[3]); w.z = cvt_pk_bf16(v1[0], v1[1]); w.w = cvt_pk_bf16(v1[2], v1[3]);
                        *(u32x4*)(pr + (size_t)row * NRCP + jj0) = w;
                        if (sdst && jj0 < NRC) { *(f32x4*)(sdst + jj0) = v0; *(f32x4*)(sdst + jj0 + 4) = v1; }
                    }
                }
        }
    }
};
struct EpiKV {
    static constexpr bool PERM = false, AFTER_DRAIN = false;
    float* ok; float* ov; bf16_t* kb; bf16_t* vt;
    __device__ __forceinline__ void operator()(const f32x4 (&acc)[2][2][4][2], const Unit& u, int wr, int wc, int fr, int fq) const {
        const int row0 = u.pm * BM + wr * 64 + fr;
#pragma unroll
        for (int ai = 0; ai < 2; ++ai)
#pragma unroll
            for (int m = 0; m < 4; ++m) {
                const int r = row0 + ai * HALF + m * 16;
#pragma unroll
                for (int bj = 0; bj < 2; ++bj)
#pragma unroll
                    for (int n = 0; n < 2; ++n) {
                        const int c = 256 * u.pn + 128 * bj + 32 * wc + 16 * n + 4 * fq;
                        const f32x4 v = acc[ai][bj][m][n];
                        if (u.pn < 8) {
                            *(f32x4*)(ok + (size_t)r * 2048 + c) = v;
                            u32x2 w; w.x = cvt_pk_bf16(v[0], v[1]); w.y = cvt_pk_bf16(v[2], v[3]);
                            *(u32x2*)(kb + (size_t)r * 2048 + c) = w;
                        } else {
                            const int cv = c - 2048;
                            *(f32x4*)(ov + (size_t)r * 2048 + cv) = v;
                            const int b = r >> 8, key = r & 255, h = cv >> 9, d = cv & 511;
                            bf16_t* dst = vt + ((size_t)((b * 4 + h) * 512 + d)) * 256 + key;
                            const unsigned w0 = cvt_pk_bf16(v[0], v[1]), w1 = cvt_pk_bf16(v[2], v[3]);
                            dst[0] = (bf16_t)(w0 & 0xffffu); dst[256] = (bf16_t)(w0 >> 16); dst[512] = (bf16_t)(w1 & 0xffffu); dst[768] = (bf16_t)(w1 >> 16);
                        }
                    }
            }
    }
};
struct EpiF32 {
    static constexpr bool PERM = false, AFTER_DRAIN = false;
    float* C; int ldc; size_t slab;
    __device__ __forceinline__ void operator()(const f32x4 (&acc)[2][2][4][2], const Unit& u, int wr, int wc, int fr, int fq) const {
        const int row0 = u.pm * BM + wr * 64 + fr, col0 = u.pn * BM + wc * 32 + 4 * fq;
#pragma unroll
        for (int ai = 0; ai < 2; ++ai)
#pragma unroll
            for (int m = 0; m < 4; ++m) { float* rowp = C + (size_t)u.ks * slab + (size_t)(row0 + ai * HALF + m * 16) * ldc + col0;
#pragma unroll
                for (int bj = 0; bj < 2; ++bj)
#pragma unroll
                    for (int n = 0; n < 2; ++n) *(f32x4*)(rowp + bj * HALF + n * 16) = acc[ai][bj][m][n]; }
    }
};
struct EpiBf16S {
    static constexpr bool PERM = true, AFTER_DRAIN = false;
    bf16_t* O; int ldc; float scale; float* f;
    __device__ __forceinline__ void operator()(const f32x4 (&acc)[2][2][4][2], const Unit& u, int wr, int wc, int fr, int fq) const {
        const int row0 = u.pm * BM + wr * 64 + fr, col0 = u.pn * BM + wc * 32 + 8 * fq;
#pragma unroll
        for (int ai = 0; ai < 2; ++ai)
#pragma unroll
            for (int m = 0; m < 4; ++m) {
                const int row = row0 + ai * HALF + m * 16;
                long foff = -1;
                if (f) {
                    if (row < MP) { const int t = row & (SEQ - 1); if (t >= SEQ - 2) foff = (long)((row >> 11) * 2 + (t - (SEQ - 2))) * DFF2; }
                    else { const int rs = row - MP, t = rs & 7; if (t >= 6) foff = (long)(NBP * 2 + (rs >> 3) * 2 + (t - 6)) * DFF2; }
                }
                float* fdst = f + (foff < 0 ? 0 : foff);
                bf16_t* rowp = O + (size_t)row * ldc + col0;
#pragma unroll
                for (int bj = 0; bj < 2; ++bj) {
                    const f32x4 v0 = acc[ai][bj][m][0] * scale, v1 = acc[ai][bj][m][1] * scale;
                    u32x4 w; w.x = cvt_pk_bf16(v0[0], v0[1]); w.y = cvt_pk_bf16(v0[2], v0[3]); w.z = cvt_pk_bf16(v1[0], v1[1]); w.w = cvt_pk_bf16(v1[2], v1[3]);
                    *(u32x4*)(rowp + bj * HALF) = w;
                    if (foff >= 0) { *(f32x4*)(fdst + col0 + bj * HALF) = v0; *(f32x4*)(fdst + col0 + bj * HALF + 4) = v1; }
                }
            }
    }
};

template <class Epi, class Sched, bool ALIGN_EPI = false, bool SP2 = false>
__device__ __forceinline__ void gemm_phase(PG8_LAS unsigned char* lds, const Gemm g, const Sched& S, const Epi& E) {
    int tid_ = threadIdx.x; asm volatile("" : "+v"(tid_));
    const int tid = tid_, wid = __builtin_amdgcn_readfirstlane(tid >> 6), lane = tid & 63, wr = wid >> 2, wc = wid & 3, fr = lane & 15, fq = lane >> 4;
    const int K = g.K, nt = K / BK;
    unsigned voffA[2], voffB[2];
#pragma unroll
    for (int i = 0; i < 2; ++i) { int R, C; stage_rc(tid * 16 + i * 8192, R, C); const int Rb = Epi::PERM ? ((R & ~31) + perm32(R & 31)) : R;
        voffA[i] = (unsigned)(R * g.ld + C) * 2u; voffB[i] = (unsigned)(Rb * g.ld + C) * 2u; }
    const size_t kstep = (size_t)(BK * 2);
    const size_t hstep = (size_t)HALF * g.ld * 2;
    const size_t tstep = 2 * hstep;
    const unsigned ldsw = (unsigned)wid * 1024u;
    const int aoff = lds_byte(wr * 64 + fr, fq * 8), boff = lds_byte(wc * 32 + fr, fq * 8);
#define PG8_SA(b, h) (((b) * 2 + (h)) * HTB)
#define PG8_SB(b, h) ((4 + (b) * 2 + (h)) * HTB)
#define PG8_STAGE(bufoff, gbase, voff) do { _Pragma("unroll") for (int _i = 0; _i < 2; ++_i) \
        __builtin_amdgcn_global_load_lds((const unsigned*)((const char*)(gbase) + (voff)[_i]), (PG8_LAS unsigned*)(lds + (bufoff) + ldsw + _i * 8192), 16, 0, 0); } while (0)
#define PG8_LDA(dst, b, h) do { _Pragma("unroll") for (int m = 0; m < 4; ++m) _Pragma("unroll") for (int k = 0; k < 2; ++k) dst[m][k] = *(const PG8_LAS bf16x8*)(lds + PG8_SA(b, h) + aoff + m * 2048 + k * 1024); } while (0)
#define PG8_LDB(dst, b, h) do { _Pragma("unroll") for (int n = 0; n < 2; ++n) _Pragma("unroll") for (int k = 0; k < 2; ++k) dst[n][k] = *(const PG8_LAS bf16x8*)(lds + PG8_SB(b, h) + boff + n * 2048 + k * 1024); } while (0)
#define PG8_MMA(ai, bj, At, Bt) do { __builtin_amdgcn_s_setprio(1); _Pragma("unroll") for (int m = 0; m < 4; ++m) _Pragma("unroll") for (int n = 0; n < 2; ++n) _Pragma("unroll") for (int k = 0; k < 2; ++k) \
        acc[ai][bj][m][n] = __builtin_amdgcn_mfma_f32_16x16x32_bf16(Bt[n][k], At[m][k], acc[ai][bj][m][n], 0, 0, 0); __builtin_amdgcn_s_setprio(0); } while (0)
#define PG8_WAIT_V(n) asm volatile("s_waitcnt vmcnt(" #n ")" ::: "memory")
#define PG8_WAIT_L(n) asm volatile("s_waitcnt lgkmcnt(" #n ")" ::: "memory")
#define PG8_BAR __builtin_amdgcn_s_barrier()
#define PG8_SCHED __builtin_amdgcn_sched_barrier(0)
    Unit cur, nxt; int ui = 0;
    if (!S.next(0, cur)) return;
    f32x4 acc[2][2][4][2];
#pragma unroll
    for (int a = 0; a < 2; ++a)
#pragma unroll
        for (int b = 0; b < 2; ++b)
#pragma unroll
            for (int m = 0; m < 4; ++m)
#pragma unroll
                for (int n = 0; n < 2; ++n) acc[a][b][m][n] = (f32x4){0.f, 0.f, 0.f, 0.f};
    bf16x8 At[4][2], B0[2][2], B1[2][2];
    const size_t sstep = (size_t)K * 2;
    const char* cA = (const char*)g.A + (size_t)cur.pm * tstep + (size_t)cur.ks * sstep; const char* cB = (const char*)g.Bt + (size_t)cur.pn * tstep + (size_t)cur.ks * sstep;
    S.a_ready(cur);
    if constexpr (SP2) {
        PG8_STAGE(PG8_SB(0, 0), cB, voffB); PG8_STAGE(PG8_SB(0, 1), cB + hstep, voffB); PG8_STAGE(PG8_SA(0, 0), cA, voffA); PG8_STAGE(PG8_SA(0, 1), cA + hstep, voffA);
        if (wr == 1) PG8_BAR;
        PG8_WAIT_V(2); PG8_BAR;
        PG8_STAGE(PG8_SB(1, 0), cB + kstep, voffB); PG8_STAGE(PG8_SA(1, 0), cA + kstep, voffA); PG8_STAGE(PG8_SB(1, 1), cB + hstep + kstep, voffB);
        PG8_WAIT_V(6); PG8_BAR;
    } else {
        PG8_STAGE(PG8_SB(0, 0), cB, voffB); PG8_STAGE(PG8_SA(0, 0), cA, voffA); PG8_STAGE(PG8_SB(0, 1), cB + hstep, voffB); PG8_STAGE(PG8_SA(0, 1), cA + hstep, voffA);
        if (wr == 1) PG8_BAR;
        PG8_WAIT_V(4); PG8_BAR;
        PG8_STAGE(PG8_SB(1, 0), cB + kstep, voffB); PG8_STAGE(PG8_SA(1, 0), cA + kstep, voffA); PG8_STAGE(PG8_SB(1, 1), cB + hstep + kstep, voffB);
        PG8_WAIT_V(6); PG8_BAR;
    }
    for (;;) {
        const bool has_next = S.next(ui + 1, nxt);
        const char* nA = has_next ? (const char*)g.A + (size_t)nxt.pm * tstep + (size_t)nxt.ks * sstep : cA; const char* nB = has_next ? (const char*)g.Bt + (size_t)nxt.pn * tstep + (size_t)nxt.ks * sstep : cB;
        for (int t = 0; t < nt; t += 2) {
            const bool last = (t == nt - 2);
            const char* a1 = cA + (size_t)(t + 1) * kstep;
            const char* a2 = last ? nA : cA + (size_t)(t + 2) * kstep; const char* b2 = last ? nB : cB + (size_t)(t + 2) * kstep;
            const char* a3 = a2 + kstep; const char* b3 = b2 + kstep;
            if (last && has_next) S.a_ready(nxt);
            if constexpr (SP2) {
            PG8_LDB(B0, 0, 0); PG8_LDB(B1, 0, 1); PG8_SCHED; PG8_LDA(At, 0, 0); PG8_STAGE(PG8_SA(1, 1), a1 + hstep, voffA);
            PG8_WAIT_V(8); PG8_WAIT_L(0); PG8_BAR; PG8_MMA(0, 0, At, B0); PG8_MMA(0, 1, At, B1); PG8_BAR; PG8_SCHED;
            PG8_LDA(At, 0, 1); PG8_STAGE(PG8_SB(0, 0), b2, voffB); PG8_STAGE(PG8_SB(0, 1), b2 + hstep, voffB); PG8_STAGE(PG8_SA(0, 0), a2, voffA);
            PG8_WAIT_V(8); PG8_WAIT_L(0); PG8_BAR; PG8_MMA(1, 0, At, B0); PG8_MMA(1, 1, At, B1); PG8_BAR; PG8_SCHED;
            PG8_LDB(B0, 1, 0); PG8_LDB(B1, 1, 1); PG8_SCHED; PG8_LDA(At, 1, 0); PG8_STAGE(PG8_SA(0, 1), a2 + hstep, voffA);
            PG8_WAIT_V(8); PG8_WAIT_L(0); PG8_BAR; PG8_MMA(0, 0, At, B0); PG8_MMA(0, 1, At, B1); PG8_BAR; PG8_SCHED;
            PG8_LDA(At, 1, 1); PG8_STAGE(PG8_SB(1, 0), b3, voffB); PG8_STAGE(PG8_SB(1, 1), b3 + hstep, voffB); PG8_STAGE(PG8_SA(1, 0), a3, voffA);
            PG8_WAIT_V(8); PG8_WAIT_L(0); PG8_BAR; PG8_MMA(1, 0, At, B0); PG8_MMA(1, 1, At, B1); PG8_BAR; PG8_SCHED;
            } else {
            PG8_LDB(B0, 0, 0); PG8_SCHED; PG8_LDA(At, 0, 0); PG8_STAGE(PG8_SA(1, 1), a1 + hstep, voffA);
            PG8_WAIT_L(8); PG8_BAR; PG8_WAIT_L(0); PG8_MMA(0, 0, At, B0); PG8_BAR; PG8_SCHED;
            PG8_LDB(B1, 0, 1); PG8_STAGE(PG8_SB(0, 0), b2, voffB);
            PG8_BAR; PG8_WAIT_L(0); PG8_MMA(0, 1, At, B1); PG8_BAR;
            PG8_LDA(At, 0, 1); PG8_STAGE(PG8_SA(0, 0), a2, voffA);
            PG8_BAR; PG8_WAIT_L(0); PG8_MMA(1, 0, At, B0); PG8_BAR; PG8_SCHED;
            PG8_STAGE(PG8_SB(0, 1), b2 + hstep, voffB);
            PG8_WAIT_V(6); PG8_BAR; PG8_MMA(1, 1, At, B1); PG8_BAR;
            PG8_LDB(B0, 1, 0); PG8_SCHED; PG8_LDA(At, 1, 0); PG8_STAGE(PG8_SA(0, 1), a2 + hstep, voffA);
            PG8_WAIT_L(8); PG8_BAR; PG8_WAIT_L(0); PG8_MMA(0, 0, At, B0); PG8_BAR; PG8_SCHED;
            PG8_LDB(B1, 1, 1); PG8_STAGE(PG8_SB(1, 0), b3, voffB);
            PG8_BAR; PG8_WAIT_L(0); PG8_MMA(0, 1, At, B1); PG8_BAR;
            PG8_LDA(At, 1, 1); PG8_STAGE(PG8_SA(1, 0), a3, voffA);
            PG8_BAR; PG8_WAIT_L(0); PG8_MMA(1, 0, At, B0); PG8_BAR; PG8_SCHED;
            PG8_STAGE(PG8_SB(1, 1), b3 + hstep, voffB);
            PG8_WAIT_V(6); PG8_BAR; PG8_MMA(1, 1, At, B1); PG8_BAR;
            }
        }
        if constexpr (ALIGN_EPI) { if (wr == 0) PG8_BAR; }
        if constexpr (!Epi::AFTER_DRAIN) { E(acc, cur, wr, wc, fr, fq); S.done(cur); }
        if (!has_next) break;
#pragma unroll
        for (int a = 0; a < 2; ++a)
#pragma unroll
            for (int b = 0; b < 2; ++b)
#pragma unroll
                for (int m = 0; m < 4; ++m)
#pragma unroll
                    for (int n = 0; n < 2; ++n) acc[a][b][m][n] = (f32x4){0.f, 0.f, 0.f, 0.f};
        cur = nxt; cA = nA; cB = nB; ++ui;
        if constexpr (ALIGN_EPI) { if (wr == 1) PG8_BAR; }
    }
    PG8_WAIT_V(0);
    if constexpr (!ALIGN_EPI) { if (wr == 0) PG8_BAR; }
    PG8_BAR;
    if constexpr (Epi::AFTER_DRAIN) { E.fused(acc, cur, wr, wc, fr, fq, lds, wid, lane); S.done(cur); }
#undef PG8_SA
#undef PG8_SB
#undef PG8_STAGE
#undef PG8_LDA
#undef PG8_LDB
#undef PG8_MMA
#undef PG8_WAIT_V
#undef PG8_WAIT_L
#undef PG8_BAR
#undef PG8_SCHED
}
}
#ifndef PG8_SP2
#define PG8_SP2 true
#endif
#ifndef PG8_ALIGN
#define PG8_ALIGN true
#endif
#define LAS __attribute__((address_space(3)))
typedef unsigned short bf16;
typedef unsigned v4u __attribute__((ext_vector_type(4)));
typedef unsigned v2u __attribute__((ext_vector_type(2)));
typedef float f32x4 __attribute__((ext_vector_type(4)));
typedef float f32x2 __attribute__((ext_vector_type(2)));
typedef short bf16x8 __attribute__((ext_vector_type(8)));
constexpr int NT = 512;
constexpr int LDS_BYTES = 147456;
constexpr int NPHASE = 15;

constexpr size_t MiB = 1u << 20;
constexpr size_t WS_WIN = 1 * MiB, WS_WKV = 23 * MiB, WS_WOUT = 39 * MiB, WS_WQ = 47 * MiB, WS_WO = 55 * MiB, WS_WUP = 63 * MiB, WS_WDN = 107 * MiB;
constexpr size_t WS_LW = 129 * MiB, WS_LA = 129 * MiB + 256 * 1024, WS_LG = 129 * MiB + 512 * 1024;
constexpr size_t WS_HB = 130 * MiB, WS_MB = 166 * MiB, WS_A2 = 170 * MiB, WS_MIX = 206 * MiB, WS_X1 = 278 * MiB, WS_Q = 350 * MiB, WS_O = 386 * MiB;
constexpr size_t WS_KB = 422 * MiB, WS_VT = 426 * MiB, WS_Y = 430 * MiB, WS_G = 466 * MiB, WS_BON = 502 * MiB;
constexpr size_t WS_SHB = 818 * MiB;
constexpr size_t WS_SI = 503 * MiB, SB_STRIDE = 18 * MiB;
constexpr size_t WS_SW = WS_SI + 5 * SB_STRIDE;
constexpr size_t WS_UP = 503 * MiB;
constexpr size_t WS_GLU = 719 * MiB, WS_PR = 737 * MiB;
constexpr size_t WS_ACT = 719 * MiB;
constexpr size_t WS_HIMG = 820 * MiB;
constexpr size_t WS_SLAB = 822 * MiB, SLAB_F = (size_t)MS * D;
constexpr size_t WS_END = 886 * MiB;
constexpr size_t O_YP = 0, O_YS = 16777216, O_CP = 18874368, O_CS = 18997248, O_SP = 22929408, O_SS = 22943488, O_WP = 23394048, O_WS = 23656192,
                 O_FP = 32044800, O_FS = 32134912, O_MK = 35018496, O_MV = 37115648, O_END = 39212800;

enum { I_XP = 0, I_XS, I_CK, I_CV, I_SCONV, I_SSHIFT, I_SWKV, I_SFFN, I_MEM, I_NMIXPRE, I_WIN, I_CDW, I_CDWB, I_CLNG, I_CLNB, I_MU, I_W0, I_WLORA, I_A0, I_ALORA,
       I_GLORA, I_KK, I_KA, I_RK, I_LNXG, I_LNXB, I_WOUT, I_NMIXPOST, I_NXAPRE, I_NMEM, I_WQ, I_WK, I_WV, I_WO, I_NXAPOST, I_NFFNPRE, I_WUP, I_FDW, I_FDWB, I_WDOWN,
       I_NFFNPOST, N_IN };

struct Params { const float* in[N_IN]; float* out; unsigned char* ws; int ph_lo, ph_hi; };

__device__ __forceinline__ unsigned f2bf(float f) { unsigned u = __builtin_bit_cast(unsigned, f); return (u + 0x7fffu + ((u >> 16) & 1u)) >> 16; }
__device__ __forceinline__ unsigned pk2(float lo, float hi) { return f2bf(lo) | (f2bf(hi) << 16); }
__device__ __forceinline__ float bflo(unsigned u) { return __builtin_bit_cast(float, u << 16); }
__device__ __forceinline__ float bfhi(unsigned u) { return __builtin_bit_cast(float, u & 0xffff0000u); }
__device__ __forceinline__ float wave_sum(float v) {
#pragma unroll
    for (int o = 1; o < 64; o <<= 1) v += __shfl_xor(v, o);
    return v;
}
__device__ __forceinline__ float wave_max(float v) {
#pragma unroll
    for (int o = 1; o < 64; o <<= 1) v = fmaxf(v, __shfl_xor(v, o));
    return v;
}
__device__ __forceinline__ float sigm(float x) { return 1.0f / (1.0f + __expf(-x)); }
#define LDS_WAIT() asm volatile("s_waitcnt lgkmcnt(0)" ::: "memory")

typedef __attribute__((address_space(1))) unsigned gu32;
#define XB_TMO      128
#define XB_XCNT(j)  (256  + 64 * (j))
#define XB_XSUB(j)  (1280 + 64 * (j))
#define XB_XGEN(j)  (2304 + 64 * (j))
#define XB_TOP      3328
#define XB_TOPGEN   3392
#define XCD_BAR_WORDS 3456
#define XB_SPIN_CAP (1u << 18)

__device__ __forceinline__ unsigned xb_ld(unsigned* p)              { return __hip_atomic_load(p, __ATOMIC_RELAXED, __HIP_MEMORY_SCOPE_AGENT); }
__device__ __forceinline__ unsigned xb_add(unsigned* p, unsigned v) { return __hip_atomic_fetch_add(p, v, __ATOMIC_RELAXED, __HIP_MEMORY_SCOPE_AGENT); }
__device__ __forceinline__ unsigned xb_xcc_id() { return (unsigned)__builtin_amdgcn_s_getreg((3 << 11) | 20) & 0xFu; }
#define XB_SPIN(cond, bar) do { unsigned _sp = 0; while (cond) { __builtin_amdgcn_s_sleep(1); \
    if ((++_sp & 255u) == 0u) { if (xb_ld(&(bar)[XB_TMO])) break; if (_sp > XB_SPIN_CAP) { atomicAdd(&(bar)[XB_TMO], 1u); break; } } } } while (0)

struct XcdBarrier {
    unsigned* bar; unsigned x;
    volatile LAS unsigned* st;
};

__device__ __forceinline__ XcdBarrier xcd_barrier_post(unsigned* bar, volatile LAS unsigned* st) {
    XcdBarrier b; b.bar = bar; b.x = xb_xcc_id(); b.st = st;
    if (threadIdx.x == 0) (void)xb_add(&bar[XB_XCNT(b.x)], 1u);
    return b;
}
__device__ __forceinline__ void xcd_barrier_complete(unsigned* bar, unsigned x, unsigned& nloc, unsigned& nx) {
    const unsigned G = gridDim.x * gridDim.y * gridDim.z;
    unsigned sum, cnt, mine, sp = 0u;
    for (;;) {
        sum = 0u; cnt = 0u; mine = 0u;
#pragma unroll
        for (unsigned j = 0; j < 16; ++j) { const unsigned c = xb_ld(&bar[XB_XCNT(j)]); sum += c; cnt += (c > 0u) ? 1u : 0u; mine = (j == x) ? c : mine; }
        if (sum == G) break;
        __builtin_amdgcn_s_sleep(1);
        if ((++sp & 255u) == 0u) { if (xb_ld(&bar[XB_TMO])) break; if (sp > XB_SPIN_CAP) { atomicAdd(&bar[XB_TMO], 1u); break; } }
    }
    nloc = mine > 0u ? mine : 1u; nx = cnt > 0u ? cnt : 1u;
}

__device__ __forceinline__ void xcd_barrier(const XcdBarrier& b) {
    asm volatile("s_waitcnt vmcnt(0)" ::: "memory");
    __syncthreads();
    if (threadIdx.x == 0) {
        unsigned* bar = b.bar;
        __builtin_amdgcn_s_waitcnt(0);
        unsigned nloc = b.st[0], nx = b.st[1];
        if (nloc == 0u) { xcd_barrier_complete(bar, b.x, nloc, nx); b.st[0] = nloc; b.st[1] = nx; }
        const unsigned old = xb_add(&bar[XB_XSUB(b.x)], 1u);
        const unsigned gen = old / nloc;
        if (old + 1u == (gen + 1u) * nloc) {
            __builtin_amdgcn_fence(__ATOMIC_RELEASE, "agent");
            asm volatile("s_waitcnt vmcnt(0)" ::: "memory");
            const unsigned og = xb_add(&bar[XB_TOP], 1u);
            const unsigned tg = og / nx;
            if (og + 1u == (tg + 1u) * nx) xb_add(&bar[XB_TOPGEN], 1u);
            else XB_SPIN(xb_ld(&bar[XB_TOPGEN]) == tg, bar);
            __builtin_amdgcn_fence(__ATOMIC_ACQUIRE, "agent");
            xb_add(&bar[XB_XGEN(b.x)], 1u);
            asm volatile("s_waitcnt vmcnt(0)" ::: "memory");
        } else {
            XB_SPIN(xb_ld(&bar[XB_XGEN(b.x)]) == gen, bar);
            __builtin_amdgcn_fence(__ATOMIC_ACQUIRE, "agent");
            asm volatile("s_waitcnt vmcnt(0)" ::: "memory");
        }
    }
    __syncthreads();
}

constexpr int MISC_OFF = LDS_BYTES - 64;
struct Ctx { int tid, lane, wave, bid, G, gw, NGW; };
__device__ __forceinline__ unsigned char* wsbase(const Params& P) { const unsigned long long x = (unsigned long long)P.ws; int lo = __builtin_amdgcn_readfirstlane((int)(unsigned)x), hi = __builtin_amdgcn_readfirstlane((int)(unsigned)(x >> 32));
    asm volatile("" : "+s"(lo), "+s"(hi)); return (unsigned char*)(((unsigned long long)(unsigned)hi << 32) | (unsigned)lo); }
__device__ __forceinline__ const float* inp(const Params& P, int i) { int z; asm volatile("s_mov_b32 %0, 0" : "=s"(z)); return P.in[i + z]; }

#ifndef MK_SUBMASK
#define MK_SUBMASK 0
#endif
#define SUBREP(i) for (int sr_ = 0; sr_ < ((((MK_SUBMASK) >> (i)) & 1) ? 2 : 1); ++sr_)
template <class ColMap>
__device__ __forceinline__ void transpose_load(const float* __restrict__ W, int N, int kb, int jb, int lane, ColMap cm, f32x4 (&v)[16]) {
    const int kr = lane >> 4, l16 = lane & 15, k0 = 64 * kb + 16 * kr, j = 64 * jb + 4 * l16;
    const int sc = cm(j);
    if (sc >= 0) {
        const float* src = W + (size_t)k0 * N + sc;
#pragma unroll
        for (int q = 0; q < 16; ++q) v[q] = __builtin_nontemporal_load((const f32x4*)(src + (size_t)q * N));
    } else {
#pragma unroll
        for (int q = 0; q < 16; ++q) v[q] = (f32x4){0.f, 0.f, 0.f, 0.f};
    }
}
__device__ __forceinline__ void transpose_store(int K, bf16* __restrict__ WT, int kb, int jb, int lane, const f32x4 (&v)[16]) {
    const int kr = lane >> 4, l16 = lane & 15, k0 = 64 * kb + 16 * kr, j = 64 * jb + 4 * l16;
#pragma unroll
    for (int e = 0; e < 4; ++e) {
        bf16* dst = WT + (size_t)(j + e) * K + k0;
        v4u o0, o1;
        o0.x = pk2(v[0][e], v[1][e]); o0.y = pk2(v[2][e], v[3][e]); o0.z = pk2(v[4][e], v[5][e]); o0.w = pk2(v[6][e], v[7][e]);
        o1.x = pk2(v[8][e], v[9][e]); o1.y = pk2(v[10][e], v[11][e]); o1.z = pk2(v[12][e], v[13][e]); o1.w = pk2(v[14][e], v[15][e]);
        *(v4u*)dst = o0; *(v4u*)(dst + 8) = o1;
    }
}
template <class ColMap>
__device__ __forceinline__ void transpose_item(const float* __restrict__ W, int K, int N, bf16* __restrict__ WT, int kb, int jb, int lane, ColMap cm) {
    f32x4 v[16]; transpose_load(W, N, kb, jb, lane, cm, v); transpose_store(K, WT, kb, jb, lane, v);
}
struct MapId { __device__ __forceinline__ int operator()(int j) const { return j; } };
struct MapIn {
    __device__ __forceinline__ int operator()(int j) const {
        if (j < 2048) { const int g = j >> 5, q = (j >> 3) & 3, n = (j >> 2) & 1, e = j & 3; return n * 1024 + 16 * g + 4 * q + e; }
        const int jj = j - 2048; return jj < NRC ? 2048 + jj : -1;
    }
};
__device__ __forceinline__ void rms_row_bf16(const float* __restrict__ xrow, const float* __restrict__ g, bf16* __restrict__ orow, int lane) {
    f32x4 v[8]; float s = 0.f;
#pragma unroll
    for (int j = 0; j < 8; ++j) { v[j] = *(const f32x4*)(xrow + 4 * (lane + 64 * j)); s += (v[j][0] * v[j][0] + v[j][1] * v[j][1]) + (v[j][2] * v[j][2] + v[j][3] * v[j][3]); }
    const float r = rsqrtf(wave_sum(s) * (1.0f / 2048.0f) + 1e-6f);
#pragma unroll
    for (int j = 0; j < 8; ++j) { const f32x4 gg = *(const f32x4*)(g + 4 * (lane + 64 * j));
        v2u o; o.x = pk2(v[j][0] * r * gg[0], v[j][1] * r * gg[1]); o.y = pk2(v[j][2] * r * gg[2], v[j][3] * r * gg[3]);
        *(v2u*)(orow + 4 * (lane + 64 * j)) = o; }
}
constexpr int I_SQ_ = 32 * 32, I_UP_ = 32 * 176, I_DN_ = 88 * 32, NDEF = 3 * I_SQ_ + I_UP_ + I_DN_;
struct DefItem { const float* W; bf16* WT; int K, N, kb, jb; };
__device__ __forceinline__ DefItem def_item(const Params& P, unsigned char* ws, int r) {
    DefItem d;
    if (r < I_SQ_) { d.W = inp(P, I_WOUT); d.WT = (bf16*)(ws + WS_WOUT); d.K = 2048; d.N = 2048; d.kb = r / 32; d.jb = r % 32; return d; } r -= I_SQ_;
    if (r < I_SQ_) { d.W = inp(P, I_WQ); d.WT = (bf16*)(ws + WS_WQ); d.K = 2048; d.N = 2048; d.kb = r / 32; d.jb = r % 32; return d; } r -= I_SQ_;
    if (r < I_SQ_) { d.W = inp(P, I_WO); d.WT = (bf16*)(ws + WS_WO); d.K = 2048; d.N = 2048; d.kb = r / 32; d.jb = r % 32; return d; } r -= I_SQ_;
    if (r < I_UP_) { d.W = inp(P, I_WUP); d.WT = (bf16*)(ws + WS_WUP); d.K = 2048; d.N = 11264; d.kb = r / 176; d.jb = r % 176; return d; } r -= I_UP_;
    d.W = inp(P, I_WDOWN); d.WT = (bf16*)(ws + WS_WDN); d.K = 5632; d.N = 2048; d.kb = r / 32; d.jb = r % 32; return d;
}
__device__ __forceinline__ void p0_prologue(const Params& P, const Ctx& C, LAS unsigned char* lds) {
    unsigned char* ws = wsbase(P);
    constexpr int I_IN = 32 * 88, I_SQ = 32 * 32;
    constexpr int NITEMS = I_IN + 2 * I_SQ;
    SUBREP(6) for (int it = C.gw; it < NITEMS; it += C.NGW) {
        int r = it;
        if (r < I_IN) { transpose_item(inp(P, I_WIN), 2048, 5568, (bf16*)(ws + WS_WIN), r / 88, r % 88, C.lane, MapIn()); continue; } r -= I_IN;
        if (r < I_SQ) { transpose_item(inp(P, I_WK), 2048, 2048, (bf16*)(ws + WS_WKV), r / 32, r % 32, C.lane, MapId()); continue; } r -= I_SQ;
        transpose_item(inp(P, I_WV), 2048, 2048, (bf16*)(ws + WS_WKV) + (size_t)2048 * 2048, r / 32, r % 32, C.lane, MapId());
    }
    const int gt = C.bid * NT + C.tid, ngt = C.G * NT;
    {   const float* s_w = inp(P, I_WLORA); const float* s_a = inp(P, I_ALORA); const float* s_g = inp(P, I_GLORA);
        for (int i = gt; i < 1024 * 96; i += ngt) { const int n = i / 96, k = i - n * 96, h = n >> 6, r = n & 63;
            bf16* img = (bf16*)(ws + WS_HIMG + (size_t)h * 65536);
            img[r * 96 + k] = (bf16)f2bf(s_w[k * 1024 + n]); img[6144 + r * 96 + k] = (bf16)f2bf(s_a[k * 1024 + n]); }
        for (int i = gt; i < 1024 * 256; i += ngt) { const int n = i >> 8, k = i & 255, h = n >> 6, r = n & 63;
            bf16* img = (bf16*)(ws + WS_HIMG + (size_t)h * 65536);
            img[12288 + r * 256 + (((k >> 3) ^ (r & 15)) << 3) + (k & 7)] = (bf16)f2bf(s_g[k * 1024 + n]); }
        const float* mu = inp(P, I_MU); const float* kk = inp(P, I_KK); const float* a0 = inp(P, I_A0); const float* w0 = inp(P, I_W0); const float* ka = inp(P, I_KA); const float* rk = inp(P, I_RK);
        for (int i = gt; i < 16 * 512; i += ngt) { const int h = i >> 9, ar = (i >> 6) & 7, j = i & 63;
            const float* bp = ar == 0 ? mu : ar == 1 ? mu + 1024 : ar == 2 ? mu + 2048 : ar == 3 ? kk : ar == 4 ? a0 : ar == 5 ? w0 : ar == 6 ? ka : rk;
            ((float*)(ws + WS_HIMG + (size_t)h * 65536 + 57344))[ar * 64 + j] = bp[h * 64 + j]; }
    }
    SUBREP(7) for (int m = C.gw; m < M + 1024; m += C.NGW) {
        if (m < M) { const float* xr = m < MP ? inp(P, I_XP) + (size_t)m * D : inp(P, I_XS) + (size_t)(m - MP) * D; rms_row_bf16(xr, inp(P, I_NMIXPRE), (bf16*)(ws + WS_HB) + (size_t)m * D, C.lane); }
        else { const int r = m - M; rms_row_bf16(inp(P, I_MEM) + (size_t)r * D, inp(P, I_NMEM), (bf16*)(ws + WS_MB) + (size_t)r * D, C.lane); }
    }
    { bf16* d = (bf16*)(ws + WS_SHB); const float* sp = inp(P, I_SSHIFT);
      for (int i = gt; i < (NBS + 1) * NRCP; i += ngt) { const int b = i / NRCP, c = i - b * NRCP; d[i] = (b < NBS && c < NRC) ? (bf16)f2bf(sp[(size_t)b * NRC + c]) : (bf16)0; } }
    { const f32x4* s = (const f32x4*)inp(P, I_SCONV); f32x4* d = (f32x4*)(P.out + O_CS);
      for (int i = gt; i < NBS * 22 * 256; i += ngt) { const int b = i / (22 * 256), r = i - b * (22 * 256); d[(size_t)b * 30 * 256 + r] = s[(size_t)b * 30 * 256 + 8 * 256 + r]; } }
}

template <int R>
__device__ __forceinline__ void conv_task(const Params& P, const Ctx& C, LAS unsigned char* lds, int grow0  , int t0  , int sb  ) {
    unsigned char* ws = wsbase(P);
    const bf16* glu = (const bf16*)(ws + WS_GLU);
    LAS unsigned* st = (LAS unsigned*)lds;
    LAS float* red = (LAS float*)(lds + 98304);
    constexpr int NR = R + 30;
    const float* sconv = inp(P, I_SCONV); const float* cdw = inp(P, I_CDW);
    for (int p = C.tid; p < NR * 128; p += NT) {
        const int rr = p >> 7, ch = p & 127; const int t = t0 - 30 + rr;
        v4u v = (v4u){0u, 0u, 0u, 0u};
        if (t >= 0) v = *(const v4u*)(glu + (size_t)(grow0 - 30 + rr) * CC + ch * 8);
        else if (sb >= 0) { const float* s = sconv + ((size_t)sb * 30 + rr) * CC + ch * 8;
            const f32x4 a = *(const f32x4*)s, b = *(const f32x4*)(s + 4); v.x = pk2(a[0], a[1]); v.y = pk2(a[2], a[3]); v.z = pk2(b[0], b[1]); v.w = pk2(b[2], b[3]); }
        *(LAS v4u*)(st + rr * 512 + ch * 4) = v;
    }
    const int c = 2 * C.tid;
    f32x2 w[31];
#pragma unroll
    for (int j = 0; j < 31; ++j) w[j] = *(const f32x2*)(cdw + j * CC + c);
    const f32x2 bias = *(const f32x2*)(inp(P, I_CDWB) + c);
    f32x2 acc[R];
#pragma unroll
    for (int r = 0; r < R; ++r) acc[r] = bias;
    __syncthreads();
#pragma unroll
    for (int rr = 0; rr < NR; ++rr) {
        if ((rr & 3) == 0) asm volatile("" ::: "memory");
        const unsigned u = st[rr * 512 + C.tid]; const float x0 = bflo(u), x1 = bfhi(u);
#pragma unroll
        for (int r = 0; r < R; ++r) { const int j = rr - r; if (j >= 0 && j < 31) { acc[r][0] += x0 * w[j][0]; acc[r][1] += x1 * w[j][1]; } }
    }
    float s[R];
#pragma unroll
    for (int r = 0; r < R; ++r) s[r] = wave_sum(acc[r][0] + acc[r][1]);
    if (C.lane == 0) {
#pragma unroll
        for (int r = 0; r < R; ++r) red[C.wave * 16 + r] = s[r]; }
    __syncthreads();
    float mean[R];
#pragma unroll
    for (int r = 0; r < R; ++r) { float t = 0.f;
#pragma unroll
        for (int wv = 0; wv < 8; ++wv) t += red[wv * 16 + r];
        mean[r] = t * (1.0f / 1024.0f); }
    __syncthreads();
#pragma unroll
    for (int r = 0; r < R; ++r) { const float d0 = acc[r][0] - mean[r], d1 = acc[r][1] - mean[r]; acc[r][0] = d0; acc[r][1] = d1; s[r] = wave_sum(d0 * d0 + d1 * d1); }
    if (C.lane == 0) {
#pragma unroll
        for (int r = 0; r < R; ++r) red[C.wave * 16 + r] = s[r]; }
    __syncthreads();
    const f32x2 lg = *(const f32x2*)(inp(P, I_CLNG) + c), lb = *(const f32x2*)(inp(P, I_CLNB) + c);
    bf16* a2 = (bf16*)(ws + WS_A2);
#pragma unroll
    for (int r = 0; r < R; ++r) { float t = 0.f;
#pragma unroll
        for (int wv = 0; wv < 8; ++wv) t += red[wv * 16 + r];
        const float rstd = rsqrtf(t * (1.0f / 1024.0f) + 1e-5f);
        float y0 = acc[r][0] * rstd * lg[0] + lb[0], y1 = acc[r][1] * rstd * lg[1] + lb[1];
        y0 = y0 * sigm(y0); y1 = y1 * sigm(y1);
        *(unsigned*)(a2 + (size_t)(grow0 + r) * D + c) = pk2(y0, y1); }
    __syncthreads();
}

#define XS8(cp_, pp_, mp_, off_, xs_) do { const v4u cu_ = *(const v4u*)((cp_) + (off_)); const v4u pu_ = *(const v4u*)((pp_) + (off_)); \
        const f32x4 m0_ = *(const f32x4*)((mp_) + (off_)), m1_ = *(const f32x4*)((mp_) + (off_) + 4); float c_, p_; \
        c_ = bflo(cu_.x); p_ = bflo(pu_.x); xs_[0] = c_ + (p_ - c_) * m0_[0]; c_ = bfhi(cu_.x); p_ = bfhi(pu_.x); xs_[1] = c_ + (p_ - c_) * m0_[1]; \
        c_ = bflo(cu_.y); p_ = bflo(pu_.y); xs_[2] = c_ + (p_ - c_) * m0_[2]; c_ = bfhi(cu_.y); p_ = bfhi(pu_.y); xs_[3] = c_ + (p_ - c_) * m0_[3]; \
        c_ = bflo(cu_.z); p_ = bflo(pu_.z); xs_[4] = c_ + (p_ - c_) * m1_[0]; c_ = bfhi(cu_.z); p_ = bfhi(pu_.z); xs_[5] = c_ + (p_ - c_) * m1_[1]; \
        c_ = bflo(cu_.w); p_ = bflo(pu_.w); xs_[6] = c_ + (p_ - c_) * m1_[2]; c_ = bfhi(cu_.w); p_ = bfhi(pu_.w); xs_[7] = c_ + (p_ - c_) * m1_[3]; } while (0)
#define XS4(cp_, pp_, mp_, off_, xs_) do { const v2u cu_ = *(const v2u*)((cp_) + (off_)); const v2u pu_ = *(const v2u*)((pp_) + (off_)); const f32x4 m0_ = *(const f32x4*)((mp_) + (off_)); float c_, p_; \
        c_ = bflo(cu_.x); p_ = bflo(pu_.x); xs_[0] = c_ + (p_ - c_) * m0_[0]; c_ = bfhi(cu_.x); p_ = bfhi(pu_.x); xs_[1] = c_ + (p_ - c_) * m0_[1]; \
        c_ = bflo(cu_.y); p_ = bflo(pu_.y); xs_[2] = c_ + (p_ - c_) * m0_[2]; c_ = bfhi(cu_.y); p_ = bfhi(pu_.y); xs_[3] = c_ + (p_ - c_) * m0_[3]; } while (0)
__device__ __forceinline__ bf16x8 pack8(const float (&x)[8]) {
    v4u o; o.x = pk2(x[0], x[1]); o.y = pk2(x[2], x[3]); o.z = pk2(x[4], x[5]); o.w = pk2(x[6], x[7]);
    return __builtin_bit_cast(bf16x8, o);
}
__device__ __forceinline__ float tanh_fast(float x) { return 1.0f - 2.0f / (1.0f + __expf(2.0f * x)); }
constexpr int PBUF = 65536;
__device__ __forceinline__ void mix4(const v2u cu, const v2u pu, const f32x4 m, float (&xs)[4]) {
    float c_, p_;
    c_ = bflo(cu.x); p_ = bflo(pu.x); xs[0] = c_ + (p_ - c_) * m[0]; c_ = bfhi(cu.x); p_ = bfhi(pu.x); xs[1] = c_ + (p_ - c_) * m[1];
    c_ = bflo(cu.y); p_ = bflo(pu.y); xs[2] = c_ + (p_ - c_) * m[2]; c_ = bfhi(cu.y); p_ = bfhi(pu.y); xs[3] = c_ + (p_ - c_) * m[3];
}
template <int NH>
__device__ __forceinline__ void prep_task(const Params& P, const Ctx& C, LAS unsigned char* lds, int rowblock, int hbase) {
    const int lane = C.lane, fr = lane & 15, fq = lane >> 4, row = rowblock * 128 + C.wave * 16 + fr;
    unsigned char* ws = wsbase(P);
    const bf16* curp = (const bf16*)(ws + WS_PR) + (size_t)row * NRCP;
    const bf16* prvp = curp - NRCP;
    if (row < MP) { if ((row & (SEQ - 1)) == 0) prvp = (const bf16*)(ws + WS_SHB) + (size_t)NBS * NRCP; }
    else { const int rs = row - MP; if ((rs & 7) == 0) prvp = (const bf16*)(ws + WS_SHB) + (size_t)(rs >> 3) * NRCP; }
    const float* mup = inp(P, I_MU);
    const unsigned char* himg = ws + WS_HIMG;
    const bf16* c8 = curp + 3072 + 8 * fq; const bf16* p8 = prvp + 3072 + 8 * fq; const float* m8 = mup + 3072 + 8 * fq;
    const f32x4 z4 = (f32x4){0.f, 0.f, 0.f, 0.f};
    const int c00 = hbase * 64 + 4 * fq;
#define PREP_STAGE(h_, b_, i0_, n_) do { int ll = lane; asm volatile("" : "+v"(ll)); _Pragma("unroll") for (int q = 0; q < (n_); ++q) { const int i = (i0_) + C.wave + 8 * q; \
        __builtin_amdgcn_global_load_lds((const unsigned*)(himg + (size_t)(h_) * PBUF + i * 1024 + ll * 16), (LAS unsigned*)(lds + (b_) * PBUF + i * 1024), 16, 0, 0); } } while (0)
#define PREP_SYNC() do { asm volatile("s_waitcnt vmcnt(0)" ::: "memory"); __syncthreads(); } while (0)
    {
        PREP_STAGE(hbase, 0, 24, 4);
        bf16x8 Ag[8];
#pragma unroll
        for (int s = 0; s < 8; ++s) { if (s == 4) asm volatile("" ::: "memory");
            float xs[8]; XS8(c8, p8, m8, 192 + 32 * s, xs);
#pragma unroll
            for (int e = 0; e < 8; ++e) xs[e] = sigm(xs[e]);
            Ag[s] = pack8(xs); }
        PREP_SYNC();
        bf16* gb = (bf16*)(ws + WS_G) + (size_t)row * RW + c00;
        const int lgo = 24576 + fr * 512;
#pragma unroll 1
        for (int hh = 0; hh < NH; ++hh) {
            if (hh + 1 < NH) PREP_STAGE(hbase + hh + 1, (hh + 1) & 1, 24, 4);
            const LAS unsigned char* wb = lds + (hh & 1) * PBUF;
#pragma unroll
            for (int nt = 0; nt < 4; ++nt) {
                f32x4 accG = z4;
#pragma unroll
                for (int s = 0; s < 8; ++s) { const bf16x8 bg = *(const LAS bf16x8*)(wb + lgo + nt * 8192 + (((4 * s + fq) ^ fr) * 16)); accG = __builtin_amdgcn_mfma_f32_16x16x32_bf16(bg, Ag[s], accG, 0, 0, 0); }
                *(v2u*)(gb + 16 * nt) = (v2u){pk2(accG[0], accG[1]), pk2(accG[2], accG[3])};
            }
            gb += 64;
            PREP_SYNC();
        }
    }
    PREP_STAGE(hbase, 0, 0, 3); if (C.wave < 2) PREP_STAGE(hbase, 0, 56, 1);
    const bf16* c4 = curp + c00; const bf16* p4 = prvp + c00;
    v2u cu[3][4], pu[3][4];
#pragma unroll
    for (int x = 0; x < 3; ++x)
#pragma unroll
        for (int nt = 0; nt < 4; ++nt) { cu[x][nt] = *(const v2u*)(c4 + 1024 * x + 16 * nt); pu[x][nt] = *(const v2u*)(p4 + 1024 * x + 16 * nt); }
    bf16x8 Aw[3], Aa[3];
#pragma unroll
    for (int s = 0; s < 3; ++s) { float xs[8]; XS8(c8, p8, m8, 32 * s, xs);
#pragma unroll
        for (int e = 0; e < 8; ++e) xs[e] = tanh_fast(xs[e]);
        Aw[s] = pack8(xs); }
#pragma unroll
    for (int s = 0; s < 3; ++s) { float xs[8]; XS8(c8, p8, m8, 96 + 32 * s, xs); Aa[s] = pack8(xs); }
    PREP_SYNC();
    constexpr size_t SS = SB_STRIDE / 2;
    bf16* sb = (bf16*)(ws + WS_SI) + (size_t)row * RW + c00; float* sw = (float*)(ws + WS_SW) + (size_t)row * RW + c00;
    float* bonp = (float*)(ws + WS_BON) + (size_t)row * RH + hbase;
    const int lwo = fr * 192 + fq * 16, lpo = 57344 + fq * 16;
#pragma unroll 1
    for (int hh = 0; hh < NH; ++hh) {
        if (hh + 1 < NH) { PREP_STAGE(hbase + hh + 1, (hh + 1) & 1, 0, 3); if (C.wave < 2) PREP_STAGE(hbase + hh + 1, (hh + 1) & 1, 56, 1); }
        const LAS unsigned char* wb = lds + (hh & 1) * PBUF;
        float ss = 0.f;
#pragma unroll
        for (int nt = 0; nt < 4; ++nt) {
            float xk0[4]; mix4(cu[1][nt], pu[1][nt], *(const LAS f32x4*)(wb + lpo + 1 * 256 + nt * 64), xk0);
            const f32x4 kkw = *(const LAS f32x4*)(wb + lpo + 3 * 256 + nt * 64);
#pragma unroll
            for (int e = 0; e < 4; ++e) { const float t = xk0[e] * kkw[e]; ss += t * t; }
        }
        ss += __shfl_xor(ss, 16); ss += __shfl_xor(ss, 32);
        const float inv = 1.0f / fmaxf(sqrtf(ss), 1e-12f);
        float bon = 0.f;
#pragma unroll
        for (int nt = 0; nt < 4; ++nt) {
            f32x4 accW = z4, accA = z4;
#pragma unroll
            for (int s = 0; s < 3; ++s) { const bf16x8 bw = *(const LAS bf16x8*)(wb + lwo + nt * 3072 + s * 64), ba = *(const LAS bf16x8*)(wb + 12288 + lwo + nt * 3072 + s * 64);
                accW = __builtin_amdgcn_mfma_f32_16x16x32_bf16(bw, Aw[s], accW, 0, 0, 0); accA = __builtin_amdgcn_mfma_f32_16x16x32_bf16(ba, Aa[s], accA, 0, 0, 0); }
            float xr[4], xv[4], xkk[4];
            mix4(cu[0][nt], pu[0][nt], *(const LAS f32x4*)(wb + lpo + 0 * 256 + nt * 64), xr);
            mix4(cu[1][nt], pu[1][nt], *(const LAS f32x4*)(wb + lpo + 1 * 256 + nt * 64), xkk);
            mix4(cu[2][nt], pu[2][nt], *(const LAS f32x4*)(wb + lpo + 2 * 256 + nt * 64), xv);
            const f32x4 kkw = *(const LAS f32x4*)(wb + lpo + 3 * 256 + nt * 64), a0 = *(const LAS f32x4*)(wb + lpo + 4 * 256 + nt * 64), w0 = *(const LAS f32x4*)(wb + lpo + 5 * 256 + nt * 64);
            const f32x4 ka = *(const LAS f32x4*)(wb + lpo + 6 * 256 + nt * 64), rk = *(const LAS f32x4*)(wb + lpo + 7 * 256 + nt * 64);
            f32x4 vw; float vk[4], va[4], vb[4];
#pragma unroll
            for (int e = 0; e < 4; ++e) {
                const float ee = 0.6065306597126334f * sigm(w0[e] + accW[e]);
                vw[e] = __expf(-ee);
                const float a = sigm(a0[e] + accA[e]);
                const float kn = xkk[e] * kkw[e] * inv;
                const float k2 = xkk[e] * (1.0f + (a - 1.0f) * ka[e]);
                vk[e] = k2; va[e] = -kn; vb[e] = kn * a;
                bon += xr[e] * k2 * rk[e];
            }
            bf16* so = sb + 16 * nt;
            *(v2u*)(so + 0 * SS) = (v2u){pk2(xr[0], xr[1]), pk2(xr[2], xr[3])};
            *(v2u*)(so + 1 * SS) = (v2u){pk2(vk[0], vk[1]), pk2(vk[2], vk[3])};
            *(v2u*)(so + 2 * SS) = (v2u){pk2(xv[0], xv[1]), pk2(xv[2], xv[3])};
            *(v2u*)(so + 3 * SS) = (v2u){pk2(va[0], va[1]), pk2(va[2], va[3])};
            *(v2u*)(so + 4 * SS) = (v2u){pk2(vb[0], vb[1]), pk2(vb[2], vb[3])};
            *(f32x4*)(sw + 16 * nt) = vw;
        }
        bon += __shfl_xor(bon, 16); bon += __shfl_xor(bon, 32);
        if (fq == 0) bonp[hh] = bon;
        sb += 64; sw += 64;
        if (hh + 1 < NH) { c4 += 64; p4 += 64;
#pragma unroll
            for (int x = 0; x < 3; ++x)
#pragma unroll
                for (int nt = 0; nt < 4; ++nt) { cu[x][nt] = *(const v2u*)(c4 + 1024 * x + 16 * nt); pu[x][nt] = *(const v2u*)(p4 + 1024 * x + 16 * nt); } }
        PREP_SYNC();
    }
#undef PREP_STAGE
#undef PREP_SYNC
}

constexpr int TC = 32, STEPF = 340;
template <int CTRL> __device__ __forceinline__ float dppf(float x) { return __builtin_bit_cast(float, __builtin_amdgcn_update_dpp(0, __builtin_bit_cast(int, x), CTRL, 0xF, 0xF, true)); }
__device__ __forceinline__ float allred16(float x) {
    x += dppf<0xB1>(x);
    x += dppf<0x4E>(x);
    x += dppf<0x141>(x);
    x += dppf<0x140>(x);
    return x;
}
#define SCAN_BAR() do { asm volatile("s_waitcnt lgkmcnt(0)" ::: "memory"); __builtin_amdgcn_s_barrier(); asm volatile("" ::: "memory"); } while (0)
#define SCAN_STEP(S01, S23, r4, w4, k4, a4, b4, v, yout) do { \
        f32x2 p2 = S01 * (f32x2){a4[0], a4[1]}; p2 = S23 * (f32x2){a4[2], a4[3]} + p2; \
        const float sa = allred16(p2[0] + p2[1]); const f32x2 sa2 = (f32x2){sa, sa}, v2 = (f32x2){v, v}; \
        f32x2 t01 = v2 * (f32x2){k4[0], k4[1]}, t23 = v2 * (f32x2){k4[2], k4[3]}; \
        t01 = sa2 * (f32x2){b4[0], b4[1]} + t01; t23 = sa2 * (f32x2){b4[2], b4[3]} + t23; \
        S01 = S01 * (f32x2){w4[0], w4[1]} + t01; S23 = S23 * (f32x2){w4[2], w4[3]} + t23; \
        f32x2 q2 = S01 * (f32x2){r4[0], r4[1]}; q2 = S23 * (f32x2){r4[2], r4[3]} + q2; \
        yout = allred16(q2[0] + q2[1]); } while (0)
__device__ __forceinline__ void ld_bf8(const bf16* p, float (&x)[8]) { const v4u u = *(const v4u*)p; x[0] = bflo(u.x); x[1] = bfhi(u.x); x[2] = bflo(u.y); x[3] = bfhi(u.y); x[4] = bflo(u.z); x[5] = bfhi(u.z); x[6] = bflo(u.w); x[7] = bfhi(u.w); }
__device__ __forceinline__ void scan_prompt(const Params& P, const Ctx& C, LAS unsigned char* lds, int chain, int rb, bool dodef) {
    unsigned char* ws = wsbase(P);
    const int b = chain >> 4, h = chain & 15, m0 = b * SEQ;
    LAS float* buf = (LAS float*)lds;
    constexpr int NCH = SEQ / TC;
    if (C.wave >= 4) {
        const int ht = C.tid - 256, t = ht >> 3, g = ht & 7;
        const bf16* SB = (const bf16*)(ws + WS_SI) + (size_t)m0 * RW + h * 64 + 8 * g; constexpr size_t SBS = SB_STRIDE / 2;
        const float* SW = (const float*)(ws + WS_SW) + (size_t)m0 * RW + h * 64 + 8 * g;
        const bf16* SV = (const bf16*)(ws + WS_SI) + 2 * SBS + (size_t)m0 * RW + h * 64 + rb * 16 + 8 * (g & 1);
        v4u lr, lk, lb, la, lv; f32x4 lw0, lw1;
#define SCAN_HLOAD(ck_) do { const int tg = (ck_) * TC + t; const size_t ro = (size_t)tg * RW; \
            lr = *(const v4u*)(SB + 0 * SBS + ro); lk = *(const v4u*)(SB + 1 * SBS + ro); lb = *(const v4u*)(SB + 4 * SBS + ro); \
            la = tg + 1 < SEQ ? *(const v4u*)(SB + 3 * SBS + ro + RW) : (v4u){0u, 0u, 0u, 0u}; \
            lw0 = *(const f32x4*)(SW + ro); lw1 = *(const f32x4*)(SW + ro + 4); lv = *(const v4u*)(SV + ro); } while (0)
#define SCAN_HWRITE(ck_) do { LAS float* d = buf + ((ck_) & 1) * (TC * STEPF) + t * STEPF; \
            const float an[8] = {bflo(la.x), bfhi(la.x), bflo(la.y), bfhi(la.y), bflo(la.z), bfhi(la.z), bflo(la.w), bfhi(la.w)}; \
            const float bb[8] = {bflo(lb.x), bfhi(lb.x), bflo(lb.y), bfhi(lb.y), bflo(lb.z), bfhi(lb.z), bflo(lb.w), bfhi(lb.w)}; \
            const float kk_[8] = {bflo(lk.x), bfhi(lk.x), bflo(lk.y), bfhi(lk.y), bflo(lk.z), bfhi(lk.z), bflo(lk.w), bfhi(lk.w)}; \
            float be = 0.f, ka_ = 0.f; _Pragma("unroll") for (int e = 0; e < 8; ++e) { be += bb[e] * an[e]; ka_ += kk_[e] * an[e]; } \
            be += __shfl_xor(be, 1); be += __shfl_xor(be, 2); be += __shfl_xor(be, 4); ka_ += __shfl_xor(ka_, 1); ka_ += __shfl_xor(ka_, 2); ka_ += __shfl_xor(ka_, 4); \
            *(LAS v4u*)(d + 0 + 8 * g) = (v4u){lr.x << 16, lr.x & 0xffff0000u, lr.y << 16, lr.y & 0xffff0000u}; *(LAS v4u*)(d + 4 + 8 * g) = (v4u){lr.z << 16, lr.z & 0xffff0000u, lr.w << 16, lr.w & 0xffff0000u}; \
            *(LAS f32x4*)(d + 64 + 8 * g) = lw0; *(LAS f32x4*)(d + 68 + 8 * g) = lw1; \
            *(LAS f32x4*)(d + 128 + 8 * g) = (f32x4){kk_[0], kk_[1], kk_[2], kk_[3]}; *(LAS f32x4*)(d + 132 + 8 * g) = (f32x4){kk_[4], kk_[5], kk_[6], kk_[7]}; \
            *(LAS f32x4*)(d + 192 + 8 * g) = (f32x4){lw0[0] * an[0], lw0[1] * an[1], lw0[2] * an[2], lw0[3] * an[3]}; *(LAS f32x4*)(d + 196 + 8 * g) = (f32x4){lw1[0] * an[4], lw1[1] * an[5], lw1[2] * an[6], lw1[3] * an[7]}; \
            *(LAS f32x4*)(d + 256 + 8 * g) = (f32x4){bb[0], bb[1], bb[2], bb[3]}; *(LAS f32x4*)(d + 260 + 8 * g) = (f32x4){bb[4], bb[5], bb[6], bb[7]}; \
            if (g < 2) { *(LAS v4u*)(d + 320 + 8 * g) = (v4u){lv.x << 16, lv.x & 0xffff0000u, lv.y << 16, lv.y & 0xffff0000u}; *(LAS v4u*)(d + 324 + 8 * g) = (v4u){lv.z << 16, lv.z & 0xffff0000u, lv.w << 16, lv.w & 0xffff0000u}; } \
            if (g == 2) *(LAS f32x2*)(d + 336) = (f32x2){be, ka_}; } while (0)
        SCAN_HLOAD(0); SCAN_HWRITE(0); SCAN_HLOAD(1);
        SCAN_BAR();
        const int sw = C.bid * 4 + (C.wave - 4), nsw = C.G * 4;
        f32x4 tv[16]; DefItem di; di.W = nullptr; di.WT = nullptr; di.K = 0; di.N = 0; di.kb = 0; di.jb = 0; bool have = false;
        for (int ck = 0; ck < NCH; ++ck) {
            if (ck + 1 < NCH) SCAN_HWRITE(ck + 1);
            if (ck + 2 < NCH) SCAN_HLOAD(ck + 2);
            if (dodef) {
                const int ph = ck % 5, it = sw + nsw * (ck / 5);
                if (ph == 0 && it < NDEF) { di = def_item(P, ws, it); transpose_load(di.W, di.N, di.kb, di.jb, C.lane, MapId(), tv); have = true; }
                if (ph == 2 && have) { transpose_store(di.K, di.WT, di.kb, di.jb, C.lane, tv); have = false; }
            }
            SCAN_BAR();
        }
#undef SCAN_HLOAD
#undef SCAN_HWRITE
    } else {
        float* Y = (float*)(ws + WS_Y);
        const int rowl = C.lane >> 4, cl = C.lane & 15, irow = rb * 16 + C.wave * 4 + rowl;
        f32x2 S01 = (f32x2){0.f, 0.f}, S23 = (f32x2){0.f, 0.f};
        float sa = 0.f, yk = 0.f;
        SCAN_BAR();
        for (int ck = 0; ck < NCH; ++ck) {
            const LAS float* cb = buf + (ck & 1) * (TC * STEPF);
            f32x4 r4 = *(const LAS f32x4*)(cb + 0 * 64 + 4 * cl), w4 = *(const LAS f32x4*)(cb + 1 * 64 + 4 * cl), k4 = *(const LAS f32x4*)(cb + 2 * 64 + 4 * cl);
            f32x4 q4 = *(const LAS f32x4*)(cb + 3 * 64 + 4 * cl), b4 = *(const LAS f32x4*)(cb + 4 * 64 + 4 * cl); float v = cb[320 + C.wave * 4 + rowl]; f32x2 bk = *(const LAS f32x2*)(cb + 336);
#pragma unroll 4
            for (int t = 0; t < TC; ++t) {
                const LAS float* nb = cb + (t + 1 < TC ? t + 1 : t) * STEPF;
                const f32x4 nr = *(const LAS f32x4*)(nb + 0 * 64 + 4 * cl), nw = *(const LAS f32x4*)(nb + 1 * 64 + 4 * cl), nk = *(const LAS f32x4*)(nb + 2 * 64 + 4 * cl);
                const f32x4 nq = *(const LAS f32x4*)(nb + 3 * 64 + 4 * cl), nbb = *(const LAS f32x4*)(nb + 4 * 64 + 4 * cl); const float nv = nb[320 + C.wave * 4 + rowl]; const f32x2 nbk = *(const LAS f32x2*)(nb + 336);
                f32x2 d2 = S01 * (f32x2){q4[0], q4[1]}; d2 = S23 * (f32x2){q4[2], q4[3]} + d2;
                const float dd = allred16(d2[0] + d2[1]);
                const float san = sa * bk[0] + (v * bk[1] + dd);
                const f32x2 sa2 = (f32x2){sa, sa}, v2 = (f32x2){v, v};
                f32x2 t01 = v2 * (f32x2){k4[0], k4[1]}, t23 = v2 * (f32x2){k4[2], k4[3]};
                t01 = sa2 * (f32x2){b4[0], b4[1]} + t01; t23 = sa2 * (f32x2){b4[2], b4[3]} + t23;
                S01 = S01 * (f32x2){w4[0], w4[1]} + t01; S23 = S23 * (f32x2){w4[2], w4[3]} + t23;
                f32x2 y2 = S01 * (f32x2){r4[0], r4[1]}; y2 = S23 * (f32x2){r4[2], r4[3]} + y2;
                const float y = allred16(y2[0] + y2[1]);
                sa = san;
                yk = (cl == (t & 15)) ? y : yk;
                if ((t & 15) == 15) Y[(size_t)(m0 + ck * TC + (t & ~15) + cl) * RW + h * 64 + irow] = yk;
                r4 = nr; w4 = nw; k4 = nk; q4 = nq; b4 = nbb; v = nv; bk = nbk;
            }
            SCAN_BAR();
        }
        float* so = P.out + O_WP + ((size_t)chain * 64 + irow) * 64 + 4 * cl;
        *(f32x4*)so = (f32x4){S01[0], S01[1], S23[0], S23[1]};
    }
    __syncthreads();
}
__device__ __forceinline__ f32x4 ld_bf4(const bf16* p) { const v2u u = *(const v2u*)p; return (f32x4){bflo(u.x), bfhi(u.x), bflo(u.y), bfhi(u.y)}; }
__device__ __forceinline__ void scan_sample(const Params& P, const Ctx& C, const float* swkv, int chain, int half) {
    unsigned char* ws = wsbase(P);
    const int b = chain >> 4, h = chain & 15, m0 = MP + 8 * b;
    const bf16* ub = (const bf16*)(ws + WS_SI) + (size_t)m0 * RW + h * 64; constexpr size_t SBS = SB_STRIDE / 2;
    const float* uw = (const float*)(ws + WS_SW) + (size_t)m0 * RW + h * 64;
    float* Y = (float*)(ws + WS_Y);
    const int rowl = C.lane >> 4, cl = C.lane & 15, irow = half * 32 + C.wave * 4 + rowl, lo = 4 * cl;
    const f32x4 s4 = *(const f32x4*)(swkv + ((size_t)chain * 64 + irow) * 64 + 4 * cl);
    f32x2 S01 = (f32x2){s4[0], s4[1]}, S23 = (f32x2){s4[2], s4[3]};
    float yk = 0.f;
#pragma unroll 4
    for (int t = 0; t < 8; ++t) {
        const bf16* ut = ub + t * RW;
        const f32x4 r4 = ld_bf4(ut + 0 * SBS + lo), k4 = ld_bf4(ut + 1 * SBS + lo), a4 = ld_bf4(ut + 3 * SBS + lo), b4 = ld_bf4(ut + 4 * SBS + lo);
        const f32x4 w4 = *(const f32x4*)(uw + t * RW + lo); const float v = bflo((unsigned)(ut + 2 * SBS)[irow]);
        float y; SCAN_STEP(S01, S23, r4, w4, k4, a4, b4, v, y);
        yk = (cl == t) ? y : yk;
    }
    if (cl < 8) Y[(size_t)(m0 + cl) * RW + h * 64 + irow] = yk;
    *(f32x4*)(P.out + O_WS + ((size_t)chain * 64 + irow) * 64 + 4 * cl) = (f32x4){S01[0], S01[1], S23[0], S23[1]};
}

__device__ __forceinline__ void post_row(const Params& P, int row, int lane) {
    unsigned char* ws = wsbase(P);
    const float* Y = (const float*)(ws + WS_Y) + (size_t)row * RW + 16 * lane;
    const bf16* V = (const bf16*)(ws + WS_SI) + 2 * (SB_STRIDE / 2) + (size_t)row * RW + 16 * lane;
    const bf16* G = (const bf16*)(ws + WS_G) + (size_t)row * RW + 16 * lane;
    const float bon = ((const float*)(ws + WS_BON))[(size_t)row * RH + (lane >> 2)];
    float y[16], s = 0.f;
#pragma unroll
    for (int q = 0; q < 4; ++q) { const f32x4 t = *(const f32x4*)(Y + 4 * q); y[4 * q] = t[0]; y[4 * q + 1] = t[1]; y[4 * q + 2] = t[2]; y[4 * q + 3] = t[3]; s += (t[0] + t[1]) + (t[2] + t[3]); }
    s += __shfl_xor(s, 1); s += __shfl_xor(s, 2);
    const float mu = s * (1.0f / 64.0f); float q2 = 0.f;
#pragma unroll
    for (int e = 0; e < 16; ++e) { y[e] -= mu; q2 += y[e] * y[e]; }
    q2 += __shfl_xor(q2, 1); q2 += __shfl_xor(q2, 2);
    const float rstd = rsqrtf(q2 * (1.0f / 64.0f) + 64e-5f);
    const float* lg = inp(P, I_LNXG) + 16 * lane; const float* lb = inp(P, I_LNXB) + 16 * lane;
    unsigned o[8];
#pragma unroll
    for (int q = 0; q < 4; ++q) { const f32x4 g4 = *(const f32x4*)(lg + 4 * q), b4 = *(const f32x4*)(lb + 4 * q), v4 = ld_bf4(V + 4 * q), gg = ld_bf4(G + 4 * q);
        float r[4];
#pragma unroll
        for (int e = 0; e < 4; ++e) r[e] = (y[4 * q + e] * rstd * g4[e] + b4[e] + bon * v4[e]) * gg[e];
        o[2 * q] = pk2(r[0], r[1]); o[2 * q + 1] = pk2(r[2], r[3]); }
    bf16* dst = (bf16*)(ws + WS_A2) + (size_t)row * D + 1024 + 16 * lane;
    *(v4u*)dst = (v4u){o[0], o[1], o[2], o[3]}; *(v4u*)(dst + 8) = (v4u){o[4], o[5], o[6], o[7]};
}

__device__ __forceinline__ void rowpass(const float* xa, const float* __restrict__ mix, int nslab, const float* __restrict__ g1, float* xo,
                                        const float* __restrict__ g2, bf16* __restrict__ hb, int lane) {
    f32x4 mv[8]; float s = 0.f;
#pragma unroll
    for (int j = 0; j < 8; ++j) { mv[j] = *(const f32x4*)(mix + 4 * (lane + 64 * j));
        for (int sl = 1; sl < nslab; ++sl) mv[j] += *(const f32x4*)(mix + sl * SLAB_F + 4 * (lane + 64 * j));
        s += (mv[j][0] * mv[j][0] + mv[j][1] * mv[j][1]) + (mv[j][2] * mv[j][2] + mv[j][3] * mv[j][3]); }
    const float r = rsqrtf(wave_sum(s) * (1.0f / 2048.0f) + 1e-6f);
    float s2 = 0.f;
#pragma unroll
    for (int j = 0; j < 8; ++j) { const f32x4 a = *(const f32x4*)(xa + 4 * (lane + 64 * j)), gg = *(const f32x4*)(g1 + 4 * (lane + 64 * j));
        mv[j] = a + mv[j] * r * gg; *(f32x4*)(xo + 4 * (lane + 64 * j)) = mv[j];
        s2 += (mv[j][0] * mv[j][0] + mv[j][1] * mv[j][1]) + (mv[j][2] * mv[j][2] + mv[j][3] * mv[j][3]); }
    if (hb) {
        const float r2 = rsqrtf(wave_sum(s2) * (1.0f / 2048.0f) + 1e-6f);
#pragma unroll
        for (int j = 0; j < 8; ++j) { const f32x4 gg = *(const f32x4*)(g2 + 4 * (lane + 64 * j));
            v2u o; o.x = pk2(mv[j][0] * r2 * gg[0], mv[j][1] * r2 * gg[1]); o.y = pk2(mv[j][2] * r2 * gg[2], mv[j][3] * r2 * gg[3]);
            *(v2u*)(hb + 4 * (lane + 64 * j)) = o; }
    }
}
__device__ __forceinline__ void attn_prompt_task(const Params& P, const Ctx& C, LAS unsigned char* lds, int b, int h, int qt) {
    unsigned char* ws = wsbase(P);
    const bf16* Qg = (const bf16*)(ws + WS_Q); const bf16* Kg = (const bf16*)(ws + WS_KB); const bf16* VTg = (const bf16*)(ws + WS_VT);
    bf16* Og = (bf16*)(ws + WS_O);
    const int fr = C.lane & 15, fq = C.lane >> 4;
    const int qrow = b * SEQ + qt * 128 + C.wave * 16 + fr;
    constexpr int BUFB = 33792;
    bf16x8 Qf[16];
#pragma unroll
    for (int s = 0; s < 16; ++s) Qf[s] = *(const bf16x8*)(Qg + (size_t)qrow * D + h * XD + 32 * s + 8 * fq);
    f32x4 accS[16];
#pragma unroll
    for (int nt = 0; nt < 16; ++nt) accS[nt] = (f32x4){0.f, 0.f, 0.f, 0.f};
    v4u stg[4];
#define ATT_GLOAD(c_) do { if ((c_) < 8) { _Pragma("unroll") for (int i = 0; i < 4; ++i) { const int idx = C.tid + i * NT, key = idx >> 3, ch = idx & 7; \
            stg[i] = *(const v4u*)(Kg + (size_t)(b * NMEM + key) * D + h * XD + (c_) * 64 + ch * 8); } } \
        else { _Pragma("unroll") for (int i = 0; i < 4; ++i) { const int idx = C.tid + i * NT, dd = idx >> 5, ch = idx & 31; \
            stg[i] = *(const v4u*)(VTg + ((size_t)((b * XH + h) * XD + ((c_) - 8) * 64 + dd)) * NMEM + ch * 8); } } } while (0)
#define ATT_SWRITE(c_) do { LAS unsigned char* sbuf = lds + ((c_) & 1) * BUFB; if ((c_) < 8) { _Pragma("unroll") for (int i = 0; i < 4; ++i) { const int idx = C.tid + i * NT, key = idx >> 3, ch = idx & 7; \
            *(LAS v4u*)(sbuf + key * 128 + ((ch ^ (key & 7)) * 16)) = stg[i]; } } \
        else { _Pragma("unroll") for (int i = 0; i < 4; ++i) { const int idx = C.tid + i * NT, dd = idx >> 5, ch = idx & 31; \
            *(LAS v4u*)(sbuf + dd * 528 + ch * 16) = stg[i]; } } } while (0)
    ATT_GLOAD(0); ATT_SWRITE(0); __syncthreads();
    bf16x8 Pf[8];
#pragma unroll
    for (int c = 0; c < 8; ++c) {
        ATT_GLOAD(c + 1);
        const LAS unsigned char* sbuf = lds + (c & 1) * BUFB;
#pragma unroll
        for (int ss = 0; ss < 2; ++ss)
#pragma unroll
            for (int nt = 0; nt < 16; ++nt) {
                const int key = 16 * nt + fr, ch = ss * 4 + fq;
                const bf16x8 kf = *(const LAS bf16x8*)(sbuf + key * 128 + ((ch ^ (key & 7)) * 16));
                accS[nt] = __builtin_amdgcn_mfma_f32_16x16x32_bf16(kf, Qf[2 * c + ss], accS[nt], 0, 0, 0);
            }
        if (c == 7) {
            float mx = -3.0e38f;
#pragma unroll
            for (int nt = 0; nt < 16; ++nt) mx = fmaxf(mx, fmaxf(fmaxf(accS[nt][0], accS[nt][1]), fmaxf(accS[nt][2], accS[nt][3])));
            mx = fmaxf(mx, __shfl_xor(mx, 16)); mx = fmaxf(mx, __shfl_xor(mx, 32));
            float sum = 0.f;
#pragma unroll
            for (int nt = 0; nt < 16; ++nt) {
#pragma unroll
                for (int e = 0; e < 4; ++e) { const float p = exp2f(accS[nt][e] - mx); accS[nt][e] = p; sum += p; } }
            sum += __shfl_xor(sum, 16); sum += __shfl_xor(sum, 32);
            const float inv = 1.0f / sum;
#pragma unroll
            for (int s = 0; s < 8; ++s) { v4u o; o.x = pk2(accS[2 * s][0] * inv, accS[2 * s][1] * inv); o.y = pk2(accS[2 * s][2] * inv, accS[2 * s][3] * inv);
                o.z = pk2(accS[2 * s + 1][0] * inv, accS[2 * s + 1][1] * inv); o.w = pk2(accS[2 * s + 1][2] * inv, accS[2 * s + 1][3] * inv); Pf[s] = __builtin_bit_cast(bf16x8, o); }
        }
        ATT_SWRITE(c + 1);
        __syncthreads();
    }
    for (int c = 8; c < 16; ++c) {
        if (c + 1 < 16) ATT_GLOAD(c + 1);
        const LAS unsigned char* sbuf = lds + (c & 1) * BUFB;
        const int dv = c - 8;
        f32x4 accO[4];
#pragma unroll
        for (int nd = 0; nd < 4; ++nd) accO[nd] = (f32x4){0.f, 0.f, 0.f, 0.f};
#pragma unroll
        for (int s = 0; s < 8; ++s)
#pragma unroll
            for (int nd = 0; nd < 4; ++nd) {
                const LAS unsigned char* rp = sbuf + (nd * 16 + fr) * 528 + (32 * s + 4 * fq) * 2;
                const v2u lo = *(const LAS v2u*)rp, hi = *(const LAS v2u*)(rp + 32);
                const bf16x8 vf = __builtin_bit_cast(bf16x8, ((v4u){lo.x, lo.y, hi.x, hi.y}));
                accO[nd] = __builtin_amdgcn_mfma_f32_16x16x32_bf16(vf, Pf[s], accO[nd], 0, 0, 0);
            }
#pragma unroll
        for (int nd = 0; nd < 4; ++nd) { v2u o; o.x = pk2(accO[nd][0], accO[nd][1]); o.y = pk2(accO[nd][2], accO[nd][3]);
            *(v2u*)(Og + (size_t)qrow * D + h * XD + dv * 64 + nd * 16 + 4 * fq) = o; }
        if (c + 1 < 16) ATT_SWRITE(c + 1);
        __syncthreads();
    }
#undef ATT_GLOAD
#undef ATT_SWRITE
}
__device__ __forceinline__ void attn_sample_task(const Params& P, const Ctx& C, LAS unsigned char* lds, int b, int h) {
    unsigned char* ws = wsbase(P);
    bf16* Og = (bf16*)(ws + WS_O);
    const float* CK = inp(P, I_CK); const float* CV = inp(P, I_CV);
    LAS float* sQ = (LAS float*)lds;
    LAS float* sS = (LAS float*)(lds + 16384);
    LAS float* sP = (LAS float*)(lds + 24576);
    LAS float* sO = (LAS float*)(lds + 32768);
    const int row0 = MP + 8 * b, fr = C.lane & 15, fq = C.lane >> 4;
#pragma unroll
    for (int j = 0; j < 2; ++j) { const int i4 = C.tid + NT * j, q = i4 >> 7, d4 = i4 & 127;
        const float* qp = (const float*)(ws + WS_SLAB) + (size_t)(8 * b + q) * D + h * XD + 4 * d4;
        f32x4 a = *(const f32x4*)qp;
#pragma unroll
        for (int sl = 1; sl < 8; ++sl) a += *(const f32x4*)(qp + sl * SLAB_F);
        *(LAS f32x4*)(sQ + q * 512 + 4 * d4) = a * 0.06375871479f; }
    __syncthreads();
    {
        bf16x8 Qf[16];
#pragma unroll
        for (int s = 0; s < 16; ++s) { const LAS float* qs = sQ + (fr & 7) * 512 + 32 * s + 8 * fq; const f32x4 x0 = *(const LAS f32x4*)qs, x1 = *(const LAS f32x4*)(qs + 4);
            v4u o; o.x = pk2(x0[0], x0[1]); o.y = pk2(x0[2], x0[3]); o.z = pk2(x1[0], x1[1]); o.w = pk2(x1[2], x1[3]); Qf[s] = __builtin_bit_cast(bf16x8, o); }
#pragma unroll
        for (int nt = 0; nt < 2; ++nt) {
            const int key = 32 * C.wave + 16 * nt + fr;
            const float* kp = CK + ((size_t)(b * NMEM + key) * XH + h) * XD + 8 * fq;
            f32x4 acc = (f32x4){0.f, 0.f, 0.f, 0.f};
#pragma unroll
            for (int s8 = 0; s8 < 2; ++s8) {
                f32x4 k0[8], k1[8];
#pragma unroll
                for (int s = 0; s < 8; ++s) { k0[s] = __builtin_nontemporal_load((const f32x4*)(kp + 32 * (8 * s8 + s))); k1[s] = __builtin_nontemporal_load((const f32x4*)(kp + 32 * (8 * s8 + s) + 4)); }
#pragma unroll
                for (int s = 0; s < 8; ++s) { v4u o; o.x = pk2(k0[s][0], k0[s][1]); o.y = pk2(k0[s][2], k0[s][3]); o.z = pk2(k1[s][0], k1[s][1]); o.w = pk2(k1[s][2], k1[s][3]);
                    acc = __builtin_amdgcn_mfma_f32_16x16x32_bf16(__builtin_bit_cast(bf16x8, o), Qf[8 * s8 + s], acc, 0, 0, 0); }
            }
            if (fr < 8) {
#pragma unroll
                for (int e = 0; e < 4; ++e) sS[fr * 256 + 32 * C.wave + 16 * nt + 4 * fq + e] = acc[e]; }
        }
    }
    __syncthreads();
    {
        const int q = C.wave; const f32x4 s4 = *(const LAS f32x4*)(sS + q * 256 + 4 * C.lane);
        const float mx = wave_max(fmaxf(fmaxf(s4[0], s4[1]), fmaxf(s4[2], s4[3])));
        const float p0 = exp2f(s4[0] - mx), p1 = exp2f(s4[1] - mx), p2 = exp2f(s4[2] - mx), p3 = exp2f(s4[3] - mx);
        const float inv = 1.0f / wave_sum((p0 + p1) + (p2 + p3));
        sP[(4 * C.lane + 0) * 8 + q] = p0 * inv; sP[(4 * C.lane + 1) * 8 + q] = p1 * inv; sP[(4 * C.lane + 2) * 8 + q] = p2 * inv; sP[(4 * C.lane + 3) * 8 + q] = p3 * inv;
    }
    __syncthreads();
    {
        const int dh = C.wave & 1, kq = C.wave >> 1;
        f32x4 acc[8];
#pragma unroll
        for (int q = 0; q < 8; ++q) acc[q] = (f32x4){0.f, 0.f, 0.f, 0.f};
        const float* vp = CV + ((size_t)(b * NMEM + 64 * kq) * XH + h) * XD + 256 * dh + 4 * C.lane;
        for (int k0 = 0; k0 < 64; k0 += 8) {
            f32x4 vv[8];
#pragma unroll
            for (int u = 0; u < 8; ++u) vv[u] = __builtin_nontemporal_load((const f32x4*)(vp + (size_t)(k0 + u) * (XH * XD)));
#pragma unroll
            for (int u = 0; u < 8; ++u) { const f32x4 pa = *(const LAS f32x4*)(sP + (64 * kq + k0 + u) * 8), pb = *(const LAS f32x4*)(sP + (64 * kq + k0 + u) * 8 + 4);
                acc[0] += vv[u] * pa[0]; acc[1] += vv[u] * pa[1]; acc[2] += vv[u] * pa[2]; acc[3] += vv[u] * pa[3];
                acc[4] += vv[u] * pb[0]; acc[5] += vv[u] * pb[1]; acc[6] += vv[u] * pb[2]; acc[7] += vv[u] * pb[3]; }
        }
#pragma unroll
        for (int q = 0; q < 8; ++q) *(LAS f32x4*)(sO + C.wave * 2048 + q * 256 + 4 * C.lane) = acc[q];
    }
    __syncthreads();
    {
        const int q = C.tid >> 6, d8 = (C.tid & 63) * 8, dh = d8 >> 8, dl = d8 & 255;
        f32x4 a = (f32x4){0.f, 0.f, 0.f, 0.f}, c2 = a;
#pragma unroll
        for (int kq = 0; kq < 4; ++kq) { const LAS float* sp = sO + (kq * 2 + dh) * 2048 + q * 256 + dl; a += *(const LAS f32x4*)sp; c2 += *(const LAS f32x4*)(sp + 4); }
        v4u o; o.x = pk2(a[0], a[1]); o.y = pk2(a[2], a[3]); o.z = pk2(c2[0], c2[1]); o.w = pk2(c2[2], c2[3]);
        *(v4u*)(Og + (size_t)(row0 + q) * D + h * XD + d8) = o;
    }
    __syncthreads();
}

__device__ __forceinline__ void unpack8(const v4u u, float (&x)[8]) { x[0] = bflo(u.x); x[1] = bfhi(u.x); x[2] = bflo(u.y); x[3] = bfhi(u.y); x[4] = bflo(u.z); x[5] = bfhi(u.z); x[6] = bflo(u.w); x[7] = bfhi(u.w); }
__device__ __forceinline__ void ffn_conv_act(const Params& P, const Ctx& C) {
    unsigned char* ws = wsbase(P);
    const bf16* UP = (const bf16*)(ws + WS_UP); bf16* ACT = (bf16*)(ws + WS_ACT);
    const float* FW = inp(P, I_FDW); const float* FB = inp(P, I_FDWB); const float* SF = inp(P, I_SFFN);
    constexpr int NG = DFF / 8;
    constexpr int NRUN = 256 + 128;
    for (int it = C.bid * NT + C.tid; it < NRUN * NG; it += C.G * NT) {
        const int run = it / NG, c = (it - run * NG) * 8;
        int row0, nrow, sb = -1, t0;
        if (run < 256) { row0 = run * 32; nrow = 32; t0 = row0 & (SEQ - 1); } else { sb = run - 256; row0 = MP + 8 * sb; nrow = 8; t0 = 0; }
        float w[2][3][8], bs[2][8];
#pragma unroll
        for (int hf = 0; hf < 2; ++hf) {
#pragma unroll
            for (int j = 0; j < 3; ++j) { const f32x4 a = *(const f32x4*)(FW + j * DFF2 + hf * DFF + c), b2 = *(const f32x4*)(FW + j * DFF2 + hf * DFF + c + 4);
                w[hf][j][0] = a[0]; w[hf][j][1] = a[1]; w[hf][j][2] = a[2]; w[hf][j][3] = a[3]; w[hf][j][4] = b2[0]; w[hf][j][5] = b2[1]; w[hf][j][6] = b2[2]; w[hf][j][7] = b2[3]; }
            const f32x4 a = *(const f32x4*)(FB + hf * DFF + c), b2 = *(const f32x4*)(FB + hf * DFF + c + 4);
            bs[hf][0] = a[0]; bs[hf][1] = a[1]; bs[hf][2] = a[2]; bs[hf][3] = a[3]; bs[hf][4] = b2[0]; bs[hf][5] = b2[1]; bs[hf][6] = b2[2]; bs[hf][7] = b2[3];
        }
        float xm2[2][8], xm1[2][8];
#pragma unroll
        for (int hf = 0; hf < 2; ++hf) {
            if (sb >= 0) { const float* s = SF + (size_t)sb * 2 * DFF2 + hf * DFF + c;
                const f32x4 a = *(const f32x4*)s, b2 = *(const f32x4*)(s + 4), a1 = *(const f32x4*)(s + DFF2), b1 = *(const f32x4*)(s + DFF2 + 4);
                xm2[hf][0] = a[0]; xm2[hf][1] = a[1]; xm2[hf][2] = a[2]; xm2[hf][3] = a[3]; xm2[hf][4] = b2[0]; xm2[hf][5] = b2[1]; xm2[hf][6] = b2[2]; xm2[hf][7] = b2[3];
                xm1[hf][0] = a1[0]; xm1[hf][1] = a1[1]; xm1[hf][2] = a1[2]; xm1[hf][3] = a1[3]; xm1[hf][4] = b1[0]; xm1[hf][5] = b1[1]; xm1[hf][6] = b1[2]; xm1[hf][7] = b1[3]; }
            else if (t0 > 0) { unpack8(*(const v4u*)(UP + (size_t)(row0 - 2) * DFF2 + hf * DFF + c), xm2[hf]); unpack8(*(const v4u*)(UP + (size_t)(row0 - 1) * DFF2 + hf * DFF + c), xm1[hf]); }
            else {
#pragma unroll
                for (int e = 0; e < 8; ++e) { xm2[hf][e] = 0.f; xm1[hf][e] = 0.f; } }
        }
        for (int r0 = 0; r0 < nrow; r0 += 4) {
            v4u u[4][2];
#pragma unroll
            for (int i = 0; i < 4; ++i) { u[i][0] = *(const v4u*)(UP + (size_t)(row0 + r0 + i) * DFF2 + c); u[i][1] = *(const v4u*)(UP + (size_t)(row0 + r0 + i) * DFF2 + DFF + c); }
#pragma unroll
            for (int i = 0; i < 4; ++i) {
                float x[2][8], uc[2][8];
                unpack8(u[i][0], x[0]); unpack8(u[i][1], x[1]);
#pragma unroll
                for (int hf = 0; hf < 2; ++hf)
#pragma unroll
                    for (int e = 0; e < 8; ++e) { uc[hf][e] = bs[hf][e] + w[hf][0][e] * xm2[hf][e] + w[hf][1][e] * xm1[hf][e] + w[hf][2][e] * x[hf][e]; xm2[hf][e] = xm1[hf][e]; xm1[hf][e] = x[hf][e]; }
                float a[8];
#pragma unroll
                for (int e = 0; e < 8; ++e) a[e] = uc[0][e] * sigm(uc[0][e]) * uc[1][e];
                v4u o; o.x = pk2(a[0], a[1]); o.y = pk2(a[2], a[3]); o.z = pk2(a[4], a[5]); o.w = pk2(a[6], a[7]);
                *(v4u*)(ACT + (size_t)(row0 + r0 + i) * DFF + c) = o;
            }
        }
    }
}

template <bool COOP>
__global__ void __launch_bounds__(NT, 2) mega(Params P) {
    extern __shared__ __attribute__((aligned(16))) unsigned char lds_raw[];
    LAS unsigned char* lds = (LAS unsigned char*)lds_raw;
    Ctx C0; C0.tid = threadIdx.x; C0.lane = C0.tid & 63; C0.wave = __builtin_amdgcn_readfirstlane(C0.tid >> 6); C0.bid = blockIdx.x; C0.G = gridDim.x;
    C0.gw = C0.bid * 8 + C0.wave; C0.NGW = C0.G * 8;
    const int lo = P.ph_lo, hi = P.ph_hi;
    if (threadIdx.x < 4) ((LAS unsigned*)(lds + MISC_OFF))[threadIdx.x] = 0u;
    __syncthreads();
    XcdBarrier xbar; xbar.bar = nullptr; xbar.x = 0; xbar.st = nullptr;
    if constexpr (COOP) xbar = xcd_barrier_post((unsigned*)P.ws, (volatile LAS unsigned*)(lds + MISC_OFF));
#ifndef MK_ONLY
#define MK_ONLY -1
#endif
#define IN(k) ((MK_ONLY < 0 || MK_ONLY == (k)) && lo <= (k) && (k) < hi)
#define PH_CTX() Ctx C = C0; unsigned char* ws = wsbase(P); (void)ws; asm volatile("" : "+v"(C.tid), "+v"(C.lane), "+s"(C.wave), "+s"(C.gw), "+s"(C.bid))
#ifndef MK_REPMASK
#define MK_REPMASK 0
#endif
#define NREP(k) (((MK_REPMASK >> (k)) & 1) ? 2 : 1)
#define SEAM(k) do { if constexpr (COOP) { if (IN(k) && IN((k) + 1)) { if ((k) == 0) cg::this_grid().sync(); else xcd_barrier(xbar); } } } while (0)

    for (int rep_ = 0; rep_ < NREP(0); ++rep_) if (IN(0)) { PH_CTX(); p0_prologue(P, C, lds); __syncthreads(); }
    SEAM(0);
    for (int rep_ = 0; rep_ < NREP(1); ++rep_) if (IN(1)) { PH_CTX();
        { pg8::Gemm g{(const pg8::bf16_t*)(ws + WS_HB), (const pg8::bf16_t*)(ws + WS_WIN), M, NINP, D, D}; pg8::StaticOrder S; S.init(M, NINP, C.G, C.bid);
          pg8::EpiIn E{(pg8::bf16_t*)(ws + WS_GLU), (pg8::bf16_t*)(ws + WS_PR), P.out + O_CP, P.out + O_CS, P.out + O_SP, P.out + O_SS};
          pg8::gemm_phase<pg8::EpiIn, pg8::StaticOrder, PG8_ALIGN, PG8_SP2>(lds, g, S, E); }
        { pg8::Gemm g{(const pg8::bf16_t*)(ws + WS_MB), (const pg8::bf16_t*)(ws + WS_WKV), 1024, 4096, D, D}; pg8::StaticOrder S; S.init(1024, 4096, C.G, (C.bid + C.G - 24) % C.G);
          pg8::EpiKV E{P.out + O_MK, P.out + O_MV, (pg8::bf16_t*)(ws + WS_KB), (pg8::bf16_t*)(ws + WS_VT)};
          pg8::gemm_phase<pg8::EpiKV, pg8::StaticOrder, PG8_ALIGN, PG8_SP2>(lds, g, S, E); }
    }
    SEAM(1);
    for (int rep_ = 0; rep_ < NREP(2); ++rep_) if (IN(2)) { PH_CTX();
        {   int cs = C.bid, cst = C.G, cn = (640 - C.bid + C.G - 1) / C.G;
            if (C.G == 256) { if (C.bid < 112) { cst = 112; cn = 4; } else { cs = 448 + (C.bid - 112); cst = 144; cn = (cs + 144 < 640) ? 2 : 1; } }
            SUBREP(0) for (int i = 0; i < cn; ++i) { const int tk = cs + i * cst;
                if (tk < 512) { const int b = tk >> 7, r0 = (tk & 127) * 16; conv_task<16>(P, C, lds, b * SEQ + r0, r0, -1); }
                else { const int sb = tk - 512; conv_task<8>(P, C, lds, MP + 8 * sb, 0, sb); } } }
        SUBREP(1) for (int tk = (C.G == 256 ? C.bid - 112 : C.bid); tk < 144; tk += C.G) if (tk >= 0) prep_task<8>(P, C, lds, tk >> 1, (tk & 1) * 8);
    }
    SEAM(2);
    for (int rep_ = 0; rep_ < NREP(3); ++rep_) if (IN(3)) { PH_CTX();
        const float* swkv = inp(P, I_SWKV);
        SUBREP(2) for (int tk = C.bid; tk < 256; tk += C.G) scan_prompt(P, C, lds, tk >> 2, tk & 3, C.G == 256 && sr_ == 0);
        { const int nsw = C.G * 4, per = (SEQ / TC + 2) / 5; const int done_upto = (C.G == 256 ? nsw * per : 0);
          for (int it = done_upto + C.gw; it < NDEF; it += C.NGW) { const DefItem di = def_item(P, ws, it); transpose_item(di.W, di.K, di.N, di.WT, di.kb, di.jb, C.lane, MapId()); } }
        SUBREP(3) for (int tk = C.bid; tk < 4096; tk += C.G) scan_sample(P, C, swkv, tk >> 1, tk & 1);
    }
    SEAM(3);
    for (int rep_ = 0; rep_ < NREP(4); ++rep_) if (IN(4)) { PH_CTX(); for (int m = C.gw; m < M; m += C.NGW) post_row(P, m, C.lane); }
    SEAM(4);
    for (int rep_ = 0; rep_ < NREP(5); ++rep_) if (IN(5)) { PH_CTX();
        { pg8::Gemm g{(const pg8::bf16_t*)(ws + WS_A2), (const pg8::bf16_t*)(ws + WS_WOUT), MP, D, D, D}; pg8::StaticOrder S; S.init(MP, D, C.G, C.bid);
          pg8::EpiF32 E{(float*)(ws + WS_MIX), D, 0}; pg8::gemm_phase<pg8::EpiF32, pg8::StaticOrder, PG8_ALIGN, PG8_SP2>(lds, g, S, E); }
        { pg8::Gemm g{(const pg8::bf16_t*)(ws + WS_A2) + (size_t)MP * D, (const pg8::bf16_t*)(ws + WS_WOUT), MS, D, D / 8, D}; pg8::SplitOrder S; S.init(MS, D, 8, C.G, C.bid);
          pg8::EpiF32 E{(float*)(ws + WS_SLAB), D, SLAB_F}; pg8::gemm_phase<pg8::EpiF32, pg8::SplitOrder, PG8_ALIGN, PG8_SP2>(lds, g, S, E); } }
    SEAM(5);
    for (int rep_ = 0; rep_ < NREP(6); ++rep_) if (IN(6)) { PH_CTX(); const float* xp = inp(P, I_XP); const float* xs = inp(P, I_XS); const float* g1 = inp(P, I_NMIXPOST); const float* g2 = inp(P, I_NXAPRE);
        for (int m = C.gw; m < M; m += C.NGW) { const float* xr = m < MP ? xp + (size_t)m * D : xs + (size_t)(m - MP) * D;
        const float* mx = m < MP ? (const float*)(ws + WS_MIX) + (size_t)m * D : (const float*)(ws + WS_SLAB) + (size_t)(m - MP) * D;
        rowpass(xr, mx, m < MP ? 1 : 8, g1, (float*)(ws + WS_X1) + (size_t)m * D, g2, (bf16*)(ws + WS_HB) + (size_t)m * D, C.lane); } }
    SEAM(6);
    for (int rep_ = 0; rep_ < NREP(7); ++rep_) if (IN(7)) { PH_CTX();
        { pg8::Gemm g{(const pg8::bf16_t*)(ws + WS_HB), (const pg8::bf16_t*)(ws + WS_WQ), MP, D, D, D}; pg8::StaticOrder S; S.init(MP, D, C.G, C.bid);
          pg8::EpiBf16S E{(pg8::bf16_t*)(ws + WS_Q), D, 0.06375871479f  , nullptr};
          pg8::gemm_phase<pg8::EpiBf16S, pg8::StaticOrder, PG8_ALIGN, PG8_SP2>(lds, g, S, E); }
        { pg8::Gemm g{(const pg8::bf16_t*)(ws + WS_HB) + (size_t)MP * D, (const pg8::bf16_t*)(ws + WS_WQ), MS, D, D / 8, D}; pg8::SplitOrder S; S.init(MS, D, 8, C.G, C.bid);
          pg8::EpiF32 E{(float*)(ws + WS_SLAB), D, SLAB_F}; pg8::gemm_phase<pg8::EpiF32, pg8::SplitOrder, PG8_ALIGN, PG8_SP2>(lds, g, S, E); } }
    SEAM(7);
    for (int rep_ = 0; rep_ < NREP(8); ++rep_) if (IN(8)) { PH_CTX();
        SUBREP(4) for (int tk = C.bid; tk < 256; tk += C.G) attn_prompt_task(P, C, lds, tk >> 6, (tk >> 4) & 3, tk & 15);
        SUBREP(5) for (int tk = C.bid; tk < 512; tk += C.G) attn_sample_task(P, C, lds, tk >> 2, tk & 3);
    }
    SEAM(8);
    for (int rep_ = 0; rep_ < NREP(9); ++rep_) if (IN(9)) { PH_CTX();
        { pg8::Gemm g{(const pg8::bf16_t*)(ws + WS_O), (const pg8::bf16_t*)(ws + WS_WO), MP, D, D, D}; pg8::StaticOrder S; S.init(MP, D, C.G, C.bid);
          pg8::EpiF32 E{(float*)(ws + WS_MIX), D, 0}; pg8::gemm_phase<pg8::EpiF32, pg8::StaticOrder, PG8_ALIGN, PG8_SP2>(lds, g, S, E); }
        { pg8::Gemm g{(const pg8::bf16_t*)(ws + WS_O) + (size_t)MP * D, (const pg8::bf16_t*)(ws + WS_WO), MS, D, D / 8, D}; pg8::SplitOrder S; S.init(MS, D, 8, C.G, C.bid);
          pg8::EpiF32 E{(float*)(ws + WS_SLAB), D, SLAB_F}; pg8::gemm_phase<pg8::EpiF32, pg8::SplitOrder, PG8_ALIGN, PG8_SP2>(lds, g, S, E); } }
    SEAM(9);
    for (int rep_ = 0; rep_ < NREP(10); ++rep_) if (IN(10)) { PH_CTX(); const float* g1 = inp(P, I_NXAPOST); const float* g2 = inp(P, I_NFFNPRE);
        for (int m = C.gw; m < M; m += C.NGW) { float* x1 = (float*)(ws + WS_X1) + (size_t)m * D;
        const float* mx = m < MP ? (const float*)(ws + WS_MIX) + (size_t)m * D : (const float*)(ws + WS_SLAB) + (size_t)(m - MP) * D;
        rowpass(x1, mx, m < MP ? 1 : 8, g1, x1, g2, (bf16*)(ws + WS_HB) + (size_t)m * D, C.lane); } }
    SEAM(10);
    for (int rep_ = 0; rep_ < NREP(11); ++rep_) if (IN(11)) { PH_CTX(); pg8::Gemm g{(const pg8::bf16_t*)(ws + WS_HB), (const pg8::bf16_t*)(ws + WS_WUP), M, DFF2, D, D}; pg8::StaticOrder S; S.init(M, DFF2, C.G, C.bid);
        pg8::EpiBf16S E{(pg8::bf16_t*)(ws + WS_UP), DFF2, 1.0f, P.out + O_FP};
        pg8::gemm_phase<pg8::EpiBf16S, pg8::StaticOrder, PG8_ALIGN, PG8_SP2>(lds, g, S, E); }
    SEAM(11);
    for (int rep_ = 0; rep_ < NREP(12); ++rep_) if (IN(12)) { PH_CTX(); ffn_conv_act(P, C); }
    SEAM(12);
    for (int rep_ = 0; rep_ < NREP(13); ++rep_) if (IN(13)) { PH_CTX();
        { pg8::Gemm g{(const pg8::bf16_t*)(ws + WS_ACT), (const pg8::bf16_t*)(ws + WS_WDN), MP, D, DFF, DFF}; pg8::StaticOrder S; S.init(MP, D, C.G, C.bid);
          pg8::EpiF32 E{(float*)(ws + WS_MIX), D, 0}; pg8::gemm_phase<pg8::EpiF32, pg8::StaticOrder, PG8_ALIGN, PG8_SP2>(lds, g, S, E); }
        { pg8::Gemm g{(const pg8::bf16_t*)(ws + WS_ACT) + (size_t)MP * DFF, (const pg8::bf16_t*)(ws + WS_WDN), MS, D, DFF / 4, DFF}; pg8::SplitOrder S; S.init(MS, D, 4, C.G, (C.bid + 128) % C.G);
          pg8::EpiF32 E{(float*)(ws + WS_SLAB), D, SLAB_F}; pg8::gemm_phase<pg8::EpiF32, pg8::SplitOrder, PG8_ALIGN, PG8_SP2>(lds, g, S, E); } }
    SEAM(13);
    for (int rep_ = 0; rep_ < NREP(14); ++rep_) if (IN(14)) { PH_CTX(); const float* g1 = inp(P, I_NFFNPOST);
        for (int m = C.gw; m < M; m += C.NGW) { const float* x2 = (const float*)(ws + WS_X1) + (size_t)m * D;
        float* yo = m < MP ? P.out + O_YP + (size_t)m * D : P.out + O_YS + (size_t)(m - MP) * D;
        const float* mx = m < MP ? (const float*)(ws + WS_MIX) + (size_t)m * D : (const float*)(ws + WS_SLAB) + (size_t)(m - MP) * D;
        rowpass(x2, mx, m < MP ? 1 : 4, g1, yo, nullptr, nullptr, C.lane); } }
#undef IN
#undef SEAM
}

#ifndef MK_ONE_LAUNCH
#define MK_ONE_LAUNCH 1
#endif
extern "C" void kernel_launch(void* const* d_in, const int* in_sizes, int n_in, void* d_out, int out_size, void* d_ws, size_t ws_size, hipStream_t stream) {
    static int grid = 0;
    if (grid == 0) {
        if (n_in != N_IN || (size_t)out_size != O_END || ws_size < WS_END) { fprintf(stderr, "kernel_launch: unexpected sizes: n_in %d out %d ws %zu (need %zu)\n", n_in, out_size, ws_size, (size_t)WS_END); grid = -1; return; }
        int dev = 0, cus = 0, per_cu = 0;
        (void)hipGetDevice(&dev); (void)hipDeviceGetAttribute(&cus, hipDeviceAttributeMultiprocessorCount, dev);
        (void)hipFuncSetAttribute((const void*)mega<(MK_ONE_LAUNCH != 0)>, hipFuncAttributeMaxDynamicSharedMemorySize, LDS_BYTES);
        (void)hipOccupancyMaxActiveBlocksPerMultiprocessor(&per_cu, (const void*)mega<(MK_ONE_LAUNCH != 0)>, NT, LDS_BYTES);
        fprintf(stderr, "kernel_launch: cus %d, occupancy query %d block(s)/CU, ws %zu MiB\n", cus, per_cu, ws_size >> 20);
        (void)hipGetLastError();
        grid = cus;
        if (per_cu < 1) { fprintf(stderr, "kernel_launch: occupancy query says 0 blocks per CU\n"); }
    }
    if (grid < 0) return;
    if (hipMemsetAsync(d_ws, 0, 16384, stream) != hipSuccess) { fprintf(stderr, "kernel_launch: hipMemsetAsync failed\n"); return; }
    Params p{};
    for (int i = 0; i < N_IN; ++i) p.in[i] = (const float*)d_in[i];
    p.out = (float*)d_out; p.ws = (unsigned char*)d_ws;
#if MK_ONE_LAUNCH
    p.ph_lo = 0; p.ph_hi = NPHASE;
    void* args[] = {&p};
    hipError_t e = hipLaunchCooperativeKernel((const void*)mega<true>, dim3(grid), dim3(NT), args, LDS_BYTES, stream);
    if (e != hipSuccess) fprintf(stderr, "cooperative launch failed: %s (grid %d)\n", hipGetErrorString(e), grid);
#else
    for (int ph = 0; ph < NPHASE; ++ph) { p.ph_lo = ph; p.ph_hi = ph + 1; hipLaunchKernelGGL((mega<false>), dim3(grid), dim3(NT), LDS_BYTES, stream, p); }
#endif
}
```

```cpp
#include <hip/hip_runtime.h>
#include <hip/hip_cooperative_groups.h>
#include <cstdio>
#include <cstdint>
namespace cg = cooperative_groups;
constexpr int D = 2048, MP = 8192, MS = 1024, M = MP + MS, SEQ = 2048, TS = 8, NBP = 4, NBS = 128;
constexpr int CC = 1024, CW = 31, RW = 1024, RH = 16, HD = 64;
constexpr int NRC = 3520, NRCP = 3584, NINP = 5632;
constexpr int NMEM = 256, XH = 4, XD = 512, DFF = 5632, DFF2 = 11264;
namespace pg8 {
#define PG8_LAS __attribute__((address_space(3)))
typedef unsigned short bf16_t;
typedef short bf16x8 __attribute__((ext_vector_type(8)));
typedef float f32x4 __attribute__((ext_vector_type(4)));
typedef unsigned u32x4 __attribute__((ext_vector_type(4)));
constexpr int BM = 256, BK = 64, HALF = 128, HTB = HALF * BK * 2  , STAGE_BYTES = 8 * HTB, NXCD = 8, WGM = 8;

__host__ __device__ __forceinline__ int lds_byte(int r, int c) { const int st = (r >> 4) * 2 + (c >> 5), rr = r & 15, cc = c & 31, ob = rr * 64 + cc * 2; return st * 1024 + (ob ^ (((ob >> 9) & 1) << 5)); }
__host__ __device__ __forceinline__ void stage_rc(int b, int& R, int& C) { const int st = b / 1024, sb = b % 1024, swz = sb ^ (((sb >> 9) & 1) << 5); R = (st >> 1) * 16 + swz / 64; C = (st & 1) * 32 + (swz % 64) / 2; }
__host__ __device__ __forceinline__ int perm32(int rho) { const int n = rho >> 4, i = rho & 15; return 8 * (i >> 2) + 4 * n + (i & 3); }

struct Unit { int pm, pn, ks; };
struct Gemm { const bf16_t* A; const bf16_t* Bt; int M, N, K, ld; };

struct StaticOrder {
    int nM, nN, nwg, G, c;
    __host__ __device__ void init(int M, int N, int G_, int c_) { nM = M / BM; nN = N / BM; nwg = nM * nN; G = G_; c = c_; }
    __host__ __device__ bool next(int i, Unit& u) const {
        const long L = (long)i * G + c; if (L >= nwg) return false;
        int wgid = (int)L; { const int q = nwg / NXCD, r = nwg % NXCD, xcd = wgid % NXCD, off = wgid / NXCD; wgid = (xcd < r ? xcd * (q + 1) : r * (q + 1) + (xcd - r) * q) + off; }
        const int nig = WGM * nN, gid = wgid / nig, fm = gid * WGM, gsz = (nM - fm) < WGM ? (nM - fm) : WGM;
        u.pm = fm + ((wgid % nig) % gsz); u.pn = (wgid % nig) / gsz; u.ks = 0; return true;
    }
    __device__ __forceinline__ void a_ready(const Unit&) const {}
    __device__ __forceinline__ void done(const Unit&) const {}
};

struct SplitOrder {
    int nN, nsplit, nitems, G, c;
    __host__ __device__ void init(int M, int N, int nsplit_, int G_, int c_) { nN = N / BM; nsplit = nsplit_; nitems = (M / BM) * nN * nsplit_; G = G_; c = c_; }
    __host__ __device__ bool next(int i, Unit& u) const { const int L = i * G + c; if (L >= nitems) return false; u.ks = L % nsplit; const int t = L / nsplit; u.pn = t % nN; u.pm = t / nN; return true; }
    __device__ __forceinline__ void a_ready(const Unit&) const {}
    __device__ __forceinline__ void done(const Unit&) const {}
};
__device__ __forceinline__ unsigned cvt_pk_bf16(float lo, float hi) { unsigned r; asm volatile("v_cvt_pk_bf16_f32 %0, %1, %2" : "=v"(r) : "v"(lo), "v"(hi)); return r; }
typedef float f32x2 __attribute__((ext_vector_type(2)));
typedef unsigned u32x2 __attribute__((ext_vector_type(2)));
struct EpiIn {
    static constexpr bool PERM = true, AFTER_DRAIN = false;
    bf16_t* glu; bf16_t* pr; float* oconv_p; float* oconv_s; float* oshift_p; float* oshift_s;
    __device__ __forceinline__ void operator()(const f32x4 (&acc)[2][2][4][2], const Unit& u, int wr, int wc, int fr, int fq) const {
        const int row0 = u.pm * BM + wr * 64 + fr;
        if (u.pn < 8) {
#pragma unroll
            for (int ai = 0; ai < 2; ++ai)
#pragma unroll
                for (int m = 0; m < 4; ++m) {
                    const int row = row0 + ai * HALF + m * 16;
                    float* cdst = nullptr;
                    if (row < MP) { const int t = row & (SEQ - 1); if (t >= SEQ - 30) cdst = oconv_p + (size_t)((row >> 11) * 30 + (t - (SEQ - 30))) * CC; }
                    else { const int rs = row - MP; cdst = oconv_s + (size_t)((rs >> 3) * 30 + 22 + (rs & 7)) * CC; }
#pragma unroll
                    for (int bj = 0; bj < 2; ++bj) {
                        const int cgl = 16 * (8 * u.pn + 4 * bj + wc) + 4 * fq;
                        const f32x4 a = acc[ai][bj][m][0], g = acc[ai][bj][m][1];
                        f32x4 v;
#pragma unroll
                        for (int e = 0; e < 4; ++e) v[e] = a[e] / (1.0f + __expf(-g[e]));
                        u32x2 w; w.x = cvt_pk_bf16(v[0], v[1]); w.y = cvt_pk_bf16(v[2], v[3]);
                        *(u32x2*)(glu + (size_t)row * CC + cgl) = w;
                        if (cdst) *(f32x4*)(cdst + cgl) = v;
                    }
                }
        } else {
#pragma unroll
            for (int ai = 0; ai < 2; ++ai)
#pragma unroll
                for (int m = 0; m < 4; ++m) {
                    const int row = row0 + ai * HALF + m * 16;
                    float* sdst = nullptr;
                    if (row < MP) { if ((row & (SEQ - 1)) == SEQ - 1) sdst = oshift_p + (size_t)(row >> 11) * NRC; }
                    else { const int rs = row - MP; if ((rs & 7) == 7) sdst = oshift_s + (size_t)(rs >> 3) * NRC; }
#pragma unroll
                    for (int bj = 0; bj < 2; ++bj) {
                        const int jj0 = 256 * (u.pn - 8) + 128 * bj + 32 * wc + 8 * fq;
                        const f32x4 v0 = acc[ai][bj][m][0], v1 = acc[ai][bj][m][1];
                        u32x4 w; w.x = cvt_pk_bf16(v0[0], v0[1]); w.y = cvt_pk_bf16(v0[2], v0[3]); w.z = cvt_pk_bf16(v1[0], v1[1]); w.w = cvt_pk_bf16(v1[2], v1[3]);
                        *(u32x4*)(pr + (size_t)row * NRCP + jj0) = w;
                        if (sdst && jj0 < NRC) { *(f32x4*)(sdst + jj0) = v0; *(f32x4*)(sdst + jj0 + 4) = v1; }
                    }
                }
        }
    }
};
struct EpiKV {
    static constexpr bool PERM = false, AFTER_DRAIN = false;
    float* ok; float* ov; bf16_t* kb; bf16_t* vt;
    __device__ __forceinline__ void operator()(const f32x4 (&acc)[2][2][4][2], const Unit& u, int wr, int wc, int fr, int fq) const {
        const int row0 = u.pm * BM + wr * 64 + fr;
#pragma unroll
        for (int ai = 0; ai < 2; ++ai)
#pragma unroll
            for (int m = 0; m < 4; ++m) {
                const int r = row0 + ai * HALF + m * 16;
#pragma unroll
                for (int bj = 0; bj < 2; ++bj)
#pragma unroll
                    for (int n = 0; n < 2; ++n) {
                        const int c = 256 * u.pn + 128 * bj + 32 * wc + 16 * n + 4 * fq;
                        const f32x4 v = acc[ai][bj][m][n];
                        if (u.pn < 8) {
                            *(f32x4*)(ok + (size_t)r * 2048 + c) = v;
                            u32x2 w; w.x = cvt_pk_bf16(v[0], v[1]); w.y = cvt_pk_bf16(v[2], v[3]);
                            *(u32x2*)(kb + (size_t)r * 2048 + c) = w;
                        } else {
                            const int cv = c - 2048;
                            *(f32x4*)(ov + (size_t)r * 2048 + cv) = v;
                            const int b = r >> 8, key = r & 255, h = cv >> 9, d = cv & 511;
                            bf16_t* dst = vt + ((size_t)((b * 4 + h) * 512 + d)) * 256 + key;
                            const unsigned w0 = cvt_pk_bf16(v[0], v[1]), w1 = cvt_pk_bf16(v[2], v[3]);
                            dst[0] = (bf16_t)(w0 & 0xffffu); dst[256] = (bf16_t)(w0 >> 16); dst[512] = (bf16_t)(w1 & 0xffffu); dst[768] = (bf16_t)(w1 >> 16);
                        }
                    }
            }
    }
};
struct EpiF32 {
    static constexpr bool PERM = false, AFTER_DRAIN = false;
    float* C; int ldc; size_t slab;
    __device__ __forceinline__ void operator()(const f32x4 (&acc)[2][2][4][2], const Unit& u, int wr, int wc, int fr, int fq) const {
        const int row0 = u.pm * BM + wr * 64 + fr, col0 = u.pn * BM + wc * 32 + 4 * fq;
#pragma unroll
        for (int ai = 0; ai < 2; ++ai)
#pragma unroll
            for (int m = 0; m < 4; ++m) { float* rowp = C + (size_t)u.ks * slab + (size_t)(row0 + ai * HALF + m * 16) * ldc + col0;
#pragma unroll
                for (int bj = 0; bj < 2; ++bj)
#pragma unroll
                    for (int n = 0; n < 2; ++n) *(f32x4*)(rowp + bj * HALF + n * 16) = acc[ai][bj][m][n]; }
    }
};
struct EpiBf16S {
    static constexpr bool PERM = true, AFTER_DRAIN = false;
    bf16_t* O; int ldc; float scale; float* f;
    __device__ __forceinline__ void operator()(const f32x4 (&acc)[2][2][4][2], const Unit& u, int wr, int wc, int fr, int fq) const {
        const int row0 = u.pm * BM + wr * 64 + fr, col0 = u.pn * BM + wc * 32 + 8 * fq;
#pragma unroll
        for (int ai = 0; ai < 2; ++ai)
#pragma unroll
            for (int m = 0; m < 4; ++m) {
                const int row = row0 + ai * HALF + m * 16;
                long foff = -1;
                if (f) {
                    if (row < MP) { const int t = row & (SEQ - 1); if (t >= SEQ - 2) foff = (long)((row >> 11) * 2 + (t - (SEQ - 2))) * DFF2; }
                    else { const int rs = row - MP, t = rs & 7; if (t >= 6) foff = (long)(NBP * 2 + (rs >> 3) * 2 + (t - 6)) * DFF2; }
                }
                float* fdst = f + (foff < 0 ? 0 : foff);
                bf16_t* rowp = O + (size_t)row * ldc + col0;
#pragma unroll
                for (int bj = 0; bj < 2; ++bj) {
                    const f32x4 v0 = acc[ai][bj][m][0] * scale, v1 = acc[ai][bj][m][1] * scale;
                    u32x4 w; w.x = cvt_pk_bf16(v0[0], v0[1]); w.y = cvt_pk_bf16(v0[2], v0[3]); w.z = cvt_pk_bf16(v1[0], v1[1]); w.w = cvt_pk_bf16(v1[2], v1[3]);
                    *(u32x4*)(rowp + bj * HALF) = w;
                    if (foff >= 0) { *(f32x4*)(fdst + col0 + bj * HALF) = v0; *(f32x4*)(fdst + col0 + bj * HALF + 4) = v1; }
                }
            }
    }
};

template <class Epi, class Sched, bool ALIGN_EPI = false, bool SP2 = false>
__device__ __forceinline__ void gemm_phase(PG8_LAS unsigned char* lds, const Gemm g, const Sched& S, const Epi& E) {
    int tid_ = threadIdx.x; asm volatile("" : "+v"(tid_));
    const int tid = tid_, wid = __builtin_amdgcn_readfirstlane(tid >> 6), lane = tid & 63, wr = wid >> 2, wc = wid & 3, fr = lane & 15, fq = lane >> 4;
    const int K = g.K, nt = K / BK;
    unsigned voffA[2], voffB[2];
#pragma unroll
    for (int i = 0; i < 2; ++i) { int R, C; stage_rc(tid * 16 + i * 8192, R, C); const int Rb = Epi::PERM ? ((R & ~31) + perm32(R & 31)) : R;
        voffA[i] = (unsigned)(R * g.ld + C) * 2u; voffB[i] = (unsigned)(Rb * g.ld + C) * 2u; }
    const size_t kstep = (size_t)(BK * 2);
    const size_t hstep = (size_t)HALF * g.ld * 2;
    const size_t tstep = 2 * hstep;
    const unsigned ldsw = (unsigned)wid * 1024u;
    const int aoff = lds_byte(wr * 64 + fr, fq * 8), boff = lds_byte(wc * 32 + fr, fq * 8);
#define PG8_SA(b, h) (((b) * 2 + (h)) * HTB)
#define PG8_SB(b, h) ((4 + (b) * 2 + (h)) * HTB)
#define PG8_STAGE(bufoff, gbase, voff) do { _Pragma("unroll") for (int _i = 0; _i < 2; ++_i) \
        __builtin_amdgcn_global_load_lds((const unsigned*)((const char*)(gbase) + (voff)[_i]), (PG8_LAS unsigned*)(lds + (bufoff) + ldsw + _i * 8192), 16, 0, 0); } while (0)
#define PG8_LDA(dst, b, h) do { _Pragma("unroll") for (int m = 0; m < 4; ++m) _Pragma("unroll") for (int k = 0; k < 2; ++k) dst[m][k] = *(const PG8_LAS bf16x8*)(lds + PG8_SA(b, h) + aoff + m * 2048 + k * 1024); } while (0)
#define PG8_LDB(dst, b, h) do { _Pragma("unroll") for (int n = 0; n < 2; ++n) _Pragma("unroll") for (int k = 0; k < 2; ++k) dst[n][k] = *(const PG8_LAS bf16x8*)(lds + PG8_SB(b, h) + boff + n * 2048 + k * 1024); } while (0)
#define PG8_MMA(ai, bj, At, Bt) do { __builtin_amdgcn_s_setprio(1); _Pragma("unroll") for (int m = 0; m < 4; ++m) _Pragma("unroll") for (int n = 0; n < 2; ++n) _Pragma("unroll") for (int k = 0; k < 2; ++k) \
        acc[ai][bj][m][n] = __builtin_amdgcn_mfma_f32_16x16x32_bf16(Bt[n][k], At[m][k], acc[ai][bj][m][n], 0, 0, 0); __builtin_amdgcn_s_setprio(0); } while (0)
#define PG8_WAIT_V(n) asm volatile("s_waitcnt vmcnt(" #n ")" ::: "memory")
#define PG8_WAIT_L(n) asm volatile("s_waitcnt lgkmcnt(" #n ")" ::: "memory")
#define PG8_BAR __builtin_amdgcn_s_barrier()
#define PG8_SCHED __builtin_amdgcn_sched_barrier(0)
    Unit cur, nxt; int ui = 0;
    if (!S.next(0, cur)) return;
    f32x4 acc[2][2][4][2];
#pragma unroll
    for (int a = 0; a < 2; ++a)
#pragma unroll
        for (int b = 0; b < 2; ++b)
#pragma unroll
            for (int m = 0; m < 4; ++m)
#pragma unroll
                for (int n = 0; n < 2; ++n) acc[a][b][m][n] = (f32x4){0.f, 0.f, 0.f, 0.f};
    bf16x8 At[4][2], B0[2][2], B1[2][2];
    const size_t sstep = (size_t)K * 2;
    const char* cA = (const char*)g.A + (size_t)cur.pm * tstep + (size_t)cur.ks * sstep; const char* cB = (const char*)g.Bt + (size_t)cur.pn * tstep + (size_t)cur.ks * sstep;
    S.a_ready(cur);
    if constexpr (SP2) {
        PG8_STAGE(PG8_SB(0, 0), cB, voffB); PG8_STAGE(PG8_SB(0, 1), cB + hstep, voffB); PG8_STAGE(PG8_SA(0, 0), cA, voffA); PG8_STAGE(PG8_SA(0, 1), cA + hstep, voffA);
        if (wr == 1) PG8_BAR;
        PG8_WAIT_V(2); PG8_BAR;
        PG8_STAGE(PG8_SB(1, 0), cB + kstep, voffB); PG8_STAGE(PG8_SA(1, 0), cA + kstep, voffA); PG8_STAGE(PG8_SB(1, 1), cB + hstep + kstep, voffB);
        PG8_WAIT_V(6); PG8_BAR;
    } else {
        PG8_STAGE(PG8_SB(0, 0), cB, voffB); PG8_STAGE(PG8_SA(0, 0), cA, voffA); PG8_STAGE(PG8_SB(0, 1), cB + hstep, voffB); PG8_STAGE(PG8_SA(0, 1), cA + hstep, voffA);
        if (wr == 1) PG8_BAR;
        PG8_WAIT_V(4); PG8_BAR;
        PG8_STAGE(PG8_SB(1, 0), cB + kstep, voffB); PG8_STAGE(PG8_SA(1, 0), cA + kstep, voffA); PG8_STAGE(PG8_SB(1, 1), cB + hstep + kstep, voffB);
        PG8_WAIT_V(6); PG8_BAR;
    }
    for (;;) {
        const bool has_next = S.next(ui + 1, nxt);
        const char* nA = has_next ? (const char*)g.A + (size_t)nxt.pm * tstep + (size_t)nxt.ks * sstep : cA; const char* nB = has_next ? (const char*)g.Bt + (size_t)nxt.pn * tstep + (size_t)nxt.ks * sstep : cB;
        for (int t = 0; t < nt; t += 2) {
            const bool last = (t == nt - 2);
            const char* a1 = cA + (size_t)(t + 1) * kstep;
            const char* a2 = last ? nA : cA + (size_t)(t + 2) * kstep; const char* b2 = last ? nB : cB + (size_t)(t + 2) * kstep;
            const char* a3 = a2 + kstep; const char* b3 = b2 + kstep;
            if (last && has_next) S.a_ready(nxt);
            if constexpr (SP2) {
            PG8_LDB(B0, 0, 0); PG8_LDB(B1, 0, 1); PG8_SCHED; PG8_LDA(At, 0, 0); PG8_STAGE(PG8_SA(1, 1), a1 + hstep, voffA);
            PG8_WAIT_V(8); PG8_WAIT_L(0); PG8_BAR; PG8_MMA(0, 0, At, B0); PG8_MMA(0, 1, At, B1); PG8_BAR; PG8_SCHED;
            PG8_LDA(At, 0, 1); PG8_STAGE(PG8_SB(0, 0), b2, voffB); PG8_STAGE(PG8_SB(0, 1), b2 + hstep, voffB); PG8_STAGE(PG8_SA(0, 0), a2, voffA);
            PG8_WAIT_V(8); PG8_WAIT_L(0); PG8_BAR; PG8_MMA(1, 0, At, B0); PG8_MMA(1, 1, At, B1); PG8_BAR; PG8_SCHED;
            PG8_LDB(B0, 1, 0); PG8_LDB(B1, 1, 1); PG8_SCHED; PG8_LDA(At, 1, 0); PG8_STAGE(PG8_SA(0, 1), a2 + hstep, voffA);
            PG8_WAIT_V(8); PG8_WAIT_L(0); PG8_BAR; PG8_MMA(0, 0, At, B0); PG8_MMA(0, 1, At, B1); PG8_BAR; PG8_SCHED;
            PG8_LDA(At, 1, 1); PG8_STAGE(PG8_SB(1, 0), b3, voffB); PG8_STAGE(PG8_SB(1, 1), b3 + hstep, voffB); PG8_STAGE(PG8_SA(1, 0), a3, voffA);
            PG8_WAIT_V(8); PG8_WAIT_L(0); PG8_BAR; PG8_MMA(1, 0, At, B0); PG8_MMA(1, 1, At, B1); PG8_BAR; PG8_SCHED;
            } else {
            PG8_LDB(B0, 0, 0); PG8_SCHED; PG8_LDA(At, 0, 0); PG8_STAGE(PG8_SA(1, 1), a1 + hstep, voffA);
            PG8_WAIT_L(8); PG8_BAR; PG8_WAIT_L(0); PG8_MMA(0, 0, At, B0); PG8_BAR; PG8_SCHED;
            PG8_LDB(B1, 0, 1); PG8_STAGE(PG8_SB(0, 0), b2, voffB);
            PG8_BAR; PG8_WAIT_L(0); PG8_MMA(0, 1, At, B1); PG8_BAR;
            PG8_LDA(At, 0, 1); PG8_STAGE(PG8_SA(0, 0), a2, voffA);
            PG8_BAR; PG8_WAIT_L(0); PG8_MMA(1, 0, At, B0); PG8_BAR; PG8_SCHED;
            PG8_STAGE(PG8_SB(0, 1), b2 + hstep, voffB);
            PG8_WAIT_V(6); PG8_BAR; PG8_MMA(1, 1, At, B1); PG8_BAR;
            PG8_LDB(B0, 1, 0); PG8_SCHED; PG8_LDA(At, 1, 0); PG8_STAGE(PG8_SA(0, 1), a2 + hstep, voffA);
            PG8_WAIT_L(8); PG8_BAR; PG8_WAIT_L(0); PG8_MMA(0, 0, At, B0); PG8_BAR; PG8_SCHED;
            PG8_LDB(B1, 1, 1); PG8_STAGE(PG8_SB(1, 0), b3, voffB);
            PG8_BAR; PG8_WAIT_L(0); PG8_MMA(0, 1, At, B1); PG8_BAR;
            PG8_LDA(At, 1, 1); PG8_STAGE(PG8_SA(1, 0), a3, voffA);
            PG8_BAR; PG8_WAIT_L(0); PG8_MMA(1, 0, At, B0); PG8_BAR; PG8_SCHED;
            PG8_STAGE(PG8_SB(1, 1), b3 + hstep, voffB);
            PG8_WAIT_V(6); PG8_BAR; PG8_MMA(1, 1, At, B1); PG8_BAR;
            }
        }
        if constexpr (ALIGN_EPI) { if (wr == 0) PG8_BAR; }
        if constexpr (!Epi::AFTER_DRAIN) { E(acc, cur, wr, wc, fr, fq); S.done(cur); }
        if (!has_next) break;
#pragma unroll
        for (int a = 0; a < 2; ++a)
#pragma unroll
            for (int b = 0; b < 2; ++b)
#pragma unroll
                for (int m = 0; m < 4; ++m)
#pragma unroll
                    for (int n = 0; n < 2; ++n) acc[a][b][m][n] = (f32x4){0.f, 0.f, 0.f, 0.f};
        cur = nxt; cA = nA; cB = nB; ++ui;
        if constexpr (ALIGN_EPI) { if (wr == 1) PG8_BAR; }
    }
    PG8_WAIT_V(0);
    if constexpr (!ALIGN_EPI) { if (wr == 0) PG8_BAR; }
    PG8_BAR;
    if constexpr (Epi::AFTER_DRAIN) { E.fused(acc, cur, wr, wc, fr, fq, lds, wid, lane); S.done(cur); }
#undef PG8_SA
#undef PG8_SB
#undef PG8_STAGE
#undef PG8_LDA
#undef PG8_LDB
#undef PG8_MMA
#undef PG8_WAIT_V
#undef PG8_WAIT_L
#undef PG8_BAR
#undef PG8_SCHED
}
}
#ifndef PG8_SP2
#define PG8_SP2 true
#endif
#ifndef PG8_ALIGN
#define PG8_ALIGN true
#endif
#define LAS __attribute__((address_space(3)))
typedef unsigned short bf16;
typedef unsigned v4u __attribute__((ext_vector_type(4)));
typedef unsigned v2u __attribute__((ext_vector_type(2)));
typedef float f32x4 __attribute__((ext_vector_type(4)));
typedef float f32x2 __attribute__((ext_vector_type(2)));
typedef short bf16x8 __attribute__((ext_vector_type(8)));
constexpr int NT = 512;
constexpr int LDS_BYTES = 147456;
constexpr int NPHASE = 15;

constexpr size_t MiB = 1u << 20;
constexpr size_t WS_WIN = 1 * MiB, WS_WKV = 23 * MiB, WS_WOUT = 39 * MiB, WS_WQ = 47 * MiB, WS_WO = 55 * MiB, WS_WUP = 63 * MiB, WS_WDN = 107 * MiB;
constexpr size_t WS_LW = 129 * MiB, WS_LA = 129 * MiB + 256 * 1024, WS_LG = 129 * MiB + 512 * 1024;
constexpr size_t WS_HB = 130 * MiB, WS_MB = 166 * MiB, WS_A2 = 170 * MiB, WS_MIX = 206 * MiB, WS_X1 = 278 * MiB, WS_Q = 350 * MiB, WS_O = 386 * MiB;
constexpr size_t WS_KB = 422 * MiB, WS_VT = 426 * MiB, WS_Y = 430 * MiB, WS_G = 466 * MiB, WS_BON = 502 * MiB;
constexpr size_t WS_SHB = 818 * MiB;
constexpr size_t WS_SI = 503 * MiB, SB_STRIDE = 18 * MiB;
constexpr size_t WS_SW = WS_SI + 5 * SB_STRIDE;
constexpr size_t WS_UP = 503 * MiB;
constexpr size_t WS_GLU = 719 * MiB, WS_PR = 737 * MiB;
constexpr size_t WS_ACT = 719 * MiB;
constexpr size_t WS_HIMG = 820 * MiB;
constexpr size_t WS_SLAB = 822 * MiB, SLAB_F = (size_t)MS * D;
constexpr size_t WS_END = 886 * MiB;
constexpr size_t O_YP = 0, O_YS = 16777216, O_CP = 18874368, O_CS = 18997248, O_SP = 22929408, O_SS = 22943488, O_WP = 23394048, O_WS = 23656192,
                 O_FP = 32044800, O_FS = 32134912, O_MK = 35018496, O_MV = 37115648, O_END = 39212800;

enum { I_XP = 0, I_XS, I_CK, I_CV, I_SCONV, I_SSHIFT, I_SWKV, I_SFFN, I_MEM, I_NMIXPRE, I_WIN, I_CDW, I_CDWB, I_CLNG, I_CLNB, I_MU, I_W0, I_WLORA, I_A0, I_ALORA,
       I_GLORA, I_KK, I_KA, I_RK, I_LNXG, I_LNXB, I_WOUT, I_NMIXPOST, I_NXAPRE, I_NMEM, I_WQ, I_WK, I_WV, I_WO, I_NXAPOST, I_NFFNPRE, I_WUP, I_FDW, I_FDWB, I_WDOWN,
       I_NFFNPOST, N_IN };

struct Params { const float* in[N_IN]; float* out; unsigned char* ws; int ph_lo, ph_hi; };

__device__ __forceinline__ unsigned f2bf(float f) { unsigned u = __builtin_bit_cast(unsigned, f); return (u + 0x7fffu + ((u >> 16) & 1u)) >> 16; }
__device__ __forceinline__ unsigned pk2(float lo, float hi) { return f2bf(lo) | (f2bf(hi) << 16); }
__device__ __forceinline__ float bflo(unsigned u) { return __builtin_bit_cast(float, u << 16); }
__device__ __forceinline__ float bfhi(unsigned u) { return __builtin_bit_cast(float, u & 0xffff0000u); }
__device__ __forceinline__ float wave_sum(float v) {
#pragma unroll
    for (int o = 1; o < 64; o <<= 1) v += __shfl_xor(v, o);
    return v;
}
__device__ __forceinline__ float wave_max(float v) {
#pragma unroll
    for (int o = 1; o < 64; o <<= 1) v = fmaxf(v, __shfl_xor(v, o));
    return v;
}
__device__ __forceinline__ float sigm(float x) { return 1.0f / (1.0f + __expf(-x)); }
#define LDS_WAIT() asm volatile("s_waitcnt lgkmcnt(0)" ::: "memory")

typedef __attribute__((address_space(1))) unsigned gu32;
#define XB_TMO      128
#define XB_XCNT(j)  (256  + 64 * (j))
#define XB_XSUB(j)  (1280 + 64 * (j))
#define XB_XGEN(j)  (2304 + 64 * (j))
#define XB_TOP      3328
#define XB_TOPGEN   3392
#define XCD_BAR_WORDS 3456
#define XB_SPIN_CAP (1u << 18)

__device__ __forceinline__ unsigned xb_ld(unsigned* p)              { return __hip_atomic_load(p, __ATOMIC_RELAXED, __HIP_MEMORY_SCOPE_AGENT); }
__device__ __forceinline__ unsigned xb_add(unsigned* p, unsigned v) { return __hip_atomic_fetch_add(p, v, __ATOMIC_RELAXED, __HIP_MEMORY_SCOPE_AGENT); }
__device__ __forceinline__ unsigned xb_xcc_id() { return (unsigned)__builtin_amdgcn_s_getreg((3 << 11) | 20) & 0xFu; }
#define XB_SPIN(cond, bar) do { unsigned _sp = 0; while (cond) { __builtin_amdgcn_s_sleep(1); \
    if ((++_sp & 255u) == 0u) { if (xb_ld(&(bar)[XB_TMO])) break; if (_sp > XB_SPIN_CAP) { atomicAdd(&(bar)[XB_TMO], 1u); break; } } } } while (0)

struct XcdBarrier {
    unsigned* bar; unsigned x;
    volatile LAS unsigned* st;
};

__device__ __forceinline__ XcdBarrier xcd_barrier_post(unsigned* bar, volatile LAS unsigned* st) {
    XcdBarrier b; b.bar = bar; b.x = xb_xcc_id(); b.st = st;
    if (threadIdx.x == 0) (void)xb_add(&bar[XB_XCNT(b.x)], 1u);
    return b;
}
__device__ __forceinline__ void xcd_barrier_complete(unsigned* bar, unsigned x, unsigned& nloc, unsigned& nx) {
    const unsigned G = gridDim.x * gridDim.y * gridDim.z;
    unsigned sum, cnt, mine, sp = 0u;
    for (;;) {
        sum = 0u; cnt = 0u; mine = 0u;
#pragma unroll
        for (unsigned j = 0; j < 16; ++j) { const unsigned c = xb_ld(&bar[XB_XCNT(j)]); sum += c; cnt += (c > 0u) ? 1u : 0u; mine = (j == x) ? c : mine; }
        if (sum == G) break;
        __builtin_amdgcn_s_sleep(1);
        if ((++sp & 255u) == 0u) { if (xb_ld(&bar[XB_TMO])) break; if (sp > XB_SPIN_CAP) { atomicAdd(&bar[XB_TMO], 1u); break; } }
    }
    nloc = mine > 0u ? mine : 1u; nx = cnt > 0u ? cnt : 1u;
}

__device__ __forceinline__ void xcd_barrier(const XcdBarrier& b) {
    asm volatile("s_waitcnt vmcnt(0)" ::: "memory");
    __syncthreads();
    if (threadIdx.x == 0) {
        unsigned* bar = b.bar;
        __builtin_amdgcn_s_waitcnt(0);
        unsigned nloc = b.st[0], nx = b.st[1];
        if (nloc == 0u) { xcd_barrier_complete(bar, b.x, nloc, nx); b.st[0] = nloc; b.st[1] = nx; }
        const unsigned old = xb_add(&bar[XB_XSUB(b.x)], 1u);
        const unsigned gen = old / nloc;
        if (old + 1u == (gen + 1u) * nloc) {
            __builtin_amdgcn_fence(__ATOMIC_RELEASE, "agent");
            asm volatile("s_waitcnt vmcnt(0)" ::: "memory");
            const unsigned og = xb_add(&bar[XB_TOP], 1u);
            const unsigned tg = og / nx;
            if (og + 1u == (tg + 1u) * nx) xb_add(&bar[XB_TOPGEN], 1u);
            else XB_SPIN(xb_ld(&bar[XB_TOPGEN]) == tg, bar);
            __builtin_amdgcn_fence(__ATOMIC_ACQUIRE, "agent");
            xb_add(&bar[XB_XGEN(b.x)], 1u);
            asm volatile("s_waitcnt vmcnt(0)" ::: "memory");
        } else {
            XB_SPIN(xb_ld(&bar[XB_XGEN(b.x)]) == gen, bar);
            __builtin_amdgcn_fence(__ATOMIC_ACQUIRE, "agent");
            asm volatile("s_waitcnt vmcnt(0)" ::: "memory");
        }
    }
    __syncthreads();
}

constexpr int MISC_OFF = LDS_BYTES - 64;
struct Ctx { int tid, lane, wave, bid, G, gw, NGW; };
__device__ __forceinline__ unsigned char* wsbase(const Params& P) { const unsigned long long x = (unsigned long long)P.ws; int lo = __builtin_amdgcn_readfirstlane((int)(unsigned)x), hi = __builtin_amdgcn_readfirstlane((int)(unsigned)(x >> 32));
    asm volatile("" : "+s"(lo), "+s"(hi)); return (unsigned char*)(((unsigned long long)(unsigned)hi << 32) | (unsigned)lo); }
__device__ __forceinline__ const float* inp(const Params& P, int i) { int z; asm volatile("s_mov_b32 %0, 0" : "=s"(z)); return P.in[i + z]; }

#ifndef MK_SUBMASK
#define MK_SUBMASK 0
#endif
#define SUBREP(i) for (int sr_ = 0; sr_ < ((((MK_SUBMASK) >> (i)) & 1) ? 2 : 1); ++sr_)
template <class ColMap>
__device__ __forceinline__ void transpose_load(const float* __restrict__ W, int N, int kb, int jb, int lane, ColMap cm, f32x4 (&v)[16]) {
    const int kr = lane >> 4, l16 = lane & 15, k0 = 64 * kb + 16 * kr, j = 64 * jb + 4 * l16;
    const int sc = cm(j);
    if (sc >= 0) {
        const float* src = W + (size_t)k0 * N + sc;
#pragma unroll
        for (int q = 0; q < 16; ++q) v[q] = __builtin_nontemporal_load((const f32x4*)(src + (size_t)q * N));
    } else {
#pragma unroll
        for (int q = 0; q < 16; ++q) v[q] = (f32x4){0.f, 0.f, 0.f, 0.f};
    }
}
__device__ __forceinline__ void transpose_store(int K, bf16* __restrict__ WT, int kb, int jb, int lane, const f32x4 (&v)[16]) {
    const int kr = lane >> 4, l16 = lane & 15, k0 = 64 * kb + 16 * kr, j = 64 * jb + 4 * l16;
#pragma unroll
    for (int e = 0; e < 4; ++e) {
        bf16* dst = WT + (size_t)(j + e) * K + k0;
        v4u o0, o1;
        o0.x = pk2(v[0][e], v[1][e]); o0.y = pk2(v[2][e], v[3][e]); o0.z = pk2(v[4][e], v[5][e]); o0.w = pk2(v[6][e], v[7][e]);
        o1.x = pk2(v[8][e], v[9][e]); o1.y = pk2(v[10][e], v[11][e]); o1.z = pk2(v[12][e], v[13][e]); o1.w = pk2(v[14][e], v[15][e]);
        *(v4u*)dst = o0; *(v4u*)(dst + 8) = o1;
    }
}
template <class ColMap>
__device__ __forceinline__ void transpose_item(const float* __restrict__ W, int K, int N, bf16* __restrict__ WT, int kb, int jb, int lane, ColMap cm) {
    f32x4 v[16]; transpose_load(W, N, kb, jb, lane, cm, v); transpose_store(K, WT, kb, jb, lane, v);
}
struct MapId { __device__ __forceinline__ int operator()(int j) const { return j; } };
struct MapIn {
    __device__ __forceinline__ int operator()(int j) const {
        if (j < 2048) { const int g = j >> 5, q = (j >> 3) & 3, n = (j >> 2) & 1, e = j & 3; return n * 1024 + 16 * g + 4 * q + e; }
        const int jj = j - 2048; return jj < NRC ? 2048 + jj : -1;
    }
};
__device__ __forceinline__ void rms_row_bf16(const float* __restrict__ xrow, const float* __restrict__ g, bf16* __restrict__ orow, int lane) {
    f32x4 v[8]; float s = 0.f;
#pragma unroll
    for (int j = 0; j < 8; ++j) { v[j] = *(const f32x4*)(xrow + 4 * (lane + 64 * j)); s += (v[j][0] * v[j][0] + v[j][1] * v[j][1]) + (v[j][2] * v[j][2] + v[j][3] * v[j][3]); }
    const float r = rsqrtf(wave_sum(s) * (1.0f / 2048.0f) + 1e-6f);
#pragma unroll
    for (int j = 0; j < 8; ++j) { const f32x4 gg = *(const f32x4*)(g + 4 * (lane + 64 * j));
        v2u o; o.x = pk2(v[j][0] * r * gg[0], v[j][1] * r * gg[1]); o.y = pk2(v[j][2] * r * gg[2], v[j][3] * r * gg[3]);
        *(v2u*)(orow + 4 * (lane + 64 * j)) = o; }
}
constexpr int I_SQ_ = 32 * 32, I_UP_ = 32 * 176, I_DN_ = 88 * 32, NDEF = 3 * I_SQ_ + I_UP_ + I_DN_;
struct DefItem { const float* W; bf16* WT; int K, N, kb, jb; };
__device__ __forceinline__ DefItem def_item(const Params& P, unsigned char* ws, int r) {
    DefItem d;
    if (r < I_SQ_) { d.W = inp(P, I_WOUT); d.WT = (bf16*)(ws + WS_WOUT); d.K = 2048; d.N = 2048; d.kb = r / 32; d.jb = r % 32; return d; } r -= I_SQ_;
    if (r < I_SQ_) { d.W = inp(P, I_WQ); d.WT = (bf16*)(ws + WS_WQ); d.K = 2048; d.N = 2048; d.kb = r / 32; d.jb = r % 32; return d; } r -= I_SQ_;
    if (r < I_SQ_) { d.W = inp(P, I_WO); d.WT = (bf16*)(ws + WS_WO); d.K = 2048; d.N = 2048; d.kb = r / 32; d.jb = r % 32; return d; } r -= I_SQ_;
    if (r < I_UP_) { d.W = inp(P, I_WUP); d.WT = (bf16*)(ws + WS_WUP); d.K = 2048; d.N = 11264; d.kb = r / 176; d.jb = r % 176; return d; } r -= I_UP_;
    d.W = inp(P, I_WDOWN); d.WT = (bf16*)(ws + WS_WDN); d.K = 5632; d.N = 2048; d.kb = r / 32; d.jb = r % 32; return d;
}
__device__ __forceinline__ void p0_prologue(const Params& P, const Ctx& C, LAS unsigned char* lds) {
    unsigned char* ws = wsbase(P);
    constexpr int I_IN = 32 * 88, I_SQ = 32 * 32;
    constexpr int NITEMS = I_IN + 2 * I_SQ;
    SUBREP(6) for (int it = C.gw; it < NITEMS; it += C.NGW) {
        int r = it;
        if (r < I_IN) { transpose_item(inp(P, I_WIN), 2048, 5568, (bf16*)(ws + WS_WIN), r / 88, r % 88, C.lane, MapIn()); continue; } r -= I_IN;
        if (r < I_SQ) { transpose_item(inp(P, I_WK), 2048, 2048, (bf16*)(ws + WS_WKV), r / 32, r % 32, C.lane, MapId()); continue; } r -= I_SQ;
        transpose_item(inp(P, I_WV), 2048, 2048, (bf16*)(ws + WS_WKV) + (size_t)2048 * 2048, r / 32, r % 32, C.lane, MapId());
    }
    const int gt = C.bid * NT + C.tid, ngt = C.G * NT;
    {   const float* s_w = inp(P, I_WLORA); const float* s_a = inp(P, I_ALORA); const float* s_g = inp(P, I_GLORA);
        for (int i = gt; i < 1024 * 96; i += ngt) { const int n = i / 96, k = i - n * 96, h = n >> 6, r = n & 63;
            bf16* img = (bf16*)(ws + WS_HIMG + (size_t)h * 65536);
            img[r * 96 + k] = (bf16)f2bf(s_w[k * 1024 + n]); img[6144 + r * 96 + k] = (bf16)f2bf(s_a[k * 1024 + n]); }
        for (int i = gt; i < 1024 * 256; i += ngt) { const int n = i >> 8, k = i & 255, h = n >> 6, r = n & 63;
            bf16* img = (bf16*)(ws + WS_HIMG + (size_t)h * 65536);
            img[12288 + r * 256 + (((k >> 3) ^ (r & 15)) << 3) + (k & 7)] = (bf16)f2bf(s_g[k * 1024 + n]); }
        const float* mu = inp(P, I_MU); const float* kk = inp(P, I_KK); const float* a0 = inp(P, I_A0); const float* w0 = inp(P, I_W0); const float* ka = inp(P, I_KA); const float* rk = inp(P, I_RK);
        for (int i = gt; i < 16 * 512; i += ngt) { const int h = i >> 9, ar = (i >> 6) & 7, j = i & 63;
            const float* bp = ar == 0 ? mu : ar == 1 ? mu + 1024 : ar == 2 ? mu + 2048 : ar == 3 ? kk : ar == 4 ? a0 : ar == 5 ? w0 : ar == 6 ? ka : rk;
            ((float*)(ws + WS_HIMG + (size_t)h * 65536 + 57344))[ar * 64 + j] = bp[h * 64 + j]; }
    }
    SUBREP(7) for (int m = C.gw; m < M + 1024; m += C.NGW) {
        if (m < M) { const float* xr = m < MP ? inp(P, I_XP) + (size_t)m * D : inp(P, I_XS) + (size_t)(m - MP) * D; rms_row_bf16(xr, inp(P, I_NMIXPRE), (bf16*)(ws + WS_HB) + (size_t)m * D, C.lane); }
        else { const int r = m - M; rms_row_bf16(inp(P, I_MEM) + (size_t)r * D, inp(P, I_NMEM), (bf16*)(ws + WS_MB) + (size_t)r * D, C.lane); }
    }
    { bf16* d = (bf16*)(ws + WS_SHB); const float* sp = inp(P, I_SSHIFT);
      for (int i = gt; i < (NBS + 1) * NRCP; i += ngt) { const int b = i / NRCP, c = i - b * NRCP; d[i] = (b < NBS && c < NRC) ? (bf16)f2bf(sp[(size_t)b * NRC + c]) : (bf16)0; } }
    { const f32x4* s = (const f32x4*)inp(P, I_SCONV); f32x4* d = (f32x4*)(P.out + O_CS);
      for (int i = gt; i < NBS * 22 * 256; i += ngt) { const int b = i / (22 * 256), r = i - b * (22 * 256); d[(size_t)b * 30 * 256 + r] = s[(size_t)b * 30 * 256 + 8 * 256 + r]; } }
}

template <int R>
__device__ __forceinline__ void conv_task(const Params& P, const Ctx& C, LAS unsigned char* lds, int grow0  , int t0  , int sb  ) {
    unsigned char* ws = wsbase(P);
    const bf16* glu = (const bf16*)(ws + WS_GLU);
    LAS unsigned* st = (LAS unsigned*)lds;
    LAS float* red = (LAS float*)(lds + 98304);
    constexpr int NR = R + 30;
    const float* sconv = inp(P, I_SCONV); const float* cdw = inp(P, I_CDW);
    for (int p = C.tid; p < NR * 128; p += NT) {
        const int rr = p >> 7, ch = p & 127; const int t = t0 - 30 + rr;
        v4u v = (v4u){0u, 0u, 0u, 0u};
        if (t >= 0) v = *(const v4u*)(glu + (size_t)(grow0 - 30 + rr) * CC + ch * 8);
        else if (sb >= 0) { const float* s = sconv + ((size_t)sb * 30 + rr) * CC + ch * 8;
            const f32x4 a = *(const f32x4*)s, b = *(const f32x4*)(s + 4); v.x = pk2(a[0], a[1]); v.y = pk2(a[2], a[3]); v.z = pk2(b[0], b[1]); v.w = pk2(b[2], b[3]); }
        *(LAS v4u*)(st + rr * 512 + ch * 4) = v;
    }
    const int c = 2 * C.tid;
    f32x2 w[31];
#pragma unroll
    for (int j = 0; j < 31; ++j) w[j] = *(const f32x2*)(cdw + j * CC + c);
    const f32x2 bias = *(const f32x2*)(inp(P, I_CDWB) + c);
    f32x2 acc[R];
#pragma unroll
    for (int r = 0; r < R; ++r) acc[r] = bias;
    __syncthreads();
#pragma unroll
    for (int rr = 0; rr < NR; ++rr) {
        if ((rr & 3) == 0) asm volatile("" ::: "memory");
        const unsigned u = st[rr * 512 + C.tid]; const float x0 = bflo(u), x1 = bfhi(u);
#pragma unroll
        for (int r = 0; r < R; ++r) { const int j = rr - r; if (j >= 0 && j < 31) { acc[r][0] += x0 * w[j][0]; acc[r][1] += x1 * w[j][1]; } }
    }
    float s[R];
#pragma unroll
    for (int r = 0; r < R; ++r) s[r] = wave_sum(acc[r][0] + acc[r][1]);
    if (C.lane == 0) {
#pragma unroll
        for (int r = 0; r < R; ++r) red[C.wave * 16 + r] = s[r]; }
    __syncthreads();
    float mean[R];
#pragma unroll
    for (int r = 0; r < R; ++r) { float t = 0.f;
#pragma unroll
        for (int wv = 0; wv < 8; ++wv) t += red[wv * 16 + r];
        mean[r] = t * (1.0f / 1024.0f); }
    __syncthreads();
#pragma unroll
    for (int r = 0; r < R; ++r) { const float d0 = acc[r][0] - mean[r], d1 = acc[r][1] - mean[r]; acc[r][0] = d0; acc[r][1] = d1; s[r] = wave_sum(d0 * d0 + d1 * d1); }
    if (C.lane == 0) {
#pragma unroll
        for (int r = 0; r < R; ++r) red[C.wave * 16 + r] = s[r]; }
    __syncthreads();
    const f32x2 lg = *(const f32x2*)(inp(P, I_CLNG) + c), lb = *(const f32x2*)(inp(P, I_CLNB) + c);
    bf16* a2 = (bf16*)(ws + WS_A2);
#pragma unroll
    for (int r = 0; r < R; ++r) { float t = 0.f;
#pragma unroll
        for (int wv = 0; wv < 8; ++wv) t += red[wv * 16 + r];
        const float rstd = rsqrtf(t * (1.0f / 1024.0f) + 1e-5f);
        float y0 = acc[r][0] * rstd * lg[0] + lb[0], y1 = acc[r][1] * rstd * lg[1] + lb[1];
        y0 = y0 * sigm(y0); y1 = y1 * sigm(y1);
        *(unsigned*)(a2 + (size_t)(grow0 + r) * D + c) = pk2(y0, y1); }
    __syncthreads();
}

#define XS8(cp_, pp_, mp_, off_, xs_) do { const v4u cu_ = *(const v4u*)((cp_) + (off_)); const v4u pu_ = *(const v4u*)((pp_) + (off_)); \
        const f32x4 m0_ = *(const f32x4*)((mp_) + (off_)), m1_ = *(const f32x4*)((mp_) + (off_) + 4); float c_, p_; \
        c_ = bflo(cu_.x); p_ = bflo(pu_.x); xs_[0] = c_ + (p_ - c_) * m0_[0]; c_ = bfhi(cu_.x); p_ = bfhi(pu_.x); xs_[1] = c_ + (p_ - c_) * m0_[1]; \
        c_ = bflo(cu_.y); p_ = bflo(pu_.y); xs_[2] = c_ + (p_ - c_) * m0_[2]; c_ = bfhi(cu_.y); p_ = bfhi(pu_.y); xs_[3] = c_ + (p_ - c_) * m0_[3]; \
        c_ = bflo(cu_.z); p_ = bflo(pu_.z); xs_[4] = c_ + (p_ - c_) * m1_[0]; c_ = bfhi(cu_.z); p_ = bfhi(pu_.z); xs_[5] = c_ + (p_ - c_) * m1_[1]; \
        c_ = bflo(cu_.w); p_ = bflo(pu_.w); xs_[6] = c_ + (p_ - c_) * m1_[2]; c_ = bfhi(cu_.w); p_ = bfhi(pu_.w); xs_[7] = c_ + (p_ - c_) * m1_[3]; } while (0)
#define XS4(cp_, pp_, mp_, off_, xs_) do { const v2u cu_ = *(const v2u*)((cp_) + (off_)); const v2u pu_ = *(const v2u*)((pp_) + (off_)); const f32x4 m0_ = *(const f32x4*)((mp_) + (off_)); float c_, p_; \
        c_ = bflo(cu_.x); p_ = bflo(pu_.x); xs_[0] = c_ + (p_ - c_) * m0_[0]; c_ = bfhi(cu_.x); p_ = bfhi(pu_.x); xs_[1] = c_ + (p_ - c_) * m0_[1]; \
        c_ = bflo(cu_.y); p_ = bflo(pu_.y); xs_[2] = c_ + (p_ - c_) * m0_[2]; c_ = bfhi(cu_.y); p_ = bfhi(pu_.y); xs_[3] = c_ + (p_ - c_) * m0_[3]; } while (0)
__device__ __forceinline__ bf16x8 pack8(const float (&x)[8]) {
    v4u o; o.x = pk2(x[0], x[1]); o.y = pk2(x[2], x[3]); o.z = pk2(x[4], x[5]); o.w = pk2(x[6], x[7]);
    return __builtin_bit_cast(bf16x8, o);
}
__device__ __forceinline__ float tanh_fast(float x) { return 1.0f - 2.0f / (1.0f + __expf(2.0f * x)); }
constexpr int PBUF = 65536;
__device__ __forceinline__ void mix4(const v2u cu, const v2u pu, const f32x4 m, float (&xs)[4]) {
    float c_, p_;
    c_ = bflo(cu.x); p_ = bflo(pu.x); xs[0] = c_ + (p_ - c_) * m[0]; c_ = bfhi(cu.x); p_ = bfhi(pu.x); xs[1] = c_ + (p_ - c_) * m[1];
    c_ = bflo(cu.y); p_ = bflo(pu.y); xs[2] = c_ + (p_ - c_) * m[2]; c_ = bfhi(cu.y); p_ = bfhi(pu.y); xs[3] = c_ + (p_ - c_) * m[3];
}
template <int NH>
__device__ __forceinline__ void prep_task(const Params& P, const Ctx& C, LAS unsigned char* lds, int rowblock, int hbase) {
    const int lane = C.lane, fr = lane & 15, fq = lane >> 4, row = rowblock * 128 + C.wave * 16 + fr;
    unsigned char* ws = wsbase(P);
    const bf16* curp = (const bf16*)(ws + WS_PR) + (size_t)row * NRCP;
    const bf16* prvp = curp - NRCP;
    if (row < MP) { if ((row & (SEQ - 1)) == 0) prvp = (const bf16*)(ws + WS_SHB) + (size_t)NBS * NRCP; }
    else { const int rs = row - MP; if ((rs & 7) == 0) prvp = (const bf16*)(ws + WS_SHB) + (size_t)(rs >> 3) * NRCP; }
    const float* mup = inp(P, I_MU);
    const unsigned char* himg = ws + WS_HIMG;
    const bf16* c8 = curp + 3072 + 8 * fq; const bf16* p8 = prvp + 3072 + 8 * fq; const float* m8 = mup + 3072 + 8 * fq;
    const f32x4 z4 = (f32x4){0.f, 0.f, 0.f, 0.f};
    const int c00 = hbase * 64 + 4 * fq;
#define PREP_STAGE(h_, b_, i0_, n_) do { int ll = lane; asm volatile("" : "+v"(ll)); _Pragma("unroll") for (int q = 0; q < (n_); ++q) { const int i = (i0_) + C.wave + 8 * q; \
        __builtin_amdgcn_global_load_lds((const unsigned*)(himg + (size_t)(h_) * PBUF + i * 1024 + ll * 16), (LAS unsigned*)(lds + (b_) * PBUF + i * 1024), 16, 0, 0); } } while (0)
#define PREP_SYNC() do { asm volatile("s_waitcnt vmcnt(0)" ::: "memory"); __syncthreads(); } while (0)
    {
        PREP_STAGE(hbase, 0, 24, 4);
        bf16x8 Ag[8];
#pragma unroll
        for (int s = 0; s < 8; ++s) { if (s == 4) asm volatile("" ::: "memory");
            float xs[8]; XS8(c8, p8, m8, 192 + 32 * s, xs);
#pragma unroll
            for (int e = 0; e < 8; ++e) xs[e] = sigm(xs[e]);
            Ag[s] = pack8(xs); }
        PREP_SYNC();
        bf16* gb = (bf16*)(ws + WS_G) + (size_t)row * RW + c00;
        const int lgo = 24576 + fr * 512;
#pragma unroll 1
        for (int hh = 0; hh < NH; ++hh) {
            if (hh + 1 < NH) PREP_STAGE(hbase + hh + 1, (hh + 1) & 1, 24, 4);
            const LAS unsigned char* wb = lds + (hh & 1) * PBUF;
#pragma unroll
            for (int nt = 0; nt < 4; ++nt) {
                f32x4 accG = z4;
#pragma unroll
                for (int s = 0; s < 8; ++s) { const bf16x8 bg = *(const LAS bf16x8*)(wb + lgo + nt * 8192 + (((4 * s + fq) ^ fr) * 16)); accG = __builtin_amdgcn_mfma_f32_16x16x32_bf16(bg, Ag[s], accG, 0, 0, 0); }
                *(v2u*)(gb + 16 * nt) = (v2u){pk2(accG[0], accG[1]), pk2(accG[2], accG[3])};
            }
            gb += 64;
            PREP_SYNC();
        }
    }
    PREP_STAGE(hbase, 0, 0, 3); if (C.wave < 2) PREP_STAGE(hbase, 0, 56, 1);
    const bf16* c4 = curp + c00; const bf16* p4 = prvp + c00;
    v2u cu[3][4], pu[3][4];
#pragma unroll
    for (int x = 0; x < 3; ++x)
#pragma unroll
        for (int nt = 0; nt < 4; ++nt) { cu[x][nt] = *(const v2u*)(c4 + 1024 * x + 16 * nt); pu[x][nt] = *(const v2u*)(p4 + 1024 * x + 16 * nt); }
    bf16x8 Aw[3], Aa[3];
#pragma unroll
    for (int s = 0; s < 3; ++s) { float xs[8]; XS8(c8, p8, m8, 32 * s, xs);
#pragma unroll
        for (int e = 0; e < 8; ++e) xs[e] = tanh_fast(xs[e]);
        Aw[s] = pack8(xs); }
#pragma unroll
    for (int s = 0; s < 3; ++s) { float xs[8]; XS8(c8, p8, m8, 96 + 32 * s, xs); Aa[s] = pack8(xs); }
    PREP_SYNC();
    constexpr size_t SS = SB_STRIDE / 2;
    bf16* sb = (bf16*)(ws + WS_SI) + (size_t)row * RW + c00; float* sw = (float*)(ws + WS_SW) + (size_t)row * RW + c00;
    float* bonp = (float*)(ws + WS_BON) + (size_t)row * RH + hbase;
    const int lwo = fr * 192 + fq * 16, lpo = 57344 + fq * 16;
#pragma unroll 1
    for (int hh = 0; hh < NH; ++hh) {
        if (hh + 1 < NH) { PREP_STAGE(hbase + hh + 1, (hh + 1) & 1, 0, 3); if (C.wave < 2) PREP_STAGE(hbase + hh + 1, (hh + 1) & 1, 56, 1); }
        const LAS unsigned char* wb = lds + (hh & 1) * PBUF;
        float ss = 0.f;
#pragma unroll
        for (int nt = 0; nt < 4; ++nt) {
            float xk0[4]; mix4(cu[1][nt], pu[1][nt], *(const LAS f32x4*)(wb + lpo + 1 * 256 + nt * 64), xk0);
            const f32x4 kkw = *(const LAS f32x4*)(wb + lpo + 3 * 256 + nt * 64);
#pragma unroll
            for (int e = 0; e < 4; ++e) { const float t = xk0[e] * kkw[e]; ss += t * t; }
        }
        ss += __shfl_xor(ss, 16); ss += __shfl_xor(ss, 32);
        const float inv = 1.0f / fmaxf(sqrtf(ss), 1e-12f);
        float bon = 0.f;
#pragma unroll
        for (int nt = 0; nt < 4; ++nt) {
            f32x4 accW = z4, accA = z4;
#pragma unroll
            for (int s = 0; s < 3; ++s) { const bf16x8 bw = *(const LAS bf16x8*)(wb + lwo + nt * 3072 + s * 64), ba = *(const LAS bf16x8*)(wb + 12288 + lwo + nt * 3072 + s * 64);
                accW = __builtin_amdgcn_mfma_f32_16x16x32_bf16(bw, Aw[s], accW, 0, 0, 0); accA = __builtin_amdgcn_mfma_f32_16x16x32_bf16(ba, Aa[s], accA, 0, 0, 0); }
            float xr[4], xv[4], xkk[4];
            mix4(cu[0][nt], pu[0][nt], *(const LAS f32x4*)(wb + lpo + 0 * 256 + nt * 64), xr);
            mix4(cu[1][nt], pu[1][nt], *(const LAS f32x4*)(wb + lpo + 1 * 256 + nt * 64), xkk);
            mix4(cu[2][nt], pu[2][nt], *(const LAS f32x4*)(wb + lpo + 2 * 256 + nt * 64), xv);
            const f32x4 kkw = *(const LAS f32x4*)(wb + lpo + 3 * 256 + nt * 64), a0 = *(const LAS f32x4*)(wb + lpo + 4 * 256 + nt * 64), w0 = *(const LAS f32x4*)(wb + lpo + 5 * 256 + nt * 64);
            const f32x4 ka = *(const LAS f32x4*)(wb + lpo + 6 * 256 + nt * 64), rk = *(const LAS f32x4*)(wb + lpo + 7 * 256 + nt * 64);
            f32x4 vw; float vk[4], va[4], vb[4];
#pragma unroll
            for (int e = 0; e < 4; ++e) {
                const float ee = 0.6065306597126334f * sigm(w0[e] + accW[e]);
                vw[e] = __expf(-ee);
                const float a = sigm(a0[e] + accA[e]);
                const float kn = xkk[e] * kkw[e] * inv;
                const float k2 = xkk[e] * (1.0f + (a - 1.0f) * ka[e]);
                vk[e] = k2; va[e] = -kn; vb[e] = kn * a;
                bon += xr[e] * k2 * rk[e];
            }
            bf16* so = sb + 16 * nt;
            *(v2u*)(so + 0 * SS) = (v2u){pk2(xr[0], xr[1]), pk2(xr[2], xr[3])};
            *(v2u*)(so + 1 * SS) = (v2u){pk2(vk[0], vk[1]), pk2(vk[2], vk[3])};
            *(v2u*)(so + 2 * SS) = (v2u){pk2(xv[0], xv[1]), pk2(xv[2], xv[3])};
            *(v2u*)(so + 3 * SS) = (v2u){pk2(va[0], va[1]), pk2(va[2], va[3])};
            *(v2u*)(so + 4 * SS) = (v2u){pk2(vb[0], vb[1]), pk2(vb[2], vb[3])};
            *(f32x4*)(sw + 16 * nt) = vw;
        }
        bon += __shfl_xor(bon, 16); bon += __shfl_xor(bon, 32);
        if (fq == 0) bonp[hh] = bon;
        sb += 64; sw += 64;
        if (hh + 1 < NH) { c4 += 64; p4 += 64;
#pragma unroll
            for (int x = 0; x < 3; ++x)
#pragma unroll
                for (int nt = 0; nt < 4; ++nt) { cu[x][nt] = *(const v2u*)(c4 + 1024 * x + 16 * nt); pu[x][nt] = *(const v2u*)(p4 + 1024 * x + 16 * nt); } }
        PREP_SYNC();
    }
#undef PREP_STAGE
#undef PREP_SYNC
}

constexpr int TC = 32, STEPF = 340;
template <int CTRL> __device__ __forceinline__ float dppf(float x) { return __builtin_bit_cast(float, __builtin_amdgcn_update_dpp(0, __builtin_bit_cast(int, x), CTRL, 0xF, 0xF, true)); }
__device__ __forceinline__ float allred16(float x) {
    x += dppf<0xB1>(x);
    x += dppf<0x4E>(x);
    x += dppf<0x141>(x);
    x += dppf<0x140>(x);
    return x;
}
#define SCAN_BAR() do { asm volatile("s_waitcnt lgkmcnt(0)" ::: "memory"); __builtin_amdgcn_s_barrier(); asm volatile("" ::: "memory"); } while (0)
#define SCAN_STEP(S01, S23, r4, w4, k4, a4, b4, v, yout) do { \
        f32x2 p2 = S01 * (f32x2){a4[0], a4[1]}; p2 = S23 * (f32x2){a4[2], a4[3]} + p2; \
        const float sa = allred16(p2[0] + p2[1]); const f32x2 sa2 = (f32x2){sa, sa}, v2 = (f32x2){v, v}; \
        f32x2 t01 = v2 * (f32x2){k4[0], k4[1]}, t23 = v2 * (f32x2){k4[2], k4[3]}; \
        t01 = sa2 * (f32x2){b4[0], b4[1]} + t01; t23 = sa2 * (f32x2){b4[2], b4[3]} + t23; \
        S01 = S01 * (f32x2){w4[0], w4[1]} + t01; S23 = S23 * (f32x2){w4[2], w4[3]} + t23; \
        f32x2 q2 = S01 * (f32x2){r4[0], r4[1]}; q2 = S23 * (f32x2){r4[2], r4[3]} + q2; \
        yout = allred16(q2[0] + q2[1]); } while (0)
__device__ __forceinline__ void ld_bf8(const bf16* p, float (&x)[8]) { const v4u u = *(const v4u*)p; x[0] = bflo(u.x); x[1] = bfhi(u.x); x[2] = bflo(u.y); x[3] = bfhi(u.y); x[4] = bflo(u.z); x[5] = bfhi(u.z); x[6] = bflo(u.w); x[7] = bfhi(u.w); }
__device__ __forceinline__ void scan_prompt(const Params& P, const Ctx& C, LAS unsigned char* lds, int chain, int rb, bool dodef) {
    unsigned char* ws = wsbase(P);
    const int b = chain >> 4, h = chain & 15, m0 = b * SEQ;
    LAS float* buf = (LAS float*)lds;
    constexpr int NCH = SEQ / TC;
    if (C.wave >= 4) {
        const int ht = C.tid - 256, t = ht >> 3, g = ht & 7;
        const bf16* SB = (const bf16*)(ws + WS_SI) + (size_t)m0 * RW + h * 64 + 8 * g; constexpr size_t SBS = SB_STRIDE / 2;
        const float* SW = (const float*)(ws + WS_SW) + (size_t)m0 * RW + h * 64 + 8 * g;
        const bf16* SV = (const bf16*)(ws + WS_SI) + 2 * SBS + (size_t)m0 * RW + h * 64 + rb * 16 + 8 * (g & 1);
        v4u lr, lk, lb, la, lv; f32x4 lw0, lw1;
#define SCAN_HLOAD(ck_) do { const int tg = (ck_) * TC + t; const size_t ro = (size_t)tg * RW; \
            lr = *(const v4u*)(SB + 0 * SBS + ro); lk = *(const v4u*)(SB + 1 * SBS + ro); lb = *(const v4u*)(SB + 4 * SBS + ro); \
            la = tg + 1 < SEQ ? *(const v4u*)(SB + 3 * SBS + ro + RW) : (v4u){0u, 0u, 0u, 0u}; \
            lw0 = *(const f32x4*)(SW + ro); lw1 = *(const f32x4*)(SW + ro + 4); lv = *(const v4u*)(SV + ro); } while (0)
#define SCAN_HWRITE(ck_) do { LAS float* d = buf + ((ck_) & 1) * (TC * STEPF) + t * STEPF; \
            const float an[8] = {bflo(la.x), bfhi(la.x), bflo(la.y), bfhi(la.y), bflo(la.z), bfhi(la.z), bflo(la.w), bfhi(la.w)}; \
            const float bb[8] = {bflo(lb.x), bfhi(lb.x), bflo(lb.y), bfhi(lb.y), bflo(lb.z), bfhi(lb.z), bflo(lb.w), bfhi(lb.w)}; \
            const float kk_[8] = {bflo(lk.x), bfhi(lk.x), bflo(lk.y), bfhi(lk.y), bflo(lk.z), bfhi(lk.z), bflo(lk.w), bfhi(lk.w)}; \
            float be = 0.f, ka_ = 0.f; _Pragma("unroll") for (int e = 0; e < 8; ++e) { be += bb[e] * an[e]; ka_ += kk_[e] * an[e]; } \
            be += __shfl_xor(be, 1); be += __shfl_xor(be, 2); be += __shfl_xor(be, 4); ka_ += __shfl_xor(ka_, 1); ka_ += __shfl_xor(ka_, 2); ka_ += __shfl_xor(ka_, 4); \
            *(LAS v4u*)(d + 0 + 8 * g) = (v4u){lr.x << 16, lr.x & 0xffff0000u, lr.y << 16, lr.y & 0xffff0000u}; *(LAS v4u*)(d + 4 + 8 * g) = (v4u){lr.z << 16, lr.z & 0xffff0000u, lr.w << 16, lr.w & 0xffff0000u}; \
            *(LAS f32x4*)(d + 64 + 8 * g) = lw0; *(LAS f32x4*)(d + 68 + 8 * g) = lw1; \
            *(LAS f32x4*)(d + 128 + 8 * g) = (f32x4){kk_[0], kk_[1], kk_[2], kk_[3]}; *(LAS f32x4*)(d + 132 + 8 * g) = (f32x4){kk_[4], kk_[5], kk_[6], kk_[7]}; \
            *(LAS f32x4*)(d + 192 + 8 * g) = (f32x4){lw0[0] * an[0], lw0[1] * an[1], lw0[2] * an[2], lw0[3] * an[3]}; *(LAS f32x4*)(d + 196 + 8 * g) = (f32x4){lw1[0] * an[4], lw1[1] * an[5], lw1[2] * an[6], lw1[3] * an[7]}; \
            *(LAS f32x4*)(d + 256 + 8 * g) = (f32x4){bb[0], bb[1], bb[2], bb[3]}; *(LAS f32x4*)(d + 260 + 8 * g) = (f32x4){bb[4], bb[5], bb[6], bb[7]}; \
            if (g < 2) { *(LAS v4u*)(d + 320 + 8 * g) = (v4u){lv.x << 16, lv.x & 0xffff0000u, lv.y << 16, lv.y & 0xffff0000u}; *(LAS v4u*)(d + 324 + 8 * g) = (v4u){lv.z << 16, lv.z & 0xffff0000u, lv.w << 16, lv.w & 0xffff0000u}; } \
            if (g == 2) *(LAS f32x2*)(d + 336) = (f32x2){be, ka_}; } while (0)
        SCAN_HLOAD(0); SCAN_HWRITE(0); SCAN_HLOAD(1);
        SCAN_BAR();
        const int sw = C.bid * 4 + (C.wave - 4), nsw = C.G * 4;
        f32x4 tv[16]; DefItem di; di.W = nullptr; di.WT = nullptr; di.K = 0; di.N = 0; di.kb = 0; di.jb = 0; bool have = false;
        for (int ck = 0; ck < NCH; ++ck) {
            if (ck + 1 < NCH) SCAN_HWRITE(ck + 1);
            if (ck + 2 < NCH) SCAN_HLOAD(ck + 2);
            if (dodef) {
                const int ph = ck % 5, it = sw + nsw * (ck / 5);
                if (ph == 0 && it < NDEF) { di = def_item(P, ws, it); transpose_load(di.W, di.N, di.kb, di.jb, C.lane, MapId(), tv); have = true; }
                if (ph == 2 && have) { transpose_store(di.K, di.WT, di.kb, di.jb, C.lane, tv); have = false; }
            }
            SCAN_BAR();
        }
#undef SCAN_HLOAD
#undef SCAN_HWRITE
    } else {
        float* Y = (float*)(ws + WS_Y);
        const int rowl = C.lane >> 4, cl = C.lane & 15, irow = rb * 16 + C.wave * 4 + rowl;
        f32x2 S01 = (f32x2){0.f, 0.f}, S23 = (f32x2){0.f, 0.f};
        float sa = 0.f, yk = 0.f;
        SCAN_BAR();
        for (int ck = 0; ck < NCH; ++ck) {
            const LAS float* cb = buf + (ck & 1) * (TC * STEPF);
            f32x4 r4 = *(const LAS f32x4*)(cb + 0 * 64 + 4 * cl), w4 = *(const LAS f32x4*)(cb + 1 * 64 + 4 * cl), k4 = *(const LAS f32x4*)(cb + 2 * 64 + 4 * cl);
            f32x4 q4 = *(const LAS f32x4*)(cb + 3 * 64 + 4 * cl), b4 = *(const LAS f32x4*)(cb + 4 * 64 + 4 * cl); float v = cb[320 + C.wave * 4 + rowl]; f32x2 bk = *(const LAS f32x2*)(cb + 336);
#pragma unroll 4
            for (int t = 0; t < TC; ++t) {
                const LAS float* nb = cb + (t + 1 < TC ? t + 1 : t) * STEPF;
                const f32x4 nr = *(const LAS f32x4*)(nb + 0 * 64 + 4 * cl), nw = *(const LAS f32x4*)(nb + 1 * 64 + 4 * cl), nk = *(const LAS f32x4*)(nb + 2 * 64 + 4 * cl);
                const f32x4 nq = *(const LAS f32x4*)(nb + 3 * 64 + 4 * cl), nbb = *(const LAS f32x4*)(nb + 4 * 64 + 4 * cl); const float nv = nb[320 + C.wave * 4 + rowl]; const f32x2 nbk = *(const LAS f32x2*)(nb + 336);
                f32x2 d2 = S01 * (f32x2){q4[0], q4[1]}; d2 = S23 * (f32x2){q4[2], q4[3]} + d2;
                const float dd = allred16(d2[0] + d2[1]);
                const float san = sa * bk[0] + (v * bk[1] + dd);
                const f32x2 sa2 = (f32x2){sa, sa}, v2 = (f32x2){v, v};
                f32x2 t01 = v2 * (f32x2){k4[0], k4[1]}, t23 = v2 * (f32x2){k4[2], k4[3]};
                t01 = sa2 * (f32x2){b4[0], b4[1]} + t01; t23 = sa2 * (f32x2){b4[2], b4[3]} + t23;
                S01 = S01 * (f32x2){w4[0], w4[1]} + t01; S23 = S23 * (f32x2){w4[2], w4[3]} + t23;
                f32x2 y2 = S01 * (f32x2){r4[0], r4[1]}; y2 = S23 * (f32x2){r4[2], r4[3]} + y2;
                const float y = allred16(y2[0] + y2[1]);
                sa = san;
                yk = (cl == (t & 15)) ? y : yk;
                if ((t & 15) == 15) Y[(size_t)(m0 + ck * TC + (t & ~15) + cl) * RW + h * 64 + irow] = yk;
                r4 = nr; w4 = nw; k4 = nk; q4 = nq; b4 = nbb; v = nv; bk = nbk;
            }
            SCAN_BAR();
        }
        float* so = P.out + O_WP + ((size_t)chain * 64 + irow) * 64 + 4 * cl;
        *(f32x4*)so = (f32x4){S01[0], S01[1], S23[0], S23[1]};
    }
    __syncthreads();
}
__device__ __forceinline__ f32x4 ld_bf4(const bf16* p) { const v2u u = *(const v2u*)p; return (f32x4){bflo(u.x), bfhi(u.x), bflo(u.y), bfhi(u.y)}; }
__device__ __forceinline__ void scan_sample(const Params& P, const Ctx& C, const float* swkv, int chain, int half) {
    unsigned char* ws = wsbase(P);
    const int b = chain >> 4, h = chain & 15, m0 = MP + 8 * b;
    const bf16* ub = (const bf16*)(ws + WS_SI) + (size_t)m0 * RW + h * 64; constexpr size_t SBS = SB_STRIDE / 2;
    const float* uw = (const float*)(ws + WS_SW) + (size_t)m0 * RW + h * 64;
    float* Y = (float*)(ws + WS_Y);
    const int rowl = C.lane >> 4, cl = C.lane & 15, irow = half * 32 + C.wave * 4 + rowl, lo = 4 * cl;
    const f32x4 s4 = *(const f32x4*)(swkv + ((size_t)chain * 64 + irow) * 64 + 4 * cl);
    f32x2 S01 = (f32x2){s4[0], s4[1]}, S23 = (f32x2){s4[2], s4[3]};
    float yk = 0.f;
#pragma unroll 4
    for (int t = 0; t < 8; ++t) {
        const bf16* ut = ub + t * RW;
        const f32x4 r4 = ld_bf4(ut + 0 * SBS + lo), k4 = ld_bf4(ut + 1 * SBS + lo), a4 = ld_bf4(ut + 3 * SBS + lo), b4 = ld_bf4(ut + 4 * SBS + lo);
        const f32x4 w4 = *(const f32x4*)(uw + t * RW + lo); const float v = bflo((unsigned)(ut + 2 * SBS)[irow]);
        float y; SCAN_STEP(S01, S23, r4, w4, k4, a4, b4, v, y);
        yk = (cl == t) ? y : yk;
    }
    if (cl < 8) Y[(size_t)(m0 + cl) * RW + h * 64 + irow] = yk;
    *(f32x4*)(P.out + O_WS + ((size_t)chain * 64 + irow) * 64 + 4 * cl) = (f32x4){S01[0], S01[1], S23[0], S23[1]};
}

__device__ __forceinline__ void post_row(const Params& P, int row, int lane) {
    unsigned char* ws = wsbase(P);
    const float* Y = (const float*)(ws + WS_Y) + (size_t)row * RW + 16 * lane;
    const bf16* V = (const bf16*)(ws + WS_SI) + 2 * (SB_STRIDE / 2) + (size_t)row * RW + 16 * lane;
    const bf16* G = (const bf16*)(ws + WS_G) + (size_t)row * RW + 16 * lane;
    const float bon = ((const float*)(ws + WS_BON))[(size_t)row * RH + (lane >> 2)];
    float y[16], s = 0.f;
#pragma unroll
    for (int q = 0; q < 4; ++q) { const f32x4 t = *(const f32x4*)(Y + 4 * q); y[4 * q] = t[0]; y[4 * q + 1] = t[1]; y[4 * q + 2] = t[2]; y[4 * q + 3] = t[3]; s += (t[0] + t[1]) + (t[2] + t[3]); }
    s += __shfl_xor(s, 1); s += __shfl_xor(s, 2);
    const float mu = s * (1.0f / 64.0f); float q2 = 0.f;
#pragma unroll
    for (int e = 0; e < 16; ++e) { y[e] -= mu; q2 += y[e] * y[e]; }
    q2 += __shfl_xor(q2, 1); q2 += __shfl_xor(q2, 2);
    const float rstd = rsqrtf(q2 * (1.0f / 64.0f) + 64e-5f);
    const float* lg = inp(P, I_LNXG) + 16 * lane; const float* lb = inp(P, I_LNXB) + 16 * lane;
    unsigned o[8];
#pragma unroll
    for (int q = 0; q < 4; ++q) { const f32x4 g4 = *(const f32x4*)(lg + 4 * q), b4 = *(const f32x4*)(lb + 4 * q), v4 = ld_bf4(V + 4 * q), gg = ld_bf4(G + 4 * q);
        float r[4];
#pragma unroll
        for (int e = 0; e < 4; ++e) r[e] = (y[4 * q + e] * rstd * g4[e] + b4[e] + bon * v4[e]) * gg[e];
        o[2 * q] = pk2(r[0], r[1]); o[2 * q + 1] = pk2(r[2], r[3]); }
    bf16* dst = (bf16*)(ws + WS_A2) + (size_t)row * D + 1024 + 16 * lane;
    *(v4u*)dst = (v4u){o[0], o[1], o[2], o[3]}; *(v4u*)(dst + 8) = (v4u){o[4], o[5], o[6], o[7]};
}

__device__ __forceinline__ void rowpass(const float* xa, const bf16* __restrict__ mixb, const float* __restrict__ mix, int nslab, const float* __restrict__ g1, float* xo,
                                        const float* __restrict__ g2, bf16* __restrict__ hb, int lane) {
    f32x4 mv[8]; float s = 0.f;
#pragma unroll
    for (int j = 0; j < 8; ++j) {
        if (mixb) mv[j] = ld_bf4(mixb + 4 * (lane + 64 * j));
        else { mv[j] = *(const f32x4*)(mix + 4 * (lane + 64 * j));
            for (int sl = 1; sl < nslab; ++sl) mv[j] += *(const f32x4*)(mix + sl * SLAB_F + 4 * (lane + 64 * j)); }
        s += (mv[j][0] * mv[j][0] + mv[j][1] * mv[j][1]) + (mv[j][2] * mv[j][2] + mv[j][3] * mv[j][3]); }
    const float r = rsqrtf(wave_sum(s) * (1.0f / 2048.0f) + 1e-6f);
    float s2 = 0.f;
#pragma unroll
    for (int j = 0; j < 8; ++j) { const f32x4 a = *(const f32x4*)(xa + 4 * (lane + 64 * j)), gg = *(const f32x4*)(g1 + 4 * (lane + 64 * j));
        mv[j] = a + mv[j] * r * gg; *(f32x4*)(xo + 4 * (lane + 64 * j)) = mv[j];
        s2 += (mv[j][0] * mv[j][0] + mv[j][1] * mv[j][1]) + (mv[j][2] * mv[j][2] + mv[j][3] * mv[j][3]); }
    if (hb) {
        const float r2 = rsqrtf(wave_sum(s2) * (1.0f / 2048.0f) + 1e-6f);
#pragma unroll
        for (int j = 0; j < 8; ++j) { const f32x4 gg = *(const f32x4*)(g2 + 4 * (lane + 64 * j));
            v2u o; o.x = pk2(mv[j][0] * r2 * gg[0], mv[j][1] * r2 * gg[1]); o.y = pk2(mv[j][2] * r2 * gg[2], mv[j][3] * r2 * gg[3]);
            *(v2u*)(hb + 4 * (lane + 64 * j)) = o; }
    }
}
__device__ __forceinline__ void attn_prompt_task(const Params& P, const Ctx& C, LAS unsigned char* lds, int b, int h, int qt) {
    unsigned char* ws = wsbase(P);
    const bf16* Qg = (const bf16*)(ws + WS_Q); const bf16* Kg = (const bf16*)(ws + WS_KB); const bf16* VTg = (const bf16*)(ws + WS_VT);
    bf16* Og = (bf16*)(ws + WS_O);
    const int fr = C.lane & 15, fq = C.lane >> 4;
    const int qrow = b * SEQ + qt * 128 + C.wave * 16 + fr;
    constexpr int BUFB = 33792;
    bf16x8 Qf[16];
#pragma unroll
    for (int s = 0; s < 16; ++s) Qf[s] = *(const bf16x8*)(Qg + (size_t)qrow * D + h * XD + 32 * s + 8 * fq);
    f32x4 accS[16];
#pragma unroll
    for (int nt = 0; nt < 16; ++nt) accS[nt] = (f32x4){0.f, 0.f, 0.f, 0.f};
    v4u stg[4];
#define ATT_GLOAD(c_) do { if ((c_) < 8) { _Pragma("unroll") for (int i = 0; i < 4; ++i) { const int idx = C.tid + i * NT, key = idx >> 3, ch = idx & 7; \
            stg[i] = *(const v4u*)(Kg + (size_t)(b * NMEM + key) * D + h * XD + (c_) * 64 + ch * 8); } } \
        else { _Pragma("unroll") for (int i = 0; i < 4; ++i) { const int idx = C.tid + i * NT, dd = idx >> 5, ch = idx & 31; \
            stg[i] = *(const v4u*)(VTg + ((size_t)((b * XH + h) * XD + ((c_) - 8) * 64 + dd)) * NMEM + ch * 8); } } } while (0)
#define ATT_SWRITE(c_) do { LAS unsigned char* sbuf = lds + ((c_) & 1) * BUFB; if ((c_) < 8) { _Pragma("unroll") for (int i = 0; i < 4; ++i) { const int idx = C.tid + i * NT, key = idx >> 3, ch = idx & 7; \
            *(LAS v4u*)(sbuf + key * 128 + ((ch ^ (key & 7)) * 16)) = stg[i]; } } \
        else { _Pragma("unroll") for (int i = 0; i < 4; ++i) { const int idx = C.tid + i * NT, dd = idx >> 5, ch = idx & 31; \
            *(LAS v4u*)(sbuf + dd * 528 + ch * 16) = stg[i]; } } } while (0)
    ATT_GLOAD(0); ATT_SWRITE(0); __syncthreads();
    bf16x8 Pf[8];
#pragma unroll
    for (int c = 0; c < 8; ++c) {
        ATT_GLOAD(c + 1);
        const LAS unsigned char* sbuf = lds + (c & 1) * BUFB;
#pragma unroll
        for (int ss = 0; ss < 2; ++ss)
#pragma unroll
            for (int nt = 0; nt < 16; ++nt) {
                const int key = 16 * nt + fr, ch = ss * 4 + fq;
                const bf16x8 kf = *(const LAS bf16x8*)(sbuf + key * 128 + ((ch ^ (key & 7)) * 16));
                accS[nt] = __builtin_amdgcn_mfma_f32_16x16x32_bf16(kf, Qf[2 * c + ss], accS[nt], 0, 0, 0);
            }
        if (c == 7) {
            float mx = -3.0e38f;
#pragma unroll
            for (int nt = 0; nt < 16; ++nt) mx = fmaxf(mx, fmaxf(fmaxf(accS[nt][0], accS[nt][1]), fmaxf(accS[nt][2], accS[nt][3])));
            mx = fmaxf(mx, __shfl_xor(mx, 16)); mx = fmaxf(mx, __shfl_xor(mx, 32));
            float sum = 0.f;
#pragma unroll
            for (int nt = 0; nt < 16; ++nt) {
#pragma unroll
                for (int e = 0; e < 4; ++e) { const float p = exp2f(accS[nt][e] - mx); accS[nt][e] = p; sum += p; } }
            sum += __shfl_xor(sum, 16); sum += __shfl_xor(sum, 32);
            const float inv = 1.0f / sum;
#pragma unroll
            for (int s = 0; s < 8; ++s) { v4u o; o.x = pk2(accS[2 * s][0] * inv, accS[2 * s][1] * inv); o.y = pk2(accS[2 * s][2] * inv, accS[2 * s][3] * inv);
                o.z = pk2(accS[2 * s + 1][0] * inv, accS[2 * s + 1][1] * inv); o.w = pk2(accS[2 * s + 1][2] * inv, accS[2 * s + 1][3] * inv); Pf[s] = __builtin_bit_cast(bf16x8, o); }
        }
        ATT_SWRITE(c + 1);
        __syncthreads();
    }
    for (int c = 8; c < 16; ++c) {
        if (c + 1 < 16) ATT_GLOAD(c + 1);
        const LAS unsigned char* sbuf = lds + (c & 1) * BUFB;
        const int dv = c - 8;
        f32x4 accO[4];
#pragma unroll
        for (int nd = 0; nd < 4; ++nd) accO[nd] = (f32x4){0.f, 0.f, 0.f, 0.f};
#pragma unroll
        for (int s = 0; s < 8; ++s)
#pragma unroll
            for (int nd = 0; nd < 4; ++nd) {
                const LAS unsigned char* rp = sbuf + (nd * 16 + fr) * 528 + (32 * s + 4 * fq) * 2;
                const v2u lo = *(const LAS v2u*)rp, hi = *(const LAS v2u*)(rp + 32);
                const bf16x8 vf = __builtin_bit_cast(bf16x8, ((v4u){lo.x, lo.y, hi.x, hi.y}));
                accO[nd] = __builtin_amdgcn_mfma_f32_16x16x32_bf16(vf, Pf[s], accO[nd], 0, 0, 0);
            }
#pragma unroll
        for (int nd = 0; nd < 4; ++nd) { v2u o; o.x = pk2(accO[nd][0], accO[nd][1]); o.y = pk2(accO[nd][2], accO[nd][3]);
            *(v2u*)(Og + (size_t)qrow * D + h * XD + dv * 64 + nd * 16 + 4 * fq) = o; }
        if (c + 1 < 16) ATT_SWRITE(c + 1);
        __syncthreads();
    }
#undef ATT_GLOAD
#undef ATT_SWRITE
}
__device__ __forceinline__ void attn_sample_task(const Params& P, const Ctx& C, LAS unsigned char* lds, int b, int h) {
    unsigned char* ws = wsbase(P);
    bf16* Og = (bf16*)(ws + WS_O);
    const float* CK = inp(P, I_CK); const float* CV = inp(P, I_CV);
    LAS float* sQ = (LAS float*)lds;
    LAS float* sS = (LAS float*)(lds + 16384);
    LAS float* sP = (LAS float*)(lds + 24576);
    LAS float* sO = (LAS float*)(lds + 32768);
    const int row0 = MP + 8 * b, fr = C.lane & 15, fq = C.lane >> 4;
#pragma unroll
    for (int j = 0; j < 2; ++j) { const int i4 = C.tid + NT * j, q = i4 >> 7, d4 = i4 & 127;
        const float* qp = (const float*)(ws + WS_SLAB) + (size_t)(8 * b + q) * D + h * XD + 4 * d4;
        f32x4 a = *(const f32x4*)qp;
#pragma unroll
        for (int sl = 1; sl < 8; ++sl) a += *(const f32x4*)(qp + sl * SLAB_F);
        *(LAS f32x4*)(sQ + q * 512 + 4 * d4) = a * 0.06375871479f; }
    __syncthreads();
    {
        bf16x8 Qf[16];
#pragma unroll
        for (int s = 0; s < 16; ++s) { const LAS float* qs = sQ + (fr & 7) * 512 + 32 * s + 8 * fq; const f32x4 x0 = *(const LAS f32x4*)qs, x1 = *(const LAS f32x4*)(qs + 4);
            v4u o; o.x = pk2(x0[0], x0[1]); o.y = pk2(x0[2], x0[3]); o.z = pk2(x1[0], x1[1]); o.w = pk2(x1[2], x1[3]); Qf[s] = __builtin_bit_cast(bf16x8, o); }
#pragma unroll
        for (int nt = 0; nt < 2; ++nt) {
            const int key = 32 * C.wave + 16 * nt + fr;
            const float* kp = CK + ((size_t)(b * NMEM + key) * XH + h) * XD + 8 * fq;
            f32x4 acc = (f32x4){0.f, 0.f, 0.f, 0.f};
#pragma unroll
            for (int s8 = 0; s8 < 2; ++s8) {
                f32x4 k0[8], k1[8];
#pragma unroll
                for (int s = 0; s < 8; ++s) { k0[s] = __builtin_nontemporal_load((const f32x4*)(kp + 32 * (8 * s8 + s))); k1[s] = __builtin_nontemporal_load((const f32x4*)(kp + 32 * (8 * s8 + s) + 4)); }
#pragma unroll
                for (int s = 0; s < 8; ++s) { v4u o; o.x = pk2(k0[s][0], k0[s][1]); o.y = pk2(k0[s][2], k0[s][3]); o.z = pk2(k1[s][0], k1[s][1]); o.w = pk2(k1[s][2], k1[s][3]);
                    acc = __builtin_amdgcn_mfma_f32_16x16x32_bf16(__builtin_bit_cast(bf16x8, o), Qf[8 * s8 + s], acc, 0, 0, 0); }
            }
            if (fr < 8) {
#pragma unroll
                for (int e = 0; e < 4; ++e) sS[fr * 256 + 32 * C.wave + 16 * nt + 4 * fq + e] = acc[e]; }
        }
    }
    __syncthreads();
    {
        const int q = C.wave; const f32x4 s4 = *(const LAS f32x4*)(sS + q * 256 + 4 * C.lane);
        const float mx = wave_max(fmaxf(fmaxf(s4[0], s4[1]), fmaxf(s4[2], s4[3])));
        const float p0 = exp2f(s4[0] - mx), p1 = exp2f(s4[1] - mx), p2 = exp2f(s4[2] - mx), p3 = exp2f(s4[3] - mx);
        const float inv = 1.0f / wave_sum((p0 + p1) + (p2 + p3));
        sP[(4 * C.lane + 0) * 8 + q] = p0 * inv; sP[(4 * C.lane + 1) * 8 + q] = p1 * inv; sP[(4 * C.lane + 2) * 8 + q] = p2 * inv; sP[(4 * C.lane + 3) * 8 + q] = p3 * inv;
    }
    __syncthreads();
    {
        const int dh = C.wave & 1, kq = C.wave >> 1;
        f32x4 acc[8];
#pragma unroll
        for (int q = 0; q < 8; ++q) acc[q] = (f32x4){0.f, 0.f, 0.f, 0.f};
        const float* vp = CV + ((size_t)(b * NMEM + 64 * kq) * XH + h) * XD + 256 * dh + 4 * C.lane;
        for (int k0 = 0; k0 < 64; k0 += 8) {
            f32x4 vv[8];
#pragma unroll
            for (int u = 0; u < 8; ++u) vv[u] = __builtin_nontemporal_load((const f32x4*)(vp + (size_t)(k0 + u) * (XH * XD)));
#pragma unroll
            for (int u = 0; u < 8; ++u) { const f32x4 pa = *(const LAS f32x4*)(sP + (64 * kq + k0 + u) * 8), pb = *(const LAS f32x4*)(sP + (64 * kq + k0 + u) * 8 + 4);
                acc[0] += vv[u] * pa[0]; acc[1] += vv[u] * pa[1]; acc[2] += vv[u] * pa[2]; acc[3] += vv[u] * pa[3];
                acc[4] += vv[u] * pb[0]; acc[5] += vv[u] * pb[1]; acc[6] += vv[u] * pb[2]; acc[7] += vv[u] * pb[3]; }
        }
#pragma unroll
        for (int q = 0; q < 8; ++q) *(LAS f32x4*)(sO + C.wave * 2048 + q * 256 + 4 * C.lane) = acc[q];
    }
    __syncthreads();
    {
        const int q = C.tid >> 6, d8 = (C.tid & 63) * 8, dh = d8 >> 8, dl = d8 & 255;
        f32x4 a = (f32x4){0.f, 0.f, 0.f, 0.f}, c2 = a;
#pragma unroll
        for (int kq = 0; kq < 4; ++kq) { const LAS float* sp = sO + (kq * 2 + dh) * 2048 + q * 256 + dl; a += *(const LAS f32x4*)sp; c2 += *(const LAS f32x4*)(sp + 4); }
        v4u o; o.x = pk2(a[0], a[1]); o.y = pk2(a[2], a[3]); o.z = pk2(c2[0], c2[1]); o.w = pk2(c2[2], c2[3]);
        *(v4u*)(Og + (size_t)(row0 + q) * D + h * XD + d8) = o;
    }
    __syncthreads();
}

__device__ __forceinline__ void unpack8(const v4u u, float (&x)[8]) { x[0] = bflo(u.x); x[1] = bfhi(u.x); x[2] = bflo(u.y); x[3] = bfhi(u.y); x[4] = bflo(u.z); x[5] = bfhi(u.z); x[6] = bflo(u.w); x[7] = bfhi(u.w); }
__device__ __forceinline__ void ffn_conv_act(const Params& P, const Ctx& C) {
    unsigned char* ws = wsbase(P);
    const bf16* UP = (const bf16*)(ws + WS_UP); bf16* ACT = (bf16*)(ws + WS_ACT);
    const float* FW = inp(P, I_FDW); const float* FB = inp(P, I_FDWB); const float* SF = inp(P, I_SFFN);
    constexpr int NG = DFF / 8;
    constexpr int NRUN = 256 + 128;
    for (int it = C.bid * NT + C.tid; it < NRUN * NG; it += C.G * NT) {
        const int run = it / NG, c = (it - run * NG) * 8;
        int row0, nrow, sb = -1, t0;
        if (run < 256) { row0 = run * 32; nrow = 32; t0 = row0 & (SEQ - 1); } else { sb = run - 256; row0 = MP + 8 * sb; nrow = 8; t0 = 0; }
        float w[2][3][8], bs[2][8];
#pragma unroll
        for (int hf = 0; hf < 2; ++hf) {
#pragma unroll
            for (int j = 0; j < 3; ++j) { const f32x4 a = *(const f32x4*)(FW + j * DFF2 + hf * DFF + c), b2 = *(const f32x4*)(FW + j * DFF2 + hf * DFF + c + 4);
                w[hf][j][0] = a[0]; w[hf][j][1] = a[1]; w[hf][j][2] = a[2]; w[hf][j][3] = a[3]; w[hf][j][4] = b2[0]; w[hf][j][5] = b2[1]; w[hf][j][6] = b2[2]; w[hf][j][7] = b2[3]; }
            const f32x4 a = *(const f32x4*)(FB + hf * DFF + c), b2 = *(const f32x4*)(FB + hf * DFF + c + 4);
            bs[hf][0] = a[0]; bs[hf][1] = a[1]; bs[hf][2] = a[2]; bs[hf][3] = a[3]; bs[hf][4] = b2[0]; bs[hf][5] = b2[1]; bs[hf][6] = b2[2]; bs[hf][7] = b2[3];
        }
        float xm2[2][8], xm1[2][8];
#pragma unroll
        for (int hf = 0; hf < 2; ++hf) {
            if (sb >= 0) { const float* s = SF + (size_t)sb * 2 * DFF2 + hf * DFF + c;
                const f32x4 a = *(const f32x4*)s, b2 = *(const f32x4*)(s + 4), a1 = *(const f32x4*)(s + DFF2), b1 = *(const f32x4*)(s + DFF2 + 4);
                xm2[hf][0] = a[0]; xm2[hf][1] = a[1]; xm2[hf][2] = a[2]; xm2[hf][3] = a[3]; xm2[hf][4] = b2[0]; xm2[hf][5] = b2[1]; xm2[hf][6] = b2[2]; xm2[hf][7] = b2[3];
                xm1[hf][0] = a1[0]; xm1[hf][1] = a1[1]; xm1[hf][2] = a1[2]; xm1[hf][3] = a1[3]; xm1[hf][4] = b1[0]; xm1[hf][5] = b1[1]; xm1[hf][6] = b1[2]; xm1[hf][7] = b1[3]; }
            else if (t0 > 0) { unpack8(*(const v4u*)(UP + (size_t)(row0 - 2) * DFF2 + hf * DFF + c), xm2[hf]); unpack8(*(const v4u*)(UP + (size_t)(row0 - 1) * DFF2 + hf * DFF + c), xm1[hf]); }
            else {
#pragma unroll
                for (int e = 0; e < 8; ++e) { xm2[hf][e] = 0.f; xm1[hf][e] = 0.f; } }
        }
        for (int r0 = 0; r0 < nrow; r0 += 4) {
            v4u u[4][2];
#pragma unroll
            for (int i = 0; i < 4; ++i) { u[i][0] = *(const v4u*)(UP + (size_t)(row0 + r0 + i) * DFF2 + c); u[i][1] = *(const v4u*)(UP + (size_t)(row0 + r0 + i) * DFF2 + DFF + c); }
#pragma unroll
            for (int i = 0; i < 4; ++i) {
                float x[2][8], uc[2][8];
                unpack8(u[i][0], x[0]); unpack8(u[i][1], x[1]);
#pragma unroll
                for (int hf = 0; hf < 2; ++hf)
#pragma unroll
                    for (int e = 0; e < 8; ++e) { uc[hf][e] = bs[hf][e] + w[hf][0][e] * xm2[hf][e] + w[hf][1][e] * xm1[hf][e] + w[hf][2][e] * x[hf][e]; xm2[hf][e] = xm1[hf][e]; xm1[hf][e] = x[hf][e]; }
                float a[8];
#pragma unroll
                for (int e = 0; e < 8; ++e) a[e] = uc[0][e] * sigm(uc[0][e]) * uc[1][e];
                v4u o; o.x = pk2(a[0], a[1]); o.y = pk2(a[2], a[3]); o.z = pk2(a[4], a[5]); o.w = pk2(a[6], a[7]);
                *(v4u*)(ACT + (size_t)(row0 + r0 + i) * DFF + c) = o;
            }
        }
    }
}

template <bool COOP>
__global__ void __launch_bounds__(NT, 2) mega(Params P) {
    extern __shared__ __attribute__((aligned(16))) unsigned char lds_raw[];
    LAS unsigned char* lds = (LAS unsigned char*)lds_raw;
    Ctx C0; C0.tid = threadIdx.x; C0.lane = C0.tid & 63; C0.wave = __builtin_amdgcn_readfirstlane(C0.tid >> 6); C0.bid = blockIdx.x; C0.G = gridDim.x;
    C0.gw = C0.bid * 8 + C0.wave; C0.NGW = C0.G * 8;
    const int lo = P.ph_lo, hi = P.ph_hi;
    if (threadIdx.x < 4) ((LAS unsigned*)(lds + MISC_OFF))[threadIdx.x] = 0u;
    __syncthreads();
    XcdBarrier xbar; xbar.bar = nullptr; xbar.x = 0; xbar.st = nullptr;
    if constexpr (COOP) xbar = xcd_barrier_post((unsigned*)P.ws, (volatile LAS unsigned*)(lds + MISC_OFF));
#ifndef MK_ONLY
#define MK_ONLY -1
#endif
#define IN(k) ((MK_ONLY < 0 || MK_ONLY == (k)) && lo <= (k) && (k) < hi)
#define PH_CTX() Ctx C = C0; unsigned char* ws = wsbase(P); (void)ws; asm volatile("" : "+v"(C.tid), "+v"(C.lane), "+s"(C.wave), "+s"(C.gw), "+s"(C.bid))
#ifndef MK_REPMASK
#define MK_REPMASK 0
#endif
#define NREP(k) (((MK_REPMASK >> (k)) & 1) ? 2 : 1)
#define SEAM(k) do { if constexpr (COOP) { if (IN(k) && IN((k) + 1)) { if ((k) == 0) cg::this_grid().sync(); else xcd_barrier(xbar); } } } while (0)

    for (int rep_ = 0; rep_ < NREP(0); ++rep_) if (IN(0)) { PH_CTX(); p0_prologue(P, C, lds); __syncthreads(); }
    SEAM(0);
    for (int rep_ = 0; rep_ < NREP(1); ++rep_) if (IN(1)) { PH_CTX();
        { pg8::Gemm g{(const pg8::bf16_t*)(ws + WS_HB), (const pg8::bf16_t*)(ws + WS_WIN), M, NINP, D, D}; pg8::StaticOrder S; S.init(M, NINP, C.G, C.bid);
          pg8::EpiIn E{(pg8::bf16_t*)(ws + WS_GLU), (pg8::bf16_t*)(ws + WS_PR), P.out + O_CP, P.out + O_CS, P.out + O_SP, P.out + O_SS};
          pg8::gemm_phase<pg8::EpiIn, pg8::StaticOrder, PG8_ALIGN, PG8_SP2>(lds, g, S, E); }
        { pg8::Gemm g{(const pg8::bf16_t*)(ws + WS_MB), (const pg8::bf16_t*)(ws + WS_WKV), 1024, 4096, D, D}; pg8::StaticOrder S; S.init(1024, 4096, C.G, (C.bid + C.G - 24) % C.G);
          pg8::EpiKV E{P.out + O_MK, P.out + O_MV, (pg8::bf16_t*)(ws + WS_KB), (pg8::bf16_t*)(ws + WS_VT)};
          pg8::gemm_phase<pg8::EpiKV, pg8::StaticOrder, PG8_ALIGN, PG8_SP2>(lds, g, S, E); }
    }
    SEAM(1);
    for (int rep_ = 0; rep_ < NREP(2); ++rep_) if (IN(2)) { PH_CTX();
        {   int cs = C.bid, cst = C.G, cn = (640 - C.bid + C.G - 1) / C.G;
            if (C.G == 256) { if (C.bid < 112) { cst = 112; cn = 4; } else { cs = 448 + (C.bid - 112); cst = 144; cn = (cs + 144 < 640) ? 2 : 1; } }
            SUBREP(0) for (int i = 0; i < cn; ++i) { const int tk = cs + i * cst;
                if (tk < 512) { const int b = tk >> 7, r0 = (tk & 127) * 16; conv_task<16>(P, C, lds, b * SEQ + r0, r0, -1); }
                else { const int sb = tk - 512; conv_task<8>(P, C, lds, MP + 8 * sb, 0, sb); } } }
        SUBREP(1) for (int tk = (C.G == 256 ? C.bid - 112 : C.bid); tk < 144; tk += C.G) if (tk >= 0) prep_task<8>(P, C, lds, tk >> 1, (tk & 1) * 8);
    }
    SEAM(2);
    for (int rep_ = 0; rep_ < NREP(3); ++rep_) if (IN(3)) { PH_CTX();
        const float* swkv = inp(P, I_SWKV);
        SUBREP(2) for (int tk = C.bid; tk < 256; tk += C.G) scan_prompt(P, C, lds, tk >> 2, tk & 3, C.G == 256 && sr_ == 0);
        { const int nsw = C.G * 4, per = (SEQ / TC + 2) / 5; const int done_upto = (C.G == 256 ? nsw * per : 0);
          for (int it = done_upto + C.gw; it < NDEF; it += C.NGW) { const DefItem di = def_item(P, ws, it); transpose_item(di.W, di.K, di.N, di.WT, di.kb, di.jb, C.lane, MapId()); } }
        SUBREP(3) for (int tk = C.bid; tk < 4096; tk += C.G) scan_sample(P, C, swkv, tk >> 1, tk & 1);
    }
    SEAM(3);
    for (int rep_ = 0; rep_ < NREP(4); ++rep_) if (IN(4)) { PH_CTX(); for (int m = C.gw; m < M; m += C.NGW) post_row(P, m, C.lane); }
    SEAM(4);
    for (int rep_ = 0; rep_ < NREP(5); ++rep_) if (IN(5)) { PH_CTX();
        { pg8::Gemm g{(const pg8::bf16_t*)(ws + WS_A2), (const pg8::bf16_t*)(ws + WS_WOUT), MP, D, D, D}; pg8::StaticOrder S; S.init(MP, D, C.G, C.bid);
          pg8::EpiBf16S E{(pg8::bf16_t*)(ws + WS_MIX), D, 1.0f, nullptr}; pg8::gemm_phase<pg8::EpiBf16S, pg8::StaticOrder, PG8_ALIGN, PG8_SP2>(lds, g, S, E); }
        { pg8::Gemm g{(const pg8::bf16_t*)(ws + WS_A2) + (size_t)MP * D, (const pg8::bf16_t*)(ws + WS_WOUT), MS, D, D / 8, D}; pg8::SplitOrder S; S.init(MS, D, 8, C.G, C.bid);
          pg8::EpiF32 E{(float*)(ws + WS_SLAB), D, SLAB_F}; pg8::gemm_phase<pg8::EpiF32, pg8::SplitOrder, PG8_ALIGN, PG8_SP2>(lds, g, S, E); } }
    SEAM(5);
    for (int rep_ = 0; rep_ < NREP(6); ++rep_) if (IN(6)) { PH_CTX(); const float* xp = inp(P, I_XP); const float* xs = inp(P, I_XS); const float* g1 = inp(P, I_NMIXPOST); const float* g2 = inp(P, I_NXAPRE);
        for (int m = C.gw; m < M; m += C.NGW) { const float* xr = m < MP ? xp + (size_t)m * D : xs + (size_t)(m - MP) * D;
        const bf16* mb = m < MP ? (const bf16*)(ws + WS_MIX) + (size_t)m * D : nullptr; const float* mx = (const float*)(ws + WS_SLAB) + (size_t)(m < MP ? 0 : m - MP) * D;
        rowpass(xr, mb, mx, 8, g1, (float*)(ws + WS_X1) + (size_t)m * D, g2, (bf16*)(ws + WS_HB) + (size_t)m * D, C.lane); } }
    SEAM(6);
    for (int rep_ = 0; rep_ < NREP(7); ++rep_) if (IN(7)) { PH_CTX();
        { pg8::Gemm g{(const pg8::bf16_t*)(ws + WS_HB), (const pg8::bf16_t*)(ws + WS_WQ), MP, D, D, D}; pg8::StaticOrder S; S.init(MP, D, C.G, C.bid);
          pg8::EpiBf16S E{(pg8::bf16_t*)(ws + WS_Q), D, 0.06375871479f  , nullptr};
          pg8::gemm_phase<pg8::EpiBf16S, pg8::StaticOrder, PG8_ALIGN, PG8_SP2>(lds, g, S, E); }
        { pg8::Gemm g{(const pg8::bf16_t*)(ws + WS_HB) + (size_t)MP * D, (const pg8::bf16_t*)(ws + WS_WQ), MS, D, D / 8, D}; pg8::SplitOrder S; S.init(MS, D, 8, C.G, C.bid);
          pg8::EpiF32 E{(float*)(ws + WS_SLAB), D, SLAB_F}; pg8::gemm_phase<pg8::EpiF32, pg8::SplitOrder, PG8_ALIGN, PG8_SP2>(lds, g, S, E); } }
    SEAM(7);
    for (int rep_ = 0; rep_ < NREP(8); ++rep_) if (IN(8)) { PH_CTX();
        SUBREP(4) for (int tk = C.bid; tk < 256; tk += C.G) attn_prompt_task(P, C, lds, tk >> 6, (tk >> 4) & 3, tk & 15);
        SUBREP(5) for (int tk = C.bid; tk < 512; tk += C.G) attn_sample_task(P, C, lds, tk >> 2, tk & 3);
    }
    SEAM(8);
    for (int rep_ = 0; rep_ < NREP(9); ++rep_) if (IN(9)) { PH_CTX();
        { pg8::Gemm g{(const pg8::bf16_t*)(ws + WS_O), (const pg8::bf16_t*)(ws + WS_WO), MP, D, D, D}; pg8::StaticOrder S; S.init(MP, D, C.G, C.bid);
          pg8::EpiBf16S E{(pg8::bf16_t*)(ws + WS_MIX), D, 1.0f, nullptr}; pg8::gemm_phase<pg8::EpiBf16S, pg8::StaticOrder, PG8_ALIGN, PG8_SP2>(lds, g, S, E); }
        { pg8::Gemm g{(const pg8::bf16_t*)(ws + WS_O) + (size_t)MP * D, (const pg8::bf16_t*)(ws + WS_WO), MS, D, D / 8, D}; pg8::SplitOrder S; S.init(MS, D, 8, C.G, C.bid);
          pg8::EpiF32 E{(float*)(ws + WS_SLAB), D, SLAB_F}; pg8::gemm_phase<pg8::EpiF32, pg8::SplitOrder, PG8_ALIGN, PG8_SP2>(lds, g, S, E); } }
    SEAM(9);
    for (int rep_ = 0; rep_ < NREP(10); ++rep_) if (IN(10)) { PH_CTX(); const float* g1 = inp(P, I_NXAPOST); const float* g2 = inp(P, I_NFFNPRE);
        for (int m = C.gw; m < M; m += C.NGW) { float* x1 = (float*)(ws + WS_X1) + (size_t)m * D;
        const bf16* mb = m < MP ? (const bf16*)(ws + WS_MIX) + (size_t)m * D : nullptr; const float* mx = (const float*)(ws + WS_SLAB) + (size_t)(m < MP ? 0 : m - MP) * D;
        rowpass(x1, mb, mx, 8, g1, x1, g2, (bf16*)(ws + WS_HB) + (size_t)m * D, C.lane); } }
    SEAM(10);
    for (int rep_ = 0; rep_ < NREP(11); ++rep_) if (IN(11)) { PH_CTX(); pg8::Gemm g{(const pg8::bf16_t*)(ws + WS_HB), (const pg8::bf16_t*)(ws + WS_WUP), M, DFF2, D, D}; pg8::StaticOrder S; S.init(M, DFF2, C.G, C.bid);
        pg8::EpiBf16S E{(pg8::bf16_t*)(ws + WS_UP), DFF2, 1.0f, P.out + O_FP};
        pg8::gemm_phase<pg8::EpiBf16S, pg8::StaticOrder, PG8_ALIGN, PG8_SP2>(lds, g, S, E); }
    SEAM(11);
    for (int rep_ = 0; rep_ < NREP(12); ++rep_) if (IN(12)) { PH_CTX(); ffn_conv_act(P, C); }
    SEAM(12);
    for (int rep_ = 0; rep_ < NREP(13); ++rep_) if (IN(13)) { PH_CTX();
        { pg8::Gemm g{(const pg8::bf16_t*)(ws + WS_ACT), (const pg8::bf16_t*)(ws + WS_WDN), MP, D, DFF, DFF}; pg8::StaticOrder S; S.init(MP, D, C.G, C.bid);
          pg8::EpiBf16S E{(pg8::bf16_t*)(ws + WS_MIX), D, 1.0f, nullptr}; pg8::gemm_phase<pg8::EpiBf16S, pg8::StaticOrder, PG8_ALIGN, PG8_SP2>(lds, g, S, E); }
        { pg8::Gemm g{(const pg8::bf16_t*)(ws + WS_ACT) + (size_t)MP * DFF, (const pg8::bf16_t*)(ws + WS_WDN), MS, D, DFF / 4, DFF}; pg8::SplitOrder S; S.init(MS, D, 4, C.G, (C.bid + 128) % C.G);
          pg8::EpiF32 E{(float*)(ws + WS_SLAB), D, SLAB_F}; pg8::gemm_phase<pg8::EpiF32, pg8::SplitOrder, PG8_ALIGN, PG8_SP2>(lds, g, S, E); } }
    SEAM(13);
    for (int rep_ = 0; rep_ < NREP(14); ++rep_) if (IN(14)) { PH_CTX(); const float* g1 = inp(P, I_NFFNPOST);
        for (int m = C.gw; m < M; m += C.NGW) { const float* x2 = (const float*)(ws + WS_X1) + (size_t)m * D;
        float* yo = m < MP ? P.out + O_YP + (size_t)m * D : P.out + O_YS + (size_t)(m - MP) * D;
        const bf16* mb = m < MP ? (const bf16*)(ws + WS_MIX) + (size_t)m * D : nullptr; const float* mx = (const float*)(ws + WS_SLAB) + (size_t)(m < MP ? 0 : m - MP) * D;
        rowpass(x2, mb, mx, 4, g1, yo, nullptr, nullptr, C.lane); } }
#undef IN
#undef SEAM
}

#ifndef MK_ONE_LAUNCH
#define MK_ONE_LAUNCH 1
#endif
extern "C" void kernel_launch(void* const* d_in, const int* in_sizes, int n_in, void* d_out, int out_size, void* d_ws, size_t ws_size, hipStream_t stream) {
    static int grid = 0;
    if (grid == 0) {
        if (n_in != N_IN || (size_t)out_size != O_END || ws_size < WS_END) { fprintf(stderr, "kernel_launch: unexpected sizes: n_in %d out %d ws %zu (need %zu)\n", n_in, out_size, ws_size, (size_t)WS_END); grid = -1; return; }
        int dev = 0, cus = 0, per_cu = 0;
        (void)hipGetDevice(&dev); (void)hipDeviceGetAttribute(&cus, hipDeviceAttributeMultiprocessorCount, dev);
        (void)hipFuncSetAttribute((const void*)mega<(MK_ONE_LAUNCH != 0)>, hipFuncAttributeMaxDynamicSharedMemorySize, LDS_BYTES);
        (void)hipOccupancyMaxActiveBlocksPerMultiprocessor(&per_cu, (const void*)mega<(MK_ONE_LAUNCH != 0)>, NT, LDS_BYTES);
        fprintf(stderr, "kernel_launch: cus %d, occupancy query %d block(s)/CU, ws %zu MiB\n", cus, per_cu, ws_size >> 20);
        (void)hipGetLastError();
        grid = cus;
        if (per_cu < 1) { fprintf(stderr, "kernel_launch: occupancy query says 0 blocks per CU\n"); }
    }
    if (grid < 0) return;
    if (hipMemsetAsync(d_ws, 0, 16384, stream) != hipSuccess) { fprintf(stderr, "kernel_launch: hipMemsetAsync failed\n"); return; }
    Params p{};
    for (int i = 0; i < N_IN; ++i) p.in[i] = (const float*)d_in[i];
    p.out = (float*)d_out; p.ws = (unsigned char*)d_ws;
#if MK_ONE_LAUNCH
    p.ph_lo = 0; p.ph_hi = NPHASE;
    void* args[] = {&p};
    hipError_t e = hipLaunchCooperativeKernel((const void*)mega<true>, dim3(grid), dim3(NT), args, LDS_BYTES, stream);
    if (e != hipSuccess) fprintf(stderr, "cooperative launch failed: %s (grid %d)\n", hipGetErrorString(e), grid);
#else
    for (int ph = 0; ph < NPHASE; ++ph) { p.ph_lo = ph; p.ph_hi = ph + 1; hipLaunchKernelGGL((mega<false>), dim3(grid), dim3(NT), LDS_BYTES, stream, p); }
#endif
}
```

```cpp
#include <hip/hip_runtime.h>
#include <hip/hip_cooperative_groups.h>
#include <cstdio>
#include <cstdint>
namespace cg = cooperative_groups;
constexpr int D = 2048, MP = 8192, MS = 1024, M = MP + MS, SEQ = 2048, TS = 8, NBP = 4, NBS = 128;
constexpr int CC = 1024, CW = 31, RW = 1024, RH = 16, HD = 64;
constexpr int NRC = 3520, NRCP = 3584, NINP = 5632;
constexpr int NMEM = 256, XH = 4, XD = 512, DFF = 5632, DFF2 = 11264;
namespace pg8 {
#define PG8_LAS __attribute__((address_space(3)))
typedef unsigned short bf16_t;
typedef short bf16x8 __attribute__((ext_vector_type(8)));
typedef float f32x4 __attribute__((ext_vector_type(4)));
typedef unsigned u32x4 __attribute__((ext_vector_type(4)));
constexpr int BM = 256, BK = 64, HALF = 128, HTB = HALF * BK * 2  , STAGE_BYTES = 8 * HTB, NXCD = 8, WGM = 8;

__host__ __device__ __forceinline__ int lds_byte(int r, int c) { const int st = (r >> 4) * 2 + (c >> 5), rr = r & 15, cc = c & 31, ob = rr * 64 + cc * 2; return st * 1024 + (ob ^ (((ob >> 9) & 1) << 5)); }
__host__ __device__ __forceinline__ void stage_rc(int b, int& R, int& C) { const int st = b / 1024, sb = b % 1024, swz = sb ^ (((sb >> 9) & 1) << 5); R = (st >> 1) * 16 + swz / 64; C = (st & 1) * 32 + (swz % 64) / 2; }
__host__ __device__ __forceinline__ int perm32(int rho) { const int n = rho >> 4, i = rho & 15; return 8 * (i >> 2) + 4 * n + (i & 3); }

struct Unit { int pm, pn, ks; };
struct Gemm { const bf16_t* A; const bf16_t* Bt; int M, N, K, ld; };

struct StaticOrder {
    int nM, nN, nwg, G, c;
    __host__ __device__ void init(int M, int N, int G_, int c_) { nM = M / BM; nN = N / BM; nwg = nM * nN; G = G_; c = c_; }
    __host__ __device__ bool next(int i, Unit& u) const {
        const long L = (long)i * G + c; if (L >= nwg) return false;
        int wgid = (int)L; { const int q = nwg / NXCD, r = nwg % NXCD, xcd = wgid % NXCD, off = wgid / NXCD; wgid = (xcd < r ? xcd * (q + 1) : r * (q + 1) + (xcd - r) * q) + off; }
        const int nig = WGM * nN, gid = wgid / nig, fm = gid * WGM, gsz = (nM - fm) < WGM ? (nM - fm) : WGM;
        u.pm = fm + ((wgid % nig) % gsz); u.pn = (wgid % nig) / gsz; u.ks = 0; return true;
    }
    __device__ __forceinline__ void a_ready(const Unit&) const {}
    __device__ __forceinline__ void done(const Unit&) const {}
};

struct SplitOrder {
    int nN, nsplit, nitems, G, c;
    __host__ __device__ void init(int M, int N, int nsplit_, int G_, int c_) { nN = N / BM; nsplit = nsplit_; nitems = (M / BM) * nN * nsplit_; G = G_; c = c_; }
    __host__ __device__ bool next(int i, Unit& u) const { const int L = i * G + c; if (L >= nitems) return false; u.ks = L % nsplit; const int t = L / nsplit; u.pn = t % nN; u.pm = t / nN; return true; }
    __device__ __forceinline__ void a_ready(const Unit&) const {}
    __device__ __forceinline__ void done(const Unit&) const {}
};
__device__ __forceinline__ unsigned cvt_pk_bf16(float lo, float hi) { unsigned r; asm volatile("v_cvt_pk_bf16_f32 %0, %1, %2" : "=v"(r) : "v"(lo), "v"(hi)); return r; }
typedef float f32x2 __attribute__((ext_vector_type(2)));
typedef unsigned u32x2 __attribute__((ext_vector_type(2)));
struct EpiIn {
    static constexpr bool PERM = true, AFTER_DRAIN = false;
    bf16_t* glu; bf16_t* pr; float* oconv_p; float* oconv_s; float* oshift_p; float* oshift_s;
    __device__ __forceinline__ void operator()(const f32x4 (&acc)[2][2][4][2], const Unit& u, int wr, int wc, int fr, int fq) const {
        const int row0 = u.pm * BM + wr * 64 + fr;
        if (u.pn < 8) {
#pragma unroll
            for (int ai = 0; ai < 2; ++ai)
#pragma unroll
                for (int m = 0; m < 4; ++m) {
                    const int row = row0 + ai * HALF + m * 16;
                    float* cdst = nullptr;
                    if (row < MP) { const int t = row & (SEQ - 1); if (t >= SEQ - 30) cdst = oconv_p + (size_t)((row >> 11) * 30 + (t - (SEQ - 30))) * CC; }
                    else { const int rs = row - MP; cdst = oconv_s + (size_t)((rs >> 3) * 30 + 22 + (rs & 7)) * CC; }
#pragma unroll
                    for (int bj = 0; bj < 2; ++bj) {
                        const int cgl = 16 * (8 * u.pn + 4 * bj + wc) + 4 * fq;
                        const f32x4 a = acc[ai][bj][m][0], g = acc[ai][bj][m][1];
                        f32x4 v;
#pragma unroll
                        for (int e = 0; e < 4; ++e) v[e] = a[e] / (1.0f + __expf(-g[e]));
                        u32x2 w; w.x = cvt_pk_bf16(v[0], v[1]); w.y = cvt_pk_bf16(v[2], v[3]);
                        *(u32x2*)(glu + (size_t)row * CC + cgl) = w;
                        if (cdst) *(f32x4*)(cdst + cgl) = v;
                    }
                }
        } else {
#pragma unroll
            for (int ai = 0; ai < 2; ++ai)
#pragma unroll
                for (int m = 0; m < 4; ++m) {
                    const int row = row0 + ai * HALF + m * 16;
                    float* sdst = nullptr;
                    if (row < MP) { if ((row & (SEQ - 1)) == SEQ - 1) sdst = oshift_p + (size_t)(row >> 11) * NRC; }
                    else { const int rs = row - MP; if ((rs & 7) == 7) sdst = oshift_s + (size_t)(rs >> 3) * NRC; }
#pragma unroll
                    for (int bj = 0; bj < 2; ++bj) {
                        const int jj0 = 256 * (u.pn - 8) + 128 * bj + 32 * wc + 8 * fq;
                        const f32x4 v0 = acc[ai][bj][m][0], v1 = acc[ai][bj][m][1];
                        u32x4 w; w.x = cvt_pk_bf16(v0[0], v0[1]); w.y = cvt_pk_bf16(v0[2], v0[3]); w.z = cvt_pk_bf16(v1[0], v1[1]); w.w = cvt_pk_bf16(v1[2], v1[3]);
                        *(u32x4*)(pr + (size_t)row * NRCP + jj0) = w;
                        if (sdst && jj0 < NRC) { *(f32x4*)(sdst + jj0) = v0; *(f32x4*)(sdst + jj0 + 4) = v1; }
                    }
                }
        }
    }
};
struct EpiKV {
    static constexpr bool PERM = false, AFTER_DRAIN = false;
    float* ok; float* ov; bf16_t* kb; bf16_t* vt;
    __device__ __forceinline__ void operator()(const f32x4 (&acc)[2][2][4][2], const Unit& u, int wr, int wc, int fr, int fq) const {
        const int row0 = u.pm * BM + wr * 64 + fr;
#pragma unroll
        for (int ai = 0; ai < 2; ++ai)
#pragma unroll
            for (int m = 0; m < 4; ++m) {
                const int r = row0 + ai * HALF + m * 16;
#pragma unroll
                for (int bj = 0; bj < 2; ++bj)
#pragma unroll
                    for (int n = 0; n < 2; ++n) {
                        const int c = 256 * u.pn + 128 * bj + 32 * wc + 16 * n + 4 * fq;
                        const f32x4 v = acc[ai][bj][m][n];
                        if (u.pn < 8) {
                            *(f32x4*)(ok + (size_t)r * 2048 + c) = v;
                            u32x2 w; w.x = cvt_pk_bf16(v[0], v[1]); w.y = cvt_pk_bf16(v[2], v[3]);
                            *(u32x2*)(kb + (size_t)r * 2048 + c) = w;
                        } else {
                            const int cv = c - 2048;
                            *(f32x4*)(ov + (size_t)r * 2048 + cv) = v;
                            const int b = r >> 8, key = r & 255, h = cv >> 9, d = cv & 511;
                            bf16_t* dst = vt + ((size_t)((b * 4 + h) * 512 + d)) * 256 + key;
                            const unsigned w0 = cvt_pk_bf16(v[0], v[1]), w1 = cvt_pk_bf16(v[2], v[3]);
                            dst[0] = (bf16_t)(w0 & 0xffffu); dst[256] = (bf16_t)(w0 >> 16); dst[512] = (bf16_t)(w1 & 0xffffu); dst[768] = (bf16_t)(w1 >> 16);
                        }
                    }
            }
    }
};
struct EpiF32 {
    static constexpr bool PERM = false, AFTER_DRAIN = false;
    float* C; int ldc; size_t slab;
    __device__ __forceinline__ void operator()(const f32x4 (&acc)[2][2][4][2], const Unit& u, int wr, int wc, int fr, int fq) const {
        const int row0 = u.pm * BM + wr * 64 + fr, col0 = u.pn * BM + wc * 32 + 4 * fq;
#pragma unroll
        for (int ai = 0; ai < 2; ++ai)
#pragma unroll
            for (int m = 0; m < 4; ++m) { float* rowp = C + (size_t)u.ks * slab + (size_t)(row0 + ai * HALF + m * 16) * ldc + col0;
#pragma unroll
                for (int bj = 0; bj < 2; ++bj)
#pragma unroll
                    for (int n = 0; n < 2; ++n) *(f32x4*)(rowp + bj * HALF + n * 16) = acc[ai][bj][m][n]; }
    }
};
struct EpiBf16S {
    static constexpr bool PERM = true, AFTER_DRAIN = false;
    bf16_t* O; int ldc; float scale; float* f;
    __device__ __forceinline__ void operator()(const f32x4 (&acc)[2][2][4][2], const Unit& u, int wr, int wc, int fr, int fq) const {
        const int row0 = u.pm * BM + wr * 64 + fr, col0 = u.pn * BM + wc * 32 + 8 * fq;
#pragma unroll
        for (int ai = 0; ai < 2; ++ai)
#pragma unroll
            for (int m = 0; m < 4; ++m) {
                const int row = row0 + ai * HALF + m * 16;
                long foff = -1;
                if (f) {
                    if (row < MP) { const int t = row & (SEQ - 1); if (t >= SEQ - 2) foff = (long)((row >> 11) * 2 + (t - (SEQ - 2))) * DFF2; }
                    else { const int rs = row - MP, t = rs & 7; if (t >= 6) foff = (long)(NBP * 2 + (rs >> 3) * 2 + (t - 6)) * DFF2; }
                }
                float* fdst = f + (foff < 0 ? 0 : foff);
                bf16_t* rowp = O + (size_t)row * ldc + col0;
#pragma unroll
                for (int bj = 0; bj < 2; ++bj) {
                    const f32x4 v0 = acc[ai][bj][m][0] * scale, v1 = acc[ai][bj][m][1] * scale;
                    u32x4 w; w.x = cvt_pk_bf16(v0[0], v0[1]); w.y = cvt_pk_bf16(v0[2], v0[3]); w.z = cvt_pk_bf16(v1[0], v1[1]); w.w = cvt_pk_bf16(v1[2], v1[3]);
                    *(u32x4*)(rowp + bj * HALF) = w;
                    if (foff >= 0) { *(f32x4*)(fdst + col0 + bj * HALF) = v0; *(f32x4*)(fdst + col0 + bj * HALF + 4) = v1; }
                }
            }
    }
};

template <class Epi, class Sched, bool ALIGN_EPI = false, bool SP2 = false>
__device__ __forceinline__ void gemm_phase(PG8_LAS unsigned char* lds, const Gemm g, const Sched& S, const Epi& E) {
    int tid_ = threadIdx.x; asm volatile("" : "+v"(tid_));
    const int tid = tid_, wid = __builtin_amdgcn_readfirstlane(tid >> 6), lane = tid & 63, wr = wid >> 2, wc = wid & 3, fr = lane & 15, fq = lane >> 4;
    const int K = g.K, nt = K / BK;
    unsigned voffA[2], voffB[2];
#pragma unroll
    for (int i = 0; i < 2; ++i) { int R, C; stage_rc(tid * 16 + i * 8192, R, C); const int Rb = Epi::PERM ? ((R & ~31) + perm32(R & 31)) : R;
        voffA[i] = (unsigned)(R * g.ld + C) * 2u; voffB[i] = (unsigned)(Rb * g.ld + C) * 2u; }
    const size_t kstep = (size_t)(BK * 2);
    const size_t hstep = (size_t)HALF * g.ld * 2;
    const size_t tstep = 2 * hstep;
    const unsigned ldsw = (unsigned)wid * 1024u;
    const int aoff = lds_byte(wr * 64 + fr, fq * 8), boff = lds_byte(wc * 32 + fr, fq * 8);
#define PG8_SA(b, h) (((b) * 2 + (h)) * HTB)
#define PG8_SB(b, h) ((4 + (b) * 2 + (h)) * HTB)
#define PG8_STAGE(bufoff, gbase, voff) do { _Pragma("unroll") for (int _i = 0; _i < 2; ++_i) \
        __builtin_amdgcn_global_load_lds((const unsigned*)((const char*)(gbase) + (voff)[_i]), (PG8_LAS unsigned*)(lds + (bufoff) + ldsw + _i * 8192), 16, 0, 0); } while (0)
#define PG8_LDA(dst, b, h) do { _Pragma("unroll") for (int m = 0; m < 4; ++m) _Pragma("unroll") for (int k = 0; k < 2; ++k) dst[m][k] = *(const PG8_LAS bf16x8*)(lds + PG8_SA(b, h) + aoff + m * 2048 + k * 1024); } while (0)
#define PG8_LDB(dst, b, h) do { _Pragma("unroll") for (int n = 0; n < 2; ++n) _Pragma("unroll") for (int k = 0; k < 2; ++k) dst[n][k] = *(const PG8_LAS bf16x8*)(lds + PG8_SB(b, h) + boff + n * 2048 + k * 1024); } while (0)
#define PG8_MMA(ai, bj, At, Bt) do { __builtin_amdgcn_s_setprio(1); _Pragma("unroll") for (int m = 0; m < 4; ++m) _Pragma("unroll") for (int n = 0; n < 2; ++n) _Pragma("unroll") for (int k = 0; k < 2; ++k) \
        acc[ai][bj][m][n] = __builtin_amdgcn_mfma_f32_16x16x32_bf16(Bt[n][k], At[m][k], acc[ai][bj][m][n], 0, 0, 0); __builtin_amdgcn_s_setprio(0); } while (0)
#define PG8_WAIT_V(n) asm volatile("s_waitcnt vmcnt(" #n ")" ::: "memory")
#define PG8_WAIT_L(n) asm volatile("s_waitcnt lgkmcnt(" #n ")" ::: "memory")
#define PG8_BAR __builtin_amdgcn_s_barrier()
#define PG8_SCHED __builtin_amdgcn_sched_barrier(0)
    Unit cur, nxt; int ui = 0;
    if (!S.next(0, cur)) return;
    f32x4 acc[2][2][4][2];
#pragma unroll
    for (int a = 0; a < 2; ++a)
#pragma unroll
        for (int b = 0; b < 2; ++b)
#pragma unroll
            for (int m = 0; m < 4; ++m)
#pragma unroll
                for (int n = 0; n < 2; ++n) acc[a][b][m][n] = (f32x4){0.f, 0.f, 0.f, 0.f};
    bf16x8 At[4][2], B0[2][2], B1[2][2];
    const size_t sstep = (size_t)K * 2;
    const char* cA = (const char*)g.A + (size_t)cur.pm * tstep + (size_t)cur.ks * sstep; const char* cB = (const char*)g.Bt + (size_t)cur.pn * tstep + (size_t)cur.ks * sstep;
    S.a_ready(cur);
    if constexpr (SP2) {
        PG8_STAGE(PG8_SB(0, 0), cB, voffB); PG8_STAGE(PG8_SB(0, 1), cB + hstep, voffB); PG8_STAGE(PG8_SA(0, 0), cA, voffA); PG8_STAGE(PG8_SA(0, 1), cA + hstep, voffA);
        if (wr == 1) PG8_BAR;
        PG8_WAIT_V(2); PG8_BAR;
        PG8_STAGE(PG8_SB(1, 0), cB + kstep, voffB); PG8_STAGE(PG8_SA(1, 0), cA + kstep, voffA); PG8_STAGE(PG8_SB(1, 1), cB + hstep + kstep, voffB);
        PG8_WAIT_V(6); PG8_BAR;
    } else {
        PG8_STAGE(PG8_SB(0, 0), cB, voffB); PG8_STAGE(PG8_SA(0, 0), cA, voffA); PG8_STAGE(PG8_SB(0, 1), cB + hstep, voffB); PG8_STAGE(PG8_SA(0, 1), cA + hstep, voffA);
        if (wr == 1) PG8_BAR;
        PG8_WAIT_V(4); PG8_BAR;
        PG8_STAGE(PG8_SB(1, 0), cB + kstep, voffB); PG8_STAGE(PG8_SA(1, 0), cA + kstep, voffA); PG8_STAGE(PG8_SB(1, 1), cB + hstep + kstep, voffB);
        PG8_WAIT_V(6); PG8_BAR;
    }
    for (;;) {
        const bool has_next = S.next(ui + 1, nxt);
        const char* nA = has_next ? (const char*)g.A + (size_t)nxt.pm * tstep + (size_t)nxt.ks * sstep : cA; const char* nB = has_next ? (const char*)g.Bt + (size_t)nxt.pn * tstep + (size_t)nxt.ks * sstep : cB;
        for (int t = 0; t < nt; t += 2) {
            const bool last = (t == nt - 2);
            const char* a1 = cA + (size_t)(t + 1) * kstep;
            const char* a2 = last ? nA : cA + (size_t)(t + 2) * kstep; const char* b2 = last ? nB : cB + (size_t)(t + 2) * kstep;
            const char* a3 = a2 + kstep; const char* b3 = b2 + kstep;
            if (last && has_next) S.a_ready(nxt);
            if constexpr (SP2) {
            PG8_LDB(B0, 0, 0); PG8_LDB(B1, 0, 1); PG8_SCHED; PG8_LDA(At, 0, 0); PG8_STAGE(PG8_SA(1, 1), a1 + hstep, voffA);
            PG8_WAIT_V(8); PG8_WAIT_L(0); PG8_BAR; PG8_MMA(0, 0, At, B0); PG8_MMA(0, 1, At, B1); PG8_BAR; PG8_SCHED;
            PG8_LDA(At, 0, 1); PG8_STAGE(PG8_SB(0, 0), b2, voffB); PG8_STAGE(PG8_SB(0, 1), b2 + hstep, voffB); PG8_STAGE(PG8_SA(0, 0), a2, voffA);
            PG8_WAIT_V(8); PG8_WAIT_L(0); PG8_BAR; PG8_MMA(1, 0, At, B0); PG8_MMA(1, 1, At, B1); PG8_BAR; PG8_SCHED;
            PG8_LDB(B0, 1, 0); PG8_LDB(B1, 1, 1); PG8_SCHED; PG8_LDA(At, 1, 0); PG8_STAGE(PG8_SA(0, 1), a2 + hstep, voffA);
            PG8_WAIT_V(8); PG8_WAIT_L(0); PG8_BAR; PG8_MMA(0, 0, At, B0); PG8_MMA(0, 1, At, B1); PG8_BAR; PG8_SCHED;
            PG8_LDA(At, 1, 1); PG8_STAGE(PG8_SB(1, 0), b3, voffB); PG8_STAGE(PG8_SB(1, 1), b3 + hstep, voffB); PG8_STAGE(PG8_SA(1, 0), a3, voffA);
            PG8_WAIT_V(8); PG8_WAIT_L(0); PG8_BAR; PG8_MMA(1, 0, At, B0); PG8_MMA(1, 1, At, B1); PG8_BAR; PG8_SCHED;
            } else {
            PG8_LDB(B0, 0, 0); PG8_SCHED; PG8_LDA(At, 0, 0); PG8_STAGE(PG8_SA(1, 1), a1 + hstep, voffA);
            PG8_WAIT_L(8); PG8_BAR; PG8_WAIT_L(0); PG8_MMA(0, 0, At, B0); PG8_BAR; PG8_SCHED;
            PG8_LDB(B1, 0, 1); PG8_STAGE(PG8_SB(0, 0), b2, voffB);
            PG8_BAR; PG8_WAIT_L(0); PG8_MMA(0, 1, At, B1); PG8_BAR;
            PG8_LDA(At, 0, 1); PG8_STAGE(PG8_SA(0, 0), a2, voffA);
            PG8_BAR; PG8_WAIT_L(0); PG8_MMA(1, 0, At, B0); PG8_BAR; PG8_SCHED;
            PG8_STAGE(PG8_SB(0, 1), b2 + hstep, voffB);
            PG8_WAIT_V(6); PG8_BAR; PG8_MMA(1, 1, At, B1); PG8_BAR;
            PG8_LDB(B0, 1, 0); PG8_SCHED; PG8_LDA(At, 1, 0); PG8_STAGE(PG8_SA(0, 1), a2 + hstep, voffA);
            PG8_WAIT_L(8); PG8_BAR; PG8_WAIT_L(0); PG8_MMA(0, 0, At, B0); PG8_BAR; PG8_SCHED;
            PG8_LDB(B1, 1, 1); PG8_STAGE(PG8_SB(1, 0), b3, voffB);
            PG8_BAR; PG8_WAIT_L(0); PG8_MMA(0, 1, At, B1); PG8_BAR;
            PG8_LDA(At, 1, 1); PG8_STAGE(PG8_SA(1, 0), a3, voffA);
            PG8_BAR; PG8_WAIT_L(0); PG8_MMA(1, 0, At, B0); PG8_BAR; PG8_SCHED;
            PG8_STAGE(PG8_SB(1, 1), b3 + hstep, voffB);
            PG8_WAIT_V(6); PG8_BAR; PG8_MMA(1, 1, At, B1); PG8_BAR;
            }
        }
        if constexpr (ALIGN_EPI) { if (wr == 0) PG8_BAR; }
        if constexpr (!Epi::AFTER_DRAIN) { E(acc, cur, wr, wc, fr, fq); S.done(cur); }
        if (!has_next) break;
#pragma unroll
        for (int a = 0; a < 2; ++a)
#pragma unroll
            for (int b = 0; b < 2; ++b)
#pragma unroll
                for (int m = 0; m < 4; ++m)
#pragma unroll
                    for (int n = 0; n < 2; ++n) acc[a][b][m][n] = (f32x4){0.f, 0.f, 0.f, 0.f};
        cur = nxt; cA = nA; cB = nB; ++ui;
        if constexpr (ALIGN_EPI) { if (wr == 1) PG8_BAR; }
    }
    PG8_WAIT_V(0);
    if constexpr (!ALIGN_EPI) { if (wr == 0) PG8_BAR; }
    PG8_BAR;
    if constexpr (Epi::AFTER_DRAIN) { E.fused(acc, cur, wr, wc, fr, fq, lds, wid, lane); S.done(cur); }
#undef PG8_SA
#undef PG8_SB
#undef PG8_STAGE
#undef PG8_LDA
#undef PG8_LDB
#undef PG8_MMA
#undef PG8_WAIT_V
#undef PG8_WAIT_L
#undef PG8_BAR
#undef PG8_SCHED
}
}
#ifndef PG8_SP2
#define PG8_SP2 true
#endif
#ifndef PG8_ALIGN
#define PG8_ALIGN true
#endif
#define LAS __attribute__((address_space(3)))
typedef unsigned short bf16;
typedef unsigned v4u __attribute__((ext_vector_type(4)));
typedef unsigned v2u __attribute__((ext_vector_type(2)));
typedef float f32x4 __attribute__((ext_vector_type(4)));
typedef float f32x2 __attribute__((ext_vector_type(2)));
typedef short bf16x8 __attribute__((ext_vector_type(8)));
constexpr int NT = 512;
constexpr int LDS_BYTES = 163840;
constexpr int NPHASE = 15;

constexpr size_t MiB = 1u << 20;
constexpr size_t WS_WIN = 1 * MiB, WS_WKV = 23 * MiB, WS_WOUT = 39 * MiB, WS_WQ = 47 * MiB, WS_WO = 55 * MiB, WS_WUP = 63 * MiB, WS_WDN = 107 * MiB;
constexpr size_t WS_LW = 129 * MiB, WS_LA = 129 * MiB + 256 * 1024, WS_LG = 129 * MiB + 512 * 1024;
constexpr size_t WS_HB = 130 * MiB, WS_MB = 166 * MiB, WS_A2 = 170 * MiB, WS_MIX = 206 * MiB, WS_X1 = 278 * MiB, WS_Q = 350 * MiB, WS_O = 386 * MiB;
constexpr size_t WS_KB = 422 * MiB, WS_VT = 426 * MiB, WS_Y = 430 * MiB, WS_G = 466 * MiB, WS_BON = 502 * MiB;
constexpr size_t WS_SHB = 818 * MiB;
constexpr size_t WS_SI = 503 * MiB, SB_STRIDE = 18 * MiB;
constexpr size_t WS_SW = WS_SI + 5 * SB_STRIDE;
constexpr size_t WS_UP = 503 * MiB;
constexpr size_t WS_GLU = 719 * MiB, WS_PR = 737 * MiB;
constexpr size_t WS_ACT = 719 * MiB;
constexpr size_t WS_HIMG = 820 * MiB;
constexpr size_t WS_SLAB = 822 * MiB, SLAB_F = (size_t)MS * D;
constexpr size_t WS_END = 886 * MiB;
constexpr size_t O_YP = 0, O_YS = 16777216, O_CP = 18874368, O_CS = 18997248, O_SP = 22929408, O_SS = 22943488, O_WP = 23394048, O_WS = 23656192,
                 O_FP = 32044800, O_FS = 32134912, O_MK = 35018496, O_MV = 37115648, O_END = 39212800;

enum { I_XP = 0, I_XS, I_CK, I_CV, I_SCONV, I_SSHIFT, I_SWKV, I_SFFN, I_MEM, I_NMIXPRE, I_WIN, I_CDW, I_CDWB, I_CLNG, I_CLNB, I_MU, I_W0, I_WLORA, I_A0, I_ALORA,
       I_GLORA, I_KK, I_KA, I_RK, I_LNXG, I_LNXB, I_WOUT, I_NMIXPOST, I_NXAPRE, I_NMEM, I_WQ, I_WK, I_WV, I_WO, I_NXAPOST, I_NFFNPRE, I_WUP, I_FDW, I_FDWB, I_WDOWN,
       I_NFFNPOST, N_IN };

struct Params { const float* in[N_IN]; float* out; unsigned char* ws; int ph_lo, ph_hi; };

__device__ __forceinline__ unsigned f2bf(float f) { unsigned u = __builtin_bit_cast(unsigned, f); return (u + 0x7fffu + ((u >> 16) & 1u)) >> 16; }
typedef __bf16 bf16x2_t __attribute__((ext_vector_type(2)));
__device__ __forceinline__ unsigned pk2(float lo, float hi) { const f32x2 v = {lo, hi}; const bf16x2_t b = __builtin_convertvector(v, bf16x2_t); return __builtin_bit_cast(unsigned, b); }
__device__ __forceinline__ float bflo(unsigned u) { return __builtin_bit_cast(float, u << 16); }
__device__ __forceinline__ float bfhi(unsigned u) { return __builtin_bit_cast(float, u & 0xffff0000u); }
__device__ __forceinline__ float wave_sum(float v) {
#pragma unroll
    for (int o = 1; o < 64; o <<= 1) v += __shfl_xor(v, o);
    return v;
}
__device__ __forceinline__ float wave_max(float v) {
#pragma unroll
    for (int o = 1; o < 64; o <<= 1) v = fmaxf(v, __shfl_xor(v, o));
    return v;
}
__device__ __forceinline__ float sigm(float x) { return 1.0f / (1.0f + __expf(-x)); }
#define LDS_WAIT() asm volatile("s_waitcnt lgkmcnt(0)" ::: "memory")

typedef __attribute__((address_space(1))) unsigned gu32;
#define XB_TMO      128
#define XB_XCNT(j)  (256  + 64 * (j))
#define XB_XSUB(j)  (1280 + 64 * (j))
#define XB_XGEN(j)  (2304 + 64 * (j))
#define XB_TOP      3328
#define XB_TOPGEN   3392
#define XCD_BAR_WORDS 3456
#define XB_SPIN_CAP (1u << 18)

__device__ __forceinline__ unsigned xb_ld(unsigned* p)              { return __hip_atomic_load(p, __ATOMIC_RELAXED, __HIP_MEMORY_SCOPE_AGENT); }
__device__ __forceinline__ unsigned xb_add(unsigned* p, unsigned v) { return __hip_atomic_fetch_add(p, v, __ATOMIC_RELAXED, __HIP_MEMORY_SCOPE_AGENT); }
__device__ __forceinline__ unsigned xb_xcc_id() { return (unsigned)__builtin_amdgcn_s_getreg((3 << 11) | 20) & 0xFu; }
#define XB_SPIN(cond, bar) do { unsigned _sp = 0; while (cond) { __builtin_amdgcn_s_sleep(1); \
    if ((++_sp & 255u) == 0u) { if (xb_ld(&(bar)[XB_TMO])) break; if (_sp > XB_SPIN_CAP) { atomicAdd(&(bar)[XB_TMO], 1u); break; } } } } while (0)

struct XcdBarrier {
    unsigned* bar; unsigned x;
    volatile LAS unsigned* st;
};

__device__ __forceinline__ XcdBarrier xcd_barrier_post(unsigned* bar, volatile LAS unsigned* st) {
    XcdBarrier b; b.bar = bar; b.x = xb_xcc_id(); b.st = st;
    if (threadIdx.x == 0) (void)xb_add(&bar[XB_XCNT(b.x)], 1u);
    return b;
}
__device__ __forceinline__ void xcd_barrier_complete(unsigned* bar, unsigned x, unsigned& nloc, unsigned& nx) {
    const unsigned G = gridDim.x * gridDim.y * gridDim.z;
    unsigned sum, cnt, mine, sp = 0u;
    for (;;) {
        sum = 0u; cnt = 0u; mine = 0u;
#pragma unroll
        for (unsigned j = 0; j < 16; ++j) { const unsigned c = xb_ld(&bar[XB_XCNT(j)]); sum += c; cnt += (c > 0u) ? 1u : 0u; mine = (j == x) ? c : mine; }
        if (sum == G) break;
        __builtin_amdgcn_s_sleep(1);
        if ((++sp & 255u) == 0u) { if (xb_ld(&bar[XB_TMO])) break; if (sp > XB_SPIN_CAP) { atomicAdd(&bar[XB_TMO], 1u); break; } }
    }
    nloc = mine > 0u ? mine : 1u; nx = cnt > 0u ? cnt : 1u;
}

__device__ __forceinline__ void xcd_barrier(const XcdBarrier& b) {
    asm volatile("s_waitcnt vmcnt(0)" ::: "memory");
    __syncthreads();
    if (threadIdx.x == 0) {
        unsigned* bar = b.bar;
        __builtin_amdgcn_s_waitcnt(0);
        unsigned nloc = b.st[0], nx = b.st[1];
        if (nloc == 0u) { xcd_barrier_complete(bar, b.x, nloc, nx); b.st[0] = nloc; b.st[1] = nx; }
        const unsigned old = xb_add(&bar[XB_XSUB(b.x)], 1u);
        const unsigned gen = old / nloc;
        if (old + 1u == (gen + 1u) * nloc) {
            __builtin_amdgcn_fence(__ATOMIC_RELEASE, "agent");
            asm volatile("s_waitcnt vmcnt(0)" ::: "memory");
            const unsigned og = xb_add(&bar[XB_TOP], 1u);
            const unsigned tg = og / nx;
            if (og + 1u == (tg + 1u) * nx) xb_add(&bar[XB_TOPGEN], 1u);
            else XB_SPIN(xb_ld(&bar[XB_TOPGEN]) == tg, bar);
            __builtin_amdgcn_fence(__ATOMIC_ACQUIRE, "agent");
            xb_add(&bar[XB_XGEN(b.x)], 1u);
            asm volatile("s_waitcnt vmcnt(0)" ::: "memory");
        } else {
            XB_SPIN(xb_ld(&bar[XB_XGEN(b.x)]) == gen, bar);
            __builtin_amdgcn_fence(__ATOMIC_ACQUIRE, "agent");
            asm volatile("s_waitcnt vmcnt(0)" ::: "memory");
        }
    }
    __syncthreads();
}

constexpr int MISC_OFF = LDS_BYTES - 64;
struct Ctx { int tid, lane, wave, bid, G, gw, NGW; };
__device__ __forceinline__ unsigned char* wsbase(const Params& P) { const unsigned long long x = (unsigned long long)P.ws; int lo = __builtin_amdgcn_readfirstlane((int)(unsigned)x), hi = __builtin_amdgcn_readfirstlane((int)(unsigned)(x >> 32));
    asm volatile("" : "+s"(lo), "+s"(hi)); return (unsigned char*)(((unsigned long long)(unsigned)hi << 32) | (unsigned)lo); }
__device__ __forceinline__ const float* inp(const Params& P, int i) { int z; asm volatile("s_mov_b32 %0, 0" : "=s"(z)); return P.in[i + z]; }

#ifndef MK_SUBMASK
#define MK_SUBMASK 0
#endif
#define SUBREP(i) for (int sr_ = 0; sr_ < ((((MK_SUBMASK) >> (i)) & 1) ? 2 : 1); ++sr_)
template <class ColMap>
__device__ __forceinline__ void transpose_load(const float* __restrict__ W, int N, int kb, int jb, int lane, ColMap cm, f32x4 (&v)[16]) {
    const int kr = lane >> 4, l16 = lane & 15, k0 = 64 * kb + 16 * kr, j = 64 * jb + 4 * l16;
    const int sc = cm(j);
    if (sc >= 0) {
        const float* src = W + (size_t)k0 * N + sc;
#pragma unroll
        for (int q = 0; q < 16; ++q) v[q] = __builtin_nontemporal_load((const f32x4*)(src + (size_t)q * N));
    } else {
#pragma unroll
        for (int q = 0; q < 16; ++q) v[q] = (f32x4){0.f, 0.f, 0.f, 0.f};
    }
}
__device__ __forceinline__ void transpose_store(int K, bf16* __restrict__ WT, int kb, int jb, int lane, const f32x4 (&v)[16]) {
    const int kr = lane >> 4, l16 = lane & 15, k0 = 64 * kb + 16 * kr, j = 64 * jb + 4 * l16;
#pragma unroll
    for (int e = 0; e < 4; ++e) {
        bf16* dst = WT + (size_t)(j + e) * K + k0;
        v4u o0, o1;
        o0.x = pk2(v[0][e], v[1][e]); o0.y = pk2(v[2][e], v[3][e]); o0.z = pk2(v[4][e], v[5][e]); o0.w = pk2(v[6][e], v[7][e]);
        o1.x = pk2(v[8][e], v[9][e]); o1.y = pk2(v[10][e], v[11][e]); o1.z = pk2(v[12][e], v[13][e]); o1.w = pk2(v[14][e], v[15][e]);
        *(v4u*)dst = o0; *(v4u*)(dst + 8) = o1;
    }
}
template <class ColMap>
__device__ __forceinline__ void transpose_item(const float* __restrict__ W, int K, int N, bf16* __restrict__ WT, int kb, int jb, int lane, ColMap cm) {
    f32x4 v[16]; transpose_load(W, N, kb, jb, lane, cm, v); transpose_store(K, WT, kb, jb, lane, v);
}
struct MapId { __device__ __forceinline__ int operator()(int j) const { return j; } };
struct MapIn {
    __device__ __forceinline__ int operator()(int j) const {
        if (j < 2048) { const int g = j >> 5, q = (j >> 3) & 3, n = (j >> 2) & 1, e = j & 3; return n * 1024 + 16 * g + 4 * q + e; }
        const int jj = j - 2048; return jj < NRC ? 2048 + jj : -1;
    }
};
__device__ __forceinline__ void rms_row_bf16(const float* __restrict__ xrow, const float* __restrict__ g, bf16* __restrict__ orow, int lane) {
    f32x4 v[8]; float s = 0.f;
#pragma unroll
    for (int j = 0; j < 8; ++j) { v[j] = *(const f32x4*)(xrow + 4 * (lane + 64 * j)); s += (v[j][0] * v[j][0] + v[j][1] * v[j][1]) + (v[j][2] * v[j][2] + v[j][3] * v[j][3]); }
    const float r = rsqrtf(wave_sum(s) * (1.0f / 2048.0f) + 1e-6f);
#pragma unroll
    for (int j = 0; j < 8; ++j) { const f32x4 gg = *(const f32x4*)(g + 4 * (lane + 64 * j));
        v2u o; o.x = pk2(v[j][0] * r * gg[0], v[j][1] * r * gg[1]); o.y = pk2(v[j][2] * r * gg[2], v[j][3] * r * gg[3]);
        *(v2u*)(orow + 4 * (lane + 64 * j)) = o; }
}
constexpr int I_SQ_ = 32 * 32, I_UP_ = 32 * 176, I_DN_ = 88 * 32, NDEF = 3 * I_SQ_ + I_UP_ + I_DN_;
struct DefItem { const float* W; bf16* WT; int K, N, kb, jb; };
__device__ __forceinline__ DefItem def_item(const Params& P, unsigned char* ws, int r) {
    DefItem d;
    if (r < I_SQ_) { d.W = inp(P, I_WOUT); d.WT = (bf16*)(ws + WS_WOUT); d.K = 2048; d.N = 2048; d.kb = r / 32; d.jb = r % 32; return d; } r -= I_SQ_;
    if (r < I_SQ_) { d.W = inp(P, I_WQ); d.WT = (bf16*)(ws + WS_WQ); d.K = 2048; d.N = 2048; d.kb = r / 32; d.jb = r % 32; return d; } r -= I_SQ_;
    if (r < I_SQ_) { d.W = inp(P, I_WO); d.WT = (bf16*)(ws + WS_WO); d.K = 2048; d.N = 2048; d.kb = r / 32; d.jb = r % 32; return d; } r -= I_SQ_;
    if (r < I_UP_) { d.W = inp(P, I_WUP); d.WT = (bf16*)(ws + WS_WUP); d.K = 2048; d.N = 11264; d.kb = r / 176; d.jb = r % 176; return d; } r -= I_UP_;
    d.W = inp(P, I_WDOWN); d.WT = (bf16*)(ws + WS_WDN); d.K = 5632; d.N = 2048; d.kb = r / 32; d.jb = r % 32; return d;
}
__device__ __forceinline__ void p0_prologue(const Params& P, const Ctx& C, LAS unsigned char* lds) {
    unsigned char* ws = wsbase(P);
    constexpr int I_IN = 32 * 88, I_SQ = 32 * 32;
    constexpr int NITEMS = I_IN + 2 * I_SQ;
    SUBREP(6) for (int it = C.gw; it < NITEMS; it += C.NGW) {
        int r = it;
        if (r < I_IN) { transpose_item(inp(P, I_WIN), 2048, 5568, (bf16*)(ws + WS_WIN), r / 88, r % 88, C.lane, MapIn()); continue; } r -= I_IN;
        if (r < I_SQ) { transpose_item(inp(P, I_WK), 2048, 2048, (bf16*)(ws + WS_WKV), r / 32, r % 32, C.lane, MapId()); continue; } r -= I_SQ;
        transpose_item(inp(P, I_WV), 2048, 2048, (bf16*)(ws + WS_WKV) + (size_t)2048 * 2048, r / 32, r % 32, C.lane, MapId());
    }
    const int gt = C.bid * NT + C.tid, ngt = C.G * NT;
    {   const float* s_w = inp(P, I_WLORA); const float* s_a = inp(P, I_ALORA); const float* s_g = inp(P, I_GLORA);
        for (int i = gt; i < 1024 * 96; i += ngt) { const int n = i / 96, k = i - n * 96, h = n >> 6, r = n & 63;
            bf16* img = (bf16*)(ws + WS_HIMG + (size_t)h * 65536);
            img[r * 96 + k] = (bf16)f2bf(s_w[k * 1024 + n]); img[6144 + r * 96 + k] = (bf16)f2bf(s_a[k * 1024 + n]); }
        for (int i = gt; i < 1024 * 256; i += ngt) { const int n = i >> 8, k = i & 255, h = n >> 6, r = n & 63;
            bf16* img = (bf16*)(ws + WS_HIMG + (size_t)h * 65536);
            img[12288 + r * 256 + (((k >> 3) ^ (r & 15)) << 3) + (k & 7)] = (bf16)f2bf(s_g[k * 1024 + n]); }
        const float* mu = inp(P, I_MU); const float* kk = inp(P, I_KK); const float* a0 = inp(P, I_A0); const float* w0 = inp(P, I_W0); const float* ka = inp(P, I_KA); const float* rk = inp(P, I_RK);
        for (int i = gt; i < 16 * 512; i += ngt) { const int h = i >> 9, ar = (i >> 6) & 7, j = i & 63;
            const float* bp = ar == 0 ? mu : ar == 1 ? mu + 1024 : ar == 2 ? mu + 2048 : ar == 3 ? kk : ar == 4 ? a0 : ar == 5 ? w0 : ar == 6 ? ka : rk;
            ((float*)(ws + WS_HIMG + (size_t)h * 65536 + 57344))[ar * 64 + j] = bp[h * 64 + j]; }
    }
    SUBREP(7) for (int m = C.gw; m < M + 1024; m += C.NGW) {
        if (m < M) { const float* xr = m < MP ? inp(P, I_XP) + (size_t)m * D : inp(P, I_XS) + (size_t)(m - MP) * D; rms_row_bf16(xr, inp(P, I_NMIXPRE), (bf16*)(ws + WS_HB) + (size_t)m * D, C.lane); }
        else { const int r = m - M; rms_row_bf16(inp(P, I_MEM) + (size_t)r * D, inp(P, I_NMEM), (bf16*)(ws + WS_MB) + (size_t)r * D, C.lane); }
    }
    { bf16* d = (bf16*)(ws + WS_SHB); const float* sp = inp(P, I_SSHIFT);
      for (int i = gt; i < (NBS + 1) * NRCP; i += ngt) { const int b = i / NRCP, c = i - b * NRCP; d[i] = (b < NBS && c < NRC) ? (bf16)f2bf(sp[(size_t)b * NRC + c]) : (bf16)0; } }
    { const f32x4* s = (const f32x4*)inp(P, I_SCONV); f32x4* d = (f32x4*)(P.out + O_CS);
      for (int i = gt; i < NBS * 22 * 256; i += ngt) { const int b = i / (22 * 256), r = i - b * (22 * 256); d[(size_t)b * 30 * 256 + r] = s[(size_t)b * 30 * 256 + 8 * 256 + r]; } }
}

template <int R>
__device__ __forceinline__ void conv_task(const Params& P, const Ctx& C, LAS unsigned char* lds, int grow0  , int t0  , int sb  ) {
    unsigned char* ws = wsbase(P);
    const bf16* glu = (const bf16*)(ws + WS_GLU);
    LAS unsigned* st = (LAS unsigned*)lds;
    LAS float* red = (LAS float*)(lds + 98304);
    constexpr int NR = R + 30;
    const float* sconv = inp(P, I_SCONV); const float* cdw = inp(P, I_CDW);
    for (int p = C.tid; p < NR * 128; p += NT) {
        const int rr = p >> 7, ch = p & 127; const int t = t0 - 30 + rr;
        v4u v = (v4u){0u, 0u, 0u, 0u};
        if (t >= 0) v = *(const v4u*)(glu + (size_t)(grow0 - 30 + rr) * CC + ch * 8);
        else if (sb >= 0) { const float* s = sconv + ((size_t)sb * 30 + rr) * CC + ch * 8;
            const f32x4 a = *(const f32x4*)s, b = *(const f32x4*)(s + 4); v.x = pk2(a[0], a[1]); v.y = pk2(a[2], a[3]); v.z = pk2(b[0], b[1]); v.w = pk2(b[2], b[3]); }
        *(LAS v4u*)(st + rr * 512 + ch * 4) = v;
    }
    const int c = 2 * C.tid;
    f32x2 w[31];
#pragma unroll
    for (int j = 0; j < 31; ++j) w[j] = *(const f32x2*)(cdw + j * CC + c);
    const f32x2 bias = *(const f32x2*)(inp(P, I_CDWB) + c);
    f32x2 acc[R];
#pragma unroll
    for (int r = 0; r < R; ++r) acc[r] = bias;
    __syncthreads();
#pragma unroll
    for (int rr = 0; rr < NR; ++rr) {
        if ((rr & 3) == 0) asm volatile("" ::: "memory");
        const unsigned u = st[rr * 512 + C.tid]; const float x0 = bflo(u), x1 = bfhi(u);
#pragma unroll
        for (int r = 0; r < R; ++r) { const int j = rr - r; if (j >= 0 && j < 31) { acc[r][0] += x0 * w[j][0]; acc[r][1] += x1 * w[j][1]; } }
    }
    float s[R];
#pragma unroll
    for (int r = 0; r < R; ++r) s[r] = wave_sum(acc[r][0] + acc[r][1]);
    if (C.lane == 0) {
#pragma unroll
        for (int r = 0; r < R; ++r) red[C.wave * 16 + r] = s[r]; }
    __syncthreads();
    float mean[R];
#pragma unroll
    for (int r = 0; r < R; ++r) { float t = 0.f;
#pragma unroll
        for (int wv = 0; wv < 8; ++wv) t += red[wv * 16 + r];
        mean[r] = t * (1.0f / 1024.0f); }
    __syncthreads();
#pragma unroll
    for (int r = 0; r < R; ++r) { const float d0 = acc[r][0] - mean[r], d1 = acc[r][1] - mean[r]; acc[r][0] = d0; acc[r][1] = d1; s[r] = wave_sum(d0 * d0 + d1 * d1); }
    if (C.lane == 0) {
#pragma unroll
        for (int r = 0; r < R; ++r) red[C.wave * 16 + r] = s[r]; }
    __syncthreads();
    const f32x2 lg = *(const f32x2*)(inp(P, I_CLNG) + c), lb = *(const f32x2*)(inp(P, I_CLNB) + c);
    bf16* a2 = (bf16*)(ws + WS_A2);
#pragma unroll
    for (int r = 0; r < R; ++r) { float t = 0.f;
#pragma unroll
        for (int wv = 0; wv < 8; ++wv) t += red[wv * 16 + r];
        const float rstd = rsqrtf(t * (1.0f / 1024.0f) + 1e-5f);
        float y0 = acc[r][0] * rstd * lg[0] + lb[0], y1 = acc[r][1] * rstd * lg[1] + lb[1];
        y0 = y0 * sigm(y0); y1 = y1 * sigm(y1);
        *(unsigned*)(a2 + (size_t)(grow0 + r) * D + c) = pk2(y0, y1); }
    __syncthreads();
}

#define XS8(cp_, pp_, mp_, off_, xs_) do { const v4u cu_ = *(const v4u*)((cp_) + (off_)); const v4u pu_ = *(const v4u*)((pp_) + (off_)); \
        const f32x4 m0_ = *(const f32x4*)((mp_) + (off_)), m1_ = *(const f32x4*)((mp_) + (off_) + 4); float c_, p_; \
        c_ = bflo(cu_.x); p_ = bflo(pu_.x); xs_[0] = c_ + (p_ - c_) * m0_[0]; c_ = bfhi(cu_.x); p_ = bfhi(pu_.x); xs_[1] = c_ + (p_ - c_) * m0_[1]; \
        c_ = bflo(cu_.y); p_ = bflo(pu_.y); xs_[2] = c_ + (p_ - c_) * m0_[2]; c_ = bfhi(cu_.y); p_ = bfhi(pu_.y); xs_[3] = c_ + (p_ - c_) * m0_[3]; \
        c_ = bflo(cu_.z); p_ = bflo(pu_.z); xs_[4] = c_ + (p_ - c_) * m1_[0]; c_ = bfhi(cu_.z); p_ = bfhi(pu_.z); xs_[5] = c_ + (p_ - c_) * m1_[1]; \
        c_ = bflo(cu_.w); p_ = bflo(pu_.w); xs_[6] = c_ + (p_ - c_) * m1_[2]; c_ = bfhi(cu_.w); p_ = bfhi(pu_.w); xs_[7] = c_ + (p_ - c_) * m1_[3]; } while (0)
#define XS4(cp_, pp_, mp_, off_, xs_) do { const v2u cu_ = *(const v2u*)((cp_) + (off_)); const v2u pu_ = *(const v2u*)((pp_) + (off_)); const f32x4 m0_ = *(const f32x4*)((mp_) + (off_)); float c_, p_; \
        c_ = bflo(cu_.x); p_ = bflo(pu_.x); xs_[0] = c_ + (p_ - c_) * m0_[0]; c_ = bfhi(cu_.x); p_ = bfhi(pu_.x); xs_[1] = c_ + (p_ - c_) * m0_[1]; \
        c_ = bflo(cu_.y); p_ = bflo(pu_.y); xs_[2] = c_ + (p_ - c_) * m0_[2]; c_ = bfhi(cu_.y); p_ = bfhi(pu_.y); xs_[3] = c_ + (p_ - c_) * m0_[3]; } while (0)
__device__ __forceinline__ bf16x8 pack8(const float (&x)[8]) {
    v4u o; o.x = pk2(x[0], x[1]); o.y = pk2(x[2], x[3]); o.z = pk2(x[4], x[5]); o.w = pk2(x[6], x[7]);
    return __builtin_bit_cast(bf16x8, o);
}
__device__ __forceinline__ float tanh_fast(float x) { return 1.0f - 2.0f / (1.0f + __expf(2.0f * x)); }
constexpr int PBUF = 65536;
__device__ __forceinline__ void mix4(const v2u cu, const v2u pu, const f32x4 m, float (&xs)[4]) {
    float c_, p_;
    c_ = bflo(cu.x); p_ = bflo(pu.x); xs[0] = c_ + (p_ - c_) * m[0]; c_ = bfhi(cu.x); p_ = bfhi(pu.x); xs[1] = c_ + (p_ - c_) * m[1];
    c_ = bflo(cu.y); p_ = bflo(pu.y); xs[2] = c_ + (p_ - c_) * m[2]; c_ = bfhi(cu.y); p_ = bfhi(pu.y); xs[3] = c_ + (p_ - c_) * m[3];
}
template <int NH>
__device__ __forceinline__ void prep_task(const Params& P, const Ctx& C, LAS unsigned char* lds, int rowblock, int hbase) {
    const int lane = C.lane, fr = lane & 15, fq = lane >> 4, row = rowblock * 128 + C.wave * 16 + fr;
    unsigned char* ws = wsbase(P);
    const bf16* curp = (const bf16*)(ws + WS_PR) + (size_t)row * NRCP;
    const bf16* prvp = curp - NRCP;
    if (row < MP) { if ((row & (SEQ - 1)) == 0) prvp = (const bf16*)(ws + WS_SHB) + (size_t)NBS * NRCP; }
    else { const int rs = row - MP; if ((rs & 7) == 0) prvp = (const bf16*)(ws + WS_SHB) + (size_t)(rs >> 3) * NRCP; }
    const float* mup = inp(P, I_MU);
    const unsigned char* himg = ws + WS_HIMG;
    const bf16* c8 = curp + 3072 + 8 * fq; const bf16* p8 = prvp + 3072 + 8 * fq; const float* m8 = mup + 3072 + 8 * fq;
    const f32x4 z4 = (f32x4){0.f, 0.f, 0.f, 0.f};
    const int c00 = hbase * 64 + 4 * fq;
#define PREP_STAGE(h_, b_, i0_, n_) do { int ll = lane; asm volatile("" : "+v"(ll)); _Pragma("unroll") for (int q = 0; q < (n_); ++q) { const int i = (i0_) + C.wave + 8 * q; \
        __builtin_amdgcn_global_load_lds((const unsigned*)(himg + (size_t)(h_) * PBUF + i * 1024 + ll * 16), (LAS unsigned*)(lds + (b_) * PBUF + i * 1024), 16, 0, 0); } } while (0)
#define PREP_SYNC() do { asm volatile("s_waitcnt vmcnt(0)" ::: "memory"); __syncthreads(); } while (0)
    {
        PREP_STAGE(hbase, 0, 24, 4);
        bf16x8 Ag[8];
#pragma unroll
        for (int s = 0; s < 8; ++s) { if (s == 4) asm volatile("" ::: "memory");
            float xs[8]; XS8(c8, p8, m8, 192 + 32 * s, xs);
#pragma unroll
            for (int e = 0; e < 8; ++e) xs[e] = sigm(xs[e]);
            Ag[s] = pack8(xs); }
        PREP_SYNC();
        bf16* gb = (bf16*)(ws + WS_G) + (size_t)row * RW + c00;
        const int lgo = 24576 + fr * 512;
#pragma unroll 1
        for (int hh = 0; hh < NH; ++hh) {
            if (hh + 1 < NH) PREP_STAGE(hbase + hh + 1, (hh + 1) & 1, 24, 4);
            const LAS unsigned char* wb = lds + (hh & 1) * PBUF;
#pragma unroll
            for (int nt = 0; nt < 4; ++nt) {
                f32x4 accG = z4;
#pragma unroll
                for (int s = 0; s < 8; ++s) { const bf16x8 bg = *(const LAS bf16x8*)(wb + lgo + nt * 8192 + (((4 * s + fq) ^ fr) * 16)); accG = __builtin_amdgcn_mfma_f32_16x16x32_bf16(bg, Ag[s], accG, 0, 0, 0); }
                *(v2u*)(gb + 16 * nt) = (v2u){pk2(accG[0], accG[1]), pk2(accG[2], accG[3])};
            }
            gb += 64;
            PREP_SYNC();
        }
    }
    PREP_STAGE(hbase, 0, 0, 3); if (C.wave < 2) PREP_STAGE(hbase, 0, 56, 1);
    const bf16* c4 = curp + c00; const bf16* p4 = prvp + c00;
    v2u cu[3][4], pu[3][4];
#pragma unroll
    for (int x = 0; x < 3; ++x)
#pragma unroll
        for (int nt = 0; nt < 4; ++nt) { cu[x][nt] = *(const v2u*)(c4 + 1024 * x + 16 * nt); pu[x][nt] = *(const v2u*)(p4 + 1024 * x + 16 * nt); }
    bf16x8 Aw[3], Aa[3];
#pragma unroll
    for (int s = 0; s < 3; ++s) { float xs[8]; XS8(c8, p8, m8, 32 * s, xs);
#pragma unroll
        for (int e = 0; e < 8; ++e) xs[e] = tanh_fast(xs[e]);
        Aw[s] = pack8(xs); }
#pragma unroll
    for (int s = 0; s < 3; ++s) { float xs[8]; XS8(c8, p8, m8, 96 + 32 * s, xs); Aa[s] = pack8(xs); }
    PREP_SYNC();
    constexpr size_t SS = SB_STRIDE / 2;
    bf16* sb = (bf16*)(ws + WS_SI) + (size_t)row * RW + c00; float* sw = (float*)(ws + WS_SW) + (size_t)row * RW + c00;
    float* bonp = (float*)(ws + WS_BON) + (size_t)row * RH + hbase;
    const int lwo = fr * 192 + fq * 16, lpo = 57344 + fq * 16;
#pragma unroll 1
    for (int hh = 0; hh < NH; ++hh) {
        if (hh + 1 < NH) { PREP_STAGE(hbase + hh + 1, (hh + 1) & 1, 0, 3); if (C.wave < 2) PREP_STAGE(hbase + hh + 1, (hh + 1) & 1, 56, 1); }
        const LAS unsigned char* wb = lds + (hh & 1) * PBUF;
        float ss = 0.f;
#pragma unroll
        for (int nt = 0; nt < 4; ++nt) {
            float xk0[4]; mix4(cu[1][nt], pu[1][nt], *(const LAS f32x4*)(wb + lpo + 1 * 256 + nt * 64), xk0);
            const f32x4 kkw = *(const LAS f32x4*)(wb + lpo + 3 * 256 + nt * 64);
#pragma unroll
            for (int e = 0; e < 4; ++e) { const float t = xk0[e] * kkw[e]; ss += t * t; }
        }
        ss += __shfl_xor(ss, 16); ss += __shfl_xor(ss, 32);
        const float inv = 1.0f / fmaxf(sqrtf(ss), 1e-12f);
        float bon = 0.f;
#pragma unroll
        for (int nt = 0; nt < 4; ++nt) {
            f32x4 accW = z4, accA = z4;
#pragma unroll
            for (int s = 0; s < 3; ++s) { const bf16x8 bw = *(const LAS bf16x8*)(wb + lwo + nt * 3072 + s * 64), ba = *(const LAS bf16x8*)(wb + 12288 + lwo + nt * 3072 + s * 64);
                accW = __builtin_amdgcn_mfma_f32_16x16x32_bf16(bw, Aw[s], accW, 0, 0, 0); accA = __builtin_amdgcn_mfma_f32_16x16x32_bf16(ba, Aa[s], accA, 0, 0, 0); }
            float xr[4], xv[4], xkk[4];
            mix4(cu[0][nt], pu[0][nt], *(const LAS f32x4*)(wb + lpo + 0 * 256 + nt * 64), xr);
            mix4(cu[1][nt], pu[1][nt], *(const LAS f32x4*)(wb + lpo + 1 * 256 + nt * 64), xkk);
            mix4(cu[2][nt], pu[2][nt], *(const LAS f32x4*)(wb + lpo + 2 * 256 + nt * 64), xv);
            const f32x4 kkw = *(const LAS f32x4*)(wb + lpo + 3 * 256 + nt * 64), a0 = *(const LAS f32x4*)(wb + lpo + 4 * 256 + nt * 64), w0 = *(const LAS f32x4*)(wb + lpo + 5 * 256 + nt * 64);
            const f32x4 ka = *(const LAS f32x4*)(wb + lpo + 6 * 256 + nt * 64), rk = *(const LAS f32x4*)(wb + lpo + 7 * 256 + nt * 64);
            f32x4 vw; float vk[4], va[4], vb[4];
#pragma unroll
            for (int e = 0; e < 4; ++e) {
                const float ee = 0.6065306597126334f * sigm(w0[e] + accW[e]);
                vw[e] = __expf(-ee);
                const float a = sigm(a0[e] + accA[e]);
                const float kn = xkk[e] * kkw[e] * inv;
                const float k2 = xkk[e] * (1.0f + (a - 1.0f) * ka[e]);
                vk[e] = k2; va[e] = -kn; vb[e] = kn * a;
                bon += xr[e] * k2 * rk[e];
            }
            bf16* so = sb + 16 * nt;
            *(v2u*)(so + 0 * SS) = (v2u){pk2(xr[0], xr[1]), pk2(xr[2], xr[3])};
            *(v2u*)(so + 1 * SS) = (v2u){pk2(vk[0], vk[1]), pk2(vk[2], vk[3])};
            *(v2u*)(so + 2 * SS) = (v2u){pk2(xv[0], xv[1]), pk2(xv[2], xv[3])};
            *(v2u*)(so + 3 * SS) = (v2u){pk2(va[0], va[1]), pk2(va[2], va[3])};
            *(v2u*)(so + 4 * SS) = (v2u){pk2(vb[0], vb[1]), pk2(vb[2], vb[3])};
            *(f32x4*)(sw + 16 * nt) = vw;
        }
        bon += __shfl_xor(bon, 16); bon += __shfl_xor(bon, 32);
        if (fq == 0) bonp[hh] = bon;
        sb += 64; sw += 64;
        if (hh + 1 < NH) { c4 += 64; p4 += 64;
#pragma unroll
            for (int x = 0; x < 3; ++x)
#pragma unroll
                for (int nt = 0; nt < 4; ++nt) { cu[x][nt] = *(const v2u*)(c4 + 1024 * x + 16 * nt); pu[x][nt] = *(const v2u*)(p4 + 1024 * x + 16 * nt); } }
        PREP_SYNC();
    }
#undef PREP_STAGE
#undef PREP_SYNC
}

constexpr int TC = 32, STEPF = 340;
template <int CTRL> __device__ __forceinline__ float dppf(float x) { return __builtin_bit_cast(float, __builtin_amdgcn_update_dpp(0, __builtin_bit_cast(int, x), CTRL, 0xF, 0xF, true)); }
__device__ __forceinline__ float allred16(float x) {
    x += dppf<0xB1>(x);
    x += dppf<0x4E>(x);
    x += dppf<0x141>(x);
    x += dppf<0x140>(x);
    return x;
}
#define SCAN_BAR() do { asm volatile("s_waitcnt lgkmcnt(0)" ::: "memory"); __builtin_amdgcn_s_barrier(); asm volatile("" ::: "memory"); } while (0)
#define SCAN_STEP(S01, S23, r4, w4, k4, a4, b4, v, yout) do { \
        f32x2 p2 = S01 * (f32x2){a4[0], a4[1]}; p2 = S23 * (f32x2){a4[2], a4[3]} + p2; \
        const float sa = allred16(p2[0] + p2[1]); const f32x2 sa2 = (f32x2){sa, sa}, v2 = (f32x2){v, v}; \
        f32x2 t01 = v2 * (f32x2){k4[0], k4[1]}, t23 = v2 * (f32x2){k4[2], k4[3]}; \
        t01 = sa2 * (f32x2){b4[0], b4[1]} + t01; t23 = sa2 * (f32x2){b4[2], b4[3]} + t23; \
        S01 = S01 * (f32x2){w4[0], w4[1]} + t01; S23 = S23 * (f32x2){w4[2], w4[3]} + t23; \
        f32x2 q2 = S01 * (f32x2){r4[0], r4[1]}; q2 = S23 * (f32x2){r4[2], r4[3]} + q2; \
        yout = allred16(q2[0] + q2[1]); } while (0)
__device__ __forceinline__ void ld_bf8(const bf16* p, float (&x)[8]) { const v4u u = *(const v4u*)p; x[0] = bflo(u.x); x[1] = bfhi(u.x); x[2] = bflo(u.y); x[3] = bfhi(u.y); x[4] = bflo(u.z); x[5] = bfhi(u.z); x[6] = bflo(u.w); x[7] = bfhi(u.w); }
__device__ __forceinline__ void scan_prompt(const Params& P, const Ctx& C, LAS unsigned char* lds, int chain, int rb, bool dodef) {
    unsigned char* ws = wsbase(P);
    const int b = chain >> 4, h = chain & 15, m0 = b * SEQ;
    LAS float* buf = (LAS float*)lds;
    LAS float* ypbuf = (LAS float*)(lds + 90112);
    constexpr int NCH = SEQ / TC;
    if (C.wave >= 4) {
        const int ht = C.tid - 256, t = ht >> 3, g = ht & 7;
        const bf16* SB = (const bf16*)(ws + WS_SI) + (size_t)m0 * RW + h * 64 + 8 * g; constexpr size_t SBS = SB_STRIDE / 2;
        const float* SW = (const float*)(ws + WS_SW) + (size_t)m0 * RW + h * 64 + 8 * g;
        const bf16* SV = (const bf16*)(ws + WS_SI) + 2 * SBS + (size_t)m0 * RW + h * 64 + rb * 16 + 8 * (g & 1);
        v4u lr, lk, lb, la, lv; f32x4 lw0, lw1;
#define SCAN_HLOAD(ck_) do { const int tg = (ck_) * TC + t; const size_t ro = (size_t)tg * RW; \
            lr = *(const v4u*)(SB + 0 * SBS + ro); lk = *(const v4u*)(SB + 1 * SBS + ro); lb = *(const v4u*)(SB + 4 * SBS + ro); \
            la = tg + 1 < SEQ ? *(const v4u*)(SB + 3 * SBS + ro + RW) : (v4u){0u, 0u, 0u, 0u}; \
            lw0 = *(const f32x4*)(SW + ro); lw1 = *(const f32x4*)(SW + ro + 4); lv = *(const v4u*)(SV + ro); } while (0)
#define SCAN_HWRITE(ck_) do { LAS float* d = buf + ((ck_) & 1) * (TC * STEPF) + t * STEPF; \
            const float an[8] = {bflo(la.x), bfhi(la.x), bflo(la.y), bfhi(la.y), bflo(la.z), bfhi(la.z), bflo(la.w), bfhi(la.w)}; \
            const float bb[8] = {bflo(lb.x), bfhi(lb.x), bflo(lb.y), bfhi(lb.y), bflo(lb.z), bfhi(lb.z), bflo(lb.w), bfhi(lb.w)}; \
            const float kk_[8] = {bflo(lk.x), bfhi(lk.x), bflo(lk.y), bfhi(lk.y), bflo(lk.z), bfhi(lk.z), bflo(lk.w), bfhi(lk.w)}; \
            float be = 0.f, ka_ = 0.f; _Pragma("unroll") for (int e = 0; e < 8; ++e) { be += bb[e] * an[e]; ka_ += kk_[e] * an[e]; } \
            be += __shfl_xor(be, 1); be += __shfl_xor(be, 2); be += __shfl_xor(be, 4); ka_ += __shfl_xor(ka_, 1); ka_ += __shfl_xor(ka_, 2); ka_ += __shfl_xor(ka_, 4); \
            *(LAS v4u*)(d + 0 + 8 * g) = (v4u){lr.x << 16, lr.x & 0xffff0000u, lr.y << 16, lr.y & 0xffff0000u}; *(LAS v4u*)(d + 4 + 8 * g) = (v4u){lr.z << 16, lr.z & 0xffff0000u, lr.w << 16, lr.w & 0xffff0000u}; \
            *(LAS f32x4*)(d + 64 + 8 * g) = lw0; *(LAS f32x4*)(d + 68 + 8 * g) = lw1; \
            *(LAS f32x4*)(d + 128 + 8 * g) = (f32x4){kk_[0], kk_[1], kk_[2], kk_[3]}; *(LAS f32x4*)(d + 132 + 8 * g) = (f32x4){kk_[4], kk_[5], kk_[6], kk_[7]}; \
            *(LAS f32x4*)(d + 192 + 8 * g) = (f32x4){lw0[0] * an[0], lw0[1] * an[1], lw0[2] * an[2], lw0[3] * an[3]}; *(LAS f32x4*)(d + 196 + 8 * g) = (f32x4){lw1[0] * an[4], lw1[1] * an[5], lw1[2] * an[6], lw1[3] * an[7]}; \
            *(LAS f32x4*)(d + 256 + 8 * g) = (f32x4){bb[0], bb[1], bb[2], bb[3]}; *(LAS f32x4*)(d + 260 + 8 * g) = (f32x4){bb[4], bb[5], bb[6], bb[7]}; \
            if (g < 2) { *(LAS v4u*)(d + 320 + 8 * g) = (v4u){lv.x << 16, lv.x & 0xffff0000u, lv.y << 16, lv.y & 0xffff0000u}; *(LAS v4u*)(d + 324 + 8 * g) = (v4u){lv.z << 16, lv.z & 0xffff0000u, lv.w << 16, lv.w & 0xffff0000u}; } \
            if (g == 2) *(LAS f32x2*)(d + 336) = (f32x2){be, ka_}; } while (0)
        SCAN_HLOAD(0); SCAN_HWRITE(0); SCAN_HLOAD(1);
        SCAN_BAR();
        const int sw = C.bid * 4 + (C.wave - 4), nsw = C.G * 4;
        f32x4 tv[16]; DefItem di; di.W = nullptr; di.WT = nullptr; di.K = 0; di.N = 0; di.kb = 0; di.jb = 0; bool have = false;
        float* Y = (float*)(ws + WS_Y) + (size_t)m0 * RW + h * 64 + rb * 16;
#define SCAN_YRED(ck_) do { const LAS float* yb = ypbuf + ((ck_) & 1) * (TC * 256); _Pragma("unroll") for (int j = 0; j < 2; ++j) { const int o = ht + 256 * j, ty = o >> 4, ri = o & 15; \
            const LAS f32x4* pp = (const LAS f32x4*)(yb + ty * 256 + ri * 16); const f32x4 s4 = (pp[0] + pp[1]) + (pp[2] + pp[3]); \
            Y[(size_t)((ck_) * TC + ty) * RW + ri] = (s4[0] + s4[1]) + (s4[2] + s4[3]); } } while (0)
        for (int ck = 0; ck < NCH; ++ck) {
            if (ck + 1 < NCH) SCAN_HWRITE(ck + 1);
            if (ck + 2 < NCH) SCAN_HLOAD(ck + 2);
            if (ck > 0) SCAN_YRED(ck - 1);
            if (dodef) {
                const int ph = ck % 5, it = sw + nsw * (ck / 5);
                if (ph == 0 && it < NDEF) { di = def_item(P, ws, it); transpose_load(di.W, di.N, di.kb, di.jb, C.lane, MapId(), tv); have = true; }
                if (ph == 2 && have) { transpose_store(di.K, di.WT, di.kb, di.jb, C.lane, tv); have = false; }
            }
            SCAN_BAR();
        }
        SCAN_YRED(NCH - 1);
#undef SCAN_YRED
#undef SCAN_HLOAD
#undef SCAN_HWRITE
    } else {
        const int rowl = C.lane >> 4, cl = C.lane & 15, irow = rb * 16 + C.wave * 4 + rowl;
        f32x2 S01 = (f32x2){0.f, 0.f}, S23 = (f32x2){0.f, 0.f};
        float sa = 0.f;
        SCAN_BAR();
        for (int ck = 0; ck < NCH; ++ck) {
            const LAS float* cb = buf + (ck & 1) * (TC * STEPF);
            f32x4 r4 = *(const LAS f32x4*)(cb + 0 * 64 + 4 * cl), w4 = *(const LAS f32x4*)(cb + 1 * 64 + 4 * cl), k4 = *(const LAS f32x4*)(cb + 2 * 64 + 4 * cl);
            f32x4 q4 = *(const LAS f32x4*)(cb + 3 * 64 + 4 * cl), b4 = *(const LAS f32x4*)(cb + 4 * 64 + 4 * cl); float v = cb[320 + C.wave * 4 + rowl]; f32x2 bk = *(const LAS f32x2*)(cb + 336);
            LAS float* yw = ypbuf + (ck & 1) * (TC * 256) + C.wave * 64 + C.lane;
#pragma unroll 4
            for (int t = 0; t < TC; ++t) {
                const LAS float* nb = cb + (t + 1 < TC ? t + 1 : t) * STEPF;
                const f32x4 nr = *(const LAS f32x4*)(nb + 0 * 64 + 4 * cl), nw = *(const LAS f32x4*)(nb + 1 * 64 + 4 * cl), nk = *(const LAS f32x4*)(nb + 2 * 64 + 4 * cl);
                const f32x4 nq = *(const LAS f32x4*)(nb + 3 * 64 + 4 * cl), nbb = *(const LAS f32x4*)(nb + 4 * 64 + 4 * cl); const float nv = nb[320 + C.wave * 4 + rowl]; const f32x2 nbk = *(const LAS f32x2*)(nb + 336);
                f32x2 d2 = S01 * (f32x2){q4[0], q4[1]}; d2 = S23 * (f32x2){q4[2], q4[3]} + d2;
                const float dd = allred16(d2[0] + d2[1]);
                const float san = sa * bk[0] + (v * bk[1] + dd);
                const f32x2 sa2 = (f32x2){sa, sa}, v2 = (f32x2){v, v};
                f32x2 t01 = v2 * (f32x2){k4[0], k4[1]}, t23 = v2 * (f32x2){k4[2], k4[3]};
                t01 = sa2 * (f32x2){b4[0], b4[1]} + t01; t23 = sa2 * (f32x2){b4[2], b4[3]} + t23;
                S01 = S01 * (f32x2){w4[0], w4[1]} + t01; S23 = S23 * (f32x2){w4[2], w4[3]} + t23;
                f32x2 y2 = S01 * (f32x2){r4[0], r4[1]}; y2 = S23 * (f32x2){r4[2], r4[3]} + y2;
                yw[t * 256] = y2[0] + y2[1];
                sa = san;
                r4 = nr; w4 = nw; k4 = nk; q4 = nq; b4 = nbb; v = nv; bk = nbk;
            }
            SCAN_BAR();
        }
        float* so = P.out + O_WP + ((size_t)chain * 64 + irow) * 64 + 4 * cl;
        *(f32x4*)so = (f32x4){S01[0], S01[1], S23[0], S23[1]};
    }
    __syncthreads();
}
__device__ __forceinline__ f32x4 ld_bf4(const bf16* p) { const v2u u = *(const v2u*)p; return (f32x4){bflo(u.x), bfhi(u.x), bflo(u.y), bfhi(u.y)}; }
__device__ __forceinline__ void scan_sample(const Params& P, const Ctx& C, const float* swkv, int chain, int half) {
    unsigned char* ws = wsbase(P);
    const int b = chain >> 4, h = chain & 15, m0 = MP + 8 * b;
    const bf16* ub = (const bf16*)(ws + WS_SI) + (size_t)m0 * RW + h * 64; constexpr size_t SBS = SB_STRIDE / 2;
    const float* uw = (const float*)(ws + WS_SW) + (size_t)m0 * RW + h * 64;
    float* Y = (float*)(ws + WS_Y);
    const int rowl = C.lane >> 4, cl = C.lane & 15, irow = half * 32 + C.wave * 4 + rowl, lo = 4 * cl;
    const f32x4 s4 = *(const f32x4*)(swkv + ((size_t)chain * 64 + irow) * 64 + 4 * cl);
    f32x2 S01 = (f32x2){s4[0], s4[1]}, S23 = (f32x2){s4[2], s4[3]};
    float yk = 0.f;
#pragma unroll 4
    for (int t = 0; t < 8; ++t) {
        const bf16* ut = ub + t * RW;
        const f32x4 r4 = ld_bf4(ut + 0 * SBS + lo), k4 = ld_bf4(ut + 1 * SBS + lo), a4 = ld_bf4(ut + 3 * SBS + lo), b4 = ld_bf4(ut + 4 * SBS + lo);
        const f32x4 w4 = *(const f32x4*)(uw + t * RW + lo); const float v = bflo((unsigned)(ut + 2 * SBS)[irow]);
        float y; SCAN_STEP(S01, S23, r4, w4, k4, a4, b4, v, y);
        yk = (cl == t) ? y : yk;
    }
    if (cl < 8) Y[(size_t)(m0 + cl) * RW + h * 64 + irow] = yk;
    *(f32x4*)(P.out + O_WS + ((size_t)chain * 64 + irow) * 64 + 4 * cl) = (f32x4){S01[0], S01[1], S23[0], S23[1]};
}

__device__ __forceinline__ void post_row(const Params& P, int row, int lane) {
    unsigned char* ws = wsbase(P);
    const float* Y = (const float*)(ws + WS_Y) + (size_t)row * RW + 16 * lane;
    const bf16* V = (const bf16*)(ws + WS_SI) + 2 * (SB_STRIDE / 2) + (size_t)row * RW + 16 * lane;
    const bf16* G = (const bf16*)(ws + WS_G) + (size_t)row * RW + 16 * lane;
    const float bon = ((const float*)(ws + WS_BON))[(size_t)row * RH + (lane >> 2)];
    float y[16], s = 0.f;
#pragma unroll
    for (int q = 0; q < 4; ++q) { const f32x4 t = *(const f32x4*)(Y + 4 * q); y[4 * q] = t[0]; y[4 * q + 1] = t[1]; y[4 * q + 2] = t[2]; y[4 * q + 3] = t[3]; s += (t[0] + t[1]) + (t[2] + t[3]); }
    s += __shfl_xor(s, 1); s += __shfl_xor(s, 2);
    const float mu = s * (1.0f / 64.0f); float q2 = 0.f;
#pragma unroll
    for (int e = 0; e < 16; ++e) { y[e] -= mu; q2 += y[e] * y[e]; }
    q2 += __shfl_xor(q2, 1); q2 += __shfl_xor(q2, 2);
    const float rstd = rsqrtf(q2 * (1.0f / 64.0f) + 64e-5f);
    const float* lg = inp(P, I_LNXG) + 16 * lane; const float* lb = inp(P, I_LNXB) + 16 * lane;
    unsigned o[8];
#pragma unroll
    for (int q = 0; q < 4; ++q) { const f32x4 g4 = *(const f32x4*)(lg + 4 * q), b4 = *(const f32x4*)(lb + 4 * q), v4 = ld_bf4(V + 4 * q), gg = ld_bf4(G + 4 * q);
        float r[4];
#pragma unroll
        for (int e = 0; e < 4; ++e) r[e] = (y[4 * q + e] * rstd * g4[e] + b4[e] + bon * v4[e]) * gg[e];
        o[2 * q] = pk2(r[0], r[1]); o[2 * q + 1] = pk2(r[2], r[3]); }
    bf16* dst = (bf16*)(ws + WS_A2) + (size_t)row * D + 1024 + 16 * lane;
    *(v4u*)dst = (v4u){o[0], o[1], o[2], o[3]}; *(v4u*)(dst + 8) = (v4u){o[4], o[5], o[6], o[7]};
}

__device__ __forceinline__ void rowpass(const float* xa, const bf16* __restrict__ mixb, const float* __restrict__ mix, int nslab, const float* __restrict__ g1, float* xo,
                                        const float* __restrict__ g2, bf16* __restrict__ hb, int lane) {
    f32x4 mv[8]; float s = 0.f;
#pragma unroll
    for (int j = 0; j < 8; ++j) {
        if (mixb) mv[j] = ld_bf4(mixb + 4 * (lane + 64 * j));
        else { mv[j] = *(const f32x4*)(mix + 4 * (lane + 64 * j));
            for (int sl = 1; sl < nslab; ++sl) mv[j] += *(const f32x4*)(mix + sl * SLAB_F + 4 * (lane + 64 * j)); }
        s += (mv[j][0] * mv[j][0] + mv[j][1] * mv[j][1]) + (mv[j][2] * mv[j][2] + mv[j][3] * mv[j][3]); }
    const float r = rsqrtf(wave_sum(s) * (1.0f / 2048.0f) + 1e-6f);
    float s2 = 0.f;
#pragma unroll
    for (int j = 0; j < 8; ++j) { const f32x4 a = *(const f32x4*)(xa + 4 * (lane + 64 * j)), gg = *(const f32x4*)(g1 + 4 * (lane + 64 * j));
        mv[j] = a + mv[j] * r * gg; *(f32x4*)(xo + 4 * (lane + 64 * j)) = mv[j];
        s2 += (mv[j][0] * mv[j][0] + mv[j][1] * mv[j][1]) + (mv[j][2] * mv[j][2] + mv[j][3] * mv[j][3]); }
    if (hb) {
        const float r2 = rsqrtf(wave_sum(s2) * (1.0f / 2048.0f) + 1e-6f);
#pragma unroll
        for (int j = 0; j < 8; ++j) { const f32x4 gg = *(const f32x4*)(g2 + 4 * (lane + 64 * j));
            v2u o; o.x = pk2(mv[j][0] * r2 * gg[0], mv[j][1] * r2 * gg[1]); o.y = pk2(mv[j][2] * r2 * gg[2], mv[j][3] * r2 * gg[3]);
            *(v2u*)(hb + 4 * (lane + 64 * j)) = o; }
    }
}
__device__ __forceinline__ void attn_prompt_task(const Params& P, const Ctx& C, LAS unsigned char* lds, int b, int h, int qt) {
    unsigned char* ws = wsbase(P);
    const bf16* Qg = (const bf16*)(ws + WS_Q); const bf16* Kg = (const bf16*)(ws + WS_KB); const bf16* VTg = (const bf16*)(ws + WS_VT);
    bf16* Og = (bf16*)(ws + WS_O);
    const int fr = C.lane & 15, fq = C.lane >> 4;
    const int qrow = b * SEQ + qt * 128 + C.wave * 16 + fr;
    constexpr int BUFB = 33792;
    bf16x8 Qf[16];
#pragma unroll
    for (int s = 0; s < 16; ++s) Qf[s] = *(const bf16x8*)(Qg + (size_t)qrow * D + h * XD + 32 * s + 8 * fq);
    f32x4 accS[16];
#pragma unroll
    for (int nt = 0; nt < 16; ++nt) accS[nt] = (f32x4){0.f, 0.f, 0.f, 0.f};
    v4u stg[4];
#define ATT_GLOAD(c_) do { if ((c_) < 8) { _Pragma("unroll") for (int i = 0; i < 4; ++i) { const int idx = C.tid + i * NT, key = idx >> 3, ch = idx & 7; \
            stg[i] = *(const v4u*)(Kg + (size_t)(b * NMEM + key) * D + h * XD + (c_) * 64 + ch * 8); } } \
        else { _Pragma("unroll") for (int i = 0; i < 4; ++i) { const int idx = C.tid + i * NT, dd = idx >> 5, ch = idx & 31; \
            stg[i] = *(const v4u*)(VTg + ((size_t)((b * XH + h) * XD + ((c_) - 8) * 64 + dd)) * NMEM + ch * 8); } } } while (0)
#define ATT_SWRITE(c_) do { LAS unsigned char* sbuf = lds + ((c_) & 1) * BUFB; if ((c_) < 8) { _Pragma("unroll") for (int i = 0; i < 4; ++i) { const int idx = C.tid + i * NT, key = idx >> 3, ch = idx & 7; \
            *(LAS v4u*)(sbuf + key * 128 + ((ch ^ (key & 7)) * 16)) = stg[i]; } } \
        else { _Pragma("unroll") for (int i = 0; i < 4; ++i) { const int idx = C.tid + i * NT, dd = idx >> 5, ch = idx & 31; \
            *(LAS v4u*)(sbuf + dd * 528 + ch * 16) = stg[i]; } } } while (0)
    ATT_GLOAD(0); ATT_SWRITE(0); __syncthreads();
    bf16x8 Pf[8];
#pragma unroll
    for (int c = 0; c < 8; ++c) {
        ATT_GLOAD(c + 1);
        const LAS unsigned char* sbuf = lds + (c & 1) * BUFB;
#pragma unroll
        for (int ss = 0; ss < 2; ++ss)
#pragma unroll
            for (int nt = 0; nt < 16; ++nt) {
                const int key = 16 * nt + fr, ch = ss * 4 + fq;
                const bf16x8 kf = *(const LAS bf16x8*)(sbuf + key * 128 + ((ch ^ (key & 7)) * 16));
                accS[nt] = __builtin_amdgcn_mfma_f32_16x16x32_bf16(kf, Qf[2 * c + ss], accS[nt], 0, 0, 0);
            }
        if (c == 7) {
            float mx = -3.0e38f;
#pragma unroll
            for (int nt = 0; nt < 16; ++nt) mx = fmaxf(mx, fmaxf(fmaxf(accS[nt][0], accS[nt][1]), fmaxf(accS[nt][2], accS[nt][3])));
            mx = fmaxf(mx, __shfl_xor(mx, 16)); mx = fmaxf(mx, __shfl_xor(mx, 32));
            float sum = 0.f;
#pragma unroll
            for (int nt = 0; nt < 16; ++nt) {
#pragma unroll
                for (int e = 0; e < 4; ++e) { const float p = exp2f(accS[nt][e] - mx); accS[nt][e] = p; sum += p; } }
            sum += __shfl_xor(sum, 16); sum += __shfl_xor(sum, 32);
            const float inv = 1.0f / sum;
#pragma unroll
            for (int s = 0; s < 8; ++s) { v4u o; o.x = pk2(accS[2 * s][0] * inv, accS[2 * s][1] * inv); o.y = pk2(accS[2 * s][2] * inv, accS[2 * s][3] * inv);
                o.z = pk2(accS[2 * s + 1][0] * inv, accS[2 * s + 1][1] * inv); o.w = pk2(accS[2 * s + 1][2] * inv, accS[2 * s + 1][3] * inv); Pf[s] = __builtin_bit_cast(bf16x8, o); }
        }
        ATT_SWRITE(c + 1);
        __syncthreads();
    }
    for (int c = 8; c < 16; ++c) {
        if (c + 1 < 16) ATT_GLOAD(c + 1);
        const LAS unsigned char* sbuf = lds + (c & 1) * BUFB;
        const int dv = c - 8;
        f32x4 accO[4];
#pragma unroll
        for (int nd = 0; nd < 4; ++nd) accO[nd] = (f32x4){0.f, 0.f, 0.f, 0.f};
#pragma unroll
        for (int s = 0; s < 8; ++s)
#pragma unroll
            for (int nd = 0; nd < 4; ++nd) {
                const LAS unsigned char* rp = sbuf + (nd * 16 + fr) * 528 + (32 * s + 4 * fq) * 2;
                const v2u lo = *(const LAS v2u*)rp, hi = *(const LAS v2u*)(rp + 32);
                const bf16x8 vf = __builtin_bit_cast(bf16x8, ((v4u){lo.x, lo.y, hi.x, hi.y}));
                accO[nd] = __builtin_amdgcn_mfma_f32_16x16x32_bf16(vf, Pf[s], accO[nd], 0, 0, 0);
            }
#pragma unroll
        for (int nd = 0; nd < 4; ++nd) { v2u o; o.x = pk2(accO[nd][0], accO[nd][1]); o.y = pk2(accO[nd][2], accO[nd][3]);
            *(v2u*)(Og + (size_t)qrow * D + h * XD + dv * 64 + nd * 16 + 4 * fq) = o; }
        if (c + 1 < 16) ATT_SWRITE(c + 1);
        __syncthreads();
    }
#undef ATT_GLOAD
#undef ATT_SWRITE
}
__device__ __forceinline__ void attn_sample_task(const Params& P, const Ctx& C, LAS unsigned char* lds, int b, int h) {
    unsigned char* ws = wsbase(P);
    bf16* Og = (bf16*)(ws + WS_O);
    const float* CK = inp(P, I_CK); const float* CV = inp(P, I_CV);
    LAS float* sQ = (LAS float*)lds;
    LAS float* sS = (LAS float*)(lds + 16384);
    LAS float* sP = (LAS float*)(lds + 24576);
    LAS float* sO = (LAS float*)(lds + 32768);
    const int row0 = MP + 8 * b, fr = C.lane & 15, fq = C.lane >> 4;
#pragma unroll
    for (int j = 0; j < 2; ++j) { const int i4 = C.tid + NT * j, q = i4 >> 7, d4 = i4 & 127;
        const float* qp = (const float*)(ws + WS_SLAB) + (size_t)(8 * b + q) * D + h * XD + 4 * d4;
        f32x4 a = *(const f32x4*)qp;
#pragma unroll
        for (int sl = 1; sl < 8; ++sl) a += *(const f32x4*)(qp + sl * SLAB_F);
        *(LAS f32x4*)(sQ + q * 512 + 4 * d4) = a * 0.06375871479f; }
    __syncthreads();
    {
        bf16x8 Qf[16];
#pragma unroll
        for (int s = 0; s < 16; ++s) { const LAS float* qs = sQ + (fr & 7) * 512 + 32 * s + 8 * fq; const f32x4 x0 = *(const LAS f32x4*)qs, x1 = *(const LAS f32x4*)(qs + 4);
            v4u o; o.x = pk2(x0[0], x0[1]); o.y = pk2(x0[2], x0[3]); o.z = pk2(x1[0], x1[1]); o.w = pk2(x1[2], x1[3]); Qf[s] = __builtin_bit_cast(bf16x8, o); }
#pragma unroll
        for (int nt = 0; nt < 2; ++nt) {
            const int key = 32 * C.wave + 16 * nt + fr;
            const float* kp = CK + ((size_t)(b * NMEM + key) * XH + h) * XD + 8 * fq;
            f32x4 acc = (f32x4){0.f, 0.f, 0.f, 0.f};
#pragma unroll
            for (int s8 = 0; s8 < 2; ++s8) {
                f32x4 k0[8], k1[8];
#pragma unroll
                for (int s = 0; s < 8; ++s) { k0[s] = __builtin_nontemporal_load((const f32x4*)(kp + 32 * (8 * s8 + s))); k1[s] = __builtin_nontemporal_load((const f32x4*)(kp + 32 * (8 * s8 + s) + 4)); }
#pragma unroll
                for (int s = 0; s < 8; ++s) { v4u o; o.x = pk2(k0[s][0], k0[s][1]); o.y = pk2(k0[s][2], k0[s][3]); o.z = pk2(k1[s][0], k1[s][1]); o.w = pk2(k1[s][2], k1[s][3]);
                    acc = __builtin_amdgcn_mfma_f32_16x16x32_bf16(__builtin_bit_cast(bf16x8, o), Qf[8 * s8 + s], acc, 0, 0, 0); }
            }
            if (fr < 8) {
#pragma unroll
                for (int e = 0; e < 4; ++e) sS[fr * 256 + 32 * C.wave + 16 * nt + 4 * fq + e] = acc[e]; }
        }
    }
    __syncthreads();
    {
        const int q = C.wave; const f32x4 s4 = *(const LAS f32x4*)(sS + q * 256 + 4 * C.lane);
        const float mx = wave_max(fmaxf(fmaxf(s4[0], s4[1]), fmaxf(s4[2], s4[3])));
        const float p0 = exp2f(s4[0] - mx), p1 = exp2f(s4[1] - mx), p2 = exp2f(s4[2] - mx), p3 = exp2f(s4[3] - mx);
        const float inv = 1.0f / wave_sum((p0 + p1) + (p2 + p3));
        sP[(4 * C.lane + 0) * 8 + q] = p0 * inv; sP[(4 * C.lane + 1) * 8 + q] = p1 * inv; sP[(4 * C.lane + 2) * 8 + q] = p2 * inv; sP[(4 * C.lane + 3) * 8 + q] = p3 * inv;
    }
    __syncthreads();
    {
        const int dh = C.wave & 1, kq = C.wave >> 1;
        f32x4 acc[8];
#pragma unroll
        for (int q = 0; q < 8; ++q) acc[q] = (f32x4){0.f, 0.f, 0.f, 0.f};
        const float* vp = CV + ((size_t)(b * NMEM + 64 * kq) * XH + h) * XD + 256 * dh + 4 * C.lane;
        for (int k0 = 0; k0 < 64; k0 += 8) {
            f32x4 vv[8];
#pragma unroll
            for (int u = 0; u < 8; ++u) vv[u] = __builtin_nontemporal_load((const f32x4*)(vp + (size_t)(k0 + u) * (XH * XD)));
#pragma unroll
            for (int u = 0; u < 8; ++u) { const f32x4 pa = *(const LAS f32x4*)(sP + (64 * kq + k0 + u) * 8), pb = *(const LAS f32x4*)(sP + (64 * kq + k0 + u) * 8 + 4);
                acc[0] += vv[u] * pa[0]; acc[1] += vv[u] * pa[1]; acc[2] += vv[u] * pa[2]; acc[3] += vv[u] * pa[3];
                acc[4] += vv[u] * pb[0]; acc[5] += vv[u] * pb[1]; acc[6] += vv[u] * pb[2]; acc[7] += vv[u] * pb[3]; }
        }
#pragma unroll
        for (int q = 0; q < 8; ++q) *(LAS f32x4*)(sO + C.wave * 2048 + q * 256 + 4 * C.lane) = acc[q];
    }
    __syncthreads();
    {
        const int q = C.tid >> 6, d8 = (C.tid & 63) * 8, dh = d8 >> 8, dl = d8 & 255;
        f32x4 a = (f32x4){0.f, 0.f, 0.f, 0.f}, c2 = a;
#pragma unroll
        for (int kq = 0; kq < 4; ++kq) { const LAS float* sp = sO + (kq * 2 + dh) * 2048 + q * 256 + dl; a += *(const LAS f32x4*)sp; c2 += *(const LAS f32x4*)(sp + 4); }
        v4u o; o.x = pk2(a[0], a[1]); o.y = pk2(a[2], a[3]); o.z = pk2(c2[0], c2[1]); o.w = pk2(c2[2], c2[3]);
        *(v4u*)(Og + (size_t)(row0 + q) * D + h * XD + d8) = o;
    }
    __syncthreads();
}

__device__ __forceinline__ void unpack8(const v4u u, float (&x)[8]) { x[0] = bflo(u.x); x[1] = bfhi(u.x); x[2] = bflo(u.y); x[3] = bfhi(u.y); x[4] = bflo(u.z); x[5] = bfhi(u.z); x[6] = bflo(u.w); x[7] = bfhi(u.w); }
__device__ __forceinline__ void ffn_conv_act(const Params& P, const Ctx& C) {
    unsigned char* ws = wsbase(P);
    const bf16* UP = (const bf16*)(ws + WS_UP); bf16* ACT = (bf16*)(ws + WS_ACT);
    const float* FW = inp(P, I_FDW); const float* FB = inp(P, I_FDWB); const float* SF = inp(P, I_SFFN);
    constexpr int NG = DFF / 8;
    constexpr int NRUN = 256 + 128;
    for (int it = C.bid * NT + C.tid; it < NRUN * NG; it += C.G * NT) {
        const int run = it / NG, c = (it - run * NG) * 8;
        int row0, nrow, sb = -1, t0;
        if (run < 256) { row0 = run * 32; nrow = 32; t0 = row0 & (SEQ - 1); } else { sb = run - 256; row0 = MP + 8 * sb; nrow = 8; t0 = 0; }
        float w[2][3][8], bs[2][8];
#pragma unroll
        for (int hf = 0; hf < 2; ++hf) {
#pragma unroll
            for (int j = 0; j < 3; ++j) { const f32x4 a = *(const f32x4*)(FW + j * DFF2 + hf * DFF + c), b2 = *(const f32x4*)(FW + j * DFF2 + hf * DFF + c + 4);
                w[hf][j][0] = a[0]; w[hf][j][1] = a[1]; w[hf][j][2] = a[2]; w[hf][j][3] = a[3]; w[hf][j][4] = b2[0]; w[hf][j][5] = b2[1]; w[hf][j][6] = b2[2]; w[hf][j][7] = b2[3]; }
            const f32x4 a = *(const f32x4*)(FB + hf * DFF + c), b2 = *(const f32x4*)(FB + hf * DFF + c + 4);
            bs[hf][0] = a[0]; bs[hf][1] = a[1]; bs[hf][2] = a[2]; bs[hf][3] = a[3]; bs[hf][4] = b2[0]; bs[hf][5] = b2[1]; bs[hf][6] = b2[2]; bs[hf][7] = b2[3];
        }
        float xm2[2][8], xm1[2][8];
#pragma unroll
        for (int hf = 0; hf < 2; ++hf) {
            if (sb >= 0) { const float* s = SF + (size_t)sb * 2 * DFF2 + hf * DFF + c;
                const f32x4 a = *(const f32x4*)s, b2 = *(const f32x4*)(s + 4), a1 = *(const f32x4*)(s + DFF2), b1 = *(const f32x4*)(s + DFF2 + 4);
                xm2[hf][0] = a[0]; xm2[hf][1] = a[1]; xm2[hf][2] = a[2]; xm2[hf][3] = a[3]; xm2[hf][4] = b2[0]; xm2[hf][5] = b2[1]; xm2[hf][6] = b2[2]; xm2[hf][7] = b2[3];
                xm1[hf][0] = a1[0]; xm1[hf][1] = a1[1]; xm1[hf][2] = a1[2]; xm1[hf][3] = a1[3]; xm1[hf][4] = b1[0]; xm1[hf][5] = b1[1]; xm1[hf][6] = b1[2]; xm1[hf][7] = b1[3]; }
            else if (t0 > 0) { unpack8(*(const v4u*)(UP + (size_t)(row0 - 2) * DFF2 + hf * DFF + c), xm2[hf]); unpack8(*(const v4u*)(UP + (size_t)(row0 - 1) * DFF2 + hf * DFF + c), xm1[hf]); }
            else {
#pragma unroll
                for (int e = 0; e < 8; ++e) { xm2[hf][e] = 0.f; xm1[hf][e] = 0.f; } }
        }
        for (int r0 = 0; r0 < nrow; r0 += 4) {
            v4u u[4][2];
#pragma unroll
            for (int i = 0; i < 4; ++i) { u[i][0] = *(const v4u*)(UP + (size_t)(row0 + r0 + i) * DFF2 + c); u[i][1] = *(const v4u*)(UP + (size_t)(row0 + r0 + i) * DFF2 + DFF + c); }
#pragma unroll
            for (int i = 0; i < 4; ++i) {
                float x[2][8], uc[2][8];
                unpack8(u[i][0], x[0]); unpack8(u[i][1], x[1]);
#pragma unroll
                for (int hf = 0; hf < 2; ++hf)
#pragma unroll
                    for (int e = 0; e < 8; ++e) { uc[hf][e] = bs[hf][e] + w[hf][0][e] * xm2[hf][e] + w[hf][1][e] * xm1[hf][e] + w[hf][2][e] * x[hf][e]; xm2[hf][e] = xm1[hf][e]; xm1[hf][e] = x[hf][e]; }
                float a[8];
#pragma unroll
                for (int e = 0; e < 8; ++e) a[e] = uc[0][e] * sigm(uc[0][e]) * uc[1][e];
                v4u o; o.x = pk2(a[0], a[1]); o.y = pk2(a[2], a[3]); o.z = pk2(a[4], a[5]); o.w = pk2(a[6], a[7]);
                *(v4u*)(ACT + (size_t)(row0 + r0 + i) * DFF + c) = o;
            }
        }
    }
}

template <bool COOP>
__global__ void __launch_bounds__(NT, 2) mega(Params P) {
    extern __shared__ __attribute__((aligned(16))) unsigned char lds_raw[];
    LAS unsigned char* lds = (LAS unsigned char*)lds_raw;
    Ctx C0; C0.tid = threadIdx.x; C0.lane = C0.tid & 63; C0.wave = __builtin_amdgcn_readfirstlane(C0.tid >> 6); C0.bid = blockIdx.x; C0.G = gridDim.x;
    C0.gw = C0.bid * 8 + C0.wave; C0.NGW = C0.G * 8;
    const int lo = P.ph_lo, hi = P.ph_hi;
    if (threadIdx.x < 4) ((LAS unsigned*)(lds + MISC_OFF))[threadIdx.x] = 0u;
    __syncthreads();
    XcdBarrier xbar; xbar.bar = nullptr; xbar.x = 0; xbar.st = nullptr;
    if constexpr (COOP) xbar = xcd_barrier_post((unsigned*)P.ws, (volatile LAS unsigned*)(lds + MISC_OFF));
#ifndef MK_ONLY
#define MK_ONLY -1
#endif
#define IN(k) ((MK_ONLY < 0 || MK_ONLY == (k)) && lo <= (k) && (k) < hi)
#define PH_CTX() Ctx C = C0; unsigned char* ws = wsbase(P); (void)ws; asm volatile("" : "+v"(C.tid), "+v"(C.lane), "+s"(C.wave), "+s"(C.gw), "+s"(C.bid))
#ifndef MK_REPMASK
#define MK_REPMASK 0
#endif
#define NREP(k) (((MK_REPMASK >> (k)) & 1) ? 2 : 1)
#define SEAM(k) do { if constexpr (COOP) { if (IN(k) && IN((k) + 1)) { if ((k) == 0) cg::this_grid().sync(); else xcd_barrier(xbar); } } } while (0)

    for (int rep_ = 0; rep_ < NREP(0); ++rep_) if (IN(0)) { PH_CTX(); p0_prologue(P, C, lds); __syncthreads(); }
    SEAM(0);
    for (int rep_ = 0; rep_ < NREP(1); ++rep_) if (IN(1)) { PH_CTX();
        { pg8::Gemm g{(const pg8::bf16_t*)(ws + WS_HB), (const pg8::bf16_t*)(ws + WS_WIN), M, NINP, D, D}; pg8::StaticOrder S; S.init(M, NINP, C.G, C.bid);
          pg8::EpiIn E{(pg8::bf16_t*)(ws + WS_GLU), (pg8::bf16_t*)(ws + WS_PR), P.out + O_CP, P.out + O_CS, P.out + O_SP, P.out + O_SS};
          pg8::gemm_phase<pg8::EpiIn, pg8::StaticOrder, PG8_ALIGN, PG8_SP2>(lds, g, S, E); }
        { pg8::Gemm g{(const pg8::bf16_t*)(ws + WS_MB), (const pg8::bf16_t*)(ws + WS_WKV), 1024, 4096, D, D}; pg8::StaticOrder S; S.init(1024, 4096, C.G, (C.bid + C.G - 24) % C.G);
          pg8::EpiKV E{P.out + O_MK, P.out + O_MV, (pg8::bf16_t*)(ws + WS_KB), (pg8::bf16_t*)(ws + WS_VT)};
          pg8::gemm_phase<pg8::EpiKV, pg8::StaticOrder, PG8_ALIGN, PG8_SP2>(lds, g, S, E); }
    }
    SEAM(1);
    for (int rep_ = 0; rep_ < NREP(2); ++rep_) if (IN(2)) { PH_CTX();
        {   int cs = C.bid, cst = C.G, cn = (640 - C.bid + C.G - 1) / C.G;
            if (C.G == 256) { if (C.bid < 112) { cst = 112; cn = (640 - C.bid + 111) / 112; } else cn = 0; }
            SUBREP(0) for (int i = 0; i < cn; ++i) { const int tk = cs + i * cst;
                if (tk < 512) { const int b = tk >> 7, r0 = (tk & 127) * 16; conv_task<16>(P, C, lds, b * SEQ + r0, r0, -1); }
                else { const int sb = tk - 512; conv_task<8>(P, C, lds, MP + 8 * sb, 0, sb); } } }
        SUBREP(1) for (int tk = (C.G == 256 ? C.bid - 112 : C.bid); tk < 144; tk += C.G) if (tk >= 0) prep_task<8>(P, C, lds, tk >> 1, (tk & 1) * 8);
    }
    SEAM(2);
    for (int rep_ = 0; rep_ < NREP(3); ++rep_) if (IN(3)) { PH_CTX();
        const float* swkv = inp(P, I_SWKV);
        SUBREP(2) for (int tk = C.bid; tk < 256; tk += C.G) scan_prompt(P, C, lds, tk >> 2, tk & 3, C.G == 256 && sr_ == 0);
        { const int nsw = C.G * 4, per = (SEQ / TC + 2) / 5; const int done_upto = (C.G == 256 ? nsw * per : 0);
          for (int it = done_upto + C.gw; it < NDEF; it += C.NGW) { const DefItem di = def_item(P, ws, it); transpose_item(di.W, di.K, di.N, di.WT, di.kb, di.jb, C.lane, MapId()); } }
        SUBREP(3) for (int tk = C.bid; tk < 4096; tk += C.G) scan_sample(P, C, swkv, tk >> 1, tk & 1);
    }
    SEAM(3);
    for (int rep_ = 0; rep_ < NREP(4); ++rep_) if (IN(4)) { PH_CTX(); for (int m = C.gw; m < M; m += C.NGW) post_row(P, m, C.lane); }
    SEAM(4);
    for (int rep_ = 0; rep_ < NREP(5); ++rep_) if (IN(5)) { PH_CTX();
        { pg8::Gemm g{(const pg8::bf16_t*)(ws + WS_A2), (const pg8::bf16_t*)(ws + WS_WOUT), MP, D, D, D}; pg8::StaticOrder S; S.init(MP, D, C.G, C.bid);
          pg8::EpiBf16S E{(pg8::bf16_t*)(ws + WS_MIX), D, 1.0f, nullptr}; pg8::gemm_phase<pg8::EpiBf16S, pg8::StaticOrder, PG8_ALIGN, PG8_SP2>(lds, g, S, E); }
        { pg8::Gemm g{(const pg8::bf16_t*)(ws + WS_A2) + (size_t)MP * D, (const pg8::bf16_t*)(ws + WS_WOUT), MS, D, D / 8, D}; pg8::SplitOrder S; S.init(MS, D, 8, C.G, C.bid);
          pg8::EpiF32 E{(float*)(ws + WS_SLAB), D, SLAB_F}; pg8::gemm_phase<pg8::EpiF32, pg8::SplitOrder, PG8_ALIGN, PG8_SP2>(lds, g, S, E); } }
    SEAM(5);
    for (int rep_ = 0; rep_ < NREP(6); ++rep_) if (IN(6)) { PH_CTX(); const float* xp = inp(P, I_XP); const float* xs = inp(P, I_XS); const float* g1 = inp(P, I_NMIXPOST); const float* g2 = inp(P, I_NXAPRE);
        for (int m = C.gw; m < M; m += C.NGW) { const float* xr = m < MP ? xp + (size_t)m * D : xs + (size_t)(m - MP) * D;
        const bf16* mb = m < MP ? (const bf16*)(ws + WS_MIX) + (size_t)m * D : nullptr; const float* mx = (const float*)(ws + WS_SLAB) + (size_t)(m < MP ? 0 : m - MP) * D;
        rowpass(xr, mb, mx, 8, g1, (float*)(ws + WS_X1) + (size_t)m * D, g2, (bf16*)(ws + WS_HB) + (size_t)m * D, C.lane); } }
    SEAM(6);
    for (int rep_ = 0; rep_ < NREP(7); ++rep_) if (IN(7)) { PH_CTX();
        { pg8::Gemm g{(const pg8::bf16_t*)(ws + WS_HB), (const pg8::bf16_t*)(ws + WS_WQ), MP, D, D, D}; pg8::StaticOrder S; S.init(MP, D, C.G, C.bid);
          pg8::EpiBf16S E{(pg8::bf16_t*)(ws + WS_Q), D, 0.06375871479f  , nullptr};
          pg8::gemm_phase<pg8::EpiBf16S, pg8::StaticOrder, PG8_ALIGN, PG8_SP2>(lds, g, S, E); }
        { pg8::Gemm g{(const pg8::bf16_t*)(ws + WS_HB) + (size_t)MP * D, (const pg8::bf16_t*)(ws + WS_WQ), MS, D, D / 8, D}; pg8::SplitOrder S; S.init(MS, D, 8, C.G, C.bid);
          pg8::EpiF32 E{(float*)(ws + WS_SLAB), D, SLAB_F}; pg8::gemm_phase<pg8::EpiF32, pg8::SplitOrder, PG8_ALIGN, PG8_SP2>(lds, g, S, E); } }
    SEAM(7);
    for (int rep_ = 0; rep_ < NREP(8); ++rep_) if (IN(8)) { PH_CTX();
        SUBREP(4) for (int tk = C.bid; tk < 256; tk += C.G) attn_prompt_task(P, C, lds, tk >> 6, (tk >> 4) & 3, tk & 15);
        SUBREP(5) for (int tk = C.bid; tk < 512; tk += C.G) attn_sample_task(P, C, lds, tk >> 2, tk & 3);
    }
    SEAM(8);
    for (int rep_ = 0; rep_ < NREP(9); ++rep_) if (IN(9)) { PH_CTX();
        { pg8::Gemm g{(const pg8::bf16_t*)(ws + WS_O), (const pg8::bf16_t*)(ws + WS_WO), MP, D, D, D}; pg8::StaticOrder S; S.init(MP, D, C.G, C.bid);
          pg8::EpiBf16S E{(pg8::bf16_t*)(ws + WS_MIX), D, 1.0f, nullptr}; pg8::gemm_phase<pg8::EpiBf16S, pg8::StaticOrder, PG8_ALIGN, PG8_SP2>(lds, g, S, E); }
        { pg8::Gemm g{(const pg8::bf16_t*)(ws + WS_O) + (size_t)MP * D, (const pg8::bf16_t*)(ws + WS_WO), MS, D, D / 8, D}; pg8::SplitOrder S; S.init(MS, D, 8, C.G, C.bid);
          pg8::EpiF32 E{(float*)(ws + WS_SLAB), D, SLAB_F}; pg8::gemm_phase<pg8::EpiF32, pg8::SplitOrder, PG8_ALIGN, PG8_SP2>(lds, g, S, E); } }
    SEAM(9);
    for (int rep_ = 0; rep_ < NREP(10); ++rep_) if (IN(10)) { PH_CTX(); const float* g1 = inp(P, I_NXAPOST); const float* g2 = inp(P, I_NFFNPRE);
        for (int m = C.gw; m < M; m += C.NGW) { float* x1 = (float*)(ws + WS_X1) + (size_t)m * D;
        const bf16* mb = m < MP ? (const bf16*)(ws + WS_MIX) + (size_t)m * D : nullptr; const float* mx = (const float*)(ws + WS_SLAB) + (size_t)(m < MP ? 0 : m - MP) * D;
        rowpass(x1, mb, mx, 8, g1, x1, g2, (bf16*)(ws + WS_HB) + (size_t)m * D, C.lane); } }
    SEAM(10);
    for (int rep_ = 0; rep_ < NREP(11); ++rep_) if (IN(11)) { PH_CTX(); pg8::Gemm g{(const pg8::bf16_t*)(ws + WS_HB), (const pg8::bf16_t*)(ws + WS_WUP), M, DFF2, D, D}; pg8::StaticOrder S; S.init(M, DFF2, C.G, C.bid);
        pg8::EpiBf16S E{(pg8::bf16_t*)(ws + WS_UP), DFF2, 1.0f, P.out + O_FP};
        pg8::gemm_phase<pg8::EpiBf16S, pg8::StaticOrder, PG8_ALIGN, PG8_SP2>(lds, g, S, E); }
    SEAM(11);
    for (int rep_ = 0; rep_ < NREP(12); ++rep_) if (IN(12)) { PH_CTX(); ffn_conv_act(P, C); }
    SEAM(12);
    for (int rep_ = 0; rep_ < NREP(13); ++rep_) if (IN(13)) { PH_CTX();
        { pg8::Gemm g{(const pg8::bf16_t*)(ws + WS_ACT), (const pg8::bf16_t*)(ws + WS_WDN), MP, D, DFF, DFF}; pg8::StaticOrder S; S.init(MP, D, C.G, C.bid);
          pg8::EpiBf16S E{(pg8::bf16_t*)(ws + WS_MIX), D, 1.0f, nullptr}; pg8::gemm_phase<pg8::EpiBf16S, pg8::StaticOrder, PG8_ALIGN, PG8_SP2>(lds, g, S, E); }
        { pg8::Gemm g{(const pg8::bf16_t*)(ws + WS_ACT) + (size_t)MP * DFF, (const pg8::bf16_t*)(ws + WS_WDN), MS, D, DFF / 4, DFF}; pg8::SplitOrder S; S.init(MS, D, 4, C.G, (C.bid + 128) % C.G);
          pg8::EpiF32 E{(float*)(ws + WS_SLAB), D, SLAB_F}; pg8::gemm_phase<pg8::EpiF32, pg8::SplitOrder, PG8_ALIGN, PG8_SP2>(lds, g, S, E); } }
    SEAM(13);
    for (int rep_ = 0; rep_ < NREP(14); ++rep_) if (IN(14)) { PH_CTX(); const float* g1 = inp(P, I_NFFNPOST);
        for (int m = C.gw; m < M; m += C.NGW) { const float* x2 = (const float*)(ws + WS_X1) + (size_t)m * D;
        float* yo = m < MP ? P.out + O_YP + (size_t)m * D : P.out + O_YS + (size_t)(m - MP) * D;
        const bf16* mb = m < MP ? (const bf16*)(ws + WS_MIX) + (size_t)m * D : nullptr; const float* mx = (const float*)(ws + WS_SLAB) + (size_t)(m < MP ? 0 : m - MP) * D;
        rowpass(x2, mb, mx, 4, g1, yo, nullptr, nullptr, C.lane); } }
#undef IN
#undef SEAM
}

#ifndef MK_ONE_LAUNCH
#define MK_ONE_LAUNCH 1
#endif
extern "C" void kernel_launch(void* const* d_in, const int* in_sizes, int n_in, void* d_out, int out_size, void* d_ws, size_t ws_size, hipStream_t stream) {
    static int grid = 0;
    if (grid == 0) {
        if (n_in != N_IN || (size_t)out_size != O_END || ws_size < WS_END) { fprintf(stderr, "kernel_launch: unexpected sizes: n_in %d out %d ws %zu (need %zu)\n", n_in, out_size, ws_size, (size_t)WS_END); grid = -1; return; }
        int dev = 0, cus = 0, per_cu = 0;
        (void)hipGetDevice(&dev); (void)hipDeviceGetAttribute(&cus, hipDeviceAttributeMultiprocessorCount, dev);
        (void)hipFuncSetAttribute((const void*)mega<(MK_ONE_LAUNCH != 0)>, hipFuncAttributeMaxDynamicSharedMemorySize, LDS_BYTES);
        (void)hipOccupancyMaxActiveBlocksPerMultiprocessor(&per_cu, (const void*)mega<(MK_ONE_LAUNCH != 0)>, NT, LDS_BYTES);
        fprintf(stderr, "kernel_launch: cus %d, occupancy query %d block(s)/CU, ws %zu MiB\n", cus, per_cu, ws_size >> 20);
        (void)hipGetLastError();
        grid = cus;
        if (per_cu < 1) { fprintf(stderr, "kernel_launch: occupancy query says 0 blocks per CU\n"); }
    }
    if (grid < 0) return;
    if (hipMemsetAsync(d_ws, 0, 16384, stream) != hipSuccess) { fprintf(stderr, "kernel_launch: hipMemsetAsync failed\n"); return; }
    Params p{};
    for (int i = 0; i < N_IN; ++i) p.in[i] = (const float*)d_in[i];
    p.out = (float*)d_out; p.ws = (unsigned char*)d_ws;
#if MK_ONE_LAUNCH
    p.ph_lo = 0; p.ph_hi = NPHASE;
    void* args[] = {&p};
    hipError_t e = hipLaunchCooperativeKernel((const void*)mega<true>, dim3(grid), dim3(NT), args, LDS_BYTES, stream);
    if (e != hipSuccess) fprintf(stderr, "cooperative launch failed: %s (grid %d)\n", hipGetErrorString(e), grid);
#else
    for (int ph = 0; ph < NPHASE; ++ph) { p.ph_lo = ph; p.ph_hi = ph + 1; hipLaunchKernelGGL((mega<false>), dim3(grid), dim3(NT), LDS_BYTES, stream, p); }
#endif
}
```

```cpp
#include <hip/hip_runtime.h>
#include <hip/hip_cooperative_groups.h>
#include <cstdio>
#include <cstdint>
namespace cg = cooperative_groups;
constexpr int D = 2048, MP = 8192, MS = 1024, M = MP + MS, SEQ = 2048, TS = 8, NBP = 4, NBS = 128;
constexpr int CC = 1024, CW = 31, RW = 1024, RH = 16, HD = 64;
constexpr int NRC = 3520, NRCP = 3584, NINP = 5632;
constexpr int NMEM = 256, XH = 4, XD = 512, DFF = 5632, DFF2 = 11264;
namespace pg8 {
#define PG8_LAS __attribute__((address_space(3)))
typedef unsigned short bf16_t;
typedef short bf16x8 __attribute__((ext_vector_type(8)));
typedef float f32x4 __attribute__((ext_vector_type(4)));
typedef unsigned u32x4 __attribute__((ext_vector_type(4)));
constexpr int BM = 256, BK = 64, HALF = 128, HTB = HALF * BK * 2  , STAGE_BYTES = 8 * HTB, NXCD = 8, WGM = 8;

__host__ __device__ __forceinline__ int lds_byte(int r, int c) { const int st = (r >> 4) * 2 + (c >> 5), rr = r & 15, cc = c & 31, ob = rr * 64 + cc * 2; return st * 1024 + (ob ^ (((ob >> 9) & 1) << 5)); }
__host__ __device__ __forceinline__ void stage_rc(int b, int& R, int& C) { const int st = b / 1024, sb = b % 1024, swz = sb ^ (((sb >> 9) & 1) << 5); R = (st >> 1) * 16 + swz / 64; C = (st & 1) * 32 + (swz % 64) / 2; }
__host__ __device__ __forceinline__ int perm32(int rho) { const int n = rho >> 4, i = rho & 15; return 8 * (i >> 2) + 4 * n + (i & 3); }

struct Unit { int pm, pn, ks; };
struct Gemm { const bf16_t* A; const bf16_t* Bt; int M, N, K, ld; };

struct StaticOrder {
    int nM, nN, nwg, G, c;
    __host__ __device__ void init(int M, int N, int G_, int c_) { nM = M / BM; nN = N / BM; nwg = nM * nN; G = G_; c = c_; }
    __host__ __device__ bool next(int i, Unit& u) const {
        const long L = (long)i * G + c; if (L >= nwg) return false;
        int wgid = (int)L; { const int q = nwg / NXCD, r = nwg % NXCD, xcd = wgid % NXCD, off = wgid / NXCD; wgid = (xcd < r ? xcd * (q + 1) : r * (q + 1) + (xcd - r) * q) + off; }
        const int nig = WGM * nN, gid = wgid / nig, fm = gid * WGM, gsz = (nM - fm) < WGM ? (nM - fm) : WGM;
        u.pm = fm + ((wgid % nig) % gsz); u.pn = (wgid % nig) / gsz; u.ks = 0; return true;
    }
    __device__ __forceinline__ void a_ready(const Unit&) const {}
    __device__ __forceinline__ void done(const Unit&) const {}
};

struct SplitOrder {
    int nN, nsplit, nitems, G, c;
    __host__ __device__ void init(int M, int N, int nsplit_, int G_, int c_) { nN = N / BM; nsplit = nsplit_; nitems = (M / BM) * nN * nsplit_; G = G_; c = c_; }
    __host__ __device__ bool next(int i, Unit& u) const { const int L = i * G + c; if (L >= nitems) return false; u.ks = L % nsplit; const int t = L / nsplit; u.pn = t % nN; u.pm = t / nN; return true; }
    __device__ __forceinline__ void a_ready(const Unit&) const {}
    __device__ __forceinline__ void done(const Unit&) const {}
};
__device__ __forceinline__ unsigned cvt_pk_bf16(float lo, float hi) { unsigned r; asm volatile("v_cvt_pk_bf16_f32 %0, %1, %2" : "=v"(r) : "v"(lo), "v"(hi)); return r; }
typedef float f32x2 __attribute__((ext_vector_type(2)));
typedef unsigned u32x2 __attribute__((ext_vector_type(2)));
struct EpiIn {
    static constexpr bool PERM = true, AFTER_DRAIN = false;
    bf16_t* glu; bf16_t* pr; float* oconv_p; float* oconv_s; float* oshift_p; float* oshift_s;
    __device__ __forceinline__ void operator()(const f32x4 (&acc)[2][2][4][2], const Unit& u, int wr, int wc, int fr, int fq) const {
        const int row0 = u.pm * BM + wr * 64 + fr;
        if (u.pn < 8) {
#pragma unroll
            for (int ai = 0; ai < 2; ++ai)
#pragma unroll
                for (int m = 0; m < 4; ++m) {
                    const int row = row0 + ai * HALF + m * 16;
                    float* cdst = nullptr;
                    if (row < MP) { const int t = row & (SEQ - 1); if (t >= SEQ - 30) cdst = oconv_p + (size_t)((row >> 11) * 30 + (t - (SEQ - 30))) * CC; }
                    else { const int rs = row - MP; cdst = oconv_s + (size_t)((rs >> 3) * 30 + 22 + (rs & 7)) * CC; }
#pragma unroll
                    for (int bj = 0; bj < 2; ++bj) {
                        const int cgl = 16 * (8 * u.pn + 4 * bj + wc) + 4 * fq;
                        const f32x4 a = acc[ai][bj][m][0], g = acc[ai][bj][m][1];
                        f32x4 v;
#pragma unroll
                        for (int e = 0; e < 4; ++e) v[e] = a[e] / (1.0f + __expf(-g[e]));
                        u32x2 w; w.x = cvt_pk_bf16(v[0], v[1]); w.y = cvt_pk_bf16(v[2], v[3]);
                        *(u32x2*)(glu + (size_t)row * CC + cgl) = w;
                        if (cdst) *(f32x4*)(cdst + cgl) = v;
                    }
                }
        } else {
#pragma unroll
            for (int ai = 0; ai < 2; ++ai)
#pragma unroll
                for (int m = 0; m < 4; ++m) {
                    const int row = row0 + ai * HALF + m * 16;
                    float* sdst = nullptr;
                    if (row < MP) { if ((row & (SEQ - 1)) == SEQ - 1) sdst = oshift_p + (size_t)(row >> 11) * NRC; }
                    else { const int rs = row - MP; if ((rs & 7) == 7) sdst = oshift_s + (size_t)(rs >> 3) * NRC; }
#pragma unroll
                    for (int bj = 0; bj < 2; ++bj) {
                        const int jj0 = 256 * (u.pn - 8) + 128 * bj + 32 * wc + 8 * fq;
                        const f32x4 v0 = acc[ai][bj][m][0], v1 = acc[ai][bj][m][1];
                        u32x4 w; w.x = cvt_pk_bf16(v0[0], v0[1]); w.y = cvt_pk_bf16(v0[2], v0[3]); w.z = cvt_pk_bf16(v1[0], v1[1]); w.w = cvt_pk_bf16(v1[2], v1[3]);
                        *(u32x4*)(pr + (size_t)row * NRCP + jj0) = w;
                        if (sdst && jj0 < NRC) { *(f32x4*)(sdst + jj0) = v0; *(f32x4*)(sdst + jj0 + 4) = v1; }
                    }
                }
        }
    }
};
struct EpiKV {
    static constexpr bool PERM = false, AFTER_DRAIN = false;
    float* ok; float* ov; bf16_t* kb; bf16_t* vt;
    __device__ __forceinline__ void operator()(const f32x4 (&acc)[2][2][4][2], const Unit& u, int wr, int wc, int fr, int fq) const {
        const int row0 = u.pm * BM + wr * 64 + fr;
#pragma unroll
        for (int ai = 0; ai < 2; ++ai)
#pragma unroll
            for (int m = 0; m < 4; ++m) {
                const int r = row0 + ai * HALF + m * 16;
#pragma unroll
                for (int bj = 0; bj < 2; ++bj)
#pragma unroll
                    for (int n = 0; n < 2; ++n) {
                        const int c = 256 * u.pn + 128 * bj + 32 * wc + 16 * n + 4 * fq;
                        const f32x4 v = acc[ai][bj][m][n];
                        if (u.pn < 8) {
                            *(f32x4*)(ok + (size_t)r * 2048 + c) = v;
                            u32x2 w; w.x = cvt_pk_bf16(v[0], v[1]); w.y = cvt_pk_bf16(v[2], v[3]);
                            *(u32x2*)(kb + (size_t)r * 2048 + c) = w;
                        } else {
                            const int cv = c - 2048;
                            *(f32x4*)(ov + (size_t)r * 2048 + cv) = v;
                            const int b = r >> 8, key = r & 255, h = cv >> 9, d = cv & 511;
                            bf16_t* dst = vt + ((size_t)((b * 4 + h) * 512 + d)) * 256 + key;
                            const unsigned w0 = cvt_pk_bf16(v[0], v[1]), w1 = cvt_pk_bf16(v[2], v[3]);
                            dst[0] = (bf16_t)(w0 & 0xffffu); dst[256] = (bf16_t)(w0 >> 16); dst[512] = (bf16_t)(w1 & 0xffffu); dst[768] = (bf16_t)(w1 >> 16);
                        }
                    }
            }
    }
};
struct EpiF32 {
    static constexpr bool PERM = false, AFTER_DRAIN = false;
    float* C; int ldc; size_t slab;
    __device__ __forceinline__ void operator()(const f32x4 (&acc)[2][2][4][2], const Unit& u, int wr, int wc, int fr, int fq) const {
        const int row0 = u.pm * BM + wr * 64 + fr, col0 = u.pn * BM + wc * 32 + 4 * fq;
#pragma unroll
        for (int ai = 0; ai < 2; ++ai)
#pragma unroll
            for (int m = 0; m < 4; ++m) { float* rowp = C + (size_t)u.ks * slab + (size_t)(row0 + ai * HALF + m * 16) * ldc + col0;
#pragma unroll
                for (int bj = 0; bj < 2; ++bj)
#pragma unroll
                    for (int n = 0; n < 2; ++n) *(f32x4*)(rowp + bj * HALF + n * 16) = acc[ai][bj][m][n]; }
    }
};
struct EpiBf16S {
    static constexpr bool PERM = true, AFTER_DRAIN = false;
    bf16_t* O; int ldc; float scale; float* f;
    __device__ __forceinline__ void operator()(const f32x4 (&acc)[2][2][4][2], const Unit& u, int wr, int wc, int fr, int fq) const {
        const int row0 = u.pm * BM + wr * 64 + fr, col0 = u.pn * BM + wc * 32 + 8 * fq;
#pragma unroll
        for (int ai = 0; ai < 2; ++ai)
#pragma unroll
            for (int m = 0; m < 4; ++m) {
                const int row = row0 + ai * HALF + m * 16;
                long foff = -1;
                if (f) {
                    if (row < MP) { const int t = row & (SEQ - 1); if (t >= SEQ - 2) foff = (long)((row >> 11) * 2 + (t - (SEQ - 2))) * DFF2; }
                    else { const int rs = row - MP, t = rs & 7; if (t >= 6) foff = (long)(NBP * 2 + (rs >> 3) * 2 + (t - 6)) * DFF2; }
                }
                float* fdst = f + (foff < 0 ? 0 : foff);
                bf16_t* rowp = O + (size_t)row * ldc + col0;
#pragma unroll
                for (int bj = 0; bj < 2; ++bj) {
                    const f32x4 v0 = acc[ai][bj][m][0] * scale, v1 = acc[ai][bj][m][1] * scale;
                    u32x4 w; w.x = cvt_pk_bf16(v0[0], v0[1]); w.y = cvt_pk_bf16(v0[2], v0[3]); w.z = cvt_pk_bf16(v1[0], v1[1]); w.w = cvt_pk_bf16(v1[2], v1[3]);
                    *(u32x4*)(rowp + bj * HALF) = w;
                    if (foff >= 0) { *(f32x4*)(fdst + col0 + bj * HALF) = v0; *(f32x4*)(fdst + col0 + bj * HALF + 4) = v1; }
                }
            }
    }
};

template <class Epi, class Sched, bool ALIGN_EPI = false, bool SP2 = false>
__device__ __forceinline__ void gemm_phase(PG8_LAS unsigned char* lds, const Gemm g, const Sched& S, const Epi& E) {
    int tid_ = threadIdx.x; asm volatile("" : "+v"(tid_));
    const int tid = tid_, wid = __builtin_amdgcn_readfirstlane(tid >> 6), lane = tid & 63, wr = wid >> 2, wc = wid & 3, fr = lane & 15, fq = lane >> 4;
    const int K = g.K, nt = K / BK;
    unsigned voffA[2], voffB[2];
#pragma unroll
    for (int i = 0; i < 2; ++i) { int R, C; stage_rc(tid * 16 + i * 8192, R, C); const int Rb = Epi::PERM ? ((R & ~31) + perm32(R & 31)) : R;
        voffA[i] = (unsigned)(R * g.ld + C) * 2u; voffB[i] = (unsigned)(Rb * g.ld + C) * 2u; }
    const size_t kstep = (size_t)(BK * 2);
    const size_t hstep = (size_t)HALF * g.ld * 2;
    const size_t tstep = 2 * hstep;
    const unsigned ldsw = (unsigned)wid * 1024u;
    const int aoff = lds_byte(wr * 64 + fr, fq * 8), boff = lds_byte(wc * 32 + fr, fq * 8);
#define PG8_SA(b, h) (((b) * 2 + (h)) * HTB)
#define PG8_SB(b, h) ((4 + (b) * 2 + (h)) * HTB)
#define PG8_STAGE(bufoff, gbase, voff) do { _Pragma("unroll") for (int _i = 0; _i < 2; ++_i) \
        __builtin_amdgcn_global_load_lds((const unsigned*)((const char*)(gbase) + (voff)[_i]), (PG8_LAS unsigned*)(lds + (bufoff) + ldsw + _i * 8192), 16, 0, 0); } while (0)
#define PG8_LDA(dst, b, h) do { _Pragma("unroll") for (int m = 0; m < 4; ++m) _Pragma("unroll") for (int k = 0; k < 2; ++k) dst[m][k] = *(const PG8_LAS bf16x8*)(lds + PG8_SA(b, h) + aoff + m * 2048 + k * 1024); } while (0)
#define PG8_LDB(dst, b, h) do { _Pragma("unroll") for (int n = 0; n < 2; ++n) _Pragma("unroll") for (int k = 0; k < 2; ++k) dst[n][k] = *(const PG8_LAS bf16x8*)(lds + PG8_SB(b, h) + boff + n * 2048 + k * 1024); } while (0)
#define PG8_MMA(ai, bj, At, Bt) do { __builtin_amdgcn_s_setprio(1); _Pragma("unroll") for (int m = 0; m < 4; ++m) _Pragma("unroll") for (int n = 0; n < 2; ++n) _Pragma("unroll") for (int k = 0; k < 2; ++k) \
        acc[ai][bj][m][n] = __builtin_amdgcn_mfma_f32_16x16x32_bf16(Bt[n][k], At[m][k], acc[ai][bj][m][n], 0, 0, 0); __builtin_amdgcn_s_setprio(0); } while (0)
#define PG8_WAIT_V(n) asm volatile("s_waitcnt vmcnt(" #n ")" ::: "memory")
#define PG8_WAIT_L(n) asm volatile("s_waitcnt lgkmcnt(" #n ")" ::: "memory")
#define PG8_BAR __builtin_amdgcn_s_barrier()
#define PG8_SCHED __builtin_amdgcn_sched_barrier(0)
    Unit cur, nxt; int ui = 0;
    if (!S.next(0, cur)) return;
    f32x4 acc[2][2][4][2];
#pragma unroll
    for (int a = 0; a < 2; ++a)
#pragma unroll
        for (int b = 0; b < 2; ++b)
#pragma unroll
            for (int m = 0; m < 4; ++m)
#pragma unroll
                for (int n = 0; n < 2; ++n) acc[a][b][m][n] = (f32x4){0.f, 0.f, 0.f, 0.f};
    bf16x8 At[4][2], B0[2][2], B1[2][2];
    const size_t sstep = (size_t)K * 2;
    const char* cA = (const char*)g.A + (size_t)cur.pm * tstep + (size_t)cur.ks * sstep; const char* cB = (const char*)g.Bt + (size_t)cur.pn * tstep + (size_t)cur.ks * sstep;
    S.a_ready(cur);
    if constexpr (SP2) {
        PG8_STAGE(PG8_SB(0, 0), cB, voffB); PG8_STAGE(PG8_SB(0, 1), cB + hstep, voffB); PG8_STAGE(PG8_SA(0, 0), cA, voffA); PG8_STAGE(PG8_SA(0, 1), cA + hstep, voffA);
        if (wr == 1) PG8_BAR;
        PG8_WAIT_V(2); PG8_BAR;
        PG8_STAGE(PG8_SB(1, 0), cB + kstep, voffB); PG8_STAGE(PG8_SA(1, 0), cA + kstep, voffA); PG8_STAGE(PG8_SB(1, 1), cB + hstep + kstep, voffB);
        PG8_WAIT_V(6); PG8_BAR;
    } else {
        PG8_STAGE(PG8_SB(0, 0), cB, voffB); PG8_STAGE(PG8_SA(0, 0), cA, voffA); PG8_STAGE(PG8_SB(0, 1), cB + hstep, voffB); PG8_STAGE(PG8_SA(0, 1), cA + hstep, voffA);
        if (wr == 1) PG8_BAR;
        PG8_WAIT_V(4); PG8_BAR;
        PG8_STAGE(PG8_SB(1, 0), cB + kstep, voffB); PG8_STAGE(PG8_SA(1, 0), cA + kstep, voffA); PG8_STAGE(PG8_SB(1, 1), cB + hstep + kstep, voffB);
        PG8_WAIT_V(6); PG8_BAR;
    }
    for (;;) {
        const bool has_next = S.next(ui + 1, nxt);
        const char* nA = has_next ? (const char*)g.A + (size_t)nxt.pm * tstep + (size_t)nxt.ks * sstep : cA; const char* nB = has_next ? (const char*)g.Bt + (size_t)nxt.pn * tstep + (size_t)nxt.ks * sstep : cB;
        for (int t = 0; t < nt; t += 2) {
            const bool last = (t == nt - 2);
            const char* a1 = cA + (size_t)(t + 1) * kstep;
            const char* a2 = last ? nA : cA + (size_t)(t + 2) * kstep; const char* b2 = last ? nB : cB + (size_t)(t + 2) * kstep;
            const char* a3 = a2 + kstep; const char* b3 = b2 + kstep;
            if (last && has_next) S.a_ready(nxt);
            if constexpr (SP2) {
            PG8_LDB(B0, 0, 0); PG8_LDB(B1, 0, 1); PG8_SCHED; PG8_LDA(At, 0, 0); PG8_STAGE(PG8_SA(1, 1), a1 + hstep, voffA);
            PG8_WAIT_V(8); PG8_WAIT_L(0); PG8_BAR; PG8_MMA(0, 0, At, B0); PG8_MMA(0, 1, At, B1); PG8_BAR; PG8_SCHED;
            PG8_LDA(At, 0, 1); PG8_STAGE(PG8_SB(0, 0), b2, voffB); PG8_STAGE(PG8_SB(0, 1), b2 + hstep, voffB); PG8_STAGE(PG8_SA(0, 0), a2, voffA);
            PG8_WAIT_V(8); PG8_WAIT_L(0); PG8_BAR; PG8_MMA(1, 0, At, B0); PG8_MMA(1, 1, At, B1); PG8_BAR; PG8_SCHED;
            PG8_LDB(B0, 1, 0); PG8_LDB(B1, 1, 1); PG8_SCHED; PG8_LDA(At, 1, 0); PG8_STAGE(PG8_SA(0, 1), a2 + hstep, voffA);
            PG8_WAIT_V(8); PG8_WAIT_L(0); PG8_BAR; PG8_MMA(0, 0, At, B0); PG8_MMA(0, 1, At, B1); PG8_BAR; PG8_SCHED;
            PG8_LDA(At, 1, 1); PG8_STAGE(PG8_SB(1, 0), b3, voffB); PG8_STAGE(PG8_SB(1, 1), b3 + hstep, voffB); PG8_STAGE(PG8_SA(1, 0), a3, voffA);
            PG8_WAIT_V(8); PG8_WAIT_L(0); PG8_BAR; PG8_MMA(1, 0, At, B0); PG8_MMA(1, 1, At, B1); PG8_BAR; PG8_SCHED;
            } else {
            PG8_LDB(B0, 0, 0); PG8_SCHED; PG8_LDA(At, 0, 0); PG8_STAGE(PG8_SA(1, 1), a1 + hstep, voffA);
            PG8_WAIT_L(8); PG8_BAR; PG8_WAIT_L(0); PG8_MMA(0, 0, At, B0); PG8_BAR; PG8_SCHED;
            PG8_LDB(B1, 0, 1); PG8_STAGE(PG8_SB(0, 0), b2, voffB);
            PG8_BAR; PG8_WAIT_L(0); PG8_MMA(0, 1, At, B1); PG8_BAR;
            PG8_LDA(At, 0, 1); PG8_STAGE(PG8_SA(0, 0), a2, voffA);
            PG8_BAR; PG8_WAIT_L(0); PG8_MMA(1, 0, At, B0); PG8_BAR; PG8_SCHED;
            PG8_STAGE(PG8_SB(0, 1), b2 + hstep, voffB);
            PG8_WAIT_V(6); PG8_BAR; PG8_MMA(1, 1, At, B1); PG8_BAR;
            PG8_LDB(B0, 1, 0); PG8_SCHED; PG8_LDA(At, 1, 0); PG8_STAGE(PG8_SA(0, 1), a2 + hstep, voffA);
            PG8_WAIT_L(8); PG8_BAR; PG8_WAIT_L(0); PG8_MMA(0, 0, At, B0); PG8_BAR; PG8_SCHED;
            PG8_LDB(B1, 1, 1); PG8_STAGE(PG8_SB(1, 0), b3, voffB);
            PG8_BAR; PG8_WAIT_L(0); PG8_MMA(0, 1, At, B1); PG8_BAR;
            PG8_LDA(At, 1, 1); PG8_STAGE(PG8_SA(1, 0), a3, voffA);
            PG8_BAR; PG8_WAIT_L(0); PG8_MMA(1, 0, At, B0); PG8_BAR; PG8_SCHED;
            PG8_STAGE(PG8_SB(1, 1), b3 + hstep, voffB);
            PG8_WAIT_V(6); PG8_BAR; PG8_MMA(1, 1, At, B1); PG8_BAR;
            }
        }
        if constexpr (ALIGN_EPI) { if (wr == 0) PG8_BAR; }
        if constexpr (!Epi::AFTER_DRAIN) { E(acc, cur, wr, wc, fr, fq); S.done(cur); }
        if (!has_next) break;
#pragma unroll
        for (int a = 0; a < 2; ++a)
#pragma unroll
            for (int b = 0; b < 2; ++b)
#pragma unroll
                for (int m = 0; m < 4; ++m)
#pragma unroll
                    for (int n = 0; n < 2; ++n) acc[a][b][m][n] = (f32x4){0.f, 0.f, 0.f, 0.f};
        cur = nxt; cA = nA; cB = nB; ++ui;
        if constexpr (ALIGN_EPI) { if (wr == 1) PG8_BAR; }
    }
    PG8_WAIT_V(0);
    if constexpr (!ALIGN_EPI) { if (wr == 0) PG8_BAR; }
    PG8_BAR;
    if constexpr (Epi::AFTER_DRAIN) { E.fused(acc, cur, wr, wc, fr, fq, lds, wid, lane); S.done(cur); }
#undef PG8_SA
#undef PG8_SB
#undef PG8_STAGE
#undef PG8_LDA
#undef PG8_LDB
#undef PG8_MMA
#undef PG8_WAIT_V
#undef PG8_WAIT_L
#undef PG8_BAR
#undef PG8_SCHED
}
}
#ifndef PG8_SP2
#define PG8_SP2 true
#endif
#ifndef PG8_ALIGN
#define PG8_ALIGN true
#endif
#define LAS __attribute__((address_space(3)))
typedef unsigned short bf16;
typedef unsigned v4u __attribute__((ext_vector_type(4)));
typedef unsigned v2u __attribute__((ext_vector_type(2)));
typedef float f32x4 __attribute__((ext_vector_type(4)));
typedef float f32x2 __attribute__((ext_vector_type(2)));
typedef short bf16x8 __attribute__((ext_vector_type(8)));
constexpr int NT = 512;
constexpr int LDS_BYTES = 163840;
constexpr int NPHASE = 15;

constexpr size_t MiB = 1u << 20;
constexpr size_t WS_WIN = 1 * MiB, WS_WKV = 23 * MiB, WS_WOUT = 39 * MiB, WS_WQ = 47 * MiB, WS_WO = 55 * MiB, WS_WUP = 63 * MiB, WS_WDN = 107 * MiB;
constexpr size_t WS_LW = 129 * MiB, WS_LA = 129 * MiB + 256 * 1024, WS_LG = 129 * MiB + 512 * 1024;
constexpr size_t WS_HB = 130 * MiB, WS_MB = 166 * MiB, WS_A2 = 170 * MiB, WS_MIX = 206 * MiB, WS_X1 = 278 * MiB, WS_Q = 350 * MiB, WS_O = 386 * MiB;
constexpr size_t WS_KB = 422 * MiB, WS_VT = 426 * MiB, WS_Y = 430 * MiB, WS_G = 466 * MiB, WS_BON = 502 * MiB;
constexpr size_t WS_SHB = 818 * MiB;
constexpr size_t WS_SI = 503 * MiB, SB_STRIDE = 18 * MiB;
constexpr size_t WS_SW = WS_SI + 5 * SB_STRIDE;
constexpr size_t WS_UP = 503 * MiB;
constexpr size_t WS_GLU = 719 * MiB, WS_PR = 737 * MiB;
constexpr size_t WS_ACT = 719 * MiB;
constexpr size_t WS_HIMG = 820 * MiB;
constexpr size_t WS_SLAB = 822 * MiB, SLAB_F = (size_t)MS * D;
constexpr size_t WS_END = 886 * MiB;
constexpr size_t O_YP = 0, O_YS = 16777216, O_CP = 18874368, O_CS = 18997248, O_SP = 22929408, O_SS = 22943488, O_WP = 23394048, O_WS = 23656192,
                 O_FP = 32044800, O_FS = 32134912, O_MK = 35018496, O_MV = 37115648, O_END = 39212800;

enum { I_XP = 0, I_XS, I_CK, I_CV, I_SCONV, I_SSHIFT, I_SWKV, I_SFFN, I_MEM, I_NMIXPRE, I_WIN, I_CDW, I_CDWB, I_CLNG, I_CLNB, I_MU, I_W0, I_WLORA, I_A0, I_ALORA,
       I_GLORA, I_KK, I_KA, I_RK, I_LNXG, I_LNXB, I_WOUT, I_NMIXPOST, I_NXAPRE, I_NMEM, I_WQ, I_WK, I_WV, I_WO, I_NXAPOST, I_NFFNPRE, I_WUP, I_FDW, I_FDWB, I_WDOWN,
       I_NFFNPOST, N_IN };

struct Params { const float* in[N_IN]; float* out; unsigned char* ws; int ph_lo, ph_hi; };

__device__ __forceinline__ unsigned f2bf(float f) { unsigned u = __builtin_bit_cast(unsigned, f); return (u + 0x7fffu + ((u >> 16) & 1u)) >> 16; }
typedef __bf16 bf16x2_t __attribute__((ext_vector_type(2)));
__device__ __forceinline__ unsigned pk2(float lo, float hi) { const f32x2 v = {lo, hi}; const bf16x2_t b = __builtin_convertvector(v, bf16x2_t); return __builtin_bit_cast(unsigned, b); }
__device__ __forceinline__ float bflo(unsigned u) { return __builtin_bit_cast(float, u << 16); }
__device__ __forceinline__ float bfhi(unsigned u) { return __builtin_bit_cast(float, u & 0xffff0000u); }
__device__ __forceinline__ float wave_sum(float v) {
#pragma unroll
    for (int o = 1; o < 64; o <<= 1) v += __shfl_xor(v, o);
    return v;
}
__device__ __forceinline__ float wave_max(float v) {
#pragma unroll
    for (int o = 1; o < 64; o <<= 1) v = fmaxf(v, __shfl_xor(v, o));
    return v;
}
__device__ __forceinline__ float sigm(float x) { return 1.0f / (1.0f + __expf(-x)); }
#define LDS_WAIT() asm volatile("s_waitcnt lgkmcnt(0)" ::: "memory")

typedef __attribute__((address_space(1))) unsigned gu32;
#define XB_TMO      128
#define XB_XCNT(j)  (256  + 64 * (j))
#define XB_XSUB(j)  (1280 + 64 * (j))
#define XB_XGEN(j)  (2304 + 64 * (j))
#define XB_TOP      3328
#define XB_TOPGEN   3392
#define XCD_BAR_WORDS 3456
#define XB_SPIN_CAP (1u << 18)

__device__ __forceinline__ unsigned xb_ld(unsigned* p)              { return __hip_atomic_load(p, __ATOMIC_RELAXED, __HIP_MEMORY_SCOPE_AGENT); }
__device__ __forceinline__ unsigned xb_add(unsigned* p, unsigned v) { return __hip_atomic_fetch_add(p, v, __ATOMIC_RELAXED, __HIP_MEMORY_SCOPE_AGENT); }
__device__ __forceinline__ unsigned xb_xcc_id() { return (unsigned)__builtin_amdgcn_s_getreg((3 << 11) | 20) & 0xFu; }
#define XB_SPIN(cond, bar) do { unsigned _sp = 0; while (cond) { __builtin_amdgcn_s_sleep(1); \
    if ((++_sp & 255u) == 0u) { if (xb_ld(&(bar)[XB_TMO])) break; if (_sp > XB_SPIN_CAP) { atomicAdd(&(bar)[XB_TMO], 1u); break; } } } } while (0)

struct XcdBarrier {
    unsigned* bar; unsigned x;
    volatile LAS unsigned* st;
};

__device__ __forceinline__ XcdBarrier xcd_barrier_post(unsigned* bar, volatile LAS unsigned* st) {
    XcdBarrier b; b.bar = bar; b.x = xb_xcc_id(); b.st = st;
    if (threadIdx.x == 0) (void)xb_add(&bar[XB_XCNT(b.x)], 1u);
    return b;
}
__device__ __forceinline__ void xcd_barrier_complete(unsigned* bar, unsigned x, unsigned& nloc, unsigned& nx) {
    const unsigned G = gridDim.x * gridDim.y * gridDim.z;
    unsigned sum, cnt, mine, sp = 0u;
    for (;;) {
        sum = 0u; cnt = 0u; mine = 0u;
#pragma unroll
        for (unsigned j = 0; j < 16; ++j) { const unsigned c = xb_ld(&bar[XB_XCNT(j)]); sum += c; cnt += (c > 0u) ? 1u : 0u; mine = (j == x) ? c : mine; }
        if (sum == G) break;
        __builtin_amdgcn_s_sleep(1);
        if ((++sp & 255u) == 0u) { if (xb_ld(&bar[XB_TMO])) break; if (sp > XB_SPIN_CAP) { atomicAdd(&bar[XB_TMO], 1u); break; } }
    }
    nloc = mine > 0u ? mine : 1u; nx = cnt > 0u ? cnt : 1u;
}

__device__ __forceinline__ void xcd_barrier(const XcdBarrier& b) {
    asm volatile("s_waitcnt vmcnt(0)" ::: "memory");
    __syncthreads();
    if (threadIdx.x == 0) {
        unsigned* bar = b.bar;
        __builtin_amdgcn_s_waitcnt(0);
        unsigned nloc = b.st[0], nx = b.st[1];
        if (nloc == 0u) { xcd_barrier_complete(bar, b.x, nloc, nx); b.st[0] = nloc; b.st[1] = nx; }
        const unsigned old = xb_add(&bar[XB_XSUB(b.x)], 1u);
        const unsigned gen = old / nloc;
        if (old + 1u == (gen + 1u) * nloc) {
            __builtin_amdgcn_fence(__ATOMIC_RELEASE, "agent");
            asm volatile("s_waitcnt vmcnt(0)" ::: "memory");
            const unsigned og = xb_add(&bar[XB_TOP], 1u);
            const unsigned tg = og / nx;
            if (og + 1u == (tg + 1u) * nx) xb_add(&bar[XB_TOPGEN], 1u);
            else XB_SPIN(xb_ld(&bar[XB_TOPGEN]) == tg, bar);
            __builtin_amdgcn_fence(__ATOMIC_ACQUIRE, "agent");
            xb_add(&bar[XB_XGEN(b.x)], 1u);
            asm volatile("s_waitcnt vmcnt(0)" ::: "memory");
        } else {
            XB_SPIN(xb_ld(&bar[XB_XGEN(b.x)]) == gen, bar);
            __builtin_amdgcn_fence(__ATOMIC_ACQUIRE, "agent");
            asm volatile("s_waitcnt vmcnt(0)" ::: "memory");
        }
    }
    __syncthreads();
}

constexpr int MISC_OFF = LDS_BYTES - 64;
struct Ctx { int tid, lane, wave, bid, G, gw, NGW; };
__device__ __forceinline__ unsigned char* wsbase(const Params& P) { const unsigned long long x = (unsigned long long)P.ws; int lo = __builtin_amdgcn_readfirstlane((int)(unsigned)x), hi = __builtin_amdgcn_readfirstlane((int)(unsigned)(x >> 32));
    asm volatile("" : "+s"(lo), "+s"(hi)); return (unsigned char*)(((unsigned long long)(unsigned)hi << 32) | (unsigned)lo); }
__device__ __forceinline__ const float* inp(const Params& P, int i) { int z; asm volatile("s_mov_b32 %0, 0" : "=s"(z)); return P.in[i + z]; }

#ifndef MK_SUBMASK
#define MK_SUBMASK 0
#endif
#define SUBREP(i) for (int sr_ = 0; sr_ < ((((MK_SUBMASK) >> (i)) & 1) ? 2 : 1); ++sr_)
template <class ColMap>
__device__ __forceinline__ void transpose_load(const float* __restrict__ W, int N, int kb, int jb, int lane, ColMap cm, f32x4 (&v)[16]) {
    const int kr = lane >> 4, l16 = lane & 15, k0 = 64 * kb + 16 * kr, j = 64 * jb + 4 * l16;
    const int sc = cm(j);
    if (sc >= 0) {
        const float* src = W + (size_t)k0 * N + sc;
#pragma unroll
        for (int q = 0; q < 16; ++q) v[q] = __builtin_nontemporal_load((const f32x4*)(src + (size_t)q * N));
    } else {
#pragma unroll
        for (int q = 0; q < 16; ++q) v[q] = (f32x4){0.f, 0.f, 0.f, 0.f};
    }
}
__device__ __forceinline__ void transpose_store(int K, bf16* __restrict__ WT, int kb, int jb, int lane, const f32x4 (&v)[16]) {
    const int kr = lane >> 4, l16 = lane & 15, k0 = 64 * kb + 16 * kr, j = 64 * jb + 4 * l16;
#pragma unroll
    for (int e = 0; e < 4; ++e) {
        bf16* dst = WT + (size_t)(j + e) * K + k0;
        v4u o0, o1;
        o0.x = pk2(v[0][e], v[1][e]); o0.y = pk2(v[2][e], v[3][e]); o0.z = pk2(v[4][e], v[5][e]); o0.w = pk2(v[6][e], v[7][e]);
        o1.x = pk2(v[8][e], v[9][e]); o1.y = pk2(v[10][e], v[11][e]); o1.z = pk2(v[12][e], v[13][e]); o1.w = pk2(v[14][e], v[15][e]);
        *(v4u*)dst = o0; *(v4u*)(dst + 8) = o1;
    }
}
template <class ColMap>
__device__ __forceinline__ void transpose_item(const float* __restrict__ W, int K, int N, bf16* __restrict__ WT, int kb, int jb, int lane, ColMap cm) {
    f32x4 v[16]; transpose_load(W, N, kb, jb, lane, cm, v); transpose_store(K, WT, kb, jb, lane, v);
}
struct MapId { __device__ __forceinline__ int operator()(int j) const { return j; } };
struct MapIn {
    __device__ __forceinline__ int operator()(int j) const {
        if (j < 2048) { const int g = j >> 5, q = (j >> 3) & 3, n = (j >> 2) & 1, e = j & 3; return n * 1024 + 16 * g + 4 * q + e; }
        const int jj = j - 2048; return jj < NRC ? 2048 + jj : -1;
    }
};
__device__ __forceinline__ void rms_row_bf16(const float* __restrict__ xrow, const float* __restrict__ g, bf16* __restrict__ orow, int lane) {
    f32x4 v[8]; float s = 0.f;
#pragma unroll
    for (int j = 0; j < 8; ++j) { v[j] = *(const f32x4*)(xrow + 4 * (lane + 64 * j)); s += (v[j][0] * v[j][0] + v[j][1] * v[j][1]) + (v[j][2] * v[j][2] + v[j][3] * v[j][3]); }
    const float r = rsqrtf(wave_sum(s) * (1.0f / 2048.0f) + 1e-6f);
#pragma unroll
    for (int j = 0; j < 8; ++j) { const f32x4 gg = *(const f32x4*)(g + 4 * (lane + 64 * j));
        v2u o; o.x = pk2(v[j][0] * r * gg[0], v[j][1] * r * gg[1]); o.y = pk2(v[j][2] * r * gg[2], v[j][3] * r * gg[3]);
        *(v2u*)(orow + 4 * (lane + 64 * j)) = o; }
}
constexpr int I_SQ_ = 32 * 32, I_UP_ = 32 * 176, I_DN_ = 88 * 32, NDEF = 3 * I_SQ_ + I_UP_ + I_DN_;
struct DefItem { const float* W; bf16* WT; int K, N, kb, jb; };
__device__ __forceinline__ DefItem def_item(const Params& P, unsigned char* ws, int r) {
    DefItem d;
    if (r < I_SQ_) { d.W = inp(P, I_WOUT); d.WT = (bf16*)(ws + WS_WOUT); d.K = 2048; d.N = 2048; d.kb = r / 32; d.jb = r % 32; return d; } r -= I_SQ_;
    if (r < I_SQ_) { d.W = inp(P, I_WQ); d.WT = (bf16*)(ws + WS_WQ); d.K = 2048; d.N = 2048; d.kb = r / 32; d.jb = r % 32; return d; } r -= I_SQ_;
    if (r < I_SQ_) { d.W = inp(P, I_WO); d.WT = (bf16*)(ws + WS_WO); d.K = 2048; d.N = 2048; d.kb = r / 32; d.jb = r % 32; return d; } r -= I_SQ_;
    if (r < I_UP_) { d.W = inp(P, I_WUP); d.WT = (bf16*)(ws + WS_WUP); d.K = 2048; d.N = 11264; d.kb = r / 176; d.jb = r % 176; return d; } r -= I_UP_;
    d.W = inp(P, I_WDOWN); d.WT = (bf16*)(ws + WS_WDN); d.K = 5632; d.N = 2048; d.kb = r / 32; d.jb = r % 32; return d;
}
__device__ __forceinline__ void p0_prologue(const Params& P, const Ctx& C, LAS unsigned char* lds) {
    unsigned char* ws = wsbase(P);
    constexpr int I_IN = 32 * 88, I_SQ = 32 * 32;
    constexpr int NITEMS = I_IN + 2 * I_SQ;
    SUBREP(6) for (int it = C.gw; it < NITEMS; it += C.NGW) {
        int r = it;
        if (r < I_IN) { transpose_item(inp(P, I_WIN), 2048, 5568, (bf16*)(ws + WS_WIN), r / 88, r % 88, C.lane, MapIn()); continue; } r -= I_IN;
        if (r < I_SQ) { transpose_item(inp(P, I_WK), 2048, 2048, (bf16*)(ws + WS_WKV), r / 32, r % 32, C.lane, MapId()); continue; } r -= I_SQ;
        transpose_item(inp(P, I_WV), 2048, 2048, (bf16*)(ws + WS_WKV) + (size_t)2048 * 2048, r / 32, r % 32, C.lane, MapId());
    }
    const int gt = C.bid * NT + C.tid, ngt = C.G * NT;
    {   const float* s_w = inp(P, I_WLORA); const float* s_a = inp(P, I_ALORA); const float* s_g = inp(P, I_GLORA);
        for (int i = gt; i < 1024 * 96; i += ngt) { const int n = i / 96, k = i - n * 96, h = n >> 6, r = n & 63;
            bf16* img = (bf16*)(ws + WS_HIMG + (size_t)h * 65536);
            img[r * 96 + k] = (bf16)f2bf(s_w[k * 1024 + n]); img[6144 + r * 96 + k] = (bf16)f2bf(s_a[k * 1024 + n]); }
        for (int i = gt; i < 1024 * 256; i += ngt) { const int n = i >> 8, k = i & 255, h = n >> 6, r = n & 63;
            bf16* img = (bf16*)(ws + WS_HIMG + (size_t)h * 65536);
            img[12288 + r * 256 + (((k >> 3) ^ (r & 15)) << 3) + (k & 7)] = (bf16)f2bf(s_g[k * 1024 + n]); }
        const float* mu = inp(P, I_MU); const float* kk = inp(P, I_KK); const float* a0 = inp(P, I_A0); const float* w0 = inp(P, I_W0); const float* ka = inp(P, I_KA); const float* rk = inp(P, I_RK);
        for (int i = gt; i < 16 * 512; i += ngt) { const int h = i >> 9, ar = (i >> 6) & 7, j = i & 63;
            const float* bp = ar == 0 ? mu : ar == 1 ? mu + 1024 : ar == 2 ? mu + 2048 : ar == 3 ? kk : ar == 4 ? a0 : ar == 5 ? w0 : ar == 6 ? ka : rk;
            ((float*)(ws + WS_HIMG + (size_t)h * 65536 + 57344))[ar * 64 + j] = bp[h * 64 + j]; }
    }
    SUBREP(7) for (int m = C.gw; m < M + 1024; m += C.NGW) {
        if (m < M) { const float* xr = m < MP ? inp(P, I_XP) + (size_t)m * D : inp(P, I_XS) + (size_t)(m - MP) * D; rms_row_bf16(xr, inp(P, I_NMIXPRE), (bf16*)(ws + WS_HB) + (size_t)m * D, C.lane); }
        else { const int r = m - M; rms_row_bf16(inp(P, I_MEM) + (size_t)r * D, inp(P, I_NMEM), (bf16*)(ws + WS_MB) + (size_t)r * D, C.lane); }
    }
    { bf16* d = (bf16*)(ws + WS_SHB); const float* sp = inp(P, I_SSHIFT);
      for (int i = gt; i < (NBS + 1) * NRCP; i += ngt) { const int b = i / NRCP, c = i - b * NRCP; d[i] = (b < NBS && c < NRC) ? (bf16)f2bf(sp[(size_t)b * NRC + c]) : (bf16)0; } }
    { const f32x4* s = (const f32x4*)inp(P, I_SCONV); f32x4* d = (f32x4*)(P.out + O_CS);
      for (int i = gt; i < NBS * 22 * 256; i += ngt) { const int b = i / (22 * 256), r = i - b * (22 * 256); d[(size_t)b * 30 * 256 + r] = s[(size_t)b * 30 * 256 + 8 * 256 + r]; } }
}

template <int R>
__device__ __forceinline__ void conv_task(const Params& P, const Ctx& C, LAS unsigned char* lds, int grow0  , int t0  , int sb  ) {
    unsigned char* ws = wsbase(P);
    const bf16* glu = (const bf16*)(ws + WS_GLU);
    LAS unsigned* st = (LAS unsigned*)lds;
    LAS float* red = (LAS float*)(lds + 98304);
    constexpr int NR = R + 30;
    const float* sconv = inp(P, I_SCONV); const float* cdw = inp(P, I_CDW);
    for (int p = C.tid; p < NR * 128; p += NT) {
        const int rr = p >> 7, ch = p & 127; const int t = t0 - 30 + rr;
        v4u v = (v4u){0u, 0u, 0u, 0u};
        if (t >= 0) v = *(const v4u*)(glu + (size_t)(grow0 - 30 + rr) * CC + ch * 8);
        else if (sb >= 0) { const float* s = sconv + ((size_t)sb * 30 + rr) * CC + ch * 8;
            const f32x4 a = *(const f32x4*)s, b = *(const f32x4*)(s + 4); v.x = pk2(a[0], a[1]); v.y = pk2(a[2], a[3]); v.z = pk2(b[0], b[1]); v.w = pk2(b[2], b[3]); }
        *(LAS v4u*)(st + rr * 512 + ch * 4) = v;
    }
    const int c = 2 * C.tid;
    f32x2 w[31];
#pragma unroll
    for (int j = 0; j < 31; ++j) w[j] = *(const f32x2*)(cdw + j * CC + c);
    const f32x2 bias = *(const f32x2*)(inp(P, I_CDWB) + c);
    f32x2 acc[R];
#pragma unroll
    for (int r = 0; r < R; ++r) acc[r] = bias;
    __syncthreads();
#pragma unroll
    for (int rr = 0; rr < NR; ++rr) {
        if ((rr & 3) == 0) asm volatile("" ::: "memory");
        const unsigned u = st[rr * 512 + C.tid]; const float x0 = bflo(u), x1 = bfhi(u);
#pragma unroll
        for (int r = 0; r < R; ++r) { const int j = rr - r; if (j >= 0 && j < 31) { acc[r][0] += x0 * w[j][0]; acc[r][1] += x1 * w[j][1]; } }
    }
    float s[R];
#pragma unroll
    for (int r = 0; r < R; ++r) s[r] = wave_sum(acc[r][0] + acc[r][1]);
    if (C.lane == 0) {
#pragma unroll
        for (int r = 0; r < R; ++r) red[C.wave * 16 + r] = s[r]; }
    __syncthreads();
    float mean[R];
#pragma unroll
    for (int r = 0; r < R; ++r) { float t = 0.f;
#pragma unroll
        for (int wv = 0; wv < 8; ++wv) t += red[wv * 16 + r];
        mean[r] = t * (1.0f / 1024.0f); }
    __syncthreads();
#pragma unroll
    for (int r = 0; r < R; ++r) { const float d0 = acc[r][0] - mean[r], d1 = acc[r][1] - mean[r]; acc[r][0] = d0; acc[r][1] = d1; s[r] = wave_sum(d0 * d0 + d1 * d1); }
    if (C.lane == 0) {
#pragma unroll
        for (int r = 0; r < R; ++r) red[C.wave * 16 + r] = s[r]; }
    __syncthreads();
    const f32x2 lg = *(const f32x2*)(inp(P, I_CLNG) + c), lb = *(const f32x2*)(inp(P, I_CLNB) + c);
    bf16* a2 = (bf16*)(ws + WS_A2);
#pragma unroll
    for (int r = 0; r < R; ++r) { float t = 0.f;
#pragma unroll
        for (int wv = 0; wv < 8; ++wv) t += red[wv * 16 + r];
        const float rstd = rsqrtf(t * (1.0f / 1024.0f) + 1e-5f);
        float y0 = acc[r][0] * rstd * lg[0] + lb[0], y1 = acc[r][1] * rstd * lg[1] + lb[1];
        y0 = y0 * sigm(y0); y1 = y1 * sigm(y1);
        *(unsigned*)(a2 + (size_t)(grow0 + r) * D + c) = pk2(y0, y1); }
    __syncthreads();
}

#define XS8(cp_, pp_, mp_, off_, xs_) do { const v4u cu_ = *(const v4u*)((cp_) + (off_)); const v4u pu_ = *(const v4u*)((pp_) + (off_)); \
        const f32x4 m0_ = *(const f32x4*)((mp_) + (off_)), m1_ = *(const f32x4*)((mp_) + (off_) + 4); float c_, p_; \
        c_ = bflo(cu_.x); p_ = bflo(pu_.x); xs_[0] = c_ + (p_ - c_) * m0_[0]; c_ = bfhi(cu_.x); p_ = bfhi(pu_.x); xs_[1] = c_ + (p_ - c_) * m0_[1]; \
        c_ = bflo(cu_.y); p_ = bflo(pu_.y); xs_[2] = c_ + (p_ - c_) * m0_[2]; c_ = bfhi(cu_.y); p_ = bfhi(pu_.y); xs_[3] = c_ + (p_ - c_) * m0_[3]; \
        c_ = bflo(cu_.z); p_ = bflo(pu_.z); xs_[4] = c_ + (p_ - c_) * m1_[0]; c_ = bfhi(cu_.z); p_ = bfhi(pu_.z); xs_[5] = c_ + (p_ - c_) * m1_[1]; \
        c_ = bflo(cu_.w); p_ = bflo(pu_.w); xs_[6] = c_ + (p_ - c_) * m1_[2]; c_ = bfhi(cu_.w); p_ = bfhi(pu_.w); xs_[7] = c_ + (p_ - c_) * m1_[3]; } while (0)
#define XS4(cp_, pp_, mp_, off_, xs_) do { const v2u cu_ = *(const v2u*)((cp_) + (off_)); const v2u pu_ = *(const v2u*)((pp_) + (off_)); const f32x4 m0_ = *(const f32x4*)((mp_) + (off_)); float c_, p_; \
        c_ = bflo(cu_.x); p_ = bflo(pu_.x); xs_[0] = c_ + (p_ - c_) * m0_[0]; c_ = bfhi(cu_.x); p_ = bfhi(pu_.x); xs_[1] = c_ + (p_ - c_) * m0_[1]; \
        c_ = bflo(cu_.y); p_ = bflo(pu_.y); xs_[2] = c_ + (p_ - c_) * m0_[2]; c_ = bfhi(cu_.y); p_ = bfhi(pu_.y); xs_[3] = c_ + (p_ - c_) * m0_[3]; } while (0)
__device__ __forceinline__ bf16x8 pack8(const float (&x)[8]) {
    v4u o; o.x = pk2(x[0], x[1]); o.y = pk2(x[2], x[3]); o.z = pk2(x[4], x[5]); o.w = pk2(x[6], x[7]);
    return __builtin_bit_cast(bf16x8, o);
}
__device__ __forceinline__ float tanh_fast(float x) { return 1.0f - 2.0f / (1.0f + __expf(2.0f * x)); }
constexpr int PBUF = 65536;
__device__ __forceinline__ void mix4(const v2u cu, const v2u pu, const f32x4 m, float (&xs)[4]) {
    float c_, p_;
    c_ = bflo(cu.x); p_ = bflo(pu.x); xs[0] = c_ + (p_ - c_) * m[0]; c_ = bfhi(cu.x); p_ = bfhi(pu.x); xs[1] = c_ + (p_ - c_) * m[1];
    c_ = bflo(cu.y); p_ = bflo(pu.y); xs[2] = c_ + (p_ - c_) * m[2]; c_ = bfhi(cu.y); p_ = bfhi(pu.y); xs[3] = c_ + (p_ - c_) * m[3];
}
template <int NH>
__device__ __forceinline__ void prep_task(const Params& P, const Ctx& C, LAS unsigned char* lds, int rowblock, int hbase) {
    const int lane = C.lane, fr = lane & 15, fq = lane >> 4, row = rowblock * 128 + C.wave * 16 + fr;
    unsigned char* ws = wsbase(P);
    const bf16* curp = (const bf16*)(ws + WS_PR) + (size_t)row * NRCP;
    const bf16* prvp = curp - NRCP;
    if (row < MP) { if ((row & (SEQ - 1)) == 0) prvp = (const bf16*)(ws + WS_SHB) + (size_t)NBS * NRCP; }
    else { const int rs = row - MP; if ((rs & 7) == 0) prvp = (const bf16*)(ws + WS_SHB) + (size_t)(rs >> 3) * NRCP; }
    const float* mup = inp(P, I_MU);
    const unsigned char* himg = ws + WS_HIMG;
    const bf16* c8 = curp + 3072 + 8 * fq; const bf16* p8 = prvp + 3072 + 8 * fq; const float* m8 = mup + 3072 + 8 * fq;
    const f32x4 z4 = (f32x4){0.f, 0.f, 0.f, 0.f};
    const int c00 = hbase * 64 + 4 * fq;
#define PREP_STAGE(h_, b_, i0_, n_) do { int ll = lane; asm volatile("" : "+v"(ll)); _Pragma("unroll") for (int q = 0; q < (n_); ++q) { const int i = (i0_) + C.wave + 8 * q; \
        __builtin_amdgcn_global_load_lds((const unsigned*)(himg + (size_t)(h_) * PBUF + i * 1024 + ll * 16), (LAS unsigned*)(lds + (b_) * PBUF + i * 1024), 16, 0, 0); } } while (0)
#define PREP_SYNC() do { asm volatile("s_waitcnt vmcnt(0)" ::: "memory"); __syncthreads(); } while (0)
    {
        PREP_STAGE(hbase, 0, 24, 4);
        bf16x8 Ag[8];
#pragma unroll
        for (int s = 0; s < 8; ++s) { if (s == 4) asm volatile("" ::: "memory");
            float xs[8]; XS8(c8, p8, m8, 192 + 32 * s, xs);
#pragma unroll
            for (int e = 0; e < 8; ++e) xs[e] = sigm(xs[e]);
            Ag[s] = pack8(xs); }
        PREP_SYNC();
        bf16* gb = (bf16*)(ws + WS_G) + (size_t)row * RW + c00;
        const int lgo = 24576 + fr * 512;
#pragma unroll 1
        for (int hh = 0; hh < NH; ++hh) {
            if (hh + 1 < NH) PREP_STAGE(hbase + hh + 1, (hh + 1) & 1, 24, 4);
            const LAS unsigned char* wb = lds + (hh & 1) * PBUF;
#pragma unroll
            for (int nt = 0; nt < 4; ++nt) {
                f32x4 accG = z4;
#pragma unroll
                for (int s = 0; s < 8; ++s) { const bf16x8 bg = *(const LAS bf16x8*)(wb + lgo + nt * 8192 + (((4 * s + fq) ^ fr) * 16)); accG = __builtin_amdgcn_mfma_f32_16x16x32_bf16(bg, Ag[s], accG, 0, 0, 0); }
                *(v2u*)(gb + 16 * nt) = (v2u){pk2(accG[0], accG[1]), pk2(accG[2], accG[3])};
            }
            gb += 64;
            PREP_SYNC();
        }
    }
    PREP_STAGE(hbase, 0, 0, 3); if (C.wave < 2) PREP_STAGE(hbase, 0, 56, 1);
    const bf16* c4 = curp + c00; const bf16* p4 = prvp + c00;
    v2u cu[3][4], pu[3][4];
#pragma unroll
    for (int x = 0; x < 3; ++x)
#pragma unroll
        for (int nt = 0; nt < 4; ++nt) { cu[x][nt] = *(const v2u*)(c4 + 1024 * x + 16 * nt); pu[x][nt] = *(const v2u*)(p4 + 1024 * x + 16 * nt); }
    bf16x8 Aw[3], Aa[3];
#pragma unroll
    for (int s = 0; s < 3; ++s) { float xs[8]; XS8(c8, p8, m8, 32 * s, xs);
#pragma unroll
        for (int e = 0; e < 8; ++e) xs[e] = tanh_fast(xs[e]);
        Aw[s] = pack8(xs); }
#pragma unroll
    for (int s = 0; s < 3; ++s) { float xs[8]; XS8(c8, p8, m8, 96 + 32 * s, xs); Aa[s] = pack8(xs); }
    PREP_SYNC();
    constexpr size_t SS = SB_STRIDE / 2;
    bf16* sb = (bf16*)(ws + WS_SI) + (size_t)row * RW + c00; float* sw = (float*)(ws + WS_SW) + (size_t)row * RW + c00;
    float* bonp = (float*)(ws + WS_BON) + (size_t)row * RH + hbase;
    const int lwo = fr * 192 + fq * 16, lpo = 57344 + fq * 16;
#pragma unroll 1
    for (int hh = 0; hh < NH; ++hh) {
        if (hh + 1 < NH) { PREP_STAGE(hbase + hh + 1, (hh + 1) & 1, 0, 3); if (C.wave < 2) PREP_STAGE(hbase + hh + 1, (hh + 1) & 1, 56, 1); }
        const LAS unsigned char* wb = lds + (hh & 1) * PBUF;
        float ss = 0.f;
#pragma unroll
        for (int nt = 0; nt < 4; ++nt) {
            float xk0[4]; mix4(cu[1][nt], pu[1][nt], *(const LAS f32x4*)(wb + lpo + 1 * 256 + nt * 64), xk0);
            const f32x4 kkw = *(const LAS f32x4*)(wb + lpo + 3 * 256 + nt * 64);
#pragma unroll
            for (int e = 0; e < 4; ++e) { const float t = xk0[e] * kkw[e]; ss += t * t; }
        }
        ss += __shfl_xor(ss, 16); ss += __shfl_xor(ss, 32);
        const float inv = 1.0f / fmaxf(sqrtf(ss), 1e-12f);
        float bon = 0.f;
#pragma unroll
        for (int nt = 0; nt < 4; ++nt) {
            f32x4 accW = z4, accA = z4;
#pragma unroll
            for (int s = 0; s < 3; ++s) { const bf16x8 bw = *(const LAS bf16x8*)(wb + lwo + nt * 3072 + s * 64), ba = *(const LAS bf16x8*)(wb + 12288 + lwo + nt * 3072 + s * 64);
                accW = __builtin_amdgcn_mfma_f32_16x16x32_bf16(bw, Aw[s], accW, 0, 0, 0); accA = __builtin_amdgcn_mfma_f32_16x16x32_bf16(ba, Aa[s], accA, 0, 0, 0); }
            float xr[4], xv[4], xkk[4];
            mix4(cu[0][nt], pu[0][nt], *(const LAS f32x4*)(wb + lpo + 0 * 256 + nt * 64), xr);
            mix4(cu[1][nt], pu[1][nt], *(const LAS f32x4*)(wb + lpo + 1 * 256 + nt * 64), xkk);
            mix4(cu[2][nt], pu[2][nt], *(const LAS f32x4*)(wb + lpo + 2 * 256 + nt * 64), xv);
            const f32x4 kkw = *(const LAS f32x4*)(wb + lpo + 3 * 256 + nt * 64), a0 = *(const LAS f32x4*)(wb + lpo + 4 * 256 + nt * 64), w0 = *(const LAS f32x4*)(wb + lpo + 5 * 256 + nt * 64);
            const f32x4 ka = *(const LAS f32x4*)(wb + lpo + 6 * 256 + nt * 64), rk = *(const LAS f32x4*)(wb + lpo + 7 * 256 + nt * 64);
            f32x4 vw; float vk[4], va[4], vb[4];
#pragma unroll
            for (int e = 0; e < 4; ++e) {
                const float ee = 0.6065306597126334f * sigm(w0[e] + accW[e]);
                vw[e] = __expf(-ee);
                const float a = sigm(a0[e] + accA[e]);
                const float kn = xkk[e] * kkw[e] * inv;
                const float k2 = xkk[e] * (1.0f + (a - 1.0f) * ka[e]);
                vk[e] = k2; va[e] = -kn; vb[e] = kn * a;
                bon += xr[e] * k2 * rk[e];
            }
            bf16* so = sb + 16 * nt;
            *(v2u*)(so + 0 * SS) = (v2u){pk2(xr[0], xr[1]), pk2(xr[2], xr[3])};
            *(v2u*)(so + 1 * SS) = (v2u){pk2(vk[0], vk[1]), pk2(vk[2], vk[3])};
            *(v2u*)(so + 2 * SS) = (v2u){pk2(xv[0], xv[1]), pk2(xv[2], xv[3])};
            *(v2u*)(so + 3 * SS) = (v2u){pk2(va[0], va[1]), pk2(va[2], va[3])};
            *(v2u*)(so + 4 * SS) = (v2u){pk2(vb[0], vb[1]), pk2(vb[2], vb[3])};
            *(f32x4*)(sw + 16 * nt) = vw;
        }
        bon += __shfl_xor(bon, 16); bon += __shfl_xor(bon, 32);
        if (fq == 0) bonp[hh] = bon;
        sb += 64; sw += 64;
        if (hh + 1 < NH) { c4 += 64; p4 += 64;
#pragma unroll
            for (int x = 0; x < 3; ++x)
#pragma unroll
                for (int nt = 0; nt < 4; ++nt) { cu[x][nt] = *(const v2u*)(c4 + 1024 * x + 16 * nt); pu[x][nt] = *(const v2u*)(p4 + 1024 * x + 16 * nt); } }
        PREP_SYNC();
    }
#undef PREP_STAGE
#undef PREP_SYNC
}

constexpr int TC = 32, STEPF = 340;
template <int CTRL> __device__ __forceinline__ float dppf(float x) { return __builtin_bit_cast(float, __builtin_amdgcn_update_dpp(0, __builtin_bit_cast(int, x), CTRL, 0xF, 0xF, true)); }
__device__ __forceinline__ float allred16(float x) {
    x += dppf<0xB1>(x);
    x += dppf<0x4E>(x);
    x += dppf<0x141>(x);
    x += dppf<0x140>(x);
    return x;
}
#define SCAN_BAR() do { asm volatile("s_waitcnt lgkmcnt(0)" ::: "memory"); __builtin_amdgcn_s_barrier(); asm volatile("" ::: "memory"); } while (0)
#define SCAN_STEP(S01, S23, r4, w4, k4, a4, b4, v, yout) do { \
        f32x2 p2 = S01 * (f32x2){a4[0], a4[1]}; p2 = S23 * (f32x2){a4[2], a4[3]} + p2; \
        const float sa = allred16(p2[0] + p2[1]); const f32x2 sa2 = (f32x2){sa, sa}, v2 = (f32x2){v, v}; \
        f32x2 t01 = v2 * (f32x2){k4[0], k4[1]}, t23 = v2 * (f32x2){k4[2], k4[3]}; \
        t01 = sa2 * (f32x2){b4[0], b4[1]} + t01; t23 = sa2 * (f32x2){b4[2], b4[3]} + t23; \
        S01 = S01 * (f32x2){w4[0], w4[1]} + t01; S23 = S23 * (f32x2){w4[2], w4[3]} + t23; \
        f32x2 q2 = S01 * (f32x2){r4[0], r4[1]}; q2 = S23 * (f32x2){r4[2], r4[3]} + q2; \
        yout = allred16(q2[0] + q2[1]); } while (0)
__device__ __forceinline__ void ld_bf8(const bf16* p, float (&x)[8]) { const v4u u = *(const v4u*)p; x[0] = bflo(u.x); x[1] = bfhi(u.x); x[2] = bflo(u.y); x[3] = bfhi(u.y); x[4] = bflo(u.z); x[5] = bfhi(u.z); x[6] = bflo(u.w); x[7] = bfhi(u.w); }
__device__ __forceinline__ void scan_prompt(const Params& P, const Ctx& C, LAS unsigned char* lds, int chain, int rb, bool dodef) {
    unsigned char* ws = wsbase(P);
    const int b = chain >> 4, h = chain & 15, m0 = b * SEQ;
    LAS float* buf = (LAS float*)lds;
    LAS float* ypbuf = (LAS float*)(lds + 90112);
    constexpr int NCH = SEQ / TC;
    if (C.wave >= 4) {
        const int ht = C.tid - 256, t = ht >> 3, g = ht & 7;
        const bf16* SB = (const bf16*)(ws + WS_SI) + (size_t)m0 * RW + h * 64 + 8 * g; constexpr size_t SBS = SB_STRIDE / 2;
        const float* SW = (const float*)(ws + WS_SW) + (size_t)m0 * RW + h * 64 + 8 * g;
        const bf16* SV = (const bf16*)(ws + WS_SI) + 2 * SBS + (size_t)m0 * RW + h * 64 + rb * 16 + 8 * (g & 1);
        v4u lr, lk, lb, la, lv; f32x4 lw0, lw1;
#define SCAN_HLOAD(ck_) do { const int tg = (ck_) * TC + t; const size_t ro = (size_t)tg * RW; \
            lr = *(const v4u*)(SB + 0 * SBS + ro); lk = *(const v4u*)(SB + 1 * SBS + ro); lb = *(const v4u*)(SB + 4 * SBS + ro); \
            la = tg + 1 < SEQ ? *(const v4u*)(SB + 3 * SBS + ro + RW) : (v4u){0u, 0u, 0u, 0u}; \
            lw0 = *(const f32x4*)(SW + ro); lw1 = *(const f32x4*)(SW + ro + 4); lv = *(const v4u*)(SV + ro); } while (0)
#define SCAN_HWRITE(ck_) do { LAS float* d = buf + ((ck_) & 1) * (TC * STEPF) + t * STEPF; \
            const float an[8] = {bflo(la.x), bfhi(la.x), bflo(la.y), bfhi(la.y), bflo(la.z), bfhi(la.z), bflo(la.w), bfhi(la.w)}; \
            const float bb[8] = {bflo(lb.x), bfhi(lb.x), bflo(lb.y), bfhi(lb.y), bflo(lb.z), bfhi(lb.z), bflo(lb.w), bfhi(lb.w)}; \
            const float kk_[8] = {bflo(lk.x), bfhi(lk.x), bflo(lk.y), bfhi(lk.y), bflo(lk.z), bfhi(lk.z), bflo(lk.w), bfhi(lk.w)}; \
            float be = 0.f, ka_ = 0.f; _Pragma("unroll") for (int e = 0; e < 8; ++e) { be += bb[e] * an[e]; ka_ += kk_[e] * an[e]; } \
            be += __shfl_xor(be, 1); be += __shfl_xor(be, 2); be += __shfl_xor(be, 4); ka_ += __shfl_xor(ka_, 1); ka_ += __shfl_xor(ka_, 2); ka_ += __shfl_xor(ka_, 4); \
            *(LAS v4u*)(d + 0 + 8 * g) = (v4u){lr.x << 16, lr.x & 0xffff0000u, lr.y << 16, lr.y & 0xffff0000u}; *(LAS v4u*)(d + 4 + 8 * g) = (v4u){lr.z << 16, lr.z & 0xffff0000u, lr.w << 16, lr.w & 0xffff0000u}; \
            *(LAS f32x4*)(d + 64 + 8 * g) = lw0; *(LAS f32x4*)(d + 68 + 8 * g) = lw1; \
            *(LAS f32x4*)(d + 128 + 8 * g) = (f32x4){kk_[0], kk_[1], kk_[2], kk_[3]}; *(LAS f32x4*)(d + 132 + 8 * g) = (f32x4){kk_[4], kk_[5], kk_[6], kk_[7]}; \
            *(LAS f32x4*)(d + 192 + 8 * g) = (f32x4){lw0[0] * an[0], lw0[1] * an[1], lw0[2] * an[2], lw0[3] * an[3]}; *(LAS f32x4*)(d + 196 + 8 * g) = (f32x4){lw1[0] * an[4], lw1[1] * an[5], lw1[2] * an[6], lw1[3] * an[7]}; \
            *(LAS f32x4*)(d + 256 + 8 * g) = (f32x4){bb[0], bb[1], bb[2], bb[3]}; *(LAS f32x4*)(d + 260 + 8 * g) = (f32x4){bb[4], bb[5], bb[6], bb[7]}; \
            if (g < 2) { *(LAS v4u*)(d + 320 + 8 * g) = (v4u){lv.x << 16, lv.x & 0xffff0000u, lv.y << 16, lv.y & 0xffff0000u}; *(LAS v4u*)(d + 324 + 8 * g) = (v4u){lv.z << 16, lv.z & 0xffff0000u, lv.w << 16, lv.w & 0xffff0000u}; } \
            if (g == 2) *(LAS f32x2*)(d + 336) = (f32x2){be, ka_}; } while (0)
        SCAN_HLOAD(0); SCAN_HWRITE(0); SCAN_HLOAD(1);
        SCAN_BAR();
        const int sw = C.bid * 4 + (C.wave - 4), nsw = C.G * 4;
        f32x4 tv[16]; DefItem di; di.W = nullptr; di.WT = nullptr; di.K = 0; di.N = 0; di.kb = 0; di.jb = 0; bool have = false;
        float* Y = (float*)(ws + WS_Y) + (size_t)m0 * RW + h * 64 + rb * 16;
#define SCAN_YRED(ck_) do { const LAS float* yb = ypbuf + ((ck_) & 1) * (TC * 256); _Pragma("unroll") for (int j = 0; j < 2; ++j) { const int o = ht + 256 * j, ty = o >> 4, ri = o & 15; \
            const LAS f32x4* pp = (const LAS f32x4*)(yb + ty * 256 + ri * 16); const f32x4 s4 = (pp[0] + pp[1]) + (pp[2] + pp[3]); \
            Y[(size_t)((ck_) * TC + ty) * RW + ri] = (s4[0] + s4[1]) + (s4[2] + s4[3]); } } while (0)
        for (int ck = 0; ck < NCH; ++ck) {
            if (ck + 1 < NCH) SCAN_HWRITE(ck + 1);
            if (ck + 2 < NCH) SCAN_HLOAD(ck + 2);
            if (ck > 0) SCAN_YRED(ck - 1);
            if (dodef) {
                const int ph = ck % 5, it = sw + nsw * (ck / 5);
                if (ph == 0 && it < NDEF) { di = def_item(P, ws, it); transpose_load(di.W, di.N, di.kb, di.jb, C.lane, MapId(), tv); have = true; }
                if (ph == 2 && have) { transpose_store(di.K, di.WT, di.kb, di.jb, C.lane, tv); have = false; }
            }
            SCAN_BAR();
        }
        SCAN_YRED(NCH - 1);
#undef SCAN_YRED
#undef SCAN_HLOAD
#undef SCAN_HWRITE
    } else {
        const int rowl = C.lane >> 4, cl = C.lane & 15, irow = rb * 16 + C.wave * 4 + rowl;
        f32x2 S01 = (f32x2){0.f, 0.f}, S23 = (f32x2){0.f, 0.f};
        float sa = 0.f;
        SCAN_BAR();
        for (int ck = 0; ck < NCH; ++ck) {
            const LAS float* cb = buf + (ck & 1) * (TC * STEPF);
            f32x4 r4 = *(const LAS f32x4*)(cb + 0 * 64 + 4 * cl), w4 = *(const LAS f32x4*)(cb + 1 * 64 + 4 * cl), k4 = *(const LAS f32x4*)(cb + 2 * 64 + 4 * cl);
            f32x4 q4 = *(const LAS f32x4*)(cb + 3 * 64 + 4 * cl), b4 = *(const LAS f32x4*)(cb + 4 * 64 + 4 * cl); float v = cb[320 + C.wave * 4 + rowl]; f32x2 bk = *(const LAS f32x2*)(cb + 336);
            LAS float* yw = ypbuf + (ck & 1) * (TC * 256) + C.wave * 64 + C.lane;
#pragma unroll 4
            for (int t = 0; t < TC; ++t) {
                const LAS float* nb = cb + (t + 1 < TC ? t + 1 : t) * STEPF;
                const f32x4 nr = *(const LAS f32x4*)(nb + 0 * 64 + 4 * cl), nw = *(const LAS f32x4*)(nb + 1 * 64 + 4 * cl), nk = *(const LAS f32x4*)(nb + 2 * 64 + 4 * cl);
                const f32x4 nq = *(const LAS f32x4*)(nb + 3 * 64 + 4 * cl), nbb = *(const LAS f32x4*)(nb + 4 * 64 + 4 * cl); const float nv = nb[320 + C.wave * 4 + rowl]; const f32x2 nbk = *(const LAS f32x2*)(nb + 336);
                f32x2 d2 = S01 * (f32x2){q4[0], q4[1]}; d2 = S23 * (f32x2){q4[2], q4[3]} + d2;
                const float dd = allred16(d2[0] + d2[1]);
                const float san = sa * bk[0] + (v * bk[1] + dd);
                const f32x2 sa2 = (f32x2){sa, sa}, v2 = (f32x2){v, v};
                f32x2 t01 = v2 * (f32x2){k4[0], k4[1]}, t23 = v2 * (f32x2){k4[2], k4[3]};
                t01 = sa2 * (f32x2){b4[0], b4[1]} + t01; t23 = sa2 * (f32x2){b4[2], b4[3]} + t23;
                S01 = S01 * (f32x2){w4[0], w4[1]} + t01; S23 = S23 * (f32x2){w4[2], w4[3]} + t23;
                f32x2 y2 = S01 * (f32x2){r4[0], r4[1]}; y2 = S23 * (f32x2){r4[2], r4[3]} + y2;
                yw[t * 256] = y2[0] + y2[1];
                sa = san;
                r4 = nr; w4 = nw; k4 = nk; q4 = nq; b4 = nbb; v = nv; bk = nbk;
            }
            SCAN_BAR();
        }
        float* so = P.out + O_WP + ((size_t)chain * 64 + irow) * 64 + 4 * cl;
        *(f32x4*)so = (f32x4){S01[0], S01[1], S23[0], S23[1]};
    }
    __syncthreads();
}
__device__ __forceinline__ f32x4 ld_bf4(const bf16* p) { const v2u u = *(const v2u*)p; return (f32x4){bflo(u.x), bfhi(u.x), bflo(u.y), bfhi(u.y)}; }
struct SsStage { v2u r[4], k[4], a[4], b[4]; f32x4 w[4]; unsigned v[4]; f32x4 s; };
__device__ __forceinline__ void ss_load(SsStage& st, unsigned char* ws, const float* swkv, int tk, int hs, int wave, int rowl, int cl) {
    const int chain = tk >> 1, hf = tk & 1, b = chain >> 4, h = chain & 15, m0 = MP + 8 * b + 4 * hs, irow = hf * 32 + wave * 4 + rowl, lo = 4 * cl;
    const bf16* ub = (const bf16*)(ws + WS_SI) + (size_t)m0 * RW + h * 64; constexpr size_t SBS = SB_STRIDE / 2;
    const float* uw = (const float*)(ws + WS_SW) + (size_t)m0 * RW + h * 64;
#pragma unroll
    for (int t = 0; t < 4; ++t) { const bf16* ut = ub + t * RW;
        st.r[t] = *(const v2u*)(ut + 0 * SBS + lo); st.k[t] = *(const v2u*)(ut + 1 * SBS + lo); st.a[t] = *(const v2u*)(ut + 3 * SBS + lo); st.b[t] = *(const v2u*)(ut + 4 * SBS + lo);
        st.w[t] = *(const f32x4*)(uw + t * RW + lo); st.v[t] = (unsigned)(ut + 2 * SBS)[irow]; }
    if (hs == 0) st.s = *(const f32x4*)(swkv + ((size_t)chain * 64 + irow) * 64 + lo);
}
__device__ __forceinline__ f32x4 bf4(const v2u u) { return (f32x4){bflo(u.x), bfhi(u.x), bflo(u.y), bfhi(u.y)}; }
__device__ __forceinline__ void ss_compute(const SsStage& st, f32x2& S01, f32x2& S23, float& yk, int hs, int cl) {
    if (hs == 0) { S01 = (f32x2){st.s[0], st.s[1]}; S23 = (f32x2){st.s[2], st.s[3]}; yk = 0.f; }
#pragma unroll
    for (int t = 0; t < 4; ++t) { const f32x4 r4 = bf4(st.r[t]), k4 = bf4(st.k[t]), a4 = bf4(st.a[t]), b4 = bf4(st.b[t]), w4 = st.w[t]; const float v = bflo(st.v[t]);
        float y; SCAN_STEP(S01, S23, r4, w4, k4, a4, b4, v, y);
        yk = (cl == 4 * hs + t) ? y : yk; }
}
__device__ __forceinline__ void ss_finish(const Params& P, unsigned char* ws, int tk, int wave, int rowl, int cl, const f32x2 S01, const f32x2 S23, float yk) {
    const int chain = tk >> 1, hf = tk & 1, b = chain >> 4, h = chain & 15, irow = hf * 32 + wave * 4 + rowl;
    if (cl < 8) ((float*)(ws + WS_Y))[(size_t)(MP + 8 * b + cl) * RW + h * 64 + irow] = yk;
    *(f32x4*)(P.out + O_WS + ((size_t)chain * 64 + irow) * 64 + 4 * cl) = (f32x4){S01[0], S01[1], S23[0], S23[1]};
}
__device__ __forceinline__ void scan_sample_all(const Params& P, const Ctx& C, const float* swkv, int first, int stride) {
    unsigned char* ws = wsbase(P);
    const int rowl = C.lane >> 4, cl = C.lane & 15;
    if (first >= 4096) return;
    SsStage A, B; f32x2 S01 = (f32x2){0.f, 0.f}, S23 = S01; float yk = 0.f;
    ss_load(A, ws, swkv, first, 0, C.wave, rowl, cl);
    for (int tk = first; tk < 4096; tk += stride) {
        ss_load(B, ws, swkv, tk, 1, C.wave, rowl, cl);
        ss_compute(A, S01, S23, yk, 0, cl);
        if (tk + stride < 4096) ss_load(A, ws, swkv, tk + stride, 0, C.wave, rowl, cl);
        ss_compute(B, S01, S23, yk, 1, cl);
        ss_finish(P, ws, tk, C.wave, rowl, cl, S01, S23, yk);
    }
}

__device__ __forceinline__ void post_row(const Params& P, int row, int lane) {
    unsigned char* ws = wsbase(P);
    const float* Y = (const float*)(ws + WS_Y) + (size_t)row * RW + 16 * lane;
    const bf16* V = (const bf16*)(ws + WS_SI) + 2 * (SB_STRIDE / 2) + (size_t)row * RW + 16 * lane;
    const bf16* G = (const bf16*)(ws + WS_G) + (size_t)row * RW + 16 * lane;
    const float bon = ((const float*)(ws + WS_BON))[(size_t)row * RH + (lane >> 2)];
    float y[16], s = 0.f;
#pragma unroll
    for (int q = 0; q < 4; ++q) { const f32x4 t = *(const f32x4*)(Y + 4 * q); y[4 * q] = t[0]; y[4 * q + 1] = t[1]; y[4 * q + 2] = t[2]; y[4 * q + 3] = t[3]; s += (t[0] + t[1]) + (t[2] + t[3]); }
    s += __shfl_xor(s, 1); s += __shfl_xor(s, 2);
    const float mu = s * (1.0f / 64.0f); float q2 = 0.f;
#pragma unroll
    for (int e = 0; e < 16; ++e) { y[e] -= mu; q2 += y[e] * y[e]; }
    q2 += __shfl_xor(q2, 1); q2 += __shfl_xor(q2, 2);
    const float rstd = rsqrtf(q2 * (1.0f / 64.0f) + 64e-5f);
    const float* lg = inp(P, I_LNXG) + 16 * lane; const float* lb = inp(P, I_LNXB) + 16 * lane;
    unsigned o[8];
#pragma unroll
    for (int q = 0; q < 4; ++q) { const f32x4 g4 = *(const f32x4*)(lg + 4 * q), b4 = *(const f32x4*)(lb + 4 * q), v4 = ld_bf4(V + 4 * q), gg = ld_bf4(G + 4 * q);
        float r[4];
#pragma unroll
        for (int e = 0; e < 4; ++e) r[e] = (y[4 * q + e] * rstd * g4[e] + b4[e] + bon * v4[e]) * gg[e];
        o[2 * q] = pk2(r[0], r[1]); o[2 * q + 1] = pk2(r[2], r[3]); }
    bf16* dst = (bf16*)(ws + WS_A2) + (size_t)row * D + 1024 + 16 * lane;
    *(v4u*)dst = (v4u){o[0], o[1], o[2], o[3]}; *(v4u*)(dst + 8) = (v4u){o[4], o[5], o[6], o[7]};
}

__device__ __forceinline__ void rowpass(const float* xa, const bf16* __restrict__ mixb, const float* __restrict__ mix, int nslab, const float* __restrict__ g1, float* xo,
                                        const float* __restrict__ g2, bf16* __restrict__ hb, int lane) {
    f32x4 mv[8]; float s = 0.f;
#pragma unroll
    for (int j = 0; j < 8; ++j) {
        if (mixb) mv[j] = ld_bf4(mixb + 4 * (lane + 64 * j));
        else { mv[j] = *(const f32x4*)(mix + 4 * (lane + 64 * j));
            for (int sl = 1; sl < nslab; ++sl) mv[j] += *(const f32x4*)(mix + sl * SLAB_F + 4 * (lane + 64 * j)); }
        s += (mv[j][0] * mv[j][0] + mv[j][1] * mv[j][1]) + (mv[j][2] * mv[j][2] + mv[j][3] * mv[j][3]); }
    const float r = rsqrtf(wave_sum(s) * (1.0f / 2048.0f) + 1e-6f);
    float s2 = 0.f;
#pragma unroll
    for (int j = 0; j < 8; ++j) { const f32x4 a = *(const f32x4*)(xa + 4 * (lane + 64 * j)), gg = *(const f32x4*)(g1 + 4 * (lane + 64 * j));
        mv[j] = a + mv[j] * r * gg; *(f32x4*)(xo + 4 * (lane + 64 * j)) = mv[j];
        s2 += (mv[j][0] * mv[j][0] + mv[j][1] * mv[j][1]) + (mv[j][2] * mv[j][2] + mv[j][3] * mv[j][3]); }
    if (hb) {
        const float r2 = rsqrtf(wave_sum(s2) * (1.0f / 2048.0f) + 1e-6f);
#pragma unroll
        for (int j = 0; j < 8; ++j) { const f32x4 gg = *(const f32x4*)(g2 + 4 * (lane + 64 * j));
            v2u o; o.x = pk2(mv[j][0] * r2 * gg[0], mv[j][1] * r2 * gg[1]); o.y = pk2(mv[j][2] * r2 * gg[2], mv[j][3] * r2 * gg[3]);
            *(v2u*)(hb + 4 * (lane + 64 * j)) = o; }
    }
}
__device__ __forceinline__ void attn_prompt_task(const Params& P, const Ctx& C, LAS unsigned char* lds, int b, int h, int qt) {
    unsigned char* ws = wsbase(P);
    const bf16* Qg = (const bf16*)(ws + WS_Q); const bf16* Kg = (const bf16*)(ws + WS_KB); const bf16* VTg = (const bf16*)(ws + WS_VT);
    bf16* Og = (bf16*)(ws + WS_O);
    const int fr = C.lane & 15, fq = C.lane >> 4;
    const int qrow = b * SEQ + qt * 128 + C.wave * 16 + fr;
    constexpr int BUFB = 33792;
    bf16x8 Qf[16];
#pragma unroll
    for (int s = 0; s < 16; ++s) Qf[s] = *(const bf16x8*)(Qg + (size_t)qrow * D + h * XD + 32 * s + 8 * fq);
    f32x4 accS[16];
#pragma unroll
    for (int nt = 0; nt < 16; ++nt) accS[nt] = (f32x4){0.f, 0.f, 0.f, 0.f};
    v4u stg[4];
#define ATT_GLOAD(c_) do { if ((c_) < 8) { _Pragma("unroll") for (int i = 0; i < 4; ++i) { const int idx = C.tid + i * NT, key = idx >> 3, ch = idx & 7; \
            stg[i] = *(const v4u*)(Kg + (size_t)(b * NMEM + key) * D + h * XD + (c_) * 64 + ch * 8); } } \
        else { _Pragma("unroll") for (int i = 0; i < 4; ++i) { const int idx = C.tid + i * NT, dd = idx >> 5, ch = idx & 31; \
            stg[i] = *(const v4u*)(VTg + ((size_t)((b * XH + h) * XD + ((c_) - 8) * 64 + dd)) * NMEM + ch * 8); } } } while (0)
#define ATT_SWRITE(c_) do { LAS unsigned char* sbuf = lds + ((c_) & 1) * BUFB; if ((c_) < 8) { _Pragma("unroll") for (int i = 0; i < 4; ++i) { const int idx = C.tid + i * NT, key = idx >> 3, ch = idx & 7; \
            *(LAS v4u*)(sbuf + key * 128 + ((ch ^ (key & 7)) * 16)) = stg[i]; } } \
        else { _Pragma("unroll") for (int i = 0; i < 4; ++i) { const int idx = C.tid + i * NT, dd = idx >> 5, ch = idx & 31; \
            *(LAS v4u*)(sbuf + dd * 528 + ch * 16) = stg[i]; } } } while (0)
    ATT_GLOAD(0); ATT_SWRITE(0); __syncthreads();
    bf16x8 Pf[8];
#pragma unroll
    for (int c = 0; c < 8; ++c) {
        ATT_GLOAD(c + 1);
        const LAS unsigned char* sbuf = lds + (c & 1) * BUFB;
#pragma unroll
        for (int ss = 0; ss < 2; ++ss)
#pragma unroll
            for (int nt = 0; nt < 16; ++nt) {
                const int key = 16 * nt + fr, ch = ss * 4 + fq;
                const bf16x8 kf = *(const LAS bf16x8*)(sbuf + key * 128 + ((ch ^ (key & 7)) * 16));
                accS[nt] = __builtin_amdgcn_mfma_f32_16x16x32_bf16(kf, Qf[2 * c + ss], accS[nt], 0, 0, 0);
            }
        if (c == 7) {
            float mx = -3.0e38f;
#pragma unroll
            for (int nt = 0; nt < 16; ++nt) mx = fmaxf(mx, fmaxf(fmaxf(accS[nt][0], accS[nt][1]), fmaxf(accS[nt][2], accS[nt][3])));
            mx = fmaxf(mx, __shfl_xor(mx, 16)); mx = fmaxf(mx, __shfl_xor(mx, 32));
            float sum = 0.f;
#pragma unroll
            for (int nt = 0; nt < 16; ++nt) {
#pragma unroll
                for (int e = 0; e < 4; ++e) { const float p = exp2f(accS[nt][e] - mx); accS[nt][e] = p; sum += p; } }
            sum += __shfl_xor(sum, 16); sum += __shfl_xor(sum, 32);
            const float inv = 1.0f / sum;
#pragma unroll
            for (int s = 0; s < 8; ++s) { v4u o; o.x = pk2(accS[2 * s][0] * inv, accS[2 * s][1] * inv); o.y = pk2(accS[2 * s][2] * inv, accS[2 * s][3] * inv);
                o.z = pk2(accS[2 * s + 1][0] * inv, accS[2 * s + 1][1] * inv); o.w = pk2(accS[2 * s + 1][2] * inv, accS[2 * s + 1][3] * inv); Pf[s] = __builtin_bit_cast(bf16x8, o); }
        }
        ATT_SWRITE(c + 1);
        __syncthreads();
    }
    for (int c = 8; c < 16; ++c) {
        if (c + 1 < 16) ATT_GLOAD(c + 1);
        const LAS unsigned char* sbuf = lds + (c & 1) * BUFB;
        const int dv = c - 8;
        f32x4 accO[4];
#pragma unroll
        for (int nd = 0; nd < 4; ++nd) accO[nd] = (f32x4){0.f, 0.f, 0.f, 0.f};
#pragma unroll
        for (int s = 0; s < 8; ++s)
#pragma unroll
            for (int nd = 0; nd < 4; ++nd) {
                const LAS unsigned char* rp = sbuf + (nd * 16 + fr) * 528 + (32 * s + 4 * fq) * 2;
                const v2u lo = *(const LAS v2u*)rp, hi = *(const LAS v2u*)(rp + 32);
                const bf16x8 vf = __builtin_bit_cast(bf16x8, ((v4u){lo.x, lo.y, hi.x, hi.y}));
                accO[nd] = __builtin_amdgcn_mfma_f32_16x16x32_bf16(vf, Pf[s], accO[nd], 0, 0, 0);
            }
#pragma unroll
        for (int nd = 0; nd < 4; ++nd) { v2u o; o.x = pk2(accO[nd][0], accO[nd][1]); o.y = pk2(accO[nd][2], accO[nd][3]);
            *(v2u*)(Og + (size_t)qrow * D + h * XD + dv * 64 + nd * 16 + 4 * fq) = o; }
        if (c + 1 < 16) ATT_SWRITE(c + 1);
        __syncthreads();
    }
#undef ATT_GLOAD
#undef ATT_SWRITE
}
__device__ __forceinline__ void attn_sample_task(const Params& P, const Ctx& C, LAS unsigned char* lds, int b, int h) {
    unsigned char* ws = wsbase(P);
    bf16* Og = (bf16*)(ws + WS_O);
    const float* CK = inp(P, I_CK); const float* CV = inp(P, I_CV);
    LAS float* sQ = (LAS float*)lds;
    LAS float* sS = (LAS float*)(lds + 16384);
    LAS float* sP = (LAS float*)(lds + 24576);
    LAS float* sO = (LAS float*)(lds + 32768);
    const int row0 = MP + 8 * b, fr = C.lane & 15, fq = C.lane >> 4;
#pragma unroll
    for (int j = 0; j < 2; ++j) { const int i4 = C.tid + NT * j, q = i4 >> 7, d4 = i4 & 127;
        const float* qp = (const float*)(ws + WS_SLAB) + (size_t)(8 * b + q) * D + h * XD + 4 * d4;
        f32x4 a = *(const f32x4*)qp;
#pragma unroll
        for (int sl = 1; sl < 8; ++sl) a += *(const f32x4*)(qp + sl * SLAB_F);
        *(LAS f32x4*)(sQ + q * 512 + 4 * d4) = a * 0.06375871479f; }
    __syncthreads();
    {
        bf16x8 Qf[16];
#pragma unroll
        for (int s = 0; s < 16; ++s) { const LAS float* qs = sQ + (fr & 7) * 512 + 32 * s + 8 * fq; const f32x4 x0 = *(const LAS f32x4*)qs, x1 = *(const LAS f32x4*)(qs + 4);
            v4u o; o.x = pk2(x0[0], x0[1]); o.y = pk2(x0[2], x0[3]); o.z = pk2(x1[0], x1[1]); o.w = pk2(x1[2], x1[3]); Qf[s] = __builtin_bit_cast(bf16x8, o); }
#pragma unroll
        for (int nt = 0; nt < 2; ++nt) {
            const int key = 32 * C.wave + 16 * nt + fr;
            const float* kp = CK + ((size_t)(b * NMEM + key) * XH + h) * XD + 8 * fq;
            f32x4 acc = (f32x4){0.f, 0.f, 0.f, 0.f};
#pragma unroll
            for (int s8 = 0; s8 < 2; ++s8) {
                f32x4 k0[8], k1[8];
#pragma unroll
                for (int s = 0; s < 8; ++s) { k0[s] = __builtin_nontemporal_load((const f32x4*)(kp + 32 * (8 * s8 + s))); k1[s] = __builtin_nontemporal_load((const f32x4*)(kp + 32 * (8 * s8 + s) + 4)); }
#pragma unroll
                for (int s = 0; s < 8; ++s) { v4u o; o.x = pk2(k0[s][0], k0[s][1]); o.y = pk2(k0[s][2], k0[s][3]); o.z = pk2(k1[s][0], k1[s][1]); o.w = pk2(k1[s][2], k1[s][3]);
                    acc = __builtin_amdgcn_mfma_f32_16x16x32_bf16(__builtin_bit_cast(bf16x8, o), Qf[8 * s8 + s], acc, 0, 0, 0); }
            }
            if (fr < 8) {
#pragma unroll
                for (int e = 0; e < 4; ++e) sS[fr * 256 + 32 * C.wave + 16 * nt + 4 * fq + e] = acc[e]; }
        }
    }
    __syncthreads();
    {
        const int q = C.wave; const f32x4 s4 = *(const LAS f32x4*)(sS + q * 256 + 4 * C.lane);
        const float mx = wave_max(fmaxf(fmaxf(s4[0], s4[1]), fmaxf(s4[2], s4[3])));
        const float p0 = exp2f(s4[0] - mx), p1 = exp2f(s4[1] - mx), p2 = exp2f(s4[2] - mx), p3 = exp2f(s4[3] - mx);
        const float inv = 1.0f / wave_sum((p0 + p1) + (p2 + p3));
        sP[(4 * C.lane + 0) * 8 + q] = p0 * inv; sP[(4 * C.lane + 1) * 8 + q] = p1 * inv; sP[(4 * C.lane + 2) * 8 + q] = p2 * inv; sP[(4 * C.lane + 3) * 8 + q] = p3 * inv;
    }
    __syncthreads();
    {
        const int dh = C.wave & 1, kq = C.wave >> 1;
        f32x4 acc[8];
#pragma unroll
        for (int q = 0; q < 8; ++q) acc[q] = (f32x4){0.f, 0.f, 0.f, 0.f};
        const float* vp = CV + ((size_t)(b * NMEM + 64 * kq) * XH + h) * XD + 256 * dh + 4 * C.lane;
        for (int k0 = 0; k0 < 64; k0 += 8) {
            f32x4 vv[8];
#pragma unroll
            for (int u = 0; u < 8; ++u) vv[u] = __builtin_nontemporal_load((const f32x4*)(vp + (size_t)(k0 + u) * (XH * XD)));
#pragma unroll
            for (int u = 0; u < 8; ++u) { const f32x4 pa = *(const LAS f32x4*)(sP + (64 * kq + k0 + u) * 8), pb = *(const LAS f32x4*)(sP + (64 * kq + k0 + u) * 8 + 4);
                acc[0] += vv[u] * pa[0]; acc[1] += vv[u] * pa[1]; acc[2] += vv[u] * pa[2]; acc[3] += vv[u] * pa[3];
                acc[4] += vv[u] * pb[0]; acc[5] += vv[u] * pb[1]; acc[6] += vv[u] * pb[2]; acc[7] += vv[u] * pb[3]; }
        }
#pragma unroll
        for (int q = 0; q < 8; ++q) *(LAS f32x4*)(sO + C.wave * 2048 + q * 256 + 4 * C.lane) = acc[q];
    }
    __syncthreads();
    {
        const int q = C.tid >> 6, d8 = (C.tid & 63) * 8, dh = d8 >> 8, dl = d8 & 255;
        f32x4 a = (f32x4){0.f, 0.f, 0.f, 0.f}, c2 = a;
#pragma unroll
        for (int kq = 0; kq < 4; ++kq) { const LAS float* sp = sO + (kq * 2 + dh) * 2048 + q * 256 + dl; a += *(const LAS f32x4*)sp; c2 += *(const LAS f32x4*)(sp + 4); }
        v4u o; o.x = pk2(a[0], a[1]); o.y = pk2(a[2], a[3]); o.z = pk2(c2[0], c2[1]); o.w = pk2(c2[2], c2[3]);
        *(v4u*)(Og + (size_t)(row0 + q) * D + h * XD + d8) = o;
    }
    __syncthreads();
}

__device__ __forceinline__ void unpack8(const v4u u, float (&x)[8]) { x[0] = bflo(u.x); x[1] = bfhi(u.x); x[2] = bflo(u.y); x[3] = bfhi(u.y); x[4] = bflo(u.z); x[5] = bfhi(u.z); x[6] = bflo(u.w); x[7] = bfhi(u.w); }
__device__ __forceinline__ void ffn_conv_act(const Params& P, const Ctx& C) {
    unsigned char* ws = wsbase(P);
    const bf16* UP = (const bf16*)(ws + WS_UP); bf16* ACT = (bf16*)(ws + WS_ACT);
    const float* FW = inp(P, I_FDW); const float* FB = inp(P, I_FDWB); const float* SF = inp(P, I_SFFN);
    constexpr int NG = DFF / 8;
    constexpr int NRUN = 256 + 128;
    for (int it = C.bid * NT + C.tid; it < NRUN * NG; it += C.G * NT) {
        const int run = it / NG, c = (it - run * NG) * 8;
        int row0, nrow, sb = -1, t0;
        if (run < 256) { row0 = run * 32; nrow = 32; t0 = row0 & (SEQ - 1); } else { sb = run - 256; row0 = MP + 8 * sb; nrow = 8; t0 = 0; }
        float w[2][3][8], bs[2][8];
#pragma unroll
        for (int hf = 0; hf < 2; ++hf) {
#pragma unroll
            for (int j = 0; j < 3; ++j) { const f32x4 a = *(const f32x4*)(FW + j * DFF2 + hf * DFF + c), b2 = *(const f32x4*)(FW + j * DFF2 + hf * DFF + c + 4);
                w[hf][j][0] = a[0]; w[hf][j][1] = a[1]; w[hf][j][2] = a[2]; w[hf][j][3] = a[3]; w[hf][j][4] = b2[0]; w[hf][j][5] = b2[1]; w[hf][j][6] = b2[2]; w[hf][j][7] = b2[3]; }
            const f32x4 a = *(const f32x4*)(FB + hf * DFF + c), b2 = *(const f32x4*)(FB + hf * DFF + c + 4);
            bs[hf][0] = a[0]; bs[hf][1] = a[1]; bs[hf][2] = a[2]; bs[hf][3] = a[3]; bs[hf][4] = b2[0]; bs[hf][5] = b2[1]; bs[hf][6] = b2[2]; bs[hf][7] = b2[3];
        }
        float xm2[2][8], xm1[2][8];
#pragma unroll
        for (int hf = 0; hf < 2; ++hf) {
            if (sb >= 0) { const float* s = SF + (size_t)sb * 2 * DFF2 + hf * DFF + c;
                const f32x4 a = *(const f32x4*)s, b2 = *(const f32x4*)(s + 4), a1 = *(const f32x4*)(s + DFF2), b1 = *(const f32x4*)(s + DFF2 + 4);
                xm2[hf][0] = a[0]; xm2[hf][1] = a[1]; xm2[hf][2] = a[2]; xm2[hf][3] = a[3]; xm2[hf][4] = b2[0]; xm2[hf][5] = b2[1]; xm2[hf][6] = b2[2]; xm2[hf][7] = b2[3];
                xm1[hf][0] = a1[0]; xm1[hf][1] = a1[1]; xm1[hf][2] = a1[2]; xm1[hf][3] = a1[3]; xm1[hf][4] = b1[0]; xm1[hf][5] = b1[1]; xm1[hf][6] = b1[2]; xm1[hf][7] = b1[3]; }
            else if (t0 > 0) { unpack8(*(const v4u*)(UP + (size_t)(row0 - 2) * DFF2 + hf * DFF + c), xm2[hf]); unpack8(*(const v4u*)(UP + (size_t)(row0 - 1) * DFF2 + hf * DFF + c), xm1[hf]); }
            else {
#pragma unroll
                for (int e = 0; e < 8; ++e) { xm2[hf][e] = 0.f; xm1[hf][e] = 0.f; } }
        }
        for (int r0 = 0; r0 < nrow; r0 += 4) {
            v4u u[4][2];
#pragma unroll
            for (int i = 0; i < 4; ++i) { u[i][0] = *(const v4u*)(UP + (size_t)(row0 + r0 + i) * DFF2 + c); u[i][1] = *(const v4u*)(UP + (size_t)(row0 + r0 + i) * DFF2 + DFF + c); }
#pragma unroll
            for (int i = 0; i < 4; ++i) {
                float x[2][8], uc[2][8];
                unpack8(u[i][0], x[0]); unpack8(u[i][1], x[1]);
#pragma unroll
                for (int hf = 0; hf < 2; ++hf)
#pragma unroll
                    for (int e = 0; e < 8; ++e) { uc[hf][e] = bs[hf][e] + w[hf][0][e] * xm2[hf][e] + w[hf][1][e] * xm1[hf][e] + w[hf][2][e] * x[hf][e]; xm2[hf][e] = xm1[hf][e]; xm1[hf][e] = x[hf][e]; }
                float a[8];
#pragma unroll
                for (int e = 0; e < 8; ++e) a[e] = uc[0][e] * sigm(uc[0][e]) * uc[1][e];
                v4u o; o.x = pk2(a[0], a[1]); o.y = pk2(a[2], a[3]); o.z = pk2(a[4], a[5]); o.w = pk2(a[6], a[7]);
                *(v4u*)(ACT + (size_t)(row0 + r0 + i) * DFF + c) = o;
            }
        }
    }
}

template <bool COOP>
__global__ void __launch_bounds__(NT, 2) mega(Params P) {
    extern __shared__ __attribute__((aligned(16))) unsigned char lds_raw[];
    LAS unsigned char* lds = (LAS unsigned char*)lds_raw;
    Ctx C0; C0.tid = threadIdx.x; C0.lane = C0.tid & 63; C0.wave = __builtin_amdgcn_readfirstlane(C0.tid >> 6); C0.bid = blockIdx.x; C0.G = gridDim.x;
    C0.gw = C0.bid * 8 + C0.wave; C0.NGW = C0.G * 8;
    const int lo = P.ph_lo, hi = P.ph_hi;
    if (threadIdx.x < 4) ((LAS unsigned*)(lds + MISC_OFF))[threadIdx.x] = 0u;
    __syncthreads();
    XcdBarrier xbar; xbar.bar = nullptr; xbar.x = 0; xbar.st = nullptr;
    if constexpr (COOP) xbar = xcd_barrier_post((unsigned*)P.ws, (volatile LAS unsigned*)(lds + MISC_OFF));
#ifndef MK_ONLY
#define MK_ONLY -1
#endif
#define IN(k) ((MK_ONLY < 0 || MK_ONLY == (k)) && lo <= (k) && (k) < hi)
#define PH_CTX() Ctx C = C0; unsigned char* ws = wsbase(P); (void)ws; asm volatile("" : "+v"(C.tid), "+v"(C.lane), "+s"(C.wave), "+s"(C.gw), "+s"(C.bid))
#ifndef MK_REPMASK
#define MK_REPMASK 0
#endif
#define NREP(k) (((MK_REPMASK >> (k)) & 1) ? 2 : 1)
#define SEAM(k) do { if constexpr (COOP) { if (IN(k) && IN((k) + 1)) { if ((k) == 0) cg::this_grid().sync(); else xcd_barrier(xbar); } } } while (0)

    for (int rep_ = 0; rep_ < NREP(0); ++rep_) if (IN(0)) { PH_CTX(); p0_prologue(P, C, lds); __syncthreads(); }
    SEAM(0);
    for (int rep_ = 0; rep_ < NREP(1); ++rep_) if (IN(1)) { PH_CTX();
        { pg8::Gemm g{(const pg8::bf16_t*)(ws + WS_HB), (const pg8::bf16_t*)(ws + WS_WIN), M, NINP, D, D}; pg8::StaticOrder S; S.init(M, NINP, C.G, C.bid);
          pg8::EpiIn E{(pg8::bf16_t*)(ws + WS_GLU), (pg8::bf16_t*)(ws + WS_PR), P.out + O_CP, P.out + O_CS, P.out + O_SP, P.out + O_SS};
          pg8::gemm_phase<pg8::EpiIn, pg8::StaticOrder, PG8_ALIGN, PG8_SP2>(lds, g, S, E); }
        { pg8::Gemm g{(const pg8::bf16_t*)(ws + WS_MB), (const pg8::bf16_t*)(ws + WS_WKV), 1024, 4096, D, D}; pg8::StaticOrder S; S.init(1024, 4096, C.G, (C.bid + C.G - 24) % C.G);
          pg8::EpiKV E{P.out + O_MK, P.out + O_MV, (pg8::bf16_t*)(ws + WS_KB), (pg8::bf16_t*)(ws + WS_VT)};
          pg8::gemm_phase<pg8::EpiKV, pg8::StaticOrder, PG8_ALIGN, PG8_SP2>(lds, g, S, E); }
    }
    SEAM(1);
    for (int rep_ = 0; rep_ < NREP(2); ++rep_) if (IN(2)) { PH_CTX();
        {   int cs = C.bid, cst = C.G, cn = (640 - C.bid + C.G - 1) / C.G;
            if (C.G == 256) { if (C.bid < 112) { cst = 112; cn = (640 - C.bid + 111) / 112; } else cn = 0; }
            SUBREP(0) for (int i = 0; i < cn; ++i) { const int tk = cs + i * cst;
                if (tk < 512) { const int b = tk >> 7, r0 = (tk & 127) * 16; conv_task<16>(P, C, lds, b * SEQ + r0, r0, -1); }
                else { const int sb = tk - 512; conv_task<8>(P, C, lds, MP + 8 * sb, 0, sb); } } }
        SUBREP(1) for (int tk = (C.G == 256 ? C.bid - 112 : C.bid); tk < 144; tk += C.G) if (tk >= 0) prep_task<8>(P, C, lds, tk >> 1, (tk & 1) * 8);
    }
    SEAM(2);
    for (int rep_ = 0; rep_ < NREP(3); ++rep_) if (IN(3)) { PH_CTX();
        const float* swkv = inp(P, I_SWKV);
        SUBREP(2) for (int tk = C.bid; tk < 256; tk += C.G) scan_prompt(P, C, lds, tk >> 2, tk & 3, C.G == 256 && sr_ == 0);
        { const int nsw = C.G * 4, per = (SEQ / TC + 2) / 5; const int done_upto = (C.G == 256 ? nsw * per : 0);
          for (int it = done_upto + C.gw; it < NDEF; it += C.NGW) { const DefItem di = def_item(P, ws, it); transpose_item(di.W, di.K, di.N, di.WT, di.kb, di.jb, C.lane, MapId()); } }
        SUBREP(3) scan_sample_all(P, C, swkv, C.bid, C.G);
    }
    SEAM(3);
    for (int rep_ = 0; rep_ < NREP(4); ++rep_) if (IN(4)) { PH_CTX(); for (int m = C.gw; m < M; m += C.NGW) post_row(P, m, C.lane); }
    SEAM(4);
    for (int rep_ = 0; rep_ < NREP(5); ++rep_) if (IN(5)) { PH_CTX();
        { pg8::Gemm g{(const pg8::bf16_t*)(ws + WS_A2), (const pg8::bf16_t*)(ws + WS_WOUT), MP, D, D, D}; pg8::StaticOrder S; S.init(MP, D, C.G, C.bid);
          pg8::EpiBf16S E{(pg8::bf16_t*)(ws + WS_MIX), D, 1.0f, nullptr}; pg8::gemm_phase<pg8::EpiBf16S, pg8::StaticOrder, PG8_ALIGN, PG8_SP2>(lds, g, S, E); }
        { pg8::Gemm g{(const pg8::bf16_t*)(ws + WS_A2) + (size_t)MP * D, (const pg8::bf16_t*)(ws + WS_WOUT), MS, D, D / 8, D}; pg8::SplitOrder S; S.init(MS, D, 8, C.G, C.bid);
          pg8::EpiF32 E{(float*)(ws + WS_SLAB), D, SLAB_F}; pg8::gemm_phase<pg8::EpiF32, pg8::SplitOrder, PG8_ALIGN, PG8_SP2>(lds, g, S, E); } }
    SEAM(5);
    for (int rep_ = 0; rep_ < NREP(6); ++rep_) if (IN(6)) { PH_CTX(); const float* xp = inp(P, I_XP); const float* xs = inp(P, I_XS); const float* g1 = inp(P, I_NMIXPOST); const float* g2 = inp(P, I_NXAPRE);
        for (int m = C.gw; m < M; m += C.NGW) { const float* xr = m < MP ? xp + (size_t)m * D : xs + (size_t)(m - MP) * D;
        const bf16* mb = m < MP ? (const bf16*)(ws + WS_MIX) + (size_t)m * D : nullptr; const float* mx = (const float*)(ws + WS_SLAB) + (size_t)(m < MP ? 0 : m - MP) * D;
        rowpass(xr, mb, mx, 8, g1, (float*)(ws + WS_X1) + (size_t)m * D, g2, (bf16*)(ws + WS_HB) + (size_t)m * D, C.lane); } }
    SEAM(6);
    for (int rep_ = 0; rep_ < NREP(7); ++rep_) if (IN(7)) { PH_CTX();
        { pg8::Gemm g{(const pg8::bf16_t*)(ws + WS_HB), (const pg8::bf16_t*)(ws + WS_WQ), MP, D, D, D}; pg8::StaticOrder S; S.init(MP, D, C.G, C.bid);
          pg8::EpiBf16S E{(pg8::bf16_t*)(ws + WS_Q), D, 0.06375871479f  , nullptr};
          pg8::gemm_phase<pg8::EpiBf16S, pg8::StaticOrder, PG8_ALIGN, PG8_SP2>(lds, g, S, E); }
        { pg8::Gemm g{(const pg8::bf16_t*)(ws + WS_HB) + (size_t)MP * D, (const pg8::bf16_t*)(ws + WS_WQ), MS, D, D / 8, D}; pg8::SplitOrder S; S.init(MS, D, 8, C.G, C.bid);
          pg8::EpiF32 E{(float*)(ws + WS_SLAB), D, SLAB_F}; pg8::gemm_phase<pg8::EpiF32, pg8::SplitOrder, PG8_ALIGN, PG8_SP2>(lds, g, S, E); } }
    SEAM(7);
    for (int rep_ = 0; rep_ < NREP(8); ++rep_) if (IN(8)) { PH_CTX();
        SUBREP(4) for (int tk = C.bid; tk < 256; tk += C.G) attn_prompt_task(P, C, lds, tk >> 6, (tk >> 4) & 3, tk & 15);
        SUBREP(5) for (int tk = C.bid; tk < 512; tk += C.G) attn_sample_task(P, C, lds, tk >> 2, tk & 3);
    }
    SEAM(8);
    for (int rep_ = 0; rep_ < NREP(9); ++rep_) if (IN(9)) { PH_CTX();
        { pg8::Gemm g{(const pg8::bf16_t*)(ws + WS_O), (const pg8::bf16_t*)(ws + WS_WO), MP, D, D, D}; pg8::StaticOrder S; S.init(MP, D, C.G, C.bid);
          pg8::EpiBf16S E{(pg8::bf16_t*)(ws + WS_MIX), D, 1.0f, nullptr}; pg8::gemm_phase<pg8::EpiBf16S, pg8::StaticOrder, PG8_ALIGN, PG8_SP2>(lds, g, S, E); }
        { pg8::Gemm g{(const pg8::bf16_t*)(ws + WS_O) + (size_t)MP * D, (const pg8::bf16_t*)(ws + WS_WO), MS, D, D / 8, D}; pg8::SplitOrder S; S.init(MS, D, 8, C.G, C.bid);
          pg8::EpiF32 E{(float*)(ws + WS_SLAB), D, SLAB_F}; pg8::gemm_phase<pg8::EpiF32, pg8::SplitOrder, PG8_ALIGN, PG8_SP2>(lds, g, S, E); } }
    SEAM(9);
    for (int rep_ = 0; rep_ < NREP(10); ++rep_) if (IN(10)) { PH_CTX(); const float* g1 = inp(P, I_NXAPOST); const float* g2 = inp(P, I_NFFNPRE);
        for (int m = C.gw; m < M; m += C.NGW) { float* x1 = (float*)(ws + WS_X1) + (size_t)m * D;
        const bf16* mb = m < MP ? (const bf16*)(ws + WS_MIX) + (size_t)m * D : nullptr; const float* mx = (const float*)(ws + WS_SLAB) + (size_t)(m < MP ? 0 : m - MP) * D;
        rowpass(x1, mb, mx, 8, g1, x1, g2, (bf16*)(ws + WS_HB) + (size_t)m * D, C.lane); } }
    SEAM(10);
    for (int rep_ = 0; rep_ < NREP(11); ++rep_) if (IN(11)) { PH_CTX(); pg8::Gemm g{(const pg8::bf16_t*)(ws + WS_HB), (const pg8::bf16_t*)(ws + WS_WUP), M, DFF2, D, D}; pg8::StaticOrder S; S.init(M, DFF2, C.G, C.bid);
        pg8::EpiBf16S E{(pg8::bf16_t*)(ws + WS_UP), DFF2, 1.0f, P.out + O_FP};
        pg8::gemm_phase<pg8::EpiBf16S, pg8::StaticOrder, PG8_ALIGN, PG8_SP2>(lds, g, S, E); }
    SEAM(11);
    for (int rep_ = 0; rep_ < NREP(12); ++rep_) if (IN(12)) { PH_CTX(); ffn_conv_act(P, C); }
    SEAM(12);
    for (int rep_ = 0; rep_ < NREP(13); ++rep_) if (IN(13)) { PH_CTX();
        { pg8::Gemm g{(const pg8::bf16_t*)(ws + WS_ACT), (const pg8::bf16_t*)(ws + WS_WDN), MP, D, DFF, DFF}; pg8::StaticOrder S; S.init(MP, D, C.G, C.bid);
          pg8::EpiBf16S E{(pg8::bf16_t*)(ws + WS_MIX), D, 1.0f, nullptr}; pg8::gemm_phase<pg8::EpiBf16S, pg8::StaticOrder, PG8_ALIGN, PG8_SP2>(lds, g, S, E); }
        { pg8::Gemm g{(const pg8::bf16_t*)(ws + WS_ACT) + (size_t)MP * DFF, (const pg8::bf16_t*)(ws + WS_WDN), MS, D, DFF / 4, DFF}; pg8::SplitOrder S; S.init(MS, D, 4, C.G, (C.bid + 128) % C.G);
          pg8::EpiF32 E{(float*)(ws + WS_SLAB), D, SLAB_F}; pg8::gemm_phase<pg8::EpiF32, pg8::SplitOrder, PG8_ALIGN, PG8_SP2>(lds, g, S, E); } }
    SEAM(13);
    for (int rep_ = 0; rep_ < NREP(14); ++rep_) if (IN(14)) { PH_CTX(); const float* g1 = inp(P, I_NFFNPOST);
        for (int m = C.gw; m < M; m += C.NGW) { const float* x2 = (const float*)(ws + WS_X1) + (size_t)m * D;
        float* yo = m < MP ? P.out + O_YP + (size_t)m * D : P.out + O_YS + (size_t)(m - MP) * D;
        const bf16* mb = m < MP ? (const bf16*)(ws + WS_MIX) + (size_t)m * D : nullptr; const float* mx = (const float*)(ws + WS_SLAB) + (size_t)(m < MP ? 0 : m - MP) * D;
        rowpass(x2, mb, mx, 4, g1, yo, nullptr, nullptr, C.lane); } }
#undef IN
#undef SEAM
}

#ifndef MK_ONE_LAUNCH
#define MK_ONE_LAUNCH 1
#endif
extern "C" void kernel_launch(void* const* d_in, const int* in_sizes, int n_in, void* d_out, int out_size, void* d_ws, size_t ws_size, hipStream_t stream) {
    static int grid = 0;
    if (grid == 0) {
        if (n_in != N_IN || (size_t)out_size != O_END || ws_size < WS_END) { fprintf(stderr, "kernel_launch: unexpected sizes: n_in %d out %d ws %zu (need %zu)\n", n_in, out_size, ws_size, (size_t)WS_END); grid = -1; return; }
        int dev = 0, cus = 0, per_cu = 0;
        (void)hipGetDevice(&dev); (void)hipDeviceGetAttribute(&cus, hipDeviceAttributeMultiprocessorCount, dev);
        (void)hipFuncSetAttribute((const void*)mega<(MK_ONE_LAUNCH != 0)>, hipFuncAttributeMaxDynamicSharedMemorySize, LDS_BYTES);
        (void)hipOccupancyMaxActiveBlocksPerMultiprocessor(&per_cu, (const void*)mega<(MK_ONE_LAUNCH != 0)>, NT, LDS_BYTES);
        fprintf(stderr, "kernel_launch: cus %d, occupancy query %d block(s)/CU, ws %zu MiB\n", cus, per_cu, ws_size >> 20);
        (void)hipGetLastError();
        grid = cus;
        if (per_cu < 1) { fprintf(stderr, "kernel_launch: occupancy query says 0 blocks per CU\n"); }
    }
    if (grid < 0) return;
    if (hipMemsetAsync(d_ws, 0, 16384, stream) != hipSuccess) { fprintf(stderr, "kernel_launch: hipMemsetAsync failed\n"); return; }
    Params p{};
    for (int i = 0; i < N_IN; ++i) p.in[i] = (const float*)d_in[i];
    p.out = (float*)d_out; p.ws = (unsigned char*)d_ws;
#if MK_ONE_LAUNCH
    p.ph_lo = 0; p.ph_hi = NPHASE;
    void* args[] = {&p};
    hipError_t e = hipLaunchCooperativeKernel((const void*)mega<true>, dim3(grid), dim3(NT), args, LDS_BYTES, stream);
    if (e != hipSuccess) fprintf(stderr, "cooperative launch failed: %s (grid %d)\n", hipGetErrorString(e), grid);
#else
    for (int ph = 0; ph < NPHASE; ++ph) { p.ph_lo = ph; p.ph_hi = ph + 1; hipLaunchKernelGGL((mega<false>), dim3(grid), dim3(NT), LDS_BYTES, stream, p); }
#endif
}
```
